# Optimizing an MI355X kernel written in HIP

```python
import jax, jax.numpy as jnp
from jax import lax
import numpy as np

D_MODEL = 1024
BATCH = 8
SEQ = 2048
DEPTH = 2

GRID_W = 64
CTX_LEN = 256
HEAD_DIM = 64
FOURIER_GROUPS = 4
FOURIER_GROUP_CH = 64
FOURIER_W = FOURIER_GROUPS * FOURIER_GROUP_CH
G_HEADS = 8
G_KV = 2
G_GROUP = G_HEADS // G_KV
W_HEADS = 4
W_KV = 2
W_GROUP = W_HEADS // W_KV
WINDOW = 128
Q_BLOCK = 128
N_BRANCH = 3
SPLIT_SIZES = (FOURIER_W,
               G_HEADS * HEAD_DIM, G_KV * HEAD_DIM, G_KV * HEAD_DIM,
               W_HEADS * HEAD_DIM, W_KV * HEAD_DIM, W_KV * HEAD_DIM,
               N_BRANCH * D_MODEL)
IN_W = sum(SPLIT_SIZES)
ROPE_THETA = 10000.0
N_EXPERTS = 16
CAPACITY_FACTOR = 2
EXPERT_FF = D_MODEL
EPS = 1e-6
NEG_INF = -1e30

kernel_name = "hybrid_dit_fourier_gqa_window_ecmoe"


def rms_norm(x, g):
    xf = x.astype(jnp.float32)
    y = xf * lax.rsqrt(jnp.mean(jnp.square(xf), axis=-1, keepdims=True) + EPS)
    return (y * g.astype(jnp.float32)).astype(x.dtype)


def modulate(h, shift, scale):
    return h * (1 + scale[:, None, :]) + shift[:, None, :]


def heads(z, n):
    return z.reshape(z.shape[:-1] + (n, HEAD_DIM))


def split_proj(z):
    points = np.cumsum(SPLIT_SIZES)[:-1].tolist()
    return jnp.split(z, points, axis=-1)


def axial_rope_angles(n_tokens):
    rows = n_tokens // GRID_W
    r, col = jnp.meshgrid(jnp.arange(rows), jnp.arange(GRID_W), indexing="ij")
    half = HEAD_DIM // 2
    inv = ROPE_THETA ** (-jnp.arange(0, half, 2, dtype=jnp.float32) / half)
    ang = jnp.concatenate([r.reshape(-1, 1).astype(jnp.float32) * inv,
                           col.reshape(-1, 1).astype(jnp.float32) * inv], axis=-1)
    return jnp.cos(ang), jnp.sin(ang)


def apply_rope(x, cos, sin):
    xf = x.astype(jnp.float32).reshape(x.shape[:-1] + (HEAD_DIM // 2, 2))
    x0, x1 = xf[..., 0], xf[..., 1]
    cs, sn = cos[None, :, None, :], sin[None, :, None, :]
    out = jnp.stack([x0 * cs - x1 * sn, x0 * sn + x1 * cs], axis=-1)
    return out.reshape(x.shape).astype(x.dtype)


def attend(q, k, v):
    s = jnp.einsum("bqhgd,bkhd->bhgqk", q, k).astype(jnp.float32) * (HEAD_DIM ** -0.5)
    p = jax.nn.softmax(s, axis=-1).astype(v.dtype)
    return jnp.einsum("bhgqk,bkhd->bqhgd", p, v)


def global_attention(q_l, k_l, v_l, k_c, v_c):
    B, T = q_l.shape[:2]
    nb = T // Q_BLOCK
    k_all = jnp.concatenate([k_c, k_l], axis=1)
    v_all = jnp.concatenate([v_c, v_l], axis=1)
    qb = q_l.reshape(B, nb, Q_BLOCK, G_KV, G_GROUP, HEAD_DIM).transpose(1, 0, 2, 3, 4, 5)
    ob = lax.map(lambda qq: attend(qq, k_all, v_all), qb)
    return ob.transpose(1, 0, 2, 3, 4, 5).reshape(B, T, G_HEADS * HEAD_DIM)


def window_attention(q_l, k_l, v_l, k_c, v_c, sink):
    B, T = q_l.shape[:2]
    L = k_c.shape[1]
    nb = T // Q_BLOCK
    q = q_l.reshape(B, nb, Q_BLOCK, W_KV, W_GROUP, HEAD_DIM)

    def band(t):
        tp = jnp.pad(t, ((0, 0), (Q_BLOCK, Q_BLOCK), (0, 0), (0, 0)))
        tp = tp.reshape(B, nb + 2, Q_BLOCK, W_KV, HEAD_DIM)
        return jnp.concatenate([tp[:, :-2], tp[:, 1:-1], tp[:, 2:]], axis=2)

    kb, vb = band(k_l), band(v_l)
    scale = HEAD_DIM ** -0.5
    s_c = jnp.einsum("bnqhgd,bkhd->bnhgqk", q, k_c).astype(jnp.float32) * scale
    s_b = jnp.einsum("bnqhgd,bnkhd->bnhgqk", q, kb).astype(jnp.float32) * scale
    qpos = jnp.arange(Q_BLOCK)[:, None]
    kpos = jnp.arange(3 * Q_BLOCK)[None, :]
    rel = qpos - kpos + Q_BLOCK
    key_abs = (jnp.arange(nb)[:, None, None] - 1) * Q_BLOCK + kpos[None]
    valid = (jnp.abs(rel)[None] <= WINDOW) & (key_abs >= 0) & (key_abs < T)
    s_b = jnp.where(valid[None, :, None, None], s_b, NEG_INF)
    s_sink = jnp.broadcast_to(sink.astype(jnp.float32).reshape(1, 1, W_KV, W_GROUP, 1, 1),
                              s_c.shape[:-1] + (1,))
    p = jax.nn.softmax(jnp.concatenate([s_c, s_b, s_sink], axis=-1), axis=-1).astype(v_l.dtype)
    o = (jnp.einsum("bnhgqk,bkhd->bnqhgd", p[..., :L], v_c)
         + jnp.einsum("bnhgqk,bnkhd->bnqhgd", p[..., L:L + 3 * Q_BLOCK], vb))
    return o.reshape(B, T, W_HEADS * HEAD_DIM)


def sink_attention_ctx(q_c, k_c, v_c, sink):
    B, L = q_c.shape[:2]
    q = q_c.reshape(B, L, W_KV, W_GROUP, HEAD_DIM)
    s = jnp.einsum("bqhgd,bkhd->bhgqk", q, k_c).astype(jnp.float32) * (HEAD_DIM ** -0.5)
    s_sink = jnp.broadcast_to(sink.astype(jnp.float32).reshape(1, W_KV, W_GROUP, 1, 1),
                              s.shape[:-1] + (1,))
    p = jax.nn.softmax(jnp.concatenate([s, s_sink], axis=-1), axis=-1)[..., :L].astype(v_c.dtype)
    o = jnp.einsum("bhgqk,bkhd->bqhgd", p, v_c)
    return o.reshape(B, L, W_HEADS * HEAD_DIM)


def fourier_mix(u):
    B, N, _ = u.shape
    g = u.astype(jnp.float32).reshape(B, N, FOURIER_GROUPS, FOURIER_GROUP_CH)
    f = jnp.fft.fft2(g, axes=(1, 3), norm="ortho").real
    return f.reshape(B, N, FOURIER_W).astype(u.dtype)


def gated_merge(gate_cols, f_mix, o_g, o_w, w_br_fourier, w_br_global, w_br_window, w_out):
    g = jax.nn.sigmoid(gate_cols).reshape(gate_cols.shape[:-1] + (N_BRANCH, D_MODEL))
    m = (g[..., 0, :] * (f_mix @ w_br_fourier)
         + g[..., 1, :] * (o_g @ w_br_global)
         + g[..., 2, :] * (o_w @ w_br_window))
    return m @ w_out


def mixer_sublayer(h, hc, cos, sin, w_in, q_norm_g, k_norm_g, sink,
                   w_br_fourier, w_br_global, w_br_window, w_out, need_ctx):
    B, T, _ = h.shape
    L = hc.shape[1]
    lf, lgq, lgk, lgv, lwq, lwk, lwv, lgate = split_proj(h @ w_in)
    cf, cgq, cgk, cgv, cwq, cwk, cwv, cgate = split_proj(hc @ w_in)
    kc_g = rms_norm(heads(cgk, G_KV), k_norm_g)
    vc_g = heads(cgv, G_KV)
    kc_w = heads(cwk, W_KV)
    vc_w = heads(cwv, W_KV)
    q_g = apply_rope(rms_norm(heads(lgq, G_HEADS), q_norm_g), cos, sin)
    k_g = apply_rope(rms_norm(heads(lgk, G_KV), k_norm_g), cos, sin)
    o_g = global_attention(q_g, k_g, heads(lgv, G_KV), kc_g, vc_g)
    q_w = apply_rope(heads(lwq, W_HEADS), cos, sin)
    k_w = apply_rope(heads(lwk, W_KV), cos, sin)
    o_w = window_attention(q_w, k_w, heads(lwv, W_KV), kc_w, vc_w, sink)
    y = gated_merge(lgate, fourier_mix(lf), o_g, o_w,
                    w_br_fourier, w_br_global, w_br_window, w_out)
    if not need_ctx:
        return y, None
    qc_g = rms_norm(heads(cgq, G_HEADS), q_norm_g).reshape(B, L, G_KV, G_GROUP, HEAD_DIM)
    oc_g = attend(qc_g, kc_g, vc_g).reshape(B, L, G_HEADS * HEAD_DIM)
    oc_w = sink_attention_ctx(heads(cwq, W_HEADS), kc_w, vc_w, sink)
    yc = gated_merge(cgate, fourier_mix(cf), oc_g, oc_w,
                     w_br_fourier, w_br_global, w_br_window, w_out)
    return y, yc


def expert_choice_ffn(h, w_router, w_gate_e, w_up_e, w_down_e):
    B, N, _ = h.shape
    cap = CAPACITY_FACTOR * N // N_EXPERTS
    aff = jax.nn.softmax((h @ w_router).astype(jnp.float32), axis=-1)
    top_aff, top_idx = lax.top_k(aff.transpose(0, 2, 1), cap)
    bidx = jnp.arange(B)[:, None, None]
    xg = h[bidx, top_idx]
    a = jnp.einsum("becd,edf->becf", xg, w_gate_e)
    u = jnp.einsum("becd,edf->becf", xg, w_up_e)
    out = jnp.einsum("becf,efd->becd", jax.nn.silu(a) * u, w_down_e) * top_aff[..., None].astype(h.dtype)
    return jnp.zeros_like(h).at[bidx, top_idx].add(out)


def setup_inputs(seed: int = 0) -> dict:
    key = jax.random.key(seed)
    ks = jax.random.split(key, 24)
    D, F, E = D_MODEL, EXPERT_FF, N_EXPERTS
    nrm = jax.random.normal
    f32 = jnp.float32
    return {
        "x": nrm(ks[0], (BATCH, SEQ, D), f32),
        "c": nrm(ks[1], (BATCH, D), f32),
        "ctx": nrm(ks[2], (BATCH, CTX_LEN, D), f32),
        "c_ctx": nrm(ks[3], (D,), f32),
        "w_ada": nrm(ks[4], (DEPTH, D, 6 * D), f32) * (0.5 * D ** -0.5),
        "b_ada": nrm(ks[5], (DEPTH, 6 * D), f32) * 0.01,
        "norm1_g": 1.0 + 0.05 * nrm(ks[6], (DEPTH, D), f32),
        "w_in": nrm(ks[7], (DEPTH, D, IN_W), f32) * D ** -0.5,
        "q_norm_g": 1.0 + 0.05 * nrm(ks[8], (DEPTH, HEAD_DIM), f32),
        "k_norm_g": 1.0 + 0.05 * nrm(ks[9], (DEPTH, HEAD_DIM), f32),
        "sink": 0.5 * nrm(ks[10], (DEPTH, W_HEADS), f32),
        "w_br_fourier": nrm(ks[11], (DEPTH, FOURIER_W, D), f32) * FOURIER_W ** -0.5,
        "w_br_global": nrm(ks[12], (DEPTH, G_HEADS * HEAD_DIM, D), f32) * (G_HEADS * HEAD_DIM) ** -0.5,
        "w_br_window": nrm(ks[13], (DEPTH, W_HEADS * HEAD_DIM, D), f32) * (W_HEADS * HEAD_DIM) ** -0.5,
        "w_out": nrm(ks[14], (DEPTH, D, D), f32) * D ** -0.5,
        "norm2_g": 1.0 + 0.05 * nrm(ks[15], (DEPTH, D), f32),
        "w_router": nrm(ks[16], (DEPTH, D, E), f32) * D ** -0.5,
        "w_gate_e": nrm(ks[17], (DEPTH, E, D, F), f32) * D ** -0.5,
        "w_up_e": nrm(ks[18], (DEPTH, E, D, F), f32) * D ** -0.5,
        "w_down_e": nrm(ks[19], (DEPTH, E, F, D), f32) * F ** -0.5,
        "final_g": 1.0 + 0.05 * nrm(ks[20], (D,), f32),
    }


def reference(x, c, ctx, c_ctx, w_ada, b_ada, norm1_g, w_in, q_norm_g, k_norm_g, sink,
              w_br_fourier, w_br_global, w_br_window, w_out, norm2_g, w_router,
              w_gate_e, w_up_e, w_down_e, final_g):
    T = x.shape[1]
    cos, sin = axial_rope_angles(T)
    xc = ctx
    silu_c = jax.nn.silu(c)
    silu_cc = jax.nn.silu(c_ctx)[None]
    for l in range(DEPTH):
        need_ctx = l < DEPTH - 1
        mod = silu_c @ w_ada[l] + b_ada[l]
        mod_c = silu_cc @ w_ada[l] + b_ada[l]
        sh1, sc1, g1, sh2, sc2, g2 = jnp.split(mod, 6, axis=-1)
        csh1, csc1, cg1, csh2, csc2, cg2 = jnp.split(mod_c, 6, axis=-1)
        h = modulate(rms_norm(x, norm1_g[l]), sh1, sc1)
        hc = modulate(rms_norm(xc, norm1_g[l]), csh1, csc1)
        y, yc = mixer_sublayer(h, hc, cos, sin, w_in[l], q_norm_g[l], k_norm_g[l], sink[l],
                               w_br_fourier[l], w_br_global[l], w_br_window[l], w_out[l], need_ctx)
        x = x + g1[:, None, :] * y
        h = modulate(rms_norm(x, norm2_g[l]), sh2, sc2)
        x = x + g2[:, None, :] * expert_choice_ffn(h, w_router[l], w_gate_e[l], w_up_e[l], w_down_e[l])
        if need_ctx:
            xc = xc + cg1[:, None, :] * yc
            hc = modulate(rms_norm(xc, norm2_g[l]), csh2, csc2)
            xc = xc + cg2[:, None, :] * expert_choice_ffn(hc, w_router[l], w_gate_e[l], w_up_e[l], w_down_e[l])
    return rms_norm(x, final_g)
```

```cpp
#define MK_N_LAUNCHES 1
#include <hip/hip_runtime.h>
#include <hip/hip_bf16.h>
#include <cstdio>
#include <cstdint>
#include <cmath>
#include <cstring>

constexpr int DM = 1024, NBATCH = 8, SEQ = 2048, CTX = 256, DEPTH = 2;
constexpr int NLAT = NBATCH * SEQ, NCTX = NBATCH * CTX, NTOK = NLAT + NCTX;
constexpr int INW = 4608, NCOLT = 19, INW2 = NCOLT * 256;
constexpr int NE = 16, CAPL = 256, CAPC = 32, RPE = NBATCH * (CAPL + CAPC);
constexpr float EPS = 1e-6f;
constexpr float QSCALE = 0.125f * 1.4426950408889634f;
constexpr float LOG2E = 1.4426950408889634f;
namespace pg8 {
#define PG8_LAS __attribute__((address_space(3)))
typedef unsigned short bf16_t;
typedef short bf16x8 __attribute__((ext_vector_type(8)));
typedef float f32x4 __attribute__((ext_vector_type(4)));
typedef unsigned u32x4 __attribute__((ext_vector_type(4)));
typedef unsigned u32x2 __attribute__((ext_vector_type(2)));
constexpr int BM = 256, BK = 64, HALF = 128, HTB = HALF * BK * 2  , STAGE_BYTES = 8 * HTB;

__host__ __device__ __forceinline__ int lds_byte(int r, int c) { const int st = (r >> 4) * 2 + (c >> 5), rr = r & 15, cc = c & 31, ob = rr * 64 + cc * 2; return st * 1024 + (ob ^ (((ob >> 9) & 1) << 5)); }
__host__ __device__ __forceinline__ void stage_rc(int b, int& R, int& C) { const int st = b / 1024, sb = b % 1024, swz = sb ^ (((sb >> 9) & 1) << 5); R = (st >> 1) * 16 + swz / 64; C = (st & 1) * 32 + (swz % 64) / 2; }

struct Unit { const char* A; const char* B; const int* arows; int ldA, ldB, nt; int pm, pn, tag; };

__device__ __forceinline__ unsigned cvt_pk_bf16(float lo, float hi) { unsigned r; asm volatile("v_cvt_pk_bf16_f32 %0, %1, %2" : "=v"(r) : "v"(lo), "v"(hi)); return r; }

template <class Epi, class Sched>
__device__ __forceinline__ void gemm_phase(PG8_LAS unsigned char* lds, PG8_LAS int* idxbuf  , const Sched& S, const Epi& E) {
    int tid = threadIdx.x; asm volatile("" : "+v"(tid));
    const int wid = __builtin_amdgcn_readfirstlane(tid >> 6), lane = tid & 63, wr = wid >> 2, wc = wid & 3, fr = lane & 15, fq = lane >> 4;
    unsigned Rr[2], Cc2[2];
#pragma unroll
    for (int i = 0; i < 2; ++i) { int R, C; stage_rc(tid * 16 + i * 8192, R, C); Rr[i] = (unsigned)R; Cc2[i] = (unsigned)C * 2u; }
    const size_t kstep = (size_t)(BK * 2);
    const unsigned ldsw = (unsigned)wid * 1024u;
    const int aoff = lds_byte(wr * 64 + fr, fq * 8), boff = lds_byte(wc * 32 + fr, fq * 8);
#define PG8_SA(b, h) (((b) * 2 + (h)) * HTB)
#define PG8_SB(b, h) ((4 + (b) * 2 + (h)) * HTB)
#define PG8_STAGE(bufoff, gbase, ld) do { _Pragma("unroll") for (int _i = 0; _i < 2; ++_i) \
        __builtin_amdgcn_global_load_lds((const unsigned*)((const char*)(gbase) + (Rr[_i] * (unsigned)(ld) + Cc2[_i])), (PG8_LAS unsigned*)(lds + (bufoff) + ldsw + _i * 8192), 16, 0, 0); } while (0)
#define PG8_STAGE_A(bufoff, gbase, ao) do { _Pragma("unroll") for (int _i = 0; _i < 2; ++_i) \
        __builtin_amdgcn_global_load_lds((const unsigned*)((const char*)(gbase) + (ao)[_i]), (PG8_LAS unsigned*)(lds + (bufoff) + ldsw + _i * 8192), 16, 0, 0); } while (0)
#define PG8_AOFF(u, ao) do { _Pragma("unroll") for (int _h = 0; _h < 2; ++_h) _Pragma("unroll") for (int _i = 0; _i < 2; ++_i) { \
        const unsigned _row = (u).arows ? (unsigned)idxbuf[Rr[_i] + 128 * _h] : Rr[_i] + 128u * _h; (ao)[_h][_i] = _row * (unsigned)(u).ldA + Cc2[_i]; } } while (0)
#define PG8_STAGE_IDX(u) do { if ((u).arows) __builtin_amdgcn_global_load_lds((const unsigned*)((u).arows + (wid & 3) * 64 + lane), (PG8_LAS unsigned*)((PG8_LAS unsigned char*)idxbuf + (wid & 3) * 256), 4, 0, 0); } while (0)
#define PG8_LDA(dst, b, h) do { _Pragma("unroll") for (int m = 0; m < 4; ++m) _Pragma("unroll") for (int k = 0; k < 2; ++k) dst[m][k] = *(const PG8_LAS bf16x8*)(lds + PG8_SA(b, h) + aoff + m * 2048 + k * 1024); } while (0)
#define PG8_LDB(dst, b, h) do { _Pragma("unroll") for (int n = 0; n < 2; ++n) _Pragma("unroll") for (int k = 0; k < 2; ++k) dst[n][k] = *(const PG8_LAS bf16x8*)(lds + PG8_SB(b, h) + boff + n * 2048 + k * 1024); } while (0)
#define PG8_MMA(ai, bj, At, Bt) do { __builtin_amdgcn_s_setprio(1); _Pragma("unroll") for (int m = 0; m < 4; ++m) _Pragma("unroll") for (int n = 0; n < 2; ++n) _Pragma("unroll") for (int k = 0; k < 2; ++k) \
        acc[ai][bj][m][n] = __builtin_amdgcn_mfma_f32_16x16x32_bf16(Bt[n][k], At[m][k], acc[ai][bj][m][n], 0, 0, 0); __builtin_amdgcn_s_setprio(0); } while (0)
#define PG8_WAIT_V(n) asm volatile("s_waitcnt vmcnt(" #n ")" ::: "memory")
#define PG8_WAIT_L(n) asm volatile("s_waitcnt lgkmcnt(" #n ")" ::: "memory")
#define PG8_BAR __builtin_amdgcn_s_barrier()
#define PG8_SCHED __builtin_amdgcn_sched_barrier(0)
    Unit cur, nxt; int ui = 0;
    if (!S.next(0, cur)) return;
    nxt = cur;
    f32x4 acc[2][2][4][2];
#pragma unroll
    for (int a = 0; a < 2; ++a)
#pragma unroll
        for (int b = 0; b < 2; ++b)
#pragma unroll
            for (int m = 0; m < 4; ++m)
#pragma unroll
                for (int n = 0; n < 2; ++n) acc[a][b][m][n] = (f32x4){0.f, 0.f, 0.f, 0.f};
    bf16x8 At[4][2], B0[2][2], B1[2][2];
    const char* cA = cur.A; const char* cB = cur.B; int clb = cur.ldB;
    unsigned ao_c[2][2], ao_n[2][2];
    if (cur.arows) { PG8_STAGE_IDX(cur); PG8_WAIT_V(0); PG8_BAR; }
    PG8_AOFF(cur, ao_c);
#pragma unroll
    for (int _h = 0; _h < 2; ++_h)
#pragma unroll
        for (int _i = 0; _i < 2; ++_i) ao_n[_h][_i] = ao_c[_h][_i];
    if (cur.arows) { PG8_WAIT_L(0); PG8_BAR; }
    {
        const size_t hB = (size_t)HALF * clb;
        PG8_STAGE(PG8_SB(0, 0), cB, clb); PG8_STAGE(PG8_SB(0, 1), cB + hB, clb); PG8_STAGE_A(PG8_SA(0, 0), cA, ao_c[0]); PG8_STAGE_A(PG8_SA(0, 1), cA, ao_c[1]);
        if (wr == 1) PG8_BAR;
        PG8_WAIT_V(2); PG8_BAR;
        PG8_STAGE(PG8_SB(1, 0), cB + kstep, clb); PG8_STAGE_A(PG8_SA(1, 0), cA + kstep, ao_c[0]); PG8_STAGE(PG8_SB(1, 1), cB + hB + kstep, clb);
        PG8_WAIT_V(6); PG8_BAR;
    }
    for (;;) {
        const bool has_next = S.next(ui + 1, nxt);
        const char* nA = has_next ? nxt.A : cA; const char* nB = has_next ? nxt.B : cB; const int nlb = has_next ? nxt.ldB : clb;
        const int nt = cur.nt;
        if (has_next) PG8_STAGE_IDX(nxt);
        for (int t = 0; t < nt; t += 2) {
            const bool last = (t == nt - 2);
            if (last) { if (has_next) { PG8_AOFF(nxt, ao_n); } else {
#pragma unroll
                for (int _h = 0; _h < 2; ++_h)
#pragma unroll
                    for (int _i = 0; _i < 2; ++_i) ao_n[_h][_i] = ao_c[_h][_i]; } }
            unsigned ao2[2][2];
#pragma unroll
            for (int _h = 0; _h < 2; ++_h)
#pragma unroll
                for (int _i = 0; _i < 2; ++_i) ao2[_h][_i] = last ? ao_n[_h][_i] : ao_c[_h][_i];
            const char* a1 = cA + (size_t)(t + 1) * kstep;
            const char* a2 = last ? nA : cA + (size_t)(t + 2) * kstep; const char* b2 = last ? nB : cB + (size_t)(t + 2) * kstep;
            const int lb2 = last ? nlb : clb;
            const size_t hB2 = (size_t)HALF * lb2;
            const char* a3 = a2 + kstep; const char* b3 = b2 + kstep;
            PG8_LDB(B0, 0, 0); PG8_LDB(B1, 0, 1); PG8_SCHED; PG8_LDA(At, 0, 0); PG8_STAGE_A(PG8_SA(1, 1), a1, ao_c[1]);
            PG8_WAIT_V(8); PG8_WAIT_L(0); PG8_BAR; PG8_MMA(0, 0, At, B0); PG8_MMA(0, 1, At, B1); PG8_BAR; PG8_SCHED;
            PG8_LDA(At, 0, 1); PG8_STAGE(PG8_SB(0, 0), b2, lb2); PG8_STAGE(PG8_SB(0, 1), b2 + hB2, lb2); PG8_STAGE_A(PG8_SA(0, 0), a2, ao2[0]);
            PG8_WAIT_V(8); PG8_WAIT_L(0); PG8_BAR; PG8_MMA(1, 0, At, B0); PG8_MMA(1, 1, At, B1); PG8_BAR; PG8_SCHED;
            PG8_LDB(B0, 1, 0); PG8_LDB(B1, 1, 1); PG8_SCHED; PG8_LDA(At, 1, 0); PG8_STAGE_A(PG8_SA(0, 1), a2, ao2[1]);
            PG8_WAIT_V(8); PG8_WAIT_L(0); PG8_BAR; PG8_MMA(0, 0, At, B0); PG8_MMA(0, 1, At, B1); PG8_BAR; PG8_SCHED;
            PG8_LDA(At, 1, 1); PG8_STAGE(PG8_SB(1, 0), b3, lb2); PG8_STAGE(PG8_SB(1, 1), b3 + hB2, lb2); PG8_STAGE_A(PG8_SA(1, 0), a3, ao2[0]);
            PG8_WAIT_V(8); PG8_WAIT_L(0); PG8_BAR; PG8_MMA(1, 0, At, B0); PG8_MMA(1, 1, At, B1); PG8_BAR; PG8_SCHED;
        }
        if (wr == 0) PG8_BAR;
        bool keep_acc;
        { Unit eu = cur; int ewr = wr, ewc = wc, efr = fr, efq = fq; asm volatile("" : "+s"(eu.pm), "+s"(eu.pn), "+s"(eu.tag), "+s"(ewr), "+s"(ewc), "+v"(efr), "+v"(efq));
          keep_acc = E(acc, eu, ewr, ewc, efr, efq); }
        if (!has_next) break;
        if (!keep_acc) {
#pragma unroll
        for (int a = 0; a < 2; ++a)
#pragma unroll
            for (int b = 0; b < 2; ++b)
#pragma unroll
                for (int m = 0; m < 4; ++m)
#pragma unroll
                    for (int n = 0; n < 2; ++n) acc[a][b][m][n] = (f32x4){0.f, 0.f, 0.f, 0.f};
        }
        cur = nxt; cA = nA; cB = nB; clb = nlb; ++ui;
#pragma unroll
        for (int _h = 0; _h < 2; ++_h)
#pragma unroll
            for (int _i = 0; _i < 2; ++_i) ao_c[_h][_i] = ao_n[_h][_i];
        if (wr == 1) PG8_BAR;
    }
    PG8_WAIT_V(0);
    PG8_BAR;
#undef PG8_SA
#undef PG8_SB
#undef PG8_STAGE
#undef PG8_STAGE_A
#undef PG8_AOFF
#undef PG8_STAGE_IDX
#undef PG8_LDA
#undef PG8_LDB
#undef PG8_MMA
#undef PG8_WAIT_V
#undef PG8_WAIT_L
#undef PG8_BAR
#undef PG8_SCHED
}
}
#include <hip/hip_bf16.h>
#include <cmath>
namespace attn_body {
using bf16=__hip_bfloat16;
using bf16x8=__attribute__((ext_vector_type(8)))short;
using s16x4=__attribute__((ext_vector_type(4)))short;
using f32x16=__attribute__((ext_vector_type(16)))float;
using u32x4=__attribute__((ext_vector_type(4)))unsigned;
constexpr int D=64;
constexpr int NW=8,QBLK=32,KVBLK=64,NCT=4;
__device__ __forceinline__ int crow(int r,int hi){return (r&3)+8*(r>>2)+4*hi;}
#define SBAR() __builtin_amdgcn_sched_barrier(0)
__device__ __forceinline__ void wmask(f32x16&p0,f32x16&p1,int kb,int qabs,int hi){
  const float NEG=-INFINITY; const int d0=kb+4*hi-qabs;
  #pragma unroll
  for(int r=0;r<16;++r){int dd=d0+(r&3)+8*(r>>2); if(dd>128||dd<-128)p0[r]=NEG; if(dd+32>128||dd+32<-128)p1[r]=NEG;}
}

constexpr int NSLOT=3, SLOTB=8192;
constexpr int LDS_K=0, LDS_V=NSLOT*SLOTB, LDS_WS=2*NSLOT*SLOTB, LDS_OST=LDS_WS+NW*64*4, LDS_BYTES=LDS_OST+NW*4096;
__device__ __forceinline__ void glds16(const void*gsrc,unsigned lds_dst){unsigned keep;
  asm volatile("s_mov_b32 %0, m0\n\ts_mov_b32 m0, %2\n\ts_nop 0\n\tglobal_load_lds_dwordx4 %1, off\n\ts_mov_b32 m0, %0":"=&s"(keep):"v"(gsrc),"s"(lds_dst):"memory");}
__device__ __forceinline__ float max3f(float a,float b,float c){float r;asm("v_max3_f32 %0, %1, %2, %3":"=v"(r):"v"(a),"v"(b),"v"(c));return r;}
__device__ __forceinline__ float max2f(float a,float b){float r;asm("v_max_f32_e32 %0, %1, %2":"=v"(r):"v"(a),"v"(b));return r;}
__device__ __forceinline__ float fadd_s(float a,float b){float r;asm("v_add_f32_e32 %0, %1, %2":"=v"(r):"v"(a),"v"(b));return r;}
__device__ __forceinline__ float fsub_s(float a,float b){float r;asm("v_sub_f32_e32 %0, %1, %2":"=v"(r):"v"(a),"v"(b));return r;}
typedef float f32x2_t __attribute__((ext_vector_type(2))); typedef __bf16 bf16x2_t __attribute__((ext_vector_type(2)));
__device__ __forceinline__ unsigned cvtpk_s(float lo,float hi){f32x2_t v={lo,hi};bf16x2_t b=__builtin_convertvector(v,bf16x2_t);return __builtin_bit_cast(unsigned,b);}
#define WAIT_BAR(N) asm volatile("s_waitcnt vmcnt(" #N ") lgkmcnt(0)\n\ts_barrier":::"memory")

__device__ __forceinline__ void qkt(f32x16&p0,f32x16&p1,const char*Kslot,const bf16x8*qr,const f32x16&negm,int r32,int hi){
  const char*kb=Kslot+hi*1024+r32*16;
  #pragma unroll
  for(int d0=0;d0<4;++d0){
    const bf16x8 b0=*reinterpret_cast<const bf16x8*>(kb+d0*2048);
    const bf16x8 b1=*reinterpret_cast<const bf16x8*>(kb+d0*2048+512);
    if(d0==0){p0=__builtin_amdgcn_mfma_f32_32x32x16_bf16(b0,qr[0],negm,0,0,0);p1=__builtin_amdgcn_mfma_f32_32x32x16_bf16(b1,qr[0],negm,0,0,0);}
    else{p0=__builtin_amdgcn_mfma_f32_32x32x16_bf16(b0,qr[d0],p0,0,0,0);p1=__builtin_amdgcn_mfma_f32_32x32x16_bf16(b1,qr[d0],p1,0,0,0);}}
}
typedef __attribute__((address_space(3))) const char* lds_cptr;
typedef short v4i16_t __attribute__((ext_vector_type(4)));
__device__ __forceinline__ void kload8(bf16x8*kf,lds_cptr kp){
  kf[0]=*(const __attribute__((address_space(3))) bf16x8*)(kp);      kf[1]=*(const __attribute__((address_space(3))) bf16x8*)(kp+512);
  kf[2]=*(const __attribute__((address_space(3))) bf16x8*)(kp+2048); kf[3]=*(const __attribute__((address_space(3))) bf16x8*)(kp+2560);
  kf[4]=*(const __attribute__((address_space(3))) bf16x8*)(kp+4096); kf[5]=*(const __attribute__((address_space(3))) bf16x8*)(kp+4608);
  kf[6]=*(const __attribute__((address_space(3))) bf16x8*)(kp+6144); kf[7]=*(const __attribute__((address_space(3))) bf16x8*)(kp+6656);
}
__device__ __forceinline__ void kload2(bf16x8*kf,lds_cptr kp,int j){ kf[2*j]=*(const __attribute__((address_space(3))) bf16x8*)(kp+j*2048); kf[2*j+1]=*(const __attribute__((address_space(3))) bf16x8*)(kp+j*2048+512); }
__device__ __forceinline__ s16x4 vtr(lds_cptr p){ return __builtin_bit_cast(s16x4,__builtin_amdgcn_ds_read_tr16_b64_v4i16((__attribute__((address_space(3))) v4i16_t*)p)); }
__device__ __forceinline__ float rowmax(const f32x16&p0,const f32x16&p1){
  float a=max3f(p0[0],p0[1],p1[0]),b=max3f(p0[2],p0[3],p1[1]);a=max3f(a,p1[2],p1[3]);
  #pragma unroll
  for(int r=4;r<16;r+=4){a=max3f(a,p0[r],p0[r+1]);b=max3f(b,p0[r+2],p0[r+3]);a=max3f(a,p1[r],p1[r+1]);b=max3f(b,p1[r+2],p1[r+3]);}
  const float m=max2f(a,b);
  auto rr=__builtin_amdgcn_permlane32_swap(__float_as_uint(m),__float_as_uint(m),false,false);
  return max2f(__uint_as_float(rr[0]),__uint_as_float(rr[1]));
}
__device__ __forceinline__ void pv(f32x16*o,int vb,bf16x8 pa0,bf16x8 pa1,bf16x8 pa2,bf16x8 pa3){
  #pragma unroll
  for(int d0=0;d0<2;++d0){s16x4 lo[4],hi[4];
    #pragma unroll
    for(int ks=0;ks<4;++ks){
      asm volatile("ds_read_b64_tr_b16 %0,%1 offset:%c2":"=&v"(lo[ks]):"v"(vb),"i"(d0*4096+ks*1024):"memory");
      asm volatile("ds_read_b64_tr_b16 %0,%1 offset:%c2":"=&v"(hi[ks]):"v"(vb),"i"(d0*4096+ks*1024+512):"memory");}
    asm volatile("s_waitcnt lgkmcnt(0)":::"memory");SBAR();
    #define PK(k) (bf16x8){lo[k][0],lo[k][1],lo[k][2],lo[k][3],hi[k][0],hi[k][1],hi[k][2],hi[k][3]}
    o[d0]=__builtin_amdgcn_mfma_f32_32x32x16_bf16(pa0,PK(0),o[d0],0,0,0);
    o[d0]=__builtin_amdgcn_mfma_f32_32x32x16_bf16(pa1,PK(1),o[d0],0,0,0);
    o[d0]=__builtin_amdgcn_mfma_f32_32x32x16_bf16(pa2,PK(2),o[d0],0,0,0);
    o[d0]=__builtin_amdgcn_mfma_f32_32x32x16_bf16(pa3,PK(3),o[d0],0,0,0);
    #undef PK
  }
}

#ifndef ATTN_STORE16
#define ATTN_STORE16(p,v) (*(u32x4*)(p)=(v))
#endif
template<int MODE,int THRL> __device__ __forceinline__ void attn_unit(const bf16*Qw,int qp,const bf16*Kc,const bf16*Kl,const bf16*Vc,const bf16*Vl,int kp,int NT,int qabs,int band0,float sinkl2,bf16*Ow,int op,char*shm){
  int tid=threadIdx.x; asm volatile("":"+v"(tid));
  const int lane=tid&63,r32=lane&31,hi=lane>>5; const int wid=__builtin_amdgcn_readfirstlane(tid>>6);
  qabs+=r32;
  const unsigned lds0=(unsigned)(uintptr_t)shm;
  float*wsf=(float*)(shm+LDS_WS)+wid*64;
  const unsigned koff_=(unsigned)(lane*kp+wid*8)*2u;
  const unsigned voff_=(unsigned)((16*(wid&3)+(lane>>2))*kp+(wid>>2)*32+(lane&3)*8)*2u;
  const unsigned kdst=lds0+LDS_K+wid*1024, vdst=lds0+LDS_V+wid*1024;
  #define DMA_K(t,slot) glds16((const char*)((t)<NCT?Kc+(long)(t)*KVBLK*kp:Kl+(long)((t)-NCT)*KVBLK*kp)+koff_,(unsigned)__builtin_amdgcn_readfirstlane(kdst+(slot)))
  #define DMA_V(t,slot) glds16((const char*)((t)<NCT?Vc+(long)(t)*KVBLK*kp:Vl+(long)((t)-NCT)*KVBLK*kp)+voff_,(unsigned)__builtin_amdgcn_readfirstlane(vdst+(slot)))
  const int vb0=(int)(lds0+LDS_V)+((lane>>4)&1)*32+(lane&3)*8+(4*hi+((lane&15)>>2))*64;
  const char*Kbase=shm+LDS_K; bf16x8 kf[8];
  const lds_cptr shm3=(lds_cptr)shm; const lds_cptr kp0=shm3+LDS_K+hi*1024+r32*16; const lds_cptr vp0=shm3+LDS_V+((lane>>4)&1)*32+(lane&3)*8+(4*hi+((lane&15)>>2))*64;
  DMA_K(0,0);DMA_V(0,0);DMA_K(1,SLOTB);
  bf16x8 qr[4];
  #pragma unroll
  for(int d0=0;d0<4;++d0)qr[d0]=*reinterpret_cast<const bf16x8*>(&Qw[(long)r32*qp+d0*16+hi*8]);
  float mhat=0.f,l_reg=0.f;f32x16 o[2];o[0]=f32x16{};o[1]=f32x16{};f32x16 negm=f32x16{};asm volatile("":"+v"(negm));
  #define CMASK(P0,P1,t) do{ if(MODE==1){ if((t)>=NCT)wmask(P0,P1,band0+KVBLK*((t)-NCT),qabs,hi);} }while(0)
  bool resc=false;
  #define START(P0,P1) do{ const float rm=rowmax(P0,P1); resc=false; \
    { const float dl=rm; mhat=fadd_s(mhat,dl); \
      _Pragma("unroll") for(int r=0;r<16;++r){P0[r]=fsub_s(P0[r],dl);P1[r]=fsub_s(P1[r],dl);} \
      _Pragma("unroll") for(int r=0;r<16;++r)negm[r]=-mhat; asm volatile("":"+v"(negm)); } \
    _Pragma("unroll") for(int r=0;r<16;++r)P0[r]=__builtin_amdgcn_exp2f(P0[r]); }while(0)
  #define RESC() do{ if(resc){ asm volatile("s_waitcnt lgkmcnt(0)":::"memory"); \
      _Pragma("unroll") for(int d_=0;d_<2;++d_) _Pragma("unroll") for(int r=0;r<16;++r)o[d_][r]*=wsf[crow(r,hi)]; } }while(0)
  f32x16 pA0,pA1,pB0,pB1;
  int sl_prev=0,sl_cur=0,sl_next=SLOTB;
  #define ROT() do{sl_prev=sl_cur;sl_cur=sl_next;sl_next=(sl_next==(NSLOT-1)*SLOTB)?0:sl_next+SLOTB;}while(0)
  DMA_K(2,2*SLOTB);
  WAIT_BAR(3);
  qkt(pA0,pA1,Kbase,qr,negm,r32,hi);asm volatile("s_nop 15\n\ts_nop 7":"+v"(pA0),"+v"(pA1));CMASK(pA0,pA1,0);
  START(pA0,pA1);
  _Pragma("unroll") for(int r=0;r<16;++r)pA1[r]=__builtin_amdgcn_exp2f(pA1[r]);
  WAIT_BAR(0);
  DMA_K(3,0);DMA_V(1,SLOTB);
  ROT();
  kload8(kf,kp0+sl_cur);
  WAIT_BAR(2);
  s16x4 vlo[8],vhi[8]; u32x4 pw0,pw1,pw2,pw3;
  #define PKW(P,B) cvtpk_s(P[B],P[B+1])
  #define PAF(k) __builtin_bit_cast(bf16x8,pw##k)
  #define VFR(i) (bf16x8){vlo[i][0],vlo[i][1],vlo[i][2],vlo[i][3],vhi[i][0],vhi[i][1],vhi[i][2],vhi[i][3]}
  #define PIN(x) asm volatile("":"+v"(x))
  #define MX3(a,b,c) __builtin_fmaxf(__builtin_fmaxf((a),(b)),(c))
  #define GAPA(MF,A0,A1,A2,A3,W0,W1,PW) do{ MF; sacc+=A0; sacc+=A1; sacc+=A2; sacc+=A3; PIN(sacc); W0; W1; PIN(PW); SBAR(); }while(0)
  #define EX(v) __builtin_amdgcn_exp2f(v)
  #define GAPB(MF,X,B) do{ MF; X[B]=EX(X[B]); X[B+1]=EX(X[B+1]); X[B+2]=EX(X[B+2]); X[B+3]=EX(X[B+3]); PIN(X); SBAR(); }while(0)
  #define VRD(i) do{ vlo[i]=vtr(vp_+(((i)>>2)*4096+((i)&3)*1024)); vhi[i]=vtr(vp_+(((i)>>2)*4096+((i)&3)*1024+512)); }while(0)
  #define KRD(G,j) do{ if(G){ kload2(kf,kp0+sl_next,j); SBAR(); } }while(0)
  #define STEP(C0,C1,P0,P1,t,GK,GV,GL) do{ SBAR(); \
    const lds_cptr vp_=vp0+sl_prev; \
    VRD(0); SBAR(); float sacc=(P0[0]+P0[1]); \
    GAPA(C0=__builtin_amdgcn_mfma_f32_32x32x16_bf16(kf[0],qr[0],negm,0,0,0), P0[2],P0[3],P0[4],P0[5],     pw0[0]=PKW(P0,0), pw0[1]=PKW(P0,2), pw0); \
    VRD(4); SBAR(); GAPA(C1=__builtin_amdgcn_mfma_f32_32x32x16_bf16(kf[1],qr[0],negm,0,0,0), P0[6],P0[7],P0[8],P0[9],     pw0[2]=PKW(P0,4), pw0[3]=PKW(P0,6), pw0); \
    VRD(1); SBAR(); GAPA(C0=__builtin_amdgcn_mfma_f32_32x32x16_bf16(kf[2],qr[1],C0,0,0,0),   P0[10],P0[11],P0[12],P0[13], pw1[0]=PKW(P0,8), pw1[1]=PKW(P0,10), pw1); \
    VRD(5); SBAR(); GAPA(C1=__builtin_amdgcn_mfma_f32_32x32x16_bf16(kf[3],qr[1],C1,0,0,0),   P0[14],P0[15],P1[0],P1[1],   pw1[2]=PKW(P0,12),pw1[3]=PKW(P0,14), pw1); \
    VRD(2); SBAR(); GAPA(C0=__builtin_amdgcn_mfma_f32_32x32x16_bf16(kf[4],qr[2],C0,0,0,0),   P1[2],P1[3],P1[4],P1[5],     pw2[0]=PKW(P1,0), pw2[1]=PKW(P1,2), pw2); \
    VRD(6); SBAR(); GAPA(C1=__builtin_amdgcn_mfma_f32_32x32x16_bf16(kf[5],qr[2],C1,0,0,0),   P1[6],P1[7],P1[8],P1[9],     pw2[2]=PKW(P1,4), pw2[3]=PKW(P1,6), pw2); \
    VRD(3); SBAR(); GAPA(C0=__builtin_amdgcn_mfma_f32_32x32x16_bf16(kf[6],qr[3],C0,0,0,0),   P1[10],P1[11],P1[12],P1[13], pw3[0]=PKW(P1,8), pw3[1]=PKW(P1,10), pw3); \
    VRD(7); SBAR(); GAPA(C1=__builtin_amdgcn_mfma_f32_32x32x16_bf16(kf[7],qr[3],C1,0,0,0),   P1[14],P1[15],0.f,0.f,       pw3[2]=PKW(P1,12),pw3[3]=PKW(P1,14), pw3); \
    l_reg+=sacc; \
    if(GK){DMA_K((t)+3,sl_cur);} if(GV){DMA_V((t)+1,sl_next);} \
    CMASK(C0,C1,t); \
    { float a=MX3(C0[0],C0[1],C1[0]),b=MX3(C0[2],C0[3],C1[1]); a=MX3(a,C1[2],C1[3]); \
      _Pragma("unroll") for(int r=4;r<16;r+=4){a=MX3(a,C0[r],C0[r+1]);b=MX3(b,C0[r+2],C0[r+3]);a=MX3(a,C1[r],C1[r+1]);b=MX3(b,C1[r+2],C1[r+3]);} \
      float rm=__builtin_fmaxf(a,b); { auto rr=__builtin_amdgcn_permlane32_swap(__float_as_uint(rm),__float_as_uint(rm),false,false); rm=__builtin_fmaxf(__uint_as_float(rr[0]),__uint_as_float(rr[1])); } \
      resc=false; \
      if(__builtin_expect(__any(rm>(float)THRL),0)){ const float dl=__builtin_fmaxf(rm,0.f); mhat+=dl; \
        _Pragma("unroll") for(int r=0;r<16;++r){C0[r]-=dl;C1[r]-=dl;} \
        _Pragma("unroll") for(int r=0;r<16;++r)negm[r]=-mhat; asm volatile("":"+v"(negm)); \
        const float f=__builtin_amdgcn_exp2f(-dl); l_reg*=f; if(hi==0)wsf[r32]=f; resc=true; } } \
    SBAR(); \
    GAPB(o[0]=__builtin_amdgcn_mfma_f32_32x32x16_bf16(PAF(0),VFR(0),o[0],0,0,0), C0,0); \
    GAPB(o[1]=__builtin_amdgcn_mfma_f32_32x32x16_bf16(PAF(0),VFR(4),o[1],0,0,0), C0,4); \
    KRD(GL,0); GAPB(o[0]=__builtin_amdgcn_mfma_f32_32x32x16_bf16(PAF(1),VFR(1),o[0],0,0,0), C0,8); \
    KRD(GL,1); GAPB(o[1]=__builtin_amdgcn_mfma_f32_32x32x16_bf16(PAF(1),VFR(5),o[1],0,0,0), C0,12); \
    KRD(GL,2); GAPB(o[0]=__builtin_amdgcn_mfma_f32_32x32x16_bf16(PAF(2),VFR(2),o[0],0,0,0), C1,0); \
    KRD(GL,3); GAPB(o[1]=__builtin_amdgcn_mfma_f32_32x32x16_bf16(PAF(2),VFR(6),o[1],0,0,0), C1,4); \
    GAPB(o[0]=__builtin_amdgcn_mfma_f32_32x32x16_bf16(PAF(3),VFR(3),o[0],0,0,0), C1,8); \
    GAPB(o[1]=__builtin_amdgcn_mfma_f32_32x32x16_bf16(PAF(3),VFR(7),o[1],0,0,0), C1,12); \
    }while(0)
  int t=1;
  for(;t+5<NT;t+=2){
    STEP(pB0,pB1,pA0,pA1,t,true,true,true);     WAIT_BAR(2); RESC(); ROT();
    STEP(pA0,pA1,pB0,pB1,t+1,true,true,true);   WAIT_BAR(2); RESC(); ROT();
  }
  #define ENDW(tt) do{ if((tt)+3<NT){WAIT_BAR(2);} else if((tt)+2<NT){WAIT_BAR(1);} else {WAIT_BAR(0);} }while(0)
  for(;t+1<NT;t+=2){
    STEP(pB0,pB1,pA0,pA1,t,(t+3<NT),(t+1<NT),(t+1<NT));       ENDW(t);   RESC(); ROT();
    STEP(pA0,pA1,pB0,pB1,t+1,(t+4<NT),(t+2<NT),(t+2<NT));     ENDW(t+1); RESC(); ROT();
  }
  STEP(pB0,pB1,pA0,pA1,NT-1,false,false,false); RESC();
  { float sacc=pB0[0]+pB0[1]; _Pragma("unroll") for(int r=2;r<16;++r)sacc+=pB0[r]; _Pragma("unroll") for(int r=0;r<16;++r)sacc+=pB1[r]; l_reg+=sacc;
    pw0=(u32x4){PKW(pB0,0),PKW(pB0,2),PKW(pB0,4),PKW(pB0,6)};pw1=(u32x4){PKW(pB0,8),PKW(pB0,10),PKW(pB0,12),PKW(pB0,14)};pw2=(u32x4){PKW(pB1,0),PKW(pB1,2),PKW(pB1,4),PKW(pB1,6)};pw3=(u32x4){PKW(pB1,8),PKW(pB1,10),PKW(pB1,12),PKW(pB1,14)};
    SBAR(); pv(o,vb0+sl_cur,PAF(0),PAF(1),PAF(2),PAF(3)); }
  #undef PKW
  #undef PAF
  #undef VFR
  #undef PIN
  #undef MX3
  #undef GAPA
  #undef GAPB
  #undef EX
  #undef VRD
  #undef KRD
  #undef STEP
  #undef ENDW
  {auto rr=__builtin_amdgcn_permlane32_swap(__float_as_uint(l_reg),__float_as_uint(l_reg),false,false);l_reg=__uint_as_float(rr[0])+__uint_as_float(rr[1]);}
  if(MODE==1)l_reg+=__builtin_amdgcn_exp2f(sinkl2-mhat);
  if(hi==0)wsf[32+r32]=l_reg;asm volatile("s_waitcnt lgkmcnt(0)":::"memory");
  float rli[16];
  #pragma unroll
  for(int r=0;r<16;++r)rli[r]=__builtin_amdgcn_rcpf(wsf[32+crow(r,hi)]);
  { bf16*stg=(bf16*)(shm+LDS_OST)+wid*2048;
    #pragma unroll
    for(int r=0;r<16;++r){const int orow=crow(r,hi);
      #pragma unroll
      for(int d0=0;d0<2;++d0)stg[orow*64+d0*32+r32]=__float2bfloat16(o[d0][r]*rli[r]);}
    asm volatile("s_waitcnt lgkmcnt(0)":::"memory");
    #pragma unroll
    for(int i=0;i<4;++i){const int row=i*8+(lane>>3),ch=lane&7; const u32x4 v=*(const u32x4*)(stg+row*64+ch*8); ATTN_STORE16(Ow+(long)row*op+ch*8,v);} }
  asm volatile("s_waitcnt lgkmcnt(0)\n\ts_barrier":::"memory");
  #undef DMA_K
  #undef DMA_V
  #undef CMASK
  #undef START
  #undef RESC
  #undef ROT
}
constexpr int ATTN_LDS_BYTES=LDS_BYTES;
#undef SBAR
#undef WAIT_BAR
}
constexpr int NWAVES = 8;
constexpr size_t MiB = 1u << 20;
constexpr size_t WS_CTL = 0, CTL_ZERO_BYTES = 256 * 1024;
constexpr size_t WS_MOD = 1 * MiB;
constexpr size_t WS_ROPE = WS_MOD + 512 * 1024;
constexpr size_t WS_AFS = WS_ROPE + 64 * 1024;
constexpr size_t WS_IDX = WS_AFS + 192 * 1024;
constexpr size_t WS_SEL = 2 * MiB;
constexpr size_t WS_AFF = 4 * MiB;
constexpr size_t WS_WIN = 8 * MiB;
constexpr size_t WS_WBR = 28 * MiB;
constexpr size_t WS_WOUT = 32 * MiB;
constexpr size_t WS_DFT = 36 * MiB;
constexpr size_t WS_DFTC = 52 * MiB;
constexpr size_t WS_WGU = 53 * MiB;
constexpr size_t WS_WD = 181 * MiB;
constexpr size_t WS_X = 245 * MiB;
constexpr size_t WS_HN = 317 * MiB;
constexpr size_t WS_QKV = 353 * MiB;
constexpr size_t WS_G = 398 * MiB;
constexpr size_t WS_BR = 506 * MiB;
constexpr size_t WS_HACT = 470 * MiB;
constexpr size_t WS_END = 542 * MiB;
constexpr size_t QKV_QG = 0, QKV_KG = (size_t)NTOK * 512 * 2, QKV_VG = QKV_KG + (size_t)NTOK * 128 * 2, QKV_QW = QKV_VG + (size_t)NTOK * 128 * 2,
                 QKV_KW = QKV_QW + (size_t)NTOK * 256 * 2, QKV_VW = QKV_KW + (size_t)NTOK * 128 * 2;
static_assert(WS_QKV + QKV_VW + (size_t)NTOK * 128 * 2 <= WS_G && WS_HN + (size_t)NTOK * DM * 4 <= WS_G && WS_G + (size_t)NTOK * 3 * DM * 2 <= WS_BR && WS_HACT >= WS_G + (size_t)NE * RPE * DM * 2 && WS_HACT + (size_t)NE * RPE * DM * 2 <= WS_END, "d_ws map");
constexpr size_t DO_MB = 0, DO_ABT = 36 * MiB, DO_ABTC = 52 * MiB;
constexpr int CW_BAR = 1024;
constexpr int CW_QUEUE = 8192;
constexpr int CW_CONVQ = 8192 + 64 * 8;
constexpr int CW_FIN = CW_CONVQ + 64;
constexpr int RING_BYTES = 131072;
constexpr int LDSCTL_OFF = RING_BYTES, MISC_OFF = LDSCTL_OFF + 320;
constexpr int IDXBUF_OFF = LDSCTL_OFF + 1024 + 8192;
constexpr int LDS_BYTES = 147456;

#define GAS __attribute__((address_space(1)))
#define LAS __attribute__((address_space(3)))
typedef unsigned short bf16;
typedef unsigned v4u __attribute__((ext_vector_type(4)));
typedef unsigned v2u __attribute__((ext_vector_type(2)));
typedef float f32x4 __attribute__((ext_vector_type(4)));
typedef GAS unsigned gu32;
#define RLX_AGENT __ATOMIC_RELAXED, __HIP_MEMORY_SCOPE_AGENT
#define LDS_WAIT() asm volatile("s_waitcnt lgkmcnt(0)" ::: "memory")
#define VM_WAIT() asm volatile("s_waitcnt vmcnt(0)" ::: "memory")
__device__ __forceinline__ unsigned f2bf(float f) { unsigned u = __builtin_bit_cast(unsigned, f); return (u + 0x7fffu + ((u >> 16) & 1u)) >> 16; }
__device__ __forceinline__ unsigned pk2(float lo, float hi) { return f2bf(lo) | (f2bf(hi) << 16); }
__device__ __forceinline__ float bf2f(unsigned short h) { return __builtin_bit_cast(float, (unsigned)h << 16); }
__device__ __forceinline__ float bflo(unsigned w) { return __builtin_bit_cast(float, w << 16); }
__device__ __forceinline__ float bfhi(unsigned w) { return __builtin_bit_cast(float, w & 0xffff0000u); }

#define XB_TMO      128
#define XB_XCNT(j)  (256  + 64 * (j))
#define XB_XSUB(j)  (1280 + 64 * (j))
#define XB_XGEN(j)  (2304 + 64 * (j))
#define XB_TOP      3328
#define XB_TOPGEN   3392
#define XCD_BAR_WORDS 3456
#define XB_SPIN_CAP (1u << 20)
__device__ __forceinline__ unsigned xb_ld(unsigned* p)              { return __hip_atomic_load(p, __ATOMIC_RELAXED, __HIP_MEMORY_SCOPE_AGENT); }
__device__ __forceinline__ unsigned xb_add(unsigned* p, unsigned v) { return __hip_atomic_fetch_add(p, v, __ATOMIC_RELAXED, __HIP_MEMORY_SCOPE_AGENT); }
__device__ __forceinline__ unsigned xb_xcc_id() { return (unsigned)__builtin_amdgcn_s_getreg((3 << 11) | 20) & 0xFu; }
#define XB_SPIN(cond, bar) do { unsigned _sp = 0; while (cond) { __builtin_amdgcn_s_sleep(1); \
    if ((++_sp & 255u) == 0u) { if (xb_ld(&(bar)[XB_TMO])) break; if (_sp > XB_SPIN_CAP) { atomicAdd(&(bar)[XB_TMO], 1u); break; } } } } while (0)
struct XcdBarrier { unsigned* bar; unsigned x; volatile LAS unsigned* st; };
__device__ __forceinline__ XcdBarrier xcd_barrier_post(unsigned* bar, volatile LAS unsigned* st) {
    XcdBarrier b; b.bar = bar; b.x = xb_xcc_id(); b.st = st;
    if (threadIdx.x == 0) (void)xb_add(&bar[XB_XCNT(b.x)], 1u);
    return b;
}
__device__ __forceinline__ void xcd_barrier_complete(unsigned* bar, unsigned x, unsigned& nloc, unsigned& nx) {
    const unsigned G = gridDim.x * gridDim.y * gridDim.z;
    unsigned sum, cnt, mine, sp = 0u;
    for (;;) {
        sum = 0u; cnt = 0u; mine = 0u;
#pragma unroll
        for (unsigned j = 0; j < 16; ++j) { const unsigned c = xb_ld(&bar[XB_XCNT(j)]); sum += c; cnt += (c > 0u) ? 1u : 0u; mine = (j == x) ? c : mine; }
        if (sum == G) break;
        __builtin_amdgcn_s_sleep(1);
        if ((++sp & 255u) == 0u) { if (xb_ld(&bar[XB_TMO])) break; if (sp > XB_SPIN_CAP) { atomicAdd(&bar[XB_TMO], 1u); break; } }
    }
    nloc = mine > 0u ? mine : 1u; nx = cnt > 0u ? cnt : 1u;
}
__device__ __forceinline__ void xcd_barrier(const XcdBarrier& b) {
    asm volatile("s_waitcnt vmcnt(0)" ::: "memory");
    __syncthreads();
    if (threadIdx.x == 0) {
        unsigned* bar = b.bar;
        __builtin_amdgcn_s_waitcnt(0);
        unsigned nloc = b.st[0], nx = b.st[1];
        if (nloc == 0u) { xcd_barrier_complete(bar, b.x, nloc, nx); b.st[0] = nloc; b.st[1] = nx; }
        const unsigned old = xb_add(&bar[XB_XSUB(b.x)], 1u);
        const unsigned gen = old / nloc;
        if (old + 1u == (gen + 1u) * nloc) {
            __builtin_amdgcn_fence(__ATOMIC_RELEASE, "agent");
            asm volatile("s_waitcnt vmcnt(0)" ::: "memory");
            const unsigned og = xb_add(&bar[XB_TOP], 1u);
            const unsigned tg = og / nx;
            if (og + 1u == (tg + 1u) * nx) xb_add(&bar[XB_TOPGEN], 1u);
            else XB_SPIN(xb_ld(&bar[XB_TOPGEN]) == tg, bar);
            __builtin_amdgcn_fence(__ATOMIC_ACQUIRE, "agent");
            xb_add(&bar[XB_XGEN(b.x)], 1u);
            asm volatile("s_waitcnt vmcnt(0)" ::: "memory");
        } else {
            XB_SPIN(xb_ld(&bar[XB_XGEN(b.x)]) == gen, bar);
            __builtin_amdgcn_fence(__ATOMIC_ACQUIRE, "agent");
            asm volatile("s_waitcnt vmcnt(0)" ::: "memory");
        }
    }
    __syncthreads();
}
template <int CTRL> __device__ __forceinline__ float dpp_mov(float v) { return __builtin_bit_cast(float, __builtin_amdgcn_update_dpp(0, __builtin_bit_cast(int, v), CTRL, 0xF, 0xF, true)); }
__device__ __forceinline__ float lx1(float v) { return dpp_mov<0xB1>(v); }
__device__ __forceinline__ float lx2(float v) { return dpp_mov<0x4E>(v); }
__device__ __forceinline__ float lx4(float v) { return dpp_mov<0x1B>(dpp_mov<0x141>(v)); }
__device__ __forceinline__ float lx8(float v) { return dpp_mov<0x141>(dpp_mov<0x140>(v)); }
__device__ __forceinline__ float lx16(float v) { return __shfl_xor(v, 16); }
__device__ __forceinline__ float lx32(float v) { const unsigned u = __builtin_bit_cast(unsigned, v); auto r = __builtin_amdgcn_permlane32_swap(u, u, false, false);
    return __builtin_bit_cast(float, (threadIdx.x & 32) ? r[0] : r[1]); }
__device__ __forceinline__ float wave_sum(float v) {
    v += lx1(v); v += lx2(v); v += lx4(v); v += lx8(v); v += lx16(v); v += lx32(v);
    return v;
}
using pg8::Unit;
typedef pg8::f32x4 (&AccRef)[2][2][4][2];

__device__ __forceinline__ v2u pack4(f32x4 v) { v2u w; w.x = pg8::cvt_pk_bf16(v[0], v[1]); w.y = pg8::cvt_pk_bf16(v[2], v[3]); return w; }
__device__ __forceinline__ float sigmoidf_(float v) { return __builtin_amdgcn_rcpf(1.f + __builtin_amdgcn_exp2f(-LOG2E * v)); }

template <class Dec> struct Strided {
    Dec d; int n, G, vcu;
    __device__ __forceinline__ bool next(int i, Unit& u) const { const int L = i * G + vcu; if (L >= n) return false; d(L, u); return true; }
};

struct DecInProj { const char* A; const char* B; int layer;
    __device__ __forceinline__ void operator()(int L, Unit& u) const {
        int pm, pn;
        if (L < 1024) { const int cg = L >> 8, rg = (L & 255) >> 5, w = L & 31; pm = rg * 8 + (w & 7); pn = cg * 4 + (w >> 3); }
        else if (L < 1216) { const int q = L - 1024, rg = q / 24, w = q % 24; pm = rg * 8 + (w & 7); pn = 16 + (w >> 3); }
        else { const int q = L - 1216; pm = 64 + (q & 7); pn = q >> 3; if (layer == DEPTH - 1) pn = pn ? 6 : 4; }
        u.A = A + (size_t)pm * 256 * (DM * 2); u.B = B + (size_t)pn * 256 * (DM * 2); u.arows = nullptr; u.ldA = DM * 2; u.ldB = DM * 2; u.nt = DM / 64; u.pm = pm; u.pn = pn; u.tag = 0;
    } };
constexpr int inproj_units(int layer) { return 1216 + (layer == DEPTH - 1 ? 16 : 152); }

struct EpiInProj {
    bf16 *ABt, *ABtc, *Qg, *Kg, *Vg, *Qw, *Kw, *Vw, *G; const float* rope; const float* qng; const float* kng;
    __device__ __forceinline__ bool operator()(AccRef acc, const Unit& u, int wr, int wc, int fr, int fq) const {
        const int pm = u.pm, pn = u.pn; const bool lat = pm < 64;
        const int rowt = wr * 64 + fr;
        if (pn < 2) {
            bf16* dst; int ld;
            if (lat) { dst = ABt + ((size_t)(pm >> 3) * 256) * (2 * SEQ) + pn * SEQ + (pm & 7) * 256; ld = 2 * SEQ; }
            else { dst = ABtc + ((size_t)(pm - 64) * 256) * (2 * CTX) + pn * CTX; ld = 2 * CTX; }
#pragma unroll
            for (int ai = 0; ai < 2; ++ai)
#pragma unroll
                for (int m = 0; m < 4; ++m) { const int tok = rowt + ai * 128 + m * 16;
#pragma unroll
                    for (int bj = 0; bj < 2; ++bj)
#pragma unroll
                        for (int n = 0; n < 2; ++n) { const int c = bj * 128 + wc * 32 + n * 16 + fq * 4; const pg8::f32x4 v = acc[ai][bj][m][n];
#pragma unroll
                            for (int j = 0; j < 4; ++j) dst[(size_t)(c + j) * ld + tok] = (bf16)f2bf(v[j]); } }
        } else if (pn < 7) {
            bf16* dst; int ld; const float* ng = nullptr; bool rope_on = false; float sc = 1.f;
            if (pn <= 3)      { dst = Qg + (pn - 2) * 256 + wc * 64; ld = 512; ng = qng; rope_on = lat; sc = QSCALE; }
            else if (pn == 4) { if (wc < 2) { dst = Kg + wc * 64; ng = kng; rope_on = lat; } else { dst = Vg + (wc - 2) * 64; } ld = 128; }
            else if (pn == 5) { dst = Qw + wc * 64; ld = 256; rope_on = lat; sc = QSCALE; }
            else              { if (wc < 2) { dst = Kw + wc * 64; rope_on = lat; } else { dst = Vw + (wc - 2) * 64; } ld = 128; }
#pragma unroll
            for (int ai = 0; ai < 2; ++ai)
#pragma unroll
                for (int m = 0; m < 4; ++m) {
                    const int row = pm * 256 + rowt + ai * 128 + m * 16;
                    pg8::f32x4 v[2][2];
                    float ss = 0.f;
#pragma unroll
                    for (int bj = 0; bj < 2; ++bj)
#pragma unroll
                        for (int n = 0; n < 2; ++n) { v[bj][n] = acc[ai][bj][m][n]; ss += (v[bj][n][0] * v[bj][n][0] + v[bj][n][1] * v[bj][n][1]) + (v[bj][n][2] * v[bj][n][2] + v[bj][n][3] * v[bj][n][3]); }
                    float r = sc;
                    if (ng) { ss += __shfl_xor(ss, 16); ss += __shfl_xor(ss, 32); r = sc * rsqrtf(ss * (1.f / 64.f) + EPS); }
                    const int t = row & (SEQ - 1);
#pragma unroll
                    for (int bj = 0; bj < 2; ++bj)
#pragma unroll
                        for (int n = 0; n < 2; ++n) {
                            pg8::f32x4 x = v[bj][n] * r; if (ng) x = x * *(const pg8::f32x4*)(ng + bj * 32 + n * 16 + fq * 4);
                            if (rope_on) {
                                const int pos = bj ? (t & 63) : (t >> 6);
                                const pg8::f32x4 cs = *(const pg8::f32x4*)(rope + ((size_t)pos * 16 + n * 8 + fq * 2) * 2);
                                x = (pg8::f32x4){x[0] * cs[0] - x[1] * cs[1], x[0] * cs[1] + x[1] * cs[0], x[2] * cs[2] - x[3] * cs[3], x[2] * cs[3] + x[3] * cs[2]};
                            }
                            *(v2u*)(dst + (size_t)row * ld + bj * 32 + n * 16 + fq * 4) = pack4(x);
                        }
                    asm volatile("" ::: "memory");
                }
        } else {
            bf16* dst = G + ((size_t)pm * 12 + (pn - 7)) * 65536 + (size_t)(((wr * 4 + wc) * 64 + fq * 16 + fr) * 8);
#pragma unroll
            for (int ai = 0; ai < 2; ++ai)
#pragma unroll
                for (int bj = 0; bj < 2; ++bj)
#pragma unroll
                    for (int m = 0; m < 4; ++m) { const pg8::f32x4 a = acc[ai][bj][m][0], b = acc[ai][bj][m][1];
                        const v2u lo = pack4((pg8::f32x4){sigmoidf_(a[0]), sigmoidf_(a[1]), sigmoidf_(a[2]), sigmoidf_(a[3])}), hi = pack4((pg8::f32x4){sigmoidf_(b[0]), sigmoidf_(b[1]), sigmoidf_(b[2]), sigmoidf_(b[3])});
                        *(v4u*)(dst + (size_t)(((ai * 2 + bj) * 4 + m) * 4096)) = (v4u){lo.x, lo.y, hi.x, hi.y}; }
        }
        return false;
    }
};

struct EpiStore { bf16* O; int ld;
    __device__ __forceinline__ bool operator()(AccRef acc, const Unit& u, int wr, int wc, int fr, int fq) const {
        bf16* dst = O + ((size_t)u.pm * 256 + wr * 64 + fr) * ld + u.pn * 256 + wc * 32 + fq * 4;
#pragma unroll
        for (int ai = 0; ai < 2; ++ai)
#pragma unroll
            for (int m = 0; m < 4; ++m)
#pragma unroll
                for (int bj = 0; bj < 2; ++bj)
#pragma unroll
                    for (int n = 0; n < 2; ++n) *(v2u*)(dst + (size_t)(ai * 128 + m * 16) * ld + bj * 128 + n * 16) = pack4(acc[ai][bj][m][n]);
        return false;
    } };
struct DecDft { const char* Dm; const char* Dc; const char* ABt; const char* ABtc;
    __device__ __forceinline__ void operator()(int L, Unit& u) const {
        if (L < 64) { const int b = L >> 3, mt = L & 7; u.A = Dm + (size_t)mt * 256 * (4 * SEQ); u.B = ABt + (size_t)b * 256 * (4 * SEQ); u.ldA = 4 * SEQ; u.ldB = 4 * SEQ; u.nt = 2 * SEQ / 64; u.pm = L; }
        else { const int b = L - 64; u.A = Dc; u.B = ABtc + (size_t)b * 256 * (4 * CTX); u.ldA = 4 * CTX; u.ldB = 4 * CTX; u.nt = 2 * CTX / 64; u.pm = 64 + b; }
        u.pn = 0; u.tag = 0; u.arows = nullptr;
    } };

struct SchedMerge { const char* BR; const char* W; int ntiles, G, vcu;
    __device__ __forceinline__ bool next(int i, Unit& u) const {
        const int round = i / 3, tag = i - round * 3, tile = round * G + vcu; if (tile >= ntiles) return false;
        const int pm = tile >> 2, pn = tile & 3, koff = tag == 0 ? 0 : (tag == 1 ? 256 : 768);
        u.A = BR + (size_t)pm * 256 * (DM * 2) + koff * 2; u.B = W + (size_t)pn * 256 * (DM * 2) + koff * 2; u.arows = nullptr; u.ldA = DM * 2; u.ldB = DM * 2; u.nt = tag == 1 ? 8 : 4; u.pm = pm; u.pn = pn; u.tag = tag;
        return true;
    } };
struct EpiMerge { const bf16* G; bf16* Mb; int probe;
    __device__ __forceinline__ bool operator()(AccRef acc, const Unit& u, int wr, int wc, int fr, int fq) const {
        const size_t row0 = (size_t)u.pm * 256 + wr * 64 + fr; const int col0 = u.pn * 256 + wc * 32 + fq * 4; const int tag = u.tag;
        const bf16* g0 = G + ((size_t)u.pm * 12 + tag * 4 + u.pn) * 65536 + (size_t)(((wr * 4 + wc) * 64 + fq * 16 + fr) * 8);
#pragma unroll
        for (int ai = 0; ai < 2; ++ai)
#pragma unroll
            for (int bj = 0; bj < 2; ++bj) {
#pragma unroll
                for (int m = 0; m < 4; ++m) { const size_t fo = (size_t)(((ai * 2 + bj) * 4 + m) * 4096);
                    const v4u gw = probe == 2 ? (v4u){0x3f803f80u, 0x3f803f80u, 0x3f803f80u, 0x3f803f80u} : *(const v4u*)(g0 + fo);
                    pg8::f32x4 ga = {bflo(gw.x), bfhi(gw.x), bflo(gw.y), bfhi(gw.y)}, gb = {bflo(gw.z), bfhi(gw.z), bflo(gw.w), bfhi(gw.w)};
                    if (tag < 2) { const v4u hw = probe == 2 ? (v4u){0x3f803f80u, 0x3f803f80u, 0x3f803f80u, 0x3f803f80u} : *(const v4u*)(g0 + 4 * 65536 + fo);
                        ga = (pg8::f32x4){ga[0] * __builtin_amdgcn_rcpf(bflo(hw.x)), ga[1] * __builtin_amdgcn_rcpf(bfhi(hw.x)), ga[2] * __builtin_amdgcn_rcpf(bflo(hw.y)), ga[3] * __builtin_amdgcn_rcpf(bfhi(hw.y))};
                        gb = (pg8::f32x4){gb[0] * __builtin_amdgcn_rcpf(bflo(hw.z)), gb[1] * __builtin_amdgcn_rcpf(bfhi(hw.z)), gb[2] * __builtin_amdgcn_rcpf(bflo(hw.w)), gb[3] * __builtin_amdgcn_rcpf(bfhi(hw.w))};
                        acc[ai][bj][m][0] = acc[ai][bj][m][0] * ga; acc[ai][bj][m][1] = acc[ai][bj][m][1] * gb; }
                    else { const size_t row = row0 + ai * 128 + m * 16; const int c = col0 + bj * 128;
                        *(v2u*)(Mb + row * DM + c) = pack4(acc[ai][bj][m][0] * ga); *(v2u*)(Mb + row * DM + c + 16) = pack4(acc[ai][bj][m][1] * gb); } }
                asm volatile("" ::: "memory"); }
        return tag < 2;
    } };

struct DecWout { const char* Mb; const char* W;
    __device__ __forceinline__ void operator()(int L, Unit& u) const { const int pm = L >> 2, pn = L & 3;
        u.A = Mb + (size_t)pm * 256 * (DM * 2); u.B = W + (size_t)pn * 256 * (DM * 2); u.arows = nullptr; u.ldA = DM * 2; u.ldB = DM * 2; u.nt = DM / 64; u.pm = pm; u.pn = pn; u.tag = 0; } };
struct EpiWout { const float* baseL; const float* baseC; float* X; const float* mod;
    __device__ __forceinline__ bool operator()(AccRef acc, const Unit& u, int wr, int wc, int fr, int fq) const {
        const int pm = u.pm; const float* base = pm < 64 ? baseL : baseC; const float* g1 = mod + (size_t)(pm < 64 ? (pm >> 3) : 8) * (6 * DM) + 2 * DM;
        const size_t row0 = (size_t)pm * 256 + wr * 64 + fr; const int col0 = u.pn * 256 + wc * 32 + fq * 4;
#pragma unroll
        for (int bj = 0; bj < 2; ++bj)
#pragma unroll
            for (int n = 0; n < 2; ++n) { const int c = col0 + bj * 128 + n * 16; const pg8::f32x4 gv = *(const pg8::f32x4*)(g1 + c);
#pragma unroll
                for (int ai = 0; ai < 2; ++ai)
#pragma unroll
                    for (int m = 0; m < 4; ++m) { const size_t off = (row0 + ai * 128 + m * 16) * DM + c;
                        *(pg8::f32x4*)(X + off) = *(const pg8::f32x4*)(base + off) + gv * acc[ai][bj][m][n]; } }
        return false;
    } };

struct DecGU { const char* H2; const int* IDX; const char* W; int nrt;
    __device__ __forceinline__ void operator()(int L, Unit& u) const { const int per = nrt * 8, e = L / per, q = L - e * per, ct = q & 7, rt = q >> 3;
        u.A = H2; u.arows = IDX + (size_t)e * RPE + rt * 256; u.B = W + ((size_t)e * 2 * DM + ct * 256) * (DM * 2); u.ldA = DM * 2; u.ldB = DM * 2; u.nt = DM / 64; u.pm = rt; u.pn = ct; u.tag = e; } };
struct EpiGU { bf16* H;
    __device__ __forceinline__ bool operator()(AccRef acc, const Unit& u, int wr, int wc, int fr, int fq) const {
        bf16* dst = H + ((size_t)u.tag * RPE + u.pm * 256 + wr * 64 + fr) * DM + u.pn * 128 + wc * 32 + fq * 4;
#pragma unroll
        for (int ai = 0; ai < 2; ++ai)
#pragma unroll
            for (int m = 0; m < 4; ++m)
#pragma unroll
                for (int n = 0; n < 2; ++n) { const pg8::f32x4 a = acc[ai][0][m][n], up = acc[ai][1][m][n];
                    const pg8::f32x4 h = {a[0] * sigmoidf_(a[0]) * up[0], a[1] * sigmoidf_(a[1]) * up[1], a[2] * sigmoidf_(a[2]) * up[2], a[3] * sigmoidf_(a[3]) * up[3]};
                    *(v2u*)(dst + (size_t)(ai * 128 + m * 16) * DM + n * 16) = pack4(h); }
        return false;
    } };
struct DecDown { const char* H; const char* W; int nrt;
    __device__ __forceinline__ void operator()(int L, Unit& u) const { const int per = nrt * 4, e = L / per, q = L - e * per, ct = q & 3, rt = q >> 2;
        u.A = H + ((size_t)e * RPE + rt * 256) * (DM * 2); u.arows = nullptr; u.B = W + ((size_t)e * DM + ct * 256) * (DM * 2); u.ldA = DM * 2; u.ldB = DM * 2; u.nt = DM / 64; u.pm = rt; u.pn = ct; u.tag = e; } };
struct EpiDown { bf16* Y; const float* afs;
    __device__ __forceinline__ bool operator()(AccRef acc, const Unit& u, int wr, int wc, int fr, int fq) const {
        const size_t r0 = (size_t)u.tag * RPE + u.pm * 256 + wr * 64 + fr;
#pragma unroll
        for (int ai = 0; ai < 2; ++ai)
#pragma unroll
            for (int m = 0; m < 4; ++m) { const size_t r = r0 + ai * 128 + m * 16; const float a = afs[r];
#pragma unroll
                for (int bj = 0; bj < 2; ++bj)
#pragma unroll
                    for (int n = 0; n < 2; ++n) *(v2u*)(Y + r * DM + u.pn * 256 + bj * 128 + wc * 32 + n * 16 + fq * 4) = pack4(acc[ai][bj][m][n] * a); }
        return false;
    } };
struct Frame {
    LAS unsigned char* lds; char* ldsg; volatile LAS unsigned* MISC; gu32* ctl;
    int vcu, G;
    unsigned char* ws; unsigned char* dout; float* out;
};
constexpr int PTRS_OFF = LDSCTL_OFF + 512;
enum { IN_X = 0, IN_C, IN_CTX, IN_CCTX, IN_WADA, IN_BADA, IN_NORM1G, IN_WIN, IN_QNG, IN_KNG, IN_SINK, IN_WBRF, IN_WBRG, IN_WBRW, IN_WOUT, IN_NORM2G, IN_WROUTER, IN_WGATE, IN_WUP, IN_WDOWN, IN_FINALG };
__device__ __forceinline__ const float* inptr(const Frame& F, int k) {
    const unsigned long long v = *(const LAS unsigned long long*)(F.lds + PTRS_OFF + 8 * k);
    const unsigned lo = __builtin_amdgcn_readfirstlane((unsigned)v), hi = __builtin_amdgcn_readfirstlane((unsigned)(v >> 32));
    return (const float*)(((unsigned long long)hi << 32) | lo);
}
#define WSP(T, off) ((T*)(F.ws + (off)))

constexpr int COSTAB_OFF = LDSCTL_OFF + 1024;
static_assert(COSTAB_OFF + 8192 <= LDS_BYTES, "cos table fits");
__device__ __forceinline__ void transpose_item(const float* W, int ldw, int k0, int n0, bf16* WT, int drow0, int dld, int dk0, int lane) {
    const int g = lane >> 3, n4 = (lane & 7) * 4;
    const float* src = W + (size_t)(k0 + 8 * g) * ldw + n0 + n4;
    f32x4 v[8];
#pragma unroll
    for (int i = 0; i < 8; ++i) v[i] = *(const GAS f32x4*)(src + (size_t)i * ldw);
    bf16* dst = WT + (size_t)(drow0 + n4) * dld + dk0 + k0 + 8 * g;
#pragma unroll
    for (int j = 0; j < 4; ++j) { v4u o; o.x = pk2(v[0][j], v[1][j]); o.y = pk2(v[2][j], v[3][j]); o.z = pk2(v[4][j], v[5][j]); o.w = pk2(v[6][j], v[7][j]);
        *(GAS v4u*)(dst + (size_t)j * dld) = o; }
}
__device__ __forceinline__ void transpose_item2(const float* W, int ldw, int k0, int n0, bf16* WT, int drow0, int dld, int lane) {
    const int g = lane >> 3, n4 = (lane & 7) * 4;
    const float* src = W + (size_t)(k0 + 8 * g) * ldw + n0 + n4;
    f32x4 v[2][8];
#pragma unroll
    for (int h = 0; h < 2; ++h)
#pragma unroll
        for (int i = 0; i < 8; ++i) v[h][i] = __builtin_nontemporal_load((const GAS f32x4*)(src + (size_t)(h * 64 + i) * ldw));
    bf16* dst = WT + (size_t)(drow0 + n4) * dld + k0 + 8 * g;
#pragma unroll
    for (int h = 0; h < 2; ++h)
#pragma unroll
        for (int j = 0; j < 4; ++j) { v4u o; o.x = pk2(v[h][0][j], v[h][1][j]); o.y = pk2(v[h][2][j], v[h][3][j]); o.z = pk2(v[h][4][j], v[h][5][j]); o.w = pk2(v[h][6][j], v[h][7][j]);
            __builtin_nontemporal_store(o, (GAS v4u*)(dst + (size_t)j * dld + h * 64)); }
}
__device__ __forceinline__ void fold_item(const float* W, int k0, int g, int sinmode, bf16* WT, int drow0, LAS float* scr, const LAS float* ctab, int lane) {
#pragma unroll 8
    for (int kk = 0; kk < 64; ++kk) scr[kk * 64 + lane] = W[(size_t)(k0 + kk) * INW + g * 64 + lane];
    LDS_WAIT(); asm volatile("" ::: "memory");
    float acc[64];
#pragma unroll
    for (int k = 0; k < 64; ++k) acc[k] = 0.f;
    for (int c = 0; c < 64; ++c) {
        const int r = (c * lane) & 63;
        const float tv = sinmode ? -ctab[((r - 16) & 63) * 32] : ctab[r * 32];
#pragma unroll
        for (int k = 0; k < 64; ++k) acc[k] = fmaf(scr[k * 64 + c], tv, acc[k]);
    }
    GAS v4u* dst = (GAS v4u*)(WT + (size_t)(drow0 + lane) * DM + k0);
#pragma unroll
    for (int q = 0; q < 8; ++q) { v4u o; o.x = pk2(acc[8 * q], acc[8 * q + 1]); o.y = pk2(acc[8 * q + 2], acc[8 * q + 3]); o.z = pk2(acc[8 * q + 4], acc[8 * q + 5]); o.w = pk2(acc[8 * q + 6], acc[8 * q + 7]); dst[q] = o; }
    LDS_WAIT(); asm volatile("" ::: "memory");
}

constexpr int CONV_WAVE_ITEMS = DEPTH * NE * 768, CONV_ITEMS = CONV_WAVE_ITEMS / NWAVES, CONV_ITEMS_L0 = CONV_ITEMS / DEPTH;
__device__ __forceinline__ void conv_wave_item(Frame& F, int r, int lane) {
    const int le = r / 768, q = r % 768, which = q / 256, qq = q % 256, kb = qq >> 5, nb = qq & 31, f0 = nb * 32;
    if (which < 2) transpose_item2((which ? inptr(F, IN_WUP) : inptr(F, IN_WGATE)) + (size_t)le * DM * DM, DM, kb * 128, f0, WSP(bf16, WS_WGU) + (size_t)le * 2 * DM * DM, (f0 >> 7) * 256 + which * 128 + (f0 & 127), DM, lane);
    else transpose_item2(inptr(F, IN_WDOWN) + (size_t)le * DM * DM, DM, kb * 128, f0, WSP(bf16, WS_WD) + (size_t)le * DM * DM, f0, DM, lane);
}
__device__ __forceinline__ void tail_convert(Frame& F, int idx, int first, int per, int end) {
    int tid_ = threadIdx.x; asm volatile("" : "+v"(tid_));
    const int lane = tid_ & 63, wave_ = __builtin_amdgcn_readfirstlane(tid_ >> 6);
    for (int t = 0; t < per; ++t) { const int it = first + idx * per + t; if (it >= end) break; conv_wave_item(F, it * NWAVES + wave_, lane); }
}

__device__ __forceinline__ void p0_prologue(Frame& F) {
    int tid_ = threadIdx.x; asm volatile("" : "+v"(tid_));
    const int lane = tid_ & 63, wave_ = __builtin_amdgcn_readfirstlane(tid_ >> 6);
    const int gw = F.vcu * NWAVES + wave_, NGW = F.G * NWAVES;
    LAS float* st = (LAS float*)F.lds;
    LAS float* red = (LAS float*)(F.lds + 40960);
    LAS float* ctab = (LAS float*)(F.lds + COSTAB_OFF);
    for (int i = tid_; i < 9 * DM; i += NWAVES * 64) { const int s = i / DM, k = i - s * DM; const float v = s < 8 ? inptr(F, IN_C)[s * DM + k] : inptr(F, IN_CCTX)[k]; st[i] = v / (1.f + expf(-v)); }
    for (int i = tid_; i < 2048; i += NWAVES * 64) ctab[i] = cosf(6.283185307179586f * (float)i * (1.f / 2048.f));
    __syncthreads();
    for (int it = F.vcu; it < DEPTH * 96; it += F.G) {
        const int l = it / 96, j = (it % 96) * 64 + lane, kb = wave_ * 128;
        const float* W = inptr(F, IN_WADA) + (size_t)l * DM * 6 * DM + (size_t)kb * 6 * DM + j;
        float acc[9];
#pragma unroll
        for (int s = 0; s < 9; ++s) acc[s] = 0.f;
        for (int k0 = 0; k0 < 128; k0 += 16) {
            float w[16];
#pragma unroll
            for (int i = 0; i < 16; ++i) w[i] = W[(size_t)(k0 + i) * 6 * DM];
#pragma unroll
            for (int i = 0; i < 16; ++i)
#pragma unroll
                for (int s = 0; s < 9; ++s) acc[s] = fmaf(st[s * DM + kb + k0 + i], w[i], acc[s]);
        }
#pragma unroll
        for (int s = 0; s < 9; ++s) red[(wave_ * 9 + s) * 64 + lane] = acc[s];
        __syncthreads();
        for (int o = tid_; o < 9 * 64; o += NWAVES * 64) { float v = 0.f;
#pragma unroll
            for (int w = 0; w < 8; ++w) v += red[w * 576 + o];
            const int s = o >> 6, jj = (it % 96) * 64 + (o & 63);
            WSP(float, WS_MOD)[((size_t)l * 9 + s) * 6 * DM + jj] = v + inptr(F, IN_BADA)[l * 6 * DM + jj]; }
        __syncthreads();
    }
    __syncthreads();
#ifdef DBG_POISON
    {
        const size_t n16 = (WS_END - WS_X) / 16, m16 = ((size_t)NLAT * DM * 4) / 16; const v4u pz = {0xFFFFFFFFu, 0xFFFFFFFFu, 0xFFFFFFFFu, 0xFFFFFFFFu};
        for (size_t i = (size_t)gw * 64 + lane; i < n16; i += (size_t)NGW * 64) ((GAS v4u*)(F.ws + WS_X))[i] = pz;
        for (size_t i = (size_t)gw * 64 + lane; i < m16; i += (size_t)NGW * 64) ((GAS v4u*)F.dout)[i] = pz;
    }
#endif
    LAS float* scr = (LAS float*)(F.lds + wave_ * 16384);
    constexpr int T_A = DEPTH * 2176, T_B = DEPTH * 128, T_C = DEPTH * 512, T_D = DEPTH * 512, T_E = DEPTH * NE * 768, T_F = SEQ + CTX, T_G = 1;
    constexpr int NITEMS = T_A + T_B + T_C + T_D + T_E + T_F + T_G;
    for (int it = gw; it < NITEMS; it += NGW) {
        int r = it;
        if (r < T_A) { const int l = r / 2176, q = r % 2176, kb = q / 136, nb = q % 136, s0 = 256 + nb * 32;
            int drow; if (s0 < 1536) { const int tile = 2 + ((s0 - 256) >> 8), hh = ((s0 - 256) & 255) >> 6, dh = (s0 & 63) >> 5; drow = tile * 256 + dh * 128 + hh * 32; } else drow = s0 + 256;
            transpose_item(inptr(F, IN_WIN) + (size_t)l * DM * INW, INW, kb * 64, s0, WSP(bf16, WS_WIN) + (size_t)l * INW2 * DM, drow, DM, 0, lane); continue; } r -= T_A;
        if (r < T_B) { const int l = r / 128, q = r % 128, kb = q >> 3, g = (q >> 1) & 3, sm = q & 1;
            fold_item(inptr(F, IN_WIN) + (size_t)l * DM * INW, kb * 64, g, sm, WSP(bf16, WS_WIN) + (size_t)l * INW2 * DM, sm * 256 + g * 64, scr, ctab, lane); continue; } r -= T_B;
        if (r < T_C) { const int l = r / 512, q = r % 512; const float* W; int kb, koff;
            if (q < 128) { W = inptr(F, IN_WBRF) + (size_t)l * 256 * DM; kb = q >> 5; koff = 0; } else if (q < 384) { W = inptr(F, IN_WBRG) + (size_t)l * 512 * DM; kb = (q - 128) >> 5; koff = 256; } else { W = inptr(F, IN_WBRW) + (size_t)l * 256 * DM; kb = (q - 384) >> 5; koff = 768; }
            const int nb = q & 31;
            transpose_item(W, DM, kb * 64, nb * 32, WSP(bf16, WS_WBR) + (size_t)l * DM * DM, nb * 32, DM, koff, lane); continue; } r -= T_C;
        if (r < T_D) { const int l = r / 512, q = r % 512, kb = q >> 5, nb = q & 31;
            transpose_item(inptr(F, IN_WOUT) + (size_t)l * DM * DM, DM, kb * 64, nb * 32, WSP(bf16, WS_WOUT) + (size_t)l * DM * DM, nb * 32, DM, 0, lane); continue; } r -= T_D;
        if (r < T_E) { if (F.G != 256) conv_wave_item(F, r, lane); continue; } r -= T_E;
        if (r < T_F) {
            const bool big = r < SEQ; const int N = big ? SEQ : CTX, k = big ? r : r - SEQ, sh = big ? 0 : 3; const float sc = 1.f / sqrtf(64.f * (float)N);
            bf16* row = (big ? WSP(bf16, WS_DFT) : WSP(bf16, WS_DFTC)) + (size_t)k * 2 * N;
            for (int n = 2 * lane; n < N; n += 128) {
                const int r0 = (k * n) & (N - 1), r1 = (k * (n + 1)) & (N - 1);
                *(GAS unsigned*)(row + n) = pk2(ctab[r0 << sh] * sc, ctab[r1 << sh] * sc);
                *(GAS unsigned*)(row + N + n) = pk2(ctab[((r0 - (N >> 2)) & (N - 1)) << sh] * sc, ctab[((r1 - (N >> 2)) & (N - 1)) << sh] * sc); }
            continue; } r -= T_F;
        {
            for (int i = lane; i < 64 * 16; i += 64) { const int pos = i >> 4, f = i & 15; const float inv = powf(10000.f, -(float)(2 * f) / 32.f), ang = (float)pos * inv;
                WSP(float, WS_ROPE)[2 * i] = cosf(ang); WSP(float, WS_ROPE)[2 * i + 1] = sinf(ang); }
        }
    }
}

__device__ __forceinline__ void norm_row(f32x4 (&v)[4], const float* gain, const float* shift, const float* scale, int lane) {
    float ss = 0.f;
#pragma unroll
    for (int j = 0; j < 4; ++j) ss += (v[j][0] * v[j][0] + v[j][1] * v[j][1]) + (v[j][2] * v[j][2] + v[j][3] * v[j][3]);
    const float r = rsqrtf(wave_sum(ss) * (1.f / DM) + EPS);
#pragma unroll
    for (int j = 0; j < 4; ++j) { const f32x4 g = *(const f32x4*)(gain + 4 * lane + 256 * j); f32x4 y = v[j] * r * g;
        if (shift) { const f32x4 sh = *(const f32x4*)(shift + 4 * lane + 256 * j), sc = *(const f32x4*)(scale + 4 * lane + 256 * j); y = y * (sc + 1.f) + sh; }
        v[j] = y; }
}
__device__ __forceinline__ void store_row_bf16(bf16* orow, const f32x4 (&v)[4], int lane) {
    GAS v2u* o8 = (GAS v2u*)orow + lane;
#pragma unroll
    for (int j = 0; j < 4; ++j) { v2u w; w.x = pg8::cvt_pk_bf16(v[j][0], v[j][1]); w.y = pg8::cvt_pk_bf16(v[j][2], v[j][3]); o8[64 * j] = w; }
}
__device__ __forceinline__ int row_modset(int r) { return r < NLAT ? (r >> 11) : 8; }
struct ModVec { f32x4 g[4], sh[4], sc[4]; };
__device__ __forceinline__ void load_modvec(ModVec& m, const float* gain, const float* shift, const float* scale, int lane) {
#pragma unroll
    for (int j = 0; j < 4; ++j) { m.g[j] = *(const f32x4*)(gain + 4 * lane + 256 * j);
        if (shift) { m.sh[j] = *(const f32x4*)(shift + 4 * lane + 256 * j); m.sc[j] = *(const f32x4*)(scale + 4 * lane + 256 * j); } else { m.sh[j] = (f32x4){0.f, 0.f, 0.f, 0.f}; m.sc[j] = (f32x4){0.f, 0.f, 0.f, 0.f}; } }
}
__device__ __forceinline__ void norm_row_m(f32x4 (&v)[4], const ModVec& m) {
    float ss = 0.f;
#pragma unroll
    for (int j = 0; j < 4; ++j) ss += (v[j][0] * v[j][0] + v[j][1] * v[j][1]) + (v[j][2] * v[j][2] + v[j][3] * v[j][3]);
    const float r = rsqrtf(wave_sum(ss) * (1.f / DM) + EPS);
#pragma unroll
    for (int j = 0; j < 4; ++j) v[j] = (v[j] * r * m.g[j]) * (m.sc[j] + 1.f) + m.sh[j];
}
__device__ __forceinline__ void load_row_f32(f32x4 (&v)[4], const float* row, int lane) {
#pragma unroll
    for (int j = 0; j < 4; ++j) v[j] = *(const f32x4*)(row + 4 * lane + 256 * j);
}

__device__ __forceinline__ void p1_norm1(Frame& F) {
    int tid_ = threadIdx.x; asm volatile("" : "+v"(tid_));
    const int lane = tid_ & 63, wave_ = __builtin_amdgcn_readfirstlane(tid_ >> 6);
    const int gw = F.vcu * NWAVES + wave_, NGW = F.G * NWAVES, rpw = (NTOK + NGW - 1) / NGW, r0 = gw * rpw, r1 = r0 + rpw < NTOK ? r0 + rpw : NTOK;
    const float* xin = inptr(F, IN_X); const float* cin = inptr(F, IN_CTX) - (size_t)NLAT * DM; const float* g1 = inptr(F, IN_NORM1G);
#define P1_ROW(r) (((r) < NLAT ? xin : cin) + (size_t)(r) * DM)
    f32x4 va[4], vb[4]; ModVec m; int cset = -1;
    if (r0 < r1) load_row_f32(va, P1_ROW(r0), lane);
    if (r0 + 1 < r1) load_row_f32(vb, P1_ROW(r0 + 1), lane);
    for (int r = r0; r < r1; ++r) {
        f32x4 v[4];
#pragma unroll
        for (int j = 0; j < 4; ++j) { v[j] = va[j]; va[j] = vb[j]; }
        if (r + 2 < r1) load_row_f32(vb, P1_ROW(r + 2), lane);
        const int set = row_modset(r);
        if (set != cset) { const float* mod = WSP(float, WS_MOD) + (size_t)set * 6 * DM; load_modvec(m, g1, mod, mod + DM, lane); cset = set; }
        norm_row_m(v, m);
        store_row_bf16(WSP(bf16, WS_HN) + (size_t)r * DM, v, lane);
    }
#undef P1_ROW
}
__device__ __forceinline__ void router_finish(const float (&a16)[NE], int r, int lane, float* AFF) {
    float b8[8], b4[4], b2[2], lg;
    { const bool hi = lane & 32;
#pragma unroll
      for (int i = 0; i < 8; ++i) { const float keep = hi ? a16[i + 8] : a16[i], send = hi ? a16[i] : a16[i + 8]; b8[i] = keep + lx32(send); } }
    { const bool hi = lane & 16;
#pragma unroll
      for (int i = 0; i < 4; ++i) { const float keep = hi ? b8[i + 4] : b8[i], send = hi ? b8[i] : b8[i + 4]; b4[i] = keep + lx16(send); } }
    { const bool hi = lane & 8;
#pragma unroll
      for (int i = 0; i < 2; ++i) { const float keep = hi ? b4[i + 2] : b4[i], send = hi ? b4[i] : b4[i + 2]; b2[i] = keep + lx8(send); } }
    { const bool hi = lane & 4; const float keep = hi ? b2[1] : b2[0], send = hi ? b2[0] : b2[1]; lg = keep + lx4(send); }
    lg += lx2(lg); lg += lx1(lg);
    float mx = lg;
    mx = fmaxf(mx, lx4(mx)); mx = fmaxf(mx, lx8(mx)); mx = fmaxf(mx, lx16(mx)); mx = fmaxf(mx, lx32(mx));
    const float ex = expf(lg - mx); float sum = ex;
    sum += lx4(sum); sum += lx8(sum); sum += lx16(sum); sum += lx32(sum);
    const int set = r < NLAT ? (r >> 11) : 8 + ((r - NLAT) >> 8), n = r < NLAT ? (r & (SEQ - 1)) : ((r - NLAT) & (CTX - 1));
    if ((lane & 3) == 0) AFF[((size_t)set * NE + ((lane >> 2) & 15)) * SEQ + n] = ex / sum;
}
__device__ __forceinline__ void pf_norm2_router(Frame& F, int l, int mode = 0) {
    int tid_ = threadIdx.x; asm volatile("" : "+v"(tid_));
    const int lane = tid_ & 63, wave_ = __builtin_amdgcn_readfirstlane(tid_ >> 6);
    const int gw = F.vcu * NWAVES + wave_, NGW = F.G * NWAVES;
    LAS float* wrT = (LAS float*)F.lds;
    for (int i = tid_; i < DM * NE; i += NWAVES * 64) { const int k = i >> 4, e = i & 15; wrT[e * DM + k] = inptr(F, IN_WROUTER)[(size_t)l * DM * NE + i]; }
    __syncthreads();
    const int nrows = (l == DEPTH - 1) ? NLAT : NTOK, rpw = (nrows + NGW - 1) / NGW, r0 = gw * rpw, r1 = r0 + rpw < nrows ? r0 + rpw : nrows;
    const float* X = WSP(float, WS_X); const float* g2n = inptr(F, IN_NORM2G) + l * DM; float* AFF = WSP(float, WS_AFF);
    f32x4 va[4], vb[4]; ModVec m; int cset = -1;
    if (r0 < r1) load_row_f32(va, X + (size_t)r0 * DM, lane);
    if (r0 + 1 < r1) load_row_f32(vb, X + (size_t)(r0 + 1) * DM, lane);
    for (int r = r0; r < r1; ++r) {
        f32x4 v[4];
#pragma unroll
        for (int j = 0; j < 4; ++j) { v[j] = va[j]; va[j] = vb[j]; }
        if (r + 2 < r1) load_row_f32(vb, X + (size_t)(r + 2) * DM, lane);
        const int mset = row_modset(r);
        if (mset != cset) { const float* mod = WSP(float, WS_MOD) + ((size_t)l * 9 + mset) * 6 * DM; load_modvec(m, g2n, mod + 3 * DM, mod + 4 * DM, lane); cset = mset; }
        norm_row_m(v, m);
        if (mode < 2) store_row_bf16(WSP(bf16, WS_HN) + (size_t)r * DM, v, lane);
        if (mode >= 1) { asm volatile("" :: "v"(v[0]), "v"(v[1]), "v"(v[2]), "v"(v[3])); continue; }
        float a16[NE];
#pragma unroll
        for (int e = 0; e < NE; ++e) { float a = 0.f;
#pragma unroll
            for (int j = 0; j < 4; ++j) { const f32x4 w = *(const LAS f32x4*)(wrT + e * DM + 4 * lane + 256 * j); a += (v[j][0] * w[0] + v[j][1] * w[1]) + (v[j][2] * w[2] + v[j][3] * w[3]); }
            a16[e] = a; if ((e & 3) == 3) asm volatile("" ::: "memory"); }
        router_finish(a16, r, lane, AFF);
    }
    __syncthreads();
}
__device__ __forceinline__ void pg_topk_gather(Frame& F, int l) {
    int tid_ = threadIdx.x; asm volatile("" : "+v"(tid_));
    const int lane = tid_ & 63, wave_ = __builtin_amdgcn_readfirstlane(tid_ >> 6);
    LAS unsigned* cnt = (LAS unsigned*)F.lds;
    LAS int* sidx = (LAS int*)(F.lds + 1024);
    const int nitems = (l == DEPTH - 1) ? 8 * NE : 16 * NE;
    const int tid = tid_, wave = wave_;
    const unsigned long long lt = (1ull << lane) - 1ull;
    for (int it = F.vcu; it < nitems; it += F.G) {
        const int set = it >> 4, e = it & 15; const bool latent = set < 8; const int N = latent ? SEQ : CTX, cap = latent ? CAPL : CAPC;
        const int rowbase = latent ? set * SEQ : NLAT + (set - 8) * CTX, xbase = latent ? set * CAPL : 8 * CAPL + (set - 8) * CAPC;
        const float* a = WSP(float, WS_AFF) + ((size_t)set * NE + e) * SEQ;
        unsigned key[4];
#pragma unroll
        for (int q = 0; q < 4; ++q) { const int i = q * 512 + tid; key[q] = i < N ? __builtin_bit_cast(unsigned, a[i]) : 0u; }
        unsigned T = 0u;
        for (int bit = 30; bit >= 0; --bit) {
            const unsigned cand = T | (1u << bit); unsigned c = 0;
#pragma unroll
            for (int q = 0; q < 4; ++q) c += (unsigned)__builtin_popcountll(__ballot(key[q] >= cand));
            LAS unsigned* cb = cnt + (bit & 1) * 8;
            if (lane == 0) cb[wave] = c;
            __syncthreads();
            unsigned tot = 0;
#pragma unroll
            for (int w = 0; w < 8; ++w) tot += cb[w];
            if (tot >= (unsigned)cap) T = cand;
        }
        LAS unsigned* cg = cnt + 64; LAS unsigned* ce = cnt + 96;
        unsigned long long bg[4], be[4];
#pragma unroll
        for (int q = 0; q < 4; ++q) { bg[q] = __ballot(key[q] > T); be[q] = __ballot(key[q] == T && key[q] != 0u);
            if (lane == 0) { cg[q * 8 + wave] = (unsigned)__builtin_popcountll(bg[q]); ce[q * 8 + wave] = (unsigned)__builtin_popcountll(be[q]); } }
        __syncthreads();
        unsigned ngt = 0;
        for (int c2 = 0; c2 < 32; ++c2) ngt += cg[c2];
        const unsigned need = (unsigned)cap - ngt;
        unsigned pre_g[4], pre_e[4];
        { unsigned rg = 0, re = 0;
#pragma unroll
          for (int q = 0; q < 4; ++q) { for (int w = 0; w < 8; ++w) { if (w == wave) { pre_g[q] = rg; pre_e[q] = re; } rg += cg[q * 8 + w]; re += ce[q * 8 + w]; } } }
        int* SEL = WSP(int, WS_SEL);
#pragma unroll
        for (int q = 0; q < 4; ++q) { const int i = q * 512 + tid;
            if (i < N) {
                const unsigned eb = pre_e[q] + (unsigned)__builtin_popcountll(be[q] & lt);
                const unsigned gb = pre_g[q] + (unsigned)__builtin_popcountll(bg[q] & lt);
                const bool isg = key[q] > T, ise = key[q] == T;
                const bool sel = isg || (ise && eb < need);
                const unsigned slot = gb + (eb < need ? eb : need);
                SEL[(size_t)(rowbase + i) * NE + e] = sel ? xbase + (int)slot : -1;
                if (sel) { WSP(float, WS_AFS)[(size_t)e * RPE + xbase + slot] = __builtin_bit_cast(float, key[q]); WSP(int, WS_IDX)[(size_t)e * RPE + xbase + slot] = rowbase + i; }
            } }
        __syncthreads();
    }
}
__device__ __forceinline__ void pj_combine(Frame& F, int l, int probe = 0) {
    int tid_ = threadIdx.x; asm volatile("" : "+v"(tid_));
    const int lane = tid_ & 63, wave_ = __builtin_amdgcn_readfirstlane(tid_ >> 6);
    const int gw = F.vcu * NWAVES + wave_, NGW = F.G * NWAVES; const bool last = l == DEPTH - 1;
    const int nrows = last ? NLAT : NTOK, rpw = (nrows + NGW - 1) / NGW, r0 = gw * rpw, r1 = r0 + rpw < nrows ? r0 + rpw : nrows;
    float* X = WSP(float, WS_X); const int* SEL = WSP(int, WS_SEL);
    const float* gnext = last ? inptr(F, IN_FINALG) : inptr(F, IN_NORM1G) + (l + 1) * DM;
    f32x4 va[4], vb[4], g2[4]; int sa = -1, sb = -1; ModVec m; int cset = -1;
    if (r0 < r1) { load_row_f32(va, X + (size_t)r0 * DM, lane); sa = lane < NE ? SEL[(size_t)r0 * NE + lane] : -1; }
    if (r0 + 1 < r1) { load_row_f32(vb, X + (size_t)(r0 + 1) * DM, lane); sb = lane < NE ? SEL[(size_t)(r0 + 1) * NE + lane] : -1; }
    for (int r = r0; r < r1; ++r) {
        f32x4 v[4], t[4];
#pragma unroll
        for (int j = 0; j < 4; ++j) { v[j] = va[j]; va[j] = vb[j]; t[j] = (f32x4){0.f, 0.f, 0.f, 0.f}; }
        const int selv = sa; sa = sb;
        if (r + 2 < r1) { load_row_f32(vb, X + (size_t)(r + 2) * DM, lane); sb = lane < NE ? SEL[(size_t)(r + 2) * NE + lane] : -1; }
        const int mset = row_modset(r);
        if (mset != cset) { const float* mod = WSP(float, WS_MOD) + ((size_t)l * 9 + mset) * 6 * DM; const float* mod1 = WSP(float, WS_MOD) + ((size_t)(last ? l : l + 1) * 9 + mset) * 6 * DM;
#pragma unroll
            for (int j = 0; j < 4; ++j) g2[j] = *(const f32x4*)(mod + 5 * DM + 4 * lane + 256 * j);
            load_modvec(m, gnext, last ? nullptr : mod1, last ? nullptr : mod1 + DM, lane); cset = mset; }
        for (int e = 0; e < NE; ++e) { const int se = __builtin_amdgcn_readlane(selv, e);
            if (se >= 0) { const GAS v2u* y = (const GAS v2u*)(WSP(bf16, WS_G) + ((size_t)e * RPE + se) * DM) + lane;
#pragma unroll
                for (int j = 0; j < 4; ++j) { const v2u w = y[64 * j]; t[j] += (f32x4){bflo(w.x), bfhi(w.x), bflo(w.y), bfhi(w.y)}; } } }
#pragma unroll
        for (int j = 0; j < 4; ++j) v[j] = v[j] + g2[j] * t[j];
        if (probe) { norm_row_m(v, m); asm volatile("" :: "v"(v[0]), "v"(v[1]), "v"(v[2]), "v"(v[3])); continue; }
        if (!last) {
#pragma unroll
            for (int j = 0; j < 4; ++j) *(f32x4*)(X + (size_t)r * DM + 4 * lane + 256 * j) = v[j];
            norm_row_m(v, m);
            store_row_bf16(WSP(bf16, WS_HN) + (size_t)r * DM, v, lane);
        } else {
            norm_row_m(v, m);
#pragma unroll
            for (int j = 0; j < 4; ++j) *(f32x4*)(F.out + (size_t)r * DM + 4 * lane + 256 * j) = v[j];
        }
    }
}

__device__ __forceinline__ void pc_mixers(Frame& F, int l, int rep) {
    int tid_ = threadIdx.x; asm volatile("" : "+v"(tid_));
    const int lane = tid_ & 63, wave_ = __builtin_amdgcn_readfirstlane(tid_ >> 6);
    const bool need_ctx = l < DEPTH - 1;
    {
        Strided<DecDft> S; S.d.Dm = (const char*)(F.ws + WS_DFT); S.d.Dc = (const char*)(F.ws + WS_DFTC); S.d.ABt = (const char*)(F.dout + DO_ABT); S.d.ABtc = (const char*)(F.dout + DO_ABTC);
        S.n = need_ctx ? 72 : 64; S.G = F.G; S.vcu = F.vcu;
        EpiStore E{WSP(bf16, WS_BR), DM};
        pg8::gemm_phase<EpiStore, Strided<DecDft>>(F.lds, (LAS int*)(F.lds + IDXBUF_OFF), S, E);
    }
    typedef attn_body::bf16 abf;
    const abf* Qg = (const abf*)(F.ws + WS_QKV + QKV_QG); const abf* Kg = (const abf*)(F.ws + WS_QKV + QKV_KG); const abf* Vg = (const abf*)(F.ws + WS_QKV + QKV_VG);
    const abf* Qw = (const abf*)(F.ws + WS_QKV + QKV_QW); const abf* Kw = (const abf*)(F.ws + WS_QKV + QKV_KW); const abf* Vw = (const abf*)(F.ws + WS_QKV + QKV_VW);
    abf* BR = (abf*)(F.ws + WS_BR);
    const int nGL = NBATCH * 2 * 32, nWL = NBATCH * 2 * 16, nGC = need_ctx ? NBATCH * 2 * 4 : 0, nWC = need_ctx ? NBATCH * 2 * 2 : 0, ntot = nGL + nWL + nGC + nWC;
    gu32* head = F.ctl + CW_QUEUE + 64 * (l + 2 * rep);
    const int wid = wave_;
    for (;;) {
        if (tid_ == 0) F.MISC[0] = __hip_atomic_fetch_add(head, 1u, RLX_AGENT);
        __syncthreads();
        const int a = (int)F.MISC[0];
        if (a >= ntot) break;
        if (a < nGL) {
            const int b = a >> 6, hkv = (a >> 5) & 1, qb = a & 31, head_ = hkv * 4 + (wid >> 1), q0 = qb * 64 + (wid & 1) * 32; const size_t qrow = (size_t)b * SEQ + q0;
            attn_body::attn_unit<0, 8>(Qg + qrow * 512 + head_ * 64, 512, Kg + (size_t)(NLAT + b * CTX) * 128 + hkv * 64, Kg + (size_t)b * SEQ * 128 + hkv * 64,
                                        Vg + (size_t)(NLAT + b * CTX) * 128 + hkv * 64, Vg + (size_t)b * SEQ * 128 + hkv * 64, 128, 4 + SEQ / 64, 0, 0, 0.f, BR + qrow * DM + 256 + head_ * 64, DM, F.ldsg);
        } else if (a < nGL + nWL) {
            const int u = a - nGL, b = u >> 5, hkv = (u >> 4) & 1, qb = u & 15, head_ = hkv * 2 + (wid >> 2), q0 = qb * 128 + (wid & 3) * 32; const size_t qrow = (size_t)b * SEQ + q0;
            const int band0 = qb * 128 - 128 < 0 ? 0 : qb * 128 - 128, band1 = qb * 128 + 256 > SEQ ? SEQ : qb * 128 + 256;
            attn_body::attn_unit<1, 8>(Qw + qrow * 256 + head_ * 64, 256, Kw + (size_t)(NLAT + b * CTX) * 128 + hkv * 64, Kw + ((size_t)b * SEQ + band0) * 128 + hkv * 64,
                                        Vw + (size_t)(NLAT + b * CTX) * 128 + hkv * 64, Vw + ((size_t)b * SEQ + band0) * 128 + hkv * 64, 128, 4 + (band1 - band0) / 64, q0, band0,
                                        inptr(F, IN_SINK)[l * 4 + head_] * LOG2E, BR + qrow * DM + 768 + head_ * 64, DM, F.ldsg);
        } else if (a < nGL + nWL + nGC) {
            const int u = a - nGL - nWL, b = u >> 3, hkv = (u >> 2) & 1, qb = u & 3, head_ = hkv * 4 + (wid >> 1); const size_t qrow = (size_t)NLAT + b * CTX + qb * 64 + (wid & 1) * 32;
            const abf* Kc = Kg + (size_t)(NLAT + b * CTX) * 128 + hkv * 64; const abf* Vc = Vg + (size_t)(NLAT + b * CTX) * 128 + hkv * 64;
            attn_body::attn_unit<0, 8>(Qg + qrow * 512 + head_ * 64, 512, Kc, Kc, Vc, Vc, 128, 4, 0, 0, 0.f, BR + qrow * DM + 256 + head_ * 64, DM, F.ldsg);
        } else {
            const int u = a - nGL - nWL - nGC, b = u >> 2, hkv = (u >> 1) & 1, qb = u & 1, head_ = hkv * 2 + (wid >> 2); const size_t qrow = (size_t)NLAT + b * CTX + qb * 128 + (wid & 3) * 32;
            const abf* Kc = Kw + (size_t)(NLAT + b * CTX) * 128 + hkv * 64; const abf* Vc = Vw + (size_t)(NLAT + b * CTX) * 128 + hkv * 64;
            attn_body::attn_unit<1, 8>(Qw + qrow * 256 + head_ * 64, 256, Kc, Kc, Vc, Vc, 128, 4, 0, 0, inptr(F, IN_SINK)[l * 4 + head_] * LOG2E, BR + qrow * DM + 768 + head_ * 64, DM, F.ldsg);
        }
    }
    __syncthreads();
}
#ifndef MK_N_LAUNCHES
#define MK_N_LAUNCHES 1
#endif
constexpr int N_PHASES = 2 + 9 * DEPTH;
struct Args { const float* in[21]; float* out; unsigned char* ws; int ph_lo, ph_hi, probe, pad_; };

__global__ void __launch_bounds__(NWAVES * 64, 2) hybrid_fwd(Args args) {
    extern __shared__ __attribute__((aligned(16))) unsigned char lds[];
    Frame F;
    F.lds = (LAS unsigned char*)lds; F.ldsg = (char*)lds; F.MISC = (volatile LAS unsigned*)(F.lds + MISC_OFF);
    F.G = gridDim.x; { const int bx = blockIdx.x; F.vcu = (F.G % 8 == 0) ? (bx % 8) * (F.G / 8) + bx / 8 : bx; }
    F.ws = args.ws; F.out = args.out; F.dout = (unsigned char*)args.out; F.ctl = (gu32*)(args.ws + WS_CTL);
    for (int u = threadIdx.x; u < (LDS_BYTES - LDSCTL_OFF) / 4; u += NWAVES * 64) ((LAS unsigned*)(F.lds + LDSCTL_OFF))[u] = 0u;
    __syncthreads();
    if (threadIdx.x < 21) *(LAS unsigned long long*)(F.lds + PTRS_OFF + 8 * threadIdx.x) = (unsigned long long)args.in[threadIdx.x];
    __syncthreads();
    XcdBarrier bar; bar.bar = (unsigned*)(F.ctl + CW_BAR); bar.x = 0; bar.st = nullptr;
    const int lo = args.ph_lo, hi = args.ph_hi;
    if (hi - lo > 1) bar = xcd_barrier_post((unsigned*)(F.ctl + CW_BAR), F.MISC + 8);
#ifndef PHSEL
#define PHSEL 0x7ff
#endif
#define IN(k) (lo <= (k) && (k) < hi)
#define KIND(j) ((PHSEL >> (j)) & 1)
#ifndef DBG_PROBE
#define DBG_PROBE 0
#endif
#ifndef FPROBE_MODE
#define FPROBE_MODE 0
#endif
#ifndef REP_MASK
#define REP_MASK 0
#endif
#define NREP(j, ok) ((((REP_MASK) >> (j)) & 1) && (ok) ? 2 : 1)
#define REPEAT(j, ok) for (int rep_ = 0, nrep_ = NREP(j, ok); rep_ < nrep_; ++rep_, (rep_ < nrep_ ? xcd_barrier(bar) : (void)0))
#define SEAM(k) do { if (IN(k) && IN((k) + 1)) xcd_barrier(bar); } while (0)

#ifdef BAR_PROBE
    if (hi - lo > 1) for (int i_ = 0; i_ < BAR_PROBE; ++i_) xcd_barrier(bar);
#endif
    if (KIND(0) && IN(0)) REPEAT(0, true) { p0_prologue(F); } SEAM(0);
    if (KIND(1) && IN(1)) REPEAT(1, true) { p1_norm1(F); } SEAM(1);
    for (int l = 0; l < DEPTH; ++l) {
        const int pb = 2 + 9 * l; const bool lastl = l == DEPTH - 1;
        const int nrt = lastl ? 64 : 72;
        if (KIND(2) && IN(pb + 0)) REPEAT(2, true) {
            Strided<DecInProj> S; S.d.A = (const char*)(F.ws + WS_HN); S.d.B = (const char*)(F.ws + WS_WIN) + (size_t)l * INW2 * DM * 2; S.d.layer = l; S.n = inproj_units(l); S.G = F.G; S.vcu = F.vcu;
            EpiInProj E; E.ABt = (bf16*)(F.dout + DO_ABT); E.ABtc = (bf16*)(F.dout + DO_ABTC);
            E.Qg = (bf16*)(F.ws + WS_QKV + QKV_QG); E.Kg = (bf16*)(F.ws + WS_QKV + QKV_KG); E.Vg = (bf16*)(F.ws + WS_QKV + QKV_VG);
            E.Qw = (bf16*)(F.ws + WS_QKV + QKV_QW); E.Kw = (bf16*)(F.ws + WS_QKV + QKV_KW); E.Vw = (bf16*)(F.ws + WS_QKV + QKV_VW);
            E.G = WSP(bf16, WS_G); E.rope = WSP(float, WS_ROPE); E.qng = inptr(F, IN_QNG) + l * 64; E.kng = inptr(F, IN_KNG) + l * 64;
            pg8::gemm_phase<EpiInProj, Strided<DecInProj>>(F.lds, (LAS int*)(F.lds + IDXBUF_OFF), S, E);
            if (l == 0 && F.G == 256 && F.vcu >= 88 && rep_ == 0) tail_convert(F, F.vcu - 88, 0, 4, 672);
        } SEAM(pb + 0);
        if (KIND(3) && IN(pb + 1)) REPEAT(3, true) { pc_mixers(F, l, rep_); } SEAM(pb + 1);
        if (KIND(4) && IN(pb + 2)) REPEAT(4, true) {
            SchedMerge S; S.BR = (const char*)(F.ws + WS_BR); S.W = (const char*)(F.ws + WS_WBR) + (size_t)l * DM * DM * 2; S.ntiles = nrt * 4; S.G = F.G; S.vcu = F.vcu;
            EpiMerge E{WSP(bf16, WS_G), (rep_ + 1 == nrep_ && !args.probe) ? (bf16*)(F.dout + DO_MB) : WSP(bf16, WS_HN), args.probe};
            pg8::gemm_phase<EpiMerge, SchedMerge>(F.lds, (LAS int*)(F.lds + IDXBUF_OFF), S, E);
            if (l == 0 && F.G == 256 && F.vcu >= 32 && rep_ == 0) tail_convert(F, F.vcu - 32, 672, 4, 1568);
        } SEAM(pb + 2);
        if (KIND(5) && IN(pb + 3)) REPEAT(5, l == 0) {
            Strided<DecWout> S; S.d.Mb = (const char*)(F.dout + DO_MB); S.d.W = (const char*)(F.ws + WS_WOUT) + (size_t)l * DM * DM * 2; S.n = nrt * 4; S.G = F.G; S.vcu = F.vcu;
            EpiWout E; E.baseL = l == 0 ? inptr(F, IN_X) : WSP(float, WS_X); E.baseC = l == 0 ? inptr(F, IN_CTX) - (size_t)NLAT * DM : WSP(float, WS_X); E.X = WSP(float, WS_X); E.mod = WSP(float, WS_MOD) + (size_t)l * 9 * 6 * DM;
            pg8::gemm_phase<EpiWout, Strided<DecWout>>(F.lds, (LAS int*)(F.lds + IDXBUF_OFF), S, E);
            if (l == 0 && F.G == 256 && F.vcu >= 32 && rep_ == 0) tail_convert(F, F.vcu - 32, 1568, 4, 2464);
        } SEAM(pb + 3);
        if (KIND(6) && IN(pb + 4)) REPEAT(6, true) { pf_norm2_router(F, l, rep_ ? FPROBE_MODE : 0); } SEAM(pb + 4);
        if (KIND(7) && IN(pb + 5)) REPEAT(7, true) { pg_topk_gather(F, l); } SEAM(pb + 5);
        const int ert = lastl ? 8 : 9;
        if (KIND(8) && IN(pb + 6)) REPEAT(8, true) {
            Strided<DecGU> S; S.d.H2 = (const char*)(F.ws + WS_HN); S.d.IDX = WSP(int, WS_IDX); S.d.W = (const char*)(F.ws + WS_WGU) + (size_t)l * NE * 2 * DM * DM * 2; S.d.nrt = ert; S.n = NE * ert * 8; S.G = F.G; S.vcu = F.vcu;
            EpiGU E{WSP(bf16, WS_HACT)};
            pg8::gemm_phase<EpiGU, Strided<DecGU>>(F.lds, (LAS int*)(F.lds + IDXBUF_OFF), S, E);
            if (l == 0 && F.G == 256 && F.vcu >= 128 && rep_ == 0) tail_convert(F, F.vcu - 128, 2464, 3, 2848);
        } SEAM(pb + 6);
        if (KIND(9) && IN(pb + 7)) REPEAT(9, true) {
            Strided<DecDown> S; S.d.H = (const char*)(F.ws + WS_HACT); S.d.W = (const char*)(F.ws + WS_WD) + (size_t)l * NE * DM * DM * 2; S.d.nrt = ert; S.n = NE * ert * 4; S.G = F.G; S.vcu = F.vcu;
            EpiDown E{WSP(bf16, WS_G), WSP(float, WS_AFS)};
            pg8::gemm_phase<EpiDown, Strided<DecDown>>(F.lds, (LAS int*)(F.lds + IDXBUF_OFF), S, E);
            if (l == 0 && F.G == 256 && F.vcu >= 64 && rep_ == 0) tail_convert(F, F.vcu - 64, 2848, 2, CONV_ITEMS);
        } SEAM(pb + 7);
        if (KIND(10) && IN(pb + 8)) REPEAT(10, true) { pj_combine(F, l, rep_); }
        if (!lastl) SEAM(pb + 8);
    }
#undef IN
#undef SEAM
}

extern "C" void kernel_launch(void* const* d_in, const int* in_sizes, int n_in, void* d_out, int out_size, void* d_ws, size_t ws_size, hipStream_t stream) {
    static int grid = 0;
    if (grid == 0) {
        if (n_in != 21 || out_size != NLAT * DM || ws_size < WS_END) { fprintf(stderr, "kernel_launch: unexpected problem (n_in %d, out %d, ws %zu < %zu)\n", n_in, out_size, ws_size, (size_t)WS_END); grid = -1; return; }
        int dev = 0, cus = 0, per_cu = 0;
        if (hipGetDevice(&dev) != hipSuccess || hipDeviceGetAttribute(&cus, hipDeviceAttributeMultiprocessorCount, dev) != hipSuccess) { grid = -1; return; }
        if (hipFuncSetAttribute((const void*)hybrid_fwd, hipFuncAttributeMaxDynamicSharedMemorySize, LDS_BYTES) != hipSuccess) { fprintf(stderr, "kernel_launch: hipFuncSetAttribute failed\n"); grid = -1; return; }
        if (hipOccupancyMaxActiveBlocksPerMultiprocessor(&per_cu, (const void*)hybrid_fwd, NWAVES * 64, LDS_BYTES) != hipSuccess || per_cu < 1) { fprintf(stderr, "kernel_launch: occupancy query says %d blocks/CU\n", per_cu); per_cu = 1; }
        (void)hipGetLastError();
        grid = cus * 1;
    }
    if (grid < 0) return;
    hipMemsetAsync((char*)d_ws + WS_CTL, 0, CTL_ZERO_BYTES, stream);
    Args a; memset(&a, 0, sizeof(a));
    for (int i = 0; i < 21; ++i) a.in[i] = (const float*)d_in[i];
    a.out = (float*)d_out; a.ws = (unsigned char*)d_ws;
#if MK_N_LAUNCHES == 1
    a.ph_lo = 0; a.ph_hi = N_PHASES;
    hipLaunchKernelGGL(hybrid_fwd, dim3(grid), dim3(NWAVES * 64), LDS_BYTES, stream, a);
#else
    for (int p = 0; p < N_PHASES; ++p) { a.ph_lo = p; a.ph_hi = p + 1; hipLaunchKernelGGL(hybrid_fwd, dim3(grid), dim3(NWAVES * 64), LDS_BYTES, stream, a);
#ifdef DBG_DUP_PHASE
        if (p == DBG_DUP_PHASE) { a.probe = DBG_PROBE; hipLaunchKernelGGL(hybrid_fwd, dim3(grid), dim3(NWAVES * 64), LDS_BYTES, stream, a); a.probe = 0; }
#endif
    }
#endif
}
```

```cpp
#define MK_N_LAUNCHES 1
#include <hip/hip_runtime.h>
#include <hip/hip_bf16.h>
#include <cstdio>
#include <cstdint>
#include <cmath>
#include <cstring>

constexpr int DM = 1024, NBATCH = 8, SEQ = 2048, CTX = 256, DEPTH = 2;
constexpr int NLAT = NBATCH * SEQ, NCTX = NBATCH * CTX, NTOK = NLAT + NCTX;
constexpr int INW = 4608, NCOLT = 19, INW2 = NCOLT * 256;
constexpr int NE = 16, CAPL = 256, CAPC = 32, RPE = NBATCH * (CAPL + CAPC);
constexpr float EPS = 1e-6f;
constexpr float QSCALE = 0.125f * 1.4426950408889634f;
constexpr float LOG2E = 1.4426950408889634f;
namespace pg8 {
#define PG8_LAS __attribute__((address_space(3)))
typedef unsigned short bf16_t;
typedef short bf16x8 __attribute__((ext_vector_type(8)));
typedef float f32x4 __attribute__((ext_vector_type(4)));
typedef unsigned u32x4 __attribute__((ext_vector_type(4)));
typedef unsigned u32x2 __attribute__((ext_vector_type(2)));
constexpr int BM = 256, BK = 64, HALF = 128, HTB = HALF * BK * 2  , STAGE_BYTES = 8 * HTB;

__host__ __device__ __forceinline__ int lds_byte(int r, int c) { const int st = (r >> 4) * 2 + (c >> 5), rr = r & 15, cc = c & 31, ob = rr * 64 + cc * 2; return st * 1024 + (ob ^ (((ob >> 9) & 1) << 5)); }
__host__ __device__ __forceinline__ void stage_rc(int b, int& R, int& C) { const int st = b / 1024, sb = b % 1024, swz = sb ^ (((sb >> 9) & 1) << 5); R = (st >> 1) * 16 + swz / 64; C = (st & 1) * 32 + (swz % 64) / 2; }

struct Unit { const char* A; const char* B; const int* arows; int ldA, ldB, nt; int pm, pn, tag; };

__device__ __forceinline__ unsigned cvt_pk_bf16(float lo, float hi) { unsigned r; asm volatile("v_cvt_pk_bf16_f32 %0, %1, %2" : "=v"(r) : "v"(lo), "v"(hi)); return r; }

template <class Epi, class Sched>
__device__ __forceinline__ void gemm_phase(PG8_LAS unsigned char* lds, PG8_LAS int* idxbuf  , const Sched& S, const Epi& E) {
    int tid = threadIdx.x; asm volatile("" : "+v"(tid));
    const int wid = __builtin_amdgcn_readfirstlane(tid >> 6), lane = tid & 63, wr = wid >> 2, wc = wid & 3, fr = lane & 15, fq = lane >> 4;
    unsigned Rr[2], Cc2[2];
#pragma unroll
    for (int i = 0; i < 2; ++i) { int R, C; stage_rc(tid * 16 + i * 8192, R, C); Rr[i] = (unsigned)R; Cc2[i] = (unsigned)C * 2u; }
    const size_t kstep = (size_t)(BK * 2);
    const unsigned ldsw = (unsigned)wid * 1024u;
    const int aoff = lds_byte(wr * 64 + fr, fq * 8), boff = lds_byte(wc * 32 + fr, fq * 8);
#define PG8_SA(b, h) (((b) * 2 + (h)) * HTB)
#define PG8_SB(b, h) ((4 + (b) * 2 + (h)) * HTB)
#define PG8_STAGE(bufoff, gbase, ld) do { _Pragma("unroll") for (int _i = 0; _i < 2; ++_i) \
        __builtin_amdgcn_global_load_lds((const unsigned*)((const char*)(gbase) + (Rr[_i] * (unsigned)(ld) + Cc2[_i])), (PG8_LAS unsigned*)(lds + (bufoff) + ldsw + _i * 8192), 16, 0, 0); } while (0)
#define PG8_STAGE_A(bufoff, gbase, ao) do { _Pragma("unroll") for (int _i = 0; _i < 2; ++_i) \
        __builtin_amdgcn_global_load_lds((const unsigned*)((const char*)(gbase) + (ao)[_i]), (PG8_LAS unsigned*)(lds + (bufoff) + ldsw + _i * 8192), 16, 0, 0); } while (0)
#define PG8_AOFF(u, ao) do { _Pragma("unroll") for (int _h = 0; _h < 2; ++_h) _Pragma("unroll") for (int _i = 0; _i < 2; ++_i) { \
        const unsigned _row = (u).arows ? (unsigned)idxbuf[Rr[_i] + 128 * _h] : Rr[_i] + 128u * _h; (ao)[_h][_i] = _row * (unsigned)(u).ldA + Cc2[_i]; } } while (0)
#define PG8_STAGE_IDX(u) do { if ((u).arows) __builtin_amdgcn_global_load_lds((const unsigned*)((u).arows + (wid & 3) * 64 + lane), (PG8_LAS unsigned*)((PG8_LAS unsigned char*)idxbuf + (wid & 3) * 256), 4, 0, 0); } while (0)
#define PG8_LDA(dst, b, h) do { _Pragma("unroll") for (int m = 0; m < 4; ++m) _Pragma("unroll") for (int k = 0; k < 2; ++k) dst[m][k] = *(const PG8_LAS bf16x8*)(lds + PG8_SA(b, h) + aoff + m * 2048 + k * 1024); } while (0)
#define PG8_LDB(dst, b, h) do { _Pragma("unroll") for (int n = 0; n < 2; ++n) _Pragma("unroll") for (int k = 0; k < 2; ++k) dst[n][k] = *(const PG8_LAS bf16x8*)(lds + PG8_SB(b, h) + boff + n * 2048 + k * 1024); } while (0)
#define PG8_MMA(ai, bj, At, Bt) do { __builtin_amdgcn_s_setprio(1); _Pragma("unroll") for (int m = 0; m < 4; ++m) _Pragma("unroll") for (int n = 0; n < 2; ++n) _Pragma("unroll") for (int k = 0; k < 2; ++k) \
        acc[ai][bj][m][n] = __builtin_amdgcn_mfma_f32_16x16x32_bf16(Bt[n][k], At[m][k], acc[ai][bj][m][n], 0, 0, 0); __builtin_amdgcn_s_setprio(0); } while (0)
#define PG8_WAIT_V(n) asm volatile("s_waitcnt vmcnt(" #n ")" ::: "memory")
#define PG8_WAIT_L(n) asm volatile("s_waitcnt lgkmcnt(" #n ")" ::: "memory")
#define PG8_BAR __builtin_amdgcn_s_barrier()
#define PG8_SCHED __builtin_amdgcn_sched_barrier(0)
    Unit cur, nxt; int ui = 0;
    if (!S.next(0, cur)) return;
    nxt = cur;
    f32x4 acc[2][2][4][2];
#pragma unroll
    for (int a = 0; a < 2; ++a)
#pragma unroll
        for (int b = 0; b < 2; ++b)
#pragma unroll
            for (int m = 0; m < 4; ++m)
#pragma unroll
                for (int n = 0; n < 2; ++n) acc[a][b][m][n] = (f32x4){0.f, 0.f, 0.f, 0.f};
    bf16x8 At[4][2], B0[2][2], B1[2][2];
    const char* cA = cur.A; const char* cB = cur.B; int clb = cur.ldB;
    unsigned ao_c[2][2], ao_n[2][2];
    if (cur.arows) { PG8_STAGE_IDX(cur); PG8_WAIT_V(0); PG8_BAR; }
    PG8_AOFF(cur, ao_c);
#pragma unroll
    for (int _h = 0; _h < 2; ++_h)
#pragma unroll
        for (int _i = 0; _i < 2; ++_i) ao_n[_h][_i] = ao_c[_h][_i];
    if (cur.arows) { PG8_WAIT_L(0); PG8_BAR; }
    {
        const size_t hB = (size_t)HALF * clb;
        PG8_STAGE(PG8_SB(0, 0), cB, clb); PG8_STAGE(PG8_SB(0, 1), cB + hB, clb); PG8_STAGE_A(PG8_SA(0, 0), cA, ao_c[0]); PG8_STAGE_A(PG8_SA(0, 1), cA, ao_c[1]);
        if (wr == 1) PG8_BAR;
        PG8_WAIT_V(2); PG8_BAR;
        PG8_STAGE(PG8_SB(1, 0), cB + kstep, clb); PG8_STAGE_A(PG8_SA(1, 0), cA + kstep, ao_c[0]); PG8_STAGE(PG8_SB(1, 1), cB + hB + kstep, clb);
        PG8_WAIT_V(6); PG8_BAR;
    }
    for (;;) {
        const bool has_next = S.next(ui + 1, nxt);
        const char* nA = has_next ? nxt.A : cA; const char* nB = has_next ? nxt.B : cB; const int nlb = has_next ? nxt.ldB : clb;
        const int nt = cur.nt;
        if (has_next) PG8_STAGE_IDX(nxt);
        for (int t = 0; t < nt; t += 2) {
            const bool last = (t == nt - 2);
            if (last) { if (has_next) { PG8_AOFF(nxt, ao_n); } else {
#pragma unroll
                for (int _h = 0; _h < 2; ++_h)
#pragma unroll
                    for (int _i = 0; _i < 2; ++_i) ao_n[_h][_i] = ao_c[_h][_i]; } }
            unsigned ao2[2][2];
#pragma unroll
            for (int _h = 0; _h < 2; ++_h)
#pragma unroll
                for (int _i = 0; _i < 2; ++_i) ao2[_h][_i] = last ? ao_n[_h][_i] : ao_c[_h][_i];
            const char* a1 = cA + (size_t)(t + 1) * kstep;
            const char* a2 = last ? nA : cA + (size_t)(t + 2) * kstep; const char* b2 = last ? nB : cB + (size_t)(t + 2) * kstep;
            const int lb2 = last ? nlb : clb;
            const size_t hB2 = (size_t)HALF * lb2;
            const char* a3 = a2 + kstep; const char* b3 = b2 + kstep;
            PG8_LDB(B0, 0, 0); PG8_LDB(B1, 0, 1); PG8_SCHED; PG8_LDA(At, 0, 0); PG8_STAGE_A(PG8_SA(1, 1), a1, ao_c[1]);
            PG8_WAIT_V(8); PG8_WAIT_L(0); PG8_BAR; PG8_MMA(0, 0, At, B0); PG8_MMA(0, 1, At, B1); PG8_BAR; PG8_SCHED;
            PG8_LDA(At, 0, 1); PG8_STAGE(PG8_SB(0, 0), b2, lb2); PG8_STAGE(PG8_SB(0, 1), b2 + hB2, lb2); PG8_STAGE_A(PG8_SA(0, 0), a2, ao2[0]);
            PG8_WAIT_V(8); PG8_WAIT_L(0); PG8_BAR; PG8_MMA(1, 0, At, B0); PG8_MMA(1, 1, At, B1); PG8_BAR; PG8_SCHED;
            PG8_LDB(B0, 1, 0); PG8_LDB(B1, 1, 1); PG8_SCHED; PG8_LDA(At, 1, 0); PG8_STAGE_A(PG8_SA(0, 1), a2, ao2[1]);
            PG8_WAIT_V(8); PG8_WAIT_L(0); PG8_BAR; PG8_MMA(0, 0, At, B0); PG8_MMA(0, 1, At, B1); PG8_BAR; PG8_SCHED;
            PG8_LDA(At, 1, 1); PG8_STAGE(PG8_SB(1, 0), b3, lb2); PG8_STAGE(PG8_SB(1, 1), b3 + hB2, lb2); PG8_STAGE_A(PG8_SA(1, 0), a3, ao2[0]);
            PG8_WAIT_V(8); PG8_WAIT_L(0); PG8_BAR; PG8_MMA(1, 0, At, B0); PG8_MMA(1, 1, At, B1); PG8_BAR; PG8_SCHED;
        }
        if (wr == 0) PG8_BAR;
        bool keep_acc;
        { Unit eu = cur; int ewr = wr, ewc = wc, efr = fr, efq = fq; asm volatile("" : "+s"(eu.pm), "+s"(eu.pn), "+s"(eu.tag), "+s"(ewr), "+s"(ewc), "+v"(efr), "+v"(efq));
          keep_acc = E(acc, eu, ewr, ewc, efr, efq); }
        if (!has_next) break;
        if (!keep_acc) {
#pragma unroll
        for (int a = 0; a < 2; ++a)
#pragma unroll
            for (int b = 0; b < 2; ++b)
#pragma unroll
                for (int m = 0; m < 4; ++m)
#pragma unroll
                    for (int n = 0; n < 2; ++n) acc[a][b][m][n] = (f32x4){0.f, 0.f, 0.f, 0.f};
        }
        cur = nxt; cA = nA; cB = nB; clb = nlb; ++ui;
#pragma unroll
        for (int _h = 0; _h < 2; ++_h)
#pragma unroll
            for (int _i = 0; _i < 2; ++_i) ao_c[_h][_i] = ao_n[_h][_i];
        if (wr == 1) PG8_BAR;
    }
    PG8_WAIT_V(0);
    PG8_BAR;
#undef PG8_SA
#undef PG8_SB
#undef PG8_STAGE
#undef PG8_STAGE_A
#undef PG8_AOFF
#undef PG8_STAGE_IDX
#undef PG8_LDA
#undef PG8_LDB
#undef PG8_MMA
#undef PG8_WAIT_V
#undef PG8_WAIT_L
#undef PG8_BAR
#undef PG8_SCHED
}
}
#include <hip/hip_bf16.h>
#include <cmath>
namespace attn_body {
using bf16=__hip_bfloat16;
using bf16x8=__attribute__((ext_vector_type(8)))short;
using s16x4=__attribute__((ext_vector_type(4)))short;
using f32x16=__attribute__((ext_vector_type(16)))float;
using u32x4=__attribute__((ext_vector_type(4)))unsigned;
constexpr int D=64;
constexpr int NW=8,QBLK=32,KVBLK=64,NCT=4;
__device__ __forceinline__ int crow(int r,int hi){return (r&3)+8*(r>>2)+4*hi;}
#define SBAR() __builtin_amdgcn_sched_barrier(0)
__device__ __forceinline__ void wmask(f32x16&p0,f32x16&p1,int kb,int qabs,int hi){
  const float NEG=-INFINITY; const int d0=kb+4*hi-qabs;
  #pragma unroll
  for(int r=0;r<16;++r){int dd=d0+(r&3)+8*(r>>2); if(dd>128||dd<-128)p0[r]=NEG; if(dd+32>128||dd+32<-128)p1[r]=NEG;}
}

constexpr int NSLOT=3, SLOTB=8192;
constexpr int LDS_K=0, LDS_V=NSLOT*SLOTB, LDS_WS=2*NSLOT*SLOTB, LDS_OST=LDS_WS+NW*64*4, LDS_BYTES=LDS_OST+NW*4096;
__device__ __forceinline__ void glds16(const void*gsrc,unsigned lds_dst){unsigned keep;
  asm volatile("s_mov_b32 %0, m0\n\ts_mov_b32 m0, %2\n\ts_nop 0\n\tglobal_load_lds_dwordx4 %1, off\n\ts_mov_b32 m0, %0":"=&s"(keep):"v"(gsrc),"s"(lds_dst):"memory");}
__device__ __forceinline__ float max3f(float a,float b,float c){float r;asm("v_max3_f32 %0, %1, %2, %3":"=v"(r):"v"(a),"v"(b),"v"(c));return r;}
__device__ __forceinline__ float max2f(float a,float b){float r;asm("v_max_f32_e32 %0, %1, %2":"=v"(r):"v"(a),"v"(b));return r;}
__device__ __forceinline__ float fadd_s(float a,float b){float r;asm("v_add_f32_e32 %0, %1, %2":"=v"(r):"v"(a),"v"(b));return r;}
__device__ __forceinline__ float fsub_s(float a,float b){float r;asm("v_sub_f32_e32 %0, %1, %2":"=v"(r):"v"(a),"v"(b));return r;}
typedef float f32x2_t __attribute__((ext_vector_type(2))); typedef __bf16 bf16x2_t __attribute__((ext_vector_type(2)));
__device__ __forceinline__ unsigned cvtpk_s(float lo,float hi){f32x2_t v={lo,hi};bf16x2_t b=__builtin_convertvector(v,bf16x2_t);return __builtin_bit_cast(unsigned,b);}
#define WAIT_BAR(N) asm volatile("s_waitcnt vmcnt(" #N ") lgkmcnt(0)\n\ts_barrier":::"memory")

__device__ __forceinline__ void qkt(f32x16&p0,f32x16&p1,const char*Kslot,const bf16x8*qr,const f32x16&negm,int r32,int hi){
  const char*kb=Kslot+hi*1024+r32*16;
  #pragma unroll
  for(int d0=0;d0<4;++d0){
    const bf16x8 b0=*reinterpret_cast<const bf16x8*>(kb+d0*2048);
    const bf16x8 b1=*reinterpret_cast<const bf16x8*>(kb+d0*2048+512);
    if(d0==0){p0=__builtin_amdgcn_mfma_f32_32x32x16_bf16(b0,qr[0],negm,0,0,0);p1=__builtin_amdgcn_mfma_f32_32x32x16_bf16(b1,qr[0],negm,0,0,0);}
    else{p0=__builtin_amdgcn_mfma_f32_32x32x16_bf16(b0,qr[d0],p0,0,0,0);p1=__builtin_amdgcn_mfma_f32_32x32x16_bf16(b1,qr[d0],p1,0,0,0);}}
}
typedef __attribute__((address_space(3))) const char* lds_cptr;
typedef short v4i16_t __attribute__((ext_vector_type(4)));
__device__ __forceinline__ void kload8(bf16x8*kf,lds_cptr kp){
  kf[0]=*(const __attribute__((address_space(3))) bf16x8*)(kp);      kf[1]=*(const __attribute__((address_space(3))) bf16x8*)(kp+512);
  kf[2]=*(const __attribute__((address_space(3))) bf16x8*)(kp+2048); kf[3]=*(const __attribute__((address_space(3))) bf16x8*)(kp+2560);
  kf[4]=*(const __attribute__((address_space(3))) bf16x8*)(kp+4096); kf[5]=*(const __attribute__((address_space(3))) bf16x8*)(kp+4608);
  kf[6]=*(const __attribute__((address_space(3))) bf16x8*)(kp+6144); kf[7]=*(const __attribute__((address_space(3))) bf16x8*)(kp+6656);
}
__device__ __forceinline__ void kload2(bf16x8*kf,lds_cptr kp,int j){ kf[2*j]=*(const __attribute__((address_space(3))) bf16x8*)(kp+j*2048); kf[2*j+1]=*(const __attribute__((address_space(3))) bf16x8*)(kp+j*2048+512); }
__device__ __forceinline__ s16x4 vtr(lds_cptr p){ return __builtin_bit_cast(s16x4,__builtin_amdgcn_ds_read_tr16_b64_v4i16((__attribute__((address_space(3))) v4i16_t*)p)); }
__device__ __forceinline__ float rowmax(const f32x16&p0,const f32x16&p1){
  float a=max3f(p0[0],p0[1],p1[0]),b=max3f(p0[2],p0[3],p1[1]);a=max3f(a,p1[2],p1[3]);
  #pragma unroll
  for(int r=4;r<16;r+=4){a=max3f(a,p0[r],p0[r+1]);b=max3f(b,p0[r+2],p0[r+3]);a=max3f(a,p1[r],p1[r+1]);b=max3f(b,p1[r+2],p1[r+3]);}
  const float m=max2f(a,b);
  auto rr=__builtin_amdgcn_permlane32_swap(__float_as_uint(m),__float_as_uint(m),false,false);
  return max2f(__uint_as_float(rr[0]),__uint_as_float(rr[1]));
}
__device__ __forceinline__ void pv(f32x16*o,int vb,bf16x8 pa0,bf16x8 pa1,bf16x8 pa2,bf16x8 pa3){
  #pragma unroll
  for(int d0=0;d0<2;++d0){s16x4 lo[4],hi[4];
    #pragma unroll
    for(int ks=0;ks<4;++ks){
      asm volatile("ds_read_b64_tr_b16 %0,%1 offset:%c2":"=&v"(lo[ks]):"v"(vb),"i"(d0*4096+ks*1024):"memory");
      asm volatile("ds_read_b64_tr_b16 %0,%1 offset:%c2":"=&v"(hi[ks]):"v"(vb),"i"(d0*4096+ks*1024+512):"memory");}
    asm volatile("s_waitcnt lgkmcnt(0)":::"memory");SBAR();
    #define PK(k) (bf16x8){lo[k][0],lo[k][1],lo[k][2],lo[k][3],hi[k][0],hi[k][1],hi[k][2],hi[k][3]}
    o[d0]=__builtin_amdgcn_mfma_f32_32x32x16_bf16(pa0,PK(0),o[d0],0,0,0);
    o[d0]=__builtin_amdgcn_mfma_f32_32x32x16_bf16(pa1,PK(1),o[d0],0,0,0);
    o[d0]=__builtin_amdgcn_mfma_f32_32x32x16_bf16(pa2,PK(2),o[d0],0,0,0);
    o[d0]=__builtin_amdgcn_mfma_f32_32x32x16_bf16(pa3,PK(3),o[d0],0,0,0);
    #undef PK
  }
}

#ifndef ATTN_STORE16
#define ATTN_STORE16(p,v) (*(u32x4*)(p)=(v))
#endif
template<int MODE,int THRL> __device__ __forceinline__ void attn_unit(const bf16*Qw,int qp,const bf16*Kc,const bf16*Kl,const bf16*Vc,const bf16*Vl,int kp,int NT,int qabs,int band0,float sinkl2,bf16*Ow,int op,char*shm){
  int tid=threadIdx.x; asm volatile("":"+v"(tid));
  const int lane=tid&63,r32=lane&31,hi=lane>>5; const int wid=__builtin_amdgcn_readfirstlane(tid>>6);
  qabs+=r32;
  const unsigned lds0=(unsigned)(uintptr_t)shm;
  float*wsf=(float*)(shm+LDS_WS)+wid*64;
  const unsigned koff_=(unsigned)(lane*kp+wid*8)*2u;
  const unsigned voff_=(unsigned)((16*(wid&3)+(lane>>2))*kp+(wid>>2)*32+(lane&3)*8)*2u;
  const unsigned kdst=lds0+LDS_K+wid*1024, vdst=lds0+LDS_V+wid*1024;
  #define DMA_K(t,slot) glds16((const char*)((t)<NCT?Kc+(long)(t)*KVBLK*kp:Kl+(long)((t)-NCT)*KVBLK*kp)+koff_,(unsigned)__builtin_amdgcn_readfirstlane(kdst+(slot)))
  #define DMA_V(t,slot) glds16((const char*)((t)<NCT?Vc+(long)(t)*KVBLK*kp:Vl+(long)((t)-NCT)*KVBLK*kp)+voff_,(unsigned)__builtin_amdgcn_readfirstlane(vdst+(slot)))
  const int vb0=(int)(lds0+LDS_V)+((lane>>4)&1)*32+(lane&3)*8+(4*hi+((lane&15)>>2))*64;
  const char*Kbase=shm+LDS_K; bf16x8 kf[8];
  const lds_cptr shm3=(lds_cptr)shm; const lds_cptr kp0=shm3+LDS_K+hi*1024+r32*16; const lds_cptr vp0=shm3+LDS_V+((lane>>4)&1)*32+(lane&3)*8+(4*hi+((lane&15)>>2))*64;
  DMA_K(0,0);DMA_V(0,0);DMA_K(1,SLOTB);
  bf16x8 qr[4];
  #pragma unroll
  for(int d0=0;d0<4;++d0)qr[d0]=*reinterpret_cast<const bf16x8*>(&Qw[(long)r32*qp+d0*16+hi*8]);
  float mhat=0.f,l_reg=0.f;f32x16 o[2];o[0]=f32x16{};o[1]=f32x16{};f32x16 negm=f32x16{};asm volatile("":"+v"(negm));
  #define CMASK(P0,P1,t) do{ if(MODE==1){ if((t)>=NCT)wmask(P0,P1,band0+KVBLK*((t)-NCT),qabs,hi);} }while(0)
  bool resc=false;
  #define START(P0,P1) do{ const float rm=rowmax(P0,P1); resc=false; \
    { const float dl=rm; mhat=fadd_s(mhat,dl); \
      _Pragma("unroll") for(int r=0;r<16;++r){P0[r]=fsub_s(P0[r],dl);P1[r]=fsub_s(P1[r],dl);} \
      _Pragma("unroll") for(int r=0;r<16;++r)negm[r]=-mhat; asm volatile("":"+v"(negm)); } \
    _Pragma("unroll") for(int r=0;r<16;++r)P0[r]=__builtin_amdgcn_exp2f(P0[r]); }while(0)
  #define RESC() do{ if(resc){ asm volatile("s_waitcnt lgkmcnt(0)":::"memory"); \
      _Pragma("unroll") for(int d_=0;d_<2;++d_) _Pragma("unroll") for(int r=0;r<16;++r)o[d_][r]*=wsf[crow(r,hi)]; } }while(0)
  f32x16 pA0,pA1,pB0,pB1;
  int sl_prev=0,sl_cur=0,sl_next=SLOTB;
  #define ROT() do{sl_prev=sl_cur;sl_cur=sl_next;sl_next=(sl_next==(NSLOT-1)*SLOTB)?0:sl_next+SLOTB;}while(0)
  DMA_K(2,2*SLOTB);
  WAIT_BAR(3);
  qkt(pA0,pA1,Kbase,qr,negm,r32,hi);asm volatile("s_nop 15\n\ts_nop 7":"+v"(pA0),"+v"(pA1));CMASK(pA0,pA1,0);
  START(pA0,pA1);
  _Pragma("unroll") for(int r=0;r<16;++r)pA1[r]=__builtin_amdgcn_exp2f(pA1[r]);
  WAIT_BAR(0);
  DMA_K(3,0);DMA_V(1,SLOTB);
  ROT();
  kload8(kf,kp0+sl_cur);
  WAIT_BAR(2);
  s16x4 vlo[8],vhi[8]; u32x4 pw0,pw1,pw2,pw3;
  #define PKW(P,B) cvtpk_s(P[B],P[B+1])
  #define PAF(k) __builtin_bit_cast(bf16x8,pw##k)
  #define VFR(i) (bf16x8){vlo[i][0],vlo[i][1],vlo[i][2],vlo[i][3],vhi[i][0],vhi[i][1],vhi[i][2],vhi[i][3]}
  #define PIN(x) asm volatile("":"+v"(x))
  #define MX3(a,b,c) __builtin_fmaxf(__builtin_fmaxf((a),(b)),(c))
  #define GAPA(MF,A0,A1,A2,A3,W0,W1,PW) do{ MF; sacc+=A0; sacc+=A1; sacc+=A2; sacc+=A3; PIN(sacc); W0; W1; PIN(PW); SBAR(); }while(0)
  #define EX(v) __builtin_amdgcn_exp2f(v)
  #define GAPB(MF,X,B) do{ MF; X[B]=EX(X[B]); X[B+1]=EX(X[B+1]); X[B+2]=EX(X[B+2]); X[B+3]=EX(X[B+3]); PIN(X); SBAR(); }while(0)
  #define VRD(i) do{ vlo[i]=vtr(vp_+(((i)>>2)*4096+((i)&3)*1024)); vhi[i]=vtr(vp_+(((i)>>2)*4096+((i)&3)*1024+512)); }while(0)
  #define KRD(G,j) do{ if(G){ kload2(kf,kp0+sl_next,j); SBAR(); } }while(0)
  #define STEP(C0,C1,P0,P1,t,GK,GV,GL) do{ SBAR(); \
    const lds_cptr vp_=vp0+sl_prev; \
    VRD(0); SBAR(); float sacc=(P0[0]+P0[1]); \
    GAPA(C0=__builtin_amdgcn_mfma_f32_32x32x16_bf16(kf[0],qr[0],negm,0,0,0), P0[2],P0[3],P0[4],P0[5],     pw0[0]=PKW(P0,0), pw0[1]=PKW(P0,2), pw0); \
    VRD(4); SBAR(); GAPA(C1=__builtin_amdgcn_mfma_f32_32x32x16_bf16(kf[1],qr[0],negm,0,0,0), P0[6],P0[7],P0[8],P0[9],     pw0[2]=PKW(P0,4), pw0[3]=PKW(P0,6), pw0); \
    VRD(1); SBAR(); GAPA(C0=__builtin_amdgcn_mfma_f32_32x32x16_bf16(kf[2],qr[1],C0,0,0,0),   P0[10],P0[11],P0[12],P0[13], pw1[0]=PKW(P0,8), pw1[1]=PKW(P0,10), pw1); \
    VRD(5); SBAR(); GAPA(C1=__builtin_amdgcn_mfma_f32_32x32x16_bf16(kf[3],qr[1],C1,0,0,0),   P0[14],P0[15],P1[0],P1[1],   pw1[2]=PKW(P0,12),pw1[3]=PKW(P0,14), pw1); \
    VRD(2); SBAR(); GAPA(C0=__builtin_amdgcn_mfma_f32_32x32x16_bf16(kf[4],qr[2],C0,0,0,0),   P1[2],P1[3],P1[4],P1[5],     pw2[0]=PKW(P1,0), pw2[1]=PKW(P1,2), pw2); \
    VRD(6); SBAR(); GAPA(C1=__builtin_amdgcn_mfma_f32_32x32x16_bf16(kf[5],qr[2],C1,0,0,0),   P1[6],P1[7],P1[8],P1[9],     pw2[2]=PKW(P1,4), pw2[3]=PKW(P1,6), pw2); \
    VRD(3); SBAR(); GAPA(C0=__builtin_amdgcn_mfma_f32_32x32x16_bf16(kf[6],qr[3],C0,0,0,0),   P1[10],P1[11],P1[12],P1[13], pw3[0]=PKW(P1,8), pw3[1]=PKW(P1,10), pw3); \
    VRD(7); SBAR(); GAPA(C1=__builtin_amdgcn_mfma_f32_32x32x16_bf16(kf[7],qr[3],C1,0,0,0),   P1[14],P1[15],0.f,0.f,       pw3[2]=PKW(P1,12),pw3[3]=PKW(P1,14), pw3); \
    l_reg+=sacc; \
    if(GK){DMA_K((t)+3,sl_cur);} if(GV){DMA_V((t)+1,sl_next);} \
    CMASK(C0,C1,t); \
    { float a=MX3(C0[0],C0[1],C1[0]),b=MX3(C0[2],C0[3],C1[1]); a=MX3(a,C1[2],C1[3]); \
      _Pragma("unroll") for(int r=4;r<16;r+=4){a=MX3(a,C0[r],C0[r+1]);b=MX3(b,C0[r+2],C0[r+3]);a=MX3(a,C1[r],C1[r+1]);b=MX3(b,C1[r+2],C1[r+3]);} \
      float rm=__builtin_fmaxf(a,b); { auto rr=__builtin_amdgcn_permlane32_swap(__float_as_uint(rm),__float_as_uint(rm),false,false); rm=__builtin_fmaxf(__uint_as_float(rr[0]),__uint_as_float(rr[1])); } \
      resc=false; \
      if(__builtin_expect(__any(rm>(float)THRL),0)){ const float dl=__builtin_fmaxf(rm,0.f); mhat+=dl; \
        _Pragma("unroll") for(int r=0;r<16;++r){C0[r]-=dl;C1[r]-=dl;} \
        _Pragma("unroll") for(int r=0;r<16;++r)negm[r]=-mhat; asm volatile("":"+v"(negm)); \
        const float f=__builtin_amdgcn_exp2f(-dl); l_reg*=f; if(hi==0)wsf[r32]=f; resc=true; } } \
    SBAR(); \
    GAPB(o[0]=__builtin_amdgcn_mfma_f32_32x32x16_bf16(PAF(0),VFR(0),o[0],0,0,0), C0,0); \
    GAPB(o[1]=__builtin_amdgcn_mfma_f32_32x32x16_bf16(PAF(0),VFR(4),o[1],0,0,0), C0,4); \
    KRD(GL,0); GAPB(o[0]=__builtin_amdgcn_mfma_f32_32x32x16_bf16(PAF(1),VFR(1),o[0],0,0,0), C0,8); \
    KRD(GL,1); GAPB(o[1]=__builtin_amdgcn_mfma_f32_32x32x16_bf16(PAF(1),VFR(5),o[1],0,0,0), C0,12); \
    KRD(GL,2); GAPB(o[0]=__builtin_amdgcn_mfma_f32_32x32x16_bf16(PAF(2),VFR(2),o[0],0,0,0), C1,0); \
    KRD(GL,3); GAPB(o[1]=__builtin_amdgcn_mfma_f32_32x32x16_bf16(PAF(2),VFR(6),o[1],0,0,0), C1,4); \
    GAPB(o[0]=__builtin_amdgcn_mfma_f32_32x32x16_bf16(PAF(3),VFR(3),o[0],0,0,0), C1,8); \
    GAPB(o[1]=__builtin_amdgcn_mfma_f32_32x32x16_bf16(PAF(3),VFR(7),o[1],0,0,0), C1,12); \
    }while(0)
  int t=1;
  for(;t+5<NT;t+=2){
    STEP(pB0,pB1,pA0,pA1,t,true,true,true);     WAIT_BAR(2); RESC(); ROT();
    STEP(pA0,pA1,pB0,pB1,t+1,true,true,true);   WAIT_BAR(2); RESC(); ROT();
  }
  #define ENDW(tt) do{ if((tt)+3<NT){WAIT_BAR(2);} else if((tt)+2<NT){WAIT_BAR(1);} else {WAIT_BAR(0);} }while(0)
  for(;t+1<NT;t+=2){
    STEP(pB0,pB1,pA0,pA1,t,(t+3<NT),(t+1<NT),(t+1<NT));       ENDW(t);   RESC(); ROT();
    STEP(pA0,pA1,pB0,pB1,t+1,(t+4<NT),(t+2<NT),(t+2<NT));     ENDW(t+1); RESC(); ROT();
  }
  STEP(pB0,pB1,pA0,pA1,NT-1,false,false,false); RESC();
  { float sacc=pB0[0]+pB0[1]; _Pragma("unroll") for(int r=2;r<16;++r)sacc+=pB0[r]; _Pragma("unroll") for(int r=0;r<16;++r)sacc+=pB1[r]; l_reg+=sacc;
    pw0=(u32x4){PKW(pB0,0),PKW(pB0,2),PKW(pB0,4),PKW(pB0,6)};pw1=(u32x4){PKW(pB0,8),PKW(pB0,10),PKW(pB0,12),PKW(pB0,14)};pw2=(u32x4){PKW(pB1,0),PKW(pB1,2),PKW(pB1,4),PKW(pB1,6)};pw3=(u32x4){PKW(pB1,8),PKW(pB1,10),PKW(pB1,12),PKW(pB1,14)};
    SBAR(); pv(o,vb0+sl_cur,PAF(0),PAF(1),PAF(2),PAF(3)); }
  #undef PKW
  #undef PAF
  #undef VFR
  #undef PIN
  #undef MX3
  #undef GAPA
  #undef GAPB
  #undef EX
  #undef VRD
  #undef KRD
  #undef STEP
  #undef ENDW
  {auto rr=__builtin_amdgcn_permlane32_swap(__float_as_uint(l_reg),__float_as_uint(l_reg),false,false);l_reg=__uint_as_float(rr[0])+__uint_as_float(rr[1]);}
  if(MODE==1)l_reg+=__builtin_amdgcn_exp2f(sinkl2-mhat);
  if(hi==0)wsf[32+r32]=l_reg;asm volatile("s_waitcnt lgkmcnt(0)":::"memory");
  float rli[16];
  #pragma unroll
  for(int r=0;r<16;++r)rli[r]=__builtin_amdgcn_rcpf(wsf[32+crow(r,hi)]);
  { bf16*stg=(bf16*)(shm+LDS_OST)+wid*2048;
    #pragma unroll
    for(int r=0;r<16;++r){const int orow=crow(r,hi);
      #pragma unroll
      for(int d0=0;d0<2;++d0)stg[orow*64+d0*32+r32]=__float2bfloat16(o[d0][r]*rli[r]);}
    asm volatile("s_waitcnt lgkmcnt(0)":::"memory");
    #pragma unroll
    for(int i=0;i<4;++i){const int row=i*8+(lane>>3),ch=lane&7; const u32x4 v=*(const u32x4*)(stg+row*64+ch*8); ATTN_STORE16(Ow+(long)row*op+ch*8,v);} }
  asm volatile("s_waitcnt lgkmcnt(0)\n\ts_barrier":::"memory");
  #undef DMA_K
  #undef DMA_V
  #undef CMASK
  #undef START
  #undef RESC
  #undef ROT
}
constexpr int ATTN_LDS_BYTES=LDS_BYTES;
#undef SBAR
#undef WAIT_BAR
}
constexpr int NWAVES = 8;
constexpr size_t MiB = 1u << 20;
constexpr size_t WS_CTL = 0, CTL_ZERO_BYTES = 256 * 1024;
constexpr size_t WS_MOD = 1 * MiB;
constexpr size_t WS_ROPE = WS_MOD + 512 * 1024;
constexpr size_t WS_AFS = WS_ROPE + 64 * 1024;
constexpr size_t WS_IDX = WS_AFS + 192 * 1024;
constexpr size_t WS_SEL = 2 * MiB;
constexpr size_t WS_AFF = 4 * MiB;
constexpr size_t WS_WIN = 8 * MiB;
constexpr size_t WS_WBR = 28 * MiB;
constexpr size_t WS_WOUT = 32 * MiB;
constexpr size_t WS_DFT = 36 * MiB;
constexpr size_t WS_DFTC = 52 * MiB;
constexpr size_t WS_WGU = 53 * MiB;
constexpr size_t WS_WD = 181 * MiB;
constexpr size_t WS_X = 245 * MiB;
constexpr size_t WS_HN = 317 * MiB;
constexpr size_t WS_QKV = 353 * MiB;
constexpr size_t WS_G = 398 * MiB;
constexpr size_t WS_BR = 506 * MiB;
constexpr size_t WS_HACT = 470 * MiB;
constexpr size_t WS_END = 542 * MiB;
constexpr size_t QKV_QG = 0, QKV_KG = (size_t)NTOK * 512 * 2, QKV_VG = QKV_KG + (size_t)NTOK * 128 * 2, QKV_QW = QKV_VG + (size_t)NTOK * 128 * 2,
                 QKV_KW = QKV_QW + (size_t)NTOK * 256 * 2, QKV_VW = QKV_KW + (size_t)NTOK * 128 * 2;
static_assert(WS_QKV + QKV_VW + (size_t)NTOK * 128 * 2 <= WS_G && WS_HN + (size_t)NTOK * DM * 4 <= WS_G && WS_G + (size_t)NTOK * 3 * DM * 2 <= WS_BR && WS_HACT >= WS_G + (size_t)NE * RPE * DM * 2 && WS_HACT + (size_t)NE * RPE * DM * 2 <= WS_END, "d_ws map");
constexpr size_t DO_MB = 0, DO_ABT = 36 * MiB, DO_ABTC = 52 * MiB;
constexpr int CW_BAR = 1024;
constexpr int CW_QUEUE = 8192;
constexpr int CW_CONVQ = 8192 + 64 * 8;
constexpr int CW_FIN = CW_CONVQ + 64;
constexpr int RING_BYTES = 131072;
constexpr int LDSCTL_OFF = RING_BYTES, MISC_OFF = LDSCTL_OFF + 320;
constexpr int IDXBUF_OFF = LDSCTL_OFF + 1024 + 8192;
constexpr int LDS_BYTES = 147456;

#define GAS __attribute__((address_space(1)))
#define LAS __attribute__((address_space(3)))
typedef unsigned short bf16;
typedef unsigned v4u __attribute__((ext_vector_type(4)));
typedef unsigned v2u __attribute__((ext_vector_type(2)));
typedef float f32x4 __attribute__((ext_vector_type(4)));
typedef GAS unsigned gu32;
#define RLX_AGENT __ATOMIC_RELAXED, __HIP_MEMORY_SCOPE_AGENT
#define LDS_WAIT() asm volatile("s_waitcnt lgkmcnt(0)" ::: "memory")
#define VM_WAIT() asm volatile("s_waitcnt vmcnt(0)" ::: "memory")
__device__ __forceinline__ unsigned f2bf(float f) { unsigned u = __builtin_bit_cast(unsigned, f); return (u + 0x7fffu + ((u >> 16) & 1u)) >> 16; }
__device__ __forceinline__ unsigned pk2(float lo, float hi) { return f2bf(lo) | (f2bf(hi) << 16); }
__device__ __forceinline__ float bf2f(unsigned short h) { return __builtin_bit_cast(float, (unsigned)h << 16); }
__device__ __forceinline__ float bflo(unsigned w) { return __builtin_bit_cast(float, w << 16); }
__device__ __forceinline__ float bfhi(unsigned w) { return __builtin_bit_cast(float, w & 0xffff0000u); }

#define XB_TMO      128
#define XB_XCNT(j)  (256  + 64 * (j))
#define XB_XSUB(j)  (1280 + 64 * (j))
#define XB_XGEN(j)  (2304 + 64 * (j))
#define XB_TOP      3328
#define XB_TOPGEN   3392
#define XCD_BAR_WORDS 3456
#define XB_SPIN_CAP (1u << 20)
__device__ __forceinline__ unsigned xb_ld(unsigned* p)              { return __hip_atomic_load(p, __ATOMIC_RELAXED, __HIP_MEMORY_SCOPE_AGENT); }
__device__ __forceinline__ unsigned xb_add(unsigned* p, unsigned v) { return __hip_atomic_fetch_add(p, v, __ATOMIC_RELAXED, __HIP_MEMORY_SCOPE_AGENT); }
__device__ __forceinline__ unsigned xb_xcc_id() { return (unsigned)__builtin_amdgcn_s_getreg((3 << 11) | 20) & 0xFu; }
#define XB_SPIN(cond, bar) do { unsigned _sp = 0; while (cond) { __builtin_amdgcn_s_sleep(1); \
    if ((++_sp & 255u) == 0u) { if (xb_ld(&(bar)[XB_TMO])) break; if (_sp > XB_SPIN_CAP) { atomicAdd(&(bar)[XB_TMO], 1u); break; } } } } while (0)
struct XcdBarrier { unsigned* bar; unsigned x; volatile LAS unsigned* st; };
__device__ __forceinline__ XcdBarrier xcd_barrier_post(unsigned* bar, volatile LAS unsigned* st) {
    XcdBarrier b; b.bar = bar; b.x = xb_xcc_id(); b.st = st;
    if (threadIdx.x == 0) (void)xb_add(&bar[XB_XCNT(b.x)], 1u);
    return b;
}
__device__ __forceinline__ void xcd_barrier_complete(unsigned* bar, unsigned x, unsigned& nloc, unsigned& nx) {
    const unsigned G = gridDim.x * gridDim.y * gridDim.z;
    unsigned sum, cnt, mine, sp = 0u;
    for (;;) {
        sum = 0u; cnt = 0u; mine = 0u;
#pragma unroll
        for (unsigned j = 0; j < 16; ++j) { const unsigned c = xb_ld(&bar[XB_XCNT(j)]); sum += c; cnt += (c > 0u) ? 1u : 0u; mine = (j == x) ? c : mine; }
        if (sum == G) break;
        __builtin_amdgcn_s_sleep(1);
        if ((++sp & 255u) == 0u) { if (xb_ld(&bar[XB_TMO])) break; if (sp > XB_SPIN_CAP) { atomicAdd(&bar[XB_TMO], 1u); break; } }
    }
    nloc = mine > 0u ? mine : 1u; nx = cnt > 0u ? cnt : 1u;
}
__device__ __forceinline__ void xcd_barrier(const XcdBarrier& b) {
    asm volatile("s_waitcnt vmcnt(0)" ::: "memory");
    __syncthreads();
    if (threadIdx.x == 0) {
        unsigned* bar = b.bar;
        __builtin_amdgcn_s_waitcnt(0);
        unsigned nloc = b.st[0], nx = b.st[1];
        if (nloc == 0u) { xcd_barrier_complete(bar, b.x, nloc, nx); b.st[0] = nloc; b.st[1] = nx; }
        const unsigned old = xb_add(&bar[XB_XSUB(b.x)], 1u);
        const unsigned gen = old / nloc;
        if (old + 1u == (gen + 1u) * nloc) {
            __builtin_amdgcn_fence(__ATOMIC_RELEASE, "agent");
            asm volatile("s_waitcnt vmcnt(0)" ::: "memory");
            const unsigned og = xb_add(&bar[XB_TOP], 1u);
            const unsigned tg = og / nx;
            if (og + 1u == (tg + 1u) * nx) xb_add(&bar[XB_TOPGEN], 1u);
            else XB_SPIN(xb_ld(&bar[XB_TOPGEN]) == tg, bar);
            __builtin_amdgcn_fence(__ATOMIC_ACQUIRE, "agent");
            xb_add(&bar[XB_XGEN(b.x)], 1u);
            asm volatile("s_waitcnt vmcnt(0)" ::: "memory");
        } else {
            XB_SPIN(xb_ld(&bar[XB_XGEN(b.x)]) == gen, bar);
            __builtin_amdgcn_fence(__ATOMIC_ACQUIRE, "agent");
            asm volatile("s_waitcnt vmcnt(0)" ::: "memory");
        }
    }
    __syncthreads();
}
template <int CTRL> __device__ __forceinline__ float dpp_mov(float v) { return __builtin_bit_cast(float, __builtin_amdgcn_update_dpp(0, __builtin_bit_cast(int, v), CTRL, 0xF, 0xF, true)); }
__device__ __forceinline__ float lx1(float v) { return dpp_mov<0xB1>(v); }
__device__ __forceinline__ float lx2(float v) { return dpp_mov<0x4E>(v); }
__device__ __forceinline__ float lx4(float v) { return dpp_mov<0x1B>(dpp_mov<0x141>(v)); }
__device__ __forceinline__ float lx8(float v) { return dpp_mov<0x141>(dpp_mov<0x140>(v)); }
__device__ __forceinline__ float lx16(float v) { return __shfl_xor(v, 16); }
__device__ __forceinline__ float lx32(float v) { const unsigned u = __builtin_bit_cast(unsigned, v); auto r = __builtin_amdgcn_permlane32_swap(u, u, false, false);
    return __builtin_bit_cast(float, (threadIdx.x & 32) ? r[0] : r[1]); }
__device__ __forceinline__ float wave_sum(float v) {
    v += lx1(v); v += lx2(v); v += lx4(v); v += lx8(v); v += lx16(v); v += lx32(v);
    return v;
}
using pg8::Unit;
typedef pg8::f32x4 (&AccRef)[2][2][4][2];

__device__ __forceinline__ v2u pack4(f32x4 v) { v2u w; w.x = pg8::cvt_pk_bf16(v[0], v[1]); w.y = pg8::cvt_pk_bf16(v[2], v[3]); return w; }
__device__ __forceinline__ float sigmoidf_(float v) { return __builtin_amdgcn_rcpf(1.f + __builtin_amdgcn_exp2f(-LOG2E * v)); }

template <class Dec> struct Strided {
    Dec d; int n, G, vcu;
    __device__ __forceinline__ bool next(int i, Unit& u) const { const int L = i * G + vcu; if (L >= n) return false; d(L, u); return true; }
};

struct DecInProj { const char* A; const char* B; int layer;
    __device__ __forceinline__ void operator()(int L, Unit& u) const {
        int pm, pn;
        if (L < 1024) { const int cg = L >> 8, rg = (L & 255) >> 5, w = L & 31; pm = rg * 8 + (w & 7); pn = cg * 4 + (w >> 3); }
        else if (L < 1216) { const int q = L - 1024, rg = q / 24, w = q % 24; pm = rg * 8 + (w & 7); pn = 16 + (w >> 3); }
        else { const int q = L - 1216; pm = 64 + (q & 7); pn = q >> 3; if (layer == DEPTH - 1) pn = pn ? 6 : 4; }
        u.A = A + (size_t)pm * 256 * (DM * 2); u.B = B + (size_t)pn * 256 * (DM * 2); u.arows = nullptr; u.ldA = DM * 2; u.ldB = DM * 2; u.nt = DM / 64; u.pm = pm; u.pn = pn; u.tag = 0;
    } };
constexpr int inproj_units(int layer) { return 1216 + (layer == DEPTH - 1 ? 16 : 152); }

struct EpiInProj {
    bf16 *ABt, *ABtc, *Qg, *Kg, *Vg, *Qw, *Kw, *Vw, *G; const float* rope; const float* qng; const float* kng;
    __device__ __forceinline__ bool operator()(AccRef acc, const Unit& u, int wr, int wc, int fr, int fq) const {
        const int pm = u.pm, pn = u.pn; const bool lat = pm < 64;
        const int rowt = wr * 64 + fr;
        if (pn < 2) {
            bf16* dst; int ld;
            if (lat) { dst = ABt + ((size_t)(pm >> 3) * 256) * (2 * SEQ) + pn * SEQ + (pm & 7) * 256; ld = 2 * SEQ; }
            else { dst = ABtc + ((size_t)(pm - 64) * 256) * (2 * CTX) + pn * CTX; ld = 2 * CTX; }
#pragma unroll
            for (int ai = 0; ai < 2; ++ai)
#pragma unroll
                for (int m = 0; m < 4; ++m) { const int tok = rowt + ai * 128 + m * 16;
#pragma unroll
                    for (int bj = 0; bj < 2; ++bj)
#pragma unroll
                        for (int n = 0; n < 2; ++n) { const int c = bj * 128 + wc * 32 + n * 16 + fq * 4; const pg8::f32x4 v = acc[ai][bj][m][n];
#pragma unroll
                            for (int j = 0; j < 4; ++j) dst[(size_t)(c + j) * ld + tok] = (bf16)f2bf(v[j]); } }
        } else if (pn < 7) {
            bf16* dst; int ld; const float* ng = nullptr; bool rope_on = false; float sc = 1.f;
            if (pn <= 3)      { dst = Qg + (pn - 2) * 256 + wc * 64; ld = 512; ng = qng; rope_on = lat; sc = QSCALE; }
            else if (pn == 4) { if (wc < 2) { dst = Kg + wc * 64; ng = kng; rope_on = lat; } else { dst = Vg + (wc - 2) * 64; } ld = 128; }
            else if (pn == 5) { dst = Qw + wc * 64; ld = 256; rope_on = lat; sc = QSCALE; }
            else              { if (wc < 2) { dst = Kw + wc * 64; rope_on = lat; } else { dst = Vw + (wc - 2) * 64; } ld = 128; }
#pragma unroll
            for (int ai = 0; ai < 2; ++ai)
#pragma unroll
                for (int m = 0; m < 4; ++m) {
                    const int row = pm * 256 + rowt + ai * 128 + m * 16;
                    pg8::f32x4 v[2][2];
                    float ss = 0.f;
#pragma unroll
                    for (int bj = 0; bj < 2; ++bj)
#pragma unroll
                        for (int n = 0; n < 2; ++n) { v[bj][n] = acc[ai][bj][m][n]; ss += (v[bj][n][0] * v[bj][n][0] + v[bj][n][1] * v[bj][n][1]) + (v[bj][n][2] * v[bj][n][2] + v[bj][n][3] * v[bj][n][3]); }
                    float r = sc;
                    if (ng) { ss += __shfl_xor(ss, 16); ss += __shfl_xor(ss, 32); r = sc * rsqrtf(ss * (1.f / 64.f) + EPS); }
                    const int t = row & (SEQ - 1);
#pragma unroll
                    for (int bj = 0; bj < 2; ++bj)
#pragma unroll
                        for (int n = 0; n < 2; ++n) {
                            pg8::f32x4 x = v[bj][n] * r; if (ng) x = x * *(const pg8::f32x4*)(ng + bj * 32 + n * 16 + fq * 4);
                            if (rope_on) {
                                const int pos = bj ? (t & 63) : (t >> 6);
                                const pg8::f32x4 cs = *(const pg8::f32x4*)(rope + ((size_t)pos * 16 + n * 8 + fq * 2) * 2);
                                x = (pg8::f32x4){x[0] * cs[0] - x[1] * cs[1], x[0] * cs[1] + x[1] * cs[0], x[2] * cs[2] - x[3] * cs[3], x[2] * cs[3] + x[3] * cs[2]};
                            }
                            *(v2u*)(dst + (size_t)row * ld + bj * 32 + n * 16 + fq * 4) = pack4(x);
                        }
                    asm volatile("" ::: "memory");
                }
        } else {
            bf16* dst = G + ((size_t)pm * 12 + (pn - 7)) * 65536 + (size_t)(((wr * 4 + wc) * 64 + fq * 16 + fr) * 8);
#pragma unroll
            for (int ai = 0; ai < 2; ++ai)
#pragma unroll
                for (int bj = 0; bj < 2; ++bj)
#pragma unroll
                    for (int m = 0; m < 4; ++m) { const pg8::f32x4 a = acc[ai][bj][m][0], b = acc[ai][bj][m][1];
                        const v2u lo = pack4((pg8::f32x4){sigmoidf_(a[0]), sigmoidf_(a[1]), sigmoidf_(a[2]), sigmoidf_(a[3])}), hi = pack4((pg8::f32x4){sigmoidf_(b[0]), sigmoidf_(b[1]), sigmoidf_(b[2]), sigmoidf_(b[3])});
                        *(v4u*)(dst + (size_t)(((ai * 2 + bj) * 4 + m) * 4096)) = (v4u){lo.x, lo.y, hi.x, hi.y}; }
        }
        return false;
    }
};

struct EpiStore { bf16* O; int ld;
    __device__ __forceinline__ bool operator()(AccRef acc, const Unit& u, int wr, int wc, int fr, int fq) const {
        bf16* dst = O + ((size_t)u.pm * 256 + wr * 64 + fr) * ld + u.pn * 256 + wc * 32 + fq * 4;
#pragma unroll
        for (int ai = 0; ai < 2; ++ai)
#pragma unroll
            for (int m = 0; m < 4; ++m)
#pragma unroll
                for (int bj = 0; bj < 2; ++bj)
#pragma unroll
                    for (int n = 0; n < 2; ++n) *(v2u*)(dst + (size_t)(ai * 128 + m * 16) * ld + bj * 128 + n * 16) = pack4(acc[ai][bj][m][n]);
        return false;
    } };
struct DecDft { const char* Dm; const char* Dc; const char* ABt; const char* ABtc;
    __device__ __forceinline__ void operator()(int L, Unit& u) const {
        if (L < 64) { const int b = L >> 3, mt = L & 7; u.A = Dm + (size_t)mt * 256 * (4 * SEQ); u.B = ABt + (size_t)b * 256 * (4 * SEQ); u.ldA = 4 * SEQ; u.ldB = 4 * SEQ; u.nt = 2 * SEQ / 64; u.pm = L; }
        else { const int b = L - 64; u.A = Dc; u.B = ABtc + (size_t)b * 256 * (4 * CTX); u.ldA = 4 * CTX; u.ldB = 4 * CTX; u.nt = 2 * CTX / 64; u.pm = 64 + b; }
        u.pn = 0; u.tag = 0; u.arows = nullptr;
    } };

struct SchedMerge { const char* BR; const char* W; int ntiles, G, vcu;
    __device__ __forceinline__ bool next(int i, Unit& u) const {
        const int round = i / 3, tag = i - round * 3, tile = round * G + vcu; if (tile >= ntiles) return false;
        const int pm = tile >> 2, pn = tile & 3, koff = tag == 0 ? 0 : (tag == 1 ? 256 : 768);
        u.A = BR + (size_t)pm * 256 * (DM * 2) + koff * 2; u.B = W + (size_t)pn * 256 * (DM * 2) + koff * 2; u.arows = nullptr; u.ldA = DM * 2; u.ldB = DM * 2; u.nt = tag == 1 ? 8 : 4; u.pm = pm; u.pn = pn; u.tag = tag;
        return true;
    } };
struct EpiMerge { const bf16* G; bf16* Mb; int probe;
    __device__ __forceinline__ bool operator()(AccRef acc, const Unit& u, int wr, int wc, int fr, int fq) const {
        const size_t row0 = (size_t)u.pm * 256 + wr * 64 + fr; const int col0 = u.pn * 256 + wc * 32 + fq * 4; const int tag = u.tag;
        const bf16* g0 = G + ((size_t)u.pm * 12 + tag * 4 + u.pn) * 65536 + (size_t)(((wr * 4 + wc) * 64 + fq * 16 + fr) * 8);
#pragma unroll
        for (int ai = 0; ai < 2; ++ai)
#pragma unroll
            for (int bj = 0; bj < 2; ++bj) {
#pragma unroll
                for (int m = 0; m < 4; ++m) { const size_t fo = (size_t)(((ai * 2 + bj) * 4 + m) * 4096);
                    const v4u gw = probe == 2 ? (v4u){0x3f803f80u, 0x3f803f80u, 0x3f803f80u, 0x3f803f80u} : *(const v4u*)(g0 + fo);
                    pg8::f32x4 ga = {bflo(gw.x), bfhi(gw.x), bflo(gw.y), bfhi(gw.y)}, gb = {bflo(gw.z), bfhi(gw.z), bflo(gw.w), bfhi(gw.w)};
                    if (tag < 2) { const v4u hw = probe == 2 ? (v4u){0x3f803f80u, 0x3f803f80u, 0x3f803f80u, 0x3f803f80u} : *(const v4u*)(g0 + 4 * 65536 + fo);
                        ga = (pg8::f32x4){ga[0] * __builtin_amdgcn_rcpf(bflo(hw.x)), ga[1] * __builtin_amdgcn_rcpf(bfhi(hw.x)), ga[2] * __builtin_amdgcn_rcpf(bflo(hw.y)), ga[3] * __builtin_amdgcn_rcpf(bfhi(hw.y))};
                        gb = (pg8::f32x4){gb[0] * __builtin_amdgcn_rcpf(bflo(hw.z)), gb[1] * __builtin_amdgcn_rcpf(bfhi(hw.z)), gb[2] * __builtin_amdgcn_rcpf(bflo(hw.w)), gb[3] * __builtin_amdgcn_rcpf(bfhi(hw.w))};
                        acc[ai][bj][m][0] = acc[ai][bj][m][0] * ga; acc[ai][bj][m][1] = acc[ai][bj][m][1] * gb; }
                    else { const size_t row = row0 + ai * 128 + m * 16; const int c = col0 + bj * 128;
                        *(v2u*)(Mb + row * DM + c) = pack4(acc[ai][bj][m][0] * ga); *(v2u*)(Mb + row * DM + c + 16) = pack4(acc[ai][bj][m][1] * gb); } }
                asm volatile("" ::: "memory"); }
        return tag < 2;
    } };

struct DecWout { const char* Mb; const char* W;
    __device__ __forceinline__ void operator()(int L, Unit& u) const { const int pm = L >> 2, pn = L & 3;
        u.A = Mb + (size_t)pm * 256 * (DM * 2); u.B = W + (size_t)pn * 256 * (DM * 2); u.arows = nullptr; u.ldA = DM * 2; u.ldB = DM * 2; u.nt = DM / 64; u.pm = pm; u.pn = pn; u.tag = 0; } };
struct EpiWout { const float* baseL; const float* baseC; float* X; const float* mod;
    __device__ __forceinline__ bool operator()(AccRef acc, const Unit& u, int wr, int wc, int fr, int fq) const {
        const int pm = u.pm; const float* base = pm < 64 ? baseL : baseC; const float* g1 = mod + (size_t)(pm < 64 ? (pm >> 3) : 8) * (6 * DM) + 2 * DM;
        const size_t row0 = (size_t)pm * 256 + wr * 64 + fr; const int col0 = u.pn * 256 + wc * 32 + fq * 4;
#pragma unroll
        for (int bj = 0; bj < 2; ++bj)
#pragma unroll
            for (int n = 0; n < 2; ++n) { const int c = col0 + bj * 128 + n * 16; const pg8::f32x4 gv = *(const pg8::f32x4*)(g1 + c);
#pragma unroll
                for (int ai = 0; ai < 2; ++ai)
#pragma unroll
                    for (int m = 0; m < 4; ++m) { const size_t off = (row0 + ai * 128 + m * 16) * DM + c;
                        *(pg8::f32x4*)(X + off) = *(const pg8::f32x4*)(base + off) + gv * acc[ai][bj][m][n]; } }
        return false;
    } };

struct DecGU { const char* H2; const int* IDX; const char* W; int nrt;
    __device__ __forceinline__ void operator()(int L, Unit& u) const { const int per = nrt * 8, e = L / per, q = L - e * per, ct = q & 7, rt = q >> 3;
        u.A = H2; u.arows = IDX + (size_t)e * RPE + rt * 256; u.B = W + ((size_t)e * 2 * DM + ct * 256) * (DM * 2); u.ldA = DM * 2; u.ldB = DM * 2; u.nt = DM / 64; u.pm = rt; u.pn = ct; u.tag = e; } };
struct EpiGU { bf16* H;
    __device__ __forceinline__ bool operator()(AccRef acc, const Unit& u, int wr, int wc, int fr, int fq) const {
        bf16* dst = H + ((size_t)u.tag * RPE + u.pm * 256 + wr * 64 + fr) * DM + u.pn * 128 + wc * 32 + fq * 4;
#pragma unroll
        for (int ai = 0; ai < 2; ++ai)
#pragma unroll
            for (int m = 0; m < 4; ++m)
#pragma unroll
                for (int n = 0; n < 2; ++n) { const pg8::f32x4 a = acc[ai][0][m][n], up = acc[ai][1][m][n];
                    const pg8::f32x4 h = {a[0] * sigmoidf_(a[0]) * up[0], a[1] * sigmoidf_(a[1]) * up[1], a[2] * sigmoidf_(a[2]) * up[2], a[3] * sigmoidf_(a[3]) * up[3]};
                    *(v2u*)(dst + (size_t)(ai * 128 + m * 16) * DM + n * 16) = pack4(h); }
        return false;
    } };
struct DecDown { const char* H; const char* W; int nrt;
    __device__ __forceinline__ void operator()(int L, Unit& u) const { const int per = nrt * 4, e = L / per, q = L - e * per, ct = q & 3, rt = q >> 2;
        u.A = H + ((size_t)e * RPE + rt * 256) * (DM * 2); u.arows = nullptr; u.B = W + ((size_t)e * DM + ct * 256) * (DM * 2); u.ldA = DM * 2; u.ldB = DM * 2; u.nt = DM / 64; u.pm = rt; u.pn = ct; u.tag = e; } };
struct EpiDown { bf16* Y; const float* afs;
    __device__ __forceinline__ bool operator()(AccRef acc, const Unit& u, int wr, int wc, int fr, int fq) const {
        const size_t r0 = (size_t)u.tag * RPE + u.pm * 256 + wr * 64 + fr;
#pragma unroll
        for (int ai = 0; ai < 2; ++ai)
#pragma unroll
            for (int m = 0; m < 4; ++m) { const size_t r = r0 + ai * 128 + m * 16; const float a = afs[r];
#pragma unroll
                for (int bj = 0; bj < 2; ++bj)
#pragma unroll
                    for (int n = 0; n < 2; ++n) *(v2u*)(Y + r * DM + u.pn * 256 + bj * 128 + wc * 32 + n * 16 + fq * 4) = pack4(acc[ai][bj][m][n] * a); }
        return false;
    } };
struct Frame {
    LAS unsigned char* lds; char* ldsg; volatile LAS unsigned* MISC; gu32* ctl;
    int vcu, G;
    unsigned char* ws; unsigned char* dout; float* out;
};
constexpr int PTRS_OFF = LDSCTL_OFF + 512;
enum { IN_X = 0, IN_C, IN_CTX, IN_CCTX, IN_WADA, IN_BADA, IN_NORM1G, IN_WIN, IN_QNG, IN_KNG, IN_SINK, IN_WBRF, IN_WBRG, IN_WBRW, IN_WOUT, IN_NORM2G, IN_WROUTER, IN_WGATE, IN_WUP, IN_WDOWN, IN_FINALG };
__device__ __forceinline__ const float* inptr(const Frame& F, int k) {
    const unsigned long long v = *(const LAS unsigned long long*)(F.lds + PTRS_OFF + 8 * k);
    const unsigned lo = __builtin_amdgcn_readfirstlane((unsigned)v), hi = __builtin_amdgcn_readfirstlane((unsigned)(v >> 32));
    return (const float*)(((unsigned long long)hi << 32) | lo);
}
#define WSP(T, off) ((T*)(F.ws + (off)))

constexpr int COSTAB_OFF = LDSCTL_OFF + 1024;
static_assert(COSTAB_OFF + 8192 <= LDS_BYTES, "cos table fits");
__device__ __forceinline__ void transpose_item(const float* W, int ldw, int k0, int n0, bf16* WT, int drow0, int dld, int dk0, int lane) {
    const int g = lane >> 3, n4 = (lane & 7) * 4;
    const float* src = W + (size_t)(k0 + 8 * g) * ldw + n0 + n4;
    f32x4 v[8];
#pragma unroll
    for (int i = 0; i < 8; ++i) v[i] = *(const GAS f32x4*)(src + (size_t)i * ldw);
    bf16* dst = WT + (size_t)(drow0 + n4) * dld + dk0 + k0 + 8 * g;
#pragma unroll
    for (int j = 0; j < 4; ++j) { v4u o; o.x = pk2(v[0][j], v[1][j]); o.y = pk2(v[2][j], v[3][j]); o.z = pk2(v[4][j], v[5][j]); o.w = pk2(v[6][j], v[7][j]);
        *(GAS v4u*)(dst + (size_t)j * dld) = o; }
}
__device__ __forceinline__ void transpose_item2(const float* W, int ldw, int k0, int n0, bf16* WT, int drow0, int dld, int lane) {
    const int g = lane >> 3, n4 = (lane & 7) * 4;
    const float* src = W + (size_t)(k0 + 8 * g) * ldw + n0 + n4;
    f32x4 v[2][8];
#pragma unroll
    for (int h = 0; h < 2; ++h)
#pragma unroll
        for (int i = 0; i < 8; ++i) v[h][i] = __builtin_nontemporal_load((const GAS f32x4*)(src + (size_t)(h * 64 + i) * ldw));
    bf16* dst = WT + (size_t)(drow0 + n4) * dld + k0 + 8 * g;
#pragma unroll
    for (int h = 0; h < 2; ++h)
#pragma unroll
        for (int j = 0; j < 4; ++j) { v4u o; o.x = pk2(v[h][0][j], v[h][1][j]); o.y = pk2(v[h][2][j], v[h][3][j]); o.z = pk2(v[h][4][j], v[h][5][j]); o.w = pk2(v[h][6][j], v[h][7][j]);
            __builtin_nontemporal_store(o, (GAS v4u*)(dst + (size_t)j * dld + h * 64)); }
}
__device__ __forceinline__ void fold_item(const float* W, int k0, int g, int sinmode, bf16* WT, int drow0, LAS float* scr, const LAS float* ctab, int lane) {
#pragma unroll 8
    for (int kk = 0; kk < 64; ++kk) scr[kk * 64 + lane] = W[(size_t)(k0 + kk) * INW + g * 64 + lane];
    LDS_WAIT(); asm volatile("" ::: "memory");
    float acc[64];
#pragma unroll
    for (int k = 0; k < 64; ++k) acc[k] = 0.f;
    for (int c = 0; c < 64; ++c) {
        const int r = (c * lane) & 63;
        const float tv = sinmode ? -ctab[((r - 16) & 63) * 32] : ctab[r * 32];
#pragma unroll
        for (int k = 0; k < 64; ++k) acc[k] = fmaf(scr[k * 64 + c], tv, acc[k]);
    }
    GAS v4u* dst = (GAS v4u*)(WT + (size_t)(drow0 + lane) * DM + k0);
#pragma unroll
    for (int q = 0; q < 8; ++q) { v4u o; o.x = pk2(acc[8 * q], acc[8 * q + 1]); o.y = pk2(acc[8 * q + 2], acc[8 * q + 3]); o.z = pk2(acc[8 * q + 4], acc[8 * q + 5]); o.w = pk2(acc[8 * q + 6], acc[8 * q + 7]); dst[q] = o; }
    LDS_WAIT(); asm volatile("" ::: "memory");
}

constexpr int CONV_WAVE_ITEMS = DEPTH * NE * 768, CONV_ITEMS = CONV_WAVE_ITEMS / NWAVES, CONV_ITEMS_L0 = CONV_ITEMS / DEPTH;
__device__ __forceinline__ void conv_wave_item(Frame& F, int r, int lane) {
    const int le = r / 768, q = r % 768, which = q / 256, qq = q % 256, kb = qq >> 5, nb = qq & 31, f0 = nb * 32;
    if (which < 2) transpose_item2((which ? inptr(F, IN_WUP) : inptr(F, IN_WGATE)) + (size_t)le * DM * DM, DM, kb * 128, f0, WSP(bf16, WS_WGU) + (size_t)le * 2 * DM * DM, (f0 >> 7) * 256 + which * 128 + (f0 & 127), DM, lane);
    else transpose_item2(inptr(F, IN_WDOWN) + (size_t)le * DM * DM, DM, kb * 128, f0, WSP(bf16, WS_WD) + (size_t)le * DM * DM, f0, DM, lane);
}
__device__ __forceinline__ void tail_convert(Frame& F, int idx, int first, int per, int end) {
    int tid_ = threadIdx.x; asm volatile("" : "+v"(tid_));
    const int lane = tid_ & 63, wave_ = __builtin_amdgcn_readfirstlane(tid_ >> 6);
    for (int t = 0; t < per; ++t) { const int it = first + idx * per + t; if (it >= end) break; conv_wave_item(F, it * NWAVES + wave_, lane); }
}

__device__ __forceinline__ void p0_prologue(Frame& F) {
    int tid_ = threadIdx.x; asm volatile("" : "+v"(tid_));
    const int lane = tid_ & 63, wave_ = __builtin_amdgcn_readfirstlane(tid_ >> 6);
    const int gw = F.vcu * NWAVES + wave_, NGW = F.G * NWAVES;
    LAS float* st = (LAS float*)F.lds;
    LAS float* red = (LAS float*)(F.lds + 40960);
    LAS float* ctab = (LAS float*)(F.lds + COSTAB_OFF);
    for (int i = tid_; i < 9 * DM; i += NWAVES * 64) { const int s = i / DM, k = i - s * DM; const float v = s < 8 ? inptr(F, IN_C)[s * DM + k] : inptr(F, IN_CCTX)[k]; st[i] = v / (1.f + expf(-v)); }
    for (int i = tid_; i < 2048; i += NWAVES * 64) ctab[i] = cosf(6.283185307179586f * (float)i * (1.f / 2048.f));
    __syncthreads();
    for (int it = F.vcu; it < DEPTH * 96; it += F.G) {
        const int l = it / 96, j = (it % 96) * 64 + lane, kb = wave_ * 128;
        const float* W = inptr(F, IN_WADA) + (size_t)l * DM * 6 * DM + (size_t)kb * 6 * DM + j;
        float acc[9];
#pragma unroll
        for (int s = 0; s < 9; ++s) acc[s] = 0.f;
        for (int k0 = 0; k0 < 128; k0 += 16) {
            float w[16];
#pragma unroll
            for (int i = 0; i < 16; ++i) w[i] = W[(size_t)(k0 + i) * 6 * DM];
#pragma unroll
            for (int i = 0; i < 16; ++i)
#pragma unroll
                for (int s = 0; s < 9; ++s) acc[s] = fmaf(st[s * DM + kb + k0 + i], w[i], acc[s]);
        }
#pragma unroll
        for (int s = 0; s < 9; ++s) red[(wave_ * 9 + s) * 64 + lane] = acc[s];
        __syncthreads();
        for (int o = tid_; o < 9 * 64; o += NWAVES * 64) { float v = 0.f;
#pragma unroll
            for (int w = 0; w < 8; ++w) v += red[w * 576 + o];
            const int s = o >> 6, jj = (it % 96) * 64 + (o & 63);
            WSP(float, WS_MOD)[((size_t)l * 9 + s) * 6 * DM + jj] = v + inptr(F, IN_BADA)[l * 6 * DM + jj]; }
        __syncthreads();
    }
    __syncthreads();
#ifdef DBG_POISON
    {
        const size_t n16 = (WS_END - WS_X) / 16, m16 = ((size_t)NLAT * DM * 4) / 16; const v4u pz = {0xFFFFFFFFu, 0xFFFFFFFFu, 0xFFFFFFFFu, 0xFFFFFFFFu};
        for (size_t i = (size_t)gw * 64 + lane; i < n16; i += (size_t)NGW * 64) ((GAS v4u*)(F.ws + WS_X))[i] = pz;
        for (size_t i = (size_t)gw * 64 + lane; i < m16; i += (size_t)NGW * 64) ((GAS v4u*)F.dout)[i] = pz;
    }
#endif
    LAS float* scr = (LAS float*)(F.lds + wave_ * 16384);
    constexpr int T_A = DEPTH * 2176, T_B = DEPTH * 128, T_C = DEPTH * 512, T_D = DEPTH * 512, T_E = DEPTH * NE * 768, T_F = SEQ + CTX, T_G = 1;
    constexpr int NITEMS = T_A + T_B + T_C + T_D + T_E + T_F + T_G;
    for (int it = gw; it < NITEMS; it += NGW) {
        int r = it;
        if (r < T_A) { const int l = r / 2176, q = r % 2176, kb = q / 136, nb = q % 136, s0 = 256 + nb * 32;
            int drow; if (s0 < 1536) { const int tile = 2 + ((s0 - 256) >> 8), hh = ((s0 - 256) & 255) >> 6, dh = (s0 & 63) >> 5; drow = tile * 256 + dh * 128 + hh * 32; } else drow = s0 + 256;
            transpose_item(inptr(F, IN_WIN) + (size_t)l * DM * INW, INW, kb * 64, s0, WSP(bf16, WS_WIN) + (size_t)l * INW2 * DM, drow, DM, 0, lane); continue; } r -= T_A;
        if (r < T_B) { const int l = r / 128, q = r % 128, kb = q >> 3, g = (q >> 1) & 3, sm = q & 1;
            fold_item(inptr(F, IN_WIN) + (size_t)l * DM * INW, kb * 64, g, sm, WSP(bf16, WS_WIN) + (size_t)l * INW2 * DM, sm * 256 + g * 64, scr, ctab, lane); continue; } r -= T_B;
        if (r < T_C) { const int l = r / 512, q = r % 512; const float* W; int kb, koff;
            if (q < 128) { W = inptr(F, IN_WBRF) + (size_t)l * 256 * DM; kb = q >> 5; koff = 0; } else if (q < 384) { W = inptr(F, IN_WBRG) + (size_t)l * 512 * DM; kb = (q - 128) >> 5; koff = 256; } else { W = inptr(F, IN_WBRW) + (size_t)l * 256 * DM; kb = (q - 384) >> 5; koff = 768; }
            const int nb = q & 31;
            transpose_item(W, DM, kb * 64, nb * 32, WSP(bf16, WS_WBR) + (size_t)l * DM * DM, nb * 32, DM, koff, lane); continue; } r -= T_C;
        if (r < T_D) { const int l = r / 512, q = r % 512, kb = q >> 5, nb = q & 31;
            transpose_item(inptr(F, IN_WOUT) + (size_t)l * DM * DM, DM, kb * 64, nb * 32, WSP(bf16, WS_WOUT) + (size_t)l * DM * DM, nb * 32, DM, 0, lane); continue; } r -= T_D;
        if (r < T_E) { if (F.G != 256) conv_wave_item(F, r, lane); continue; } r -= T_E;
        if (r < T_F) {
            const bool big = r < SEQ; const int N = big ? SEQ : CTX, k = big ? r : r - SEQ, sh = big ? 0 : 3; const float sc = 1.f / sqrtf(64.f * (float)N);
            bf16* row = (big ? WSP(bf16, WS_DFT) : WSP(bf16, WS_DFTC)) + (size_t)k * 2 * N;
            for (int n = 2 * lane; n < N; n += 128) {
                const int r0 = (k * n) & (N - 1), r1 = (k * (n + 1)) & (N - 1);
                *(GAS unsigned*)(row + n) = pk2(ctab[r0 << sh] * sc, ctab[r1 << sh] * sc);
                *(GAS unsigned*)(row + N + n) = pk2(ctab[((r0 - (N >> 2)) & (N - 1)) << sh] * sc, ctab[((r1 - (N >> 2)) & (N - 1)) << sh] * sc); }
            continue; } r -= T_F;
        {
            for (int i = lane; i < 64 * 16; i += 64) { const int pos = i >> 4, f = i & 15; const float inv = powf(10000.f, -(float)(2 * f) / 32.f), ang = (float)pos * inv;
                WSP(float, WS_ROPE)[2 * i] = cosf(ang); WSP(float, WS_ROPE)[2 * i + 1] = sinf(ang); }
        }
    }
}

__device__ __forceinline__ void norm_row(f32x4 (&v)[4], const float* gain, const float* shift, const float* scale, int lane) {
    float ss = 0.f;
#pragma unroll
    for (int j = 0; j < 4; ++j) ss += (v[j][0] * v[j][0] + v[j][1] * v[j][1]) + (v[j][2] * v[j][2] + v[j][3] * v[j][3]);
    const float r = rsqrtf(wave_sum(ss) * (1.f / DM) + EPS);
#pragma unroll
    for (int j = 0; j < 4; ++j) { const f32x4 g = *(const f32x4*)(gain + 4 * lane + 256 * j); f32x4 y = v[j] * r * g;
        if (shift) { const f32x4 sh = *(const f32x4*)(shift + 4 * lane + 256 * j), sc = *(const f32x4*)(scale + 4 * lane + 256 * j); y = y * (sc + 1.f) + sh; }
        v[j] = y; }
}
__device__ __forceinline__ void store_row_bf16(bf16* orow, const f32x4 (&v)[4], int lane) {
    GAS v2u* o8 = (GAS v2u*)orow + lane;
#pragma unroll
    for (int j = 0; j < 4; ++j) { v2u w; w.x = pg8::cvt_pk_bf16(v[j][0], v[j][1]); w.y = pg8::cvt_pk_bf16(v[j][2], v[j][3]); o8[64 * j] = w; }
}
__device__ __forceinline__ int row_modset(int r) { return r < NLAT ? (r >> 11) : 8; }
struct ModVec { f32x4 g[4], sh[4], sc[4]; };
__device__ __forceinline__ void load_modvec(ModVec& m, const float* gain, const float* shift, const float* scale, int lane) {
#pragma unroll
    for (int j = 0; j < 4; ++j) { m.g[j] = *(const f32x4*)(gain + 4 * lane + 256 * j);
        if (shift) { m.sh[j] = *(const f32x4*)(shift + 4 * lane + 256 * j); m.sc[j] = *(const f32x4*)(scale + 4 * lane + 256 * j); } else { m.sh[j] = (f32x4){0.f, 0.f, 0.f, 0.f}; m.sc[j] = (f32x4){0.f, 0.f, 0.f, 0.f}; } }
}
__device__ __forceinline__ void norm_row_m(f32x4 (&v)[4], const ModVec& m) {
    float ss = 0.f;
#pragma unroll
    for (int j = 0; j < 4; ++j) ss += (v[j][0] * v[j][0] + v[j][1] * v[j][1]) + (v[j][2] * v[j][2] + v[j][3] * v[j][3]);
    const float r = rsqrtf(wave_sum(ss) * (1.f / DM) + EPS);
#pragma unroll
    for (int j = 0; j < 4; ++j) v[j] = (v[j] * r * m.g[j]) * (m.sc[j] + 1.f) + m.sh[j];
}
__device__ __forceinline__ void load_row_f32(f32x4 (&v)[4], const float* row, int lane) {
#pragma unroll
    for (int j = 0; j < 4; ++j) v[j] = *(const f32x4*)(row + 4 * lane + 256 * j);
}

__device__ __forceinline__ void p1_norm1(Frame& F) {
    int tid_ = threadIdx.x; asm volatile("" : "+v"(tid_));
    const int lane = tid_ & 63, wave_ = __builtin_amdgcn_readfirstlane(tid_ >> 6);
    const int gw = F.vcu * NWAVES + wave_, NGW = F.G * NWAVES, rpw = (NTOK + NGW - 1) / NGW, r0 = gw * rpw, r1 = r0 + rpw < NTOK ? r0 + rpw : NTOK;
    const float* xin = inptr(F, IN_X); const float* cin = inptr(F, IN_CTX) - (size_t)NLAT * DM; const float* g1 = inptr(F, IN_NORM1G);
#define P1_ROW(r) (((r) < NLAT ? xin : cin) + (size_t)(r) * DM)
    f32x4 va[4], vb[4]; ModVec m; int cset = -1;
    if (r0 < r1) load_row_f32(va, P1_ROW(r0), lane);
    if (r0 + 1 < r1) load_row_f32(vb, P1_ROW(r0 + 1), lane);
    for (int r = r0; r < r1; ++r) {
        f32x4 v[4];
#pragma unroll
        for (int j = 0; j < 4; ++j) { v[j] = va[j]; va[j] = vb[j]; }
        if (r + 2 < r1) load_row_f32(vb, P1_ROW(r + 2), lane);
        const int set = row_modset(r);
        if (set != cset) { const float* mod = WSP(float, WS_MOD) + (size_t)set * 6 * DM; load_modvec(m, g1, mod, mod + DM, lane); cset = set; }
        norm_row_m(v, m);
        store_row_bf16(WSP(bf16, WS_HN) + (size_t)r * DM, v, lane);
    }
#undef P1_ROW
}
__device__ __forceinline__ void router_finish(const float (&a16)[NE], int r, int lane, float* AFF) {
    float b8[8], b4[4], b2[2], lg;
    { const bool hi = lane & 32;
#pragma unroll
      for (int i = 0; i < 8; ++i) { const float keep = hi ? a16[i + 8] : a16[i], send = hi ? a16[i] : a16[i + 8]; b8[i] = keep + lx32(send); } }
    { const bool hi = lane & 16;
#pragma unroll
      for (int i = 0; i < 4; ++i) { const float keep = hi ? b8[i + 4] : b8[i], send = hi ? b8[i] : b8[i + 4]; b4[i] = keep + lx16(send); } }
    { const bool hi = lane & 8;
#pragma unroll
      for (int i = 0; i < 2; ++i) { const float keep = hi ? b4[i + 2] : b4[i], send = hi ? b4[i] : b4[i + 2]; b2[i] = keep + lx8(send); } }
    { const bool hi = lane & 4; const float keep = hi ? b2[1] : b2[0], send = hi ? b2[0] : b2[1]; lg = keep + lx4(send); }
    lg += lx2(lg); lg += lx1(lg);
    float mx = lg;
    mx = fmaxf(mx, lx4(mx)); mx = fmaxf(mx, lx8(mx)); mx = fmaxf(mx, lx16(mx)); mx = fmaxf(mx, lx32(mx));
    const float ex = expf(lg - mx); float sum = ex;
    sum += lx4(sum); sum += lx8(sum); sum += lx16(sum); sum += lx32(sum);
    const int set = r < NLAT ? (r >> 11) : 8 + ((r - NLAT) >> 8), n = r < NLAT ? (r & (SEQ - 1)) : ((r - NLAT) & (CTX - 1));
    if ((lane & 3) == 0) AFF[((size_t)set * NE + ((lane >> 2) & 15)) * SEQ + n] = ex / sum;
}
__device__ __forceinline__ void pf_norm2_router(Frame& F, int l, int mode = 0) {
    int tid_ = threadIdx.x; asm volatile("" : "+v"(tid_));
    const int lane = tid_ & 63, wave_ = __builtin_amdgcn_readfirstlane(tid_ >> 6);
    const int gw = F.vcu * NWAVES + wave_, NGW = F.G * NWAVES;
    LAS float* wrT = (LAS float*)F.lds;
    for (int i = tid_; i < DM * NE; i += NWAVES * 64) { const int k = i >> 4, e = i & 15; wrT[e * DM + k] = inptr(F, IN_WROUTER)[(size_t)l * DM * NE + i]; }
    __syncthreads();
    const int nrows = (l == DEPTH - 1) ? NLAT : NTOK, rpw = (nrows + NGW - 1) / NGW, r0 = gw * rpw, r1 = r0 + rpw < nrows ? r0 + rpw : nrows;
    const float* X = WSP(float, WS_X); const float* g2n = inptr(F, IN_NORM2G) + l * DM; float* AFF = WSP(float, WS_AFF);
    f32x4 va[4], vb[4]; ModVec m; int cset = -1;
    if (r0 < r1) load_row_f32(va, X + (size_t)r0 * DM, lane);
    if (r0 + 1 < r1) load_row_f32(vb, X + (size_t)(r0 + 1) * DM, lane);
    for (int r = r0; r < r1; ++r) {
        f32x4 v[4];
#pragma unroll
        for (int j = 0; j < 4; ++j) { v[j] = va[j]; va[j] = vb[j]; }
        if (r + 2 < r1) load_row_f32(vb, X + (size_t)(r + 2) * DM, lane);
        const int mset = row_modset(r);
        if (mset != cset) { const float* mod = WSP(float, WS_MOD) + ((size_t)l * 9 + mset) * 6 * DM; load_modvec(m, g2n, mod + 3 * DM, mod + 4 * DM, lane); cset = mset; }
        norm_row_m(v, m);
        if (mode < 2) store_row_bf16(WSP(bf16, WS_HN) + (size_t)r * DM, v, lane);
        if (mode >= 1) { asm volatile("" :: "v"(v[0]), "v"(v[1]), "v"(v[2]), "v"(v[3])); continue; }
        float a16[NE];
#pragma unroll
        for (int e = 0; e < NE; ++e) { float a = 0.f;
#pragma unroll
            for (int j = 0; j < 4; ++j) { const f32x4 w = *(const LAS f32x4*)(wrT + e * DM + 4 * lane + 256 * j); a = fmaf(v[j][0], w[0], a); a = fmaf(v[j][1], w[1], a); a = fmaf(v[j][2], w[2], a); a = fmaf(v[j][3], w[3], a); }
            a16[e] = a; if ((e & 3) == 3) asm volatile("" ::: "memory"); }
        router_finish(a16, r, lane, AFF);
    }
    __syncthreads();
}
__device__ __forceinline__ void pg_topk_gather(Frame& F, int l) {
    int tid_ = threadIdx.x; asm volatile("" : "+v"(tid_));
    const int lane = tid_ & 63, wave_ = __builtin_amdgcn_readfirstlane(tid_ >> 6);
    LAS unsigned* cnt = (LAS unsigned*)F.lds;
    LAS int* sidx = (LAS int*)(F.lds + 1024);
    const int nitems = (l == DEPTH - 1) ? 8 * NE : 16 * NE;
    const int tid = tid_, wave = wave_;
    const unsigned long long lt = (1ull << lane) - 1ull;
    for (int it = F.vcu; it < nitems; it += F.G) {
        const int set = it >> 4, e = it & 15; const bool latent = set < 8; const int N = latent ? SEQ : CTX, cap = latent ? CAPL : CAPC;
        const int rowbase = latent ? set * SEQ : NLAT + (set - 8) * CTX, xbase = latent ? set * CAPL : 8 * CAPL + (set - 8) * CAPC;
        const float* a = WSP(float, WS_AFF) + ((size_t)set * NE + e) * SEQ;
        unsigned key[4];
#pragma unroll
        for (int q = 0; q < 4; ++q) { const int i = q * 512 + tid; key[q] = i < N ? __builtin_bit_cast(unsigned, a[i]) : 0u; }
        unsigned T = 0u;
        for (int bit = 30; bit >= 0; --bit) {
            const unsigned cand = T | (1u << bit); unsigned c = 0;
#pragma unroll
            for (int q = 0; q < 4; ++q) c += (unsigned)__builtin_popcountll(__ballot(key[q] >= cand));
            LAS unsigned* cb = cnt + (bit & 1) * 8;
            if (lane == 0) cb[wave] = c;
            __syncthreads();
            unsigned tot = 0;
#pragma unroll
            for (int w = 0; w < 8; ++w) tot += cb[w];
            if (tot >= (unsigned)cap) T = cand;
        }
        LAS unsigned* cg = cnt + 64; LAS unsigned* ce = cnt + 96;
        unsigned long long bg[4], be[4];
#pragma unroll
        for (int q = 0; q < 4; ++q) { bg[q] = __ballot(key[q] > T); be[q] = __ballot(key[q] == T && key[q] != 0u);
            if (lane == 0) { cg[q * 8 + wave] = (unsigned)__builtin_popcountll(bg[q]); ce[q * 8 + wave] = (unsigned)__builtin_popcountll(be[q]); } }
        __syncthreads();
        unsigned ngt = 0;
        for (int c2 = 0; c2 < 32; ++c2) ngt += cg[c2];
        const unsigned need = (unsigned)cap - ngt;
        unsigned pre_g[4], pre_e[4];
        { unsigned rg = 0, re = 0;
#pragma unroll
          for (int q = 0; q < 4; ++q) { for (int w = 0; w < 8; ++w) { if (w == wave) { pre_g[q] = rg; pre_e[q] = re; } rg += cg[q * 8 + w]; re += ce[q * 8 + w]; } } }
        int* SEL = WSP(int, WS_SEL);
#pragma unroll
        for (int q = 0; q < 4; ++q) { const int i = q * 512 + tid;
            if (i < N) {
                const unsigned eb = pre_e[q] + (unsigned)__builtin_popcountll(be[q] & lt);
                const unsigned gb = pre_g[q] + (unsigned)__builtin_popcountll(bg[q] & lt);
                const bool isg = key[q] > T, ise = key[q] == T;
                const bool sel = isg || (ise && eb < need);
                const unsigned slot = gb + (eb < need ? eb : need);
                SEL[(size_t)(rowbase + i) * NE + e] = sel ? xbase + (int)slot : -1;
                if (sel) { WSP(float, WS_AFS)[(size_t)e * RPE + xbase + slot] = __builtin_bit_cast(float, key[q]); WSP(int, WS_IDX)[(size_t)e * RPE + xbase + slot] = rowbase + i; }
            } }
        __syncthreads();
    }
}
__device__ __forceinline__ void pj_combine(Frame& F, int l, int probe = 0) {
    int tid_ = threadIdx.x; asm volatile("" : "+v"(tid_));
    const int lane = tid_ & 63, wave_ = __builtin_amdgcn_readfirstlane(tid_ >> 6);
    const int gw = F.vcu * NWAVES + wave_, NGW = F.G * NWAVES; const bool last = l == DEPTH - 1;
    const int nrows = last ? NLAT : NTOK, rpw = (nrows + NGW - 1) / NGW, r0 = gw * rpw, r1 = r0 + rpw < nrows ? r0 + rpw : nrows;
    float* X = WSP(float, WS_X); const int* SEL = WSP(int, WS_SEL);
    const float* gnext = last ? inptr(F, IN_FINALG) : inptr(F, IN_NORM1G) + (l + 1) * DM;
    f32x4 va[4], vb[4], g2[4]; int sa = -1, sb = -1; ModVec m; int cset = -1;
    if (r0 < r1) { load_row_f32(va, X + (size_t)r0 * DM, lane); sa = lane < NE ? SEL[(size_t)r0 * NE + lane] : -1; }
    if (r0 + 1 < r1) { load_row_f32(vb, X + (size_t)(r0 + 1) * DM, lane); sb = lane < NE ? SEL[(size_t)(r0 + 1) * NE + lane] : -1; }
    for (int r = r0; r < r1; ++r) {
        f32x4 v[4], t[4];
#pragma unroll
        for (int j = 0; j < 4; ++j) { v[j] = va[j]; va[j] = vb[j]; t[j] = (f32x4){0.f, 0.f, 0.f, 0.f}; }
        const int selv = sa; sa = sb;
        if (r + 2 < r1) { load_row_f32(vb, X + (size_t)(r + 2) * DM, lane); sb = lane < NE ? SEL[(size_t)(r + 2) * NE + lane] : -1; }
        const int mset = row_modset(r);
        if (mset != cset) { const float* mod = WSP(float, WS_MOD) + ((size_t)l * 9 + mset) * 6 * DM; const float* mod1 = WSP(float, WS_MOD) + ((size_t)(last ? l : l + 1) * 9 + mset) * 6 * DM;
#pragma unroll
            for (int j = 0; j < 4; ++j) g2[j] = *(const f32x4*)(mod + 5 * DM + 4 * lane + 256 * j);
            load_modvec(m, gnext, last ? nullptr : mod1, last ? nullptr : mod1 + DM, lane); cset = mset; }
        for (int e = 0; e < NE; ++e) { const int se = __builtin_amdgcn_readlane(selv, e);
            if (se >= 0) { const GAS v2u* y = (const GAS v2u*)(WSP(bf16, WS_G) + ((size_t)e * RPE + se) * DM) + lane;
#pragma unroll
                for (int j = 0; j < 4; ++j) { const v2u w = y[64 * j]; t[j] += (f32x4){bflo(w.x), bfhi(w.x), bflo(w.y), bfhi(w.y)}; } } }
#pragma unroll
        for (int j = 0; j < 4; ++j) v[j] = v[j] + g2[j] * t[j];
        if (probe) { norm_row_m(v, m); asm volatile("" :: "v"(v[0]), "v"(v[1]), "v"(v[2]), "v"(v[3])); continue; }
        if (!last) {
#pragma unroll
            for (int j = 0; j < 4; ++j) *(f32x4*)(X + (size_t)r * DM + 4 * lane + 256 * j) = v[j];
            norm_row_m(v, m);
            store_row_bf16(WSP(bf16, WS_HN) + (size_t)r * DM, v, lane);
        } else {
            norm_row_m(v, m);
#pragma unroll
            for (int j = 0; j < 4; ++j) *(f32x4*)(F.out + (size_t)r * DM + 4 * lane + 256 * j) = v[j];
        }
    }
}

__device__ __forceinline__ void pc_mixers(Frame& F, int l, int rep) {
    int tid_ = threadIdx.x; asm volatile("" : "+v"(tid_));
    const int lane = tid_ & 63, wave_ = __builtin_amdgcn_readfirstlane(tid_ >> 6);
    const bool need_ctx = l < DEPTH - 1;
    {
        Strided<DecDft> S; S.d.Dm = (const char*)(F.ws + WS_DFT); S.d.Dc = (const char*)(F.ws + WS_DFTC); S.d.ABt = (const char*)(F.dout + DO_ABT); S.d.ABtc = (const char*)(F.dout + DO_ABTC);
        S.n = need_ctx ? 72 : 64; S.G = F.G; S.vcu = F.vcu;
        EpiStore E{WSP(bf16, WS_BR), DM};
        pg8::gemm_phase<EpiStore, Strided<DecDft>>(F.lds, (LAS int*)(F.lds + IDXBUF_OFF), S, E);
    }
    typedef attn_body::bf16 abf;
    const abf* Qg = (const abf*)(F.ws + WS_QKV + QKV_QG); const abf* Kg = (const abf*)(F.ws + WS_QKV + QKV_KG); const abf* Vg = (const abf*)(F.ws + WS_QKV + QKV_VG);
    const abf* Qw = (const abf*)(F.ws + WS_QKV + QKV_QW); const abf* Kw = (const abf*)(F.ws + WS_QKV + QKV_KW); const abf* Vw = (const abf*)(F.ws + WS_QKV + QKV_VW);
    abf* BR = (abf*)(F.ws + WS_BR);
    const int nGL = NBATCH * 2 * 32, nWL = NBATCH * 2 * 16, nGC = need_ctx ? NBATCH * 2 * 4 : 0, nWC = need_ctx ? NBATCH * 2 * 2 : 0, ntot = nGL + nWL + nGC + nWC;
    gu32* head = F.ctl + CW_QUEUE + 64 * (l + 2 * rep);
    const int wid = wave_;
    for (;;) {
        if (tid_ == 0) F.MISC[0] = __hip_atomic_fetch_add(head, 1u, RLX_AGENT);
        __syncthreads();
        const int a = (int)F.MISC[0];
        if (a >= ntot) break;
        if (a < nGL) {
            const int b = a >> 6, hkv = (a >> 5) & 1, qb = a & 31, head_ = hkv * 4 + (wid >> 1), q0 = qb * 64 + (wid & 1) * 32; const size_t qrow = (size_t)b * SEQ + q0;
            attn_body::attn_unit<0, 8>(Qg + qrow * 512 + head_ * 64, 512, Kg + (size_t)(NLAT + b * CTX) * 128 + hkv * 64, Kg + (size_t)b * SEQ * 128 + hkv * 64,
                                        Vg + (size_t)(NLAT + b * CTX) * 128 + hkv * 64, Vg + (size_t)b * SEQ * 128 + hkv * 64, 128, 4 + SEQ / 64, 0, 0, 0.f, BR + qrow * DM + 256 + head_ * 64, DM, F.ldsg);
        } else if (a < nGL + nWL) {
            const int u = a - nGL, b = u >> 5, hkv = (u >> 4) & 1, qb = u & 15, head_ = hkv * 2 + (wid >> 2), q0 = qb * 128 + (wid & 3) * 32; const size_t qrow = (size_t)b * SEQ + q0;
            const int band0 = qb * 128 - 128 < 0 ? 0 : qb * 128 - 128, band1 = qb * 128 + 256 > SEQ ? SEQ : qb * 128 + 256;
            attn_body::attn_unit<1, 8>(Qw + qrow * 256 + head_ * 64, 256, Kw + (size_t)(NLAT + b * CTX) * 128 + hkv * 64, Kw + ((size_t)b * SEQ + band0) * 128 + hkv * 64,
                                        Vw + (size_t)(NLAT + b * CTX) * 128 + hkv * 64, Vw + ((size_t)b * SEQ + band0) * 128 + hkv * 64, 128, 4 + (band1 - band0) / 64, q0, band0,
                                        inptr(F, IN_SINK)[l * 4 + head_] * LOG2E, BR + qrow * DM + 768 + head_ * 64, DM, F.ldsg);
        } else if (a < nGL + nWL + nGC) {
            const int u = a - nGL - nWL, b = u >> 3, hkv = (u >> 2) & 1, qb = u & 3, head_ = hkv * 4 + (wid >> 1); const size_t qrow = (size_t)NLAT + b * CTX + qb * 64 + (wid & 1) * 32;
            const abf* Kc = Kg + (size_t)(NLAT + b * CTX) * 128 + hkv * 64; const abf* Vc = Vg + (size_t)(NLAT + b * CTX) * 128 + hkv * 64;
            attn_body::attn_unit<0, 8>(Qg + qrow * 512 + head_ * 64, 512, Kc, Kc, Vc, Vc, 128, 4, 0, 0, 0.f, BR + qrow * DM + 256 + head_ * 64, DM, F.ldsg);
        } else {
            const int u = a - nGL - nWL - nGC, b = u >> 2, hkv = (u >> 1) & 1, qb = u & 1, head_ = hkv * 2 + (wid >> 2); const size_t qrow = (size_t)NLAT + b * CTX + qb * 128 + (wid & 3) * 32;
            const abf* Kc = Kw + (size_t)(NLAT + b * CTX) * 128 + hkv * 64; const abf* Vc = Vw + (size_t)(NLAT + b * CTX) * 128 + hkv * 64;
            attn_body::attn_unit<1, 8>(Qw + qrow * 256 + head_ * 64, 256, Kc, Kc, Vc, Vc, 128, 4, 0, 0, inptr(F, IN_SINK)[l * 4 + head_] * LOG2E, BR + qrow * DM + 768 + head_ * 64, DM, F.ldsg);
        }
    }
    __syncthreads();
}
#ifndef MK_N_LAUNCHES
#define MK_N_LAUNCHES 1
#endif
constexpr int N_PHASES = 2 + 9 * DEPTH;
struct Args { const float* in[21]; float* out; unsigned char* ws; int ph_lo, ph_hi, probe, pad_; };

__global__ void __launch_bounds__(NWAVES * 64, 2) hybrid_fwd(Args args) {
    extern __shared__ __attribute__((aligned(16))) unsigned char lds[];
    Frame F;
    F.lds = (LAS unsigned char*)lds; F.ldsg = (char*)lds; F.MISC = (volatile LAS unsigned*)(F.lds + MISC_OFF);
    F.G = gridDim.x; { const int bx = blockIdx.x; F.vcu = (F.G % 8 == 0) ? (bx % 8) * (F.G / 8) + bx / 8 : bx; }
    F.ws = args.ws; F.out = args.out; F.dout = (unsigned char*)args.out; F.ctl = (gu32*)(args.ws + WS_CTL);
    for (int u = threadIdx.x; u < (LDS_BYTES - LDSCTL_OFF) / 4; u += NWAVES * 64) ((LAS unsigned*)(F.lds + LDSCTL_OFF))[u] = 0u;
    __syncthreads();
    if (threadIdx.x < 21) *(LAS unsigned long long*)(F.lds + PTRS_OFF + 8 * threadIdx.x) = (unsigned long long)args.in[threadIdx.x];
    __syncthreads();
    XcdBarrier bar; bar.bar = (unsigned*)(F.ctl + CW_BAR); bar.x = 0; bar.st = nullptr;
    const int lo = args.ph_lo, hi = args.ph_hi;
    if (hi - lo > 1) bar = xcd_barrier_post((unsigned*)(F.ctl + CW_BAR), F.MISC + 8);
#ifndef PHSEL
#define PHSEL 0x7ff
#endif
#define IN(k) (lo <= (k) && (k) < hi)
#define KIND(j) ((PHSEL >> (j)) & 1)
#ifndef DBG_PROBE
#define DBG_PROBE 0
#endif
#ifndef FPROBE_MODE
#define FPROBE_MODE 0
#endif
#ifndef REP_MASK
#define REP_MASK 0
#endif
#define NREP(j, ok) ((((REP_MASK) >> (j)) & 1) && (ok) ? 2 : 1)
#define REPEAT(j, ok) for (int rep_ = 0, nrep_ = NREP(j, ok); rep_ < nrep_; ++rep_, (rep_ < nrep_ ? xcd_barrier(bar) : (void)0))
#define SEAM(k) do { if (IN(k) && IN((k) + 1)) xcd_barrier(bar); } while (0)

#ifdef BAR_PROBE
    if (hi - lo > 1) for (int i_ = 0; i_ < BAR_PROBE; ++i_) xcd_barrier(bar);
#endif
    if (KIND(0) && IN(0)) REPEAT(0, true) { p0_prologue(F); } SEAM(0);
    if (KIND(1) && IN(1)) REPEAT(1, true) { p1_norm1(F); } SEAM(1);
    for (int l = 0; l < DEPTH; ++l) {
        const int pb = 2 + 9 * l; const bool lastl = l == DEPTH - 1;
        const int nrt = lastl ? 64 : 72;
        if (KIND(2) && IN(pb + 0)) REPEAT(2, true) {
            Strided<DecInProj> S; S.d.A = (const char*)(F.ws + WS_HN); S.d.B = (const char*)(F.ws + WS_WIN) + (size_t)l * INW2 * DM * 2; S.d.layer = l; S.n = inproj_units(l); S.G = F.G; S.vcu = F.vcu;
            EpiInProj E; E.ABt = (bf16*)(F.dout + DO_ABT); E.ABtc = (bf16*)(F.dout + DO_ABTC);
            E.Qg = (bf16*)(F.ws + WS_QKV + QKV_QG); E.Kg = (bf16*)(F.ws + WS_QKV + QKV_KG); E.Vg = (bf16*)(F.ws + WS_QKV + QKV_VG);
            E.Qw = (bf16*)(F.ws + WS_QKV + QKV_QW); E.Kw = (bf16*)(F.ws + WS_QKV + QKV_KW); E.Vw = (bf16*)(F.ws + WS_QKV + QKV_VW);
            E.G = WSP(bf16, WS_G); E.rope = WSP(float, WS_ROPE); E.qng = inptr(F, IN_QNG) + l * 64; E.kng = inptr(F, IN_KNG) + l * 64;
            pg8::gemm_phase<EpiInProj, Strided<DecInProj>>(F.lds, (LAS int*)(F.lds + IDXBUF_OFF), S, E);
            if (l == 0 && F.G == 256 && F.vcu >= 88 && rep_ == 0) tail_convert(F, F.vcu - 88, 0, 4, 672);
        } SEAM(pb + 0);
        if (KIND(3) && IN(pb + 1)) REPEAT(3, true) { pc_mixers(F, l, rep_); } SEAM(pb + 1);
        if (KIND(4) && IN(pb + 2)) REPEAT(4, true) {
            SchedMerge S; S.BR = (const char*)(F.ws + WS_BR); S.W = (const char*)(F.ws + WS_WBR) + (size_t)l * DM * DM * 2; S.ntiles = nrt * 4; S.G = F.G; S.vcu = F.vcu;
            EpiMerge E{WSP(bf16, WS_G), (rep_ + 1 == nrep_ && !args.probe) ? (bf16*)(F.dout + DO_MB) : WSP(bf16, WS_HN), args.probe};
            pg8::gemm_phase<EpiMerge, SchedMerge>(F.lds, (LAS int*)(F.lds + IDXBUF_OFF), S, E);
            if (l == 0 && F.G == 256 && F.vcu >= 32 && rep_ == 0) tail_convert(F, F.vcu - 32, 672, 4, 1568);
        } SEAM(pb + 2);
        if (KIND(5) && IN(pb + 3)) REPEAT(5, l == 0) {
            Strided<DecWout> S; S.d.Mb = (const char*)(F.dout + DO_MB); S.d.W = (const char*)(F.ws + WS_WOUT) + (size_t)l * DM * DM * 2; S.n = nrt * 4; S.G = F.G; S.vcu = F.vcu;
            EpiWout E; E.baseL = l == 0 ? inptr(F, IN_X) : WSP(float, WS_X); E.baseC = l == 0 ? inptr(F, IN_CTX) - (size_t)NLAT * DM : WSP(float, WS_X); E.X = WSP(float, WS_X); E.mod = WSP(float, WS_MOD) + (size_t)l * 9 * 6 * DM;
            pg8::gemm_phase<EpiWout, Strided<DecWout>>(F.lds, (LAS int*)(F.lds + IDXBUF_OFF), S, E);
            if (l == 0 && F.G == 256 && F.vcu >= 32 && rep_ == 0) tail_convert(F, F.vcu - 32, 1568, 4, 2464);
        } SEAM(pb + 3);
        if (KIND(6) && IN(pb + 4)) REPEAT(6, true) { pf_norm2_router(F, l, rep_ ? FPROBE_MODE : 0); } SEAM(pb + 4);
        if (KIND(7) && IN(pb + 5)) REPEAT(7, true) { pg_topk_gather(F, l); } SEAM(pb + 5);
        const int ert = lastl ? 8 : 9;
        if (KIND(8) && IN(pb + 6)) REPEAT(8, true) {
            Strided<DecGU> S; S.d.H2 = (const char*)(F.ws + WS_HN); S.d.IDX = WSP(int, WS_IDX); S.d.W = (const char*)(F.ws + WS_WGU) + (size_t)l * NE * 2 * DM * DM * 2; S.d.nrt = ert; S.n = NE * ert * 8; S.G = F.G; S.vcu = F.vcu;
            EpiGU E{WSP(bf16, WS_HACT)};
            pg8::gemm_phase<EpiGU, Strided<DecGU>>(F.lds, (LAS int*)(F.lds + IDXBUF_OFF), S, E);
            if (l == 0 && F.G == 256 && F.vcu >= 128 && rep_ == 0) tail_convert(F, F.vcu - 128, 2464, 3, 2848);
        } SEAM(pb + 6);
        if (KIND(9) && IN(pb + 7)) REPEAT(9, true) {
            Strided<DecDown> S; S.d.H = (const char*)(F.ws + WS_HACT); S.d.W = (const char*)(F.ws + WS_WD) + (size_t)l * NE * DM * DM * 2; S.d.nrt = ert; S.n = NE * ert * 4; S.G = F.G; S.vcu = F.vcu;
            EpiDown E{WSP(bf16, WS_G), WSP(float, WS_AFS)};
            pg8::gemm_phase<EpiDown, Strided<DecDown>>(F.lds, (LAS int*)(F.lds + IDXBUF_OFF), S, E);
            if (l == 0 && F.G == 256 && F.vcu >= 64 && rep_ == 0) tail_convert(F, F.vcu - 64, 2848, 2, CONV_ITEMS);
        } SEAM(pb + 7);
        if (KIND(10) && IN(pb + 8)) REPEAT(10, true) { pj_combine(F, l, rep_); }
        if (!lastl) SEAM(pb + 8);
    }
#undef IN
#undef SEAM
}

extern "C" void kernel_launch(void* const* d_in, const int* in_sizes, int n_in, void* d_out, int out_size, void* d_ws, size_t ws_size, hipStream_t stream) {
    static int grid = 0;
    if (grid == 0) {
        if (n_in != 21 || out_size != NLAT * DM || ws_size < WS_END) { fprintf(stderr, "kernel_launch: unexpected problem (n_in %d, out %d, ws %zu < %zu)\n", n_in, out_size, ws_size, (size_t)WS_END); grid = -1; return; }
        int dev = 0, cus = 0, per_cu = 0;
        if (hipGetDevice(&dev) != hipSuccess || hipDeviceGetAttribute(&cus, hipDeviceAttributeMultiprocessorCount, dev) != hipSuccess) { grid = -1; return; }
        if (hipFuncSetAttribute((const void*)hybrid_fwd, hipFuncAttributeMaxDynamicSharedMemorySize, LDS_BYTES) != hipSuccess) { fprintf(stderr, "kernel_launch: hipFuncSetAttribute failed\n"); grid = -1; return; }
        if (hipOccupancyMaxActiveBlocksPerMultiprocessor(&per_cu, (const void*)hybrid_fwd, NWAVES * 64, LDS_BYTES) != hipSuccess || per_cu < 1) { fprintf(stderr, "kernel_launch: occupancy query says %d blocks/CU\n", per_cu); per_cu = 1; }
        (void)hipGetLastError();
        grid = cus * 1;
    }
    if (grid < 0) return;
    hipMemsetAsync((char*)d_ws + WS_CTL, 0, CTL_ZERO_BYTES, stream);
    Args a; memset(&a, 0, sizeof(a));
    for (int i = 0; i < 21; ++i) a.in[i] = (const float*)d_in[i];
    a.out = (float*)d_out; a.ws = (unsigned char*)d_ws;
#if MK_N_LAUNCHES == 1
    a.ph_lo = 0; a.ph_hi = N_PHASES;
    hipLaunchKernelGGL(hybrid_fwd, dim3(grid), dim3(NWAVES * 64), LDS_BYTES, stream, a);
#else
    for (int p = 0; p < N_PHASES; ++p) { a.ph_lo = p; a.ph_hi = p + 1; hipLaunchKernelGGL(hybrid_fwd, dim3(grid), dim3(NWAVES * 64), LDS_BYTES, stream, a);
#ifdef DBG_DUP_PHASE
        if (p == DBG_DUP_PHASE) { a.probe = DBG_PROBE; hipLaunchKernelGGL(hybrid_fwd, dim3(grid), dim3(NWAVES * 64), LDS_BYTES, stream, a); a.probe = 0; }
#endif
    }
#endif
}
```

```cpp
#define MK_N_LAUNCHES 1
#include <hip/hip_runtime.h>
#include <hip/hip_bf16.h>
#include <cstdio>
#include <cstdint>
#include <cmath>
#include <cstring>

constexpr int DM = 1024, NBATCH = 8, SEQ = 2048, CTX = 256, DEPTH = 2;
constexpr int NLAT = NBATCH * SEQ, NCTX = NBATCH * CTX, NTOK = NLAT + NCTX;
constexpr int INW = 4608, NCOLT = 19, INW2 = NCOLT * 256;
constexpr int NE = 16, CAPL = 256, CAPC = 32, RPE = NBATCH * (CAPL + CAPC);
constexpr float EPS = 1e-6f;
constexpr float QSCALE = 0.125f * 1.4426950408889634f;
constexpr float LOG2E = 1.4426950408889634f;
namespace pg8 {
#define PG8_LAS __attribute__((address_space(3)))
typedef unsigned short bf16_t;
typedef short bf16x8 __attribute__((ext_vector_type(8)));
typedef float f32x4 __attribute__((ext_vector_type(4)));
typedef unsigned u32x4 __attribute__((ext_vector_type(4)));
typedef unsigned u32x2 __attribute__((ext_vector_type(2)));
constexpr int BM = 256, BK = 64, HALF = 128, HTB = HALF * BK * 2  , STAGE_BYTES = 8 * HTB;

__host__ __device__ __forceinline__ int lds_byte(int r, int c) { const int st = (r >> 4) * 2 + (c >> 5), rr = r & 15, cc = c & 31, ob = rr * 64 + cc * 2; return st * 1024 + (ob ^ (((ob >> 9) & 1) << 5)); }
__host__ __device__ __forceinline__ void stage_rc(int b, int& R, int& C) { const int st = b / 1024, sb = b % 1024, swz = sb ^ (((sb >> 9) & 1) << 5); R = (st >> 1) * 16 + swz / 64; C = (st & 1) * 32 + (swz % 64) / 2; }

struct Unit { const char* A; const char* B; const int* arows; int ldA, ldB, nt; int pm, pn, tag; };

__device__ __forceinline__ unsigned cvt_pk_bf16(float lo, float hi) { unsigned r; asm volatile("v_cvt_pk_bf16_f32 %0, %1, %2" : "=v"(r) : "v"(lo), "v"(hi)); return r; }

template <class Epi, class Sched>
__device__ __forceinline__ void gemm_phase(PG8_LAS unsigned char* lds, PG8_LAS int* idxbuf  , const Sched& S, const Epi& E) {
    int tid = threadIdx.x; asm volatile("" : "+v"(tid));
    const int wid = __builtin_amdgcn_readfirstlane(tid >> 6), lane = tid & 63, wr = wid >> 2, wc = wid & 3, fr = lane & 15, fq = lane >> 4;
    unsigned Rr[2], Cc2[2];
#pragma unroll
    for (int i = 0; i < 2; ++i) { int R, C; stage_rc(tid * 16 + i * 8192, R, C); Rr[i] = (unsigned)R; Cc2[i] = (unsigned)C * 2u; }
    const size_t kstep = (size_t)(BK * 2);
    const unsigned ldsw = (unsigned)wid * 1024u;
    const int aoff = lds_byte(wr * 64 + fr, fq * 8), boff = lds_byte(wc * 32 + fr, fq * 8);
#define PG8_SA(b, h) (((b) * 2 + (h)) * HTB)
#define PG8_SB(b, h) ((4 + (b) * 2 + (h)) * HTB)
#define PG8_STAGE(bufoff, gbase, ld) do { _Pragma("unroll") for (int _i = 0; _i < 2; ++_i) \
        __builtin_amdgcn_global_load_lds((const unsigned*)((const char*)(gbase) + (Rr[_i] * (unsigned)(ld) + Cc2[_i])), (PG8_LAS unsigned*)(lds + (bufoff) + ldsw + _i * 8192), 16, 0, 0); } while (0)
#define PG8_STAGE_A(bufoff, gbase, ao) do { _Pragma("unroll") for (int _i = 0; _i < 2; ++_i) \
        __builtin_amdgcn_global_load_lds((const unsigned*)((const char*)(gbase) + (ao)[_i]), (PG8_LAS unsigned*)(lds + (bufoff) + ldsw + _i * 8192), 16, 0, 0); } while (0)
#define PG8_AOFF(u, ao) do { _Pragma("unroll") for (int _h = 0; _h < 2; ++_h) _Pragma("unroll") for (int _i = 0; _i < 2; ++_i) { \
        const unsigned _row = (u).arows ? (unsigned)idxbuf[Rr[_i] + 128 * _h] : Rr[_i] + 128u * _h; (ao)[_h][_i] = _row * (unsigned)(u).ldA + Cc2[_i]; } } while (0)
#define PG8_STAGE_IDX(u) do { if ((u).arows) __builtin_amdgcn_global_load_lds((const unsigned*)((u).arows + (wid & 3) * 64 + lane), (PG8_LAS unsigned*)((PG8_LAS unsigned char*)idxbuf + (wid & 3) * 256), 4, 0, 0); } while (0)
#define PG8_LDA(dst, b, h) do { _Pragma("unroll") for (int m = 0; m < 4; ++m) _Pragma("unroll") for (int k = 0; k < 2; ++k) dst[m][k] = *(const PG8_LAS bf16x8*)(lds + PG8_SA(b, h) + aoff + m * 2048 + k * 1024); } while (0)
#define PG8_LDB(dst, b, h) do { _Pragma("unroll") for (int n = 0; n < 2; ++n) _Pragma("unroll") for (int k = 0; k < 2; ++k) dst[n][k] = *(const PG8_LAS bf16x8*)(lds + PG8_SB(b, h) + boff + n * 2048 + k * 1024); } while (0)
#define PG8_MMA(ai, bj, At, Bt) do { __builtin_amdgcn_s_setprio(1); _Pragma("unroll") for (int m = 0; m < 4; ++m) _Pragma("unroll") for (int n = 0; n < 2; ++n) _Pragma("unroll") for (int k = 0; k < 2; ++k) \
        acc[ai][bj][m][n] = __builtin_amdgcn_mfma_f32_16x16x32_bf16(Bt[n][k], At[m][k], acc[ai][bj][m][n], 0, 0, 0); __builtin_amdgcn_s_setprio(0); } while (0)
#define PG8_WAIT_V(n) asm volatile("s_waitcnt vmcnt(" #n ")" ::: "memory")
#define PG8_WAIT_L(n) asm volatile("s_waitcnt lgkmcnt(" #n ")" ::: "memory")
#define PG8_BAR __builtin_amdgcn_s_barrier()
#define PG8_SCHED __builtin_amdgcn_sched_barrier(0)
    Unit cur, nxt; int ui = 0;
    if (!S.next(0, cur)) return;
    nxt = cur;
    f32x4 acc[2][2][4][2];
#pragma unroll
    for (int a = 0; a < 2; ++a)
#pragma unroll
        for (int b = 0; b < 2; ++b)
#pragma unroll
            for (int m = 0; m < 4; ++m)
#pragma unroll
                for (int n = 0; n < 2; ++n) acc[a][b][m][n] = (f32x4){0.f, 0.f, 0.f, 0.f};
    bf16x8 At[4][2], B0[2][2], B1[2][2];
    const char* cA = cur.A; const char* cB = cur.B; int clb = cur.ldB;
    unsigned ao_c[2][2], ao_n[2][2];
    if (cur.arows) { PG8_STAGE_IDX(cur); PG8_WAIT_V(0); PG8_BAR; }
    PG8_AOFF(cur, ao_c);
#pragma unroll
    for (int _h = 0; _h < 2; ++_h)
#pragma unroll
        for (int _i = 0; _i < 2; ++_i) ao_n[_h][_i] = ao_c[_h][_i];
    if (cur.arows) { PG8_WAIT_L(0); PG8_BAR; }
    {
        const size_t hB = (size_t)HALF * clb;
        PG8_STAGE(PG8_SB(0, 0), cB, clb); PG8_STAGE(PG8_SB(0, 1), cB + hB, clb); PG8_STAGE_A(PG8_SA(0, 0), cA, ao_c[0]); PG8_STAGE_A(PG8_SA(0, 1), cA, ao_c[1]);
        if (wr == 1) PG8_BAR;
        PG8_WAIT_V(2); PG8_BAR;
        PG8_STAGE(PG8_SB(1, 0), cB + kstep, clb); PG8_STAGE_A(PG8_SA(1, 0), cA + kstep, ao_c[0]); PG8_STAGE(PG8_SB(1, 1), cB + hB + kstep, clb);
        PG8_WAIT_V(6); PG8_BAR;
    }
    for (;;) {
        const bool has_next = S.next(ui + 1, nxt);
        const char* nA = has_next ? nxt.A : cA; const char* nB = has_next ? nxt.B : cB; const int nlb = has_next ? nxt.ldB : clb;
        const int nt = cur.nt;
        if (has_next) PG8_STAGE_IDX(nxt);
        for (int t = 0; t < nt; t += 2) {
            const bool last = (t == nt - 2);
            if (last) { if (has_next) { PG8_AOFF(nxt, ao_n); } else {
#pragma unroll
                for (int _h = 0; _h < 2; ++_h)
#pragma unroll
                    for (int _i = 0; _i < 2; ++_i) ao_n[_h][_i] = ao_c[_h][_i]; } }
            unsigned ao2[2][2];
#pragma unroll
            for (int _h = 0; _h < 2; ++_h)
#pragma unroll
                for (int _i = 0; _i < 2; ++_i) ao2[_h][_i] = last ? ao_n[_h][_i] : ao_c[_h][_i];
            const char* a1 = cA + (size_t)(t + 1) * kstep;
            const char* a2 = last ? nA : cA + (size_t)(t + 2) * kstep; const char* b2 = last ? nB : cB + (size_t)(t + 2) * kstep;
            const int lb2 = last ? nlb : clb;
            const size_t hB2 = (size_t)HALF * lb2;
            const char* a3 = a2 + kstep; const char* b3 = b2 + kstep;
            PG8_LDB(B0, 0, 0); PG8_LDB(B1, 0, 1); PG8_SCHED; PG8_LDA(At, 0, 0); PG8_STAGE_A(PG8_SA(1, 1), a1, ao_c[1]);
            PG8_WAIT_V(8); PG8_WAIT_L(0); PG8_BAR; PG8_MMA(0, 0, At, B0); PG8_MMA(0, 1, At, B1); PG8_BAR; PG8_SCHED;
            PG8_LDA(At, 0, 1); PG8_STAGE(PG8_SB(0, 0), b2, lb2); PG8_STAGE(PG8_SB(0, 1), b2 + hB2, lb2); PG8_STAGE_A(PG8_SA(0, 0), a2, ao2[0]);
            PG8_WAIT_V(8); PG8_WAIT_L(0); PG8_BAR; PG8_MMA(1, 0, At, B0); PG8_MMA(1, 1, At, B1); PG8_BAR; PG8_SCHED;
            PG8_LDB(B0, 1, 0); PG8_LDB(B1, 1, 1); PG8_SCHED; PG8_LDA(At, 1, 0); PG8_STAGE_A(PG8_SA(0, 1), a2, ao2[1]);
            PG8_WAIT_V(8); PG8_WAIT_L(0); PG8_BAR; PG8_MMA(0, 0, At, B0); PG8_MMA(0, 1, At, B1); PG8_BAR; PG8_SCHED;
            PG8_LDA(At, 1, 1); PG8_STAGE(PG8_SB(1, 0), b3, lb2); PG8_STAGE(PG8_SB(1, 1), b3 + hB2, lb2); PG8_STAGE_A(PG8_SA(1, 0), a3, ao2[0]);
            PG8_WAIT_V(8); PG8_WAIT_L(0); PG8_BAR; PG8_MMA(1, 0, At, B0); PG8_MMA(1, 1, At, B1); PG8_BAR; PG8_SCHED;
        }
        if (wr == 0) PG8_BAR;
        bool keep_acc;
        { Unit eu = cur; int ewr = wr, ewc = wc, efr = fr, efq = fq; asm volatile("" : "+s"(eu.pm), "+s"(eu.pn), "+s"(eu.tag), "+s"(ewr), "+s"(ewc), "+v"(efr), "+v"(efq));
          keep_acc = E(acc, eu, ewr, ewc, efr, efq); }
        if (!has_next) break;
        if (!keep_acc) {
#pragma unroll
        for (int a = 0; a < 2; ++a)
#pragma unroll
            for (int b = 0; b < 2; ++b)
#pragma unroll
                for (int m = 0; m < 4; ++m)
#pragma unroll
                    for (int n = 0; n < 2; ++n) acc[a][b][m][n] = (f32x4){0.f, 0.f, 0.f, 0.f};
        }
        cur = nxt; cA = nA; cB = nB; clb = nlb; ++ui;
#pragma unroll
        for (int _h = 0; _h < 2; ++_h)
#pragma unroll
            for (int _i = 0; _i < 2; ++_i) ao_c[_h][_i] = ao_n[_h][_i];
        if (wr == 1) PG8_BAR;
    }
    PG8_WAIT_V(0);
    PG8_BAR;
#undef PG8_SA
#undef PG8_SB
#undef PG8_STAGE
#undef PG8_STAGE_A
#undef PG8_AOFF
#undef PG8_STAGE_IDX
#undef PG8_LDA
#undef PG8_LDB
#undef PG8_MMA
#undef PG8_WAIT_V
#undef PG8_WAIT_L
#undef PG8_BAR
#undef PG8_SCHED
}
}
#include <hip/hip_bf16.h>
#include <cmath>
namespace attn_body {
using bf16=__hip_bfloat16;
using bf16x8=__attribute__((ext_vector_type(8)))short;
using s16x4=__attribute__((ext_vector_type(4)))short;
using f32x16=__attribute__((ext_vector_type(16)))float;
using u32x4=__attribute__((ext_vector_type(4)))unsigned;
constexpr int D=64;
constexpr int NW=8,QBLK=32,KVBLK=64,NCT=4;
__device__ __forceinline__ int crow(int r,int hi){return (r&3)+8*(r>>2)+4*hi;}
#define SBAR() __builtin_amdgcn_sched_barrier(0)
__device__ __forceinline__ void wmask(f32x16&p0,f32x16&p1,int kb,int qabs,int hi){
  const float NEG=-INFINITY; const int d0=kb+4*hi-qabs;
  #pragma unroll
  for(int r=0;r<16;++r){int dd=d0+(r&3)+8*(r>>2); if(dd>128||dd<-128)p0[r]=NEG; if(dd+32>128||dd+32<-128)p1[r]=NEG;}
}

constexpr int NSLOT=3, SLOTB=8192;
constexpr int LDS_K=0, LDS_V=NSLOT*SLOTB, LDS_WS=2*NSLOT*SLOTB, LDS_OST=LDS_WS+NW*64*4, LDS_BYTES=LDS_OST+NW*4096;
__device__ __forceinline__ void glds16(const void*gsrc,unsigned lds_dst){unsigned keep;
  asm volatile("s_mov_b32 %0, m0\n\ts_mov_b32 m0, %2\n\ts_nop 0\n\tglobal_load_lds_dwordx4 %1, off\n\ts_mov_b32 m0, %0":"=&s"(keep):"v"(gsrc),"s"(lds_dst):"memory");}
__device__ __forceinline__ float max3f(float a,float b,float c){float r;asm("v_max3_f32 %0, %1, %2, %3":"=v"(r):"v"(a),"v"(b),"v"(c));return r;}
__device__ __forceinline__ float max2f(float a,float b){float r;asm("v_max_f32_e32 %0, %1, %2":"=v"(r):"v"(a),"v"(b));return r;}
__device__ __forceinline__ float fadd_s(float a,float b){float r;asm("v_add_f32_e32 %0, %1, %2":"=v"(r):"v"(a),"v"(b));return r;}
__device__ __forceinline__ float fsub_s(float a,float b){float r;asm("v_sub_f32_e32 %0, %1, %2":"=v"(r):"v"(a),"v"(b));return r;}
typedef float f32x2_t __attribute__((ext_vector_type(2))); typedef __bf16 bf16x2_t __attribute__((ext_vector_type(2)));
__device__ __forceinline__ unsigned cvtpk_s(float lo,float hi){f32x2_t v={lo,hi};bf16x2_t b=__builtin_convertvector(v,bf16x2_t);return __builtin_bit_cast(unsigned,b);}
#define WAIT_BAR(N) asm volatile("s_waitcnt vmcnt(" #N ") lgkmcnt(0)\n\ts_barrier":::"memory")

__device__ __forceinline__ void qkt(f32x16&p0,f32x16&p1,const char*Kslot,const bf16x8*qr,const f32x16&negm,int r32,int hi){
  const char*kb=Kslot+hi*1024+r32*16;
  #pragma unroll
  for(int d0=0;d0<4;++d0){
    const bf16x8 b0=*reinterpret_cast<const bf16x8*>(kb+d0*2048);
    const bf16x8 b1=*reinterpret_cast<const bf16x8*>(kb+d0*2048+512);
    if(d0==0){p0=__builtin_amdgcn_mfma_f32_32x32x16_bf16(b0,qr[0],negm,0,0,0);p1=__builtin_amdgcn_mfma_f32_32x32x16_bf16(b1,qr[0],negm,0,0,0);}
    else{p0=__builtin_amdgcn_mfma_f32_32x32x16_bf16(b0,qr[d0],p0,0,0,0);p1=__builtin_amdgcn_mfma_f32_32x32x16_bf16(b1,qr[d0],p1,0,0,0);}}
}
typedef __attribute__((address_space(3))) const char* lds_cptr;
typedef short v4i16_t __attribute__((ext_vector_type(4)));
__device__ __forceinline__ void kload8(bf16x8*kf,lds_cptr kp){
  kf[0]=*(const __attribute__((address_space(3))) bf16x8*)(kp);      kf[1]=*(const __attribute__((address_space(3))) bf16x8*)(kp+512);
  kf[2]=*(const __attribute__((address_space(3))) bf16x8*)(kp+2048); kf[3]=*(const __attribute__((address_space(3))) bf16x8*)(kp+2560);
  kf[4]=*(const __attribute__((address_space(3))) bf16x8*)(kp+4096); kf[5]=*(const __attribute__((address_space(3))) bf16x8*)(kp+4608);
  kf[6]=*(const __attribute__((address_space(3))) bf16x8*)(kp+6144); kf[7]=*(const __attribute__((address_space(3))) bf16x8*)(kp+6656);
}
__device__ __forceinline__ void kload2(bf16x8*kf,lds_cptr kp,int j){ kf[2*j]=*(const __attribute__((address_space(3))) bf16x8*)(kp+j*2048); kf[2*j+1]=*(const __attribute__((address_space(3))) bf16x8*)(kp+j*2048+512); }
__device__ __forceinline__ s16x4 vtr(lds_cptr p){ return __builtin_bit_cast(s16x4,__builtin_amdgcn_ds_read_tr16_b64_v4i16((__attribute__((address_space(3))) v4i16_t*)p)); }
__device__ __forceinline__ float rowmax(const f32x16&p0,const f32x16&p1){
  float a=max3f(p0[0],p0[1],p1[0]),b=max3f(p0[2],p0[3],p1[1]);a=max3f(a,p1[2],p1[3]);
  #pragma unroll
  for(int r=4;r<16;r+=4){a=max3f(a,p0[r],p0[r+1]);b=max3f(b,p0[r+2],p0[r+3]);a=max3f(a,p1[r],p1[r+1]);b=max3f(b,p1[r+2],p1[r+3]);}
  const float m=max2f(a,b);
  auto rr=__builtin_amdgcn_permlane32_swap(__float_as_uint(m),__float_as_uint(m),false,false);
  return max2f(__uint_as_float(rr[0]),__uint_as_float(rr[1]));
}
__device__ __forceinline__ void pv(f32x16*o,int vb,bf16x8 pa0,bf16x8 pa1,bf16x8 pa2,bf16x8 pa3){
  #pragma unroll
  for(int d0=0;d0<2;++d0){s16x4 lo[4],hi[4];
    #pragma unroll
    for(int ks=0;ks<4;++ks){
      asm volatile("ds_read_b64_tr_b16 %0,%1 offset:%c2":"=&v"(lo[ks]):"v"(vb),"i"(d0*4096+ks*1024):"memory");
      asm volatile("ds_read_b64_tr_b16 %0,%1 offset:%c2":"=&v"(hi[ks]):"v"(vb),"i"(d0*4096+ks*1024+512):"memory");}
    asm volatile("s_waitcnt lgkmcnt(0)":::"memory");SBAR();
    #define PK(k) (bf16x8){lo[k][0],lo[k][1],lo[k][2],lo[k][3],hi[k][0],hi[k][1],hi[k][2],hi[k][3]}
    o[d0]=__builtin_amdgcn_mfma_f32_32x32x16_bf16(pa0,PK(0),o[d0],0,0,0);
    o[d0]=__builtin_amdgcn_mfma_f32_32x32x16_bf16(pa1,PK(1),o[d0],0,0,0);
    o[d0]=__builtin_amdgcn_mfma_f32_32x32x16_bf16(pa2,PK(2),o[d0],0,0,0);
    o[d0]=__builtin_amdgcn_mfma_f32_32x32x16_bf16(pa3,PK(3),o[d0],0,0,0);
    #undef PK
  }
}

#ifndef ATTN_STORE16
#define ATTN_STORE16(p,v) (*(u32x4*)(p)=(v))
#endif
template<int MODE,int THRL> __device__ __forceinline__ void attn_unit(const bf16*Qw,int qp,const bf16*Kc,const bf16*Kl,const bf16*Vc,const bf16*Vl,int kp,int NT,int qabs,int band0,float sinkl2,bf16*Ow,int op,char*shm){
  int tid=threadIdx.x; asm volatile("":"+v"(tid));
  const int lane=tid&63,r32=lane&31,hi=lane>>5; const int wid=__builtin_amdgcn_readfirstlane(tid>>6);
  qabs+=r32;
  const unsigned lds0=(unsigned)(uintptr_t)shm;
  float*wsf=(float*)(shm+LDS_WS)+wid*64;
  const unsigned koff_=(unsigned)(lane*kp+wid*8)*2u;
  const unsigned voff_=(unsigned)((16*(wid&3)+(lane>>2))*kp+(wid>>2)*32+(lane&3)*8)*2u;
  const unsigned kdst=lds0+LDS_K+wid*1024, vdst=lds0+LDS_V+wid*1024;
  #define DMA_K(t,slot) glds16((const char*)((t)<NCT?Kc+(long)(t)*KVBLK*kp:Kl+(long)((t)-NCT)*KVBLK*kp)+koff_,(unsigned)__builtin_amdgcn_readfirstlane(kdst+(slot)))
  #define DMA_V(t,slot) glds16((const char*)((t)<NCT?Vc+(long)(t)*KVBLK*kp:Vl+(long)((t)-NCT)*KVBLK*kp)+voff_,(unsigned)__builtin_amdgcn_readfirstlane(vdst+(slot)))
  const int vb0=(int)(lds0+LDS_V)+((lane>>4)&1)*32+(lane&3)*8+(4*hi+((lane&15)>>2))*64;
  const char*Kbase=shm+LDS_K; bf16x8 kf[8];
  const lds_cptr shm3=(lds_cptr)shm; const lds_cptr kp0=shm3+LDS_K+hi*1024+r32*16; const lds_cptr vp0=shm3+LDS_V+((lane>>4)&1)*32+(lane&3)*8+(4*hi+((lane&15)>>2))*64;
  DMA_K(0,0);DMA_V(0,0);DMA_K(1,SLOTB);
  bf16x8 qr[4];
  #pragma unroll
  for(int d0=0;d0<4;++d0)qr[d0]=*reinterpret_cast<const bf16x8*>(&Qw[(long)r32*qp+d0*16+hi*8]);
  float mhat=0.f,l_reg=0.f;f32x16 o[2];o[0]=f32x16{};o[1]=f32x16{};f32x16 negm=f32x16{};asm volatile("":"+v"(negm));
  #define CMASK(P0,P1,t) do{ if(MODE==1){ if((t)>=NCT)wmask(P0,P1,band0+KVBLK*((t)-NCT),qabs,hi);} }while(0)
  bool resc=false;
  #define START(P0,P1) do{ const float rm=rowmax(P0,P1); resc=false; \
    { const float dl=rm; mhat=fadd_s(mhat,dl); \
      _Pragma("unroll") for(int r=0;r<16;++r){P0[r]=fsub_s(P0[r],dl);P1[r]=fsub_s(P1[r],dl);} \
      _Pragma("unroll") for(int r=0;r<16;++r)negm[r]=-mhat; asm volatile("":"+v"(negm)); } \
    _Pragma("unroll") for(int r=0;r<16;++r)P0[r]=__builtin_amdgcn_exp2f(P0[r]); }while(0)
  #define RESC() do{ if(resc){ asm volatile("s_waitcnt lgkmcnt(0)":::"memory"); \
      _Pragma("unroll") for(int d_=0;d_<2;++d_) _Pragma("unroll") for(int r=0;r<16;++r)o[d_][r]*=wsf[crow(r,hi)]; } }while(0)
  f32x16 pA0,pA1,pB0,pB1;
  int sl_prev=0,sl_cur=0,sl_next=SLOTB;
  #define ROT() do{sl_prev=sl_cur;sl_cur=sl_next;sl_next=(sl_next==(NSLOT-1)*SLOTB)?0:sl_next+SLOTB;}while(0)
  DMA_K(2,2*SLOTB);
  WAIT_BAR(3);
  qkt(pA0,pA1,Kbase,qr,negm,r32,hi);asm volatile("s_nop 15\n\ts_nop 7":"+v"(pA0),"+v"(pA1));CMASK(pA0,pA1,0);
  START(pA0,pA1);
  _Pragma("unroll") for(int r=0;r<16;++r)pA1[r]=__builtin_amdgcn_exp2f(pA1[r]);
  WAIT_BAR(0);
  DMA_K(3,0);DMA_V(1,SLOTB);
  ROT();
  kload8(kf,kp0+sl_cur);
  WAIT_BAR(2);
  s16x4 vlo[8],vhi[8]; u32x4 pw0,pw1,pw2,pw3;
  #define PKW(P,B) cvtpk_s(P[B],P[B+1])
  #define PAF(k) __builtin_bit_cast(bf16x8,pw##k)
  #define VFR(i) (bf16x8){vlo[i][0],vlo[i][1],vlo[i][2],vlo[i][3],vhi[i][0],vhi[i][1],vhi[i][2],vhi[i][3]}
  #define PIN(x) asm volatile("":"+v"(x))
  #define MX3(a,b,c) __builtin_fmaxf(__builtin_fmaxf((a),(b)),(c))
  #define GAPA(MF,A0,A1,A2,A3,W0,W1,PW) do{ MF; sacc+=A0; sacc+=A1; sacc+=A2; sacc+=A3; PIN(sacc); W0; W1; PIN(PW); SBAR(); }while(0)
  #define EX(v) __builtin_amdgcn_exp2f(v)
  #define GAPB(MF,X,B) do{ MF; X[B]=EX(X[B]); X[B+1]=EX(X[B+1]); X[B+2]=EX(X[B+2]); X[B+3]=EX(X[B+3]); PIN(X); SBAR(); }while(0)
  #define VRD(i) do{ vlo[i]=vtr(vp_+(((i)>>2)*4096+((i)&3)*1024)); vhi[i]=vtr(vp_+(((i)>>2)*4096+((i)&3)*1024+512)); }while(0)
  #define KRD(G,j) do{ if(G){ kload2(kf,kp0+sl_next,j); SBAR(); } }while(0)
  #define STEP(C0,C1,P0,P1,t,GK,GV,GL) do{ SBAR(); \
    const lds_cptr vp_=vp0+sl_prev; \
    VRD(0); SBAR(); float sacc=(P0[0]+P0[1]); \
    GAPA(C0=__builtin_amdgcn_mfma_f32_32x32x16_bf16(kf[0],qr[0],negm,0,0,0), P0[2],P0[3],P0[4],P0[5],     pw0[0]=PKW(P0,0), pw0[1]=PKW(P0,2), pw0); \
    VRD(4); SBAR(); GAPA(C1=__builtin_amdgcn_mfma_f32_32x32x16_bf16(kf[1],qr[0],negm,0,0,0), P0[6],P0[7],P0[8],P0[9],     pw0[2]=PKW(P0,4), pw0[3]=PKW(P0,6), pw0); \
    VRD(1); SBAR(); GAPA(C0=__builtin_amdgcn_mfma_f32_32x32x16_bf16(kf[2],qr[1],C0,0,0,0),   P0[10],P0[11],P0[12],P0[13], pw1[0]=PKW(P0,8), pw1[1]=PKW(P0,10), pw1); \
    VRD(5); SBAR(); GAPA(C1=__builtin_amdgcn_mfma_f32_32x32x16_bf16(kf[3],qr[1],C1,0,0,0),   P0[14],P0[15],P1[0],P1[1],   pw1[2]=PKW(P0,12),pw1[3]=PKW(P0,14), pw1); \
    VRD(2); SBAR(); GAPA(C0=__builtin_amdgcn_mfma_f32_32x32x16_bf16(kf[4],qr[2],C0,0,0,0),   P1[2],P1[3],P1[4],P1[5],     pw2[0]=PKW(P1,0), pw2[1]=PKW(P1,2), pw2); \
    VRD(6); SBAR(); GAPA(C1=__builtin_amdgcn_mfma_f32_32x32x16_bf16(kf[5],qr[2],C1,0,0,0),   P1[6],P1[7],P1[8],P1[9],     pw2[2]=PKW(P1,4), pw2[3]=PKW(P1,6), pw2); \
    VRD(3); SBAR(); GAPA(C0=__builtin_amdgcn_mfma_f32_32x32x16_bf16(kf[6],qr[3],C0,0,0,0),   P1[10],P1[11],P1[12],P1[13], pw3[0]=PKW(P1,8), pw3[1]=PKW(P1,10), pw3); \
    VRD(7); SBAR(); GAPA(C1=__builtin_amdgcn_mfma_f32_32x32x16_bf16(kf[7],qr[3],C1,0,0,0),   P1[14],P1[15],0.f,0.f,       pw3[2]=PKW(P1,12),pw3[3]=PKW(P1,14), pw3); \
    l_reg+=sacc; \
    if(GK){DMA_K((t)+3,sl_cur);} if(GV){DMA_V((t)+1,sl_next);} \
    CMASK(C0,C1,t); \
    { float a=MX3(C0[0],C0[1],C1[0]),b=MX3(C0[2],C0[3],C1[1]); a=MX3(a,C1[2],C1[3]); \
      _Pragma("unroll") for(int r=4;r<16;r+=4){a=MX3(a,C0[r],C0[r+1]);b=MX3(b,C0[r+2],C0[r+3]);a=MX3(a,C1[r],C1[r+1]);b=MX3(b,C1[r+2],C1[r+3]);} \
      float rm=__builtin_fmaxf(a,b); { auto rr=__builtin_amdgcn_permlane32_swap(__float_as_uint(rm),__float_as_uint(rm),false,false); rm=__builtin_fmaxf(__uint_as_float(rr[0]),__uint_as_float(rr[1])); } \
      resc=false; \
      if(__builtin_expect(__any(rm>(float)THRL),0)){ const float dl=__builtin_fmaxf(rm,0.f); mhat+=dl; \
        _Pragma("unroll") for(int r=0;r<16;++r){C0[r]-=dl;C1[r]-=dl;} \
        _Pragma("unroll") for(int r=0;r<16;++r)negm[r]=-mhat; asm volatile("":"+v"(negm)); \
        const float f=__builtin_amdgcn_exp2f(-dl); l_reg*=f; if(hi==0)wsf[r32]=f; resc=true; } } \
    SBAR(); \
    GAPB(o[0]=__builtin_amdgcn_mfma_f32_32x32x16_bf16(PAF(0),VFR(0),o[0],0,0,0), C0,0); \
    GAPB(o[1]=__builtin_amdgcn_mfma_f32_32x32x16_bf16(PAF(0),VFR(4),o[1],0,0,0), C0,4); \
    KRD(GL,0); GAPB(o[0]=__builtin_amdgcn_mfma_f32_32x32x16_bf16(PAF(1),VFR(1),o[0],0,0,0), C0,8); \
    KRD(GL,1); GAPB(o[1]=__builtin_amdgcn_mfma_f32_32x32x16_bf16(PAF(1),VFR(5),o[1],0,0,0), C0,12); \
    KRD(GL,2); GAPB(o[0]=__builtin_amdgcn_mfma_f32_32x32x16_bf16(PAF(2),VFR(2),o[0],0,0,0), C1,0); \
    KRD(GL,3); GAPB(o[1]=__builtin_amdgcn_mfma_f32_32x32x16_bf16(PAF(2),VFR(6),o[1],0,0,0), C1,4); \
    GAPB(o[0]=__builtin_amdgcn_mfma_f32_32x32x16_bf16(PAF(3),VFR(3),o[0],0,0,0), C1,8); \
    GAPB(o[1]=__builtin_amdgcn_mfma_f32_32x32x16_bf16(PAF(3),VFR(7),o[1],0,0,0), C1,12); \
    }while(0)
  int t=1;
  for(;t+5<NT;t+=2){
    STEP(pB0,pB1,pA0,pA1,t,true,true,true);     WAIT_BAR(2); RESC(); ROT();
    STEP(pA0,pA1,pB0,pB1,t+1,true,true,true);   WAIT_BAR(2); RESC(); ROT();
  }
  #define ENDW(tt) do{ if((tt)+3<NT){WAIT_BAR(2);} else if((tt)+2<NT){WAIT_BAR(1);} else {WAIT_BAR(0);} }while(0)
  for(;t+1<NT;t+=2){
    STEP(pB0,pB1,pA0,pA1,t,(t+3<NT),(t+1<NT),(t+1<NT));       ENDW(t);   RESC(); ROT();
    STEP(pA0,pA1,pB0,pB1,t+1,(t+4<NT),(t+2<NT),(t+2<NT));     ENDW(t+1); RESC(); ROT();
  }
  STEP(pB0,pB1,pA0,pA1,NT-1,false,false,false); RESC();
  { float sacc=pB0[0]+pB0[1]; _Pragma("unroll") for(int r=2;r<16;++r)sacc+=pB0[r]; _Pragma("unroll") for(int r=0;r<16;++r)sacc+=pB1[r]; l_reg+=sacc;
    pw0=(u32x4){PKW(pB0,0),PKW(pB0,2),PKW(pB0,4),PKW(pB0,6)};pw1=(u32x4){PKW(pB0,8),PKW(pB0,10),PKW(pB0,12),PKW(pB0,14)};pw2=(u32x4){PKW(pB1,0),PKW(pB1,2),PKW(pB1,4),PKW(pB1,6)};pw3=(u32x4){PKW(pB1,8),PKW(pB1,10),PKW(pB1,12),PKW(pB1,14)};
    SBAR(); pv(o,vb0+sl_cur,PAF(0),PAF(1),PAF(2),PAF(3)); }
  #undef PKW
  #undef PAF
  #undef VFR
  #undef PIN
  #undef MX3
  #undef GAPA
  #undef GAPB
  #undef EX
  #undef VRD
  #undef KRD
  #undef STEP
  #undef ENDW
  {auto rr=__builtin_amdgcn_permlane32_swap(__float_as_uint(l_reg),__float_as_uint(l_reg),false,false);l_reg=__uint_as_float(rr[0])+__uint_as_float(rr[1]);}
  if(MODE==1)l_reg+=__builtin_amdgcn_exp2f(sinkl2-mhat);
  if(hi==0)wsf[32+r32]=l_reg;asm volatile("s_waitcnt lgkmcnt(0)":::"memory");
  float rli[16];
  #pragma unroll
  for(int r=0;r<16;++r)rli[r]=__builtin_amdgcn_rcpf(wsf[32+crow(r,hi)]);
  { bf16*stg=(bf16*)(shm+LDS_OST)+wid*2048;
    #pragma unroll
    for(int r=0;r<16;++r){const int orow=crow(r,hi);
      #pragma unroll
      for(int d0=0;d0<2;++d0)stg[orow*64+d0*32+r32]=__float2bfloat16(o[d0][r]*rli[r]);}
    asm volatile("s_waitcnt lgkmcnt(0)":::"memory");
    #pragma unroll
    for(int i=0;i<4;++i){const int row=i*8+(lane>>3),ch=lane&7; const u32x4 v=*(const u32x4*)(stg+row*64+ch*8); ATTN_STORE16(Ow+(long)row*op+ch*8,v);} }
  asm volatile("s_waitcnt lgkmcnt(0)\n\ts_barrier":::"memory");
  #undef DMA_K
  #undef DMA_V
  #undef CMASK
  #undef START
  #undef RESC
  #undef ROT
}
constexpr int ATTN_LDS_BYTES=LDS_BYTES;
#undef SBAR
#undef WAIT_BAR
}
constexpr int NWAVES = 8;
constexpr size_t MiB = 1u << 20;
constexpr size_t WS_CTL = 0, CTL_ZERO_BYTES = 256 * 1024;
constexpr size_t WS_MOD = 1 * MiB;
constexpr size_t WS_ROPE = WS_MOD + 512 * 1024;
constexpr size_t WS_AFS = WS_ROPE + 64 * 1024;
constexpr size_t WS_IDX = WS_AFS + 192 * 1024;
constexpr size_t WS_SEL = 2 * MiB;
constexpr size_t WS_AFF = 4 * MiB;
constexpr size_t WS_WIN = 8 * MiB;
constexpr size_t WS_WBR = 28 * MiB;
constexpr size_t WS_WOUT = 32 * MiB;
constexpr size_t WS_DFT = 36 * MiB;
constexpr size_t WS_DFTC = 52 * MiB;
constexpr size_t WS_WGU = 53 * MiB;
constexpr size_t WS_WD = 181 * MiB;
constexpr size_t WS_X = 245 * MiB;
constexpr size_t WS_HN = 317 * MiB;
constexpr size_t WS_QKV = 353 * MiB;
constexpr size_t WS_G = 398 * MiB;
constexpr size_t WS_BR = 506 * MiB;
constexpr size_t WS_HACT = 470 * MiB;
constexpr size_t WS_END = 542 * MiB;
constexpr size_t QKV_QG = 0, QKV_KG = (size_t)NTOK * 512 * 2, QKV_VG = QKV_KG + (size_t)NTOK * 128 * 2, QKV_QW = QKV_VG + (size_t)NTOK * 128 * 2,
                 QKV_KW = QKV_QW + (size_t)NTOK * 256 * 2, QKV_VW = QKV_KW + (size_t)NTOK * 128 * 2;
static_assert(WS_QKV + QKV_VW + (size_t)NTOK * 128 * 2 <= WS_G && WS_HN + (size_t)NTOK * DM * 4 <= WS_G && WS_G + (size_t)NTOK * 3 * DM * 2 <= WS_BR && WS_HACT >= WS_G + (size_t)NE * RPE * DM * 2 && WS_HACT + (size_t)NE * RPE * DM * 2 <= WS_END, "d_ws map");
constexpr size_t DO_MB = 0, DO_ABT = 36 * MiB, DO_ABTC = 52 * MiB;
constexpr int CW_BAR = 1024;
constexpr int CW_QUEUE = 8192;
constexpr int CW_CONVQ = 8192 + 64 * 8;
constexpr int CW_FIN = CW_CONVQ + 64;
constexpr int RING_BYTES = 131072;
constexpr int LDSCTL_OFF = RING_BYTES, MISC_OFF = LDSCTL_OFF + 320;
constexpr int IDXBUF_OFF = LDSCTL_OFF + 1024 + 8192;
constexpr int LDS_BYTES = 147456;

#define GAS __attribute__((address_space(1)))
#define LAS __attribute__((address_space(3)))
typedef unsigned short bf16;
typedef unsigned v4u __attribute__((ext_vector_type(4)));
typedef unsigned v2u __attribute__((ext_vector_type(2)));
typedef float f32x4 __attribute__((ext_vector_type(4)));
typedef GAS unsigned gu32;
#define RLX_AGENT __ATOMIC_RELAXED, __HIP_MEMORY_SCOPE_AGENT
#define LDS_WAIT() asm volatile("s_waitcnt lgkmcnt(0)" ::: "memory")
#define VM_WAIT() asm volatile("s_waitcnt vmcnt(0)" ::: "memory")
__device__ __forceinline__ unsigned f2bf(float f) { unsigned u = __builtin_bit_cast(unsigned, f); return (u + 0x7fffu + ((u >> 16) & 1u)) >> 16; }
__device__ __forceinline__ unsigned pk2(float lo, float hi) { return f2bf(lo) | (f2bf(hi) << 16); }
__device__ __forceinline__ float bf2f(unsigned short h) { return __builtin_bit_cast(float, (unsigned)h << 16); }
__device__ __forceinline__ float bflo(unsigned w) { return __builtin_bit_cast(float, w << 16); }
__device__ __forceinline__ float bfhi(unsigned w) { return __builtin_bit_cast(float, w & 0xffff0000u); }

#define XB_TMO      128
#define XB_XCNT(j)  (256  + 64 * (j))
#define XB_XSUB(j)  (1280 + 64 * (j))
#define XB_XGEN(j)  (2304 + 64 * (j))
#define XB_TOP      3328
#define XB_TOPGEN   3392
#define XCD_BAR_WORDS 3456
#define XB_SPIN_CAP (1u << 20)
__device__ __forceinline__ unsigned xb_ld(unsigned* p)              { return __hip_atomic_load(p, __ATOMIC_RELAXED, __HIP_MEMORY_SCOPE_AGENT); }
__device__ __forceinline__ unsigned xb_add(unsigned* p, unsigned v) { return __hip_atomic_fetch_add(p, v, __ATOMIC_RELAXED, __HIP_MEMORY_SCOPE_AGENT); }
__device__ __forceinline__ unsigned xb_xcc_id() { return (unsigned)__builtin_amdgcn_s_getreg((3 << 11) | 20) & 0xFu; }
#define XB_SPIN(cond, bar) do { unsigned _sp = 0; while (cond) { __builtin_amdgcn_s_sleep(1); \
    if ((++_sp & 255u) == 0u) { if (xb_ld(&(bar)[XB_TMO])) break; if (_sp > XB_SPIN_CAP) { atomicAdd(&(bar)[XB_TMO], 1u); break; } } } } while (0)
struct XcdBarrier { unsigned* bar; unsigned x; volatile LAS unsigned* st; };
__device__ __forceinline__ XcdBarrier xcd_barrier_post(unsigned* bar, volatile LAS unsigned* st) {
    XcdBarrier b; b.bar = bar; b.x = xb_xcc_id(); b.st = st;
    if (threadIdx.x == 0) (void)xb_add(&bar[XB_XCNT(b.x)], 1u);
    return b;
}
__device__ __forceinline__ void xcd_barrier_complete(unsigned* bar, unsigned x, unsigned& nloc, unsigned& nx) {
    const unsigned G = gridDim.x * gridDim.y * gridDim.z;
    unsigned sum, cnt, mine, sp = 0u;
    for (;;) {
        sum = 0u; cnt = 0u; mine = 0u;
#pragma unroll
        for (unsigned j = 0; j < 16; ++j) { const unsigned c = xb_ld(&bar[XB_XCNT(j)]); sum += c; cnt += (c > 0u) ? 1u : 0u; mine = (j == x) ? c : mine; }
        if (sum == G) break;
        __builtin_amdgcn_s_sleep(1);
        if ((++sp & 255u) == 0u) { if (xb_ld(&bar[XB_TMO])) break; if (sp > XB_SPIN_CAP) { atomicAdd(&bar[XB_TMO], 1u); break; } }
    }
    nloc = mine > 0u ? mine : 1u; nx = cnt > 0u ? cnt : 1u;
}
__device__ __forceinline__ void xcd_barrier(const XcdBarrier& b) {
    asm volatile("s_waitcnt vmcnt(0)" ::: "memory");
    __syncthreads();
    if (threadIdx.x == 0) {
        unsigned* bar = b.bar;
        __builtin_amdgcn_s_waitcnt(0);
        unsigned nloc = b.st[0], nx = b.st[1];
        if (nloc == 0u) { xcd_barrier_complete(bar, b.x, nloc, nx); b.st[0] = nloc; b.st[1] = nx; }
        const unsigned old = xb_add(&bar[XB_XSUB(b.x)], 1u);
        const unsigned gen = old / nloc;
        if (old + 1u == (gen + 1u) * nloc) {
            __builtin_amdgcn_fence(__ATOMIC_RELEASE, "agent");
            asm volatile("s_waitcnt vmcnt(0)" ::: "memory");
            const unsigned og = xb_add(&bar[XB_TOP], 1u);
            const unsigned tg = og / nx;
            if (og + 1u == (tg + 1u) * nx) xb_add(&bar[XB_TOPGEN], 1u);
            else XB_SPIN(xb_ld(&bar[XB_TOPGEN]) == tg, bar);
            __builtin_amdgcn_fence(__ATOMIC_ACQUIRE, "agent");
            xb_add(&bar[XB_XGEN(b.x)], 1u);
            asm volatile("s_waitcnt vmcnt(0)" ::: "memory");
        } else {
            XB_SPIN(xb_ld(&bar[XB_XGEN(b.x)]) == gen, bar);
            __builtin_amdgcn_fence(__ATOMIC_ACQUIRE, "agent");
            asm volatile("s_waitcnt vmcnt(0)" ::: "memory");
        }
    }
    __syncthreads();
}
template <int CTRL> __device__ __forceinline__ float dpp_mov(float v) { return __builtin_bit_cast(float, __builtin_amdgcn_update_dpp(0, __builtin_bit_cast(int, v), CTRL, 0xF, 0xF, true)); }
__device__ __forceinline__ float lx1(float v) { return dpp_mov<0xB1>(v); }
__device__ __forceinline__ float lx2(float v) { return dpp_mov<0x4E>(v); }
__device__ __forceinline__ float lx4(float v) { return dpp_mov<0x1B>(dpp_mov<0x141>(v)); }
__device__ __forceinline__ float lx8(float v) { return dpp_mov<0x141>(dpp_mov<0x140>(v)); }
__device__ __forceinline__ float lx16(float v) { return __shfl_xor(v, 16); }
__device__ __forceinline__ float lx32(float v) { const unsigned u = __builtin_bit_cast(unsigned, v); auto r = __builtin_amdgcn_permlane32_swap(u, u, false, false);
    return __builtin_bit_cast(float, (threadIdx.x & 32) ? r[0] : r[1]); }
__device__ __forceinline__ float wave_sum(float v) {
    v += lx1(v); v += lx2(v); v += lx4(v); v += lx8(v); v += lx16(v); v += lx32(v);
    return v;
}
using pg8::Unit;
typedef pg8::f32x4 (&AccRef)[2][2][4][2];

__device__ __forceinline__ v2u pack4(f32x4 v) { v2u w; w.x = pg8::cvt_pk_bf16(v[0], v[1]); w.y = pg8::cvt_pk_bf16(v[2], v[3]); return w; }
__device__ __forceinline__ float sigmoidf_(float v) { return __builtin_amdgcn_rcpf(1.f + __builtin_amdgcn_exp2f(-LOG2E * v)); }

template <class Dec> struct Strided {
    Dec d; int n, G, vcu;
    __device__ __forceinline__ bool next(int i, Unit& u) const { const int L = i * G + vcu; if (L >= n) return false; d(L, u); return true; }
};

struct DecInProj { const char* A; const char* B; int layer;
    __device__ __forceinline__ void operator()(int L, Unit& u) const {
        int pm, pn;
        if (L < 1024) { const int cg = L >> 8, rg = (L & 255) >> 5, w = L & 31; pm = rg * 8 + (w & 7); pn = cg * 4 + (w >> 3); }
        else if (L < 1216) { const int q = L - 1024, rg = q / 24, w = q % 24; pm = rg * 8 + (w & 7); pn = 16 + (w >> 3); }
        else { const int q = L - 1216; pm = 64 + (q & 7); pn = q >> 3; if (layer == DEPTH - 1) pn = pn ? 6 : 4; }
        u.A = A + (size_t)pm * 256 * (DM * 2); u.B = B + (size_t)pn * 256 * (DM * 2); u.arows = nullptr; u.ldA = DM * 2; u.ldB = DM * 2; u.nt = DM / 64; u.pm = pm; u.pn = pn; u.tag = 0;
    } };
constexpr int inproj_units(int layer) { return 1216 + (layer == DEPTH - 1 ? 16 : 152); }

struct EpiInProj {
    bf16 *ABt, *ABtc, *Qg, *Kg, *Vg, *Qw, *Kw, *Vw, *G; const float* rope; const float* qng; const float* kng;
    __device__ __forceinline__ bool operator()(AccRef acc, const Unit& u, int wr, int wc, int fr, int fq) const {
        const int pm = u.pm, pn = u.pn; const bool lat = pm < 64;
        const int rowt = wr * 64 + fr;
        if (pn < 2) {
            bf16* dst; int ld;
            if (lat) { dst = ABt + ((size_t)(pm >> 3) * 256) * (2 * SEQ) + pn * SEQ + (pm & 7) * 256; ld = 2 * SEQ; }
            else { dst = ABtc + ((size_t)(pm - 64) * 256) * (2 * CTX) + pn * CTX; ld = 2 * CTX; }
#pragma unroll
            for (int ai = 0; ai < 2; ++ai)
#pragma unroll
                for (int m = 0; m < 4; ++m) { const int tok = rowt + ai * 128 + m * 16;
#pragma unroll
                    for (int bj = 0; bj < 2; ++bj)
#pragma unroll
                        for (int n = 0; n < 2; ++n) { const int c = bj * 128 + wc * 32 + n * 16 + fq * 4; const pg8::f32x4 v = acc[ai][bj][m][n];
#pragma unroll
                            for (int j = 0; j < 4; ++j) dst[(size_t)(c + j) * ld + tok] = (bf16)f2bf(v[j]); } }
        } else if (pn < 7) {
            bf16* dst; int ld; const float* ng = nullptr; bool rope_on = false; float sc = 1.f;
            if (pn <= 3)      { dst = Qg + (pn - 2) * 256 + wc * 64; ld = 512; ng = qng; rope_on = lat; sc = QSCALE; }
            else if (pn == 4) { if (wc < 2) { dst = Kg + wc * 64; ng = kng; rope_on = lat; } else { dst = Vg + (wc - 2) * 64; } ld = 128; }
            else if (pn == 5) { dst = Qw + wc * 64; ld = 256; rope_on = lat; sc = QSCALE; }
            else              { if (wc < 2) { dst = Kw + wc * 64; rope_on = lat; } else { dst = Vw + (wc - 2) * 64; } ld = 128; }
#pragma unroll
            for (int ai = 0; ai < 2; ++ai)
#pragma unroll
                for (int m = 0; m < 4; ++m) {
                    const int row = pm * 256 + rowt + ai * 128 + m * 16;
                    pg8::f32x4 v[2][2];
                    float ss = 0.f;
#pragma unroll
                    for (int bj = 0; bj < 2; ++bj)
#pragma unroll
                        for (int n = 0; n < 2; ++n) { v[bj][n] = acc[ai][bj][m][n]; ss += (v[bj][n][0] * v[bj][n][0] + v[bj][n][1] * v[bj][n][1]) + (v[bj][n][2] * v[bj][n][2] + v[bj][n][3] * v[bj][n][3]); }
                    float r = sc;
                    if (ng) { ss += __shfl_xor(ss, 16); ss += __shfl_xor(ss, 32); r = sc * rsqrtf(ss * (1.f / 64.f) + EPS); }
                    const int t = row & (SEQ - 1);
#pragma unroll
                    for (int bj = 0; bj < 2; ++bj)
#pragma unroll
                        for (int n = 0; n < 2; ++n) {
                            pg8::f32x4 x = v[bj][n] * r; if (ng) x = x * *(const pg8::f32x4*)(ng + bj * 32 + n * 16 + fq * 4);
                            if (rope_on) {
                                const int pos = bj ? (t & 63) : (t >> 6);
                                const pg8::f32x4 cs = *(const pg8::f32x4*)(rope + ((size_t)pos * 16 + n * 8 + fq * 2) * 2);
                                x = (pg8::f32x4){x[0] * cs[0] - x[1] * cs[1], x[0] * cs[1] + x[1] * cs[0], x[2] * cs[2] - x[3] * cs[3], x[2] * cs[3] + x[3] * cs[2]};
                            }
                            *(v2u*)(dst + (size_t)row * ld + bj * 32 + n * 16 + fq * 4) = pack4(x);
                        }
                    asm volatile("" ::: "memory");
                }
        } else {
            bf16* dst = G + ((size_t)pm * 12 + (pn - 7)) * 65536 + (size_t)(((wr * 4 + wc) * 64 + fq * 16 + fr) * 8);
#pragma unroll
            for (int ai = 0; ai < 2; ++ai)
#pragma unroll
                for (int bj = 0; bj < 2; ++bj)
#pragma unroll
                    for (int m = 0; m < 4; ++m) { const pg8::f32x4 a = acc[ai][bj][m][0], b = acc[ai][bj][m][1];
                        const v2u lo = pack4((pg8::f32x4){sigmoidf_(a[0]), sigmoidf_(a[1]), sigmoidf_(a[2]), sigmoidf_(a[3])}), hi = pack4((pg8::f32x4){sigmoidf_(b[0]), sigmoidf_(b[1]), sigmoidf_(b[2]), sigmoidf_(b[3])});
                        *(v4u*)(dst + (size_t)(((ai * 2 + bj) * 4 + m) * 4096)) = (v4u){lo.x, lo.y, hi.x, hi.y}; }
        }
        return false;
    }
};

struct EpiStore { bf16* O; int ld;
    __device__ __forceinline__ bool operator()(AccRef acc, const Unit& u, int wr, int wc, int fr, int fq) const {
        bf16* dst = O + ((size_t)u.pm * 256 + wr * 64 + fr) * ld + u.pn * 256 + wc * 32 + fq * 4;
#pragma unroll
        for (int ai = 0; ai < 2; ++ai)
#pragma unroll
            for (int m = 0; m < 4; ++m)
#pragma unroll
                for (int bj = 0; bj < 2; ++bj)
#pragma unroll
                    for (int n = 0; n < 2; ++n) *(v2u*)(dst + (size_t)(ai * 128 + m * 16) * ld + bj * 128 + n * 16) = pack4(acc[ai][bj][m][n]);
        return false;
    } };
struct DecDft { const char* Dm; const char* Dc; const char* ABt; const char* ABtc;
    __device__ __forceinline__ void operator()(int L, Unit& u) const {
        if (L < 64) { const int b = L >> 3, mt = L & 7; u.A = Dm + (size_t)mt * 256 * (4 * SEQ); u.B = ABt + (size_t)b * 256 * (4 * SEQ); u.ldA = 4 * SEQ; u.ldB = 4 * SEQ; u.nt = 2 * SEQ / 64; u.pm = L; }
        else { const int b = L - 64; u.A = Dc; u.B = ABtc + (size_t)b * 256 * (4 * CTX); u.ldA = 4 * CTX; u.ldB = 4 * CTX; u.nt = 2 * CTX / 64; u.pm = 64 + b; }
        u.pn = 0; u.tag = 0; u.arows = nullptr;
    } };

struct SchedMerge { const char* BR; const char* W; int ntiles, G, vcu;
    __device__ __forceinline__ bool next(int i, Unit& u) const {
        const int round = i / 3, tag = i - round * 3, tile = round * G + vcu; if (tile >= ntiles) return false;
        const int pm = tile >> 2, pn = tile & 3, koff = tag == 0 ? 0 : (tag == 1 ? 256 : 768);
        u.A = BR + (size_t)pm * 256 * (DM * 2) + koff * 2; u.B = W + (size_t)pn * 256 * (DM * 2) + koff * 2; u.arows = nullptr; u.ldA = DM * 2; u.ldB = DM * 2; u.nt = tag == 1 ? 8 : 4; u.pm = pm; u.pn = pn; u.tag = tag;
        return true;
    } };
struct EpiMerge { const bf16* G; bf16* Mb; int probe;
    __device__ __forceinline__ bool operator()(AccRef acc, const Unit& u, int wr, int wc, int fr, int fq) const {
        const size_t row0 = (size_t)u.pm * 256 + wr * 64 + fr; const int col0 = u.pn * 256 + wc * 32 + fq * 4; const int tag = u.tag;
        const bf16* g0 = G + ((size_t)u.pm * 12 + tag * 4 + u.pn) * 65536 + (size_t)(((wr * 4 + wc) * 64 + fq * 16 + fr) * 8);
#pragma unroll
        for (int ai = 0; ai < 2; ++ai)
#pragma unroll
            for (int bj = 0; bj < 2; ++bj) {
#pragma unroll
                for (int m = 0; m < 4; ++m) { const size_t fo = (size_t)(((ai * 2 + bj) * 4 + m) * 4096);
                    const v4u gw = probe == 2 ? (v4u){0x3f803f80u, 0x3f803f80u, 0x3f803f80u, 0x3f803f80u} : *(const v4u*)(g0 + fo);
                    pg8::f32x4 ga = {bflo(gw.x), bfhi(gw.x), bflo(gw.y), bfhi(gw.y)}, gb = {bflo(gw.z), bfhi(gw.z), bflo(gw.w), bfhi(gw.w)};
                    if (tag < 2) { const v4u hw = probe == 2 ? (v4u){0x3f803f80u, 0x3f803f80u, 0x3f803f80u, 0x3f803f80u} : *(const v4u*)(g0 + 4 * 65536 + fo);
                        ga = (pg8::f32x4){ga[0] * __builtin_amdgcn_rcpf(bflo(hw.x)), ga[1] * __builtin_amdgcn_rcpf(bfhi(hw.x)), ga[2] * __builtin_amdgcn_rcpf(bflo(hw.y)), ga[3] * __builtin_amdgcn_rcpf(bfhi(hw.y))};
                        gb = (pg8::f32x4){gb[0] * __builtin_amdgcn_rcpf(bflo(hw.z)), gb[1] * __builtin_amdgcn_rcpf(bfhi(hw.z)), gb[2] * __builtin_amdgcn_rcpf(bflo(hw.w)), gb[3] * __builtin_amdgcn_rcpf(bfhi(hw.w))};
                        acc[ai][bj][m][0] = acc[ai][bj][m][0] * ga; acc[ai][bj][m][1] = acc[ai][bj][m][1] * gb; }
                    else { const size_t row = row0 + ai * 128 + m * 16; const int c = col0 + bj * 128;
                        *(v2u*)(Mb + row * DM + c) = pack4(acc[ai][bj][m][0] * ga); *(v2u*)(Mb + row * DM + c + 16) = pack4(acc[ai][bj][m][1] * gb); } }
                asm volatile("" ::: "memory"); }
        return tag < 2;
    } };

struct DecWout { const char* Mb; const char* W;
    __device__ __forceinline__ void operator()(int L, Unit& u) const { const int pm = L >> 2, pn = L & 3;
        u.A = Mb + (size_t)pm * 256 * (DM * 2); u.B = W + (size_t)pn * 256 * (DM * 2); u.arows = nullptr; u.ldA = DM * 2; u.ldB = DM * 2; u.nt = DM / 64; u.pm = pm; u.pn = pn; u.tag = 0; } };
struct EpiWout { const float* baseL; const float* baseC; float* X; const float* mod;
    __device__ __forceinline__ bool operator()(AccRef acc, const Unit& u, int wr, int wc, int fr, int fq) const {
        const int pm = u.pm; const float* base = pm < 64 ? baseL : baseC; const float* g1 = mod + (size_t)(pm < 64 ? (pm >> 3) : 8) * (6 * DM) + 2 * DM;
        const size_t row0 = (size_t)pm * 256 + wr * 64 + fr; const int col0 = u.pn * 256 + wc * 32 + fq * 4;
#pragma unroll
        for (int bj = 0; bj < 2; ++bj)
#pragma unroll
            for (int n = 0; n < 2; ++n) { const int c = col0 + bj * 128 + n * 16; const pg8::f32x4 gv = *(const pg8::f32x4*)(g1 + c);
#pragma unroll
                for (int ai = 0; ai < 2; ++ai)
#pragma unroll
                    for (int m = 0; m < 4; ++m) { const size_t off = (row0 + ai * 128 + m * 16) * DM + c;
                        *(pg8::f32x4*)(X + off) = *(const pg8::f32x4*)(base + off) + gv * acc[ai][bj][m][n]; } }
        return false;
    } };

struct DecGU { const char* H2; const int* IDX; const char* W; int nrt;
    __device__ __forceinline__ void operator()(int L, Unit& u) const { const int per = nrt * 8, e = L / per, q = L - e * per, ct = q & 7, rt = q >> 3;
        u.A = H2; u.arows = IDX + (size_t)e * RPE + rt * 256; u.B = W + ((size_t)e * 2 * DM + ct * 256) * (DM * 2); u.ldA = DM * 2; u.ldB = DM * 2; u.nt = DM / 64; u.pm = rt; u.pn = ct; u.tag = e; } };
struct EpiGU { bf16* H;
    __device__ __forceinline__ bool operator()(AccRef acc, const Unit& u, int wr, int wc, int fr, int fq) const {
        bf16* dst = H + ((size_t)u.tag * RPE + u.pm * 256 + wr * 64 + fr) * DM + u.pn * 128 + wc * 32 + fq * 4;
#pragma unroll
        for (int ai = 0; ai < 2; ++ai)
#pragma unroll
            for (int m = 0; m < 4; ++m)
#pragma unroll
                for (int n = 0; n < 2; ++n) { const pg8::f32x4 a = acc[ai][0][m][n], up = acc[ai][1][m][n];
                    const pg8::f32x4 h = {a[0] * sigmoidf_(a[0]) * up[0], a[1] * sigmoidf_(a[1]) * up[1], a[2] * sigmoidf_(a[2]) * up[2], a[3] * sigmoidf_(a[3]) * up[3]};
                    *(v2u*)(dst + (size_t)(ai * 128 + m * 16) * DM + n * 16) = pack4(h); }
        return false;
    } };
struct DecDown { const char* H; const char* W; int nrt;
    __device__ __forceinline__ void operator()(int L, Unit& u) const { const int per = nrt * 4, e = L / per, q = L - e * per, ct = q & 3, rt = q >> 2;
        u.A = H + ((size_t)e * RPE + rt * 256) * (DM * 2); u.arows = nullptr; u.B = W + ((size_t)e * DM + ct * 256) * (DM * 2); u.ldA = DM * 2; u.ldB = DM * 2; u.nt = DM / 64; u.pm = rt; u.pn = ct; u.tag = e; } };
struct EpiDown { bf16* Y; const float* afs;
    __device__ __forceinline__ bool operator()(AccRef acc, const Unit& u, int wr, int wc, int fr, int fq) const {
        const size_t r0 = (size_t)u.tag * RPE + u.pm * 256 + wr * 64 + fr;
#pragma unroll
        for (int ai = 0; ai < 2; ++ai)
#pragma unroll
            for (int m = 0; m < 4; ++m) { const size_t r = r0 + ai * 128 + m * 16; const float a = afs[r];
#pragma unroll
                for (int bj = 0; bj < 2; ++bj)
#pragma unroll
                    for (int n = 0; n < 2; ++n) *(v2u*)(Y + r * DM + u.pn * 256 + bj * 128 + wc * 32 + n * 16 + fq * 4) = pack4(acc[ai][bj][m][n] * a); }
        return false;
    } };
struct Frame {
    LAS unsigned char* lds; char* ldsg; volatile LAS unsigned* MISC; gu32* ctl;
    int vcu, G;
    unsigned char* ws; unsigned char* dout; float* out;
};
constexpr int PTRS_OFF = LDSCTL_OFF + 512;
enum { IN_X = 0, IN_C, IN_CTX, IN_CCTX, IN_WADA, IN_BADA, IN_NORM1G, IN_WIN, IN_QNG, IN_KNG, IN_SINK, IN_WBRF, IN_WBRG, IN_WBRW, IN_WOUT, IN_NORM2G, IN_WROUTER, IN_WGATE, IN_WUP, IN_WDOWN, IN_FINALG };
__device__ __forceinline__ const float* inptr(const Frame& F, int k) {
    const unsigned long long v = *(const LAS unsigned long long*)(F.lds + PTRS_OFF + 8 * k);
    const unsigned lo = __builtin_amdgcn_readfirstlane((unsigned)v), hi = __builtin_amdgcn_readfirstlane((unsigned)(v >> 32));
    return (const float*)(((unsigned long long)hi << 32) | lo);
}
#define WSP(T, off) ((T*)(F.ws + (off)))

constexpr int COSTAB_OFF = LDSCTL_OFF + 1024;
static_assert(COSTAB_OFF + 8192 <= LDS_BYTES, "cos table fits");
__device__ __forceinline__ void transpose_item(const float* W, int ldw, int k0, int n0, bf16* WT, int drow0, int dld, int dk0, int lane) {
    const int g = lane >> 3, n4 = (lane & 7) * 4;
    const float* src = W + (size_t)(k0 + 8 * g) * ldw + n0 + n4;
    f32x4 v[8];
#pragma unroll
    for (int i = 0; i < 8; ++i) v[i] = *(const GAS f32x4*)(src + (size_t)i * ldw);
    bf16* dst = WT + (size_t)(drow0 + n4) * dld + dk0 + k0 + 8 * g;
#pragma unroll
    for (int j = 0; j < 4; ++j) { v4u o; o.x = pk2(v[0][j], v[1][j]); o.y = pk2(v[2][j], v[3][j]); o.z = pk2(v[4][j], v[5][j]); o.w = pk2(v[6][j], v[7][j]);
        *(GAS v4u*)(dst + (size_t)j * dld) = o; }
}
__device__ __forceinline__ void transpose_item2(const float* W, int ldw, int k0, int n0, bf16* WT, int drow0, int dld, int lane) {
    const int g = lane >> 3, n4 = (lane & 7) * 4;
    const float* src = W + (size_t)(k0 + 8 * g) * ldw + n0 + n4;
    f32x4 v[2][8];
#pragma unroll
    for (int h = 0; h < 2; ++h)
#pragma unroll
        for (int i = 0; i < 8; ++i) v[h][i] = __builtin_nontemporal_load((const GAS f32x4*)(src + (size_t)(h * 64 + i) * ldw));
    bf16* dst = WT + (size_t)(drow0 + n4) * dld + k0 + 8 * g;
#pragma unroll
    for (int h = 0; h < 2; ++h)
#pragma unroll
        for (int j = 0; j < 4; ++j) { v4u o; o.x = pk2(v[h][0][j], v[h][1][j]); o.y = pk2(v[h][2][j], v[h][3][j]); o.z = pk2(v[h][4][j], v[h][5][j]); o.w = pk2(v[h][6][j], v[h][7][j]);
            __builtin_nontemporal_store(o, (GAS v4u*)(dst + (size_t)j * dld + h * 64)); }
}
__device__ __forceinline__ void fold_item(const float* W, int k0, int g, int sinmode, bf16* WT, int drow0, LAS float* scr, const LAS float* ctab, int lane) {
#pragma unroll
    for (int kk = 0; kk < 16; ++kk) scr[lane * 20 + kk] = W[(size_t)(k0 + kk) * INW + g * 64 + lane];
    LDS_WAIT(); asm volatile("" ::: "memory");
    float acc[16];
#pragma unroll
    for (int k = 0; k < 16; ++k) acc[k] = 0.f;
#pragma unroll 4
    for (int c = 0; c < 64; ++c) {
        const int r = (c * lane) & 63;
        const float tv = sinmode ? -ctab[((r - 16) & 63) * 32] : ctab[r * 32];
#pragma unroll
        for (int k4 = 0; k4 < 4; ++k4) { const f32x4 w = *(const LAS f32x4*)(scr + c * 20 + 4 * k4);
            acc[4 * k4] = fmaf(w[0], tv, acc[4 * k4]); acc[4 * k4 + 1] = fmaf(w[1], tv, acc[4 * k4 + 1]); acc[4 * k4 + 2] = fmaf(w[2], tv, acc[4 * k4 + 2]); acc[4 * k4 + 3] = fmaf(w[3], tv, acc[4 * k4 + 3]); }
    }
    GAS v4u* dst = (GAS v4u*)(WT + (size_t)(drow0 + lane) * DM + k0);
#pragma unroll
    for (int q = 0; q < 2; ++q) { v4u o; o.x = pk2(acc[8 * q], acc[8 * q + 1]); o.y = pk2(acc[8 * q + 2], acc[8 * q + 3]); o.z = pk2(acc[8 * q + 4], acc[8 * q + 5]); o.w = pk2(acc[8 * q + 6], acc[8 * q + 7]); dst[q] = o; }
    LDS_WAIT(); asm volatile("" ::: "memory");
}

#ifndef CONV_IN_ATTN
#define CONV_IN_ATTN 0
#endif
constexpr int CONV_WAVE_ITEMS = DEPTH * NE * 768, CONV_ITEMS = CONV_WAVE_ITEMS / NWAVES, CONV_ITEMS_L0 = CONV_ITEMS / DEPTH;
__device__ __forceinline__ void conv_wave_item(Frame& F, int r, int lane) {
    const int le = r / 768, q = r % 768, which = q / 256, qq = q % 256, kb = qq >> 5, nb = qq & 31, f0 = nb * 32;
    if (which < 2) transpose_item2((which ? inptr(F, IN_WUP) : inptr(F, IN_WGATE)) + (size_t)le * DM * DM, DM, kb * 128, f0, WSP(bf16, WS_WGU) + (size_t)le * 2 * DM * DM, (f0 >> 7) * 256 + which * 128 + (f0 & 127), DM, lane);
    else transpose_item2(inptr(F, IN_WDOWN) + (size_t)le * DM * DM, DM, kb * 128, f0, WSP(bf16, WS_WD) + (size_t)le * DM * DM, f0, DM, lane);
}
__device__ __forceinline__ void tail_convert(Frame& F, int idx, int first, int per, int end) {
    int tid_ = threadIdx.x; asm volatile("" : "+v"(tid_));
    const int lane = tid_ & 63, wave_ = __builtin_amdgcn_readfirstlane(tid_ >> 6);
    for (int t = 0; t < per; ++t) { const int it = first + idx * per + t; if (it >= end) break; conv_wave_item(F, it * NWAVES + wave_, lane); }
}

__device__ __forceinline__ void p0_prologue(Frame& F, int mode = 0) {
    int tid_ = threadIdx.x; asm volatile("" : "+v"(tid_));
    const int lane = tid_ & 63, wave_ = __builtin_amdgcn_readfirstlane(tid_ >> 6);
    const int gw = F.vcu * NWAVES + wave_, NGW = F.G * NWAVES;
    LAS float* st = (LAS float*)F.lds;
    LAS float* red = (LAS float*)(F.lds + 40960);
    LAS float* ctab = (LAS float*)(F.lds + COSTAB_OFF);
    { const float* cp = inptr(F, IN_C); const float* ccp = inptr(F, IN_CCTX);
#pragma unroll 6
      for (int i = tid_; i < 9 * DM; i += NWAVES * 64) { const int s = i / DM, k = i - s * DM; const float v = s < 8 ? cp[s * DM + k] : ccp[k]; st[i] = v / (1.f + expf(-v)); } }
    for (int i = tid_; i < 2048; i += NWAVES * 64) ctab[i] = cosf(6.283185307179586f * (float)i * (1.f / 2048.f));
    __syncthreads();
    const float* bada = inptr(F, IN_BADA);
    if (mode != 2) for (int it = F.vcu; it < DEPTH * 96; it += F.G) {
        const int l = it / 96, j = (it % 96) * 64 + lane, kb = wave_ * 128;
        const float* W = inptr(F, IN_WADA) + (size_t)l * DM * 6 * DM + (size_t)kb * 6 * DM + j;
        float acc[9];
#pragma unroll
        for (int s = 0; s < 9; ++s) acc[s] = 0.f;
        for (int k0 = 0; k0 < 128; k0 += 16) {
            float w[16];
#pragma unroll
            for (int i = 0; i < 16; ++i) w[i] = W[(size_t)(k0 + i) * 6 * DM];
#pragma unroll
            for (int i = 0; i < 16; ++i)
#pragma unroll
                for (int s = 0; s < 9; ++s) acc[s] = fmaf(st[s * DM + kb + k0 + i], w[i], acc[s]);
        }
#pragma unroll
        for (int s = 0; s < 9; ++s) red[(wave_ * 9 + s) * 64 + lane] = acc[s];
        __syncthreads();
        for (int o = tid_; o < 9 * 64; o += NWAVES * 64) { float v = 0.f;
#pragma unroll
            for (int w = 0; w < 8; ++w) v += red[w * 576 + o];
            const int s = o >> 6, jj = (it % 96) * 64 + (o & 63);
            WSP(float, WS_MOD)[((size_t)l * 9 + s) * 6 * DM + jj] = v + bada[l * 6 * DM + jj]; }
        __syncthreads();
    }
    __syncthreads();
#ifdef DBG_POISON
    {
        const size_t n16 = (WS_END - WS_X) / 16, m16 = ((size_t)NLAT * DM * 4) / 16; const v4u pz = {0xFFFFFFFFu, 0xFFFFFFFFu, 0xFFFFFFFFu, 0xFFFFFFFFu};
        for (size_t i = (size_t)gw * 64 + lane; i < n16; i += (size_t)NGW * 64) ((GAS v4u*)(F.ws + WS_X))[i] = pz;
        for (size_t i = (size_t)gw * 64 + lane; i < m16; i += (size_t)NGW * 64) ((GAS v4u*)F.dout)[i] = pz;
    }
#endif
    LAS float* scr = (LAS float*)(F.lds + wave_ * 16384);
    constexpr int T_A = DEPTH * 2176, T_B = DEPTH * 512, T_C = DEPTH * 512, T_D = DEPTH * 512, T_E = DEPTH * NE * 768, T_F = SEQ + CTX, T_G = 1;
    constexpr int NITEMS = T_A + T_B + T_C + T_D + T_E + T_F + T_G;
    if (mode != 1 && mode != 5 && mode != 6) for (int it = gw; it < NITEMS; it += NGW) {
        int r = it;
        if (r < T_A) { const int l = r / 2176, q = r % 2176, kb = q / 136, nb = q % 136, s0 = 256 + nb * 32;
            int drow; if (s0 < 1536) { const int tile = 2 + ((s0 - 256) >> 8), hh = ((s0 - 256) & 255) >> 6, dh = (s0 & 63) >> 5; drow = tile * 256 + dh * 128 + hh * 32; } else drow = s0 + 256;
            transpose_item(inptr(F, IN_WIN) + (size_t)l * DM * INW, INW, kb * 64, s0, WSP(bf16, WS_WIN) + (size_t)l * INW2 * DM, drow, DM, 0, lane); continue; } r -= T_A;
        if (r < T_B) { const int l = r / 512, q = r % 512, kq = q & 3, kb = (q >> 2) >> 3, g = ((q >> 2) >> 1) & 3, sm = (q >> 2) & 1;
            fold_item(inptr(F, IN_WIN) + (size_t)l * DM * INW, kb * 64 + kq * 16, g, sm, WSP(bf16, WS_WIN) + (size_t)l * INW2 * DM, sm * 256 + g * 64, scr, ctab, lane); continue; } r -= T_B;
        if (r < T_C) { const int l = r / 512, q = r % 512; const float* W; int kb, koff;
            if (q < 128) { W = inptr(F, IN_WBRF) + (size_t)l * 256 * DM; kb = q >> 5; koff = 0; } else if (q < 384) { W = inptr(F, IN_WBRG) + (size_t)l * 512 * DM; kb = (q - 128) >> 5; koff = 256; } else { W = inptr(F, IN_WBRW) + (size_t)l * 256 * DM; kb = (q - 384) >> 5; koff = 768; }
            const int nb = q & 31;
            transpose_item(W, DM, kb * 64, nb * 32, WSP(bf16, WS_WBR) + (size_t)l * DM * DM, nb * 32, DM, koff, lane); continue; } r -= T_C;
        if (r < T_D) { const int l = r / 512, q = r % 512, kb = q >> 5, nb = q & 31;
            transpose_item(inptr(F, IN_WOUT) + (size_t)l * DM * DM, DM, kb * 64, nb * 32, WSP(bf16, WS_WOUT) + (size_t)l * DM * DM, nb * 32, DM, 0, lane); continue; } r -= T_D;
        if (r < T_E) { if (F.G != 256) conv_wave_item(F, r, lane); continue; } r -= T_E;
        if (r < T_F) {
            const bool big = r < SEQ; const int N = big ? SEQ : CTX, k = big ? r : r - SEQ, sh = big ? 0 : 3; const float sc = 1.f / sqrtf(64.f * (float)N);
            bf16* row = (big ? WSP(bf16, WS_DFT) : WSP(bf16, WS_DFTC)) + (size_t)k * 2 * N;
            for (int n = 2 * lane; n < N; n += 128) {
                const int r0 = (k * n) & (N - 1), r1 = (k * (n + 1)) & (N - 1);
                *(GAS unsigned*)(row + n) = pk2(ctab[r0 << sh] * sc, ctab[r1 << sh] * sc);
                *(GAS unsigned*)(row + N + n) = pk2(ctab[((r0 - (N >> 2)) & (N - 1)) << sh] * sc, ctab[((r1 - (N >> 2)) & (N - 1)) << sh] * sc); }
            continue; } r -= T_F;
        {
            for (int i = lane; i < 64 * 16; i += 64) { const int pos = i >> 4, f = i & 15; const float inv = powf(10000.f, -(float)(2 * f) / 32.f), ang = (float)pos * inv;
                WSP(float, WS_ROPE)[2 * i] = cosf(ang); WSP(float, WS_ROPE)[2 * i + 1] = sinf(ang); }
        }
    }
}

__device__ __forceinline__ void norm_row(f32x4 (&v)[4], const float* gain, const float* shift, const float* scale, int lane) {
    float ss = 0.f;
#pragma unroll
    for (int j = 0; j < 4; ++j) ss += (v[j][0] * v[j][0] + v[j][1] * v[j][1]) + (v[j][2] * v[j][2] + v[j][3] * v[j][3]);
    const float r = rsqrtf(wave_sum(ss) * (1.f / DM) + EPS);
#pragma unroll
    for (int j = 0; j < 4; ++j) { const f32x4 g = *(const f32x4*)(gain + 4 * lane + 256 * j); f32x4 y = v[j] * r * g;
        if (shift) { const f32x4 sh = *(const f32x4*)(shift + 4 * lane + 256 * j), sc = *(const f32x4*)(scale + 4 * lane + 256 * j); y = y * (sc + 1.f) + sh; }
        v[j] = y; }
}
__device__ __forceinline__ void store_row_bf16(bf16* orow, const f32x4 (&v)[4], int lane) {
    GAS v2u* o8 = (GAS v2u*)orow + lane;
#pragma unroll
    for (int j = 0; j < 4; ++j) { v2u w; w.x = pg8::cvt_pk_bf16(v[j][0], v[j][1]); w.y = pg8::cvt_pk_bf16(v[j][2], v[j][3]); o8[64 * j] = w; }
}
__device__ __forceinline__ int row_modset(int r) { return r < NLAT ? (r >> 11) : 8; }
struct ModVec { f32x4 g[4], sh[4], sc[4]; };
__device__ __forceinline__ void load_modvec(ModVec& m, const float* gain, const float* shift, const float* scale, int lane) {
#pragma unroll
    for (int j = 0; j < 4; ++j) { m.g[j] = *(const f32x4*)(gain + 4 * lane + 256 * j);
        if (shift) { m.sh[j] = *(const f32x4*)(shift + 4 * lane + 256 * j); m.sc[j] = *(const f32x4*)(scale + 4 * lane + 256 * j); } else { m.sh[j] = (f32x4){0.f, 0.f, 0.f, 0.f}; m.sc[j] = (f32x4){0.f, 0.f, 0.f, 0.f}; } }
}
__device__ __forceinline__ void norm_row_m(f32x4 (&v)[4], const ModVec& m) {
    float ss = 0.f;
#pragma unroll
    for (int j = 0; j < 4; ++j) ss += (v[j][0] * v[j][0] + v[j][1] * v[j][1]) + (v[j][2] * v[j][2] + v[j][3] * v[j][3]);
    const float r = rsqrtf(wave_sum(ss) * (1.f / DM) + EPS);
#pragma unroll
    for (int j = 0; j < 4; ++j) v[j] = (v[j] * r * m.g[j]) * (m.sc[j] + 1.f) + m.sh[j];
}
__device__ __forceinline__ void load_row_f32(f32x4 (&v)[4], const float* row, int lane) {
#pragma unroll
    for (int j = 0; j < 4; ++j) v[j] = *(const f32x4*)(row + 4 * lane + 256 * j);
}

__device__ __forceinline__ void p1_norm1(Frame& F) {
    int tid_ = threadIdx.x; asm volatile("" : "+v"(tid_));
    const int lane = tid_ & 63, wave_ = __builtin_amdgcn_readfirstlane(tid_ >> 6);
    const int gw = F.vcu * NWAVES + wave_, NGW = F.G * NWAVES, rpw = (NTOK + NGW - 1) / NGW, r0 = gw * rpw, r1 = r0 + rpw < NTOK ? r0 + rpw : NTOK;
    const float* xin = inptr(F, IN_X); const float* cin = inptr(F, IN_CTX) - (size_t)NLAT * DM; const float* g1 = inptr(F, IN_NORM1G);
#define P1_ROW(r) (((r) < NLAT ? xin : cin) + (size_t)(r) * DM)
    f32x4 va[4], vb[4]; ModVec m; int cset = -1;
    if (r0 < r1) load_row_f32(va, P1_ROW(r0), lane);
    if (r0 + 1 < r1) load_row_f32(vb, P1_ROW(r0 + 1), lane);
    for (int r = r0; r < r1; ++r) {
        f32x4 v[4];
#pragma unroll
        for (int j = 0; j < 4; ++j) { v[j] = va[j]; va[j] = vb[j]; }
        if (r + 2 < r1) load_row_f32(vb, P1_ROW(r + 2), lane);
        const int set = row_modset(r);
        if (set != cset) { const float* mod = WSP(float, WS_MOD) + (size_t)set * 6 * DM; load_modvec(m, g1, mod, mod + DM, lane); cset = set; }
        norm_row_m(v, m);
        store_row_bf16(WSP(bf16, WS_HN) + (size_t)r * DM, v, lane);
    }
#undef P1_ROW
}
__device__ __forceinline__ void router_finish(const float (&a16)[NE], int r, int lane, float* AFF) {
    float b8[8], b4[4], b2[2], lg;
    { const bool hi = lane & 32;
#pragma unroll
      for (int i = 0; i < 8; ++i) { const float keep = hi ? a16[i + 8] : a16[i], send = hi ? a16[i] : a16[i + 8]; b8[i] = keep + lx32(send); } }
    { const bool hi = lane & 16;
#pragma unroll
      for (int i = 0; i < 4; ++i) { const float keep = hi ? b8[i + 4] : b8[i], send = hi ? b8[i] : b8[i + 4]; b4[i] = keep + lx16(send); } }
    { const bool hi = lane & 8;
#pragma unroll
      for (int i = 0; i < 2; ++i) { const float keep = hi ? b4[i + 2] : b4[i], send = hi ? b4[i] : b4[i + 2]; b2[i] = keep + lx8(send); } }
    { const bool hi = lane & 4; const float keep = hi ? b2[1] : b2[0], send = hi ? b2[0] : b2[1]; lg = keep + lx4(send); }
    lg += lx2(lg); lg += lx1(lg);
    float mx = lg;
    mx = fmaxf(mx, lx4(mx)); mx = fmaxf(mx, lx8(mx)); mx = fmaxf(mx, lx16(mx)); mx = fmaxf(mx, lx32(mx));
    const float ex = expf(lg - mx); float sum = ex;
    sum += lx4(sum); sum += lx8(sum); sum += lx16(sum); sum += lx32(sum);
    const int set = r < NLAT ? (r >> 11) : 8 + ((r - NLAT) >> 8), n = r < NLAT ? (r & (SEQ - 1)) : ((r - NLAT) & (CTX - 1));
    if ((lane & 3) == 0) AFF[((size_t)set * NE + ((lane >> 2) & 15)) * SEQ + n] = ex / sum;
}
__device__ __forceinline__ void pf_norm2_router(Frame& F, int l, int mode = 0) {
    int tid_ = threadIdx.x; asm volatile("" : "+v"(tid_));
    const int lane = tid_ & 63, wave_ = __builtin_amdgcn_readfirstlane(tid_ >> 6);
    const int gw = F.vcu * NWAVES + wave_, NGW = F.G * NWAVES;
    LAS float* wrT = (LAS float*)F.lds;
    { const float* wr = inptr(F, IN_WROUTER) + (size_t)l * DM * NE;
#pragma unroll 8
      for (int i = tid_; i < DM * NE; i += NWAVES * 64) { const int k = i >> 4, e = i & 15; wrT[e * DM + k] = wr[i]; } }
    __syncthreads();
    const int nrows = (l == DEPTH - 1) ? NLAT : NTOK, rpw = (nrows + NGW - 1) / NGW, r0 = gw * rpw, r1 = r0 + rpw < nrows ? r0 + rpw : nrows;
    const float* X = WSP(float, WS_X); const float* g2n = inptr(F, IN_NORM2G) + l * DM; float* AFF = WSP(float, WS_AFF);
    f32x4 va[4], vb[4]; ModVec m; int cset = -1;
    if (r0 < r1) load_row_f32(va, X + (size_t)r0 * DM, lane);
    if (r0 + 1 < r1) load_row_f32(vb, X + (size_t)(r0 + 1) * DM, lane);
    for (int r = r0; r < r1; ++r) {
        f32x4 v[4];
#pragma unroll
        for (int j = 0; j < 4; ++j) { v[j] = va[j]; va[j] = vb[j]; }
        if (r + 2 < r1) load_row_f32(vb, X + (size_t)(r + 2) * DM, lane);
        const int mset = row_modset(r);
        if (mset != cset) { const float* mod = WSP(float, WS_MOD) + ((size_t)l * 9 + mset) * 6 * DM; load_modvec(m, g2n, mod + 3 * DM, mod + 4 * DM, lane); cset = mset; }
        norm_row_m(v, m);
        if (mode < 2) store_row_bf16(WSP(bf16, WS_HN) + (size_t)r * DM, v, lane);
        if (mode >= 1) { asm volatile("" :: "v"(v[0]), "v"(v[1]), "v"(v[2]), "v"(v[3])); continue; }
        float a16[NE];
#pragma unroll
        for (int e = 0; e < NE; ++e) { float a = 0.f;
#pragma unroll
            for (int j = 0; j < 4; ++j) { const f32x4 w = *(const LAS f32x4*)(wrT + e * DM + 4 * lane + 256 * j); a = fmaf(v[j][0], w[0], a); a = fmaf(v[j][1], w[1], a); a = fmaf(v[j][2], w[2], a); a = fmaf(v[j][3], w[3], a); }
            a16[e] = a; if ((e & 3) == 3) asm volatile("" ::: "memory"); }
        router_finish(a16, r, lane, AFF);
    }
    __syncthreads();
}
__device__ __forceinline__ void pg_topk_gather(Frame& F, int l) {
    int tid_ = threadIdx.x; asm volatile("" : "+v"(tid_));
    const int lane = tid_ & 63, wave_ = __builtin_amdgcn_readfirstlane(tid_ >> 6);
    LAS unsigned* cnt = (LAS unsigned*)F.lds;
    LAS int* sidx = (LAS int*)(F.lds + 1024);
    const int nitems = (l == DEPTH - 1) ? 8 * NE : 16 * NE;
    const int tid = tid_, wave = wave_;
    const unsigned long long lt = (1ull << lane) - 1ull;
    for (int it = F.vcu; it < nitems; it += F.G) {
        const int set = it >> 4, e = it & 15; const bool latent = set < 8; const int N = latent ? SEQ : CTX, cap = latent ? CAPL : CAPC;
        const int rowbase = latent ? set * SEQ : NLAT + (set - 8) * CTX, xbase = latent ? set * CAPL : 8 * CAPL + (set - 8) * CAPC;
        const float* a = WSP(float, WS_AFF) + ((size_t)set * NE + e) * SEQ;
        unsigned key[4];
#pragma unroll
        for (int q = 0; q < 4; ++q) { const int i = q * 512 + tid; key[q] = i < N ? __builtin_bit_cast(unsigned, a[i]) : 0u; }
        unsigned T = 0u;
        for (int bit = 30; bit >= 0; --bit) {
            const unsigned cand = T | (1u << bit); unsigned c = 0;
#pragma unroll
            for (int q = 0; q < 4; ++q) c += (unsigned)__builtin_popcountll(__ballot(key[q] >= cand));
            LAS unsigned* cb = cnt + (bit & 1) * 8;
            if (lane == 0) cb[wave] = c;
            __syncthreads();
            unsigned tot = 0;
#pragma unroll
            for (int w = 0; w < 8; ++w) tot += cb[w];
            if (tot >= (unsigned)cap) T = cand;
        }
        LAS unsigned* cg = cnt + 64; LAS unsigned* ce = cnt + 96;
        unsigned long long bg[4], be[4];
#pragma unroll
        for (int q = 0; q < 4; ++q) { bg[q] = __ballot(key[q] > T); be[q] = __ballot(key[q] == T && key[q] != 0u);
            if (lane == 0) { cg[q * 8 + wave] = (unsigned)__builtin_popcountll(bg[q]); ce[q * 8 + wave] = (unsigned)__builtin_popcountll(be[q]); } }
        __syncthreads();
        unsigned ngt = 0;
        for (int c2 = 0; c2 < 32; ++c2) ngt += cg[c2];
        const unsigned need = (unsigned)cap - ngt;
        unsigned pre_g[4], pre_e[4];
        { unsigned rg = 0, re = 0;
#pragma unroll
          for (int q = 0; q < 4; ++q) { for (int w = 0; w < 8; ++w) { if (w == wave) { pre_g[q] = rg; pre_e[q] = re; } rg += cg[q * 8 + w]; re += ce[q * 8 + w]; } } }
        int* SEL = WSP(int, WS_SEL);
#pragma unroll
        for (int q = 0; q < 4; ++q) { const int i = q * 512 + tid;
            if (i < N) {
                const unsigned eb = pre_e[q] + (unsigned)__builtin_popcountll(be[q] & lt);
                const unsigned gb = pre_g[q] + (unsigned)__builtin_popcountll(bg[q] & lt);
                const bool isg = key[q] > T, ise = key[q] == T;
                const bool sel = isg || (ise && eb < need);
                const unsigned slot = gb + (eb < need ? eb : need);
                SEL[(size_t)(rowbase + i) * NE + e] = sel ? xbase + (int)slot : -1;
                if (sel) { WSP(float, WS_AFS)[(size_t)e * RPE + xbase + slot] = __builtin_bit_cast(float, key[q]); WSP(int, WS_IDX)[(size_t)e * RPE + xbase + slot] = rowbase + i; }
            } }
        __syncthreads();
    }
}
__device__ __forceinline__ void pj_combine(Frame& F, int l, int probe = 0) {
    int tid_ = threadIdx.x; asm volatile("" : "+v"(tid_));
    const int lane = tid_ & 63, wave_ = __builtin_amdgcn_readfirstlane(tid_ >> 6);
    const int gw = F.vcu * NWAVES + wave_, NGW = F.G * NWAVES; const bool last = l == DEPTH - 1;
    const int nrows = last ? NLAT : NTOK, rpw = (nrows + NGW - 1) / NGW, r0 = gw * rpw, r1 = r0 + rpw < nrows ? r0 + rpw : nrows;
    float* X = WSP(float, WS_X); const int* SEL = WSP(int, WS_SEL);
    const float* gnext = last ? inptr(F, IN_FINALG) : inptr(F, IN_NORM1G) + (l + 1) * DM;
    f32x4 va[4], vb[4], g2[4]; int sa = -1, sb = -1; ModVec m; int cset = -1;
    if (r0 < r1) { load_row_f32(va, X + (size_t)r0 * DM, lane); sa = lane < NE ? SEL[(size_t)r0 * NE + lane] : -1; }
    if (r0 + 1 < r1) { load_row_f32(vb, X + (size_t)(r0 + 1) * DM, lane); sb = lane < NE ? SEL[(size_t)(r0 + 1) * NE + lane] : -1; }
    for (int r = r0; r < r1; ++r) {
        f32x4 v[4], t[4];
#pragma unroll
        for (int j = 0; j < 4; ++j) { v[j] = va[j]; va[j] = vb[j]; t[j] = (f32x4){0.f, 0.f, 0.f, 0.f}; }
        const int selv = sa; sa = sb;
        if (r + 2 < r1) { load_row_f32(vb, X + (size_t)(r + 2) * DM, lane); sb = lane < NE ? SEL[(size_t)(r + 2) * NE + lane] : -1; }
        const int mset = row_modset(r);
        if (mset != cset) { const float* mod = WSP(float, WS_MOD) + ((size_t)l * 9 + mset) * 6 * DM; const float* mod1 = WSP(float, WS_MOD) + ((size_t)(last ? l : l + 1) * 9 + mset) * 6 * DM;
#pragma unroll
            for (int j = 0; j < 4; ++j) g2[j] = *(const f32x4*)(mod + 5 * DM + 4 * lane + 256 * j);
            load_modvec(m, gnext, last ? nullptr : mod1, last ? nullptr : mod1 + DM, lane); cset = mset; }
        for (int e = 0; e < NE; ++e) { const int se = __builtin_amdgcn_readlane(selv, e);
            if (se >= 0) { const GAS v2u* y = (const GAS v2u*)(WSP(bf16, WS_G) + ((size_t)e * RPE + se) * DM) + lane;
#pragma unroll
                for (int j = 0; j < 4; ++j) { const v2u w = y[64 * j]; t[j] += (f32x4){bflo(w.x), bfhi(w.x), bflo(w.y), bfhi(w.y)}; } } }
#pragma unroll
        for (int j = 0; j < 4; ++j) v[j] = v[j] + g2[j] * t[j];
        if (probe) { norm_row_m(v, m); asm volatile("" :: "v"(v[0]), "v"(v[1]), "v"(v[2]), "v"(v[3])); continue; }
        if (!last) {
#pragma unroll
            for (int j = 0; j < 4; ++j) *(f32x4*)(X + (size_t)r * DM + 4 * lane + 256 * j) = v[j];
            norm_row_m(v, m);
            store_row_bf16(WSP(bf16, WS_HN) + (size_t)r * DM, v, lane);
        } else {
            norm_row_m(v, m);
#pragma unroll
            for (int j = 0; j < 4; ++j) *(f32x4*)(F.out + (size_t)r * DM + 4 * lane + 256 * j) = v[j];
        }
    }
}

__device__ __forceinline__ void pc_mixers(Frame& F, int l, int rep) {
    int tid_ = threadIdx.x; asm volatile("" : "+v"(tid_));
    const int lane = tid_ & 63, wave_ = __builtin_amdgcn_readfirstlane(tid_ >> 6);
    const bool need_ctx = l < DEPTH - 1;
    {
        Strided<DecDft> S; S.d.Dm = (const char*)(F.ws + WS_DFT); S.d.Dc = (const char*)(F.ws + WS_DFTC); S.d.ABt = (const char*)(F.dout + DO_ABT); S.d.ABtc = (const char*)(F.dout + DO_ABTC);
        S.n = need_ctx ? 72 : 64; S.G = F.G; S.vcu = F.vcu;
        EpiStore E{WSP(bf16, WS_BR), DM};
        pg8::gemm_phase<EpiStore, Strided<DecDft>>(F.lds, (LAS int*)(F.lds + IDXBUF_OFF), S, E);
    }
    typedef attn_body::bf16 abf;
    const abf* Qg = (const abf*)(F.ws + WS_QKV + QKV_QG); const abf* Kg = (const abf*)(F.ws + WS_QKV + QKV_KG); const abf* Vg = (const abf*)(F.ws + WS_QKV + QKV_VG);
    const abf* Qw = (const abf*)(F.ws + WS_QKV + QKV_QW); const abf* Kw = (const abf*)(F.ws + WS_QKV + QKV_KW); const abf* Vw = (const abf*)(F.ws + WS_QKV + QKV_VW);
    abf* BR = (abf*)(F.ws + WS_BR);
    const int nGL = NBATCH * 2 * 32, nWL = NBATCH * 2 * 16, nGC = need_ctx ? NBATCH * 2 * 4 : 0, nWC = need_ctx ? NBATCH * 2 * 2 : 0, nattn = nGL + nWL + nGC + nWC;
    const int nconv = (CONV_IN_ATTN && F.G == 256 && rep == 0) ? CONV_ITEMS_L0 : 0, ntot = nattn + nconv;
    gu32* head = F.ctl + CW_QUEUE + 64 * (l + 2 * rep);
    const int wid = wave_;
    for (;;) {
        if (tid_ == 0) F.MISC[0] = __hip_atomic_fetch_add(head, 1u, RLX_AGENT);
        __syncthreads();
        const int q = (int)F.MISC[0];
        if (q >= ntot) break;
        const int c0 = (int)(((long long)q * nconv) / ntot), c1 = (int)(((long long)(q + 1) * nconv) / ntot);
        if (c1 > c0) { conv_wave_item(F, (l * CONV_ITEMS_L0 + c0) * NWAVES + wave_, lane); __syncthreads(); continue; }
        const int a = q - c0;
        if (a < nGL) {
            const int b = a >> 6, hkv = (a >> 5) & 1, qb = a & 31, head_ = hkv * 4 + (wid >> 1), q0 = qb * 64 + (wid & 1) * 32; const size_t qrow = (size_t)b * SEQ + q0;
            attn_body::attn_unit<0, 8>(Qg + qrow * 512 + head_ * 64, 512, Kg + (size_t)(NLAT + b * CTX) * 128 + hkv * 64, Kg + (size_t)b * SEQ * 128 + hkv * 64,
                                        Vg + (size_t)(NLAT + b * CTX) * 128 + hkv * 64, Vg + (size_t)b * SEQ * 128 + hkv * 64, 128, 4 + SEQ / 64, 0, 0, 0.f, BR + qrow * DM + 256 + head_ * 64, DM, F.ldsg);
        } else if (a < nGL + nWL) {
            const int u = a - nGL, b = u >> 5, hkv = (u >> 4) & 1, qb = u & 15, head_ = hkv * 2 + (wid >> 2), q0 = qb * 128 + (wid & 3) * 32; const size_t qrow = (size_t)b * SEQ + q0;
            const int band0 = qb * 128 - 128 < 0 ? 0 : qb * 128 - 128, band1 = qb * 128 + 256 > SEQ ? SEQ : qb * 128 + 256;
            attn_body::attn_unit<1, 8>(Qw + qrow * 256 + head_ * 64, 256, Kw + (size_t)(NLAT + b * CTX) * 128 + hkv * 64, Kw + ((size_t)b * SEQ + band0) * 128 + hkv * 64,
                                        Vw + (size_t)(NLAT + b * CTX) * 128 + hkv * 64, Vw + ((size_t)b * SEQ + band0) * 128 + hkv * 64, 128, 4 + (band1 - band0) / 64, q0, band0,
                                        inptr(F, IN_SINK)[l * 4 + head_] * LOG2E, BR + qrow * DM + 768 + head_ * 64, DM, F.ldsg);
        } else if (a < nGL + nWL + nGC) {
            const int u = a - nGL - nWL, b = u >> 3, hkv = (u >> 2) & 1, qb = u & 3, head_ = hkv * 4 + (wid >> 1); const size_t qrow = (size_t)NLAT + b * CTX + qb * 64 + (wid & 1) * 32;
            const abf* Kc = Kg + (size_t)(NLAT + b * CTX) * 128 + hkv * 64; const abf* Vc = Vg + (size_t)(NLAT + b * CTX) * 128 + hkv * 64;
            attn_body::attn_unit<0, 8>(Qg + qrow * 512 + head_ * 64, 512, Kc, Kc, Vc, Vc, 128, 4, 0, 0, 0.f, BR + qrow * DM + 256 + head_ * 64, DM, F.ldsg);
        } else {
            const int u = a - nGL - nWL - nGC, b = u >> 2, hkv = (u >> 1) & 1, qb = u & 1, head_ = hkv * 2 + (wid >> 2); const size_t qrow = (size_t)NLAT + b * CTX + qb * 128 + (wid & 3) * 32;
            const abf* Kc = Kw + (size_t)(NLAT + b * CTX) * 128 + hkv * 64; const abf* Vc = Vw + (size_t)(NLAT + b * CTX) * 128 + hkv * 64;
            attn_body::attn_unit<1, 8>(Qw + qrow * 256 + head_ * 64, 256, Kc, Kc, Vc, Vc, 128, 4, 0, 0, inptr(F, IN_SINK)[l * 4 + head_] * LOG2E, BR + qrow * DM + 768 + head_ * 64, DM, F.ldsg);
        }
    }
    __syncthreads();
}
#ifndef MK_N_LAUNCHES
#define MK_N_LAUNCHES 1
#endif
constexpr int N_PHASES = 2 + 9 * DEPTH;
struct Args { const float* in[21]; float* out; unsigned char* ws; int ph_lo, ph_hi, probe, pad_; };

__global__ void __launch_bounds__(NWAVES * 64, 2) hybrid_fwd(Args args) {
    extern __shared__ __attribute__((aligned(16))) unsigned char lds[];
    Frame F;
    F.lds = (LAS unsigned char*)lds; F.ldsg = (char*)lds; F.MISC = (volatile LAS unsigned*)(F.lds + MISC_OFF);
    F.G = gridDim.x; { const int bx = blockIdx.x; F.vcu = (F.G % 8 == 0) ? (bx % 8) * (F.G / 8) + bx / 8 : bx; }
    F.ws = args.ws; F.out = args.out; F.dout = (unsigned char*)args.out; F.ctl = (gu32*)(args.ws + WS_CTL);
    for (int u = threadIdx.x; u < (LDS_BYTES - LDSCTL_OFF) / 4; u += NWAVES * 64) ((LAS unsigned*)(F.lds + LDSCTL_OFF))[u] = 0u;
    __syncthreads();
    if (threadIdx.x < 21) *(LAS unsigned long long*)(F.lds + PTRS_OFF + 8 * threadIdx.x) = (unsigned long long)args.in[threadIdx.x];
    __syncthreads();
    XcdBarrier bar; bar.bar = (unsigned*)(F.ctl + CW_BAR); bar.x = 0; bar.st = nullptr;
    const int lo = args.ph_lo, hi = args.ph_hi;
    if (hi - lo > 1) bar = xcd_barrier_post((unsigned*)(F.ctl + CW_BAR), F.MISC + 8);
#ifndef PHSEL
#define PHSEL 0x7ff
#endif
#define IN(k) (lo <= (k) && (k) < hi)
#define KIND(j) ((PHSEL >> (j)) & 1)
#ifndef DBG_PROBE
#define DBG_PROBE 0
#endif
#ifndef FPROBE_MODE
#define FPROBE_MODE 0
#endif
#ifndef REP_MASK
#define REP_MASK 0
#endif
#define NREP(j, ok) ((((REP_MASK) >> (j)) & 1) && (ok) ? 2 : 1)
#define REPEAT(j, ok) for (int rep_ = 0, nrep_ = NREP(j, ok); rep_ < nrep_; ++rep_, (rep_ < nrep_ ? xcd_barrier(bar) : (void)0))
#define SEAM(k) do { if (IN(k) && IN((k) + 1)) xcd_barrier(bar); } while (0)

#ifdef BAR_PROBE
    if (hi - lo > 1) for (int i_ = 0; i_ < BAR_PROBE; ++i_) xcd_barrier(bar);
#endif
    if (KIND(0) && IN(0)) REPEAT(0, true) { p0_prologue(F, rep_ ? DBG_PROBE : 0); } SEAM(0);
    if (KIND(1) && IN(1)) REPEAT(1, true) { p1_norm1(F); } SEAM(1);
    for (int l = 0; l < DEPTH; ++l) {
        const int pb = 2 + 9 * l; const bool lastl = l == DEPTH - 1;
        const int nrt = lastl ? 64 : 72;
        if (KIND(2) && IN(pb + 0)) REPEAT(2, true) {
            Strided<DecInProj> S; S.d.A = (const char*)(F.ws + WS_HN); S.d.B = (const char*)(F.ws + WS_WIN) + (size_t)l * INW2 * DM * 2; S.d.layer = l; S.n = inproj_units(l); S.G = F.G; S.vcu = F.vcu;
            EpiInProj E; E.ABt = (bf16*)(F.dout + DO_ABT); E.ABtc = (bf16*)(F.dout + DO_ABTC);
            E.Qg = (bf16*)(F.ws + WS_QKV + QKV_QG); E.Kg = (bf16*)(F.ws + WS_QKV + QKV_KG); E.Vg = (bf16*)(F.ws + WS_QKV + QKV_VG);
            E.Qw = (bf16*)(F.ws + WS_QKV + QKV_QW); E.Kw = (bf16*)(F.ws + WS_QKV + QKV_KW); E.Vw = (bf16*)(F.ws + WS_QKV + QKV_VW);
            E.G = WSP(bf16, WS_G); E.rope = WSP(float, WS_ROPE); E.qng = inptr(F, IN_QNG) + l * 64; E.kng = inptr(F, IN_KNG) + l * 64;
            pg8::gemm_phase<EpiInProj, Strided<DecInProj>>(F.lds, (LAS int*)(F.lds + IDXBUF_OFF), S, E);
            if (!CONV_IN_ATTN && l == 0 && F.G == 256 && F.vcu >= 88 && rep_ == 0) tail_convert(F, F.vcu - 88, 0, 4, 672);
        } SEAM(pb + 0);
        if (KIND(3) && IN(pb + 1)) REPEAT(3, true) { pc_mixers(F, l, rep_); } SEAM(pb + 1);
        if (KIND(4) && IN(pb + 2)) REPEAT(4, true) {
            SchedMerge S; S.BR = (const char*)(F.ws + WS_BR); S.W = (const char*)(F.ws + WS_WBR) + (size_t)l * DM * DM * 2; S.ntiles = nrt * 4; S.G = F.G; S.vcu = F.vcu;
            EpiMerge E{WSP(bf16, WS_G), (rep_ + 1 == nrep_ && !args.probe) ? (bf16*)(F.dout + DO_MB) : WSP(bf16, WS_HN), args.probe};
            pg8::gemm_phase<EpiMerge, SchedMerge>(F.lds, (LAS int*)(F.lds + IDXBUF_OFF), S, E);
            if (!CONV_IN_ATTN && l == 0 && F.G == 256 && F.vcu >= 32 && rep_ == 0) tail_convert(F, F.vcu - 32, 672, 2, 1120);
        } SEAM(pb + 2);
        if (KIND(5) && IN(pb + 3)) REPEAT(5, l == 0) {
            Strided<DecWout> S; S.d.Mb = (const char*)(F.dout + DO_MB); S.d.W = (const char*)(F.ws + WS_WOUT) + (size_t)l * DM * DM * 2; S.n = nrt * 4; S.G = F.G; S.vcu = F.vcu;
            EpiWout E; E.baseL = l == 0 ? inptr(F, IN_X) : WSP(float, WS_X); E.baseC = l == 0 ? inptr(F, IN_CTX) - (size_t)NLAT * DM : WSP(float, WS_X); E.X = WSP(float, WS_X); E.mod = WSP(float, WS_MOD) + (size_t)l * 9 * 6 * DM;
            pg8::gemm_phase<EpiWout, Strided<DecWout>>(F.lds, (LAS int*)(F.lds + IDXBUF_OFF), S, E);
            if (!CONV_IN_ATTN && l == 0 && F.G == 256 && F.vcu >= 32 && rep_ == 0) tail_convert(F, F.vcu - 32, 1120, 5, 2240);
        } SEAM(pb + 3);
        if (KIND(6) && IN(pb + 4)) REPEAT(6, true) { pf_norm2_router(F, l, rep_ ? FPROBE_MODE : 0); } SEAM(pb + 4);
        if (KIND(7) && IN(pb + 5)) REPEAT(7, true) { pg_topk_gather(F, l); } SEAM(pb + 5);
        const int ert = lastl ? 8 : 9;
        if (KIND(8) && IN(pb + 6)) REPEAT(8, true) {
            Strided<DecGU> S; S.d.H2 = (const char*)(F.ws + WS_HN); S.d.IDX = WSP(int, WS_IDX); S.d.W = (const char*)(F.ws + WS_WGU) + (size_t)l * NE * 2 * DM * DM * 2; S.d.nrt = ert; S.n = NE * ert * 8; S.G = F.G; S.vcu = F.vcu;
            EpiGU E{WSP(bf16, WS_HACT)};
            pg8::gemm_phase<EpiGU, Strided<DecGU>>(F.lds, (LAS int*)(F.lds + IDXBUF_OFF), S, E);
            if (!CONV_IN_ATTN && l == 0 && F.G == 256 && F.vcu >= 128 && rep_ == 0) tail_convert(F, F.vcu - 128, 2240, 3, 2624);
        } SEAM(pb + 6);
        if (KIND(9) && IN(pb + 7)) REPEAT(9, true) {
            Strided<DecDown> S; S.d.H = (const char*)(F.ws + WS_HACT); S.d.W = (const char*)(F.ws + WS_WD) + (size_t)l * NE * DM * DM * 2; S.d.nrt = ert; S.n = NE * ert * 4; S.G = F.G; S.vcu = F.vcu;
            EpiDown E{WSP(bf16, WS_G), WSP(float, WS_AFS)};
            pg8::gemm_phase<EpiDown, Strided<DecDown>>(F.lds, (LAS int*)(F.lds + IDXBUF_OFF), S, E);
            if (!CONV_IN_ATTN && l == 0 && F.G == 256 && F.vcu >= 64 && rep_ == 0) tail_convert(F, F.vcu - 64, 2624, 3, CONV_ITEMS);
        } SEAM(pb + 7);
        if (KIND(10) && IN(pb + 8)) REPEAT(10, true) { pj_combine(F, l, rep_); }
        if (!lastl) SEAM(pb + 8);
    }
#undef IN
#undef SEAM
}

extern "C" void kernel_launch(void* const* d_in, const int* in_sizes, int n_in, void* d_out, int out_size, void* d_ws, size_t ws_size, hipStream_t stream) {
    static int grid = 0;
    if (grid == 0) {
        if (n_in != 21 || out_size != NLAT * DM || ws_size < WS_END) { fprintf(stderr, "kernel_launch: unexpected problem (n_in %d, out %d, ws %zu < %zu)\n", n_in, out_size, ws_size, (size_t)WS_END); grid = -1; return; }
        int dev = 0, cus = 0, per_cu = 0;
        if (hipGetDevice(&dev) != hipSuccess || hipDeviceGetAttribute(&cus, hipDeviceAttributeMultiprocessorCount, dev) != hipSuccess) { grid = -1; return; }
        if (hipFuncSetAttribute((const void*)hybrid_fwd, hipFuncAttributeMaxDynamicSharedMemorySize, LDS_BYTES) != hipSuccess) { fprintf(stderr, "kernel_launch: hipFuncSetAttribute failed\n"); grid = -1; return; }
        if (hipOccupancyMaxActiveBlocksPerMultiprocessor(&per_cu, (const void*)hybrid_fwd, NWAVES * 64, LDS_BYTES) != hipSuccess || per_cu < 1) { fprintf(stderr, "kernel_launch: occupancy query says %d blocks/CU\n", per_cu); per_cu = 1; }
        (void)hipGetLastError();
        grid = cus * 1;
    }
    if (grid < 0) return;
    hipMemsetAsync((char*)d_ws + WS_CTL, 0, CTL_ZERO_BYTES, stream);
    Args a; memset(&a, 0, sizeof(a));
    for (int i = 0; i < 21; ++i) a.in[i] = (const float*)d_in[i];
    a.out = (float*)d_out; a.ws = (unsigned char*)d_ws;
#if MK_N_LAUNCHES == 1
    a.ph_lo = 0; a.ph_hi = N_PHASES;
    hipLaunchKernelGGL(hybrid_fwd, dim3(grid), dim3(NWAVES * 64), LDS_BYTES, stream, a);
#else
    for (int p = 0; p < N_PHASES; ++p) { a.ph_lo = p; a.ph_hi = p + 1; hipLaunchKernelGGL(hybrid_fwd, dim3(grid), dim3(NWAVES * 64), LDS_BYTES, stream, a);
#ifdef DBG_DUP_PHASE
        if (p == DBG_DUP_PHASE) { a.probe = DBG_PROBE; hipLaunchKernelGGL(hybrid_fwd, dim3(grid), dim3(NWAVES * 64), LDS_BYTES, stream, a); a.probe = 0; }
#endif
    }
#endif
}
```

```cpp
#define MK_N_LAUNCHES 1
#include <hip/hip_runtime.h>
#include <hip/hip_bf16.h>
#include <cstdio>
#include <cstdint>
#include <cmath>
#include <cstring>

constexpr int DM = 1024, NBATCH = 8, SEQ = 2048, CTX = 256, DEPTH = 2;
constexpr int NLAT = NBATCH * SEQ, NCTX = NBATCH * CTX, NTOK = NLAT + NCTX;
constexpr int INW = 4608, NCOLT = 19, INW2 = NCOLT * 256;
constexpr int NE = 16, CAPL = 256, CAPC = 32, RPE = NBATCH * (CAPL + CAPC);
constexpr float EPS = 1e-6f;
constexpr float QSCALE = 0.125f * 1.4426950408889634f;
constexpr float LOG2E = 1.4426950408889634f;
namespace pg8 {
#define PG8_LAS __attribute__((address_space(3)))
typedef unsigned short bf16_t;
typedef short bf16x8 __attribute__((ext_vector_type(8)));
typedef float f32x4 __attribute__((ext_vector_type(4)));
typedef unsigned u32x4 __attribute__((ext_vector_type(4)));
typedef unsigned u32x2 __attribute__((ext_vector_type(2)));
constexpr int BM = 256, BK = 64, HALF = 128, HTB = HALF * BK * 2  , STAGE_BYTES = 8 * HTB;

__host__ __device__ __forceinline__ int lds_byte(int r, int c) { const int st = (r >> 4) * 2 + (c >> 5), rr = r & 15, cc = c & 31, ob = rr * 64 + cc * 2; return st * 1024 + (ob ^ (((ob >> 9) & 1) << 5)); }
__host__ __device__ __forceinline__ int perm32(int rho) { const int n = rho >> 4, i = rho & 15; return 8 * (i >> 2) + 4 * n + (i & 3); }
__host__ __device__ __forceinline__ void stage_rc(int b, int& R, int& C) { const int st = b / 1024, sb = b % 1024, swz = sb ^ (((sb >> 9) & 1) << 5); R = (st >> 1) * 16 + swz / 64; C = (st & 1) * 32 + (swz % 64) / 2; }

struct Unit { const char* A; const char* B; const int* arows; int ldA, ldB, nt; int pm, pn, tag; };

__device__ __forceinline__ unsigned cvt_pk_bf16(float lo, float hi) { unsigned r; asm volatile("v_cvt_pk_bf16_f32 %0, %1, %2" : "=v"(r) : "v"(lo), "v"(hi)); return r; }

template <class Epi, class Sched>
__device__ __forceinline__ void gemm_phase(PG8_LAS unsigned char* lds, PG8_LAS int* idxbuf  , const Sched& S, const Epi& E) {
    int tid = threadIdx.x; asm volatile("" : "+v"(tid));
    const int wid = __builtin_amdgcn_readfirstlane(tid >> 6), lane = tid & 63, wr = wid >> 2, wc = wid & 3, fr = lane & 15, fq = lane >> 4;
    unsigned Rr[2], RrB[2], Cc2[2];
#pragma unroll
    for (int i = 0; i < 2; ++i) { int R, C; stage_rc(tid * 16 + i * 8192, R, C); Rr[i] = (unsigned)R; RrB[i] = Epi::PERM ? (unsigned)((R & ~31) + perm32(R & 31)) : (unsigned)R; Cc2[i] = (unsigned)C * 2u; }
    const size_t kstep = (size_t)(BK * 2);
    const unsigned ldsw = (unsigned)wid * 1024u;
    const int aoff = lds_byte(wr * 64 + fr, fq * 8), boff = lds_byte(wc * 32 + fr, fq * 8);
#define PG8_SA(b, h) (((b) * 2 + (h)) * HTB)
#define PG8_SB(b, h) ((4 + (b) * 2 + (h)) * HTB)
#define PG8_STAGE(bufoff, gbase, ld) do { _Pragma("unroll") for (int _i = 0; _i < 2; ++_i) \
        __builtin_amdgcn_global_load_lds((const unsigned*)((const char*)(gbase) + (RrB[_i] * (unsigned)(ld) + Cc2[_i])), (PG8_LAS unsigned*)(lds + (bufoff) + ldsw + _i * 8192), 16, 0, 0); } while (0)
#define PG8_STAGE_A(bufoff, gbase, ao) do { _Pragma("unroll") for (int _i = 0; _i < 2; ++_i) \
        __builtin_amdgcn_global_load_lds((const unsigned*)((const char*)(gbase) + (ao)[_i]), (PG8_LAS unsigned*)(lds + (bufoff) + ldsw + _i * 8192), 16, 0, 0); } while (0)
#define PG8_AOFF(u, ao) do { _Pragma("unroll") for (int _h = 0; _h < 2; ++_h) _Pragma("unroll") for (int _i = 0; _i < 2; ++_i) { \
        const unsigned _row = (u).arows ? (unsigned)idxbuf[Rr[_i] + 128 * _h] : Rr[_i] + 128u * _h; (ao)[_h][_i] = _row * (unsigned)(u).ldA + Cc2[_i]; } } while (0)
#define PG8_STAGE_IDX(u) do { if ((u).arows) __builtin_amdgcn_global_load_lds((const unsigned*)((u).arows + (wid & 3) * 64 + lane), (PG8_LAS unsigned*)((PG8_LAS unsigned char*)idxbuf + (wid & 3) * 256), 4, 0, 0); } while (0)
#define PG8_LDA(dst, b, h) do { _Pragma("unroll") for (int m = 0; m < 4; ++m) _Pragma("unroll") for (int k = 0; k < 2; ++k) dst[m][k] = *(const PG8_LAS bf16x8*)(lds + PG8_SA(b, h) + aoff + m * 2048 + k * 1024); } while (0)
#define PG8_LDB(dst, b, h) do { _Pragma("unroll") for (int n = 0; n < 2; ++n) _Pragma("unroll") for (int k = 0; k < 2; ++k) dst[n][k] = *(const PG8_LAS bf16x8*)(lds + PG8_SB(b, h) + boff + n * 2048 + k * 1024); } while (0)
#define PG8_MMA(ai, bj, At, Bt) do { __builtin_amdgcn_s_setprio(1); _Pragma("unroll") for (int m = 0; m < 4; ++m) _Pragma("unroll") for (int n = 0; n < 2; ++n) _Pragma("unroll") for (int k = 0; k < 2; ++k) \
        acc[ai][bj][m][n] = __builtin_amdgcn_mfma_f32_16x16x32_bf16(Bt[n][k], At[m][k], acc[ai][bj][m][n], 0, 0, 0); __builtin_amdgcn_s_setprio(0); } while (0)
#define PG8_WAIT_V(n) asm volatile("s_waitcnt vmcnt(" #n ")" ::: "memory")
#define PG8_WAIT_L(n) asm volatile("s_waitcnt lgkmcnt(" #n ")" ::: "memory")
#define PG8_BAR __builtin_amdgcn_s_barrier()
#define PG8_SCHED __builtin_amdgcn_sched_barrier(0)
    Unit cur, nxt; int ui = 0;
    if (!S.next(0, cur)) return;
    nxt = cur;
    f32x4 acc[2][2][4][2];
#pragma unroll
    for (int a = 0; a < 2; ++a)
#pragma unroll
        for (int b = 0; b < 2; ++b)
#pragma unroll
            for (int m = 0; m < 4; ++m)
#pragma unroll
                for (int n = 0; n < 2; ++n) acc[a][b][m][n] = (f32x4){0.f, 0.f, 0.f, 0.f};
    bf16x8 At[4][2], B0[2][2], B1[2][2];
    const char* cA = cur.A; const char* cB = cur.B; int clb = cur.ldB;
    unsigned ao_c[2][2], ao_n[2][2];
    if (cur.arows) { PG8_STAGE_IDX(cur); PG8_WAIT_V(0); PG8_BAR; }
    PG8_AOFF(cur, ao_c);
#pragma unroll
    for (int _h = 0; _h < 2; ++_h)
#pragma unroll
        for (int _i = 0; _i < 2; ++_i) ao_n[_h][_i] = ao_c[_h][_i];
    if (cur.arows) { PG8_WAIT_L(0); PG8_BAR; }
    {
        const size_t hB = (size_t)HALF * clb;
        PG8_STAGE(PG8_SB(0, 0), cB, clb); PG8_STAGE(PG8_SB(0, 1), cB + hB, clb); PG8_STAGE_A(PG8_SA(0, 0), cA, ao_c[0]); PG8_STAGE_A(PG8_SA(0, 1), cA, ao_c[1]);
        if (wr == 1) PG8_BAR;
        PG8_WAIT_V(2); PG8_BAR;
        PG8_STAGE(PG8_SB(1, 0), cB + kstep, clb); PG8_STAGE_A(PG8_SA(1, 0), cA + kstep, ao_c[0]); PG8_STAGE(PG8_SB(1, 1), cB + hB + kstep, clb);
        PG8_WAIT_V(6); PG8_BAR;
    }
    for (;;) {
        const bool has_next = S.next(ui + 1, nxt);
        const char* nA = has_next ? nxt.A : cA; const char* nB = has_next ? nxt.B : cB; const int nlb = has_next ? nxt.ldB : clb;
        const int nt = cur.nt;
        if (has_next) PG8_STAGE_IDX(nxt);
        for (int t = 0; t < nt; t += 2) {
            const bool last = (t == nt - 2);
            if (last) { if (has_next) { PG8_AOFF(nxt, ao_n); } else {
#pragma unroll
                for (int _h = 0; _h < 2; ++_h)
#pragma unroll
                    for (int _i = 0; _i < 2; ++_i) ao_n[_h][_i] = ao_c[_h][_i]; } }
            unsigned ao2[2][2];
#pragma unroll
            for (int _h = 0; _h < 2; ++_h)
#pragma unroll
                for (int _i = 0; _i < 2; ++_i) ao2[_h][_i] = last ? ao_n[_h][_i] : ao_c[_h][_i];
            const char* a1 = cA + (size_t)(t + 1) * kstep;
            const char* a2 = last ? nA : cA + (size_t)(t + 2) * kstep; const char* b2 = last ? nB : cB + (size_t)(t + 2) * kstep;
            const int lb2 = last ? nlb : clb;
            const size_t hB2 = (size_t)HALF * lb2;
            const char* a3 = a2 + kstep; const char* b3 = b2 + kstep;
            PG8_LDB(B0, 0, 0); PG8_LDB(B1, 0, 1); PG8_SCHED; PG8_LDA(At, 0, 0); PG8_STAGE_A(PG8_SA(1, 1), a1, ao_c[1]);
            PG8_WAIT_V(8); PG8_WAIT_L(0); PG8_BAR; PG8_MMA(0, 0, At, B0); PG8_MMA(0, 1, At, B1); PG8_BAR; PG8_SCHED;
            PG8_LDA(At, 0, 1); PG8_STAGE(PG8_SB(0, 0), b2, lb2); PG8_STAGE(PG8_SB(0, 1), b2 + hB2, lb2); PG8_STAGE_A(PG8_SA(0, 0), a2, ao2[0]);
            PG8_WAIT_V(8); PG8_WAIT_L(0); PG8_BAR; PG8_MMA(1, 0, At, B0); PG8_MMA(1, 1, At, B1); PG8_BAR; PG8_SCHED;
            PG8_LDB(B0, 1, 0); PG8_LDB(B1, 1, 1); PG8_SCHED; PG8_LDA(At, 1, 0); PG8_STAGE_A(PG8_SA(0, 1), a2, ao2[1]);
            PG8_WAIT_V(8); PG8_WAIT_L(0); PG8_BAR; PG8_MMA(0, 0, At, B0); PG8_MMA(0, 1, At, B1); PG8_BAR; PG8_SCHED;
            PG8_LDA(At, 1, 1); PG8_STAGE(PG8_SB(1, 0), b3, lb2); PG8_STAGE(PG8_SB(1, 1), b3 + hB2, lb2); PG8_STAGE_A(PG8_SA(1, 0), a3, ao2[0]);
            PG8_WAIT_V(8); PG8_WAIT_L(0); PG8_BAR; PG8_MMA(1, 0, At, B0); PG8_MMA(1, 1, At, B1); PG8_BAR; PG8_SCHED;
        }
        if (wr == 0) PG8_BAR;
        bool keep_acc;
        { Unit eu = cur; int ewr = wr, ewc = wc, efr = fr, efq = fq; asm volatile("" : "+s"(eu.pm), "+s"(eu.pn), "+s"(eu.tag), "+s"(ewr), "+s"(ewc), "+v"(efr), "+v"(efq));
          keep_acc = E(acc, eu, ewr, ewc, efr, efq); }
        if (!has_next) break;
        if (!keep_acc) {
#pragma unroll
        for (int a = 0; a < 2; ++a)
#pragma unroll
            for (int b = 0; b < 2; ++b)
#pragma unroll
                for (int m = 0; m < 4; ++m)
#pragma unroll
                    for (int n = 0; n < 2; ++n) acc[a][b][m][n] = (f32x4){0.f, 0.f, 0.f, 0.f};
        }
        cur = nxt; cA = nA; cB = nB; clb = nlb; ++ui;
#pragma unroll
        for (int _h = 0; _h < 2; ++_h)
#pragma unroll
            for (int _i = 0; _i < 2; ++_i) ao_c[_h][_i] = ao_n[_h][_i];
        if (wr == 1) PG8_BAR;
    }
    PG8_WAIT_V(0);
    PG8_BAR;
#undef PG8_SA
#undef PG8_SB
#undef PG8_STAGE
#undef PG8_STAGE_A
#undef PG8_AOFF
#undef PG8_STAGE_IDX
#undef PG8_LDA
#undef PG8_LDB
#undef PG8_MMA
#undef PG8_WAIT_V
#undef PG8_WAIT_L
#undef PG8_BAR
#undef PG8_SCHED
}
}
#include <hip/hip_bf16.h>
#include <cmath>
namespace attn_body {
using bf16=__hip_bfloat16;
using bf16x8=__attribute__((ext_vector_type(8)))short;
using s16x4=__attribute__((ext_vector_type(4)))short;
using f32x16=__attribute__((ext_vector_type(16)))float;
using u32x4=__attribute__((ext_vector_type(4)))unsigned;
constexpr int D=64;
constexpr int NW=8,QBLK=32,KVBLK=64,NCT=4;
__device__ __forceinline__ int crow(int r,int hi){return (r&3)+8*(r>>2)+4*hi;}
#define SBAR() __builtin_amdgcn_sched_barrier(0)
__device__ __forceinline__ void wmask(f32x16&p0,f32x16&p1,int kb,int qabs,int hi){
  const float NEG=-INFINITY; const int d0=kb+4*hi-qabs;
  #pragma unroll
  for(int r=0;r<16;++r){int dd=d0+(r&3)+8*(r>>2); if(dd>128||dd<-128)p0[r]=NEG; if(dd+32>128||dd+32<-128)p1[r]=NEG;}
}

constexpr int NSLOT=3, SLOTB=8192;
constexpr int LDS_K=0, LDS_V=NSLOT*SLOTB, LDS_WS=2*NSLOT*SLOTB, LDS_OST=LDS_WS+NW*64*4, LDS_BYTES=LDS_OST+NW*4096;
__device__ __forceinline__ void glds16(const void*gsrc,unsigned lds_dst){unsigned keep;
  asm volatile("s_mov_b32 %0, m0\n\ts_mov_b32 m0, %2\n\ts_nop 0\n\tglobal_load_lds_dwordx4 %1, off\n\ts_mov_b32 m0, %0":"=&s"(keep):"v"(gsrc),"s"(lds_dst):"memory");}
__device__ __forceinline__ float max3f(float a,float b,float c){float r;asm("v_max3_f32 %0, %1, %2, %3":"=v"(r):"v"(a),"v"(b),"v"(c));return r;}
__device__ __forceinline__ float max2f(float a,float b){float r;asm("v_max_f32_e32 %0, %1, %2":"=v"(r):"v"(a),"v"(b));return r;}
__device__ __forceinline__ float fadd_s(float a,float b){float r;asm("v_add_f32_e32 %0, %1, %2":"=v"(r):"v"(a),"v"(b));return r;}
__device__ __forceinline__ float fsub_s(float a,float b){float r;asm("v_sub_f32_e32 %0, %1, %2":"=v"(r):"v"(a),"v"(b));return r;}
typedef float f32x2_t __attribute__((ext_vector_type(2))); typedef __bf16 bf16x2_t __attribute__((ext_vector_type(2)));
__device__ __forceinline__ unsigned cvtpk_s(float lo,float hi){f32x2_t v={lo,hi};bf16x2_t b=__builtin_convertvector(v,bf16x2_t);return __builtin_bit_cast(unsigned,b);}
#define WAIT_BAR(N) asm volatile("s_waitcnt vmcnt(" #N ") lgkmcnt(0)\n\ts_barrier":::"memory")

__device__ __forceinline__ void qkt(f32x16&p0,f32x16&p1,const char*Kslot,const bf16x8*qr,const f32x16&negm,int r32,int hi){
  const char*kb=Kslot+hi*1024+r32*16;
  #pragma unroll
  for(int d0=0;d0<4;++d0){
    const bf16x8 b0=*reinterpret_cast<const bf16x8*>(kb+d0*2048);
    const bf16x8 b1=*reinterpret_cast<const bf16x8*>(kb+d0*2048+512);
    if(d0==0){p0=__builtin_amdgcn_mfma_f32_32x32x16_bf16(b0,qr[0],negm,0,0,0);p1=__builtin_amdgcn_mfma_f32_32x32x16_bf16(b1,qr[0],negm,0,0,0);}
    else{p0=__builtin_amdgcn_mfma_f32_32x32x16_bf16(b0,qr[d0],p0,0,0,0);p1=__builtin_amdgcn_mfma_f32_32x32x16_bf16(b1,qr[d0],p1,0,0,0);}}
}
typedef __attribute__((address_space(3))) const char* lds_cptr;
typedef short v4i16_t __attribute__((ext_vector_type(4)));
__device__ __forceinline__ void kload8(bf16x8*kf,lds_cptr kp){
  kf[0]=*(const __attribute__((address_space(3))) bf16x8*)(kp);      kf[1]=*(const __attribute__((address_space(3))) bf16x8*)(kp+512);
  kf[2]=*(const __attribute__((address_space(3))) bf16x8*)(kp+2048); kf[3]=*(const __attribute__((address_space(3))) bf16x8*)(kp+2560);
  kf[4]=*(const __attribute__((address_space(3))) bf16x8*)(kp+4096); kf[5]=*(const __attribute__((address_space(3))) bf16x8*)(kp+4608);
  kf[6]=*(const __attribute__((address_space(3))) bf16x8*)(kp+6144); kf[7]=*(const __attribute__((address_space(3))) bf16x8*)(kp+6656);
}
__device__ __forceinline__ void kload2(bf16x8*kf,lds_cptr kp,int j){ kf[2*j]=*(const __attribute__((address_space(3))) bf16x8*)(kp+j*2048); kf[2*j+1]=*(const __attribute__((address_space(3))) bf16x8*)(kp+j*2048+512); }
__device__ __forceinline__ s16x4 vtr(lds_cptr p){ return __builtin_bit_cast(s16x4,__builtin_amdgcn_ds_read_tr16_b64_v4i16((__attribute__((address_space(3))) v4i16_t*)p)); }
__device__ __forceinline__ float rowmax(const f32x16&p0,const f32x16&p1){
  float a=max3f(p0[0],p0[1],p1[0]),b=max3f(p0[2],p0[3],p1[1]);a=max3f(a,p1[2],p1[3]);
  #pragma unroll
  for(int r=4;r<16;r+=4){a=max3f(a,p0[r],p0[r+1]);b=max3f(b,p0[r+2],p0[r+3]);a=max3f(a,p1[r],p1[r+1]);b=max3f(b,p1[r+2],p1[r+3]);}
  const float m=max2f(a,b);
  auto rr=__builtin_amdgcn_permlane32_swap(__float_as_uint(m),__float_as_uint(m),false,false);
  return max2f(__uint_as_float(rr[0]),__uint_as_float(rr[1]));
}
__device__ __forceinline__ void pv(f32x16*o,int vb,bf16x8 pa0,bf16x8 pa1,bf16x8 pa2,bf16x8 pa3){
  #pragma unroll
  for(int d0=0;d0<2;++d0){s16x4 lo[4],hi[4];
    #pragma unroll
    for(int ks=0;ks<4;++ks){
      asm volatile("ds_read_b64_tr_b16 %0,%1 offset:%c2":"=&v"(lo[ks]):"v"(vb),"i"(d0*4096+ks*1024):"memory");
      asm volatile("ds_read_b64_tr_b16 %0,%1 offset:%c2":"=&v"(hi[ks]):"v"(vb),"i"(d0*4096+ks*1024+512):"memory");}
    asm volatile("s_waitcnt lgkmcnt(0)":::"memory");SBAR();
    #define PK(k) (bf16x8){lo[k][0],lo[k][1],lo[k][2],lo[k][3],hi[k][0],hi[k][1],hi[k][2],hi[k][3]}
    o[d0]=__builtin_amdgcn_mfma_f32_32x32x16_bf16(pa0,PK(0),o[d0],0,0,0);
    o[d0]=__builtin_amdgcn_mfma_f32_32x32x16_bf16(pa1,PK(1),o[d0],0,0,0);
    o[d0]=__builtin_amdgcn_mfma_f32_32x32x16_bf16(pa2,PK(2),o[d0],0,0,0);
    o[d0]=__builtin_amdgcn_mfma_f32_32x32x16_bf16(pa3,PK(3),o[d0],0,0,0);
    #undef PK
  }
}

#ifndef ATTN_STORE16
#define ATTN_STORE16(p,v) (*(u32x4*)(p)=(v))
#endif
template<int MODE,int THRL> __device__ __forceinline__ void attn_unit(const bf16*Qw,int qp,const bf16*Kc,const bf16*Kl,const bf16*Vc,const bf16*Vl,int kp,int NT,int qabs,int band0,float sinkl2,bf16*Ow,int op,char*shm){
  int tid=threadIdx.x; asm volatile("":"+v"(tid));
  const int lane=tid&63,r32=lane&31,hi=lane>>5; const int wid=__builtin_amdgcn_readfirstlane(tid>>6);
  qabs+=r32;
  const unsigned lds0=(unsigned)(uintptr_t)shm;
  float*wsf=(float*)(shm+LDS_WS)+wid*64;
  const unsigned koff_=(unsigned)(lane*kp+wid*8)*2u;
  const unsigned voff_=(unsigned)((16*(wid&3)+(lane>>2))*kp+(wid>>2)*32+(lane&3)*8)*2u;
  const unsigned kdst=lds0+LDS_K+wid*1024, vdst=lds0+LDS_V+wid*1024;
  #define DMA_K(t,slot) glds16((const char*)((t)<NCT?Kc+(long)(t)*KVBLK*kp:Kl+(long)((t)-NCT)*KVBLK*kp)+koff_,(unsigned)__builtin_amdgcn_readfirstlane(kdst+(slot)))
  #define DMA_V(t,slot) glds16((const char*)((t)<NCT?Vc+(long)(t)*KVBLK*kp:Vl+(long)((t)-NCT)*KVBLK*kp)+voff_,(unsigned)__builtin_amdgcn_readfirstlane(vdst+(slot)))
  const int vb0=(int)(lds0+LDS_V)+((lane>>4)&1)*32+(lane&3)*8+(4*hi+((lane&15)>>2))*64;
  const char*Kbase=shm+LDS_K; bf16x8 kf[8];
  const lds_cptr shm3=(lds_cptr)shm; const lds_cptr kp0=shm3+LDS_K+hi*1024+r32*16; const lds_cptr vp0=shm3+LDS_V+((lane>>4)&1)*32+(lane&3)*8+(4*hi+((lane&15)>>2))*64;
  DMA_K(0,0);DMA_V(0,0);DMA_K(1,SLOTB);
  bf16x8 qr[4];
  #pragma unroll
  for(int d0=0;d0<4;++d0)qr[d0]=*reinterpret_cast<const bf16x8*>(&Qw[(long)r32*qp+d0*16+hi*8]);
  float mhat=0.f,l_reg=0.f;f32x16 o[2];o[0]=f32x16{};o[1]=f32x16{};f32x16 negm=f32x16{};asm volatile("":"+v"(negm));
  #define CMASK(P0,P1,t) do{ if(MODE==1){ if((t)>=NCT)wmask(P0,P1,band0+KVBLK*((t)-NCT),qabs,hi);} }while(0)
  bool resc=false;
  #define START(P0,P1) do{ const float rm=rowmax(P0,P1); resc=false; \
    { const float dl=rm; mhat=fadd_s(mhat,dl); \
      _Pragma("unroll") for(int r=0;r<16;++r){P0[r]=fsub_s(P0[r],dl);P1[r]=fsub_s(P1[r],dl);} \
      _Pragma("unroll") for(int r=0;r<16;++r)negm[r]=-mhat; asm volatile("":"+v"(negm)); } \
    _Pragma("unroll") for(int r=0;r<16;++r)P0[r]=__builtin_amdgcn_exp2f(P0[r]); }while(0)
  #define RESC() do{ if(resc){ asm volatile("s_waitcnt lgkmcnt(0)":::"memory"); \
      _Pragma("unroll") for(int d_=0;d_<2;++d_) _Pragma("unroll") for(int r=0;r<16;++r)o[d_][r]*=wsf[crow(r,hi)]; } }while(0)
  f32x16 pA0,pA1,pB0,pB1;
  int sl_prev=0,sl_cur=0,sl_next=SLOTB;
  #define ROT() do{sl_prev=sl_cur;sl_cur=sl_next;sl_next=(sl_next==(NSLOT-1)*SLOTB)?0:sl_next+SLOTB;}while(0)
  DMA_K(2,2*SLOTB);
  WAIT_BAR(3);
  qkt(pA0,pA1,Kbase,qr,negm,r32,hi);asm volatile("s_nop 15\n\ts_nop 7":"+v"(pA0),"+v"(pA1));CMASK(pA0,pA1,0);
  START(pA0,pA1);
  _Pragma("unroll") for(int r=0;r<16;++r)pA1[r]=__builtin_amdgcn_exp2f(pA1[r]);
  WAIT_BAR(0);
  DMA_K(3,0);DMA_V(1,SLOTB);
  ROT();
  kload8(kf,kp0+sl_cur);
  WAIT_BAR(2);
  s16x4 vlo[8],vhi[8]; u32x4 pw0,pw1,pw2,pw3;
  #define PKW(P,B) cvtpk_s(P[B],P[B+1])
  #define PAF(k) __builtin_bit_cast(bf16x8,pw##k)
  #define VFR(i) (bf16x8){vlo[i][0],vlo[i][1],vlo[i][2],vlo[i][3],vhi[i][0],vhi[i][1],vhi[i][2],vhi[i][3]}
  #define PIN(x) asm volatile("":"+v"(x))
  #define MX3(a,b,c) __builtin_fmaxf(__builtin_fmaxf((a),(b)),(c))
  #define GAPA(MF,A0,A1,A2,A3,W0,W1,PW) do{ MF; sacc+=A0; sacc+=A1; sacc+=A2; sacc+=A3; PIN(sacc); W0; W1; PIN(PW); SBAR(); }while(0)
  #define EX(v) __builtin_amdgcn_exp2f(v)
  #define GAPB(MF,X,B) do{ MF; X[B]=EX(X[B]); X[B+1]=EX(X[B+1]); X[B+2]=EX(X[B+2]); X[B+3]=EX(X[B+3]); PIN(X); SBAR(); }while(0)
  #define VRD(i) do{ vlo[i]=vtr(vp_+(((i)>>2)*4096+((i)&3)*1024)); vhi[i]=vtr(vp_+(((i)>>2)*4096+((i)&3)*1024+512)); }while(0)
  #define KRD(G,j) do{ if(G){ kload2(kf,kp0+sl_next,j); SBAR(); } }while(0)
  #define STEP(C0,C1,P0,P1,t,GK,GV,GL) do{ SBAR(); \
    const lds_cptr vp_=vp0+sl_prev; \
    VRD(0); SBAR(); float sacc=(P0[0]+P0[1]); \
    GAPA(C0=__builtin_amdgcn_mfma_f32_32x32x16_bf16(kf[0],qr[0],negm,0,0,0), P0[2],P0[3],P0[4],P0[5],     pw0[0]=PKW(P0,0), pw0[1]=PKW(P0,2), pw0); \
    VRD(4); SBAR(); GAPA(C1=__builtin_amdgcn_mfma_f32_32x32x16_bf16(kf[1],qr[0],negm,0,0,0), P0[6],P0[7],P0[8],P0[9],     pw0[2]=PKW(P0,4), pw0[3]=PKW(P0,6), pw0); \
    VRD(1); SBAR(); GAPA(C0=__builtin_amdgcn_mfma_f32_32x32x16_bf16(kf[2],qr[1],C0,0,0,0),   P0[10],P0[11],P0[12],P0[13], pw1[0]=PKW(P0,8), pw1[1]=PKW(P0,10), pw1); \
    VRD(5); SBAR(); GAPA(C1=__builtin_amdgcn_mfma_f32_32x32x16_bf16(kf[3],qr[1],C1,0,0,0),   P0[14],P0[15],P1[0],P1[1],   pw1[2]=PKW(P0,12),pw1[3]=PKW(P0,14), pw1); \
    VRD(2); SBAR(); GAPA(C0=__builtin_amdgcn_mfma_f32_32x32x16_bf16(kf[4],qr[2],C0,0,0,0),   P1[2],P1[3],P1[4],P1[5],     pw2[0]=PKW(P1,0), pw2[1]=PKW(P1,2), pw2); \
    VRD(6); SBAR(); GAPA(C1=__builtin_amdgcn_mfma_f32_32x32x16_bf16(kf[5],qr[2],C1,0,0,0),   P1[6],P1[7],P1[8],P1[9],     pw2[2]=PKW(P1,4), pw2[3]=PKW(P1,6), pw2); \
    VRD(3); SBAR(); GAPA(C0=__builtin_amdgcn_mfma_f32_32x32x16_bf16(kf[6],qr[3],C0,0,0,0),   P1[10],P1[11],P1[12],P1[13], pw3[0]=PKW(P1,8), pw3[1]=PKW(P1,10), pw3); \
    VRD(7); SBAR(); GAPA(C1=__builtin_amdgcn_mfma_f32_32x32x16_bf16(kf[7],qr[3],C1,0,0,0),   P1[14],P1[15],0.f,0.f,       pw3[2]=PKW(P1,12),pw3[3]=PKW(P1,14), pw3); \
    l_reg+=sacc; \
    if(GK){DMA_K((t)+3,sl_cur);} if(GV){DMA_V((t)+1,sl_next);} \
    CMASK(C0,C1,t); \
    { float a=MX3(C0[0],C0[1],C1[0]),b=MX3(C0[2],C0[3],C1[1]); a=MX3(a,C1[2],C1[3]); \
      _Pragma("unroll") for(int r=4;r<16;r+=4){a=MX3(a,C0[r],C0[r+1]);b=MX3(b,C0[r+2],C0[r+3]);a=MX3(a,C1[r],C1[r+1]);b=MX3(b,C1[r+2],C1[r+3]);} \
      float rm=__builtin_fmaxf(a,b); { auto rr=__builtin_amdgcn_permlane32_swap(__float_as_uint(rm),__float_as_uint(rm),false,false); rm=__builtin_fmaxf(__uint_as_float(rr[0]),__uint_as_float(rr[1])); } \
      resc=false; \
      if(__builtin_expect(__any(rm>(float)THRL),0)){ const float dl=__builtin_fmaxf(rm,0.f); mhat+=dl; \
        _Pragma("unroll") for(int r=0;r<16;++r){C0[r]-=dl;C1[r]-=dl;} \
        _Pragma("unroll") for(int r=0;r<16;++r)negm[r]=-mhat; asm volatile("":"+v"(negm)); \
        const float f=__builtin_amdgcn_exp2f(-dl); l_reg*=f; if(hi==0)wsf[r32]=f; resc=true; } } \
    SBAR(); \
    GAPB(o[0]=__builtin_amdgcn_mfma_f32_32x32x16_bf16(PAF(0),VFR(0),o[0],0,0,0), C0,0); \
    GAPB(o[1]=__builtin_amdgcn_mfma_f32_32x32x16_bf16(PAF(0),VFR(4),o[1],0,0,0), C0,4); \
    KRD(GL,0); GAPB(o[0]=__builtin_amdgcn_mfma_f32_32x32x16_bf16(PAF(1),VFR(1),o[0],0,0,0), C0,8); \
    KRD(GL,1); GAPB(o[1]=__builtin_amdgcn_mfma_f32_32x32x16_bf16(PAF(1),VFR(5),o[1],0,0,0), C0,12); \
    KRD(GL,2); GAPB(o[0]=__builtin_amdgcn_mfma_f32_32x32x16_bf16(PAF(2),VFR(2),o[0],0,0,0), C1,0); \
    KRD(GL,3); GAPB(o[1]=__builtin_amdgcn_mfma_f32_32x32x16_bf16(PAF(2),VFR(6),o[1],0,0,0), C1,4); \
    GAPB(o[0]=__builtin_amdgcn_mfma_f32_32x32x16_bf16(PAF(3),VFR(3),o[0],0,0,0), C1,8); \
    GAPB(o[1]=__builtin_amdgcn_mfma_f32_32x32x16_bf16(PAF(3),VFR(7),o[1],0,0,0), C1,12); \
    }while(0)
  int t=1;
  for(;t+5<NT;t+=2){
    STEP(pB0,pB1,pA0,pA1,t,true,true,true);     WAIT_BAR(2); RESC(); ROT();
    STEP(pA0,pA1,pB0,pB1,t+1,true,true,true);   WAIT_BAR(2); RESC(); ROT();
  }
  #define ENDW(tt) do{ if((tt)+3<NT){WAIT_BAR(2);} else if((tt)+2<NT){WAIT_BAR(1);} else {WAIT_BAR(0);} }while(0)
  for(;t+1<NT;t+=2){
    STEP(pB0,pB1,pA0,pA1,t,(t+3<NT),(t+1<NT),(t+1<NT));       ENDW(t);   RESC(); ROT();
    STEP(pA0,pA1,pB0,pB1,t+1,(t+4<NT),(t+2<NT),(t+2<NT));     ENDW(t+1); RESC(); ROT();
  }
  STEP(pB0,pB1,pA0,pA1,NT-1,false,false,false); RESC();
  { float sacc=pB0[0]+pB0[1]; _Pragma("unroll") for(int r=2;r<16;++r)sacc+=pB0[r]; _Pragma("unroll") for(int r=0;r<16;++r)sacc+=pB1[r]; l_reg+=sacc;
    pw0=(u32x4){PKW(pB0,0),PKW(pB0,2),PKW(pB0,4),PKW(pB0,6)};pw1=(u32x4){PKW(pB0,8),PKW(pB0,10),PKW(pB0,12),PKW(pB0,14)};pw2=(u32x4){PKW(pB1,0),PKW(pB1,2),PKW(pB1,4),PKW(pB1,6)};pw3=(u32x4){PKW(pB1,8),PKW(pB1,10),PKW(pB1,12),PKW(pB1,14)};
    SBAR(); pv(o,vb0+sl_cur,PAF(0),PAF(1),PAF(2),PAF(3)); }
  #undef PKW
  #undef PAF
  #undef VFR
  #undef PIN
  #undef MX3
  #undef GAPA
  #undef GAPB
  #undef EX
  #undef VRD
  #undef KRD
  #undef STEP
  #undef ENDW
  {auto rr=__builtin_amdgcn_permlane32_swap(__float_as_uint(l_reg),__float_as_uint(l_reg),false,false);l_reg=__uint_as_float(rr[0])+__uint_as_float(rr[1]);}
  if(MODE==1)l_reg+=__builtin_amdgcn_exp2f(sinkl2-mhat);
  if(hi==0)wsf[32+r32]=l_reg;asm volatile("s_waitcnt lgkmcnt(0)":::"memory");
  float rli[16];
  #pragma unroll
  for(int r=0;r<16;++r)rli[r]=__builtin_amdgcn_rcpf(wsf[32+crow(r,hi)]);
  { bf16*stg=(bf16*)(shm+LDS_OST)+wid*2048;
    #pragma unroll
    for(int r=0;r<16;++r){const int orow=crow(r,hi);
      #pragma unroll
      for(int d0=0;d0<2;++d0)stg[orow*64+d0*32+r32]=__float2bfloat16(o[d0][r]*rli[r]);}
    asm volatile("s_waitcnt lgkmcnt(0)":::"memory");
    #pragma unroll
    for(int i=0;i<4;++i){const int row=i*8+(lane>>3),ch=lane&7; const u32x4 v=*(const u32x4*)(stg+row*64+ch*8); ATTN_STORE16(Ow+(long)row*op+ch*8,v);} }
  asm volatile("s_waitcnt lgkmcnt(0)\n\ts_barrier":::"memory");
  #undef DMA_K
  #undef DMA_V
  #undef CMASK
  #undef START
  #undef RESC
  #undef ROT
}
constexpr int ATTN_LDS_BYTES=LDS_BYTES;
#undef SBAR
#undef WAIT_BAR
}
constexpr int NWAVES = 8;
constexpr size_t MiB = 1u << 20;
constexpr size_t WS_CTL = 0, CTL_ZERO_BYTES = 256 * 1024;
constexpr size_t WS_MOD = 1 * MiB;
constexpr size_t WS_ROPE = WS_MOD + 512 * 1024;
constexpr size_t WS_AFS = WS_ROPE + 64 * 1024;
constexpr size_t WS_IDX = WS_AFS + 192 * 1024;
constexpr size_t WS_SEL = 2 * MiB;
constexpr size_t WS_AFF = 4 * MiB;
constexpr size_t WS_WIN = 8 * MiB;
constexpr size_t WS_WBR = 28 * MiB;
constexpr size_t WS_WOUT = 32 * MiB;
constexpr size_t WS_DFT = 36 * MiB;
constexpr size_t WS_DFTC = 52 * MiB;
constexpr size_t WS_WGU = 53 * MiB;
constexpr size_t WS_WD = 181 * MiB;
constexpr size_t WS_X = 245 * MiB;
constexpr size_t WS_HN = 317 * MiB;
constexpr size_t WS_QKV = 353 * MiB;
constexpr size_t WS_G = 398 * MiB;
constexpr size_t WS_BR = 506 * MiB;
constexpr size_t WS_HACT = 470 * MiB;
constexpr size_t WS_END = 542 * MiB;
constexpr size_t QKV_QG = 0, QKV_KG = (size_t)NTOK * 512 * 2, QKV_VG = QKV_KG + (size_t)NTOK * 128 * 2, QKV_QW = QKV_VG + (size_t)NTOK * 128 * 2,
                 QKV_KW = QKV_QW + (size_t)NTOK * 256 * 2, QKV_VW = QKV_KW + (size_t)NTOK * 128 * 2;
static_assert(WS_QKV + QKV_VW + (size_t)NTOK * 128 * 2 <= WS_G && WS_HN + (size_t)NTOK * DM * 4 <= WS_G && WS_G + (size_t)NTOK * 3 * DM * 2 <= WS_BR && WS_HACT >= WS_G + (size_t)NE * RPE * DM * 2 && WS_HACT + (size_t)NE * RPE * DM * 2 <= WS_END, "d_ws map");
constexpr size_t DO_MB = 0, DO_ABT = 36 * MiB, DO_ABTC = 52 * MiB;
constexpr int CW_BAR = 1024;
constexpr int CW_QUEUE = 8192;
constexpr int CW_CONVQ = 8192 + 64 * 8;
constexpr int CW_FIN = CW_CONVQ + 64;
constexpr int RING_BYTES = 131072;
constexpr int LDSCTL_OFF = RING_BYTES, MISC_OFF = LDSCTL_OFF + 320;
constexpr int IDXBUF_OFF = LDSCTL_OFF + 1024 + 8192;
constexpr int LDS_BYTES = 147456;

#define GAS __attribute__((address_space(1)))
#define LAS __attribute__((address_space(3)))
typedef unsigned short bf16;
typedef unsigned v4u __attribute__((ext_vector_type(4)));
typedef unsigned v2u __attribute__((ext_vector_type(2)));
typedef float f32x4 __attribute__((ext_vector_type(4)));
typedef GAS unsigned gu32;
#define RLX_AGENT __ATOMIC_RELAXED, __HIP_MEMORY_SCOPE_AGENT
#define LDS_WAIT() asm volatile("s_waitcnt lgkmcnt(0)" ::: "memory")
#define VM_WAIT() asm volatile("s_waitcnt vmcnt(0)" ::: "memory")
__device__ __forceinline__ unsigned f2bf(float f) { unsigned u = __builtin_bit_cast(unsigned, f); return (u + 0x7fffu + ((u >> 16) & 1u)) >> 16; }
__device__ __forceinline__ unsigned pk2(float lo, float hi) { return f2bf(lo) | (f2bf(hi) << 16); }
__device__ __forceinline__ float bf2f(unsigned short h) { return __builtin_bit_cast(float, (unsigned)h << 16); }
__device__ __forceinline__ float bflo(unsigned w) { return __builtin_bit_cast(float, w << 16); }
__device__ __forceinline__ float bfhi(unsigned w) { return __builtin_bit_cast(float, w & 0xffff0000u); }

#define XB_TMO      128
#define XB_XCNT(j)  (256  + 64 * (j))
#define XB_XSUB(j)  (1280 + 64 * (j))
#define XB_XGEN(j)  (2304 + 64 * (j))
#define XB_TOP      3328
#define XB_TOPGEN   3392
#define XCD_BAR_WORDS 3456
#define XB_SPIN_CAP (1u << 20)
__device__ __forceinline__ unsigned xb_ld(unsigned* p)              { return __hip_atomic_load(p, __ATOMIC_RELAXED, __HIP_MEMORY_SCOPE_AGENT); }
__device__ __forceinline__ unsigned xb_add(unsigned* p, unsigned v) { return __hip_atomic_fetch_add(p, v, __ATOMIC_RELAXED, __HIP_MEMORY_SCOPE_AGENT); }
__device__ __forceinline__ unsigned xb_xcc_id() { return (unsigned)__builtin_amdgcn_s_getreg((3 << 11) | 20) & 0xFu; }
#define XB_SPIN(cond, bar) do { unsigned _sp = 0; while (cond) { __builtin_amdgcn_s_sleep(1); \
    if ((++_sp & 255u) == 0u) { if (xb_ld(&(bar)[XB_TMO])) break; if (_sp > XB_SPIN_CAP) { atomicAdd(&(bar)[XB_TMO], 1u); break; } } } } while (0)
struct XcdBarrier { unsigned* bar; unsigned x; volatile LAS unsigned* st; };
__device__ __forceinline__ XcdBarrier xcd_barrier_post(unsigned* bar, volatile LAS unsigned* st) {
    XcdBarrier b; b.bar = bar; b.x = xb_xcc_id(); b.st = st;
    if (threadIdx.x == 0) (void)xb_add(&bar[XB_XCNT(b.x)], 1u);
    return b;
}
__device__ __forceinline__ void xcd_barrier_complete(unsigned* bar, unsigned x, unsigned& nloc, unsigned& nx) {
    const unsigned G = gridDim.x * gridDim.y * gridDim.z;
    unsigned sum, cnt, mine, sp = 0u;
    for (;;) {
        sum = 0u; cnt = 0u; mine = 0u;
#pragma unroll
        for (unsigned j = 0; j < 16; ++j) { const unsigned c = xb_ld(&bar[XB_XCNT(j)]); sum += c; cnt += (c > 0u) ? 1u : 0u; mine = (j == x) ? c : mine; }
        if (sum == G) break;
        __builtin_amdgcn_s_sleep(1);
        if ((++sp & 255u) == 0u) { if (xb_ld(&bar[XB_TMO])) break; if (sp > XB_SPIN_CAP) { atomicAdd(&bar[XB_TMO], 1u); break; } }
    }
    nloc = mine > 0u ? mine : 1u; nx = cnt > 0u ? cnt : 1u;
}
__device__ __forceinline__ void xcd_barrier(const XcdBarrier& b) {
    asm volatile("s_waitcnt vmcnt(0)" ::: "memory");
    __syncthreads();
    if (threadIdx.x == 0) {
        unsigned* bar = b.bar;
        __builtin_amdgcn_s_waitcnt(0);
        unsigned nloc = b.st[0], nx = b.st[1];
        if (nloc == 0u) { xcd_barrier_complete(bar, b.x, nloc, nx); b.st[0] = nloc; b.st[1] = nx; }
        const unsigned old = xb_add(&bar[XB_XSUB(b.x)], 1u);
        const unsigned gen = old / nloc;
        if (old + 1u == (gen + 1u) * nloc) {
            __builtin_amdgcn_fence(__ATOMIC_RELEASE, "agent");
            asm volatile("s_waitcnt vmcnt(0)" ::: "memory");
            const unsigned og = xb_add(&bar[XB_TOP], 1u);
            const unsigned tg = og / nx;
            if (og + 1u == (tg + 1u) * nx) xb_add(&bar[XB_TOPGEN], 1u);
            else XB_SPIN(xb_ld(&bar[XB_TOPGEN]) == tg, bar);
            __builtin_amdgcn_fence(__ATOMIC_ACQUIRE, "agent");
            xb_add(&bar[XB_XGEN(b.x)], 1u);
            asm volatile("s_waitcnt vmcnt(0)" ::: "memory");
        } else {
            XB_SPIN(xb_ld(&bar[XB_XGEN(b.x)]) == gen, bar);
            __builtin_amdgcn_fence(__ATOMIC_ACQUIRE, "agent");
            asm volatile("s_waitcnt vmcnt(0)" ::: "memory");
        }
    }
    __syncthreads();
}
template <int CTRL> __device__ __forceinline__ float dpp_mov(float v) { return __builtin_bit_cast(float, __builtin_amdgcn_update_dpp(0, __builtin_bit_cast(int, v), CTRL, 0xF, 0xF, true)); }
__device__ __forceinline__ float lx1(float v) { return dpp_mov<0xB1>(v); }
__device__ __forceinline__ float lx2(float v) { return dpp_mov<0x4E>(v); }
__device__ __forceinline__ float lx4(float v) { return dpp_mov<0x1B>(dpp_mov<0x141>(v)); }
__device__ __forceinline__ float lx8(float v) { return dpp_mov<0x141>(dpp_mov<0x140>(v)); }
__device__ __forceinline__ float lx16(float v) { return __shfl_xor(v, 16); }
__device__ __forceinline__ float lx32(float v) { const unsigned u = __builtin_bit_cast(unsigned, v); auto r = __builtin_amdgcn_permlane32_swap(u, u, false, false);
    return __builtin_bit_cast(float, (threadIdx.x & 32) ? r[0] : r[1]); }
__device__ __forceinline__ float wave_sum(float v) {
    v += lx1(v); v += lx2(v); v += lx4(v); v += lx8(v); v += lx16(v); v += lx32(v);
    return v;
}
using pg8::Unit;
typedef pg8::f32x4 (&AccRef)[2][2][4][2];

__device__ __forceinline__ v2u pack4(f32x4 v) { v2u w; w.x = pg8::cvt_pk_bf16(v[0], v[1]); w.y = pg8::cvt_pk_bf16(v[2], v[3]); return w; }
__device__ __forceinline__ float sigmoidf_(float v) { return __builtin_amdgcn_rcpf(1.f + __builtin_amdgcn_exp2f(-LOG2E * v)); }

template <class Dec> struct Strided {
    Dec d; int n, G, vcu;
    __device__ __forceinline__ bool next(int i, Unit& u) const { const int L = i * G + vcu; if (L >= n) return false; d(L, u); return true; }
};

struct DecInProj { const char* A; const char* B; int layer;
    __device__ __forceinline__ void operator()(int L, Unit& u) const {
        int pm, pn;
        if (L < 1024) { const int cg = L >> 8, rg = (L & 255) >> 5, w = L & 31; pm = rg * 8 + (w & 7); pn = cg * 4 + (w >> 3); }
        else if (L < 1216) { const int q = L - 1024, rg = q / 24, w = q % 24; pm = rg * 8 + (w & 7); pn = 16 + (w >> 3); }
        else { const int q = L - 1216; pm = 64 + (q & 7); pn = q >> 3; if (layer == DEPTH - 1) pn = pn ? 6 : 4; }
        u.A = A + (size_t)pm * 256 * (DM * 2); u.B = B + (size_t)pn * 256 * (DM * 2); u.arows = nullptr; u.ldA = DM * 2; u.ldB = DM * 2; u.nt = DM / 64; u.pm = pm; u.pn = pn; u.tag = 0;
    } };
constexpr int inproj_units(int layer) { return 1216 + (layer == DEPTH - 1 ? 16 : 152); }

struct EpiInProj {
    static constexpr bool PERM = false;
    bf16 *ABt, *ABtc, *Qg, *Kg, *Vg, *Qw, *Kw, *Vw, *G; const float* rope; const float* qng; const float* kng;
    __device__ __forceinline__ bool operator()(AccRef acc, const Unit& u, int wr, int wc, int fr, int fq) const {
        const int pm = u.pm, pn = u.pn; const bool lat = pm < 64;
        const int rowt = wr * 64 + fr;
        if (pn < 2) {
            bf16* dst; int ld;
            if (lat) { dst = ABt + ((size_t)(pm >> 3) * 256) * (2 * SEQ) + pn * SEQ + (pm & 7) * 256; ld = 2 * SEQ; }
            else { dst = ABtc + ((size_t)(pm - 64) * 256) * (2 * CTX) + pn * CTX; ld = 2 * CTX; }
#pragma unroll
            for (int ai = 0; ai < 2; ++ai)
#pragma unroll
                for (int m = 0; m < 4; ++m) { const int tok = rowt + ai * 128 + m * 16;
#pragma unroll
                    for (int bj = 0; bj < 2; ++bj)
#pragma unroll
                        for (int n = 0; n < 2; ++n) { const int c = bj * 128 + wc * 32 + n * 16 + fq * 4; const pg8::f32x4 v = acc[ai][bj][m][n];
#pragma unroll
                            for (int j = 0; j < 4; ++j) dst[(size_t)(c + j) * ld + tok] = (bf16)f2bf(v[j]); } }
        } else if (pn < 7) {
            bf16* dst; int ld; const float* ng = nullptr; bool rope_on = false; float sc = 1.f;
            if (pn <= 3)      { dst = Qg + (pn - 2) * 256 + wc * 64; ld = 512; ng = qng; rope_on = lat; sc = QSCALE; }
            else if (pn == 4) { if (wc < 2) { dst = Kg + wc * 64; ng = kng; rope_on = lat; } else { dst = Vg + (wc - 2) * 64; } ld = 128; }
            else if (pn == 5) { dst = Qw + wc * 64; ld = 256; rope_on = lat; sc = QSCALE; }
            else              { if (wc < 2) { dst = Kw + wc * 64; rope_on = lat; } else { dst = Vw + (wc - 2) * 64; } ld = 128; }
#pragma unroll
            for (int ai = 0; ai < 2; ++ai)
#pragma unroll
                for (int m = 0; m < 4; ++m) {
                    const int row = pm * 256 + rowt + ai * 128 + m * 16;
                    pg8::f32x4 v[2][2];
                    float ss = 0.f;
#pragma unroll
                    for (int bj = 0; bj < 2; ++bj)
#pragma unroll
                        for (int n = 0; n < 2; ++n) { v[bj][n] = acc[ai][bj][m][n]; ss += (v[bj][n][0] * v[bj][n][0] + v[bj][n][1] * v[bj][n][1]) + (v[bj][n][2] * v[bj][n][2] + v[bj][n][3] * v[bj][n][3]); }
                    float r = sc;
                    if (ng) { ss += __shfl_xor(ss, 16); ss += __shfl_xor(ss, 32); r = sc * rsqrtf(ss * (1.f / 64.f) + EPS); }
                    const int t = row & (SEQ - 1);
#pragma unroll
                    for (int bj = 0; bj < 2; ++bj)
#pragma unroll
                        for (int n = 0; n < 2; ++n) {
                            pg8::f32x4 x = v[bj][n] * r; if (ng) x = x * *(const pg8::f32x4*)(ng + bj * 32 + n * 16 + fq * 4);
                            if (rope_on) {
                                const int pos = bj ? (t & 63) : (t >> 6);
                                const pg8::f32x4 cs = *(const pg8::f32x4*)(rope + ((size_t)pos * 16 + n * 8 + fq * 2) * 2);
                                x = (pg8::f32x4){x[0] * cs[0] - x[1] * cs[1], x[0] * cs[1] + x[1] * cs[0], x[2] * cs[2] - x[3] * cs[3], x[2] * cs[3] + x[3] * cs[2]};
                            }
                            *(v2u*)(dst + (size_t)row * ld + bj * 32 + n * 16 + fq * 4) = pack4(x);
                        }
                    asm volatile("" ::: "memory");
                }
        } else {
            bf16* dst = G + ((size_t)pm * 12 + (pn - 7)) * 65536 + (size_t)(((wr * 4 + wc) * 64 + fq * 16 + fr) * 8);
#pragma unroll
            for (int ai = 0; ai < 2; ++ai)
#pragma unroll
                for (int bj = 0; bj < 2; ++bj)
#pragma unroll
                    for (int m = 0; m < 4; ++m) { const pg8::f32x4 a = acc[ai][bj][m][0], b = acc[ai][bj][m][1];
                        const v2u lo = pack4((pg8::f32x4){sigmoidf_(a[0]), sigmoidf_(a[1]), sigmoidf_(a[2]), sigmoidf_(a[3])}), hi = pack4((pg8::f32x4){sigmoidf_(b[0]), sigmoidf_(b[1]), sigmoidf_(b[2]), sigmoidf_(b[3])});
                        *(v4u*)(dst + (size_t)(((ai * 2 + bj) * 4 + m) * 4096)) = (v4u){lo.x, lo.y, hi.x, hi.y}; }
        }
        return false;
    }
};

struct EpiStore { static constexpr bool PERM = false; bf16* O; int ld;
    __device__ __forceinline__ bool operator()(AccRef acc, const Unit& u, int wr, int wc, int fr, int fq) const {
        bf16* dst = O + ((size_t)u.pm * 256 + wr * 64 + fr) * ld + u.pn * 256 + wc * 32 + fq * 4;
#pragma unroll
        for (int ai = 0; ai < 2; ++ai)
#pragma unroll
            for (int m = 0; m < 4; ++m)
#pragma unroll
                for (int bj = 0; bj < 2; ++bj)
#pragma unroll
                    for (int n = 0; n < 2; ++n) *(v2u*)(dst + (size_t)(ai * 128 + m * 16) * ld + bj * 128 + n * 16) = pack4(acc[ai][bj][m][n]);
        return false;
    } };
struct DecDft { const char* Dm; const char* Dc; const char* ABt; const char* ABtc;
    __device__ __forceinline__ void operator()(int L, Unit& u) const {
        if (L < 64) { const int b = L >> 3, mt = L & 7; u.A = Dm + (size_t)mt * 256 * (4 * SEQ); u.B = ABt + (size_t)b * 256 * (4 * SEQ); u.ldA = 4 * SEQ; u.ldB = 4 * SEQ; u.nt = 2 * SEQ / 64; u.pm = L; }
        else { const int b = L - 64; u.A = Dc; u.B = ABtc + (size_t)b * 256 * (4 * CTX); u.ldA = 4 * CTX; u.ldB = 4 * CTX; u.nt = 2 * CTX / 64; u.pm = 64 + b; }
        u.pn = 0; u.tag = 0; u.arows = nullptr;
    } };

struct SchedMerge { const char* BR; const char* W; int ntiles, G, vcu;
    __device__ __forceinline__ bool next(int i, Unit& u) const {
        const int round = i / 3, tag = i - round * 3, tile = round * G + vcu; if (tile >= ntiles) return false;
        const int pm = tile >> 2, pn = tile & 3, koff = tag == 0 ? 0 : (tag == 1 ? 256 : 768);
        u.A = BR + (size_t)pm * 256 * (DM * 2) + koff * 2; u.B = W + (size_t)pn * 256 * (DM * 2) + koff * 2; u.arows = nullptr; u.ldA = DM * 2; u.ldB = DM * 2; u.nt = tag == 1 ? 8 : 4; u.pm = pm; u.pn = pn; u.tag = tag;
        return true;
    } };
struct EpiMerge { static constexpr bool PERM = false; const bf16* G; bf16* Mb; int probe;
    __device__ __forceinline__ bool operator()(AccRef acc, const Unit& u, int wr, int wc, int fr, int fq) const {
        const size_t row0 = (size_t)u.pm * 256 + wr * 64 + fr; const int col0 = u.pn * 256 + wc * 32 + fq * 4; const int tag = u.tag;
        const bf16* g0 = G + ((size_t)u.pm * 12 + tag * 4 + u.pn) * 65536 + (size_t)(((wr * 4 + wc) * 64 + fq * 16 + fr) * 8);
#pragma unroll
        for (int ai = 0; ai < 2; ++ai)
#pragma unroll
            for (int bj = 0; bj < 2; ++bj) {
#pragma unroll
                for (int m = 0; m < 4; ++m) { const size_t fo = (size_t)(((ai * 2 + bj) * 4 + m) * 4096);
                    const v4u gw = probe == 2 ? (v4u){0x3f803f80u, 0x3f803f80u, 0x3f803f80u, 0x3f803f80u} : *(const v4u*)(g0 + fo);
                    pg8::f32x4 ga = {bflo(gw.x), bfhi(gw.x), bflo(gw.y), bfhi(gw.y)}, gb = {bflo(gw.z), bfhi(gw.z), bflo(gw.w), bfhi(gw.w)};
                    if (tag < 2) { const v4u hw = probe == 2 ? (v4u){0x3f803f80u, 0x3f803f80u, 0x3f803f80u, 0x3f803f80u} : *(const v4u*)(g0 + 4 * 65536 + fo);
                        ga = (pg8::f32x4){ga[0] * __builtin_amdgcn_rcpf(bflo(hw.x)), ga[1] * __builtin_amdgcn_rcpf(bfhi(hw.x)), ga[2] * __builtin_amdgcn_rcpf(bflo(hw.y)), ga[3] * __builtin_amdgcn_rcpf(bfhi(hw.y))};
                        gb = (pg8::f32x4){gb[0] * __builtin_amdgcn_rcpf(bflo(hw.z)), gb[1] * __builtin_amdgcn_rcpf(bfhi(hw.z)), gb[2] * __builtin_amdgcn_rcpf(bflo(hw.w)), gb[3] * __builtin_amdgcn_rcpf(bfhi(hw.w))};
                        acc[ai][bj][m][0] = acc[ai][bj][m][0] * ga; acc[ai][bj][m][1] = acc[ai][bj][m][1] * gb; }
                    else { const size_t row = row0 + ai * 128 + m * 16; const int c = col0 + bj * 128;
                        *(v2u*)(Mb + row * DM + c) = pack4(acc[ai][bj][m][0] * ga); *(v2u*)(Mb + row * DM + c + 16) = pack4(acc[ai][bj][m][1] * gb); } }
                asm volatile("" ::: "memory"); }
        return tag < 2;
    } };

struct DecWout { const char* Mb; const char* W;
    __device__ __forceinline__ void operator()(int L, Unit& u) const { const int pm = L >> 2, pn = L & 3;
        u.A = Mb + (size_t)pm * 256 * (DM * 2); u.B = W + (size_t)pn * 256 * (DM * 2); u.arows = nullptr; u.ldA = DM * 2; u.ldB = DM * 2; u.nt = DM / 64; u.pm = pm; u.pn = pn; u.tag = 0; } };
struct EpiWout { static constexpr bool PERM = true; const float* baseL; const float* baseC; float* X; const float* mod;
    __device__ __forceinline__ bool operator()(AccRef acc, const Unit& u, int wr, int wc, int fr, int fq) const {
        const int pm = u.pm; const float* base = pm < 64 ? baseL : baseC; const float* g1 = mod + (size_t)(pm < 64 ? (pm >> 3) : 8) * (6 * DM) + 2 * DM;
        const size_t row0 = (size_t)pm * 256 + wr * 64 + fr; const int col0 = u.pn * 256 + wc * 32 + fq * 8;
#pragma unroll
        for (int bj = 0; bj < 2; ++bj) { const int c = col0 + bj * 128; const pg8::f32x4 gv0 = *(const pg8::f32x4*)(g1 + c), gv1 = *(const pg8::f32x4*)(g1 + c + 4);
#pragma unroll
            for (int ai = 0; ai < 2; ++ai)
#pragma unroll
                for (int m = 0; m < 4; ++m) { const size_t off = (row0 + ai * 128 + m * 16) * DM + c;
                    *(pg8::f32x4*)(X + off) = *(const pg8::f32x4*)(base + off) + gv0 * acc[ai][bj][m][0]; *(pg8::f32x4*)(X + off + 4) = *(const pg8::f32x4*)(base + off + 4) + gv1 * acc[ai][bj][m][1]; } }
        return false;
    } };

struct DecGU { const char* H2; const int* IDX; const char* W; int nrt;
    __device__ __forceinline__ void operator()(int L, Unit& u) const { const int per = nrt * 8, e = L / per, q = L - e * per, ct = q & 7, rt = q >> 3;
        u.A = H2; u.arows = IDX + (size_t)e * RPE + rt * 256; u.B = W + ((size_t)e * 2 * DM + ct * 256) * (DM * 2); u.ldA = DM * 2; u.ldB = DM * 2; u.nt = DM / 64; u.pm = rt; u.pn = ct; u.tag = e; } };
struct EpiGU { static constexpr bool PERM = true; bf16* H;
    __device__ __forceinline__ bool operator()(AccRef acc, const Unit& u, int wr, int wc, int fr, int fq) const {
        bf16* dst = H + ((size_t)u.tag * RPE + u.pm * 256 + wr * 64 + fr) * DM + u.pn * 128 + wc * 32 + fq * 8;
#pragma unroll
        for (int ai = 0; ai < 2; ++ai)
#pragma unroll
            for (int m = 0; m < 4; ++m) { v2u o[2];
#pragma unroll
                for (int n = 0; n < 2; ++n) { const pg8::f32x4 a = acc[ai][0][m][n], up = acc[ai][1][m][n];
                    o[n] = pack4((pg8::f32x4){a[0] * sigmoidf_(a[0]) * up[0], a[1] * sigmoidf_(a[1]) * up[1], a[2] * sigmoidf_(a[2]) * up[2], a[3] * sigmoidf_(a[3]) * up[3]}); }
                *(v4u*)(dst + (size_t)(ai * 128 + m * 16) * DM) = (v4u){o[0].x, o[0].y, o[1].x, o[1].y}; }
        return false;
    } };
struct DecDown { const char* H; const char* W; int nrt;
    __device__ __forceinline__ void operator()(int L, Unit& u) const { const int per = nrt * 4, e = L / per, q = L - e * per, ct = q & 3, rt = q >> 2;
        u.A = H + ((size_t)e * RPE + rt * 256) * (DM * 2); u.arows = nullptr; u.B = W + ((size_t)e * DM + ct * 256) * (DM * 2); u.ldA = DM * 2; u.ldB = DM * 2; u.nt = DM / 64; u.pm = rt; u.pn = ct; u.tag = e; } };
struct EpiDown { static constexpr bool PERM = true; bf16* Y; const float* afs;
    __device__ __forceinline__ bool operator()(AccRef acc, const Unit& u, int wr, int wc, int fr, int fq) const {
        const size_t r0 = (size_t)u.tag * RPE + u.pm * 256 + wr * 64 + fr;
#pragma unroll
        for (int ai = 0; ai < 2; ++ai)
#pragma unroll
            for (int m = 0; m < 4; ++m) { const size_t r = r0 + ai * 128 + m * 16; const float a = afs[r];
#pragma unroll
                for (int bj = 0; bj < 2; ++bj) { const v2u o0 = pack4(acc[ai][bj][m][0] * a), o1 = pack4(acc[ai][bj][m][1] * a);
                    *(v4u*)(Y + r * DM + u.pn * 256 + bj * 128 + wc * 32 + fq * 8) = (v4u){o0.x, o0.y, o1.x, o1.y}; } }
        return false;
    } };
struct Frame {
    LAS unsigned char* lds; char* ldsg; volatile LAS unsigned* MISC; gu32* ctl;
    int vcu, G;
    unsigned char* ws; unsigned char* dout; float* out;
};
constexpr int PTRS_OFF = LDSCTL_OFF + 512;
enum { IN_X = 0, IN_C, IN_CTX, IN_CCTX, IN_WADA, IN_BADA, IN_NORM1G, IN_WIN, IN_QNG, IN_KNG, IN_SINK, IN_WBRF, IN_WBRG, IN_WBRW, IN_WOUT, IN_NORM2G, IN_WROUTER, IN_WGATE, IN_WUP, IN_WDOWN, IN_FINALG };
__device__ __forceinline__ const float* inptr(const Frame& F, int k) {
    const unsigned long long v = *(const LAS unsigned long long*)(F.lds + PTRS_OFF + 8 * k);
    const unsigned lo = __builtin_amdgcn_readfirstlane((unsigned)v), hi = __builtin_amdgcn_readfirstlane((unsigned)(v >> 32));
    return (const float*)(((unsigned long long)hi << 32) | lo);
}
#define WSP(T, off) ((T*)(F.ws + (off)))

constexpr int COSTAB_OFF = LDSCTL_OFF + 1024;
static_assert(COSTAB_OFF + 8192 <= LDS_BYTES, "cos table fits");
__device__ __forceinline__ void transpose_item(const float* W, int ldw, int k0, int n0, bf16* WT, int drow0, int dld, int dk0, int lane) {
    const int g = lane >> 3, n4 = (lane & 7) * 4;
    const float* src = W + (size_t)(k0 + 8 * g) * ldw + n0 + n4;
    f32x4 v[8];
#pragma unroll
    for (int i = 0; i < 8; ++i) v[i] = *(const GAS f32x4*)(src + (size_t)i * ldw);
    bf16* dst = WT + (size_t)(drow0 + n4) * dld + dk0 + k0 + 8 * g;
#pragma unroll
    for (int j = 0; j < 4; ++j) { v4u o; o.x = pk2(v[0][j], v[1][j]); o.y = pk2(v[2][j], v[3][j]); o.z = pk2(v[4][j], v[5][j]); o.w = pk2(v[6][j], v[7][j]);
        *(GAS v4u*)(dst + (size_t)j * dld) = o; }
}
__device__ __forceinline__ void transpose_item2(const float* W, int ldw, int k0, int n0, bf16* WT, int drow0, int dld, int lane) {
    const int g = lane >> 3, n4 = (lane & 7) * 4;
    const float* src = W + (size_t)(k0 + 8 * g) * ldw + n0 + n4;
    f32x4 v[2][8];
#pragma unroll
    for (int h = 0; h < 2; ++h)
#pragma unroll
        for (int i = 0; i < 8; ++i) v[h][i] = __builtin_nontemporal_load((const GAS f32x4*)(src + (size_t)(h * 64 + i) * ldw));
    bf16* dst = WT + (size_t)(drow0 + n4) * dld + k0 + 8 * g;
#pragma unroll
    for (int h = 0; h < 2; ++h)
#pragma unroll
        for (int j = 0; j < 4; ++j) { v4u o; o.x = pk2(v[h][0][j], v[h][1][j]); o.y = pk2(v[h][2][j], v[h][3][j]); o.z = pk2(v[h][4][j], v[h][5][j]); o.w = pk2(v[h][6][j], v[h][7][j]);
            __builtin_nontemporal_store(o, (GAS v4u*)(dst + (size_t)j * dld + h * 64)); }
}
__device__ __forceinline__ void fold_item(const float* W, int k0, int g, int sinmode, bf16* WT, int drow0, LAS float* scr, const LAS float* ctab, int lane) {
#pragma unroll
    for (int kk = 0; kk < 16; ++kk) scr[lane * 20 + kk] = W[(size_t)(k0 + kk) * INW + g * 64 + lane];
    LDS_WAIT(); asm volatile("" ::: "memory");
    float acc[16];
#pragma unroll
    for (int k = 0; k < 16; ++k) acc[k] = 0.f;
#pragma unroll 4
    for (int c = 0; c < 64; ++c) {
        const int r = (c * lane) & 63;
        const float tv = sinmode ? -ctab[((r - 16) & 63) * 32] : ctab[r * 32];
#pragma unroll
        for (int k4 = 0; k4 < 4; ++k4) { const f32x4 w = *(const LAS f32x4*)(scr + c * 20 + 4 * k4);
            acc[4 * k4] = fmaf(w[0], tv, acc[4 * k4]); acc[4 * k4 + 1] = fmaf(w[1], tv, acc[4 * k4 + 1]); acc[4 * k4 + 2] = fmaf(w[2], tv, acc[4 * k4 + 2]); acc[4 * k4 + 3] = fmaf(w[3], tv, acc[4 * k4 + 3]); }
    }
    GAS v4u* dst = (GAS v4u*)(WT + (size_t)(drow0 + lane) * DM + k0);
#pragma unroll
    for (int q = 0; q < 2; ++q) { v4u o; o.x = pk2(acc[8 * q], acc[8 * q + 1]); o.y = pk2(acc[8 * q + 2], acc[8 * q + 3]); o.z = pk2(acc[8 * q + 4], acc[8 * q + 5]); o.w = pk2(acc[8 * q + 6], acc[8 * q + 7]); dst[q] = o; }
    LDS_WAIT(); asm volatile("" ::: "memory");
}

#ifndef CONV_IN_ATTN
#define CONV_IN_ATTN 0
#endif
constexpr int CONV_WAVE_ITEMS = DEPTH * NE * 768, CONV_ITEMS = CONV_WAVE_ITEMS / NWAVES, CONV_ITEMS_L0 = CONV_ITEMS / DEPTH;
__device__ __forceinline__ void conv_wave_item(Frame& F, int r, int lane) {
    const int le = r / 768, q = r % 768, which = q / 256, qq = q % 256, kb = qq >> 5, nb = qq & 31, f0 = nb * 32;
    if (which < 2) transpose_item2((which ? inptr(F, IN_WUP) : inptr(F, IN_WGATE)) + (size_t)le * DM * DM, DM, kb * 128, f0, WSP(bf16, WS_WGU) + (size_t)le * 2 * DM * DM, (f0 >> 7) * 256 + which * 128 + (f0 & 127), DM, lane);
    else transpose_item2(inptr(F, IN_WDOWN) + (size_t)le * DM * DM, DM, kb * 128, f0, WSP(bf16, WS_WD) + (size_t)le * DM * DM, f0, DM, lane);
}
__device__ __forceinline__ void tail_convert(Frame& F, int idx, int first, int per, int end) {
    int tid_ = threadIdx.x; asm volatile("" : "+v"(tid_));
    const int lane = tid_ & 63, wave_ = __builtin_amdgcn_readfirstlane(tid_ >> 6);
    for (int t = 0; t < per; ++t) { const int it = first + idx * per + t; if (it >= end) break; conv_wave_item(F, it * NWAVES + wave_, lane); }
}

__device__ __forceinline__ void p0_prologue(Frame& F, int mode = 0) {
    int tid_ = threadIdx.x; asm volatile("" : "+v"(tid_));
    const int lane = tid_ & 63, wave_ = __builtin_amdgcn_readfirstlane(tid_ >> 6);
    const int gw = F.vcu * NWAVES + wave_, NGW = F.G * NWAVES;
    LAS float* st = (LAS float*)F.lds;
    LAS float* red = (LAS float*)(F.lds + 40960);
    LAS float* ctab = (LAS float*)(F.lds + COSTAB_OFF);
    { const float* cp = inptr(F, IN_C); const float* ccp = inptr(F, IN_CCTX);
#pragma unroll 6
      for (int i = tid_; i < 9 * DM; i += NWAVES * 64) { const int s = i / DM, k = i - s * DM; const float v = s < 8 ? cp[s * DM + k] : ccp[k]; st[i] = v / (1.f + expf(-v)); } }
    for (int i = tid_; i < 2048; i += NWAVES * 64) ctab[i] = cosf(6.283185307179586f * (float)i * (1.f / 2048.f));
    __syncthreads();
    const float* bada = inptr(F, IN_BADA);
    if (mode != 2) for (int it = F.vcu; it < DEPTH * 96; it += F.G) {
        const int l = it / 96, j = (it % 96) * 64 + lane, kb = wave_ * 128;
        const float* W = inptr(F, IN_WADA) + (size_t)l * DM * 6 * DM + (size_t)kb * 6 * DM + j;
        float acc[9];
#pragma unroll
        for (int s = 0; s < 9; ++s) acc[s] = 0.f;
        for (int k0 = 0; k0 < 128; k0 += 16) {
            float w[16];
#pragma unroll
            for (int i = 0; i < 16; ++i) w[i] = W[(size_t)(k0 + i) * 6 * DM];
#pragma unroll
            for (int i = 0; i < 16; ++i)
#pragma unroll
                for (int s = 0; s < 9; ++s) acc[s] = fmaf(st[s * DM + kb + k0 + i], w[i], acc[s]);
        }
#pragma unroll
        for (int s = 0; s < 9; ++s) red[(wave_ * 9 + s) * 64 + lane] = acc[s];
        __syncthreads();
        for (int o = tid_; o < 9 * 64; o += NWAVES * 64) { float v = 0.f;
#pragma unroll
            for (int w = 0; w < 8; ++w) v += red[w * 576 + o];
            const int s = o >> 6, jj = (it % 96) * 64 + (o & 63);
            WSP(float, WS_MOD)[((size_t)l * 9 + s) * 6 * DM + jj] = v + bada[l * 6 * DM + jj]; }
        __syncthreads();
    }
    __syncthreads();
#ifdef DBG_POISON
    {
        const size_t n16 = (WS_END - WS_X) / 16, m16 = ((size_t)NLAT * DM * 4) / 16; const v4u pz = {0xFFFFFFFFu, 0xFFFFFFFFu, 0xFFFFFFFFu, 0xFFFFFFFFu};
        for (size_t i = (size_t)gw * 64 + lane; i < n16; i += (size_t)NGW * 64) ((GAS v4u*)(F.ws + WS_X))[i] = pz;
        for (size_t i = (size_t)gw * 64 + lane; i < m16; i += (size_t)NGW * 64) ((GAS v4u*)F.dout)[i] = pz;
    }
#endif
    LAS float* scr = (LAS float*)(F.lds + wave_ * 16384);
    constexpr int T_A = DEPTH * 2176, T_B = DEPTH * 512, T_C = DEPTH * 512, T_D = DEPTH * 512, T_E = DEPTH * NE * 768, T_F = SEQ + CTX, T_G = 1;
    constexpr int NITEMS = T_A + T_B + T_C + T_D + T_E + T_F + T_G;
    if (mode != 1 && mode != 5 && mode != 6) for (int it = gw; it < NITEMS; it += NGW) {
        int r = it;
        if (r < T_A) { const int l = r / 2176, q = r % 2176, kb = q / 136, nb = q % 136, s0 = 256 + nb * 32;
            int drow; if (s0 < 1536) { const int tile = 2 + ((s0 - 256) >> 8), hh = ((s0 - 256) & 255) >> 6, dh = (s0 & 63) >> 5; drow = tile * 256 + dh * 128 + hh * 32; } else drow = s0 + 256;
            transpose_item(inptr(F, IN_WIN) + (size_t)l * DM * INW, INW, kb * 64, s0, WSP(bf16, WS_WIN) + (size_t)l * INW2 * DM, drow, DM, 0, lane); continue; } r -= T_A;
        if (r < T_B) { const int l = r / 512, q = r % 512, kq = q & 3, kb = (q >> 2) >> 3, g = ((q >> 2) >> 1) & 3, sm = (q >> 2) & 1;
            fold_item(inptr(F, IN_WIN) + (size_t)l * DM * INW, kb * 64 + kq * 16, g, sm, WSP(bf16, WS_WIN) + (size_t)l * INW2 * DM, sm * 256 + g * 64, scr, ctab, lane); continue; } r -= T_B;
        if (r < T_C) { const int l = r / 512, q = r % 512; const float* W; int kb, koff;
            if (q < 128) { W = inptr(F, IN_WBRF) + (size_t)l * 256 * DM; kb = q >> 5; koff = 0; } else if (q < 384) { W = inptr(F, IN_WBRG) + (size_t)l * 512 * DM; kb = (q - 128) >> 5; koff = 256; } else { W = inptr(F, IN_WBRW) + (size_t)l * 256 * DM; kb = (q - 384) >> 5; koff = 768; }
            const int nb = q & 31;
            transpose_item(W, DM, kb * 64, nb * 32, WSP(bf16, WS_WBR) + (size_t)l * DM * DM, nb * 32, DM, koff, lane); continue; } r -= T_C;
        if (r < T_D) { const int l = r / 512, q = r % 512, kb = q >> 5, nb = q & 31;
            transpose_item(inptr(F, IN_WOUT) + (size_t)l * DM * DM, DM, kb * 64, nb * 32, WSP(bf16, WS_WOUT) + (size_t)l * DM * DM, nb * 32, DM, 0, lane); continue; } r -= T_D;
        if (r < T_E) { if (F.G != 256) conv_wave_item(F, r, lane); continue; } r -= T_E;
        if (r < T_F) {
            const bool big = r < SEQ; const int N = big ? SEQ : CTX, k = big ? r : r - SEQ, sh = big ? 0 : 3; const float sc = 1.f / sqrtf(64.f * (float)N);
            bf16* row = (big ? WSP(bf16, WS_DFT) : WSP(bf16, WS_DFTC)) + (size_t)k * 2 * N;
            for (int n = 2 * lane; n < N; n += 128) {
                const int r0 = (k * n) & (N - 1), r1 = (k * (n + 1)) & (N - 1);
                *(GAS unsigned*)(row + n) = pk2(ctab[r0 << sh] * sc, ctab[r1 << sh] * sc);
                *(GAS unsigned*)(row + N + n) = pk2(ctab[((r0 - (N >> 2)) & (N - 1)) << sh] * sc, ctab[((r1 - (N >> 2)) & (N - 1)) << sh] * sc); }
            continue; } r -= T_F;
        {
            for (int i = lane; i < 64 * 16; i += 64) { const int pos = i >> 4, f = i & 15; const float inv = powf(10000.f, -(float)(2 * f) / 32.f), ang = (float)pos * inv;
                WSP(float, WS_ROPE)[2 * i] = cosf(ang); WSP(float, WS_ROPE)[2 * i + 1] = sinf(ang); }
        }
    }
}

__device__ __forceinline__ void norm_row(f32x4 (&v)[4], const float* gain, const float* shift, const float* scale, int lane) {
    float ss = 0.f;
#pragma unroll
    for (int j = 0; j < 4; ++j) ss += (v[j][0] * v[j][0] + v[j][1] * v[j][1]) + (v[j][2] * v[j][2] + v[j][3] * v[j][3]);
    const float r = rsqrtf(wave_sum(ss) * (1.f / DM) + EPS);
#pragma unroll
    for (int j = 0; j < 4; ++j) { const f32x4 g = *(const f32x4*)(gain + 4 * lane + 256 * j); f32x4 y = v[j] * r * g;
        if (shift) { const f32x4 sh = *(const f32x4*)(shift + 4 * lane + 256 * j), sc = *(const f32x4*)(scale + 4 * lane + 256 * j); y = y * (sc + 1.f) + sh; }
        v[j] = y; }
}
__device__ __forceinline__ void store_row_bf16(bf16* orow, const f32x4 (&v)[4], int lane) {
    GAS v2u* o8 = (GAS v2u*)orow + lane;
#pragma unroll
    for (int j = 0; j < 4; ++j) { v2u w; w.x = pg8::cvt_pk_bf16(v[j][0], v[j][1]); w.y = pg8::cvt_pk_bf16(v[j][2], v[j][3]); o8[64 * j] = w; }
}
__device__ __forceinline__ int row_modset(int r) { return r < NLAT ? (r >> 11) : 8; }
struct ModVec { f32x4 g[4], sh[4], sc[4]; };
__device__ __forceinline__ void load_modvec(ModVec& m, const float* gain, const float* shift, const float* scale, int lane) {
#pragma unroll
    for (int j = 0; j < 4; ++j) { m.g[j] = *(const f32x4*)(gain + 4 * lane + 256 * j);
        if (shift) { m.sh[j] = *(const f32x4*)(shift + 4 * lane + 256 * j); m.sc[j] = *(const f32x4*)(scale + 4 * lane + 256 * j); } else { m.sh[j] = (f32x4){0.f, 0.f, 0.f, 0.f}; m.sc[j] = (f32x4){0.f, 0.f, 0.f, 0.f}; } }
}
__device__ __forceinline__ void norm_row_m(f32x4 (&v)[4], const ModVec& m) {
    float ss = 0.f;
#pragma unroll
    for (int j = 0; j < 4; ++j) ss += (v[j][0] * v[j][0] + v[j][1] * v[j][1]) + (v[j][2] * v[j][2] + v[j][3] * v[j][3]);
    const float r = rsqrtf(wave_sum(ss) * (1.f / DM) + EPS);
#pragma unroll
    for (int j = 0; j < 4; ++j) v[j] = (v[j] * r * m.g[j]) * (m.sc[j] + 1.f) + m.sh[j];
}
__device__ __forceinline__ void load_row_f32(f32x4 (&v)[4], const float* row, int lane) {
#pragma unroll
    for (int j = 0; j < 4; ++j) v[j] = *(const f32x4*)(row + 4 * lane + 256 * j);
}

__device__ __forceinline__ void p1_norm1(Frame& F) {
    int tid_ = threadIdx.x; asm volatile("" : "+v"(tid_));
    const int lane = tid_ & 63, wave_ = __builtin_amdgcn_readfirstlane(tid_ >> 6);
    const int gw = F.vcu * NWAVES + wave_, NGW = F.G * NWAVES, rpw = (NTOK + NGW - 1) / NGW, r0 = gw * rpw, r1 = r0 + rpw < NTOK ? r0 + rpw : NTOK;
    const float* xin = inptr(F, IN_X); const float* cin = inptr(F, IN_CTX) - (size_t)NLAT * DM; const float* g1 = inptr(F, IN_NORM1G);
#define P1_ROW(r) (((r) < NLAT ? xin : cin) + (size_t)(r) * DM)
    f32x4 va[4], vb[4]; ModVec m; int cset = -1;
    if (r0 < r1) load_row_f32(va, P1_ROW(r0), lane);
    if (r0 + 1 < r1) load_row_f32(vb, P1_ROW(r0 + 1), lane);
    for (int r = r0; r < r1; ++r) {
        f32x4 v[4];
#pragma unroll
        for (int j = 0; j < 4; ++j) { v[j] = va[j]; va[j] = vb[j]; }
        if (r + 2 < r1) load_row_f32(vb, P1_ROW(r + 2), lane);
        const int set = row_modset(r);
        if (set != cset) { const float* mod = WSP(float, WS_MOD) + (size_t)set * 6 * DM; load_modvec(m, g1, mod, mod + DM, lane); cset = set; }
        norm_row_m(v, m);
        store_row_bf16(WSP(bf16, WS_HN) + (size_t)r * DM, v, lane);
    }
#undef P1_ROW
}
__device__ __forceinline__ void router_finish(const float (&a16)[NE], int r, int lane, float* AFF) {
    float b8[8], b4[4], b2[2], lg;
    { const bool hi = lane & 32;
#pragma unroll
      for (int i = 0; i < 8; ++i) { const float keep = hi ? a16[i + 8] : a16[i], send = hi ? a16[i] : a16[i + 8]; b8[i] = keep + lx32(send); } }
    { const bool hi = lane & 16;
#pragma unroll
      for (int i = 0; i < 4; ++i) { const float keep = hi ? b8[i + 4] : b8[i], send = hi ? b8[i] : b8[i + 4]; b4[i] = keep + lx16(send); } }
    { const bool hi = lane & 8;
#pragma unroll
      for (int i = 0; i < 2; ++i) { const float keep = hi ? b4[i + 2] : b4[i], send = hi ? b4[i] : b4[i + 2]; b2[i] = keep + lx8(send); } }
    { const bool hi = lane & 4; const float keep = hi ? b2[1] : b2[0], send = hi ? b2[0] : b2[1]; lg = keep + lx4(send); }
    lg += lx2(lg); lg += lx1(lg);
    float mx = lg;
    mx = fmaxf(mx, lx4(mx)); mx = fmaxf(mx, lx8(mx)); mx = fmaxf(mx, lx16(mx)); mx = fmaxf(mx, lx32(mx));
    const float ex = expf(lg - mx); float sum = ex;
    sum += lx4(sum); sum += lx8(sum); sum += lx16(sum); sum += lx32(sum);
    const int set = r < NLAT ? (r >> 11) : 8 + ((r - NLAT) >> 8), n = r < NLAT ? (r & (SEQ - 1)) : ((r - NLAT) & (CTX - 1));
    if ((lane & 3) == 0) AFF[((size_t)set * NE + ((lane >> 2) & 15)) * SEQ + n] = ex / sum;
}
__device__ __forceinline__ void pf_norm2_router(Frame& F, int l, int mode = 0) {
    int tid_ = threadIdx.x; asm volatile("" : "+v"(tid_));
    const int lane = tid_ & 63, wave_ = __builtin_amdgcn_readfirstlane(tid_ >> 6);
    const int gw = F.vcu * NWAVES + wave_, NGW = F.G * NWAVES;
    LAS float* wrT = (LAS float*)F.lds;
    { const float* wr = inptr(F, IN_WROUTER) + (size_t)l * DM * NE;
#pragma unroll 8
      for (int i = tid_; i < DM * NE; i += NWAVES * 64) { const int k = i >> 4, e = i & 15; wrT[e * DM + k] = wr[i]; } }
    __syncthreads();
    const int nrows = (l == DEPTH - 1) ? NLAT : NTOK, rpw = (nrows + NGW - 1) / NGW, r0 = gw * rpw, r1 = r0 + rpw < nrows ? r0 + rpw : nrows;
    const float* X = WSP(float, WS_X); const float* g2n = inptr(F, IN_NORM2G) + l * DM; float* AFF = WSP(float, WS_AFF);
    f32x4 va[4], vb[4]; ModVec m; int cset = -1;
    if (r0 < r1) load_row_f32(va, X + (size_t)r0 * DM, lane);
    if (r0 + 1 < r1) load_row_f32(vb, X + (size_t)(r0 + 1) * DM, lane);
    for (int r = r0; r < r1; ++r) {
        f32x4 v[4];
#pragma unroll
        for (int j = 0; j < 4; ++j) { v[j] = va[j]; va[j] = vb[j]; }
        if (r + 2 < r1) load_row_f32(vb, X + (size_t)(r + 2) * DM, lane);
        const int mset = row_modset(r);
        if (mset != cset) { const float* mod = WSP(float, WS_MOD) + ((size_t)l * 9 + mset) * 6 * DM; load_modvec(m, g2n, mod + 3 * DM, mod + 4 * DM, lane); cset = mset; }
        norm_row_m(v, m);
        if (mode < 2) store_row_bf16(WSP(bf16, WS_HN) + (size_t)r * DM, v, lane);
        if (mode >= 1) { asm volatile("" :: "v"(v[0]), "v"(v[1]), "v"(v[2]), "v"(v[3])); continue; }
        float a16[NE];
#pragma unroll
        for (int e = 0; e < NE; ++e) { float a = 0.f;
#pragma unroll
            for (int j = 0; j < 4; ++j) { const f32x4 w = *(const LAS f32x4*)(wrT + e * DM + 4 * lane + 256 * j); a = fmaf(v[j][0], w[0], a); a = fmaf(v[j][1], w[1], a); a = fmaf(v[j][2], w[2], a); a = fmaf(v[j][3], w[3], a); }
            a16[e] = a; if ((e & 3) == 3) asm volatile("" ::: "memory"); }
        router_finish(a16, r, lane, AFF);
    }
    __syncthreads();
}
__device__ __forceinline__ void pg_topk_gather(Frame& F, int l) {
    int tid_ = threadIdx.x; asm volatile("" : "+v"(tid_));
    const int lane = tid_ & 63, wave_ = __builtin_amdgcn_readfirstlane(tid_ >> 6);
    LAS unsigned* cnt = (LAS unsigned*)F.lds;
    LAS int* sidx = (LAS int*)(F.lds + 1024);
    const int nitems = (l == DEPTH - 1) ? 8 * NE : 16 * NE;
    const int tid = tid_, wave = wave_;
    const unsigned long long lt = (1ull << lane) - 1ull;
    for (int it = F.vcu; it < nitems; it += F.G) {
        const int set = it >> 4, e = it & 15; const bool latent = set < 8; const int N = latent ? SEQ : CTX, cap = latent ? CAPL : CAPC;
        const int rowbase = latent ? set * SEQ : NLAT + (set - 8) * CTX, xbase = latent ? set * CAPL : 8 * CAPL + (set - 8) * CAPC;
        const float* a = WSP(float, WS_AFF) + ((size_t)set * NE + e) * SEQ;
        unsigned key[4];
#pragma unroll
        for (int q = 0; q < 4; ++q) { const int i = q * 512 + tid; key[q] = i < N ? __builtin_bit_cast(unsigned, a[i]) : 0u; }
        unsigned T = 0u;
        for (int bit = 30; bit >= 0; --bit) {
            const unsigned cand = T | (1u << bit); unsigned c = 0;
#pragma unroll
            for (int q = 0; q < 4; ++q) c += (unsigned)__builtin_popcountll(__ballot(key[q] >= cand));
            LAS unsigned* cb = cnt + (bit & 1) * 8;
            if (lane == 0) cb[wave] = c;
            __syncthreads();
            unsigned tot = 0;
#pragma unroll
            for (int w = 0; w < 8; ++w) tot += cb[w];
            if (tot >= (unsigned)cap) T = cand;
        }
        LAS unsigned* cg = cnt + 64; LAS unsigned* ce = cnt + 96;
        unsigned long long bg[4], be[4];
#pragma unroll
        for (int q = 0; q < 4; ++q) { bg[q] = __ballot(key[q] > T); be[q] = __ballot(key[q] == T && key[q] != 0u);
            if (lane == 0) { cg[q * 8 + wave] = (unsigned)__builtin_popcountll(bg[q]); ce[q * 8 + wave] = (unsigned)__builtin_popcountll(be[q]); } }
        __syncthreads();
        unsigned ngt = 0;
        for (int c2 = 0; c2 < 32; ++c2) ngt += cg[c2];
        const unsigned need = (unsigned)cap - ngt;
        unsigned pre_g[4], pre_e[4];
        { unsigned rg = 0, re = 0;
#pragma unroll
          for (int q = 0; q < 4; ++q) { for (int w = 0; w < 8; ++w) { if (w == wave) { pre_g[q] = rg; pre_e[q] = re; } rg += cg[q * 8 + w]; re += ce[q * 8 + w]; } } }
        int* SEL = WSP(int, WS_SEL);
#pragma unroll
        for (int q = 0; q < 4; ++q) { const int i = q * 512 + tid;
            if (i < N) {
                const unsigned eb = pre_e[q] + (unsigned)__builtin_popcountll(be[q] & lt);
                const unsigned gb = pre_g[q] + (unsigned)__builtin_popcountll(bg[q] & lt);
                const bool isg = key[q] > T, ise = key[q] == T;
                const bool sel = isg || (ise && eb < need);
                const unsigned slot = gb + (eb < need ? eb : need);
                SEL[(size_t)(rowbase + i) * NE + e] = sel ? xbase + (int)slot : -1;
                if (sel) { WSP(float, WS_AFS)[(size_t)e * RPE + xbase + slot] = __builtin_bit_cast(float, key[q]); WSP(int, WS_IDX)[(size_t)e * RPE + xbase + slot] = rowbase + i; }
            } }
        __syncthreads();
    }
}
__device__ __forceinline__ void pj_combine(Frame& F, int l, int probe = 0) {
    int tid_ = threadIdx.x; asm volatile("" : "+v"(tid_));
    const int lane = tid_ & 63, wave_ = __builtin_amdgcn_readfirstlane(tid_ >> 6);
    const int gw = F.vcu * NWAVES + wave_, NGW = F.G * NWAVES; const bool last = l == DEPTH - 1;
    const int nrows = last ? NLAT : NTOK, rpw = (nrows + NGW - 1) / NGW, r0 = gw * rpw, r1 = r0 + rpw < nrows ? r0 + rpw : nrows;
    float* X = WSP(float, WS_X); const int* SEL = WSP(int, WS_SEL);
    const float* gnext = last ? inptr(F, IN_FINALG) : inptr(F, IN_NORM1G) + (l + 1) * DM;
    f32x4 va[4], vb[4], g2[4]; int sa = -1, sb = -1; ModVec m; int cset = -1;
    if (r0 < r1) { load_row_f32(va, X + (size_t)r0 * DM, lane); sa = lane < NE ? SEL[(size_t)r0 * NE + lane] : -1; }
    if (r0 + 1 < r1) { load_row_f32(vb, X + (size_t)(r0 + 1) * DM, lane); sb = lane < NE ? SEL[(size_t)(r0 + 1) * NE + lane] : -1; }
    for (int r = r0; r < r1; ++r) {
        f32x4 v[4], t[4];
#pragma unroll
        for (int j = 0; j < 4; ++j) { v[j] = va[j]; va[j] = vb[j]; t[j] = (f32x4){0.f, 0.f, 0.f, 0.f}; }
        const int selv = sa; sa = sb;
        if (r + 2 < r1) { load_row_f32(vb, X + (size_t)(r + 2) * DM, lane); sb = lane < NE ? SEL[(size_t)(r + 2) * NE + lane] : -1; }
        const int mset = row_modset(r);
        if (mset != cset) { const float* mod = WSP(float, WS_MOD) + ((size_t)l * 9 + mset) * 6 * DM; const float* mod1 = WSP(float, WS_MOD) + ((size_t)(last ? l : l + 1) * 9 + mset) * 6 * DM;
#pragma unroll
            for (int j = 0; j < 4; ++j) g2[j] = *(const f32x4*)(mod + 5 * DM + 4 * lane + 256 * j);
            load_modvec(m, gnext, last ? nullptr : mod1, last ? nullptr : mod1 + DM, lane); cset = mset; }
        for (int e = 0; e < NE; ++e) { const int se = __builtin_amdgcn_readlane(selv, e);
            if (se >= 0) { const GAS v2u* y = (const GAS v2u*)(WSP(bf16, WS_G) + ((size_t)e * RPE + se) * DM) + lane;
#pragma unroll
                for (int j = 0; j < 4; ++j) { const v2u w = y[64 * j]; t[j] += (f32x4){bflo(w.x), bfhi(w.x), bflo(w.y), bfhi(w.y)}; } } }
#pragma unroll
        for (int j = 0; j < 4; ++j) v[j] = v[j] + g2[j] * t[j];
        if (probe) { norm_row_m(v, m); asm volatile("" :: "v"(v[0]), "v"(v[1]), "v"(v[2]), "v"(v[3])); continue; }
        if (!last) {
#pragma unroll
            for (int j = 0; j < 4; ++j) *(f32x4*)(X + (size_t)r * DM + 4 * lane + 256 * j) = v[j];
            norm_row_m(v, m);
            store_row_bf16(WSP(bf16, WS_HN) + (size_t)r * DM, v, lane);
        } else {
            norm_row_m(v, m);
#pragma unroll
            for (int j = 0; j < 4; ++j) *(f32x4*)(F.out + (size_t)r * DM + 4 * lane + 256 * j) = v[j];
        }
    }
}

__device__ __forceinline__ void pc_mixers(Frame& F, int l, int rep) {
    int tid_ = threadIdx.x; asm volatile("" : "+v"(tid_));
    const int lane = tid_ & 63, wave_ = __builtin_amdgcn_readfirstlane(tid_ >> 6);
    const bool need_ctx = l < DEPTH - 1;
    {
        Strided<DecDft> S; S.d.Dm = (const char*)(F.ws + WS_DFT); S.d.Dc = (const char*)(F.ws + WS_DFTC); S.d.ABt = (const char*)(F.dout + DO_ABT); S.d.ABtc = (const char*)(F.dout + DO_ABTC);
        S.n = need_ctx ? 72 : 64; S.G = F.G; S.vcu = F.vcu;
        EpiStore E{WSP(bf16, WS_BR), DM};
        pg8::gemm_phase<EpiStore, Strided<DecDft>>(F.lds, (LAS int*)(F.lds + IDXBUF_OFF), S, E);
    }
    typedef attn_body::bf16 abf;
    const abf* Qg = (const abf*)(F.ws + WS_QKV + QKV_QG); const abf* Kg = (const abf*)(F.ws + WS_QKV + QKV_KG); const abf* Vg = (const abf*)(F.ws + WS_QKV + QKV_VG);
    const abf* Qw = (const abf*)(F.ws + WS_QKV + QKV_QW); const abf* Kw = (const abf*)(F.ws + WS_QKV + QKV_KW); const abf* Vw = (const abf*)(F.ws + WS_QKV + QKV_VW);
    abf* BR = (abf*)(F.ws + WS_BR);
    const int nGL = NBATCH * 2 * 32, nWL = NBATCH * 2 * 16, nGC = need_ctx ? NBATCH * 2 * 4 : 0, nWC = need_ctx ? NBATCH * 2 * 2 : 0, nattn = nGL + nWL + nGC + nWC;
    const int nconv = (CONV_IN_ATTN && F.G == 256 && rep == 0) ? CONV_ITEMS_L0 : 0, ntot = nattn + nconv;
    gu32* head = F.ctl + CW_QUEUE + 64 * (l + 2 * rep);
    const int wid = wave_;
    for (;;) {
        if (tid_ == 0) F.MISC[0] = __hip_atomic_fetch_add(head, 1u, RLX_AGENT);
        __syncthreads();
        const int q = (int)F.MISC[0];
        if (q >= ntot) break;
        const int c0 = (int)(((long long)q * nconv) / ntot), c1 = (int)(((long long)(q + 1) * nconv) / ntot);
        if (c1 > c0) { conv_wave_item(F, (l * CONV_ITEMS_L0 + c0) * NWAVES + wave_, lane); __syncthreads(); continue; }
        const int a = q - c0;
        if (a < nGL) {
            const int b = a >> 6, hkv = (a >> 5) & 1, qb = a & 31, head_ = hkv * 4 + (wid >> 1), q0 = qb * 64 + (wid & 1) * 32; const size_t qrow = (size_t)b * SEQ + q0;
            attn_body::attn_unit<0, 8>(Qg + qrow * 512 + head_ * 64, 512, Kg + (size_t)(NLAT + b * CTX) * 128 + hkv * 64, Kg + (size_t)b * SEQ * 128 + hkv * 64,
                                        Vg + (size_t)(NLAT + b * CTX) * 128 + hkv * 64, Vg + (size_t)b * SEQ * 128 + hkv * 64, 128, 4 + SEQ / 64, 0, 0, 0.f, BR + qrow * DM + 256 + head_ * 64, DM, F.ldsg);
        } else if (a < nGL + nWL) {
            const int u = a - nGL, b = u >> 5, hkv = (u >> 4) & 1, qb = u & 15, head_ = hkv * 2 + (wid >> 2), q0 = qb * 128 + (wid & 3) * 32; const size_t qrow = (size_t)b * SEQ + q0;
            const int band0 = qb * 128 - 128 < 0 ? 0 : qb * 128 - 128, band1 = qb * 128 + 256 > SEQ ? SEQ : qb * 128 + 256;
            attn_body::attn_unit<1, 8>(Qw + qrow * 256 + head_ * 64, 256, Kw + (size_t)(NLAT + b * CTX) * 128 + hkv * 64, Kw + ((size_t)b * SEQ + band0) * 128 + hkv * 64,
                                        Vw + (size_t)(NLAT + b * CTX) * 128 + hkv * 64, Vw + ((size_t)b * SEQ + band0) * 128 + hkv * 64, 128, 4 + (band1 - band0) / 64, q0, band0,
                                        inptr(F, IN_SINK)[l * 4 + head_] * LOG2E, BR + qrow * DM + 768 + head_ * 64, DM, F.ldsg);
        } else if (a < nGL + nWL + nGC) {
            const int u = a - nGL - nWL, b = u >> 3, hkv = (u >> 2) & 1, qb = u & 3, head_ = hkv * 4 + (wid >> 1); const size_t qrow = (size_t)NLAT + b * CTX + qb * 64 + (wid & 1) * 32;
            const abf* Kc = Kg + (size_t)(NLAT + b * CTX) * 128 + hkv * 64; const abf* Vc = Vg + (size_t)(NLAT + b * CTX) * 128 + hkv * 64;
            attn_body::attn_unit<0, 8>(Qg + qrow * 512 + head_ * 64, 512, Kc, Kc, Vc, Vc, 128, 4, 0, 0, 0.f, BR + qrow * DM + 256 + head_ * 64, DM, F.ldsg);
        } else {
            const int u = a - nGL - nWL - nGC, b = u >> 2, hkv = (u >> 1) & 1, qb = u & 1, head_ = hkv * 2 + (wid >> 2); const size_t qrow = (size_t)NLAT + b * CTX + qb * 128 + (wid & 3) * 32;
            const abf* Kc = Kw + (size_t)(NLAT + b * CTX) * 128 + hkv * 64; const abf* Vc = Vw + (size_t)(NLAT + b * CTX) * 128 + hkv * 64;
            attn_body::attn_unit<1, 8>(Qw + qrow * 256 + head_ * 64, 256, Kc, Kc, Vc, Vc, 128, 4, 0, 0, inptr(F, IN_SINK)[l * 4 + head_] * LOG2E, BR + qrow * DM + 768 + head_ * 64, DM, F.ldsg);
        }
    }
    __syncthreads();
}
#ifndef MK_N_LAUNCHES
#define MK_N_LAUNCHES 1
#endif
constexpr int N_PHASES = 2 + 9 * DEPTH;
struct Args { const float* in[21]; float* out; unsigned char* ws; int ph_lo, ph_hi, probe, pad_; };

__global__ void __launch_bounds__(NWAVES * 64, 2) hybrid_fwd(Args args) {
    extern __shared__ __attribute__((aligned(16))) unsigned char lds[];
    Frame F;
    F.lds = (LAS unsigned char*)lds; F.ldsg = (char*)lds; F.MISC = (volatile LAS unsigned*)(F.lds + MISC_OFF);
    F.G = gridDim.x; { const int bx = blockIdx.x; F.vcu = (F.G % 8 == 0) ? (bx % 8) * (F.G / 8) + bx / 8 : bx; }
    F.ws = args.ws; F.out = args.out; F.dout = (unsigned char*)args.out; F.ctl = (gu32*)(args.ws + WS_CTL);
    for (int u = threadIdx.x; u < (LDS_BYTES - LDSCTL_OFF) / 4; u += NWAVES * 64) ((LAS unsigned*)(F.lds + LDSCTL_OFF))[u] = 0u;
    __syncthreads();
    if (threadIdx.x < 21) *(LAS unsigned long long*)(F.lds + PTRS_OFF + 8 * threadIdx.x) = (unsigned long long)args.in[threadIdx.x];
    __syncthreads();
    XcdBarrier bar; bar.bar = (unsigned*)(F.ctl + CW_BAR); bar.x = 0; bar.st = nullptr;
    const int lo = args.ph_lo, hi = args.ph_hi;
    if (hi - lo > 1) bar = xcd_barrier_post((unsigned*)(F.ctl + CW_BAR), F.MISC + 8);
#ifndef PHSEL
#define PHSEL 0x7ff
#endif
#define IN(k) (lo <= (k) && (k) < hi)
#define KIND(j) ((PHSEL >> (j)) & 1)
#ifndef DBG_PROBE
#define DBG_PROBE 0
#endif
#ifndef FPROBE_MODE
#define FPROBE_MODE 0
#endif
#ifndef REP_MASK
#define REP_MASK 0
#endif
#define NREP(j, ok) ((((REP_MASK) >> (j)) & 1) && (ok) ? 2 : 1)
#define REPEAT(j, ok) for (int rep_ = 0, nrep_ = NREP(j, ok); rep_ < nrep_; ++rep_, (rep_ < nrep_ ? xcd_barrier(bar) : (void)0))
#define SEAM(k) do { if (IN(k) && IN((k) + 1)) xcd_barrier(bar); } while (0)

#ifdef BAR_PROBE
    if (hi - lo > 1) for (int i_ = 0; i_ < BAR_PROBE; ++i_) xcd_barrier(bar);
#endif
    if (KIND(0) && IN(0)) REPEAT(0, true) { p0_prologue(F, rep_ ? DBG_PROBE : 0); } SEAM(0);
    if (KIND(1) && IN(1)) REPEAT(1, true) { p1_norm1(F); } SEAM(1);
    for (int l = 0; l < DEPTH; ++l) {
        const int pb = 2 + 9 * l; const bool lastl = l == DEPTH - 1;
        const int nrt = lastl ? 64 : 72;
        if (KIND(2) && IN(pb + 0)) REPEAT(2, true) {
            Strided<DecInProj> S; S.d.A = (const char*)(F.ws + WS_HN); S.d.B = (const char*)(F.ws + WS_WIN) + (size_t)l * INW2 * DM * 2; S.d.layer = l; S.n = inproj_units(l); S.G = F.G; S.vcu = F.vcu;
            EpiInProj E; E.ABt = (bf16*)(F.dout + DO_ABT); E.ABtc = (bf16*)(F.dout + DO_ABTC);
            E.Qg = (bf16*)(F.ws + WS_QKV + QKV_QG); E.Kg = (bf16*)(F.ws + WS_QKV + QKV_KG); E.Vg = (bf16*)(F.ws + WS_QKV + QKV_VG);
            E.Qw = (bf16*)(F.ws + WS_QKV + QKV_QW); E.Kw = (bf16*)(F.ws + WS_QKV + QKV_KW); E.Vw = (bf16*)(F.ws + WS_QKV + QKV_VW);
            E.G = WSP(bf16, WS_G); E.rope = WSP(float, WS_ROPE); E.qng = inptr(F, IN_QNG) + l * 64; E.kng = inptr(F, IN_KNG) + l * 64;
            pg8::gemm_phase<EpiInProj, Strided<DecInProj>>(F.lds, (LAS int*)(F.lds + IDXBUF_OFF), S, E);
            if (!CONV_IN_ATTN && l == 0 && F.G == 256 && F.vcu >= 88 && rep_ == 0) tail_convert(F, F.vcu - 88, 0, 4, 672);
        } SEAM(pb + 0);
        if (KIND(3) && IN(pb + 1)) REPEAT(3, true) { pc_mixers(F, l, rep_); } SEAM(pb + 1);
        if (KIND(4) && IN(pb + 2)) REPEAT(4, true) {
            SchedMerge S; S.BR = (const char*)(F.ws + WS_BR); S.W = (const char*)(F.ws + WS_WBR) + (size_t)l * DM * DM * 2; S.ntiles = nrt * 4; S.G = F.G; S.vcu = F.vcu;
            EpiMerge E{WSP(bf16, WS_G), (rep_ + 1 == nrep_ && !args.probe) ? (bf16*)(F.dout + DO_MB) : WSP(bf16, WS_HN), args.probe};
            pg8::gemm_phase<EpiMerge, SchedMerge>(F.lds, (LAS int*)(F.lds + IDXBUF_OFF), S, E);
            if (!CONV_IN_ATTN && l == 0 && F.G == 256 && F.vcu >= 32 && rep_ == 0) tail_convert(F, F.vcu - 32, 672, 2, 1120);
        } SEAM(pb + 2);
        if (KIND(5) && IN(pb + 3)) REPEAT(5, l == 0) {
            Strided<DecWout> S; S.d.Mb = (const char*)(F.dout + DO_MB); S.d.W = (const char*)(F.ws + WS_WOUT) + (size_t)l * DM * DM * 2; S.n = nrt * 4; S.G = F.G; S.vcu = F.vcu;
            EpiWout E; E.baseL = l == 0 ? inptr(F, IN_X) : WSP(float, WS_X); E.baseC = l == 0 ? inptr(F, IN_CTX) - (size_t)NLAT * DM : WSP(float, WS_X); E.X = WSP(float, WS_X); E.mod = WSP(float, WS_MOD) + (size_t)l * 9 * 6 * DM;
            pg8::gemm_phase<EpiWout, Strided<DecWout>>(F.lds, (LAS int*)(F.lds + IDXBUF_OFF), S, E);
            if (!CONV_IN_ATTN && l == 0 && F.G == 256 && F.vcu >= 32 && rep_ == 0) tail_convert(F, F.vcu - 32, 1120, 5, 2240);
        } SEAM(pb + 3);
        if (KIND(6) && IN(pb + 4)) REPEAT(6, true) { pf_norm2_router(F, l, rep_ ? FPROBE_MODE : 0); } SEAM(pb + 4);
        if (KIND(7) && IN(pb + 5)) REPEAT(7, true) { pg_topk_gather(F, l); } SEAM(pb + 5);
        const int ert = lastl ? 8 : 9;
        if (KIND(8) && IN(pb + 6)) REPEAT(8, true) {
            Strided<DecGU> S; S.d.H2 = (const char*)(F.ws + WS_HN); S.d.IDX = WSP(int, WS_IDX); S.d.W = (const char*)(F.ws + WS_WGU) + (size_t)l * NE * 2 * DM * DM * 2; S.d.nrt = ert; S.n = NE * ert * 8; S.G = F.G; S.vcu = F.vcu;
            EpiGU E{WSP(bf16, WS_HACT)};
            pg8::gemm_phase<EpiGU, Strided<DecGU>>(F.lds, (LAS int*)(F.lds + IDXBUF_OFF), S, E);
            if (!CONV_IN_ATTN && l == 0 && F.G == 256 && F.vcu >= 128 && rep_ == 0) tail_convert(F, F.vcu - 128, 2240, 3, 2624);
        } SEAM(pb + 6);
        if (KIND(9) && IN(pb + 7)) REPEAT(9, true) {
            Strided<DecDown> S; S.d.H = (const char*)(F.ws + WS_HACT); S.d.W = (const char*)(F.ws + WS_WD) + (size_t)l * NE * DM * DM * 2; S.d.nrt = ert; S.n = NE * ert * 4; S.G = F.G; S.vcu = F.vcu;
            EpiDown E{WSP(bf16, WS_G), WSP(float, WS_AFS)};
            pg8::gemm_phase<EpiDown, Strided<DecDown>>(F.lds, (LAS int*)(F.lds + IDXBUF_OFF), S, E);
            if (!CONV_IN_ATTN && l == 0 && F.G == 256 && F.vcu >= 64 && rep_ == 0) tail_convert(F, F.vcu - 64, 2624, 3, CONV_ITEMS);
        } SEAM(pb + 7);
        if (KIND(10) && IN(pb + 8)) REPEAT(10, true) { pj_combine(F, l, rep_); }
        if (!lastl) SEAM(pb + 8);
    }
#undef IN
#undef SEAM
}

extern "C" void kernel_launch(void* const* d_in, const int* in_sizes, int n_in, void* d_out, int out_size, void* d_ws, size_t ws_size, hipStream_t stream) {
    static int grid = 0;
    if (grid == 0) {
        if (n_in != 21 || out_size != NLAT * DM || ws_size < WS_END) { fprintf(stderr, "kernel_launch: unexpected problem (n_in %d, out %d, ws %zu < %zu)\n", n_in, out_size, ws_size, (size_t)WS_END); grid = -1; return; }
        int dev = 0, cus = 0, per_cu = 0;
        if (hipGetDevice(&dev) != hipSuccess || hipDeviceGetAttribute(&cus, hipDeviceAttributeMultiprocessorCount, dev) != hipSuccess) { grid = -1; return; }
        if (hipFuncSetAttribute((const void*)hybrid_fwd, hipFuncAttributeMaxDynamicSharedMemorySize, LDS_BYTES) != hipSuccess) { fprintf(stderr, "kernel_launch: hipFuncSetAttribute failed\n"); grid = -1; return; }
        if (hipOccupancyMaxActiveBlocksPerMultiprocessor(&per_cu, (const void*)hybrid_fwd, NWAVES * 64, LDS_BYTES) != hipSuccess || per_cu < 1) { fprintf(stderr, "kernel_launch: occupancy query says %d blocks/CU\n", per_cu); per_cu = 1; }
        (void)hipGetLastError();
        grid = cus * 1;
    }
    if (grid < 0) return;
    hipMemsetAsync((char*)d_ws + WS_CTL, 0, CTL_ZERO_BYTES, stream);
    Args a; memset(&a, 0, sizeof(a));
    for (int i = 0; i < 21; ++i) a.in[i] = (const float*)d_in[i];
    a.out = (float*)d_out; a.ws = (unsigned char*)d_ws;
#if MK_N_LAUNCHES == 1
    a.ph_lo = 0; a.ph_hi = N_PHASES;
    hipLaunchKernelGGL(hybrid_fwd, dim3(grid), dim3(NWAVES * 64), LDS_BYTES, stream, a);
#else
    for (int p = 0; p < N_PHASES; ++p) { a.ph_lo = p; a.ph_hi = p + 1; hipLaunchKernelGGL(hybrid_fwd, dim3(grid), dim3(NWAVES * 64), LDS_BYTES, stream, a);
#ifdef DBG_DUP_PHASE
        if (p == DBG_DUP_PHASE) { a.probe = DBG_PROBE; hipLaunchKernelGGL(hybrid_fwd, dim3(grid), dim3(NWAVES * 64), LDS_BYTES, stream, a); a.probe = 0; }
#endif
    }
#endif
}
```

```cpp
#define MK_N_LAUNCHES 1
#include <hip/hip_runtime.h>
#include <hip/hip_bf16.h>
#include <cstdio>
#include <cstdint>
#include <cmath>
#include <cstring>

constexpr int DM = 1024, NBATCH = 8, SEQ = 2048, CTX = 256, DEPTH = 2;
constexpr int NLAT = NBATCH * SEQ, NCTX = NBATCH * CTX, NTOK = NLAT + NCTX;
constexpr int INW = 4608, NCOLT = 19, INW2 = NCOLT * 256;
constexpr int NE = 16, CAPL = 256, CAPC = 32, RPE = NBATCH * (CAPL + CAPC);
constexpr float EPS = 1e-6f;
constexpr float QSCALE = 0.125f * 1.4426950408889634f;
constexpr float LOG2E = 1.4426950408889634f;
namespace pg8 {
#define PG8_LAS __attribute__((address_space(3)))
typedef unsigned short bf16_t;
typedef short bf16x8 __attribute__((ext_vector_type(8)));
typedef float f32x4 __attribute__((ext_vector_type(4)));
typedef unsigned u32x4 __attribute__((ext_vector_type(4)));
typedef unsigned u32x2 __attribute__((ext_vector_type(2)));
constexpr int BM = 256, BK = 64, HALF = 128, HTB = HALF * BK * 2  , STAGE_BYTES = 8 * HTB;

__host__ __device__ __forceinline__ int lds_byte(int r, int c) { const int st = (r >> 4) * 2 + (c >> 5), rr = r & 15, cc = c & 31, ob = rr * 64 + cc * 2; return st * 1024 + (ob ^ (((ob >> 9) & 1) << 5)); }
__host__ __device__ __forceinline__ int perm32(int rho) { const int n = rho >> 4, i = rho & 15; return 8 * (i >> 2) + 4 * n + (i & 3); }
__host__ __device__ __forceinline__ void stage_rc(int b, int& R, int& C) { const int st = b / 1024, sb = b % 1024, swz = sb ^ (((sb >> 9) & 1) << 5); R = (st >> 1) * 16 + swz / 64; C = (st & 1) * 32 + (swz % 64) / 2; }

struct Unit { const char* A; const char* B; const int* arows; int ldA, ldB, nt; int pm, pn, tag; };

typedef float f32x2_c __attribute__((ext_vector_type(2)));
typedef __bf16 bf16x2_c __attribute__((ext_vector_type(2)));
__device__ __forceinline__ unsigned cvt_pk_bf16(float lo, float hi) { const f32x2_c v = {lo, hi}; const bf16x2_c b = __builtin_convertvector(v, bf16x2_c); return __builtin_bit_cast(unsigned, b); }

template <class Epi, class Sched>
__device__ __forceinline__ void gemm_phase(PG8_LAS unsigned char* lds, PG8_LAS int* idxbuf  , const Sched& S, const Epi& E) {
    int tid = threadIdx.x; asm volatile("" : "+v"(tid));
    const int wid = __builtin_amdgcn_readfirstlane(tid >> 6), lane = tid & 63, wr = wid >> 2, wc = wid & 3, fr = lane & 15, fq = lane >> 4;
    unsigned Rr[2], RrB[2], Cc2[2];
#pragma unroll
    for (int i = 0; i < 2; ++i) { int R, C; stage_rc(tid * 16 + i * 8192, R, C); Rr[i] = (unsigned)R; RrB[i] = Epi::PERM ? (unsigned)((R & ~31) + perm32(R & 31)) : (unsigned)R; Cc2[i] = (unsigned)C * 2u; }
    const size_t kstep = (size_t)(BK * 2);
    const unsigned ldsw = (unsigned)wid * 1024u;
    const int aoff = lds_byte(wr * 64 + fr, fq * 8), boff = lds_byte(wc * 32 + fr, fq * 8);
#define PG8_SA(b, h) (((b) * 2 + (h)) * HTB)
#define PG8_SB(b, h) ((4 + (b) * 2 + (h)) * HTB)
#define PG8_STAGE(bufoff, gbase, ld) do { _Pragma("unroll") for (int _i = 0; _i < 2; ++_i) \
        __builtin_amdgcn_global_load_lds((const unsigned*)((const char*)(gbase) + (RrB[_i] * (unsigned)(ld) + Cc2[_i])), (PG8_LAS unsigned*)(lds + (bufoff) + ldsw + _i * 8192), 16, 0, 0); } while (0)
#define PG8_STAGE_A(bufoff, gbase, ao) do { _Pragma("unroll") for (int _i = 0; _i < 2; ++_i) \
        __builtin_amdgcn_global_load_lds((const unsigned*)((const char*)(gbase) + (ao)[_i]), (PG8_LAS unsigned*)(lds + (bufoff) + ldsw + _i * 8192), 16, 0, 0); } while (0)
#define PG8_AOFF(u, ao) do { _Pragma("unroll") for (int _h = 0; _h < 2; ++_h) _Pragma("unroll") for (int _i = 0; _i < 2; ++_i) { \
        const unsigned _row = (u).arows ? (unsigned)idxbuf[Rr[_i] + 128 * _h] : Rr[_i] + 128u * _h; (ao)[_h][_i] = _row * (unsigned)(u).ldA + Cc2[_i]; } } while (0)
#define PG8_STAGE_IDX(u) do { if ((u).arows) __builtin_amdgcn_global_load_lds((const unsigned*)((u).arows + (wid & 3) * 64 + lane), (PG8_LAS unsigned*)((PG8_LAS unsigned char*)idxbuf + (wid & 3) * 256), 4, 0, 0); } while (0)
#define PG8_LDA(dst, b, h) do { _Pragma("unroll") for (int m = 0; m < 4; ++m) _Pragma("unroll") for (int k = 0; k < 2; ++k) dst[m][k] = *(const PG8_LAS bf16x8*)(lds + PG8_SA(b, h) + aoff + m * 2048 + k * 1024); } while (0)
#define PG8_LDB(dst, b, h) do { _Pragma("unroll") for (int n = 0; n < 2; ++n) _Pragma("unroll") for (int k = 0; k < 2; ++k) dst[n][k] = *(const PG8_LAS bf16x8*)(lds + PG8_SB(b, h) + boff + n * 2048 + k * 1024); } while (0)
#define PG8_MMA(ai, bj, At, Bt) do { __builtin_amdgcn_s_setprio(1); _Pragma("unroll") for (int m = 0; m < 4; ++m) _Pragma("unroll") for (int n = 0; n < 2; ++n) _Pragma("unroll") for (int k = 0; k < 2; ++k) \
        acc[ai][bj][m][n] = __builtin_amdgcn_mfma_f32_16x16x32_bf16(Bt[n][k], At[m][k], acc[ai][bj][m][n], 0, 0, 0); __builtin_amdgcn_s_setprio(0); } while (0)
#define PG8_WAIT_V(n) asm volatile("s_waitcnt vmcnt(" #n ")" ::: "memory")
#define PG8_WAIT_L(n) asm volatile("s_waitcnt lgkmcnt(" #n ")" ::: "memory")
#define PG8_BAR __builtin_amdgcn_s_barrier()
#define PG8_SCHED __builtin_amdgcn_sched_barrier(0)
    Unit cur, nxt; int ui = 0;
    if (!S.next(0, cur)) return;
    nxt = cur;
    f32x4 acc[2][2][4][2];
#pragma unroll
    for (int a = 0; a < 2; ++a)
#pragma unroll
        for (int b = 0; b < 2; ++b)
#pragma unroll
            for (int m = 0; m < 4; ++m)
#pragma unroll
                for (int n = 0; n < 2; ++n) acc[a][b][m][n] = (f32x4){0.f, 0.f, 0.f, 0.f};
    bf16x8 At[4][2], B0[2][2], B1[2][2];
    const char* cA = cur.A; const char* cB = cur.B; int clb = cur.ldB;
    unsigned ao_c[2][2], ao_n[2][2];
    if (cur.arows) { PG8_STAGE_IDX(cur); PG8_WAIT_V(0); PG8_BAR; }
    PG8_AOFF(cur, ao_c);
#pragma unroll
    for (int _h = 0; _h < 2; ++_h)
#pragma unroll
        for (int _i = 0; _i < 2; ++_i) ao_n[_h][_i] = ao_c[_h][_i];
    if (cur.arows) { PG8_WAIT_L(0); PG8_BAR; }
    {
        const size_t hB = (size_t)HALF * clb;
        PG8_STAGE(PG8_SB(0, 0), cB, clb); PG8_STAGE(PG8_SB(0, 1), cB + hB, clb); PG8_STAGE_A(PG8_SA(0, 0), cA, ao_c[0]); PG8_STAGE_A(PG8_SA(0, 1), cA, ao_c[1]);
        if (wr == 1) PG8_BAR;
        PG8_WAIT_V(2); PG8_BAR;
        PG8_STAGE(PG8_SB(1, 0), cB + kstep, clb); PG8_STAGE_A(PG8_SA(1, 0), cA + kstep, ao_c[0]); PG8_STAGE(PG8_SB(1, 1), cB + hB + kstep, clb);
        PG8_WAIT_V(6); PG8_BAR;
    }
    for (;;) {
        const bool has_next = S.next(ui + 1, nxt);
        const char* nA = has_next ? nxt.A : cA; const char* nB = has_next ? nxt.B : cB; const int nlb = has_next ? nxt.ldB : clb;
        const int nt = cur.nt;
        if (has_next) PG8_STAGE_IDX(nxt);
        for (int t = 0; t < nt; t += 2) {
            const bool last = (t == nt - 2);
            if (last) { if (has_next) { PG8_AOFF(nxt, ao_n); } else {
#pragma unroll
                for (int _h = 0; _h < 2; ++_h)
#pragma unroll
                    for (int _i = 0; _i < 2; ++_i) ao_n[_h][_i] = ao_c[_h][_i]; } }
            unsigned ao2[2][2];
#pragma unroll
            for (int _h = 0; _h < 2; ++_h)
#pragma unroll
                for (int _i = 0; _i < 2; ++_i) ao2[_h][_i] = last ? ao_n[_h][_i] : ao_c[_h][_i];
            const char* a1 = cA + (size_t)(t + 1) * kstep;
            const char* a2 = last ? nA : cA + (size_t)(t + 2) * kstep; const char* b2 = last ? nB : cB + (size_t)(t + 2) * kstep;
            const int lb2 = last ? nlb : clb;
            const size_t hB2 = (size_t)HALF * lb2;
            const char* a3 = a2 + kstep; const char* b3 = b2 + kstep;
            PG8_LDB(B0, 0, 0); PG8_LDB(B1, 0, 1); PG8_SCHED; PG8_LDA(At, 0, 0); PG8_STAGE_A(PG8_SA(1, 1), a1, ao_c[1]);
            PG8_WAIT_V(8); PG8_WAIT_L(0); PG8_BAR; PG8_MMA(0, 0, At, B0); PG8_MMA(0, 1, At, B1); PG8_BAR; PG8_SCHED;
            PG8_LDA(At, 0, 1); PG8_STAGE(PG8_SB(0, 0), b2, lb2); PG8_STAGE(PG8_SB(0, 1), b2 + hB2, lb2); PG8_STAGE_A(PG8_SA(0, 0), a2, ao2[0]);
            PG8_WAIT_V(8); PG8_WAIT_L(0); PG8_BAR; PG8_MMA(1, 0, At, B0); PG8_MMA(1, 1, At, B1); PG8_BAR; PG8_SCHED;
            PG8_LDB(B0, 1, 0); PG8_LDB(B1, 1, 1); PG8_SCHED; PG8_LDA(At, 1, 0); PG8_STAGE_A(PG8_SA(0, 1), a2, ao2[1]);
            PG8_WAIT_V(8); PG8_WAIT_L(0); PG8_BAR; PG8_MMA(0, 0, At, B0); PG8_MMA(0, 1, At, B1); PG8_BAR; PG8_SCHED;
            PG8_LDA(At, 1, 1); PG8_STAGE(PG8_SB(1, 0), b3, lb2); PG8_STAGE(PG8_SB(1, 1), b3 + hB2, lb2); PG8_STAGE_A(PG8_SA(1, 0), a3, ao2[0]);
            PG8_WAIT_V(8); PG8_WAIT_L(0); PG8_BAR; PG8_MMA(1, 0, At, B0); PG8_MMA(1, 1, At, B1); PG8_BAR; PG8_SCHED;
        }
        if (wr == 0) PG8_BAR;
        bool keep_acc;
        { Unit eu = cur; int ewr = wr, ewc = wc, efr = fr, efq = fq; asm volatile("" : "+s"(eu.pm), "+s"(eu.pn), "+s"(eu.tag), "+s"(ewr), "+s"(ewc), "+v"(efr), "+v"(efq));
          keep_acc = E(acc, eu, ewr, ewc, efr, efq); }
        if (!has_next) break;
        if (!keep_acc) {
#pragma unroll
        for (int a = 0; a < 2; ++a)
#pragma unroll
            for (int b = 0; b < 2; ++b)
#pragma unroll
                for (int m = 0; m < 4; ++m)
#pragma unroll
                    for (int n = 0; n < 2; ++n) acc[a][b][m][n] = (f32x4){0.f, 0.f, 0.f, 0.f};
        }
        cur = nxt; cA = nA; cB = nB; clb = nlb; ++ui;
#pragma unroll
        for (int _h = 0; _h < 2; ++_h)
#pragma unroll
            for (int _i = 0; _i < 2; ++_i) ao_c[_h][_i] = ao_n[_h][_i];
        if (wr == 1) PG8_BAR;
    }
    PG8_WAIT_V(0);
    PG8_BAR;
#undef PG8_SA
#undef PG8_SB
#undef PG8_STAGE
#undef PG8_STAGE_A
#undef PG8_AOFF
#undef PG8_STAGE_IDX
#undef PG8_LDA
#undef PG8_LDB
#undef PG8_MMA
#undef PG8_WAIT_V
#undef PG8_WAIT_L
#undef PG8_BAR
#undef PG8_SCHED
}
}
#include <hip/hip_bf16.h>
#include <cmath>
namespace attn_body {
using bf16=__hip_bfloat16;
using bf16x8=__attribute__((ext_vector_type(8)))short;
using s16x4=__attribute__((ext_vector_type(4)))short;
using f32x16=__attribute__((ext_vector_type(16)))float;
using u32x4=__attribute__((ext_vector_type(4)))unsigned;
constexpr int D=64;
constexpr int NW=8,QBLK=32,KVBLK=64,NCT=4;
__device__ __forceinline__ int crow(int r,int hi){return (r&3)+8*(r>>2)+4*hi;}
#define SBAR() __builtin_amdgcn_sched_barrier(0)
__device__ __forceinline__ void wmask(f32x16&p0,f32x16&p1,int kb,int qabs,int hi){
  const float NEG=-INFINITY; const int d0=kb+4*hi-qabs;
  #pragma unroll
  for(int r=0;r<16;++r){int dd=d0+(r&3)+8*(r>>2); if(dd>128||dd<-128)p0[r]=NEG; if(dd+32>128||dd+32<-128)p1[r]=NEG;}
}

constexpr int NSLOT=3, SLOTB=8192;
constexpr int LDS_K=0, LDS_V=NSLOT*SLOTB, LDS_WS=2*NSLOT*SLOTB, LDS_OST=LDS_WS+NW*64*4, LDS_BYTES=LDS_OST+NW*4096;
__device__ __forceinline__ void glds16(const void*gsrc,unsigned lds_dst){unsigned keep;
  asm volatile("s_mov_b32 %0, m0\n\ts_mov_b32 m0, %2\n\ts_nop 0\n\tglobal_load_lds_dwordx4 %1, off\n\ts_mov_b32 m0, %0":"=&s"(keep):"v"(gsrc),"s"(lds_dst):"memory");}
__device__ __forceinline__ float max3f(float a,float b,float c){float r;asm("v_max3_f32 %0, %1, %2, %3":"=v"(r):"v"(a),"v"(b),"v"(c));return r;}
__device__ __forceinline__ float max2f(float a,float b){float r;asm("v_max_f32_e32 %0, %1, %2":"=v"(r):"v"(a),"v"(b));return r;}
__device__ __forceinline__ float fadd_s(float a,float b){float r;asm("v_add_f32_e32 %0, %1, %2":"=v"(r):"v"(a),"v"(b));return r;}
__device__ __forceinline__ float fsub_s(float a,float b){float r;asm("v_sub_f32_e32 %0, %1, %2":"=v"(r):"v"(a),"v"(b));return r;}
typedef float f32x2_t __attribute__((ext_vector_type(2))); typedef __bf16 bf16x2_t __attribute__((ext_vector_type(2)));
__device__ __forceinline__ unsigned cvtpk_s(float lo,float hi){f32x2_t v={lo,hi};bf16x2_t b=__builtin_convertvector(v,bf16x2_t);return __builtin_bit_cast(unsigned,b);}
#define WAIT_BAR(N) asm volatile("s_waitcnt vmcnt(" #N ") lgkmcnt(0)\n\ts_barrier":::"memory")

__device__ __forceinline__ void qkt(f32x16&p0,f32x16&p1,const char*Kslot,const bf16x8*qr,const f32x16&negm,int r32,int hi){
  const char*kb=Kslot+hi*1024+r32*16;
  #pragma unroll
  for(int d0=0;d0<4;++d0){
    const bf16x8 b0=*reinterpret_cast<const bf16x8*>(kb+d0*2048);
    const bf16x8 b1=*reinterpret_cast<const bf16x8*>(kb+d0*2048+512);
    if(d0==0){p0=__builtin_amdgcn_mfma_f32_32x32x16_bf16(b0,qr[0],negm,0,0,0);p1=__builtin_amdgcn_mfma_f32_32x32x16_bf16(b1,qr[0],negm,0,0,0);}
    else{p0=__builtin_amdgcn_mfma_f32_32x32x16_bf16(b0,qr[d0],p0,0,0,0);p1=__builtin_amdgcn_mfma_f32_32x32x16_bf16(b1,qr[d0],p1,0,0,0);}}
}
typedef __attribute__((address_space(3))) const char* lds_cptr;
typedef short v4i16_t __attribute__((ext_vector_type(4)));
__device__ __forceinline__ void kload8(bf16x8*kf,lds_cptr kp){
  kf[0]=*(const __attribute__((address_space(3))) bf16x8*)(kp);      kf[1]=*(const __attribute__((address_space(3))) bf16x8*)(kp+512);
  kf[2]=*(const __attribute__((address_space(3))) bf16x8*)(kp+2048); kf[3]=*(const __attribute__((address_space(3))) bf16x8*)(kp+2560);
  kf[4]=*(const __attribute__((address_space(3))) bf16x8*)(kp+4096); kf[5]=*(const __attribute__((address_space(3))) bf16x8*)(kp+4608);
  kf[6]=*(const __attribute__((address_space(3))) bf16x8*)(kp+6144); kf[7]=*(const __attribute__((address_space(3))) bf16x8*)(kp+6656);
}
__device__ __forceinline__ void kload2(bf16x8*kf,lds_cptr kp,int j){ kf[2*j]=*(const __attribute__((address_space(3))) bf16x8*)(kp+j*2048); kf[2*j+1]=*(const __attribute__((address_space(3))) bf16x8*)(kp+j*2048+512); }
__device__ __forceinline__ s16x4 vtr(lds_cptr p){ return __builtin_bit_cast(s16x4,__builtin_amdgcn_ds_read_tr16_b64_v4i16((__attribute__((address_space(3))) v4i16_t*)p)); }
__device__ __forceinline__ float rowmax(const f32x16&p0,const f32x16&p1){
  float a=max3f(p0[0],p0[1],p1[0]),b=max3f(p0[2],p0[3],p1[1]);a=max3f(a,p1[2],p1[3]);
  #pragma unroll
  for(int r=4;r<16;r+=4){a=max3f(a,p0[r],p0[r+1]);b=max3f(b,p0[r+2],p0[r+3]);a=max3f(a,p1[r],p1[r+1]);b=max3f(b,p1[r+2],p1[r+3]);}
  const float m=max2f(a,b);
  auto rr=__builtin_amdgcn_permlane32_swap(__float_as_uint(m),__float_as_uint(m),false,false);
  return max2f(__uint_as_float(rr[0]),__uint_as_float(rr[1]));
}
__device__ __forceinline__ void pv(f32x16*o,int vb,bf16x8 pa0,bf16x8 pa1,bf16x8 pa2,bf16x8 pa3){
  #pragma unroll
  for(int d0=0;d0<2;++d0){s16x4 lo[4],hi[4];
    #pragma unroll
    for(int ks=0;ks<4;++ks){
      asm volatile("ds_read_b64_tr_b16 %0,%1 offset:%c2":"=&v"(lo[ks]):"v"(vb),"i"(d0*4096+ks*1024):"memory");
      asm volatile("ds_read_b64_tr_b16 %0,%1 offset:%c2":"=&v"(hi[ks]):"v"(vb),"i"(d0*4096+ks*1024+512):"memory");}
    asm volatile("s_waitcnt lgkmcnt(0)":::"memory");SBAR();
    #define PK(k) (bf16x8){lo[k][0],lo[k][1],lo[k][2],lo[k][3],hi[k][0],hi[k][1],hi[k][2],hi[k][3]}
    o[d0]=__builtin_amdgcn_mfma_f32_32x32x16_bf16(pa0,PK(0),o[d0],0,0,0);
    o[d0]=__builtin_amdgcn_mfma_f32_32x32x16_bf16(pa1,PK(1),o[d0],0,0,0);
    o[d0]=__builtin_amdgcn_mfma_f32_32x32x16_bf16(pa2,PK(2),o[d0],0,0,0);
    o[d0]=__builtin_amdgcn_mfma_f32_32x32x16_bf16(pa3,PK(3),o[d0],0,0,0);
    #undef PK
  }
}

#ifndef ATTN_STORE16
#define ATTN_STORE16(p,v) (*(u32x4*)(p)=(v))
#endif
template<int MODE,int THRL> __device__ __forceinline__ void attn_unit(const bf16*Qw,int qp,const bf16*Kc,const bf16*Kl,const bf16*Vc,const bf16*Vl,int kp,int NT,int qabs,int band0,float sinkl2,bf16*Ow,int op,char*shm){
  int tid=threadIdx.x; asm volatile("":"+v"(tid));
  const int lane=tid&63,r32=lane&31,hi=lane>>5; const int wid=__builtin_amdgcn_readfirstlane(tid>>6);
  qabs+=r32;
  const unsigned lds0=(unsigned)(uintptr_t)shm;
  float*wsf=(float*)(shm+LDS_WS)+wid*64;
  const unsigned koff_=(unsigned)(lane*kp+wid*8)*2u;
  const unsigned voff_=(unsigned)((16*(wid&3)+(lane>>2))*kp+(wid>>2)*32+(lane&3)*8)*2u;
  const unsigned kdst=lds0+LDS_K+wid*1024, vdst=lds0+LDS_V+wid*1024;
  #define DMA_K(t,slot) glds16((const char*)((t)<NCT?Kc+(long)(t)*KVBLK*kp:Kl+(long)((t)-NCT)*KVBLK*kp)+koff_,(unsigned)__builtin_amdgcn_readfirstlane(kdst+(slot)))
  #define DMA_V(t,slot) glds16((const char*)((t)<NCT?Vc+(long)(t)*KVBLK*kp:Vl+(long)((t)-NCT)*KVBLK*kp)+voff_,(unsigned)__builtin_amdgcn_readfirstlane(vdst+(slot)))
  const int vb0=(int)(lds0+LDS_V)+((lane>>4)&1)*32+(lane&3)*8+(4*hi+((lane&15)>>2))*64;
  const char*Kbase=shm+LDS_K; bf16x8 kf[8];
  const lds_cptr shm3=(lds_cptr)shm; const lds_cptr kp0=shm3+LDS_K+hi*1024+r32*16; const lds_cptr vp0=shm3+LDS_V+((lane>>4)&1)*32+(lane&3)*8+(4*hi+((lane&15)>>2))*64;
  DMA_K(0,0);DMA_V(0,0);DMA_K(1,SLOTB);
  bf16x8 qr[4];
  #pragma unroll
  for(int d0=0;d0<4;++d0)qr[d0]=*reinterpret_cast<const bf16x8*>(&Qw[(long)r32*qp+d0*16+hi*8]);
  float mhat=0.f,l_reg=0.f;f32x16 o[2];o[0]=f32x16{};o[1]=f32x16{};f32x16 negm=f32x16{};asm volatile("":"+v"(negm));
  #define CMASK(P0,P1,t) do{ if(MODE==1){ if((t)>=NCT)wmask(P0,P1,band0+KVBLK*((t)-NCT),qabs,hi);} }while(0)
  bool resc=false;
  #define START(P0,P1) do{ const float rm=rowmax(P0,P1); resc=false; \
    { const float dl=rm; mhat=fadd_s(mhat,dl); \
      _Pragma("unroll") for(int r=0;r<16;++r){P0[r]=fsub_s(P0[r],dl);P1[r]=fsub_s(P1[r],dl);} \
      _Pragma("unroll") for(int r=0;r<16;++r)negm[r]=-mhat; asm volatile("":"+v"(negm)); } \
    _Pragma("unroll") for(int r=0;r<16;++r)P0[r]=__builtin_amdgcn_exp2f(P0[r]); }while(0)
  #define RESC() do{ if(resc){ asm volatile("s_waitcnt lgkmcnt(0)":::"memory"); \
      _Pragma("unroll") for(int d_=0;d_<2;++d_) _Pragma("unroll") for(int r=0;r<16;++r)o[d_][r]*=wsf[crow(r,hi)]; } }while(0)
  f32x16 pA0,pA1,pB0,pB1;
  int sl_prev=0,sl_cur=0,sl_next=SLOTB;
  #define ROT() do{sl_prev=sl_cur;sl_cur=sl_next;sl_next=(sl_next==(NSLOT-1)*SLOTB)?0:sl_next+SLOTB;}while(0)
  DMA_K(2,2*SLOTB);
  WAIT_BAR(3);
  qkt(pA0,pA1,Kbase,qr,negm,r32,hi);asm volatile("s_nop 15\n\ts_nop 7":"+v"(pA0),"+v"(pA1));CMASK(pA0,pA1,0);
  START(pA0,pA1);
  _Pragma("unroll") for(int r=0;r<16;++r)pA1[r]=__builtin_amdgcn_exp2f(pA1[r]);
  WAIT_BAR(0);
  DMA_K(3,0);DMA_V(1,SLOTB);
  ROT();
  kload8(kf,kp0+sl_cur);
  WAIT_BAR(2);
  s16x4 vlo[8],vhi[8]; u32x4 pw0,pw1,pw2,pw3;
  #define PKW(P,B) cvtpk_s(P[B],P[B+1])
  #define PAF(k) __builtin_bit_cast(bf16x8,pw##k)
  #define VFR(i) (bf16x8){vlo[i][0],vlo[i][1],vlo[i][2],vlo[i][3],vhi[i][0],vhi[i][1],vhi[i][2],vhi[i][3]}
  #define PIN(x) asm volatile("":"+v"(x))
  #define MX3(a,b,c) __builtin_fmaxf(__builtin_fmaxf((a),(b)),(c))
  #define GAPA(MF,A0,A1,A2,A3,W0,W1,PW) do{ MF; sacc+=A0; sacc+=A1; sacc+=A2; sacc+=A3; PIN(sacc); W0; W1; PIN(PW); SBAR(); }while(0)
  #define EX(v) __builtin_amdgcn_exp2f(v)
  #define GAPB(MF,X,B) do{ MF; X[B]=EX(X[B]); X[B+1]=EX(X[B+1]); X[B+2]=EX(X[B+2]); X[B+3]=EX(X[B+3]); PIN(X); SBAR(); }while(0)
  #define VRD(i) do{ vlo[i]=vtr(vp_+(((i)>>2)*4096+((i)&3)*1024)); vhi[i]=vtr(vp_+(((i)>>2)*4096+((i)&3)*1024+512)); }while(0)
  #define KRD(G,j) do{ if(G){ kload2(kf,kp0+sl_next,j); SBAR(); } }while(0)
  #define STEP(C0,C1,P0,P1,t,GK,GV,GL) do{ SBAR(); \
    const lds_cptr vp_=vp0+sl_prev; \
    VRD(0); SBAR(); float sacc=(P0[0]+P0[1]); \
    GAPA(C0=__builtin_amdgcn_mfma_f32_32x32x16_bf16(kf[0],qr[0],negm,0,0,0), P0[2],P0[3],P0[4],P0[5],     pw0[0]=PKW(P0,0), pw0[1]=PKW(P0,2), pw0); \
    VRD(4); SBAR(); GAPA(C1=__builtin_amdgcn_mfma_f32_32x32x16_bf16(kf[1],qr[0],negm,0,0,0), P0[6],P0[7],P0[8],P0[9],     pw0[2]=PKW(P0,4), pw0[3]=PKW(P0,6), pw0); \
    VRD(1); SBAR(); GAPA(C0=__builtin_amdgcn_mfma_f32_32x32x16_bf16(kf[2],qr[1],C0,0,0,0),   P0[10],P0[11],P0[12],P0[13], pw1[0]=PKW(P0,8), pw1[1]=PKW(P0,10), pw1); \
    VRD(5); SBAR(); GAPA(C1=__builtin_amdgcn_mfma_f32_32x32x16_bf16(kf[3],qr[1],C1,0,0,0),   P0[14],P0[15],P1[0],P1[1],   pw1[2]=PKW(P0,12),pw1[3]=PKW(P0,14), pw1); \
    VRD(2); SBAR(); GAPA(C0=__builtin_amdgcn_mfma_f32_32x32x16_bf16(kf[4],qr[2],C0,0,0,0),   P1[2],P1[3],P1[4],P1[5],     pw2[0]=PKW(P1,0), pw2[1]=PKW(P1,2), pw2); \
    VRD(6); SBAR(); GAPA(C1=__builtin_amdgcn_mfma_f32_32x32x16_bf16(kf[5],qr[2],C1,0,0,0),   P1[6],P1[7],P1[8],P1[9],     pw2[2]=PKW(P1,4), pw2[3]=PKW(P1,6), pw2); \
    VRD(3); SBAR(); GAPA(C0=__builtin_amdgcn_mfma_f32_32x32x16_bf16(kf[6],qr[3],C0,0,0,0),   P1[10],P1[11],P1[12],P1[13], pw3[0]=PKW(P1,8), pw3[1]=PKW(P1,10), pw3); \
    VRD(7); SBAR(); GAPA(C1=__builtin_amdgcn_mfma_f32_32x32x16_bf16(kf[7],qr[3],C1,0,0,0),   P1[14],P1[15],0.f,0.f,       pw3[2]=PKW(P1,12),pw3[3]=PKW(P1,14), pw3); \
    l_reg+=sacc; \
    if(GK){DMA_K((t)+3,sl_cur);} if(GV){DMA_V((t)+1,sl_next);} \
    CMASK(C0,C1,t); \
    { float a=MX3(C0[0],C0[1],C1[0]),b=MX3(C0[2],C0[3],C1[1]); a=MX3(a,C1[2],C1[3]); \
      _Pragma("unroll") for(int r=4;r<16;r+=4){a=MX3(a,C0[r],C0[r+1]);b=MX3(b,C0[r+2],C0[r+3]);a=MX3(a,C1[r],C1[r+1]);b=MX3(b,C1[r+2],C1[r+3]);} \
      float rm=__builtin_fmaxf(a,b); { auto rr=__builtin_amdgcn_permlane32_swap(__float_as_uint(rm),__float_as_uint(rm),false,false); rm=__builtin_fmaxf(__uint_as_float(rr[0]),__uint_as_float(rr[1])); } \
      resc=false; \
      if(__builtin_expect(__any(rm>(float)THRL),0)){ const float dl=__builtin_fmaxf(rm,0.f); mhat+=dl; \
        _Pragma("unroll") for(int r=0;r<16;++r){C0[r]-=dl;C1[r]-=dl;} \
        _Pragma("unroll") for(int r=0;r<16;++r)negm[r]=-mhat; asm volatile("":"+v"(negm)); \
        const float f=__builtin_amdgcn_exp2f(-dl); l_reg*=f; if(hi==0)wsf[r32]=f; resc=true; } } \
    SBAR(); \
    GAPB(o[0]=__builtin_amdgcn_mfma_f32_32x32x16_bf16(PAF(0),VFR(0),o[0],0,0,0), C0,0); \
    GAPB(o[1]=__builtin_amdgcn_mfma_f32_32x32x16_bf16(PAF(0),VFR(4),o[1],0,0,0), C0,4); \
    KRD(GL,0); GAPB(o[0]=__builtin_amdgcn_mfma_f32_32x32x16_bf16(PAF(1),VFR(1),o[0],0,0,0), C0,8); \
    KRD(GL,1); GAPB(o[1]=__builtin_amdgcn_mfma_f32_32x32x16_bf16(PAF(1),VFR(5),o[1],0,0,0), C0,12); \
    KRD(GL,2); GAPB(o[0]=__builtin_amdgcn_mfma_f32_32x32x16_bf16(PAF(2),VFR(2),o[0],0,0,0), C1,0); \
    KRD(GL,3); GAPB(o[1]=__builtin_amdgcn_mfma_f32_32x32x16_bf16(PAF(2),VFR(6),o[1],0,0,0), C1,4); \
    GAPB(o[0]=__builtin_amdgcn_mfma_f32_32x32x16_bf16(PAF(3),VFR(3),o[0],0,0,0), C1,8); \
    GAPB(o[1]=__builtin_amdgcn_mfma_f32_32x32x16_bf16(PAF(3),VFR(7),o[1],0,0,0), C1,12); \
    }while(0)
  int t=1;
  for(;t+5<NT;t+=2){
    STEP(pB0,pB1,pA0,pA1,t,true,true,true);     WAIT_BAR(2); RESC(); ROT();
    STEP(pA0,pA1,pB0,pB1,t+1,true,true,true);   WAIT_BAR(2); RESC(); ROT();
  }
  #define ENDW(tt) do{ if((tt)+3<NT){WAIT_BAR(2);} else if((tt)+2<NT){WAIT_BAR(1);} else {WAIT_BAR(0);} }while(0)
  for(;t+1<NT;t+=2){
    STEP(pB0,pB1,pA0,pA1,t,(t+3<NT),(t+1<NT),(t+1<NT));       ENDW(t);   RESC(); ROT();
    STEP(pA0,pA1,pB0,pB1,t+1,(t+4<NT),(t+2<NT),(t+2<NT));     ENDW(t+1); RESC(); ROT();
  }
  STEP(pB0,pB1,pA0,pA1,NT-1,false,false,false); RESC();
  { float sacc=pB0[0]+pB0[1]; _Pragma("unroll") for(int r=2;r<16;++r)sacc+=pB0[r]; _Pragma("unroll") for(int r=0;r<16;++r)sacc+=pB1[r]; l_reg+=sacc;
    pw0=(u32x4){PKW(pB0,0),PKW(pB0,2),PKW(pB0,4),PKW(pB0,6)};pw1=(u32x4){PKW(pB0,8),PKW(pB0,10),PKW(pB0,12),PKW(pB0,14)};pw2=(u32x4){PKW(pB1,0),PKW(pB1,2),PKW(pB1,4),PKW(pB1,6)};pw3=(u32x4){PKW(pB1,8),PKW(pB1,10),PKW(pB1,12),PKW(pB1,14)};
    SBAR(); pv(o,vb0+sl_cur,PAF(0),PAF(1),PAF(2),PAF(3)); }
  #undef PKW
  #undef PAF
  #undef VFR
  #undef PIN
  #undef MX3
  #undef GAPA
  #undef GAPB
  #undef EX
  #undef VRD
  #undef KRD
  #undef STEP
  #undef ENDW
  {auto rr=__builtin_amdgcn_permlane32_swap(__float_as_uint(l_reg),__float_as_uint(l_reg),false,false);l_reg=__uint_as_float(rr[0])+__uint_as_float(rr[1]);}
  if(MODE==1)l_reg+=__builtin_amdgcn_exp2f(sinkl2-mhat);
  if(hi==0)wsf[32+r32]=l_reg;asm volatile("s_waitcnt lgkmcnt(0)":::"memory");
  float rli[16];
  #pragma unroll
  for(int r=0;r<16;++r)rli[r]=__builtin_amdgcn_rcpf(wsf[32+crow(r,hi)]);
  { bf16*stg=(bf16*)(shm+LDS_OST)+wid*2048;
    #pragma unroll
    for(int r=0;r<16;++r){const int orow=crow(r,hi);
      #pragma unroll
      for(int d0=0;d0<2;++d0)stg[orow*64+d0*32+r32]=__float2bfloat16(o[d0][r]*rli[r]);}
    asm volatile("s_waitcnt lgkmcnt(0)":::"memory");
    #pragma unroll
    for(int i=0;i<4;++i){const int row=i*8+(lane>>3),ch=lane&7; const u32x4 v=*(const u32x4*)(stg+row*64+ch*8); ATTN_STORE16(Ow+(long)row*op+ch*8,v);} }
  asm volatile("s_waitcnt lgkmcnt(0)\n\ts_barrier":::"memory");
  #undef DMA_K
  #undef DMA_V
  #undef CMASK
  #undef START
  #undef RESC
  #undef ROT
}
constexpr int ATTN_LDS_BYTES=LDS_BYTES;
#undef SBAR
#undef WAIT_BAR
}
constexpr int NWAVES = 8;
constexpr size_t MiB = 1u << 20;
constexpr size_t WS_CTL = 0, CTL_ZERO_BYTES = 256 * 1024;
constexpr size_t WS_MOD = 1 * MiB;
constexpr size_t WS_ROPE = WS_MOD + 512 * 1024;
constexpr size_t WS_AFS = WS_ROPE + 64 * 1024;
constexpr size_t WS_IDX = WS_AFS + 192 * 1024;
constexpr size_t WS_SEL = 2 * MiB;
constexpr size_t WS_AFF = 4 * MiB;
constexpr size_t WS_ABTC = WS_AFF;
constexpr size_t WS_WIN = 6 * MiB;
constexpr size_t WS_WBR = 25 * MiB;
constexpr size_t WS_WOUT = 29 * MiB;
constexpr size_t WS_DFT = 33 * MiB;
constexpr size_t WS_DFTC = 49 * MiB;
constexpr size_t WS_WGU = 50 * MiB;
constexpr size_t WS_WD = 178 * MiB;
constexpr size_t WS_X = 242 * MiB;
constexpr size_t WS_HN = 314 * MiB;
constexpr size_t WS_MB = WS_HN;
constexpr size_t WS_QKV = 350 * MiB;
constexpr size_t WS_G = 395 * MiB;
constexpr size_t WS_BR = 503 * MiB;
constexpr size_t WS_HACT = 467 * MiB;
constexpr size_t WS_ABT = 539 * MiB;
constexpr size_t WS_END = 555 * MiB;
constexpr size_t QKV_QG = 0, QKV_KG = (size_t)NTOK * 512 * 2, QKV_VG = QKV_KG + (size_t)NTOK * 128 * 2, QKV_QW = QKV_VG + (size_t)NTOK * 128 * 2,
                 QKV_KW = QKV_QW + (size_t)NTOK * 256 * 2, QKV_VW = QKV_KW + (size_t)NTOK * 128 * 2;
static_assert(WS_WIN + (size_t)DEPTH * INW2 * DM * 2 <= WS_WBR && WS_QKV + QKV_VW + (size_t)NTOK * 128 * 2 <= WS_G && WS_G + (size_t)NTOK * 3 * DM * 2 <= WS_BR && WS_HACT >= WS_G + (size_t)NE * RPE * DM * 2 &&
              WS_HACT + (size_t)NE * RPE * DM * 2 <= WS_ABT && WS_ABT + (size_t)NBATCH * 256 * 2 * SEQ * 2 <= WS_END && (size_t)NBATCH * 256 * 2 * CTX * 2 <= 2 * MiB, "d_ws map");
constexpr int CW_BAR = 1024;
constexpr int CW_QUEUE = 8192;
constexpr int CW_CONVQ = 8192 + 64 * 8;
constexpr int CW_FIN = CW_CONVQ + 64;
constexpr int RING_BYTES = 131072;
constexpr int LDSCTL_OFF = RING_BYTES, MISC_OFF = LDSCTL_OFF + 320;
constexpr int IDXBUF_OFF = LDSCTL_OFF + 1024 + 8192;
constexpr int LDS_BYTES = 147456;

#define GAS __attribute__((address_space(1)))
#define LAS __attribute__((address_space(3)))
typedef unsigned short bf16;
typedef unsigned v4u __attribute__((ext_vector_type(4)));
typedef unsigned v2u __attribute__((ext_vector_type(2)));
typedef float f32x4 __attribute__((ext_vector_type(4)));
typedef GAS unsigned gu32;
#define RLX_AGENT __ATOMIC_RELAXED, __HIP_MEMORY_SCOPE_AGENT
#define LDS_WAIT() asm volatile("s_waitcnt lgkmcnt(0)" ::: "memory")
#define VM_WAIT() asm volatile("s_waitcnt vmcnt(0)" ::: "memory")
__device__ __forceinline__ unsigned f2bf(float f) { unsigned u = __builtin_bit_cast(unsigned, f); return (u + 0x7fffu + ((u >> 16) & 1u)) >> 16; }
__device__ __forceinline__ unsigned pk2(float lo, float hi) { return f2bf(lo) | (f2bf(hi) << 16); }
__device__ __forceinline__ float bf2f(unsigned short h) { return __builtin_bit_cast(float, (unsigned)h << 16); }
__device__ __forceinline__ float bflo(unsigned w) { return __builtin_bit_cast(float, w << 16); }
__device__ __forceinline__ float bfhi(unsigned w) { return __builtin_bit_cast(float, w & 0xffff0000u); }

#define XB_TMO      128
#define XB_XCNT(j)  (256  + 64 * (j))
#define XB_XSUB(j)  (1280 + 64 * (j))
#define XB_XGEN(j)  (2304 + 64 * (j))
#define XB_TOP      3328
#define XB_TOPGEN   3392
#define XCD_BAR_WORDS 3456
#define XB_SPIN_CAP (1u << 20)
__device__ __forceinline__ unsigned xb_ld(unsigned* p)              { return __hip_atomic_load(p, __ATOMIC_RELAXED, __HIP_MEMORY_SCOPE_AGENT); }
__device__ __forceinline__ unsigned xb_add(unsigned* p, unsigned v) { return __hip_atomic_fetch_add(p, v, __ATOMIC_RELAXED, __HIP_MEMORY_SCOPE_AGENT); }
__device__ __forceinline__ unsigned xb_xcc_id() { return (unsigned)__builtin_amdgcn_s_getreg((3 << 11) | 20) & 0xFu; }
#define XB_SPIN(cond, bar) do { unsigned _sp = 0; while (cond) { __builtin_amdgcn_s_sleep(1); \
    if ((++_sp & 255u) == 0u) { if (xb_ld(&(bar)[XB_TMO])) break; if (_sp > XB_SPIN_CAP) { atomicAdd(&(bar)[XB_TMO], 1u); break; } } } } while (0)
struct XcdBarrier { unsigned* bar; unsigned x; volatile LAS unsigned* st; };
__device__ __forceinline__ XcdBarrier xcd_barrier_post(unsigned* bar, volatile LAS unsigned* st) {
    XcdBarrier b; b.bar = bar; b.x = xb_xcc_id(); b.st = st;
    if (threadIdx.x == 0) (void)xb_add(&bar[XB_XCNT(b.x)], 1u);
    return b;
}
__device__ __forceinline__ void xcd_barrier_complete(unsigned* bar, unsigned x, unsigned& nloc, unsigned& nx) {
    const unsigned G = gridDim.x * gridDim.y * gridDim.z;
    unsigned sum, cnt, mine, sp = 0u;
    for (;;) {
        sum = 0u; cnt = 0u; mine = 0u;
#pragma unroll
        for (unsigned j = 0; j < 16; ++j) { const unsigned c = xb_ld(&bar[XB_XCNT(j)]); sum += c; cnt += (c > 0u) ? 1u : 0u; mine = (j == x) ? c : mine; }
        if (sum == G) break;
        __builtin_amdgcn_s_sleep(1);
        if ((++sp & 255u) == 0u) { if (xb_ld(&bar[XB_TMO])) break; if (sp > XB_SPIN_CAP) { atomicAdd(&bar[XB_TMO], 1u); break; } }
    }
    nloc = mine > 0u ? mine : 1u; nx = cnt > 0u ? cnt : 1u;
}
__device__ __forceinline__ void xcd_barrier(const XcdBarrier& b) {
    asm volatile("s_waitcnt vmcnt(0)" ::: "memory");
    __syncthreads();
    if (threadIdx.x == 0) {
        unsigned* bar = b.bar;
        __builtin_amdgcn_s_waitcnt(0);
        unsigned nloc = b.st[0], nx = b.st[1];
        if (nloc == 0u) { xcd_barrier_complete(bar, b.x, nloc, nx); b.st[0] = nloc; b.st[1] = nx; }
        const unsigned old = xb_add(&bar[XB_XSUB(b.x)], 1u);
        const unsigned gen = old / nloc;
        if (old + 1u == (gen + 1u) * nloc) {
            __builtin_amdgcn_fence(__ATOMIC_RELEASE, "agent");
            asm volatile("s_waitcnt vmcnt(0)" ::: "memory");
            const unsigned og = xb_add(&bar[XB_TOP], 1u);
            const unsigned tg = og / nx;
            if (og + 1u == (tg + 1u) * nx) xb_add(&bar[XB_TOPGEN], 1u);
            else XB_SPIN(xb_ld(&bar[XB_TOPGEN]) == tg, bar);
            __builtin_amdgcn_fence(__ATOMIC_ACQUIRE, "agent");
            xb_add(&bar[XB_XGEN(b.x)], 1u);
            asm volatile("s_waitcnt vmcnt(0)" ::: "memory");
        } else {
            XB_SPIN(xb_ld(&bar[XB_XGEN(b.x)]) == gen, bar);
            __builtin_amdgcn_fence(__ATOMIC_ACQUIRE, "agent");
            asm volatile("s_waitcnt vmcnt(0)" ::: "memory");
        }
    }
    __syncthreads();
}
template <int CTRL> __device__ __forceinline__ float dpp_mov(float v) { return __builtin_bit_cast(float, __builtin_amdgcn_update_dpp(0, __builtin_bit_cast(int, v), CTRL, 0xF, 0xF, true)); }
__device__ __forceinline__ float lx1(float v) { return dpp_mov<0xB1>(v); }
__device__ __forceinline__ float lx2(float v) { return dpp_mov<0x4E>(v); }
__device__ __forceinline__ float lx4(float v) { return dpp_mov<0x1B>(dpp_mov<0x141>(v)); }
__device__ __forceinline__ float lx8(float v) { return dpp_mov<0x141>(dpp_mov<0x140>(v)); }
__device__ __forceinline__ float lx16(float v) { return __shfl_xor(v, 16); }
__device__ __forceinline__ float lx32(float v) { const unsigned u = __builtin_bit_cast(unsigned, v); auto r = __builtin_amdgcn_permlane32_swap(u, u, false, false);
    return __builtin_bit_cast(float, (threadIdx.x & 32) ? r[0] : r[1]); }
__device__ __forceinline__ float wave_sum(float v) {
    v += lx1(v); v += lx2(v); v += lx4(v); v += lx8(v); v += lx16(v); v += lx32(v);
    return v;
}
using pg8::Unit;
typedef pg8::f32x4 (&AccRef)[2][2][4][2];

__device__ __forceinline__ v2u pack4(f32x4 v) { v2u w; w.x = pg8::cvt_pk_bf16(v[0], v[1]); w.y = pg8::cvt_pk_bf16(v[2], v[3]); return w; }
__device__ __forceinline__ float sigmoidf_(float v) { return __builtin_amdgcn_rcpf(1.f + __builtin_amdgcn_exp2f(-LOG2E * v)); }

template <class Dec> struct Strided {
    Dec d; int n, G, vcu;
    __device__ __forceinline__ bool next(int i, Unit& u) const { const int L = i * G + vcu; if (L >= n) return false; d(L, u); return true; }
};

struct DecInProj { const char* A; const char* B; int layer;
    __device__ __forceinline__ void operator()(int L, Unit& u) const {
        int pm, pn;
        if (L < 1024) { const int cg = L >> 8, rg = (L & 255) >> 5, w = L & 31; pm = rg * 8 + (w & 7); pn = cg * 4 + (w >> 3); }
        else if (L < 1216) { const int q = L - 1024, rg = q / 24, w = q % 24; pm = rg * 8 + (w & 7); pn = 16 + (w >> 3); }
        else { const int q = L - 1216; pm = 64 + (q & 7); pn = q >> 3; if (layer == DEPTH - 1) pn = pn ? 6 : 4; }
        u.A = A + (size_t)pm * 256 * (DM * 2); u.B = B + (size_t)pn * 256 * (DM * 2); u.arows = nullptr; u.ldA = DM * 2; u.ldB = DM * 2; u.nt = DM / 64; u.pm = pm; u.pn = pn; u.tag = 0;
    } };
constexpr int inproj_units(int layer) { return 1216 + (layer == DEPTH - 1 ? 16 : 152); }

struct EpiInProj {
    static constexpr bool PERM = true;
    bf16 *ABt, *ABtc, *Qg, *Kg, *Vg, *Qw, *Kw, *Vw, *G; const float* rope; const float* qng; const float* kng;
    __device__ __forceinline__ bool operator()(AccRef acc, const Unit& u, int wr, int wc, int fr, int fq) const {
        const int pm = u.pm, pn = u.pn; const bool lat = pm < 64;
        const int rowt = wr * 64 + fr;
        if (pn < 2) {
            bf16* dst; int ld;
            if (lat) { dst = ABt + ((size_t)(pm >> 3) * 256) * (2 * SEQ) + pn * SEQ + (pm & 7) * 256; ld = 2 * SEQ; }
            else { dst = ABtc + ((size_t)(pm - 64) * 256) * (2 * CTX) + pn * CTX; ld = 2 * CTX; }
#pragma unroll
            for (int ai = 0; ai < 2; ++ai)
#pragma unroll
                for (int m = 0; m < 4; ++m) { const int tok = rowt + ai * 128 + m * 16;
#pragma unroll
                    for (int bj = 0; bj < 2; ++bj)
#pragma unroll
                        for (int n = 0; n < 2; ++n) { const int c = bj * 128 + wc * 32 + fq * 8 + n * 4; const pg8::f32x4 v = acc[ai][bj][m][n];
#pragma unroll
                            for (int j = 0; j < 4; ++j) dst[(size_t)(c + j) * ld + tok] = (bf16)f2bf(v[j]); } }
        } else if (pn < 7) {
            bf16* dst; int ld; const float* ng = nullptr; bool rope_on = false; float sc = 1.f;
            if (pn <= 3)      { dst = Qg + (pn - 2) * 256 + wc * 64; ld = 512; ng = qng; rope_on = lat; sc = QSCALE; }
            else if (pn == 4) { if (wc < 2) { dst = Kg + wc * 64; ng = kng; rope_on = lat; } else { dst = Vg + (wc - 2) * 64; } ld = 128; }
            else if (pn == 5) { dst = Qw + wc * 64; ld = 256; rope_on = lat; sc = QSCALE; }
            else              { if (wc < 2) { dst = Kw + wc * 64; rope_on = lat; } else { dst = Vw + (wc - 2) * 64; } ld = 128; }
#pragma unroll
            for (int ai = 0; ai < 2; ++ai)
#pragma unroll
                for (int m = 0; m < 4; ++m) {
                    const int row = pm * 256 + rowt + ai * 128 + m * 16;
                    pg8::f32x4 v[2][2];
                    float ss = 0.f;
#pragma unroll
                    for (int bj = 0; bj < 2; ++bj)
#pragma unroll
                        for (int n = 0; n < 2; ++n) { v[bj][n] = acc[ai][bj][m][n]; ss += (v[bj][n][0] * v[bj][n][0] + v[bj][n][1] * v[bj][n][1]) + (v[bj][n][2] * v[bj][n][2] + v[bj][n][3] * v[bj][n][3]); }
                    float r = sc;
                    if (ng) { ss += __shfl_xor(ss, 16); ss += __shfl_xor(ss, 32); r = sc * rsqrtf(ss * (1.f / 64.f) + EPS); }
                    const int t = row & (SEQ - 1);
#pragma unroll
                    for (int bj = 0; bj < 2; ++bj) { v2u o[2];
#pragma unroll
                        for (int n = 0; n < 2; ++n) {
                            pg8::f32x4 x = v[bj][n] * r; if (ng) x = x * *(const pg8::f32x4*)(ng + bj * 32 + fq * 8 + n * 4);
                            if (rope_on) {
                                const int pos = bj ? (t & 63) : (t >> 6);
                                const pg8::f32x4 cs = *(const pg8::f32x4*)(rope + ((size_t)pos * 16 + fq * 4 + n * 2) * 2);
                                x = (pg8::f32x4){x[0] * cs[0] - x[1] * cs[1], x[0] * cs[1] + x[1] * cs[0], x[2] * cs[2] - x[3] * cs[3], x[2] * cs[3] + x[3] * cs[2]};
                            }
                            o[n] = pack4(x);
                        }
                        *(v4u*)(dst + (size_t)row * ld + bj * 32 + fq * 8) = (v4u){o[0].x, o[0].y, o[1].x, o[1].y}; }
                    asm volatile("" ::: "memory");
                }
        } else {
            bf16* dst = G + ((size_t)pm * 12 + (pn - 7)) * 65536 + (size_t)(((wr * 4 + wc) * 64 + fq * 16 + fr) * 8);
#pragma unroll
            for (int ai = 0; ai < 2; ++ai)
#pragma unroll
                for (int bj = 0; bj < 2; ++bj)
#pragma unroll
                    for (int m = 0; m < 4; ++m) { const pg8::f32x4 a = acc[ai][bj][m][0], b = acc[ai][bj][m][1];
                        const v2u lo = pack4((pg8::f32x4){sigmoidf_(a[0]), sigmoidf_(a[1]), sigmoidf_(a[2]), sigmoidf_(a[3])}), hi = pack4((pg8::f32x4){sigmoidf_(b[0]), sigmoidf_(b[1]), sigmoidf_(b[2]), sigmoidf_(b[3])});
                        *(v4u*)(dst + (size_t)(((ai * 2 + bj) * 4 + m) * 4096)) = (v4u){lo.x, lo.y, hi.x, hi.y}; }
        }
        return false;
    }
};

struct EpiStore { static constexpr bool PERM = true; bf16* O; int ld;
    __device__ __forceinline__ bool operator()(AccRef acc, const Unit& u, int wr, int wc, int fr, int fq) const {
        bf16* dst = O + ((size_t)u.pm * 256 + wr * 64 + fr) * ld + u.pn * 256 + wc * 32 + fq * 8;
#pragma unroll
        for (int ai = 0; ai < 2; ++ai)
#pragma unroll
            for (int m = 0; m < 4; ++m)
#pragma unroll
                for (int bj = 0; bj < 2; ++bj) { const v2u o0 = pack4(acc[ai][bj][m][0]), o1 = pack4(acc[ai][bj][m][1]);
                    *(v4u*)(dst + (size_t)(ai * 128 + m * 16) * ld + bj * 128) = (v4u){o0.x, o0.y, o1.x, o1.y}; }
        return false;
    } };
struct DecDft { const char* Dm; const char* Dc; const char* ABt; const char* ABtc;
    __device__ __forceinline__ void operator()(int L, Unit& u) const {
        if (L < 64) { const int b = L >> 3, mt = L & 7; u.A = Dm + (size_t)mt * 256 * (4 * SEQ); u.B = ABt + (size_t)b * 256 * (4 * SEQ); u.ldA = 4 * SEQ; u.ldB = 4 * SEQ; u.nt = 2 * SEQ / 64; u.pm = L; }
        else { const int b = L - 64; u.A = Dc; u.B = ABtc + (size_t)b * 256 * (4 * CTX); u.ldA = 4 * CTX; u.ldB = 4 * CTX; u.nt = 2 * CTX / 64; u.pm = 64 + b; }
        u.pn = 0; u.tag = 0; u.arows = nullptr;
    } };

struct SchedMerge { const char* BR; const char* W; int ntiles, G, vcu;
    __device__ __forceinline__ bool next(int i, Unit& u) const {
        const int round = i / 3, tag = i - round * 3, tile = round * G + vcu; if (tile >= ntiles) return false;
        const int pm = tile >> 2, pn = tile & 3, koff = tag == 0 ? 0 : (tag == 1 ? 256 : 768);
        u.A = BR + (size_t)pm * 256 * (DM * 2) + koff * 2; u.B = W + (size_t)pn * 256 * (DM * 2) + koff * 2; u.arows = nullptr; u.ldA = DM * 2; u.ldB = DM * 2; u.nt = tag == 1 ? 8 : 4; u.pm = pm; u.pn = pn; u.tag = tag;
        return true;
    } };
struct EpiMerge { static constexpr bool PERM = true; const bf16* G; bf16* Mb; int probe;
    __device__ __forceinline__ bool operator()(AccRef acc, const Unit& u, int wr, int wc, int fr, int fq) const {
        const size_t row0 = (size_t)u.pm * 256 + wr * 64 + fr; const int col0 = u.pn * 256 + wc * 32 + fq * 8; const int tag = u.tag;
        const bf16* g0 = G + ((size_t)u.pm * 12 + tag * 4 + u.pn) * 65536 + (size_t)(((wr * 4 + wc) * 64 + fq * 16 + fr) * 8);
#pragma unroll
        for (int ai = 0; ai < 2; ++ai)
#pragma unroll
            for (int bj = 0; bj < 2; ++bj) {
#pragma unroll
                for (int m = 0; m < 4; ++m) { const size_t fo = (size_t)(((ai * 2 + bj) * 4 + m) * 4096);
                    const v4u gw = probe == 2 ? (v4u){0x3f803f80u, 0x3f803f80u, 0x3f803f80u, 0x3f803f80u} : *(const v4u*)(g0 + fo);
                    pg8::f32x4 ga = {bflo(gw.x), bfhi(gw.x), bflo(gw.y), bfhi(gw.y)}, gb = {bflo(gw.z), bfhi(gw.z), bflo(gw.w), bfhi(gw.w)};
                    if (tag < 2) { const v4u hw = probe == 2 ? (v4u){0x3f803f80u, 0x3f803f80u, 0x3f803f80u, 0x3f803f80u} : *(const v4u*)(g0 + 4 * 65536 + fo);
                        ga = (pg8::f32x4){ga[0] * __builtin_amdgcn_rcpf(bflo(hw.x)), ga[1] * __builtin_amdgcn_rcpf(bfhi(hw.x)), ga[2] * __builtin_amdgcn_rcpf(bflo(hw.y)), ga[3] * __builtin_amdgcn_rcpf(bfhi(hw.y))};
                        gb = (pg8::f32x4){gb[0] * __builtin_amdgcn_rcpf(bflo(hw.z)), gb[1] * __builtin_amdgcn_rcpf(bfhi(hw.z)), gb[2] * __builtin_amdgcn_rcpf(bflo(hw.w)), gb[3] * __builtin_amdgcn_rcpf(bfhi(hw.w))};
                        acc[ai][bj][m][0] = acc[ai][bj][m][0] * ga; acc[ai][bj][m][1] = acc[ai][bj][m][1] * gb; }
                    else { const size_t row = row0 + ai * 128 + m * 16; const int c = col0 + bj * 128;
                        const v2u o0 = pack4(acc[ai][bj][m][0] * ga), o1 = pack4(acc[ai][bj][m][1] * gb); *(v4u*)(Mb + row * DM + c) = (v4u){o0.x, o0.y, o1.x, o1.y}; } }
                asm volatile("" ::: "memory"); }
        return tag < 2;
    } };

struct DecWout { const char* Mb; const char* W;
    __device__ __forceinline__ void operator()(int L, Unit& u) const { const int pm = L >> 2, pn = L & 3;
        u.A = Mb + (size_t)pm * 256 * (DM * 2); u.B = W + (size_t)pn * 256 * (DM * 2); u.arows = nullptr; u.ldA = DM * 2; u.ldB = DM * 2; u.nt = DM / 64; u.pm = pm; u.pn = pn; u.tag = 0; } };
struct EpiWout { static constexpr bool PERM = true; const float* baseL; const float* baseC; float* X; const float* mod;
    __device__ __forceinline__ bool operator()(AccRef acc, const Unit& u, int wr, int wc, int fr, int fq) const {
        const int pm = u.pm; const float* base = pm < 64 ? baseL : baseC; const float* g1 = mod + (size_t)(pm < 64 ? (pm >> 3) : 8) * (6 * DM) + 2 * DM;
        const size_t row0 = (size_t)pm * 256 + wr * 64 + fr; const int col0 = u.pn * 256 + wc * 32 + fq * 8;
#pragma unroll
        for (int bj = 0; bj < 2; ++bj) { const int c = col0 + bj * 128; const pg8::f32x4 gv0 = *(const pg8::f32x4*)(g1 + c), gv1 = *(const pg8::f32x4*)(g1 + c + 4);
#pragma unroll
            for (int ai = 0; ai < 2; ++ai)
#pragma unroll
                for (int m = 0; m < 4; ++m) { const size_t off = (row0 + ai * 128 + m * 16) * DM + c;
                    *(pg8::f32x4*)(X + off) = *(const pg8::f32x4*)(base + off) + gv0 * acc[ai][bj][m][0]; *(pg8::f32x4*)(X + off + 4) = *(const pg8::f32x4*)(base + off + 4) + gv1 * acc[ai][bj][m][1]; } }
        return false;
    } };

struct DecGU { const char* H2; const int* IDX; const char* W; int nrt;
    __device__ __forceinline__ void operator()(int L, Unit& u) const { const int per = nrt * 8, e = L / per, q = L - e * per, ct = q & 7, rt = q >> 3;
        u.A = H2; u.arows = IDX + (size_t)e * RPE + rt * 256; u.B = W + ((size_t)e * 2 * DM + ct * 256) * (DM * 2); u.ldA = DM * 2; u.ldB = DM * 2; u.nt = DM / 64; u.pm = rt; u.pn = ct; u.tag = e; } };
struct EpiGU { static constexpr bool PERM = true; bf16* H;
    __device__ __forceinline__ bool operator()(AccRef acc, const Unit& u, int wr, int wc, int fr, int fq) const {
        bf16* dst = H + ((size_t)u.tag * RPE + u.pm * 256 + wr * 64 + fr) * DM + u.pn * 128 + wc * 32 + fq * 8;
#pragma unroll
        for (int ai = 0; ai < 2; ++ai)
#pragma unroll
            for (int m = 0; m < 4; ++m) { v2u o[2];
#pragma unroll
                for (int n = 0; n < 2; ++n) { const pg8::f32x4 a = acc[ai][0][m][n], up = acc[ai][1][m][n];
                    o[n] = pack4((pg8::f32x4){a[0] * sigmoidf_(a[0]) * up[0], a[1] * sigmoidf_(a[1]) * up[1], a[2] * sigmoidf_(a[2]) * up[2], a[3] * sigmoidf_(a[3]) * up[3]}); }
                *(v4u*)(dst + (size_t)(ai * 128 + m * 16) * DM) = (v4u){o[0].x, o[0].y, o[1].x, o[1].y}; }
        return false;
    } };
struct DecDown { const char* H; const char* W; int nrt;
    __device__ __forceinline__ void operator()(int L, Unit& u) const { const int per = nrt * 4, e = L / per, q = L - e * per, ct = q & 3, rt = q >> 2;
        u.A = H + ((size_t)e * RPE + rt * 256) * (DM * 2); u.arows = nullptr; u.B = W + ((size_t)e * DM + ct * 256) * (DM * 2); u.ldA = DM * 2; u.ldB = DM * 2; u.nt = DM / 64; u.pm = rt; u.pn = ct; u.tag = e; } };
struct EpiDown { static constexpr bool PERM = true; bf16* Y; const float* afs;
    __device__ __forceinline__ bool operator()(AccRef acc, const Unit& u, int wr, int wc, int fr, int fq) const {
        const size_t r0 = (size_t)u.tag * RPE + u.pm * 256 + wr * 64 + fr;
#pragma unroll
        for (int ai = 0; ai < 2; ++ai)
#pragma unroll
            for (int m = 0; m < 4; ++m) { const size_t r = r0 + ai * 128 + m * 16; const float a = afs[r];
#pragma unroll
                for (int bj = 0; bj < 2; ++bj) { const v2u o0 = pack4(acc[ai][bj][m][0] * a), o1 = pack4(acc[ai][bj][m][1] * a);
                    *(v4u*)(Y + r * DM + u.pn * 256 + bj * 128 + wc * 32 + fq * 8) = (v4u){o0.x, o0.y, o1.x, o1.y}; } }
        return false;
    } };
struct Frame {
    LAS unsigned char* lds; char* ldsg; volatile LAS unsigned* MISC; gu32* ctl;
    int vcu, G;
    unsigned char* ws; unsigned char* dout; float* out;
};
constexpr int PTRS_OFF = LDSCTL_OFF + 512;
enum { IN_X = 0, IN_C, IN_CTX, IN_CCTX, IN_WADA, IN_BADA, IN_NORM1G, IN_WIN, IN_QNG, IN_KNG, IN_SINK, IN_WBRF, IN_WBRG, IN_WBRW, IN_WOUT, IN_NORM2G, IN_WROUTER, IN_WGATE, IN_WUP, IN_WDOWN, IN_FINALG };
__device__ __forceinline__ const float* inptr(const Frame& F, int k) {
    const unsigned long long v = *(const LAS unsigned long long*)(F.lds + PTRS_OFF + 8 * k);
    const unsigned lo = __builtin_amdgcn_readfirstlane((unsigned)v), hi = __builtin_amdgcn_readfirstlane((unsigned)(v >> 32));
    return (const float*)(((unsigned long long)hi << 32) | lo);
}
#define WSP(T, off) ((T*)(F.ws + (off)))

constexpr int COSTAB_OFF = LDSCTL_OFF + 1024;
static_assert(COSTAB_OFF + 8192 <= LDS_BYTES, "cos table fits");
__device__ __forceinline__ void transpose_item(const float* W, int ldw, int k0, int n0, bf16* WT, int drow0, int dld, int dk0, int lane) {
    const int g = lane >> 3, n4 = (lane & 7) * 4;
    const float* src = W + (size_t)(k0 + 8 * g) * ldw + n0 + n4;
    f32x4 v[8];
#pragma unroll
    for (int i = 0; i < 8; ++i) v[i] = *(const GAS f32x4*)(src + (size_t)i * ldw);
    bf16* dst = WT + (size_t)(drow0 + n4) * dld + dk0 + k0 + 8 * g;
#pragma unroll
    for (int j = 0; j < 4; ++j) { v4u o; o.x = pk2(v[0][j], v[1][j]); o.y = pk2(v[2][j], v[3][j]); o.z = pk2(v[4][j], v[5][j]); o.w = pk2(v[6][j], v[7][j]);
        *(GAS v4u*)(dst + (size_t)j * dld) = o; }
}
__device__ __forceinline__ void transpose_item2(const float* W, int ldw, int k0, int n0, bf16* WT, int drow0, int dld, int lane) {
    const int g = lane >> 3, n4 = (lane & 7) * 4;
    const float* src = W + (size_t)(k0 + 8 * g) * ldw + n0 + n4;
    f32x4 v[2][8];
#pragma unroll
    for (int h = 0; h < 2; ++h)
#pragma unroll
        for (int i = 0; i < 8; ++i) v[h][i] = __builtin_nontemporal_load((const GAS f32x4*)(src + (size_t)(h * 64 + i) * ldw));
    bf16* dst = WT + (size_t)(drow0 + n4) * dld + k0 + 8 * g;
#pragma unroll
    for (int h = 0; h < 2; ++h)
#pragma unroll
        for (int j = 0; j < 4; ++j) { v4u o; o.x = pk2(v[h][0][j], v[h][1][j]); o.y = pk2(v[h][2][j], v[h][3][j]); o.z = pk2(v[h][4][j], v[h][5][j]); o.w = pk2(v[h][6][j], v[h][7][j]);
            __builtin_nontemporal_store(o, (GAS v4u*)(dst + (size_t)j * dld + h * 64)); }
}
__device__ __forceinline__ void fold_item(const float* W, int k0, int g, int sinmode, bf16* WT, int drow0, LAS float* scr, const LAS float* ctab, int lane) {
#pragma unroll
    for (int kk = 0; kk < 16; ++kk) scr[lane * 20 + kk] = W[(size_t)(k0 + kk) * INW + g * 64 + lane];
    LDS_WAIT(); asm volatile("" ::: "memory");
    float acc[16];
#pragma unroll
    for (int k = 0; k < 16; ++k) acc[k] = 0.f;
#pragma unroll 4
    for (int c = 0; c < 64; ++c) {
        const int r = (c * lane) & 63;
        const float tv = sinmode ? -ctab[((r - 16) & 63) * 32] : ctab[r * 32];
#pragma unroll
        for (int k4 = 0; k4 < 4; ++k4) { const f32x4 w = *(const LAS f32x4*)(scr + c * 20 + 4 * k4);
            acc[4 * k4] = fmaf(w[0], tv, acc[4 * k4]); acc[4 * k4 + 1] = fmaf(w[1], tv, acc[4 * k4 + 1]); acc[4 * k4 + 2] = fmaf(w[2], tv, acc[4 * k4 + 2]); acc[4 * k4 + 3] = fmaf(w[3], tv, acc[4 * k4 + 3]); }
    }
    GAS v4u* dst = (GAS v4u*)(WT + (size_t)(drow0 + lane) * DM + k0);
#pragma unroll
    for (int q = 0; q < 2; ++q) { v4u o; o.x = pk2(acc[8 * q], acc[8 * q + 1]); o.y = pk2(acc[8 * q + 2], acc[8 * q + 3]); o.z = pk2(acc[8 * q + 4], acc[8 * q + 5]); o.w = pk2(acc[8 * q + 6], acc[8 * q + 7]); dst[q] = o; }
    LDS_WAIT(); asm volatile("" ::: "memory");
}

#ifndef CONV_IN_ATTN
#define CONV_IN_ATTN 0
#endif
constexpr int CONV_WAVE_ITEMS = DEPTH * NE * 768, CONV_ITEMS = CONV_WAVE_ITEMS / NWAVES, CONV_ITEMS_L0 = CONV_ITEMS / DEPTH;
__device__ __forceinline__ void conv_wave_item(Frame& F, int r, int lane) {
    const int le = r / 768, q = r % 768, which = q / 256, qq = q % 256, kb = qq >> 5, nb = qq & 31, f0 = nb * 32;
    if (which < 2) transpose_item2((which ? inptr(F, IN_WUP) : inptr(F, IN_WGATE)) + (size_t)le * DM * DM, DM, kb * 128, f0, WSP(bf16, WS_WGU) + (size_t)le * 2 * DM * DM, (f0 >> 7) * 256 + which * 128 + (f0 & 127), DM, lane);
    else transpose_item2(inptr(F, IN_WDOWN) + (size_t)le * DM * DM, DM, kb * 128, f0, WSP(bf16, WS_WD) + (size_t)le * DM * DM, f0, DM, lane);
}
__device__ __forceinline__ void tail_convert(Frame& F, int idx, int first, int per, int end) {
    int tid_ = threadIdx.x; asm volatile("" : "+v"(tid_));
    const int lane = tid_ & 63, wave_ = __builtin_amdgcn_readfirstlane(tid_ >> 6);
    for (int t = 0; t < per; ++t) { const int it = first + idx * per + t; if (it >= end) break; conv_wave_item(F, it * NWAVES + wave_, lane); }
}

__device__ __forceinline__ void p0_prologue(Frame& F, int mode = 0) {
    int tid_ = threadIdx.x; asm volatile("" : "+v"(tid_));
    const int lane = tid_ & 63, wave_ = __builtin_amdgcn_readfirstlane(tid_ >> 6);
    const int gw = F.vcu * NWAVES + wave_, NGW = F.G * NWAVES;
    LAS float* st = (LAS float*)F.lds;
    LAS float* red = (LAS float*)(F.lds + 40960);
    LAS float* ctab = (LAS float*)(F.lds + COSTAB_OFF);
    { const float* cp = inptr(F, IN_C); const float* ccp = inptr(F, IN_CCTX);
#pragma unroll 6
      for (int i = tid_; i < 9 * DM; i += NWAVES * 64) { const int s = i / DM, k = i - s * DM; const float v = s < 8 ? cp[s * DM + k] : ccp[k]; st[i] = v / (1.f + expf(-v)); } }
    for (int i = tid_; i < 2048; i += NWAVES * 64) ctab[i] = cosf(6.283185307179586f * (float)i * (1.f / 2048.f));
    __syncthreads();
    const float* bada = inptr(F, IN_BADA);
    if (mode != 2) for (int it = F.vcu; it < DEPTH * 96; it += F.G) {
        const int l = it / 96, j = (it % 96) * 64 + lane, kb = wave_ * 128;
        const float* W = inptr(F, IN_WADA) + (size_t)l * DM * 6 * DM + (size_t)kb * 6 * DM + j;
        float acc[9];
#pragma unroll
        for (int s = 0; s < 9; ++s) acc[s] = 0.f;
        for (int k0 = 0; k0 < 128; k0 += 16) {
            float w[16];
#pragma unroll
            for (int i = 0; i < 16; ++i) w[i] = W[(size_t)(k0 + i) * 6 * DM];
#pragma unroll
            for (int i = 0; i < 16; ++i)
#pragma unroll
                for (int s = 0; s < 9; ++s) acc[s] = fmaf(st[s * DM + kb + k0 + i], w[i], acc[s]);
        }
#pragma unroll
        for (int s = 0; s < 9; ++s) red[(wave_ * 9 + s) * 64 + lane] = acc[s];
        __syncthreads();
        for (int o = tid_; o < 9 * 64; o += NWAVES * 64) { float v = 0.f;
#pragma unroll
            for (int w = 0; w < 8; ++w) v += red[w * 576 + o];
            const int s = o >> 6, jj = (it % 96) * 64 + (o & 63);
            WSP(float, WS_MOD)[((size_t)l * 9 + s) * 6 * DM + jj] = v + bada[l * 6 * DM + jj]; }
        __syncthreads();
    }
    __syncthreads();
#ifdef DBG_POISON
    {
        const size_t n16 = (WS_END - WS_X) / 16, m16 = ((size_t)NLAT * DM * 4) / 16; const v4u pz = {0xFFFFFFFFu, 0xFFFFFFFFu, 0xFFFFFFFFu, 0xFFFFFFFFu};
        for (size_t i = (size_t)gw * 64 + lane; i < n16; i += (size_t)NGW * 64) ((GAS v4u*)(F.ws + WS_X))[i] = pz;
        for (size_t i = (size_t)gw * 64 + lane; i < m16; i += (size_t)NGW * 64) ((GAS v4u*)F.dout)[i] = pz;
    }
#endif
    LAS float* scr = (LAS float*)(F.lds + wave_ * 16384);
    constexpr int T_A = DEPTH * 2176, T_B = DEPTH * 512, T_C = DEPTH * 512, T_D = DEPTH * 512, T_E = DEPTH * NE * 768, T_F = SEQ + CTX, T_G = 1;
    constexpr int NITEMS = T_A + T_B + T_C + T_D + T_E + T_F + T_G;
    if (mode != 1 && mode != 5 && mode != 6) for (int it = gw; it < NITEMS; it += NGW) {
        int r = it;
        if (r < T_A) { const int l = r / 2176, q = r % 2176, kb = q / 136, nb = q % 136, s0 = 256 + nb * 32;
            int drow; if (s0 < 1536) { const int tile = 2 + ((s0 - 256) >> 8), hh = ((s0 - 256) & 255) >> 6, dh = (s0 & 63) >> 5; drow = tile * 256 + dh * 128 + hh * 32; } else drow = s0 + 256;
            transpose_item(inptr(F, IN_WIN) + (size_t)l * DM * INW, INW, kb * 64, s0, WSP(bf16, WS_WIN) + (size_t)l * INW2 * DM, drow, DM, 0, lane); continue; } r -= T_A;
        if (r < T_B) { const int l = r / 512, q = r % 512, kq = q & 3, kb = (q >> 2) >> 3, g = ((q >> 2) >> 1) & 3, sm = (q >> 2) & 1;
            fold_item(inptr(F, IN_WIN) + (size_t)l * DM * INW, kb * 64 + kq * 16, g, sm, WSP(bf16, WS_WIN) + (size_t)l * INW2 * DM, sm * 256 + g * 64, scr, ctab, lane); continue; } r -= T_B;
        if (r < T_C) { const int l = r / 512, q = r % 512; const float* W; int kb, koff;
            if (q < 128) { W = inptr(F, IN_WBRF) + (size_t)l * 256 * DM; kb = q >> 5; koff = 0; } else if (q < 384) { W = inptr(F, IN_WBRG) + (size_t)l * 512 * DM; kb = (q - 128) >> 5; koff = 256; } else { W = inptr(F, IN_WBRW) + (size_t)l * 256 * DM; kb = (q - 384) >> 5; koff = 768; }
            const int nb = q & 31;
            transpose_item(W, DM, kb * 64, nb * 32, WSP(bf16, WS_WBR) + (size_t)l * DM * DM, nb * 32, DM, koff, lane); continue; } r -= T_C;
        if (r < T_D) { const int l = r / 512, q = r % 512, kb = q >> 5, nb = q & 31;
            transpose_item(inptr(F, IN_WOUT) + (size_t)l * DM * DM, DM, kb * 64, nb * 32, WSP(bf16, WS_WOUT) + (size_t)l * DM * DM, nb * 32, DM, 0, lane); continue; } r -= T_D;
        if (r < T_E) { if (F.G != 256) conv_wave_item(F, r, lane); continue; } r -= T_E;
        if (r < T_F) {
            const bool big = r < SEQ; const int N = big ? SEQ : CTX, k = big ? r : r - SEQ, sh = big ? 0 : 3; const float sc = 1.f / sqrtf(64.f * (float)N);
            bf16* row = (big ? WSP(bf16, WS_DFT) : WSP(bf16, WS_DFTC)) + (size_t)k * 2 * N;
            for (int n = 2 * lane; n < N; n += 128) {
                const int r0 = (k * n) & (N - 1), r1 = (k * (n + 1)) & (N - 1);
                *(GAS unsigned*)(row + n) = pk2(ctab[r0 << sh] * sc, ctab[r1 << sh] * sc);
                *(GAS unsigned*)(row + N + n) = pk2(ctab[((r0 - (N >> 2)) & (N - 1)) << sh] * sc, ctab[((r1 - (N >> 2)) & (N - 1)) << sh] * sc); }
            continue; } r -= T_F;
        {
            for (int i = lane; i < 64 * 16; i += 64) { const int pos = i >> 4, f = i & 15; const float inv = powf(10000.f, -(float)(2 * f) / 32.f), ang = (float)pos * inv;
                WSP(float, WS_ROPE)[2 * i] = cosf(ang); WSP(float, WS_ROPE)[2 * i + 1] = sinf(ang); }
        }
    }
}

__device__ __forceinline__ void norm_row(f32x4 (&v)[4], const float* gain, const float* shift, const float* scale, int lane) {
    float ss = 0.f;
#pragma unroll
    for (int j = 0; j < 4; ++j) ss += (v[j][0] * v[j][0] + v[j][1] * v[j][1]) + (v[j][2] * v[j][2] + v[j][3] * v[j][3]);
    const float r = rsqrtf(wave_sum(ss) * (1.f / DM) + EPS);
#pragma unroll
    for (int j = 0; j < 4; ++j) { const f32x4 g = *(const f32x4*)(gain + 4 * lane + 256 * j); f32x4 y = v[j] * r * g;
        if (shift) { const f32x4 sh = *(const f32x4*)(shift + 4 * lane + 256 * j), sc = *(const f32x4*)(scale + 4 * lane + 256 * j); y = y * (sc + 1.f) + sh; }
        v[j] = y; }
}
__device__ __forceinline__ void store_row_bf16(bf16* orow, const f32x4 (&v)[4], int lane) {
    GAS v2u* o8 = (GAS v2u*)orow + lane;
#pragma unroll
    for (int j = 0; j < 4; ++j) { v2u w; w.x = pg8::cvt_pk_bf16(v[j][0], v[j][1]); w.y = pg8::cvt_pk_bf16(v[j][2], v[j][3]); o8[64 * j] = w; }
}
__device__ __forceinline__ int row_modset(int r) { return r < NLAT ? (r >> 11) : 8; }
struct ModVec { f32x4 g[4], sh[4], sc[4]; };
__device__ __forceinline__ void load_modvec(ModVec& m, const float* gain, const float* shift, const float* scale, int lane) {
#pragma unroll
    for (int j = 0; j < 4; ++j) { m.g[j] = *(const f32x4*)(gain + 4 * lane + 256 * j);
        if (shift) { m.sh[j] = *(const f32x4*)(shift + 4 * lane + 256 * j); m.sc[j] = *(const f32x4*)(scale + 4 * lane + 256 * j); } else { m.sh[j] = (f32x4){0.f, 0.f, 0.f, 0.f}; m.sc[j] = (f32x4){0.f, 0.f, 0.f, 0.f}; } }
}
__device__ __forceinline__ void norm_row_m(f32x4 (&v)[4], const ModVec& m) {
    float ss = 0.f;
#pragma unroll
    for (int j = 0; j < 4; ++j) ss += (v[j][0] * v[j][0] + v[j][1] * v[j][1]) + (v[j][2] * v[j][2] + v[j][3] * v[j][3]);
    const float r = rsqrtf(wave_sum(ss) * (1.f / DM) + EPS);
#pragma unroll
    for (int j = 0; j < 4; ++j) v[j] = (v[j] * r * m.g[j]) * (m.sc[j] + 1.f) + m.sh[j];
}
__device__ __forceinline__ void load_row_f32(f32x4 (&v)[4], const float* row, int lane) {
#pragma unroll
    for (int j = 0; j < 4; ++j) v[j] = *(const f32x4*)(row + 4 * lane + 256 * j);
}

__device__ __forceinline__ void p1_norm1(Frame& F) {
    int tid_ = threadIdx.x; asm volatile("" : "+v"(tid_));
    const int lane = tid_ & 63, wave_ = __builtin_amdgcn_readfirstlane(tid_ >> 6);
    const int gw = F.vcu * NWAVES + wave_, NGW = F.G * NWAVES, rpw = (NTOK + NGW - 1) / NGW, r0 = gw * rpw, r1 = r0 + rpw < NTOK ? r0 + rpw : NTOK;
    const float* xin = inptr(F, IN_X); const float* cin = inptr(F, IN_CTX) - (size_t)NLAT * DM; const float* g1 = inptr(F, IN_NORM1G);
#define P1_ROW(r) (((r) < NLAT ? xin : cin) + (size_t)(r) * DM)
    f32x4 va[4], vb[4]; ModVec m; int cset = -1;
    if (r0 < r1) load_row_f32(va, P1_ROW(r0), lane);
    if (r0 + 1 < r1) load_row_f32(vb, P1_ROW(r0 + 1), lane);
    for (int r = r0; r < r1; ++r) {
        f32x4 v[4];
#pragma unroll
        for (int j = 0; j < 4; ++j) { v[j] = va[j]; va[j] = vb[j]; }
        if (r + 2 < r1) load_row_f32(vb, P1_ROW(r + 2), lane);
        const int set = row_modset(r);
        if (set != cset) { const float* mod = WSP(float, WS_MOD) + (size_t)set * 6 * DM; load_modvec(m, g1, mod, mod + DM, lane); cset = set; }
        norm_row_m(v, m);
        store_row_bf16(WSP(bf16, WS_HN) + (size_t)r * DM, v, lane);
    }
#undef P1_ROW
}
__device__ __forceinline__ void router_finish(const float (&a16)[NE], int r, int lane, float* AFF) {
    float b8[8], b4[4], b2[2], lg;
    { const bool hi = lane & 32;
#pragma unroll
      for (int i = 0; i < 8; ++i) { const float keep = hi ? a16[i + 8] : a16[i], send = hi ? a16[i] : a16[i + 8]; b8[i] = keep + lx32(send); } }
    { const bool hi = lane & 16;
#pragma unroll
      for (int i = 0; i < 4; ++i) { const float keep = hi ? b8[i + 4] : b8[i], send = hi ? b8[i] : b8[i + 4]; b4[i] = keep + lx16(send); } }
    { const bool hi = lane & 8;
#pragma unroll
      for (int i = 0; i < 2; ++i) { const float keep = hi ? b4[i + 2] : b4[i], send = hi ? b4[i] : b4[i + 2]; b2[i] = keep + lx8(send); } }
    { const bool hi = lane & 4; const float keep = hi ? b2[1] : b2[0], send = hi ? b2[0] : b2[1]; lg = keep + lx4(send); }
    lg += lx2(lg); lg += lx1(lg);
    float mx = lg;
    mx = fmaxf(mx, lx4(mx)); mx = fmaxf(mx, lx8(mx)); mx = fmaxf(mx, lx16(mx)); mx = fmaxf(mx, lx32(mx));
    const float ex = expf(lg - mx); float sum = ex;
    sum += lx4(sum); sum += lx8(sum); sum += lx16(sum); sum += lx32(sum);
    const int set = r < NLAT ? (r >> 11) : 8 + ((r - NLAT) >> 8), n = r < NLAT ? (r & (SEQ - 1)) : ((r - NLAT) & (CTX - 1));
    if ((lane & 3) == 0) AFF[((size_t)set * NE + ((lane >> 2) & 15)) * SEQ + n] = ex / sum;
}
__device__ __forceinline__ void pf_norm2_router(Frame& F, int l, int mode = 0) {
    int tid_ = threadIdx.x; asm volatile("" : "+v"(tid_));
    const int lane = tid_ & 63, wave_ = __builtin_amdgcn_readfirstlane(tid_ >> 6);
    const int gw = F.vcu * NWAVES + wave_, NGW = F.G * NWAVES;
    LAS float* wrT = (LAS float*)F.lds;
    { const float* wr = inptr(F, IN_WROUTER) + (size_t)l * DM * NE;
#pragma unroll 8
      for (int i = tid_; i < DM * NE; i += NWAVES * 64) { const int k = i >> 4, e = i & 15; wrT[e * DM + k] = wr[i]; } }
    __syncthreads();
    const int nrows = (l == DEPTH - 1) ? NLAT : NTOK, rpw = (nrows + NGW - 1) / NGW, r0 = gw * rpw, r1 = r0 + rpw < nrows ? r0 + rpw : nrows;
    const float* X = WSP(float, WS_X); const float* g2n = inptr(F, IN_NORM2G) + l * DM; float* AFF = WSP(float, WS_AFF);
    f32x4 va[4], vb[4]; ModVec m; int cset = -1;
    if (r0 < r1) load_row_f32(va, X + (size_t)r0 * DM, lane);
    if (r0 + 1 < r1) load_row_f32(vb, X + (size_t)(r0 + 1) * DM, lane);
    for (int r = r0; r < r1; ++r) {
        f32x4 v[4];
#pragma unroll
        for (int j = 0; j < 4; ++j) { v[j] = va[j]; va[j] = vb[j]; }
        if (r + 2 < r1) load_row_f32(vb, X + (size_t)(r + 2) * DM, lane);
        const int mset = row_modset(r);
        if (mset != cset) { const float* mod = WSP(float, WS_MOD) + ((size_t)l * 9 + mset) * 6 * DM; load_modvec(m, g2n, mod + 3 * DM, mod + 4 * DM, lane); cset = mset; }
        norm_row_m(v, m);
        if (mode < 2) store_row_bf16(WSP(bf16, WS_HN) + (size_t)r * DM, v, lane);
        if (mode >= 1) { asm volatile("" :: "v"(v[0]), "v"(v[1]), "v"(v[2]), "v"(v[3])); continue; }
        float a16[NE];
#pragma unroll
        for (int e = 0; e < NE; ++e) { float a = 0.f;
#pragma unroll
            for (int j = 0; j < 4; ++j) { const f32x4 w = *(const LAS f32x4*)(wrT + e * DM + 4 * lane + 256 * j); a = fmaf(v[j][0], w[0], a); a = fmaf(v[j][1], w[1], a); a = fmaf(v[j][2], w[2], a); a = fmaf(v[j][3], w[3], a); }
            a16[e] = a; if ((e & 3) == 3) asm volatile("" ::: "memory"); }
        router_finish(a16, r, lane, AFF);
    }
    __syncthreads();
}
__device__ __forceinline__ void pg_topk_gather(Frame& F, int l) {
    int tid_ = threadIdx.x; asm volatile("" : "+v"(tid_));
    const int lane = tid_ & 63, wave_ = __builtin_amdgcn_readfirstlane(tid_ >> 6);
    LAS unsigned* cnt = (LAS unsigned*)F.lds;
    LAS int* sidx = (LAS int*)(F.lds + 1024);
    const int nitems = (l == DEPTH - 1) ? 8 * NE : 16 * NE;
    const int tid = tid_, wave = wave_;
    const unsigned long long lt = (1ull << lane) - 1ull;
    for (int it = F.vcu; it < nitems; it += F.G) {
        const int set = it >> 4, e = it & 15; const bool latent = set < 8; const int N = latent ? SEQ : CTX, cap = latent ? CAPL : CAPC;
        const int rowbase = latent ? set * SEQ : NLAT + (set - 8) * CTX, xbase = latent ? set * CAPL : 8 * CAPL + (set - 8) * CAPC;
        const float* a = WSP(float, WS_AFF) + ((size_t)set * NE + e) * SEQ;
        unsigned key[4];
#pragma unroll
        for (int q = 0; q < 4; ++q) { const int i = q * 512 + tid; key[q] = i < N ? __builtin_bit_cast(unsigned, a[i]) : 0u; }
        unsigned T = 0u;
        for (int bit = 30; bit >= 0; --bit) {
            const unsigned cand = T | (1u << bit); unsigned c = 0;
#pragma unroll
            for (int q = 0; q < 4; ++q) c += (unsigned)__builtin_popcountll(__ballot(key[q] >= cand));
            LAS unsigned* cb = cnt + (bit & 1) * 8;
            if (lane == 0) cb[wave] = c;
            __syncthreads();
            unsigned tot = 0;
#pragma unroll
            for (int w = 0; w < 8; ++w) tot += cb[w];
            if (tot >= (unsigned)cap) T = cand;
        }
        LAS unsigned* cg = cnt + 64; LAS unsigned* ce = cnt + 96;
        unsigned long long bg[4], be[4];
#pragma unroll
        for (int q = 0; q < 4; ++q) { bg[q] = __ballot(key[q] > T); be[q] = __ballot(key[q] == T && key[q] != 0u);
            if (lane == 0) { cg[q * 8 + wave] = (unsigned)__builtin_popcountll(bg[q]); ce[q * 8 + wave] = (unsigned)__builtin_popcountll(be[q]); } }
        __syncthreads();
        unsigned ngt = 0;
        for (int c2 = 0; c2 < 32; ++c2) ngt += cg[c2];
        const unsigned need = (unsigned)cap - ngt;
        unsigned pre_g[4], pre_e[4];
        { unsigned rg = 0, re = 0;
#pragma unroll
          for (int q = 0; q < 4; ++q) { for (int w = 0; w < 8; ++w) { if (w == wave) { pre_g[q] = rg; pre_e[q] = re; } rg += cg[q * 8 + w]; re += ce[q * 8 + w]; } } }
        int* SEL = WSP(int, WS_SEL);
#pragma unroll
        for (int q = 0; q < 4; ++q) { const int i = q * 512 + tid;
            if (i < N) {
                const unsigned eb = pre_e[q] + (unsigned)__builtin_popcountll(be[q] & lt);
                const unsigned gb = pre_g[q] + (unsigned)__builtin_popcountll(bg[q] & lt);
                const bool isg = key[q] > T, ise = key[q] == T;
                const bool sel = isg || (ise && eb < need);
                const unsigned slot = gb + (eb < need ? eb : need);
                SEL[(size_t)(rowbase + i) * NE + e] = sel ? xbase + (int)slot : -1;
                if (sel) { WSP(float, WS_AFS)[(size_t)e * RPE + xbase + slot] = __builtin_bit_cast(float, key[q]); WSP(int, WS_IDX)[(size_t)e * RPE + xbase + slot] = rowbase + i; }
            } }
        __syncthreads();
    }
}
__device__ __forceinline__ void pj_combine(Frame& F, int l, int probe = 0) {
    int tid_ = threadIdx.x; asm volatile("" : "+v"(tid_));
    const int lane = tid_ & 63, wave_ = __builtin_amdgcn_readfirstlane(tid_ >> 6);
    const int gw = F.vcu * NWAVES + wave_, NGW = F.G * NWAVES; const bool last = l == DEPTH - 1;
    const int nrows = last ? NLAT : NTOK, rpw = (nrows + NGW - 1) / NGW, r0 = gw * rpw, r1 = r0 + rpw < nrows ? r0 + rpw : nrows;
    float* X = WSP(float, WS_X); const int* SEL = WSP(int, WS_SEL);
    const float* gnext = last ? inptr(F, IN_FINALG) : inptr(F, IN_NORM1G) + (l + 1) * DM;
    f32x4 va[4], vb[4], g2[4]; int sa = -1, sb = -1; ModVec m; int cset = -1;
    if (r0 < r1) { load_row_f32(va, X + (size_t)r0 * DM, lane); sa = lane < NE ? SEL[(size_t)r0 * NE + lane] : -1; }
    if (r0 + 1 < r1) { load_row_f32(vb, X + (size_t)(r0 + 1) * DM, lane); sb = lane < NE ? SEL[(size_t)(r0 + 1) * NE + lane] : -1; }
    for (int r = r0; r < r1; ++r) {
        f32x4 v[4], t[4];
#pragma unroll
        for (int j = 0; j < 4; ++j) { v[j] = va[j]; va[j] = vb[j]; t[j] = (f32x4){0.f, 0.f, 0.f, 0.f}; }
        const int selv = sa; sa = sb;
        if (r + 2 < r1) { load_row_f32(vb, X + (size_t)(r + 2) * DM, lane); sb = lane < NE ? SEL[(size_t)(r + 2) * NE + lane] : -1; }
        const int mset = row_modset(r);
        if (mset != cset) { const float* mod = WSP(float, WS_MOD) + ((size_t)l * 9 + mset) * 6 * DM; const float* mod1 = WSP(float, WS_MOD) + ((size_t)(last ? l : l + 1) * 9 + mset) * 6 * DM;
#pragma unroll
            for (int j = 0; j < 4; ++j) g2[j] = *(const f32x4*)(mod + 5 * DM + 4 * lane + 256 * j);
            load_modvec(m, gnext, last ? nullptr : mod1, last ? nullptr : mod1 + DM, lane); cset = mset; }
        for (int e = 0; e < NE; ++e) { const int se = __builtin_amdgcn_readlane(selv, e);
            if (se >= 0) { const GAS v2u* y = (const GAS v2u*)(WSP(bf16, WS_G) + ((size_t)e * RPE + se) * DM) + lane;
#pragma unroll
                for (int j = 0; j < 4; ++j) { const v2u w = y[64 * j]; t[j] += (f32x4){bflo(w.x), bfhi(w.x), bflo(w.y), bfhi(w.y)}; } } }
#pragma unroll
        for (int j = 0; j < 4; ++j) v[j] = v[j] + g2[j] * t[j];
        if (probe) { norm_row_m(v, m); asm volatile("" :: "v"(v[0]), "v"(v[1]), "v"(v[2]), "v"(v[3])); continue; }
        if (!last) {
#pragma unroll
            for (int j = 0; j < 4; ++j) *(f32x4*)(X + (size_t)r * DM + 4 * lane + 256 * j) = v[j];
            norm_row_m(v, m);
            store_row_bf16(WSP(bf16, WS_HN) + (size_t)r * DM, v, lane);
        } else {
            norm_row_m(v, m);
#pragma unroll
            for (int j = 0; j < 4; ++j) *(f32x4*)(F.out + (size_t)r * DM + 4 * lane + 256 * j) = v[j];
        }
    }
}

__device__ __forceinline__ void pc_mixers(Frame& F, int l, int rep) {
    int tid_ = threadIdx.x; asm volatile("" : "+v"(tid_));
    const int lane = tid_ & 63, wave_ = __builtin_amdgcn_readfirstlane(tid_ >> 6);
    const bool need_ctx = l < DEPTH - 1;
    {
        Strided<DecDft> S; S.d.Dm = (const char*)(F.ws + WS_DFT); S.d.Dc = (const char*)(F.ws + WS_DFTC); S.d.ABt = (const char*)(F.ws + WS_ABT); S.d.ABtc = (const char*)(F.ws + WS_ABTC);
        S.n = need_ctx ? 72 : 64; S.G = F.G; S.vcu = F.vcu;
        EpiStore E{WSP(bf16, WS_BR), DM};
        pg8::gemm_phase<EpiStore, Strided<DecDft>>(F.lds, (LAS int*)(F.lds + IDXBUF_OFF), S, E);
    }
    typedef attn_body::bf16 abf;
    const abf* Qg = (const abf*)(F.ws + WS_QKV + QKV_QG); const abf* Kg = (const abf*)(F.ws + WS_QKV + QKV_KG); const abf* Vg = (const abf*)(F.ws + WS_QKV + QKV_VG);
    const abf* Qw = (const abf*)(F.ws + WS_QKV + QKV_QW); const abf* Kw = (const abf*)(F.ws + WS_QKV + QKV_KW); const abf* Vw = (const abf*)(F.ws + WS_QKV + QKV_VW);
    abf* BR = (abf*)(F.ws + WS_BR);
    const int nGL = NBATCH * 2 * 32, nWL = NBATCH * 2 * 16, nGC = need_ctx ? NBATCH * 2 * 4 : 0, nWC = need_ctx ? NBATCH * 2 * 2 : 0, nattn = nGL + nWL + nGC + nWC;
    const int nconv = (CONV_IN_ATTN && F.G == 256 && rep == 0) ? CONV_ITEMS_L0 : 0, ntot = nattn + nconv;
    gu32* head = F.ctl + CW_QUEUE + 64 * (l + 2 * rep);
    const int wid = wave_;
    for (;;) {
        if (tid_ == 0) F.MISC[0] = __hip_atomic_fetch_add(head, 1u, RLX_AGENT);
        __syncthreads();
        const int q = (int)F.MISC[0];
        if (q >= ntot) break;
        const int c0 = (int)(((long long)q * nconv) / ntot), c1 = (int)(((long long)(q + 1) * nconv) / ntot);
        if (c1 > c0) { conv_wave_item(F, (l * CONV_ITEMS_L0 + c0) * NWAVES + wave_, lane); __syncthreads(); continue; }
        const int a = q - c0;
        if (a < nGL) {
            const int b = a >> 6, hkv = (a >> 5) & 1, qb = a & 31, head_ = hkv * 4 + (wid >> 1), q0 = qb * 64 + (wid & 1) * 32; const size_t qrow = (size_t)b * SEQ + q0;
            attn_body::attn_unit<0, 8>(Qg + qrow * 512 + head_ * 64, 512, Kg + (size_t)(NLAT + b * CTX) * 128 + hkv * 64, Kg + (size_t)b * SEQ * 128 + hkv * 64,
                                        Vg + (size_t)(NLAT + b * CTX) * 128 + hkv * 64, Vg + (size_t)b * SEQ * 128 + hkv * 64, 128, 4 + SEQ / 64, 0, 0, 0.f, BR + qrow * DM + 256 + head_ * 64, DM, F.ldsg);
        } else if (a < nGL + nWL) {
            const int u = a - nGL, b = u >> 5, hkv = (u >> 4) & 1, qb = u & 15, head_ = hkv * 2 + (wid >> 2), q0 = qb * 128 + (wid & 3) * 32; const size_t qrow = (size_t)b * SEQ + q0;
            const int band0 = qb * 128 - 128 < 0 ? 0 : qb * 128 - 128, band1 = qb * 128 + 256 > SEQ ? SEQ : qb * 128 + 256;
            attn_body::attn_unit<1, 8>(Qw + qrow * 256 + head_ * 64, 256, Kw + (size_t)(NLAT + b * CTX) * 128 + hkv * 64, Kw + ((size_t)b * SEQ + band0) * 128 + hkv * 64,
                                        Vw + (size_t)(NLAT + b * CTX) * 128 + hkv * 64, Vw + ((size_t)b * SEQ + band0) * 128 + hkv * 64, 128, 4 + (band1 - band0) / 64, q0, band0,
                                        inptr(F, IN_SINK)[l * 4 + head_] * LOG2E, BR + qrow * DM + 768 + head_ * 64, DM, F.ldsg);
        } else if (a < nGL + nWL + nGC) {
            const int u = a - nGL - nWL, b = u >> 3, hkv = (u >> 2) & 1, qb = u & 3, head_ = hkv * 4 + (wid >> 1); const size_t qrow = (size_t)NLAT + b * CTX + qb * 64 + (wid & 1) * 32;
            const abf* Kc = Kg + (size_t)(NLAT + b * CTX) * 128 + hkv * 64; const abf* Vc = Vg + (size_t)(NLAT + b * CTX) * 128 + hkv * 64;
            attn_body::attn_unit<0, 8>(Qg + qrow * 512 + head_ * 64, 512, Kc, Kc, Vc, Vc, 128, 4, 0, 0, 0.f, BR + qrow * DM + 256 + head_ * 64, DM, F.ldsg);
        } else {
            const int u = a - nGL - nWL - nGC, b = u >> 2, hkv = (u >> 1) & 1, qb = u & 1, head_ = hkv * 2 + (wid >> 2); const size_t qrow = (size_t)NLAT + b * CTX + qb * 128 + (wid & 3) * 32;
            const abf* Kc = Kw + (size_t)(NLAT + b * CTX) * 128 + hkv * 64; const abf* Vc = Vw + (size_t)(NLAT + b * CTX) * 128 + hkv * 64;
            attn_body::attn_unit<1, 8>(Qw + qrow * 256 + head_ * 64, 256, Kc, Kc, Vc, Vc, 128, 4, 0, 0, inptr(F, IN_SINK)[l * 4 + head_] * LOG2E, BR + qrow * DM + 768 + head_ * 64, DM, F.ldsg);
        }
    }
    __syncthreads();
}
#ifndef MK_N_LAUNCHES
#define MK_N_LAUNCHES 1
#endif
constexpr int N_PHASES = 2 + 9 * DEPTH;
struct Args { const float* in[21]; float* out; unsigned char* ws; int ph_lo, ph_hi, probe, pad_; };

__global__ void __launch_bounds__(NWAVES * 64, 2) hybrid_fwd(Args args) {
    extern __shared__ __attribute__((aligned(16))) unsigned char lds[];
    Frame F;
    F.lds = (LAS unsigned char*)lds; F.ldsg = (char*)lds; F.MISC = (volatile LAS unsigned*)(F.lds + MISC_OFF);
    F.G = gridDim.x; { const int bx = blockIdx.x; F.vcu = (F.G % 8 == 0) ? (bx % 8) * (F.G / 8) + bx / 8 : bx; }
    F.ws = args.ws; F.out = args.out; F.dout = (unsigned char*)args.out; F.ctl = (gu32*)(args.ws + WS_CTL);
#ifdef DBG_LDSPOISON
    for (int u = threadIdx.x; u < LDSCTL_OFF / 4; u += NWAVES * 64) ((LAS unsigned*)F.lds)[u] = 0xFFFFFFFFu;
#endif
    for (int u = threadIdx.x; u < (LDS_BYTES - LDSCTL_OFF) / 4; u += NWAVES * 64) ((LAS unsigned*)(F.lds + LDSCTL_OFF))[u] = 0u;
    __syncthreads();
    if (threadIdx.x < 21) *(LAS unsigned long long*)(F.lds + PTRS_OFF + 8 * threadIdx.x) = (unsigned long long)args.in[threadIdx.x];
    __syncthreads();
    XcdBarrier bar; bar.bar = (unsigned*)(F.ctl + CW_BAR); bar.x = 0; bar.st = nullptr;
    const int lo = args.ph_lo, hi = args.ph_hi;
    if (hi - lo > 1) bar = xcd_barrier_post((unsigned*)(F.ctl + CW_BAR), F.MISC + 8);
#ifndef PHSEL
#define PHSEL 0x7ff
#endif
#define IN(k) (lo <= (k) && (k) < hi)
#define KIND(j) ((PHSEL >> (j)) & 1)
#ifndef DBG_PROBE
#define DBG_PROBE 0
#endif
#ifndef FPROBE_MODE
#define FPROBE_MODE 0
#endif
#ifndef REP_MASK
#define REP_MASK 0
#endif
#define NREP(j, ok) ((((REP_MASK) >> (j)) & 1) && (ok) ? 2 : 1)
#define REPEAT(j, ok) for (int rep_ = 0, nrep_ = NREP(j, ok); rep_ < nrep_; ++rep_, (rep_ < nrep_ ? xcd_barrier(bar) : (void)0))
#define SEAM(k) do { if (IN(k) && IN((k) + 1)) xcd_barrier(bar); } while (0)

#ifdef BAR_PROBE
    if (hi - lo > 1) for (int i_ = 0; i_ < BAR_PROBE; ++i_) xcd_barrier(bar);
#endif
    if (KIND(0) && IN(0)) REPEAT(0, true) { p0_prologue(F, rep_ ? DBG_PROBE : 0); } SEAM(0);
    if (KIND(1) && IN(1)) REPEAT(1, true) { p1_norm1(F); } SEAM(1);
    for (int l = 0; l < DEPTH; ++l) {
        const int pb = 2 + 9 * l; const bool lastl = l == DEPTH - 1;
        const int nrt = lastl ? 64 : 72;
        if (KIND(2) && IN(pb + 0)) REPEAT(2, true) {
            Strided<DecInProj> S; S.d.A = (const char*)(F.ws + WS_HN); S.d.B = (const char*)(F.ws + WS_WIN) + (size_t)l * INW2 * DM * 2; S.d.layer = l; S.n = inproj_units(l); S.G = F.G; S.vcu = F.vcu;
            EpiInProj E; E.ABt = (bf16*)(F.ws + WS_ABT); E.ABtc = (bf16*)(F.ws + WS_ABTC);
            E.Qg = (bf16*)(F.ws + WS_QKV + QKV_QG); E.Kg = (bf16*)(F.ws + WS_QKV + QKV_KG); E.Vg = (bf16*)(F.ws + WS_QKV + QKV_VG);
            E.Qw = (bf16*)(F.ws + WS_QKV + QKV_QW); E.Kw = (bf16*)(F.ws + WS_QKV + QKV_KW); E.Vw = (bf16*)(F.ws + WS_QKV + QKV_VW);
            E.G = WSP(bf16, WS_G); E.rope = WSP(float, WS_ROPE); E.qng = inptr(F, IN_QNG) + l * 64; E.kng = inptr(F, IN_KNG) + l * 64;
            pg8::gemm_phase<EpiInProj, Strided<DecInProj>>(F.lds, (LAS int*)(F.lds + IDXBUF_OFF), S, E);
            if (!CONV_IN_ATTN && l == 0 && F.G == 256 && F.vcu >= 88 && rep_ == 0) tail_convert(F, F.vcu - 88, 0, 4, 672);
        } SEAM(pb + 0);
        if (KIND(3) && IN(pb + 1)) REPEAT(3, true) { pc_mixers(F, l, rep_); } SEAM(pb + 1);
        if (KIND(4) && IN(pb + 2)) REPEAT(4, true) {
            SchedMerge S; S.BR = (const char*)(F.ws + WS_BR); S.W = (const char*)(F.ws + WS_WBR) + (size_t)l * DM * DM * 2; S.ntiles = nrt * 4; S.G = F.G; S.vcu = F.vcu;
            EpiMerge E{WSP(bf16, WS_G), (rep_ + 1 == nrep_ && !args.probe) ? (bf16*)(F.ws + WS_MB) : WSP(bf16, WS_HN), args.probe};
            pg8::gemm_phase<EpiMerge, SchedMerge>(F.lds, (LAS int*)(F.lds + IDXBUF_OFF), S, E);
            if (!CONV_IN_ATTN && l == 0 && F.G == 256 && F.vcu >= 32 && rep_ == 0) tail_convert(F, F.vcu - 32, 672, 2, 1120);
        } SEAM(pb + 2);
        if (KIND(5) && IN(pb + 3)) REPEAT(5, l == 0) {
            Strided<DecWout> S; S.d.Mb = (const char*)(F.ws + WS_MB); S.d.W = (const char*)(F.ws + WS_WOUT) + (size_t)l * DM * DM * 2; S.n = nrt * 4; S.G = F.G; S.vcu = F.vcu;
            EpiWout E; E.baseL = l == 0 ? inptr(F, IN_X) : WSP(float, WS_X); E.baseC = l == 0 ? inptr(F, IN_CTX) - (size_t)NLAT * DM : WSP(float, WS_X); E.X = WSP(float, WS_X); E.mod = WSP(float, WS_MOD) + (size_t)l * 9 * 6 * DM;
            pg8::gemm_phase<EpiWout, Strided<DecWout>>(F.lds, (LAS int*)(F.lds + IDXBUF_OFF), S, E);
            if (!CONV_IN_ATTN && l == 0 && F.G == 256 && F.vcu >= 32 && rep_ == 0) tail_convert(F, F.vcu - 32, 1120, 5, 2240);
        } SEAM(pb + 3);
        if (KIND(6) && IN(pb + 4)) REPEAT(6, true) { pf_norm2_router(F, l, rep_ ? FPROBE_MODE : 0); } SEAM(pb + 4);
        if (KIND(7) && IN(pb + 5)) REPEAT(7, true) { pg_topk_gather(F, l); } SEAM(pb + 5);
        const int ert = lastl ? 8 : 9;
        if (KIND(8) && IN(pb + 6)) REPEAT(8, true) {
            Strided<DecGU> S; S.d.H2 = (const char*)(F.ws + WS_HN); S.d.IDX = WSP(int, WS_IDX); S.d.W = (const char*)(F.ws + WS_WGU) + (size_t)l * NE * 2 * DM * DM * 2; S.d.nrt = ert; S.n = NE * ert * 8; S.G = F.G; S.vcu = F.vcu;
            EpiGU E{WSP(bf16, WS_HACT)};
            pg8::gemm_phase<EpiGU, Strided<DecGU>>(F.lds, (LAS int*)(F.lds + IDXBUF_OFF), S, E);
            if (!CONV_IN_ATTN && l == 0 && F.G == 256 && F.vcu >= 128 && rep_ == 0) tail_convert(F, F.vcu - 128, 2240, 3, 2624);
        } SEAM(pb + 6);
        if (KIND(9) && IN(pb + 7)) REPEAT(9, true) {
            Strided<DecDown> S; S.d.H = (const char*)(F.ws + WS_HACT); S.d.W = (const char*)(F.ws + WS_WD) + (size_t)l * NE * DM * DM * 2; S.d.nrt = ert; S.n = NE * ert * 4; S.G = F.G; S.vcu = F.vcu;
            EpiDown E{WSP(bf16, WS_G), WSP(float, WS_AFS)};
            pg8::gemm_phase<EpiDown, Strided<DecDown>>(F.lds, (LAS int*)(F.lds + IDXBUF_OFF), S, E);
            if (!CONV_IN_ATTN && l == 0 && F.G == 256 && F.vcu >= 64 && rep_ == 0) tail_convert(F, F.vcu - 64, 2624, 3, CONV_ITEMS);
        } SEAM(pb + 7);
        if (KIND(10) && IN(pb + 8)) REPEAT(10, true) { pj_combine(F, l, rep_); }
        if (!lastl) SEAM(pb + 8);
    }
#undef IN
#undef SEAM
}

#ifdef DBG_STOP
__global__ void k_dump(const unsigned short* __restrict__ src, float* __restrict__ out, size_t n) {
    for (size_t i = (size_t)blockIdx.x * blockDim.x + threadIdx.x; i < n; i += (size_t)gridDim.x * blockDim.x) out[i] = __uint_as_float((unsigned)src[i] << 16);
}
#endif
extern "C" void kernel_launch(void* const* d_in, const int* in_sizes, int n_in, void* d_out, int out_size, void* d_ws, size_t ws_size, hipStream_t stream) {
    static int grid = 0;
    if (grid == 0) {
        if (n_in != 21 || out_size != NLAT * DM || ws_size < WS_END) { fprintf(stderr, "kernel_launch: unexpected problem (n_in %d, out %d, ws %zu < %zu)\n", n_in, out_size, ws_size, (size_t)WS_END); grid = -1; return; }
        int dev = 0, cus = 0, per_cu = 0;
        if (hipGetDevice(&dev) != hipSuccess || hipDeviceGetAttribute(&cus, hipDeviceAttributeMultiprocessorCount, dev) != hipSuccess) { grid = -1; return; }
        if (hipFuncSetAttribute((const void*)hybrid_fwd, hipFuncAttributeMaxDynamicSharedMemorySize, LDS_BYTES) != hipSuccess) { fprintf(stderr, "kernel_launch: hipFuncSetAttribute failed\n"); grid = -1; return; }
        if (hipOccupancyMaxActiveBlocksPerMultiprocessor(&per_cu, (const void*)hybrid_fwd, NWAVES * 64, LDS_BYTES) != hipSuccess || per_cu < 1) { fprintf(stderr, "kernel_launch: occupancy query says %d blocks/CU\n", per_cu); per_cu = 1; }
        (void)hipGetLastError();
        grid = cus * 1;
    }
    if (grid < 0) return;
    hipMemsetAsync((char*)d_ws + WS_CTL, 0, CTL_ZERO_BYTES, stream);
    Args a; memset(&a, 0, sizeof(a));
    for (int i = 0; i < 21; ++i) a.in[i] = (const float*)d_in[i];
    a.out = (float*)d_out; a.ws = (unsigned char*)d_ws;
#if MK_N_LAUNCHES == 1
    a.ph_lo = 0; a.ph_hi = N_PHASES;
    hipLaunchKernelGGL(hybrid_fwd, dim3(grid), dim3(NWAVES * 64), LDS_BYTES, stream, a);
#else
    int nph_ = N_PHASES;
#ifdef DBG_STOP
    nph_ = DBG_STOP;
#endif
    for (int p = 0; p < nph_; ++p) { a.ph_lo = p; a.ph_hi = p + 1; hipLaunchKernelGGL(hybrid_fwd, dim3(grid), dim3(NWAVES * 64), LDS_BYTES, stream, a);
#ifdef DBG_DUP_PHASE
        if (p == DBG_DUP_PHASE) { a.probe = DBG_PROBE; hipLaunchKernelGGL(hybrid_fwd, dim3(grid), dim3(NWAVES * 64), LDS_BYTES, stream, a); a.probe = 0; }
#endif
    }
#ifdef DBG_STOP
    hipLaunchKernelGGL(k_dump, dim3(2048), dim3(256), 0, stream, (const unsigned short*)((const char*)d_ws + ((size_t)DBG_DUMP_MIB << 20)), (float*)d_out, (size_t)NLAT * DM);
#endif
#endif
}
```

```cpp
#define MK_N_LAUNCHES 1
#include <hip/hip_runtime.h>
#include <hip/hip_bf16.h>
#include <cstdio>
#include <cstdint>
#include <cmath>
#include <cstring>

constexpr int DM = 1024, NBATCH = 8, SEQ = 2048, CTX = 256, DEPTH = 2;
constexpr int NLAT = NBATCH * SEQ, NCTX = NBATCH * CTX, NTOK = NLAT + NCTX;
constexpr int INW = 4608, NCOLT = 19, INW2 = NCOLT * 256;
constexpr int NE = 16, CAPL = 256, CAPC = 32, RPE = NBATCH * (CAPL + CAPC);
constexpr float EPS = 1e-6f;
constexpr float QSCALE = 0.125f * 1.4426950408889634f;
constexpr float LOG2E = 1.4426950408889634f;
namespace pg8 {
#define PG8_LAS __attribute__((address_space(3)))
typedef unsigned short bf16_t;
typedef short bf16x8 __attribute__((ext_vector_type(8)));
typedef float f32x4 __attribute__((ext_vector_type(4)));
typedef unsigned u32x4 __attribute__((ext_vector_type(4)));
typedef unsigned u32x2 __attribute__((ext_vector_type(2)));
constexpr int BM = 256, BK = 64, HALF = 128, HTB = HALF * BK * 2  , STAGE_BYTES = 8 * HTB;

__host__ __device__ __forceinline__ int lds_byte(int r, int c) { const int st = (r >> 4) * 2 + (c >> 5), rr = r & 15, cc = c & 31, ob = rr * 64 + cc * 2; return st * 1024 + (ob ^ (((ob >> 9) & 1) << 5)); }
__host__ __device__ __forceinline__ int perm32(int rho) { const int n = rho >> 4, i = rho & 15; return 8 * (i >> 2) + 4 * n + (i & 3); }
__host__ __device__ __forceinline__ void stage_rc(int b, int& R, int& C) { const int st = b / 1024, sb = b % 1024, swz = sb ^ (((sb >> 9) & 1) << 5); R = (st >> 1) * 16 + swz / 64; C = (st & 1) * 32 + (swz % 64) / 2; }

struct Unit { const char* A; const char* B; const int* arows; int ldA, ldB, nt; int pm, pn, tag; };

typedef float f32x2_c __attribute__((ext_vector_type(2)));
typedef __bf16 bf16x2_c __attribute__((ext_vector_type(2)));
__device__ __forceinline__ unsigned cvt_pk_bf16(float lo, float hi) { const f32x2_c v = {lo, hi}; const bf16x2_c b = __builtin_convertvector(v, bf16x2_c); return __builtin_bit_cast(unsigned, b); }

template <class Epi, class Sched>
__device__ __forceinline__ void gemm_phase(PG8_LAS unsigned char* lds, PG8_LAS int* idxbuf  , const Sched& S, const Epi& E) {
    int tid = threadIdx.x; asm volatile("" : "+v"(tid));
    const int wid = __builtin_amdgcn_readfirstlane(tid >> 6), lane = tid & 63, wr = wid >> 2, wc = wid & 3, fr = lane & 15, fq = lane >> 4;
    unsigned Rr[2], RrB[2], Cc2[2];
#pragma unroll
    for (int i = 0; i < 2; ++i) { int R, C; stage_rc(tid * 16 + i * 8192, R, C); Rr[i] = (unsigned)R; RrB[i] = Epi::PERM ? (unsigned)((R & ~31) + perm32(R & 31)) : (unsigned)R; Cc2[i] = (unsigned)C * 2u; }
    const size_t kstep = (size_t)(BK * 2);
    const unsigned ldsw = (unsigned)wid * 1024u;
    const int aoff = lds_byte(wr * 64 + fr, fq * 8), boff = lds_byte(wc * 32 + fr, fq * 8);
#define PG8_SA(b, h) (((b) * 2 + (h)) * HTB)
#define PG8_SB(b, h) ((4 + (b) * 2 + (h)) * HTB)
#define PG8_STAGE(bufoff, gbase, ld) do { _Pragma("unroll") for (int _i = 0; _i < 2; ++_i) \
        __builtin_amdgcn_global_load_lds((const unsigned*)((const char*)(gbase) + (RrB[_i] * (unsigned)(ld) + Cc2[_i])), (PG8_LAS unsigned*)(lds + (bufoff) + ldsw + _i * 8192), 16, 0, 0); } while (0)
#define PG8_STAGE_A(bufoff, gbase, ao) do { _Pragma("unroll") for (int _i = 0; _i < 2; ++_i) \
        __builtin_amdgcn_global_load_lds((const unsigned*)((const char*)(gbase) + (ao)[_i]), (PG8_LAS unsigned*)(lds + (bufoff) + ldsw + _i * 8192), 16, 0, 0); } while (0)
#define PG8_AOFF(u, ao) do { _Pragma("unroll") for (int _h = 0; _h < 2; ++_h) _Pragma("unroll") for (int _i = 0; _i < 2; ++_i) { \
        const unsigned _row = (u).arows ? (unsigned)idxbuf[Rr[_i] + 128 * _h] : Rr[_i] + 128u * _h; (ao)[_h][_i] = _row * (unsigned)(u).ldA + Cc2[_i]; } } while (0)
#define PG8_STAGE_IDX(u) do { if ((u).arows) __builtin_amdgcn_global_load_lds((const unsigned*)((u).arows + (wid & 3) * 64 + lane), (PG8_LAS unsigned*)((PG8_LAS unsigned char*)idxbuf + (wid & 3) * 256), 4, 0, 0); } while (0)
#define PG8_LDA(dst, b, h) do { _Pragma("unroll") for (int m = 0; m < 4; ++m) _Pragma("unroll") for (int k = 0; k < 2; ++k) dst[m][k] = *(const PG8_LAS bf16x8*)(lds + PG8_SA(b, h) + aoff + m * 2048 + k * 1024); } while (0)
#define PG8_LDB(dst, b, h) do { _Pragma("unroll") for (int n = 0; n < 2; ++n) _Pragma("unroll") for (int k = 0; k < 2; ++k) dst[n][k] = *(const PG8_LAS bf16x8*)(lds + PG8_SB(b, h) + boff + n * 2048 + k * 1024); } while (0)
#define PG8_MMA(ai, bj, At, Bt) do { __builtin_amdgcn_s_setprio(1); _Pragma("unroll") for (int m = 0; m < 4; ++m) _Pragma("unroll") for (int n = 0; n < 2; ++n) _Pragma("unroll") for (int k = 0; k < 2; ++k) \
        acc[ai][bj][m][n] = __builtin_amdgcn_mfma_f32_16x16x32_bf16(Bt[n][k], At[m][k], acc[ai][bj][m][n], 0, 0, 0); __builtin_amdgcn_s_setprio(0); } while (0)
#define PG8_WAIT_V(n) asm volatile("s_waitcnt vmcnt(" #n ")" ::: "memory")
#define PG8_WAIT_L(n) asm volatile("s_waitcnt lgkmcnt(" #n ")" ::: "memory")
#define PG8_BAR __builtin_amdgcn_s_barrier()
#define PG8_SCHED __builtin_amdgcn_sched_barrier(0)
    Unit cur, nxt; int ui = 0;
    if (!S.next(0, cur)) return;
    nxt = cur;
    f32x4 acc[2][2][4][2];
#pragma unroll
    for (int a = 0; a < 2; ++a)
#pragma unroll
        for (int b = 0; b < 2; ++b)
#pragma unroll
            for (int m = 0; m < 4; ++m)
#pragma unroll
                for (int n = 0; n < 2; ++n) acc[a][b][m][n] = (f32x4){0.f, 0.f, 0.f, 0.f};
    bf16x8 At[4][2], B0[2][2], B1[2][2];
    const char* cA = cur.A; const char* cB = cur.B; int clb = cur.ldB;
    unsigned ao_c[2][2], ao_n[2][2];
    if (cur.arows) { PG8_STAGE_IDX(cur); PG8_WAIT_V(0); PG8_BAR; }
    PG8_AOFF(cur, ao_c);
#pragma unroll
    for (int _h = 0; _h < 2; ++_h)
#pragma unroll
        for (int _i = 0; _i < 2; ++_i) ao_n[_h][_i] = ao_c[_h][_i];
    if (cur.arows) { PG8_WAIT_L(0); PG8_BAR; }
    {
        const size_t hB = (size_t)HALF * clb;
        PG8_STAGE(PG8_SB(0, 0), cB, clb); PG8_STAGE(PG8_SB(0, 1), cB + hB, clb); PG8_STAGE_A(PG8_SA(0, 0), cA, ao_c[0]); PG8_STAGE_A(PG8_SA(0, 1), cA, ao_c[1]);
        if (wr == 1) PG8_BAR;
        PG8_WAIT_V(2); PG8_BAR;
        PG8_STAGE(PG8_SB(1, 0), cB + kstep, clb); PG8_STAGE_A(PG8_SA(1, 0), cA + kstep, ao_c[0]); PG8_STAGE(PG8_SB(1, 1), cB + hB + kstep, clb);
        PG8_WAIT_V(6); PG8_BAR;
    }
    for (;;) {
        const bool has_next = S.next(ui + 1, nxt);
        const char* nA = has_next ? nxt.A : cA; const char* nB = has_next ? nxt.B : cB; const int nlb = has_next ? nxt.ldB : clb;
        const int nt = cur.nt;
        if (has_next) PG8_STAGE_IDX(nxt);
        for (int t = 0; t < nt; t += 2) {
            const bool last = (t == nt - 2);
            if (last) { if (has_next) { PG8_AOFF(nxt, ao_n); } else {
#pragma unroll
                for (int _h = 0; _h < 2; ++_h)
#pragma unroll
                    for (int _i = 0; _i < 2; ++_i) ao_n[_h][_i] = ao_c[_h][_i]; } }
            unsigned ao2[2][2];
#pragma unroll
            for (int _h = 0; _h < 2; ++_h)
#pragma unroll
                for (int _i = 0; _i < 2; ++_i) ao2[_h][_i] = last ? ao_n[_h][_i] : ao_c[_h][_i];
            const char* a1 = cA + (size_t)(t + 1) * kstep;
            const char* a2 = last ? nA : cA + (size_t)(t + 2) * kstep; const char* b2 = last ? nB : cB + (size_t)(t + 2) * kstep;
            const int lb2 = last ? nlb : clb;
            const size_t hB2 = (size_t)HALF * lb2;
            const char* a3 = a2 + kstep; const char* b3 = b2 + kstep;
            PG8_LDB(B0, 0, 0); PG8_LDB(B1, 0, 1); PG8_SCHED; PG8_LDA(At, 0, 0); PG8_STAGE_A(PG8_SA(1, 1), a1, ao_c[1]);
            PG8_WAIT_V(8); PG8_WAIT_L(0); PG8_BAR; PG8_MMA(0, 0, At, B0); PG8_MMA(0, 1, At, B1); PG8_BAR; PG8_SCHED;
            PG8_LDA(At, 0, 1); PG8_STAGE(PG8_SB(0, 0), b2, lb2); PG8_STAGE(PG8_SB(0, 1), b2 + hB2, lb2); PG8_STAGE_A(PG8_SA(0, 0), a2, ao2[0]);
            PG8_WAIT_V(8); PG8_WAIT_L(0); PG8_BAR; PG8_MMA(1, 0, At, B0); PG8_MMA(1, 1, At, B1); PG8_BAR; PG8_SCHED;
            PG8_LDB(B0, 1, 0); PG8_LDB(B1, 1, 1); PG8_SCHED; PG8_LDA(At, 1, 0); PG8_STAGE_A(PG8_SA(0, 1), a2, ao2[1]);
            PG8_WAIT_V(8); PG8_WAIT_L(0); PG8_BAR; PG8_MMA(0, 0, At, B0); PG8_MMA(0, 1, At, B1); PG8_BAR; PG8_SCHED;
            PG8_LDA(At, 1, 1); PG8_STAGE(PG8_SB(1, 0), b3, lb2); PG8_STAGE(PG8_SB(1, 1), b3 + hB2, lb2); PG8_STAGE_A(PG8_SA(1, 0), a3, ao2[0]);
            PG8_WAIT_V(8); PG8_WAIT_L(0); PG8_BAR; PG8_MMA(1, 0, At, B0); PG8_MMA(1, 1, At, B1); PG8_BAR; PG8_SCHED;
        }
        if (wr == 0) PG8_BAR;
        bool keep_acc;
        { Unit eu = cur; int ewr = wr, ewc = wc, efr = fr, efq = fq; asm volatile("" : "+s"(eu.pm), "+s"(eu.pn), "+s"(eu.tag), "+s"(ewr), "+s"(ewc), "+v"(efr), "+v"(efq));
          keep_acc = E(acc, eu, ewr, ewc, efr, efq); }
        if (!has_next) break;
        if (!keep_acc) {
#pragma unroll
        for (int a = 0; a < 2; ++a)
#pragma unroll
            for (int b = 0; b < 2; ++b)
#pragma unroll
                for (int m = 0; m < 4; ++m)
#pragma unroll
                    for (int n = 0; n < 2; ++n) acc[a][b][m][n] = (f32x4){0.f, 0.f, 0.f, 0.f};
        }
        cur = nxt; cA = nA; cB = nB; clb = nlb; ++ui;
#pragma unroll
        for (int _h = 0; _h < 2; ++_h)
#pragma unroll
            for (int _i = 0; _i < 2; ++_i) ao_c[_h][_i] = ao_n[_h][_i];
        if (wr == 1) PG8_BAR;
    }
    PG8_WAIT_V(0);
    PG8_BAR;
#undef PG8_SA
#undef PG8_SB
#undef PG8_STAGE
#undef PG8_STAGE_A
#undef PG8_AOFF
#undef PG8_STAGE_IDX
#undef PG8_LDA
#undef PG8_LDB
#undef PG8_MMA
#undef PG8_WAIT_V
#undef PG8_WAIT_L
#undef PG8_BAR
#undef PG8_SCHED
}
}
#include <hip/hip_bf16.h>
#include <cmath>
namespace attn_body {
using bf16=__hip_bfloat16;
using bf16x8=__attribute__((ext_vector_type(8)))short;
using s16x4=__attribute__((ext_vector_type(4)))short;
using f32x16=__attribute__((ext_vector_type(16)))float;
using u32x4=__attribute__((ext_vector_type(4)))unsigned;
constexpr int D=64;
constexpr int NW=8,QBLK=32,KVBLK=64,NCT=4;
__device__ __forceinline__ int crow(int r,int hi){return (r&3)+8*(r>>2)+4*hi;}
#define SBAR() __builtin_amdgcn_sched_barrier(0)
__device__ __forceinline__ void wmask(f32x16&p0,f32x16&p1,int kb,int qabs,int hi){
  const float NEG=-INFINITY; const int d0=kb+4*hi-qabs;
  #pragma unroll
  for(int r=0;r<16;++r){int dd=d0+(r&3)+8*(r>>2); if(dd>128||dd<-128)p0[r]=NEG; if(dd+32>128||dd+32<-128)p1[r]=NEG;}
}

constexpr int NSLOT=3, SLOTB=8192;
constexpr int LDS_K=0, LDS_V=NSLOT*SLOTB, LDS_WS=2*NSLOT*SLOTB, LDS_OST=LDS_WS+NW*64*4, LDS_BYTES=LDS_OST+NW*4096;
__device__ __forceinline__ void glds16(const void*gsrc,unsigned lds_dst){unsigned keep;
  asm volatile("s_mov_b32 %0, m0\n\ts_mov_b32 m0, %2\n\ts_nop 0\n\tglobal_load_lds_dwordx4 %1, off\n\ts_mov_b32 m0, %0":"=&s"(keep):"v"(gsrc),"s"(lds_dst):"memory");}
__device__ __forceinline__ float max3f(float a,float b,float c){float r;asm("v_max3_f32 %0, %1, %2, %3":"=v"(r):"v"(a),"v"(b),"v"(c));return r;}
__device__ __forceinline__ float max2f(float a,float b){float r;asm("v_max_f32_e32 %0, %1, %2":"=v"(r):"v"(a),"v"(b));return r;}
__device__ __forceinline__ float fadd_s(float a,float b){float r;asm("v_add_f32_e32 %0, %1, %2":"=v"(r):"v"(a),"v"(b));return r;}
__device__ __forceinline__ float fsub_s(float a,float b){float r;asm("v_sub_f32_e32 %0, %1, %2":"=v"(r):"v"(a),"v"(b));return r;}
typedef float f32x2_t __attribute__((ext_vector_type(2))); typedef __bf16 bf16x2_t __attribute__((ext_vector_type(2)));
__device__ __forceinline__ unsigned cvtpk_s(float lo,float hi){f32x2_t v={lo,hi};bf16x2_t b=__builtin_convertvector(v,bf16x2_t);return __builtin_bit_cast(unsigned,b);}
#define WAIT_BAR(N) asm volatile("s_waitcnt vmcnt(" #N ") lgkmcnt(0)\n\ts_barrier":::"memory")

__device__ __forceinline__ void qkt(f32x16&p0,f32x16&p1,const char*Kslot,const bf16x8*qr,const f32x16&negm,int r32,int hi){
  const char*kb=Kslot+hi*1024+r32*16;
  #pragma unroll
  for(int d0=0;d0<4;++d0){
    const bf16x8 b0=*reinterpret_cast<const bf16x8*>(kb+d0*2048);
    const bf16x8 b1=*reinterpret_cast<const bf16x8*>(kb+d0*2048+512);
    if(d0==0){p0=__builtin_amdgcn_mfma_f32_32x32x16_bf16(b0,qr[0],negm,0,0,0);p1=__builtin_amdgcn_mfma_f32_32x32x16_bf16(b1,qr[0],negm,0,0,0);}
    else{p0=__builtin_amdgcn_mfma_f32_32x32x16_bf16(b0,qr[d0],p0,0,0,0);p1=__builtin_amdgcn_mfma_f32_32x32x16_bf16(b1,qr[d0],p1,0,0,0);}}
}
typedef __attribute__((address_space(3))) const char* lds_cptr;
typedef short v4i16_t __attribute__((ext_vector_type(4)));
__device__ __forceinline__ void kload8(bf16x8*kf,lds_cptr kp){
  kf[0]=*(const __attribute__((address_space(3))) bf16x8*)(kp);      kf[1]=*(const __attribute__((address_space(3))) bf16x8*)(kp+512);
  kf[2]=*(const __attribute__((address_space(3))) bf16x8*)(kp+2048); kf[3]=*(const __attribute__((address_space(3))) bf16x8*)(kp+2560);
  kf[4]=*(const __attribute__((address_space(3))) bf16x8*)(kp+4096); kf[5]=*(const __attribute__((address_space(3))) bf16x8*)(kp+4608);
  kf[6]=*(const __attribute__((address_space(3))) bf16x8*)(kp+6144); kf[7]=*(const __attribute__((address_space(3))) bf16x8*)(kp+6656);
}
__device__ __forceinline__ void kload2(bf16x8*kf,lds_cptr kp,int j){ kf[2*j]=*(const __attribute__((address_space(3))) bf16x8*)(kp+j*2048); kf[2*j+1]=*(const __attribute__((address_space(3))) bf16x8*)(kp+j*2048+512); }
__device__ __forceinline__ s16x4 vtr(lds_cptr p){ return __builtin_bit_cast(s16x4,__builtin_amdgcn_ds_read_tr16_b64_v4i16((__attribute__((address_space(3))) v4i16_t*)p)); }
__device__ __forceinline__ float rowmax(const f32x16&p0,const f32x16&p1){
  float a=max3f(p0[0],p0[1],p1[0]),b=max3f(p0[2],p0[3],p1[1]);a=max3f(a,p1[2],p1[3]);
  #pragma unroll
  for(int r=4;r<16;r+=4){a=max3f(a,p0[r],p0[r+1]);b=max3f(b,p0[r+2],p0[r+3]);a=max3f(a,p1[r],p1[r+1]);b=max3f(b,p1[r+2],p1[r+3]);}
  const float m=max2f(a,b);
  auto rr=__builtin_amdgcn_permlane32_swap(__float_as_uint(m),__float_as_uint(m),false,false);
  return max2f(__uint_as_float(rr[0]),__uint_as_float(rr[1]));
}
__device__ __forceinline__ void pv(f32x16*o,int vb,bf16x8 pa0,bf16x8 pa1,bf16x8 pa2,bf16x8 pa3){
  #pragma unroll
  for(int d0=0;d0<2;++d0){s16x4 lo[4],hi[4];
    #pragma unroll
    for(int ks=0;ks<4;++ks){
      asm volatile("ds_read_b64_tr_b16 %0,%1 offset:%c2":"=&v"(lo[ks]):"v"(vb),"i"(d0*4096+ks*1024):"memory");
      asm volatile("ds_read_b64_tr_b16 %0,%1 offset:%c2":"=&v"(hi[ks]):"v"(vb),"i"(d0*4096+ks*1024+512):"memory");}
    asm volatile("s_waitcnt lgkmcnt(0)":::"memory");SBAR();
    #define PK(k) (bf16x8){lo[k][0],lo[k][1],lo[k][2],lo[k][3],hi[k][0],hi[k][1],hi[k][2],hi[k][3]}
    o[d0]=__builtin_amdgcn_mfma_f32_32x32x16_bf16(pa0,PK(0),o[d0],0,0,0);
    o[d0]=__builtin_amdgcn_mfma_f32_32x32x16_bf16(pa1,PK(1),o[d0],0,0,0);
    o[d0]=__builtin_amdgcn_mfma_f32_32x32x16_bf16(pa2,PK(2),o[d0],0,0,0);
    o[d0]=__builtin_amdgcn_mfma_f32_32x32x16_bf16(pa3,PK(3),o[d0],0,0,0);
    #undef PK
  }
}

#ifndef ATTN_STORE16
#define ATTN_STORE16(p,v) (*(u32x4*)(p)=(v))
#endif
template<int MODE,int THRL> __device__ __forceinline__ void attn_unit(const bf16*Qw,int qp,const bf16*Kc,const bf16*Kl,const bf16*Vc,const bf16*Vl,int kp,int NT,int qabs,int band0,float sinkl2,bf16*Ow,int op,char*shm){
  int tid=threadIdx.x; asm volatile("":"+v"(tid));
  const int lane=tid&63,r32=lane&31,hi=lane>>5; const int wid=__builtin_amdgcn_readfirstlane(tid>>6);
  qabs+=r32;
  const unsigned lds0=(unsigned)(uintptr_t)shm;
  float*wsf=(float*)(shm+LDS_WS)+wid*64;
  const unsigned koff_=(unsigned)(lane*kp+wid*8)*2u;
  const unsigned voff_=(unsigned)((16*(wid&3)+(lane>>2))*kp+(wid>>2)*32+(lane&3)*8)*2u;
  const unsigned kdst=lds0+LDS_K+wid*1024, vdst=lds0+LDS_V+wid*1024;
  #define DMA_K(t,slot) glds16((const char*)((t)<NCT?Kc+(long)(t)*KVBLK*kp:Kl+(long)((t)-NCT)*KVBLK*kp)+koff_,(unsigned)__builtin_amdgcn_readfirstlane(kdst+(slot)))
  #define DMA_V(t,slot) glds16((const char*)((t)<NCT?Vc+(long)(t)*KVBLK*kp:Vl+(long)((t)-NCT)*KVBLK*kp)+voff_,(unsigned)__builtin_amdgcn_readfirstlane(vdst+(slot)))
  const int vb0=(int)(lds0+LDS_V)+((lane>>4)&1)*32+(lane&3)*8+(4*hi+((lane&15)>>2))*64;
  const char*Kbase=shm+LDS_K; bf16x8 kf[8];
  const lds_cptr shm3=(lds_cptr)shm; const lds_cptr kp0=shm3+LDS_K+hi*1024+r32*16; const lds_cptr vp0=shm3+LDS_V+((lane>>4)&1)*32+(lane&3)*8+(4*hi+((lane&15)>>2))*64;
  DMA_K(0,0);DMA_V(0,0);DMA_K(1,SLOTB);
  bf16x8 qr[4];
  #pragma unroll
  for(int d0=0;d0<4;++d0)qr[d0]=*reinterpret_cast<const bf16x8*>(&Qw[(long)r32*qp+d0*16+hi*8]);
  float mhat=0.f,l_reg=0.f;f32x16 o[2];o[0]=f32x16{};o[1]=f32x16{};f32x16 negm=f32x16{};asm volatile("":"+v"(negm));
  #define CMASK(P0,P1,t) do{ if(MODE==1){ if((t)>=NCT)wmask(P0,P1,band0+KVBLK*((t)-NCT),qabs,hi);} }while(0)
  bool resc=false;
  #define START(P0,P1) do{ const float rm=rowmax(P0,P1); resc=false; \
    { const float dl=rm; mhat=fadd_s(mhat,dl); \
      _Pragma("unroll") for(int r=0;r<16;++r){P0[r]=fsub_s(P0[r],dl);P1[r]=fsub_s(P1[r],dl);} \
      _Pragma("unroll") for(int r=0;r<16;++r)negm[r]=-mhat; asm volatile("":"+v"(negm)); } \
    _Pragma("unroll") for(int r=0;r<16;++r)P0[r]=__builtin_amdgcn_exp2f(P0[r]); }while(0)
  #define RESC() do{ if(resc){ asm volatile("s_waitcnt lgkmcnt(0)":::"memory"); \
      _Pragma("unroll") for(int d_=0;d_<2;++d_) _Pragma("unroll") for(int r=0;r<16;++r)o[d_][r]*=wsf[crow(r,hi)]; } }while(0)
  f32x16 pA0,pA1,pB0,pB1;
  int sl_prev=0,sl_cur=0,sl_next=SLOTB;
  #define ROT() do{sl_prev=sl_cur;sl_cur=sl_next;sl_next=(sl_next==(NSLOT-1)*SLOTB)?0:sl_next+SLOTB;}while(0)
  DMA_K(2,2*SLOTB);
  WAIT_BAR(3);
  qkt(pA0,pA1,Kbase,qr,negm,r32,hi);asm volatile("s_nop 15\n\ts_nop 7":"+v"(pA0),"+v"(pA1));CMASK(pA0,pA1,0);
  START(pA0,pA1);
  _Pragma("unroll") for(int r=0;r<16;++r)pA1[r]=__builtin_amdgcn_exp2f(pA1[r]);
  WAIT_BAR(0);
  DMA_K(3,0);DMA_V(1,SLOTB);
  ROT();
  kload8(kf,kp0+sl_cur);
  WAIT_BAR(2);
  s16x4 vlo[8],vhi[8]; u32x4 pw0,pw1,pw2,pw3;
  #define PKW(P,B) cvtpk_s(P[B],P[B+1])
  #define PAF(k) __builtin_bit_cast(bf16x8,pw##k)
  #define VFR(i) (bf16x8){vlo[i][0],vlo[i][1],vlo[i][2],vlo[i][3],vhi[i][0],vhi[i][1],vhi[i][2],vhi[i][3]}
  #define PIN(x) asm volatile("":"+v"(x))
  #define MX3(a,b,c) __builtin_fmaxf(__builtin_fmaxf((a),(b)),(c))
  #define GAPA(MF,A0,A1,A2,A3,W0,W1,PW) do{ MF; sacc+=A0; sacc+=A1; sacc+=A2; sacc+=A3; PIN(sacc); W0; W1; PIN(PW); SBAR(); }while(0)
  #define EX(v) __builtin_amdgcn_exp2f(v)
  #define GAPB(MF,X,B) do{ MF; X[B]=EX(X[B]); X[B+1]=EX(X[B+1]); X[B+2]=EX(X[B+2]); X[B+3]=EX(X[B+3]); PIN(X); SBAR(); }while(0)
  #define VRD(i) do{ vlo[i]=vtr(vp_+(((i)>>2)*4096+((i)&3)*1024)); vhi[i]=vtr(vp_+(((i)>>2)*4096+((i)&3)*1024+512)); }while(0)
  #define KRD(G,j) do{ if(G){ kload2(kf,kp0+sl_next,j); SBAR(); } }while(0)
  #define STEP(C0,C1,P0,P1,t,GK,GV,GL) do{ SBAR(); \
    const lds_cptr vp_=vp0+sl_prev; \
    VRD(0); SBAR(); float sacc=(P0[0]+P0[1]); \
    GAPA(C0=__builtin_amdgcn_mfma_f32_32x32x16_bf16(kf[0],qr[0],negm,0,0,0), P0[2],P0[3],P0[4],P0[5],     pw0[0]=PKW(P0,0), pw0[1]=PKW(P0,2), pw0); \
    VRD(4); SBAR(); GAPA(C1=__builtin_amdgcn_mfma_f32_32x32x16_bf16(kf[1],qr[0],negm,0,0,0), P0[6],P0[7],P0[8],P0[9],     pw0[2]=PKW(P0,4), pw0[3]=PKW(P0,6), pw0); \
    VRD(1); SBAR(); GAPA(C0=__builtin_amdgcn_mfma_f32_32x32x16_bf16(kf[2],qr[1],C0,0,0,0),   P0[10],P0[11],P0[12],P0[13], pw1[0]=PKW(P0,8), pw1[1]=PKW(P0,10), pw1); \
    VRD(5); SBAR(); GAPA(C1=__builtin_amdgcn_mfma_f32_32x32x16_bf16(kf[3],qr[1],C1,0,0,0),   P0[14],P0[15],P1[0],P1[1],   pw1[2]=PKW(P0,12),pw1[3]=PKW(P0,14), pw1); \
    VRD(2); SBAR(); GAPA(C0=__builtin_amdgcn_mfma_f32_32x32x16_bf16(kf[4],qr[2],C0,0,0,0),   P1[2],P1[3],P1[4],P1[5],     pw2[0]=PKW(P1,0), pw2[1]=PKW(P1,2), pw2); \
    VRD(6); SBAR(); GAPA(C1=__builtin_amdgcn_mfma_f32_32x32x16_bf16(kf[5],qr[2],C1,0,0,0),   P1[6],P1[7],P1[8],P1[9],     pw2[2]=PKW(P1,4), pw2[3]=PKW(P1,6), pw2); \
    VRD(3); SBAR(); GAPA(C0=__builtin_amdgcn_mfma_f32_32x32x16_bf16(kf[6],qr[3],C0,0,0,0),   P1[10],P1[11],P1[12],P1[13], pw3[0]=PKW(P1,8), pw3[1]=PKW(P1,10), pw3); \
    VRD(7); SBAR(); GAPA(C1=__builtin_amdgcn_mfma_f32_32x32x16_bf16(kf[7],qr[3],C1,0,0,0),   P1[14],P1[15],0.f,0.f,       pw3[2]=PKW(P1,12),pw3[3]=PKW(P1,14), pw3); \
    l_reg+=sacc; \
    if(GK){DMA_K((t)+3,sl_cur);} if(GV){DMA_V((t)+1,sl_next);} \
    CMASK(C0,C1,t); \
    { float a=MX3(C0[0],C0[1],C1[0]),b=MX3(C0[2],C0[3],C1[1]); a=MX3(a,C1[2],C1[3]); \
      _Pragma("unroll") for(int r=4;r<16;r+=4){a=MX3(a,C0[r],C0[r+1]);b=MX3(b,C0[r+2],C0[r+3]);a=MX3(a,C1[r],C1[r+1]);b=MX3(b,C1[r+2],C1[r+3]);} \
      float rm=__builtin_fmaxf(a,b); { auto rr=__builtin_amdgcn_permlane32_swap(__float_as_uint(rm),__float_as_uint(rm),false,false); rm=__builtin_fmaxf(__uint_as_float(rr[0]),__uint_as_float(rr[1])); } \
      resc=false; \
      if(__builtin_expect(__any(rm>(float)THRL),0)){ const float dl=__builtin_fmaxf(rm,0.f); mhat+=dl; \
        _Pragma("unroll") for(int r=0;r<16;++r){C0[r]-=dl;C1[r]-=dl;} \
        _Pragma("unroll") for(int r=0;r<16;++r)negm[r]=-mhat; asm volatile("":"+v"(negm)); \
        const float f=__builtin_amdgcn_exp2f(-dl); l_reg*=f; if(hi==0)wsf[r32]=f; resc=true; } } \
    SBAR(); \
    GAPB(o[0]=__builtin_amdgcn_mfma_f32_32x32x16_bf16(PAF(0),VFR(0),o[0],0,0,0), C0,0); \
    GAPB(o[1]=__builtin_amdgcn_mfma_f32_32x32x16_bf16(PAF(0),VFR(4),o[1],0,0,0), C0,4); \
    KRD(GL,0); GAPB(o[0]=__builtin_amdgcn_mfma_f32_32x32x16_bf16(PAF(1),VFR(1),o[0],0,0,0), C0,8); \
    KRD(GL,1); GAPB(o[1]=__builtin_amdgcn_mfma_f32_32x32x16_bf16(PAF(1),VFR(5),o[1],0,0,0), C0,12); \
    KRD(GL,2); GAPB(o[0]=__builtin_amdgcn_mfma_f32_32x32x16_bf16(PAF(2),VFR(2),o[0],0,0,0), C1,0); \
    KRD(GL,3); GAPB(o[1]=__builtin_amdgcn_mfma_f32_32x32x16_bf16(PAF(2),VFR(6),o[1],0,0,0), C1,4); \
    GAPB(o[0]=__builtin_amdgcn_mfma_f32_32x32x16_bf16(PAF(3),VFR(3),o[0],0,0,0), C1,8); \
    GAPB(o[1]=__builtin_amdgcn_mfma_f32_32x32x16_bf16(PAF(3),VFR(7),o[1],0,0,0), C1,12); \
    }while(0)
  int t=1;
  for(;t+5<NT;t+=2){
    STEP(pB0,pB1,pA0,pA1,t,true,true,true);     WAIT_BAR(2); RESC(); ROT();
    STEP(pA0,pA1,pB0,pB1,t+1,true,true,true);   WAIT_BAR(2); RESC(); ROT();
  }
  #define ENDW(tt) do{ if((tt)+3<NT){WAIT_BAR(2);} else if((tt)+2<NT){WAIT_BAR(1);} else {WAIT_BAR(0);} }while(0)
  for(;t+1<NT;t+=2){
    STEP(pB0,pB1,pA0,pA1,t,(t+3<NT),(t+1<NT),(t+1<NT));       ENDW(t);   RESC(); ROT();
    STEP(pA0,pA1,pB0,pB1,t+1,(t+4<NT),(t+2<NT),(t+2<NT));     ENDW(t+1); RESC(); ROT();
  }
  STEP(pB0,pB1,pA0,pA1,NT-1,false,false,false); RESC();
  { float sacc=pB0[0]+pB0[1]; _Pragma("unroll") for(int r=2;r<16;++r)sacc+=pB0[r]; _Pragma("unroll") for(int r=0;r<16;++r)sacc+=pB1[r]; l_reg+=sacc;
    pw0=(u32x4){PKW(pB0,0),PKW(pB0,2),PKW(pB0,4),PKW(pB0,6)};pw1=(u32x4){PKW(pB0,8),PKW(pB0,10),PKW(pB0,12),PKW(pB0,14)};pw2=(u32x4){PKW(pB1,0),PKW(pB1,2),PKW(pB1,4),PKW(pB1,6)};pw3=(u32x4){PKW(pB1,8),PKW(pB1,10),PKW(pB1,12),PKW(pB1,14)};
    SBAR(); pv(o,vb0+sl_cur,PAF(0),PAF(1),PAF(2),PAF(3)); }
  #undef PKW
  #undef PAF
  #undef VFR
  #undef PIN
  #undef MX3
  #undef GAPA
  #undef GAPB
  #undef EX
  #undef VRD
  #undef KRD
  #undef STEP
  #undef ENDW
  {auto rr=__builtin_amdgcn_permlane32_swap(__float_as_uint(l_reg),__float_as_uint(l_reg),false,false);l_reg=__uint_as_float(rr[0])+__uint_as_float(rr[1]);}
  if(MODE==1)l_reg+=__builtin_amdgcn_exp2f(sinkl2-mhat);
  if(hi==0)wsf[32+r32]=l_reg;asm volatile("s_waitcnt lgkmcnt(0)":::"memory");
  float rli[16];
  #pragma unroll
  for(int r=0;r<16;++r)rli[r]=__builtin_amdgcn_rcpf(wsf[32+crow(r,hi)]);
  { bf16*stg=(bf16*)(shm+LDS_OST)+wid*2048;
    #pragma unroll
    for(int r=0;r<16;++r){const int orow=crow(r,hi);
      #pragma unroll
      for(int d0=0;d0<2;++d0)stg[orow*64+d0*32+r32]=__float2bfloat16(o[d0][r]*rli[r]);}
    asm volatile("s_waitcnt lgkmcnt(0)":::"memory");
    #pragma unroll
    for(int i=0;i<4;++i){const int row=i*8+(lane>>3),ch=lane&7; const u32x4 v=*(const u32x4*)(stg+row*64+ch*8); ATTN_STORE16(Ow+(long)row*op+ch*8,v);} }
  asm volatile("s_waitcnt lgkmcnt(0)\n\ts_barrier":::"memory");
  #undef DMA_K
  #undef DMA_V
  #undef CMASK
  #undef START
  #undef RESC
  #undef ROT
}
constexpr int ATTN_LDS_BYTES=LDS_BYTES;
#undef SBAR
#undef WAIT_BAR
}
constexpr int NWAVES = 8;
constexpr size_t MiB = 1u << 20;
constexpr size_t WS_CTL = 0, CTL_ZERO_BYTES = 256 * 1024;
constexpr size_t WS_MOD = 1 * MiB;
constexpr size_t WS_ROPE = WS_MOD + 512 * 1024;
constexpr size_t WS_AFS = WS_ROPE + 64 * 1024;
constexpr size_t WS_IDX = WS_AFS + 192 * 1024;
constexpr size_t WS_SEL = 2 * MiB;
constexpr size_t WS_AFF = 4 * MiB;
constexpr size_t WS_ABTC = WS_AFF;
constexpr size_t WS_WIN = 6 * MiB;
constexpr size_t WS_WBR = 25 * MiB;
constexpr size_t WS_WOUT = 29 * MiB;
constexpr size_t WS_DFT = 33 * MiB;
constexpr size_t WS_DFTC = 49 * MiB;
constexpr size_t WS_WGU = 50 * MiB;
constexpr size_t WS_WD = 178 * MiB;
constexpr size_t WS_X = 242 * MiB;
constexpr size_t WS_HN = 314 * MiB;
constexpr size_t WS_MB = WS_HN;
constexpr size_t WS_QKV = 350 * MiB;
constexpr size_t WS_G = 395 * MiB;
constexpr size_t WS_BR = 503 * MiB;
constexpr size_t WS_HACT = 467 * MiB;
constexpr size_t WS_ABT = 539 * MiB;
constexpr size_t WS_END = 555 * MiB;
constexpr size_t QKV_QG = 0, QKV_KG = (size_t)NTOK * 512 * 2, QKV_VG = QKV_KG + (size_t)NTOK * 128 * 2, QKV_QW = QKV_VG + (size_t)NTOK * 128 * 2,
                 QKV_KW = QKV_QW + (size_t)NTOK * 256 * 2, QKV_VW = QKV_KW + (size_t)NTOK * 128 * 2;
static_assert(WS_WIN + (size_t)DEPTH * INW2 * DM * 2 <= WS_WBR && WS_QKV + QKV_VW + (size_t)NTOK * 128 * 2 <= WS_G && WS_G + (size_t)NTOK * 3 * DM * 2 <= WS_BR && WS_HACT >= WS_G + (size_t)NE * RPE * DM * 2 &&
              WS_HACT + (size_t)NE * RPE * DM * 2 <= WS_ABT && WS_ABT + (size_t)NBATCH * 256 * 2 * SEQ * 2 <= WS_END && (size_t)NBATCH * 256 * 2 * CTX * 2 <= 2 * MiB, "d_ws map");
constexpr int CW_BAR = 1024;
constexpr int CW_QUEUE = 8192;
constexpr int CW_CONVQ = 8192 + 64 * 8;
constexpr int CW_FIN = CW_CONVQ + 64;
constexpr int RING_BYTES = 131072;
constexpr int LDSCTL_OFF = RING_BYTES, MISC_OFF = LDSCTL_OFF + 320;
constexpr int IDXBUF_OFF = LDSCTL_OFF + 1024 + 8192;
constexpr int LDS_BYTES = 147456;

#define GAS __attribute__((address_space(1)))
#define LAS __attribute__((address_space(3)))
typedef unsigned short bf16;
typedef unsigned v4u __attribute__((ext_vector_type(4)));
typedef unsigned v2u __attribute__((ext_vector_type(2)));
typedef float f32x4 __attribute__((ext_vector_type(4)));
typedef GAS unsigned gu32;
#define RLX_AGENT __ATOMIC_RELAXED, __HIP_MEMORY_SCOPE_AGENT
#define LDS_WAIT() asm volatile("s_waitcnt lgkmcnt(0)" ::: "memory")
#define VM_WAIT() asm volatile("s_waitcnt vmcnt(0)" ::: "memory")
__device__ __forceinline__ unsigned f2bf(float f) { unsigned u = __builtin_bit_cast(unsigned, f); return (u + 0x7fffu + ((u >> 16) & 1u)) >> 16; }
__device__ __forceinline__ unsigned pk2(float lo, float hi) { return f2bf(lo) | (f2bf(hi) << 16); }
__device__ __forceinline__ float bf2f(unsigned short h) { return __builtin_bit_cast(float, (unsigned)h << 16); }
__device__ __forceinline__ float bflo(unsigned w) { return __builtin_bit_cast(float, w << 16); }
__device__ __forceinline__ float bfhi(unsigned w) { return __builtin_bit_cast(float, w & 0xffff0000u); }

#define XB_TMO      128
#define XB_XCNT(j)  (256  + 64 * (j))
#define XB_XSUB(j)  (1280 + 64 * (j))
#define XB_XGEN(j)  (2304 + 64 * (j))
#define XB_TOP      3328
#define XB_TOPGEN   3392
#define XCD_BAR_WORDS 3456
#define XB_SPIN_CAP (1u << 20)
__device__ __forceinline__ unsigned xb_ld(unsigned* p)              { return __hip_atomic_load(p, __ATOMIC_RELAXED, __HIP_MEMORY_SCOPE_AGENT); }
__device__ __forceinline__ unsigned xb_add(unsigned* p, unsigned v) { return __hip_atomic_fetch_add(p, v, __ATOMIC_RELAXED, __HIP_MEMORY_SCOPE_AGENT); }
__device__ __forceinline__ unsigned xb_xcc_id() { return (unsigned)__builtin_amdgcn_s_getreg((3 << 11) | 20) & 0xFu; }
#define XB_SPIN(cond, bar) do { unsigned _sp = 0; while (cond) { __builtin_amdgcn_s_sleep(1); \
    if ((++_sp & 255u) == 0u) { if (xb_ld(&(bar)[XB_TMO])) break; if (_sp > XB_SPIN_CAP) { atomicAdd(&(bar)[XB_TMO], 1u); break; } } } } while (0)
struct XcdBarrier { unsigned* bar; unsigned x; volatile LAS unsigned* st; };
__device__ __forceinline__ XcdBarrier xcd_barrier_post(unsigned* bar, volatile LAS unsigned* st) {
    XcdBarrier b; b.bar = bar; b.x = xb_xcc_id(); b.st = st;
    if (threadIdx.x == 0) (void)xb_add(&bar[XB_XCNT(b.x)], 1u);
    return b;
}
__device__ __forceinline__ void xcd_barrier_complete(unsigned* bar, unsigned x, unsigned& nloc, unsigned& nx) {
    const unsigned G = gridDim.x * gridDim.y * gridDim.z;
    unsigned sum, cnt, mine, sp = 0u;
    for (;;) {
        sum = 0u; cnt = 0u; mine = 0u;
#pragma unroll
        for (unsigned j = 0; j < 16; ++j) { const unsigned c = xb_ld(&bar[XB_XCNT(j)]); sum += c; cnt += (c > 0u) ? 1u : 0u; mine = (j == x) ? c : mine; }
        if (sum == G) break;
        __builtin_amdgcn_s_sleep(1);
        if ((++sp & 255u) == 0u) { if (xb_ld(&bar[XB_TMO])) break; if (sp > XB_SPIN_CAP) { atomicAdd(&bar[XB_TMO], 1u); break; } }
    }
    nloc = mine > 0u ? mine : 1u; nx = cnt > 0u ? cnt : 1u;
}
__device__ __forceinline__ void xcd_barrier(const XcdBarrier& b) {
    asm volatile("s_waitcnt vmcnt(0)" ::: "memory");
    __syncthreads();
    if (threadIdx.x == 0) {
        unsigned* bar = b.bar;
        __builtin_amdgcn_s_waitcnt(0);
        unsigned nloc = b.st[0], nx = b.st[1];
        if (nloc == 0u) { xcd_barrier_complete(bar, b.x, nloc, nx); b.st[0] = nloc; b.st[1] = nx; }
        const unsigned old = xb_add(&bar[XB_XSUB(b.x)], 1u);
        const unsigned gen = old / nloc;
        if (old + 1u == (gen + 1u) * nloc) {
            __builtin_amdgcn_fence(__ATOMIC_RELEASE, "agent");
            asm volatile("s_waitcnt vmcnt(0)" ::: "memory");
            const unsigned og = xb_add(&bar[XB_TOP], 1u);
            const unsigned tg = og / nx;
            if (og + 1u == (tg + 1u) * nx) xb_add(&bar[XB_TOPGEN], 1u);
            else XB_SPIN(xb_ld(&bar[XB_TOPGEN]) == tg, bar);
            __builtin_amdgcn_fence(__ATOMIC_ACQUIRE, "agent");
            xb_add(&bar[XB_XGEN(b.x)], 1u);
            asm volatile("s_waitcnt vmcnt(0)" ::: "memory");
        } else {
            XB_SPIN(xb_ld(&bar[XB_XGEN(b.x)]) == gen, bar);
            __builtin_amdgcn_fence(__ATOMIC_ACQUIRE, "agent");
            asm volatile("s_waitcnt vmcnt(0)" ::: "memory");
        }
    }
    __syncthreads();
}
template <int CTRL> __device__ __forceinline__ float dpp_mov(float v) { return __builtin_bit_cast(float, __builtin_amdgcn_update_dpp(0, __builtin_bit_cast(int, v), CTRL, 0xF, 0xF, true)); }
__device__ __forceinline__ float lx1(float v) { return dpp_mov<0xB1>(v); }
__device__ __forceinline__ float lx2(float v) { return dpp_mov<0x4E>(v); }
__device__ __forceinline__ float lx4(float v) { return dpp_mov<0x1B>(dpp_mov<0x141>(v)); }
__device__ __forceinline__ float lx8(float v) { return dpp_mov<0x141>(dpp_mov<0x140>(v)); }
__device__ __forceinline__ float lx16(float v) { return __shfl_xor(v, 16); }
__device__ __forceinline__ float lx32(float v) { const unsigned u = __builtin_bit_cast(unsigned, v); auto r = __builtin_amdgcn_permlane32_swap(u, u, false, false);
    return __builtin_bit_cast(float, (threadIdx.x & 32) ? r[0] : r[1]); }
__device__ __forceinline__ float wave_sum(float v) {
    v += lx1(v); v += lx2(v); v += lx4(v); v += lx8(v); v += lx16(v); v += lx32(v);
    return v;
}
using pg8::Unit;
typedef pg8::f32x4 (&AccRef)[2][2][4][2];

__device__ __forceinline__ v2u pack4(f32x4 v) { v2u w; w.x = pg8::cvt_pk_bf16(v[0], v[1]); w.y = pg8::cvt_pk_bf16(v[2], v[3]); return w; }
__device__ __forceinline__ float sigmoidf_(float v) { return __builtin_amdgcn_rcpf(1.f + __builtin_amdgcn_exp2f(-LOG2E * v)); }

template <class Dec> struct Strided {
    Dec d; int n, G, vcu;
    __device__ __forceinline__ bool next(int i, Unit& u) const { const int L = i * G + vcu; if (L >= n) return false; d(L, u); return true; }
};

struct DecInProj { const char* A; const char* B; int layer;
    __device__ __forceinline__ void operator()(int L, Unit& u) const {
        int pm, pn;
        if (L < 1024) { const int cg = L >> 8, rg = (L & 255) >> 5, w = L & 31; pm = rg * 8 + (w & 7); pn = cg * 4 + (w >> 3); }
        else if (L < 1216) { const int q = L - 1024, rg = q / 24, w = q % 24; pm = rg * 8 + (w & 7); pn = 16 + (w >> 3); }
        else { const int q = L - 1216; pm = 64 + (q & 7); pn = q >> 3; if (layer == DEPTH - 1) pn = pn ? 6 : 4; }
        u.A = A + (size_t)pm * 256 * (DM * 2); u.B = B + (size_t)pn * 256 * (DM * 2); u.arows = nullptr; u.ldA = DM * 2; u.ldB = DM * 2; u.nt = DM / 64; u.pm = pm; u.pn = pn; u.tag = 0;
    } };
constexpr int inproj_units(int layer) { return 1216 + (layer == DEPTH - 1 ? 16 : 152); }

struct EpiInProj {
    static constexpr bool PERM = true;
    bf16 *ABt, *ABtc, *Qg, *Kg, *Vg, *Qw, *Kw, *Vw, *G; const float* rope; const float* qng; const float* kng;
    __device__ __forceinline__ bool operator()(AccRef acc, const Unit& u, int wr, int wc, int fr, int fq) const {
        const int pm = u.pm, pn = u.pn; const bool lat = pm < 64;
        const int rowt = wr * 64 + fr;
        if (pn < 2) {
            bf16* dst; int ld;
            if (lat) { dst = ABt + ((size_t)(pm >> 3) * 256) * (2 * SEQ) + pn * SEQ + (pm & 7) * 256; ld = 2 * SEQ; }
            else { dst = ABtc + ((size_t)(pm - 64) * 256) * (2 * CTX) + pn * CTX; ld = 2 * CTX; }
#pragma unroll
            for (int ai = 0; ai < 2; ++ai)
#pragma unroll
                for (int m = 0; m < 4; ++m) { const int tok = rowt + ai * 128 + m * 16;
#pragma unroll
                    for (int bj = 0; bj < 2; ++bj)
#pragma unroll
                        for (int n = 0; n < 2; ++n) { const int c = bj * 128 + wc * 32 + fq * 8 + n * 4; const pg8::f32x4 v = acc[ai][bj][m][n];
#pragma unroll
                            for (int j = 0; j < 4; ++j) dst[(size_t)(c + j) * ld + tok] = (bf16)f2bf(v[j]); } }
        } else if (pn < 7) {
            bf16* dst; int ld; const float* ng = nullptr; bool rope_on = false; float sc = 1.f;
            if (pn <= 3)      { dst = Qg + (pn - 2) * 256 + wc * 64; ld = 512; ng = qng; rope_on = lat; sc = QSCALE; }
            else if (pn == 4) { if (wc < 2) { dst = Kg + wc * 64; ng = kng; rope_on = lat; } else { dst = Vg + (wc - 2) * 64; } ld = 128; }
            else if (pn == 5) { dst = Qw + wc * 64; ld = 256; rope_on = lat; sc = QSCALE; }
            else              { if (wc < 2) { dst = Kw + wc * 64; rope_on = lat; } else { dst = Vw + (wc - 2) * 64; } ld = 128; }
#pragma unroll
            for (int ai = 0; ai < 2; ++ai)
#pragma unroll
                for (int m = 0; m < 4; ++m) {
                    const int row = pm * 256 + rowt + ai * 128 + m * 16;
                    pg8::f32x4 v[2][2];
                    float ss = 0.f;
#pragma unroll
                    for (int bj = 0; bj < 2; ++bj)
#pragma unroll
                        for (int n = 0; n < 2; ++n) { v[bj][n] = acc[ai][bj][m][n]; ss += (v[bj][n][0] * v[bj][n][0] + v[bj][n][1] * v[bj][n][1]) + (v[bj][n][2] * v[bj][n][2] + v[bj][n][3] * v[bj][n][3]); }
                    float r = sc;
                    if (ng) { ss += __shfl_xor(ss, 16); ss += __shfl_xor(ss, 32); r = sc * rsqrtf(ss * (1.f / 64.f) + EPS); }
                    const int t = row & (SEQ - 1);
#pragma unroll
                    for (int bj = 0; bj < 2; ++bj) { v2u o[2];
#pragma unroll
                        for (int n = 0; n < 2; ++n) {
                            pg8::f32x4 x = v[bj][n] * r; if (ng) x = x * *(const pg8::f32x4*)(ng + bj * 32 + fq * 8 + n * 4);
                            if (rope_on) {
                                const int pos = bj ? (t & 63) : (t >> 6);
                                const pg8::f32x4 cs = *(const pg8::f32x4*)(rope + ((size_t)pos * 16 + fq * 4 + n * 2) * 2);
                                x = (pg8::f32x4){x[0] * cs[0] - x[1] * cs[1], x[0] * cs[1] + x[1] * cs[0], x[2] * cs[2] - x[3] * cs[3], x[2] * cs[3] + x[3] * cs[2]};
                            }
                            o[n] = pack4(x);
                        }
                        *(v4u*)(dst + (size_t)row * ld + bj * 32 + fq * 8) = (v4u){o[0].x, o[0].y, o[1].x, o[1].y}; }
                    asm volatile("" ::: "memory");
                }
        } else {
            bf16* dst = G + ((size_t)pm * 12 + (pn - 7)) * 65536 + (size_t)(((wr * 4 + wc) * 64 + fq * 16 + fr) * 8);
#pragma unroll
            for (int ai = 0; ai < 2; ++ai)
#pragma unroll
                for (int bj = 0; bj < 2; ++bj)
#pragma unroll
                    for (int m = 0; m < 4; ++m) { const pg8::f32x4 a = acc[ai][bj][m][0], b = acc[ai][bj][m][1];
                        const v2u lo = pack4((pg8::f32x4){sigmoidf_(a[0]), sigmoidf_(a[1]), sigmoidf_(a[2]), sigmoidf_(a[3])}), hi = pack4((pg8::f32x4){sigmoidf_(b[0]), sigmoidf_(b[1]), sigmoidf_(b[2]), sigmoidf_(b[3])});
                        *(v4u*)(dst + (size_t)(((ai * 2 + bj) * 4 + m) * 4096)) = (v4u){lo.x, lo.y, hi.x, hi.y}; }
        }
        return false;
    }
};

struct EpiStore { static constexpr bool PERM = true; bf16* O; int ld;
    __device__ __forceinline__ bool operator()(AccRef acc, const Unit& u, int wr, int wc, int fr, int fq) const {
        bf16* dst = O + ((size_t)u.pm * 256 + wr * 64 + fr) * ld + u.pn * 256 + wc * 32 + fq * 8;
#pragma unroll
        for (int ai = 0; ai < 2; ++ai)
#pragma unroll
            for (int m = 0; m < 4; ++m)
#pragma unroll
                for (int bj = 0; bj < 2; ++bj) { const v2u o0 = pack4(acc[ai][bj][m][0]), o1 = pack4(acc[ai][bj][m][1]);
                    *(v4u*)(dst + (size_t)(ai * 128 + m * 16) * ld + bj * 128) = (v4u){o0.x, o0.y, o1.x, o1.y}; }
        return false;
    } };
struct DecDft { const char* Dm; const char* Dc; const char* ABt; const char* ABtc;
    __device__ __forceinline__ void operator()(int L, Unit& u) const {
        if (L < 64) { const int b = L >> 3, mt = L & 7; u.A = Dm + (size_t)mt * 256 * (4 * SEQ); u.B = ABt + (size_t)b * 256 * (4 * SEQ); u.ldA = 4 * SEQ; u.ldB = 4 * SEQ; u.nt = 2 * SEQ / 64; u.pm = L; }
        else { const int b = L - 64; u.A = Dc; u.B = ABtc + (size_t)b * 256 * (4 * CTX); u.ldA = 4 * CTX; u.ldB = 4 * CTX; u.nt = 2 * CTX / 64; u.pm = 64 + b; }
        u.pn = 0; u.tag = 0; u.arows = nullptr;
    } };

struct SchedMerge { const char* BR; const char* W; int ntiles, G, vcu;
    __device__ __forceinline__ bool next(int i, Unit& u) const {
        const int round = i / 3, tag = i - round * 3, tile = round * G + vcu; if (tile >= ntiles) return false;
        const int pm = tile >> 2, pn = tile & 3, koff = tag == 0 ? 0 : (tag == 1 ? 256 : 768);
        u.A = BR + (size_t)pm * 256 * (DM * 2) + koff * 2; u.B = W + (size_t)pn * 256 * (DM * 2) + koff * 2; u.arows = nullptr; u.ldA = DM * 2; u.ldB = DM * 2; u.nt = tag == 1 ? 8 : 4; u.pm = pm; u.pn = pn; u.tag = tag;
        return true;
    } };
struct EpiMerge { static constexpr bool PERM = true; const bf16* G; bf16* Mb; int probe;
    __device__ __forceinline__ bool operator()(AccRef acc, const Unit& u, int wr, int wc, int fr, int fq) const {
        const size_t row0 = (size_t)u.pm * 256 + wr * 64 + fr; const int col0 = u.pn * 256 + wc * 32 + fq * 8; const int tag = u.tag;
        const bf16* g0 = G + ((size_t)u.pm * 12 + tag * 4 + u.pn) * 65536 + (size_t)(((wr * 4 + wc) * 64 + fq * 16 + fr) * 8);
#pragma unroll
        for (int ai = 0; ai < 2; ++ai)
#pragma unroll
            for (int bj = 0; bj < 2; ++bj) {
#pragma unroll
                for (int m = 0; m < 4; ++m) { const size_t fo = (size_t)(((ai * 2 + bj) * 4 + m) * 4096);
                    const v4u gw = probe == 2 ? (v4u){0x3f803f80u, 0x3f803f80u, 0x3f803f80u, 0x3f803f80u} : *(const v4u*)(g0 + fo);
                    pg8::f32x4 ga = {bflo(gw.x), bfhi(gw.x), bflo(gw.y), bfhi(gw.y)}, gb = {bflo(gw.z), bfhi(gw.z), bflo(gw.w), bfhi(gw.w)};
                    if (tag < 2) { const v4u hw = probe == 2 ? (v4u){0x3f803f80u, 0x3f803f80u, 0x3f803f80u, 0x3f803f80u} : *(const v4u*)(g0 + 4 * 65536 + fo);
                        ga = (pg8::f32x4){ga[0] * __builtin_amdgcn_rcpf(bflo(hw.x)), ga[1] * __builtin_amdgcn_rcpf(bfhi(hw.x)), ga[2] * __builtin_amdgcn_rcpf(bflo(hw.y)), ga[3] * __builtin_amdgcn_rcpf(bfhi(hw.y))};
                        gb = (pg8::f32x4){gb[0] * __builtin_amdgcn_rcpf(bflo(hw.z)), gb[1] * __builtin_amdgcn_rcpf(bfhi(hw.z)), gb[2] * __builtin_amdgcn_rcpf(bflo(hw.w)), gb[3] * __builtin_amdgcn_rcpf(bfhi(hw.w))};
                        acc[ai][bj][m][0] = acc[ai][bj][m][0] * ga; acc[ai][bj][m][1] = acc[ai][bj][m][1] * gb; }
                    else { const size_t row = row0 + ai * 128 + m * 16; const int c = col0 + bj * 128;
                        const v2u o0 = pack4(acc[ai][bj][m][0] * ga), o1 = pack4(acc[ai][bj][m][1] * gb); *(v4u*)(Mb + row * DM + c) = (v4u){o0.x, o0.y, o1.x, o1.y}; } }
                asm volatile("" ::: "memory"); }
        return tag < 2;
    } };

struct DecWout { const char* Mb; const char* W;
    __device__ __forceinline__ void operator()(int L, Unit& u) const { const int pm = L >> 2, pn = L & 3;
        u.A = Mb + (size_t)pm * 256 * (DM * 2); u.B = W + (size_t)pn * 256 * (DM * 2); u.arows = nullptr; u.ldA = DM * 2; u.ldB = DM * 2; u.nt = DM / 64; u.pm = pm; u.pn = pn; u.tag = 0; } };
struct EpiWout { static constexpr bool PERM = true; const float* baseL; const float* baseC; const bf16* baseX; bf16* X; const float* mod; int from_x;
    __device__ __forceinline__ bool operator()(AccRef acc, const Unit& u, int wr, int wc, int fr, int fq) const {
        const int pm = u.pm; const float* base = pm < 64 ? baseL : baseC; const float* g1 = mod + (size_t)(pm < 64 ? (pm >> 3) : 8) * (6 * DM) + 2 * DM;
        const size_t row0 = (size_t)pm * 256 + wr * 64 + fr; const int col0 = u.pn * 256 + wc * 32 + fq * 8;
#pragma unroll
        for (int bj = 0; bj < 2; ++bj) { const int c = col0 + bj * 128; const pg8::f32x4 gv0 = *(const pg8::f32x4*)(g1 + c), gv1 = *(const pg8::f32x4*)(g1 + c + 4);
#pragma unroll
            for (int ai = 0; ai < 2; ++ai)
#pragma unroll
                for (int m = 0; m < 4; ++m) { const size_t off = (row0 + ai * 128 + m * 16) * DM + c; pg8::f32x4 b0, b1;
                    if (from_x) { const v4u w = *(const v4u*)(baseX + off); b0 = (pg8::f32x4){bflo(w.x), bfhi(w.x), bflo(w.y), bfhi(w.y)}; b1 = (pg8::f32x4){bflo(w.z), bfhi(w.z), bflo(w.w), bfhi(w.w)}; }
                    else { b0 = *(const pg8::f32x4*)(base + off); b1 = *(const pg8::f32x4*)(base + off + 4); }
                    const v2u o0 = pack4(b0 + gv0 * acc[ai][bj][m][0]), o1 = pack4(b1 + gv1 * acc[ai][bj][m][1]);
                    *(v4u*)(X + off) = (v4u){o0.x, o0.y, o1.x, o1.y}; } }
        return false;
    } };

struct DecGU { const char* H2; const int* IDX; const char* W; int nrt;
    __device__ __forceinline__ void operator()(int L, Unit& u) const { const int per = nrt * 8, e = L / per, q = L - e * per, ct = q & 7, rt = q >> 3;
        u.A = H2; u.arows = IDX + (size_t)e * RPE + rt * 256; u.B = W + ((size_t)e * 2 * DM + ct * 256) * (DM * 2); u.ldA = DM * 2; u.ldB = DM * 2; u.nt = DM / 64; u.pm = rt; u.pn = ct; u.tag = e; } };
struct EpiGU { static constexpr bool PERM = true; bf16* H;
    __device__ __forceinline__ bool operator()(AccRef acc, const Unit& u, int wr, int wc, int fr, int fq) const {
        bf16* dst = H + ((size_t)u.tag * RPE + u.pm * 256 + wr * 64 + fr) * DM + u.pn * 128 + wc * 32 + fq * 8;
#pragma unroll
        for (int ai = 0; ai < 2; ++ai)
#pragma unroll
            for (int m = 0; m < 4; ++m) { v2u o[2];
#pragma unroll
                for (int n = 0; n < 2; ++n) { const pg8::f32x4 a = acc[ai][0][m][n], up = acc[ai][1][m][n];
                    o[n] = pack4((pg8::f32x4){a[0] * sigmoidf_(a[0]) * up[0], a[1] * sigmoidf_(a[1]) * up[1], a[2] * sigmoidf_(a[2]) * up[2], a[3] * sigmoidf_(a[3]) * up[3]}); }
                *(v4u*)(dst + (size_t)(ai * 128 + m * 16) * DM) = (v4u){o[0].x, o[0].y, o[1].x, o[1].y}; }
        return false;
    } };
struct DecDown { const char* H; const char* W; int nrt;
    __device__ __forceinline__ void operator()(int L, Unit& u) const { const int per = nrt * 4, e = L / per, q = L - e * per, ct = q & 3, rt = q >> 2;
        u.A = H + ((size_t)e * RPE + rt * 256) * (DM * 2); u.arows = nullptr; u.B = W + ((size_t)e * DM + ct * 256) * (DM * 2); u.ldA = DM * 2; u.ldB = DM * 2; u.nt = DM / 64; u.pm = rt; u.pn = ct; u.tag = e; } };
struct EpiDown { static constexpr bool PERM = true; bf16* Y; const float* afs;
    __device__ __forceinline__ bool operator()(AccRef acc, const Unit& u, int wr, int wc, int fr, int fq) const {
        const size_t r0 = (size_t)u.tag * RPE + u.pm * 256 + wr * 64 + fr;
#pragma unroll
        for (int ai = 0; ai < 2; ++ai)
#pragma unroll
            for (int m = 0; m < 4; ++m) { const size_t r = r0 + ai * 128 + m * 16; const float a = afs[r];
#pragma unroll
                for (int bj = 0; bj < 2; ++bj) { const v2u o0 = pack4(acc[ai][bj][m][0] * a), o1 = pack4(acc[ai][bj][m][1] * a);
                    *(v4u*)(Y + r * DM + u.pn * 256 + bj * 128 + wc * 32 + fq * 8) = (v4u){o0.x, o0.y, o1.x, o1.y}; } }
        return false;
    } };
struct Frame {
    LAS unsigned char* lds; char* ldsg; volatile LAS unsigned* MISC; gu32* ctl;
    int vcu, G;
    unsigned char* ws; unsigned char* dout; float* out;
};
constexpr int PTRS_OFF = LDSCTL_OFF + 512;
enum { IN_X = 0, IN_C, IN_CTX, IN_CCTX, IN_WADA, IN_BADA, IN_NORM1G, IN_WIN, IN_QNG, IN_KNG, IN_SINK, IN_WBRF, IN_WBRG, IN_WBRW, IN_WOUT, IN_NORM2G, IN_WROUTER, IN_WGATE, IN_WUP, IN_WDOWN, IN_FINALG };
__device__ __forceinline__ const float* inptr(const Frame& F, int k) {
    const unsigned long long v = *(const LAS unsigned long long*)(F.lds + PTRS_OFF + 8 * k);
    const unsigned lo = __builtin_amdgcn_readfirstlane((unsigned)v), hi = __builtin_amdgcn_readfirstlane((unsigned)(v >> 32));
    return (const float*)(((unsigned long long)hi << 32) | lo);
}
#define WSP(T, off) ((T*)(F.ws + (off)))

constexpr int COSTAB_OFF = LDSCTL_OFF + 1024;
static_assert(COSTAB_OFF + 8192 <= LDS_BYTES, "cos table fits");
__device__ __forceinline__ void transpose_item(const float* W, int ldw, int k0, int n0, bf16* WT, int drow0, int dld, int dk0, int lane) {
    const int g = lane >> 3, n4 = (lane & 7) * 4;
    const float* src = W + (size_t)(k0 + 8 * g) * ldw + n0 + n4;
    f32x4 v[8];
#pragma unroll
    for (int i = 0; i < 8; ++i) v[i] = *(const GAS f32x4*)(src + (size_t)i * ldw);
    bf16* dst = WT + (size_t)(drow0 + n4) * dld + dk0 + k0 + 8 * g;
#pragma unroll
    for (int j = 0; j < 4; ++j) { v4u o; o.x = pk2(v[0][j], v[1][j]); o.y = pk2(v[2][j], v[3][j]); o.z = pk2(v[4][j], v[5][j]); o.w = pk2(v[6][j], v[7][j]);
        *(GAS v4u*)(dst + (size_t)j * dld) = o; }
}
__device__ __forceinline__ void transpose_item2(const float* W, int ldw, int k0, int n0, bf16* WT, int drow0, int dld, int lane) {
    const int g = lane >> 3, n4 = (lane & 7) * 4;
    const float* src = W + (size_t)(k0 + 8 * g) * ldw + n0 + n4;
    f32x4 v[2][8];
#pragma unroll
    for (int h = 0; h < 2; ++h)
#pragma unroll
        for (int i = 0; i < 8; ++i) v[h][i] = __builtin_nontemporal_load((const GAS f32x4*)(src + (size_t)(h * 64 + i) * ldw));
    bf16* dst = WT + (size_t)(drow0 + n4) * dld + k0 + 8 * g;
#pragma unroll
    for (int h = 0; h < 2; ++h)
#pragma unroll
        for (int j = 0; j < 4; ++j) { v4u o; o.x = pk2(v[h][0][j], v[h][1][j]); o.y = pk2(v[h][2][j], v[h][3][j]); o.z = pk2(v[h][4][j], v[h][5][j]); o.w = pk2(v[h][6][j], v[h][7][j]);
            __builtin_nontemporal_store(o, (GAS v4u*)(dst + (size_t)j * dld + h * 64)); }
}
__device__ __forceinline__ void fold_item(const float* W, int k0, int g, int sinmode, bf16* WT, int drow0, LAS float* scr, const LAS float* ctab, int lane) {
#pragma unroll
    for (int kk = 0; kk < 16; ++kk) scr[lane * 20 + kk] = W[(size_t)(k0 + kk) * INW + g * 64 + lane];
    LDS_WAIT(); asm volatile("" ::: "memory");
    float acc[16];
#pragma unroll
    for (int k = 0; k < 16; ++k) acc[k] = 0.f;
#pragma unroll 4
    for (int c = 0; c < 64; ++c) {
        const int r = (c * lane) & 63;
        const float tv = sinmode ? -ctab[((r - 16) & 63) * 32] : ctab[r * 32];
#pragma unroll
        for (int k4 = 0; k4 < 4; ++k4) { const f32x4 w = *(const LAS f32x4*)(scr + c * 20 + 4 * k4);
            acc[4 * k4] = fmaf(w[0], tv, acc[4 * k4]); acc[4 * k4 + 1] = fmaf(w[1], tv, acc[4 * k4 + 1]); acc[4 * k4 + 2] = fmaf(w[2], tv, acc[4 * k4 + 2]); acc[4 * k4 + 3] = fmaf(w[3], tv, acc[4 * k4 + 3]); }
    }
    GAS v4u* dst = (GAS v4u*)(WT + (size_t)(drow0 + lane) * DM + k0);
#pragma unroll
    for (int q = 0; q < 2; ++q) { v4u o; o.x = pk2(acc[8 * q], acc[8 * q + 1]); o.y = pk2(acc[8 * q + 2], acc[8 * q + 3]); o.z = pk2(acc[8 * q + 4], acc[8 * q + 5]); o.w = pk2(acc[8 * q + 6], acc[8 * q + 7]); dst[q] = o; }
    LDS_WAIT(); asm volatile("" ::: "memory");
}

#ifndef CONV_IN_ATTN
#define CONV_IN_ATTN 0
#endif
constexpr int CONV_WAVE_ITEMS = DEPTH * NE * 768, CONV_ITEMS = CONV_WAVE_ITEMS / NWAVES, CONV_ITEMS_L0 = CONV_ITEMS / DEPTH;
__device__ __forceinline__ void conv_wave_item(Frame& F, int r, int lane) {
    const int le = r / 768, q = r % 768, which = q / 256, qq = q % 256, kb = qq >> 5, nb = qq & 31, f0 = nb * 32;
    if (which < 2) transpose_item2((which ? inptr(F, IN_WUP) : inptr(F, IN_WGATE)) + (size_t)le * DM * DM, DM, kb * 128, f0, WSP(bf16, WS_WGU) + (size_t)le * 2 * DM * DM, (f0 >> 7) * 256 + which * 128 + (f0 & 127), DM, lane);
    else transpose_item2(inptr(F, IN_WDOWN) + (size_t)le * DM * DM, DM, kb * 128, f0, WSP(bf16, WS_WD) + (size_t)le * DM * DM, f0, DM, lane);
}
__device__ __forceinline__ void tail_convert(Frame& F, int idx, int first, int per, int end) {
    int tid_ = threadIdx.x; asm volatile("" : "+v"(tid_));
    const int lane = tid_ & 63, wave_ = __builtin_amdgcn_readfirstlane(tid_ >> 6);
    for (int t = 0; t < per; ++t) { const int it = first + idx * per + t; if (it >= end) break; conv_wave_item(F, it * NWAVES + wave_, lane); }
}

__device__ __forceinline__ void p0_prologue(Frame& F, int mode = 0) {
    int tid_ = threadIdx.x; asm volatile("" : "+v"(tid_));
    const int lane = tid_ & 63, wave_ = __builtin_amdgcn_readfirstlane(tid_ >> 6);
    const int gw = F.vcu * NWAVES + wave_, NGW = F.G * NWAVES;
    LAS float* st = (LAS float*)F.lds;
    LAS float* red = (LAS float*)(F.lds + 40960);
    LAS float* ctab = (LAS float*)(F.lds + COSTAB_OFF);
    { const float* cp = inptr(F, IN_C); const float* ccp = inptr(F, IN_CCTX);
#pragma unroll 6
      for (int i = tid_; i < 9 * DM; i += NWAVES * 64) { const int s = i / DM, k = i - s * DM; const float v = s < 8 ? cp[s * DM + k] : ccp[k]; st[i] = v / (1.f + expf(-v)); } }
    for (int i = tid_; i < 2048; i += NWAVES * 64) ctab[i] = cosf(6.283185307179586f * (float)i * (1.f / 2048.f));
    __syncthreads();
    const float* bada = inptr(F, IN_BADA);
    if (mode != 2) for (int it = F.vcu; it < DEPTH * 96; it += F.G) {
        const int l = it / 96, j = (it % 96) * 64 + lane, kb = wave_ * 128;
        const float* W = inptr(F, IN_WADA) + (size_t)l * DM * 6 * DM + (size_t)kb * 6 * DM + j;
        float acc[9];
#pragma unroll
        for (int s = 0; s < 9; ++s) acc[s] = 0.f;
        for (int k0 = 0; k0 < 128; k0 += 16) {
            float w[16];
#pragma unroll
            for (int i = 0; i < 16; ++i) w[i] = W[(size_t)(k0 + i) * 6 * DM];
#pragma unroll
            for (int i = 0; i < 16; ++i)
#pragma unroll
                for (int s = 0; s < 9; ++s) acc[s] = fmaf(st[s * DM + kb + k0 + i], w[i], acc[s]);
        }
#pragma unroll
        for (int s = 0; s < 9; ++s) red[(wave_ * 9 + s) * 64 + lane] = acc[s];
        __syncthreads();
        for (int o = tid_; o < 9 * 64; o += NWAVES * 64) { float v = 0.f;
#pragma unroll
            for (int w = 0; w < 8; ++w) v += red[w * 576 + o];
            const int s = o >> 6, jj = (it % 96) * 64 + (o & 63);
            WSP(float, WS_MOD)[((size_t)l * 9 + s) * 6 * DM + jj] = v + bada[l * 6 * DM + jj]; }
        __syncthreads();
    }
    __syncthreads();
#ifdef DBG_POISON
    {
        const size_t n16 = (WS_END - WS_X) / 16, m16 = ((size_t)NLAT * DM * 4) / 16; const v4u pz = {0xFFFFFFFFu, 0xFFFFFFFFu, 0xFFFFFFFFu, 0xFFFFFFFFu};
        for (size_t i = (size_t)gw * 64 + lane; i < n16; i += (size_t)NGW * 64) ((GAS v4u*)(F.ws + WS_X))[i] = pz;
        for (size_t i = (size_t)gw * 64 + lane; i < m16; i += (size_t)NGW * 64) ((GAS v4u*)F.dout)[i] = pz;
    }
#endif
    LAS float* scr = (LAS float*)(F.lds + wave_ * 16384);
    constexpr int T_A = DEPTH * 2176, T_B = DEPTH * 512, T_C = DEPTH * 512, T_D = DEPTH * 512, T_E = DEPTH * NE * 768, T_F = SEQ + CTX, T_G = 1;
    constexpr int NITEMS = T_A + T_B + T_C + T_D + T_E + T_F + T_G;
    if (mode != 1 && mode != 5 && mode != 6) for (int it = gw; it < NITEMS; it += NGW) {
        int r = it;
        if (r < T_A) { const int l = r / 2176, q = r % 2176, kb = q / 136, nb = q % 136, s0 = 256 + nb * 32;
            int drow; if (s0 < 1536) { const int tile = 2 + ((s0 - 256) >> 8), hh = ((s0 - 256) & 255) >> 6, dh = (s0 & 63) >> 5; drow = tile * 256 + dh * 128 + hh * 32; } else drow = s0 + 256;
            transpose_item(inptr(F, IN_WIN) + (size_t)l * DM * INW, INW, kb * 64, s0, WSP(bf16, WS_WIN) + (size_t)l * INW2 * DM, drow, DM, 0, lane); continue; } r -= T_A;
        if (r < T_B) { const int l = r / 512, q = r % 512, kq = q & 3, kb = (q >> 2) >> 3, g = ((q >> 2) >> 1) & 3, sm = (q >> 2) & 1;
            fold_item(inptr(F, IN_WIN) + (size_t)l * DM * INW, kb * 64 + kq * 16, g, sm, WSP(bf16, WS_WIN) + (size_t)l * INW2 * DM, sm * 256 + g * 64, scr, ctab, lane); continue; } r -= T_B;
        if (r < T_C) { const int l = r / 512, q = r % 512; const float* W; int kb, koff;
            if (q < 128) { W = inptr(F, IN_WBRF) + (size_t)l * 256 * DM; kb = q >> 5; koff = 0; } else if (q < 384) { W = inptr(F, IN_WBRG) + (size_t)l * 512 * DM; kb = (q - 128) >> 5; koff = 256; } else { W = inptr(F, IN_WBRW) + (size_t)l * 256 * DM; kb = (q - 384) >> 5; koff = 768; }
            const int nb = q & 31;
            transpose_item(W, DM, kb * 64, nb * 32, WSP(bf16, WS_WBR) + (size_t)l * DM * DM, nb * 32, DM, koff, lane); continue; } r -= T_C;
        if (r < T_D) { const int l = r / 512, q = r % 512, kb = q >> 5, nb = q & 31;
            transpose_item(inptr(F, IN_WOUT) + (size_t)l * DM * DM, DM, kb * 64, nb * 32, WSP(bf16, WS_WOUT) + (size_t)l * DM * DM, nb * 32, DM, 0, lane); continue; } r -= T_D;
        if (r < T_E) { if (F.G != 256) conv_wave_item(F, r, lane); continue; } r -= T_E;
        if (r < T_F) {
            const bool big = r < SEQ; const int N = big ? SEQ : CTX, k = big ? r : r - SEQ, sh = big ? 0 : 3; const float sc = 1.f / sqrtf(64.f * (float)N);
            bf16* row = (big ? WSP(bf16, WS_DFT) : WSP(bf16, WS_DFTC)) + (size_t)k * 2 * N;
            for (int n = 2 * lane; n < N; n += 128) {
                const int r0 = (k * n) & (N - 1), r1 = (k * (n + 1)) & (N - 1);
                *(GAS unsigned*)(row + n) = pk2(ctab[r0 << sh] * sc, ctab[r1 << sh] * sc);
                *(GAS unsigned*)(row + N + n) = pk2(ctab[((r0 - (N >> 2)) & (N - 1)) << sh] * sc, ctab[((r1 - (N >> 2)) & (N - 1)) << sh] * sc); }
            continue; } r -= T_F;
        {
            for (int i = lane; i < 64 * 16; i += 64) { const int pos = i >> 4, f = i & 15; const float inv = powf(10000.f, -(float)(2 * f) / 32.f), ang = (float)pos * inv;
                WSP(float, WS_ROPE)[2 * i] = cosf(ang); WSP(float, WS_ROPE)[2 * i + 1] = sinf(ang); }
        }
    }
}

__device__ __forceinline__ void norm_row(f32x4 (&v)[4], const float* gain, const float* shift, const float* scale, int lane) {
    float ss = 0.f;
#pragma unroll
    for (int j = 0; j < 4; ++j) ss += (v[j][0] * v[j][0] + v[j][1] * v[j][1]) + (v[j][2] * v[j][2] + v[j][3] * v[j][3]);
    const float r = rsqrtf(wave_sum(ss) * (1.f / DM) + EPS);
#pragma unroll
    for (int j = 0; j < 4; ++j) { const f32x4 g = *(const f32x4*)(gain + 4 * lane + 256 * j); f32x4 y = v[j] * r * g;
        if (shift) { const f32x4 sh = *(const f32x4*)(shift + 4 * lane + 256 * j), sc = *(const f32x4*)(scale + 4 * lane + 256 * j); y = y * (sc + 1.f) + sh; }
        v[j] = y; }
}
__device__ __forceinline__ void store_row_bf16(bf16* orow, const f32x4 (&v)[4], int lane) {
    GAS v2u* o8 = (GAS v2u*)orow + lane;
#pragma unroll
    for (int j = 0; j < 4; ++j) { v2u w; w.x = pg8::cvt_pk_bf16(v[j][0], v[j][1]); w.y = pg8::cvt_pk_bf16(v[j][2], v[j][3]); o8[64 * j] = w; }
}
__device__ __forceinline__ int row_modset(int r) { return r < NLAT ? (r >> 11) : 8; }
struct ModVec { f32x4 g[4], sh[4], sc[4]; };
__device__ __forceinline__ void load_modvec(ModVec& m, const float* gain, const float* shift, const float* scale, int lane) {
#pragma unroll
    for (int j = 0; j < 4; ++j) { m.g[j] = *(const f32x4*)(gain + 4 * lane + 256 * j);
        if (shift) { m.sh[j] = *(const f32x4*)(shift + 4 * lane + 256 * j); m.sc[j] = *(const f32x4*)(scale + 4 * lane + 256 * j); } else { m.sh[j] = (f32x4){0.f, 0.f, 0.f, 0.f}; m.sc[j] = (f32x4){0.f, 0.f, 0.f, 0.f}; } }
}
__device__ __forceinline__ void norm_row_m(f32x4 (&v)[4], const ModVec& m) {
    float ss = 0.f;
#pragma unroll
    for (int j = 0; j < 4; ++j) ss += (v[j][0] * v[j][0] + v[j][1] * v[j][1]) + (v[j][2] * v[j][2] + v[j][3] * v[j][3]);
    const float r = rsqrtf(wave_sum(ss) * (1.f / DM) + EPS);
#pragma unroll
    for (int j = 0; j < 4; ++j) v[j] = (v[j] * r * m.g[j]) * (m.sc[j] + 1.f) + m.sh[j];
}
__device__ __forceinline__ void load_row_bf16(f32x4 (&v)[4], const bf16* row, int lane) {
    const GAS v2u* i8 = (const GAS v2u*)row + lane;
#pragma unroll
    for (int j = 0; j < 4; ++j) { const v2u w = i8[64 * j]; v[j] = (f32x4){bflo(w.x), bfhi(w.x), bflo(w.y), bfhi(w.y)}; }
}
__device__ __forceinline__ void load_row_f32(f32x4 (&v)[4], const float* row, int lane) {
#pragma unroll
    for (int j = 0; j < 4; ++j) v[j] = *(const f32x4*)(row + 4 * lane + 256 * j);
}

__device__ __forceinline__ void p1_norm1(Frame& F) {
    int tid_ = threadIdx.x; asm volatile("" : "+v"(tid_));
    const int lane = tid_ & 63, wave_ = __builtin_amdgcn_readfirstlane(tid_ >> 6);
    const int gw = F.vcu * NWAVES + wave_, NGW = F.G * NWAVES, rpw = (NTOK + NGW - 1) / NGW, r0 = gw * rpw, r1 = r0 + rpw < NTOK ? r0 + rpw : NTOK;
    const float* xin = inptr(F, IN_X); const float* cin = inptr(F, IN_CTX) - (size_t)NLAT * DM; const float* g1 = inptr(F, IN_NORM1G);
#define P1_ROW(r) (((r) < NLAT ? xin : cin) + (size_t)(r) * DM)
    f32x4 va[4], vb[4]; ModVec m; int cset = -1;
    if (r0 < r1) load_row_f32(va, P1_ROW(r0), lane);
    if (r0 + 1 < r1) load_row_f32(vb, P1_ROW(r0 + 1), lane);
    for (int r = r0; r < r1; ++r) {
        f32x4 v[4];
#pragma unroll
        for (int j = 0; j < 4; ++j) { v[j] = va[j]; va[j] = vb[j]; }
        if (r + 2 < r1) load_row_f32(vb, P1_ROW(r + 2), lane);
        const int set = row_modset(r);
        if (set != cset) { const float* mod = WSP(float, WS_MOD) + (size_t)set * 6 * DM; load_modvec(m, g1, mod, mod + DM, lane); cset = set; }
        norm_row_m(v, m);
        store_row_bf16(WSP(bf16, WS_HN) + (size_t)r * DM, v, lane);
    }
#undef P1_ROW
}
__device__ __forceinline__ void router_finish(const float (&a16)[NE], int r, int lane, float* AFF) {
    float b8[8], b4[4], b2[2], lg;
    { const bool hi = lane & 32;
#pragma unroll
      for (int i = 0; i < 8; ++i) { const float keep = hi ? a16[i + 8] : a16[i], send = hi ? a16[i] : a16[i + 8]; b8[i] = keep + lx32(send); } }
    { const bool hi = lane & 16;
#pragma unroll
      for (int i = 0; i < 4; ++i) { const float keep = hi ? b8[i + 4] : b8[i], send = hi ? b8[i] : b8[i + 4]; b4[i] = keep + lx16(send); } }
    { const bool hi = lane & 8;
#pragma unroll
      for (int i = 0; i < 2; ++i) { const float keep = hi ? b4[i + 2] : b4[i], send = hi ? b4[i] : b4[i + 2]; b2[i] = keep + lx8(send); } }
    { const bool hi = lane & 4; const float keep = hi ? b2[1] : b2[0], send = hi ? b2[0] : b2[1]; lg = keep + lx4(send); }
    lg += lx2(lg); lg += lx1(lg);
    float mx = lg;
    mx = fmaxf(mx, lx4(mx)); mx = fmaxf(mx, lx8(mx)); mx = fmaxf(mx, lx16(mx)); mx = fmaxf(mx, lx32(mx));
    const float ex = expf(lg - mx); float sum = ex;
    sum += lx4(sum); sum += lx8(sum); sum += lx16(sum); sum += lx32(sum);
    const int set = r < NLAT ? (r >> 11) : 8 + ((r - NLAT) >> 8), n = r < NLAT ? (r & (SEQ - 1)) : ((r - NLAT) & (CTX - 1));
    if ((lane & 3) == 0) AFF[((size_t)set * NE + ((lane >> 2) & 15)) * SEQ + n] = ex / sum;
}
__device__ __forceinline__ void pf_norm2_router(Frame& F, int l, int mode = 0) {
    int tid_ = threadIdx.x; asm volatile("" : "+v"(tid_));
    const int lane = tid_ & 63, wave_ = __builtin_amdgcn_readfirstlane(tid_ >> 6);
    const int gw = F.vcu * NWAVES + wave_, NGW = F.G * NWAVES;
    LAS float* wrT = (LAS float*)F.lds;
    { const float* wr = inptr(F, IN_WROUTER) + (size_t)l * DM * NE;
#pragma unroll 8
      for (int i = tid_; i < DM * NE; i += NWAVES * 64) { const int k = i >> 4, e = i & 15; wrT[e * DM + k] = wr[i]; } }
    __syncthreads();
    const int nrows = (l == DEPTH - 1) ? NLAT : NTOK, rpw = (nrows + NGW - 1) / NGW, r0 = gw * rpw, r1 = r0 + rpw < nrows ? r0 + rpw : nrows;
    const bf16* X = WSP(bf16, WS_X); const float* g2n = inptr(F, IN_NORM2G) + l * DM; float* AFF = WSP(float, WS_AFF);
    f32x4 va[4], vb[4]; ModVec m; int cset = -1;
    if (r0 < r1) load_row_bf16(va, X + (size_t)r0 * DM, lane);
    if (r0 + 1 < r1) load_row_bf16(vb, X + (size_t)(r0 + 1) * DM, lane);
    for (int r = r0; r < r1; ++r) {
        f32x4 v[4];
#pragma unroll
        for (int j = 0; j < 4; ++j) { v[j] = va[j]; va[j] = vb[j]; }
        if (r + 2 < r1) load_row_bf16(vb, X + (size_t)(r + 2) * DM, lane);
        const int mset = row_modset(r);
        if (mset != cset) { const float* mod = WSP(float, WS_MOD) + ((size_t)l * 9 + mset) * 6 * DM; load_modvec(m, g2n, mod + 3 * DM, mod + 4 * DM, lane); cset = mset; }
        norm_row_m(v, m);
        if (mode < 2) store_row_bf16(WSP(bf16, WS_HN) + (size_t)r * DM, v, lane);
        if (mode >= 1) { asm volatile("" :: "v"(v[0]), "v"(v[1]), "v"(v[2]), "v"(v[3])); continue; }
        float a16[NE];
#pragma unroll
        for (int e = 0; e < NE; ++e) { float a = 0.f;
#pragma unroll
            for (int j = 0; j < 4; ++j) { const f32x4 w = *(const LAS f32x4*)(wrT + e * DM + 4 * lane + 256 * j); a = fmaf(v[j][0], w[0], a); a = fmaf(v[j][1], w[1], a); a = fmaf(v[j][2], w[2], a); a = fmaf(v[j][3], w[3], a); }
            a16[e] = a; if ((e & 3) == 3) asm volatile("" ::: "memory"); }
        router_finish(a16, r, lane, AFF);
    }
    __syncthreads();
}
__device__ __forceinline__ void pg_topk_gather(Frame& F, int l) {
    int tid_ = threadIdx.x; asm volatile("" : "+v"(tid_));
    const int lane = tid_ & 63, wave_ = __builtin_amdgcn_readfirstlane(tid_ >> 6);
    LAS unsigned* cnt = (LAS unsigned*)F.lds;
    LAS int* sidx = (LAS int*)(F.lds + 1024);
    const int nitems = (l == DEPTH - 1) ? 8 * NE : 16 * NE;
    const int tid = tid_, wave = wave_;
    const unsigned long long lt = (1ull << lane) - 1ull;
    for (int it = F.vcu; it < nitems; it += F.G) {
        const int set = it >> 4, e = it & 15; const bool latent = set < 8; const int N = latent ? SEQ : CTX, cap = latent ? CAPL : CAPC;
        const int rowbase = latent ? set * SEQ : NLAT + (set - 8) * CTX, xbase = latent ? set * CAPL : 8 * CAPL + (set - 8) * CAPC;
        const float* a = WSP(float, WS_AFF) + ((size_t)set * NE + e) * SEQ;
        unsigned key[4];
#pragma unroll
        for (int q = 0; q < 4; ++q) { const int i = q * 512 + tid; key[q] = i < N ? __builtin_bit_cast(unsigned, a[i]) : 0u; }
        unsigned T = 0u;
        for (int bit = 30; bit >= 0; --bit) {
            const unsigned cand = T | (1u << bit); unsigned c = 0;
#pragma unroll
            for (int q = 0; q < 4; ++q) c += (unsigned)__builtin_popcountll(__ballot(key[q] >= cand));
            LAS unsigned* cb = cnt + (bit & 1) * 8;
            if (lane == 0) cb[wave] = c;
            __syncthreads();
            unsigned tot = 0;
#pragma unroll
            for (int w = 0; w < 8; ++w) tot += cb[w];
            if (tot >= (unsigned)cap) T = cand;
        }
        LAS unsigned* cg = cnt + 64; LAS unsigned* ce = cnt + 96;
        unsigned long long bg[4], be[4];
#pragma unroll
        for (int q = 0; q < 4; ++q) { bg[q] = __ballot(key[q] > T); be[q] = __ballot(key[q] == T && key[q] != 0u);
            if (lane == 0) { cg[q * 8 + wave] = (unsigned)__builtin_popcountll(bg[q]); ce[q * 8 + wave] = (unsigned)__builtin_popcountll(be[q]); } }
        __syncthreads();
        unsigned ngt = 0;
        for (int c2 = 0; c2 < 32; ++c2) ngt += cg[c2];
        const unsigned need = (unsigned)cap - ngt;
        unsigned pre_g[4], pre_e[4];
        { unsigned rg = 0, re = 0;
#pragma unroll
          for (int q = 0; q < 4; ++q) { for (int w = 0; w < 8; ++w) { if (w == wave) { pre_g[q] = rg; pre_e[q] = re; } rg += cg[q * 8 + w]; re += ce[q * 8 + w]; } } }
        int* SEL = WSP(int, WS_SEL);
#pragma unroll
        for (int q = 0; q < 4; ++q) { const int i = q * 512 + tid;
            if (i < N) {
                const unsigned eb = pre_e[q] + (unsigned)__builtin_popcountll(be[q] & lt);
                const unsigned gb = pre_g[q] + (unsigned)__builtin_popcountll(bg[q] & lt);
                const bool isg = key[q] > T, ise = key[q] == T;
                const bool sel = isg || (ise && eb < need);
                const unsigned slot = gb + (eb < need ? eb : need);
                SEL[(size_t)(rowbase + i) * NE + e] = sel ? xbase + (int)slot : -1;
                if (sel) { WSP(float, WS_AFS)[(size_t)e * RPE + xbase + slot] = __builtin_bit_cast(float, key[q]); WSP(int, WS_IDX)[(size_t)e * RPE + xbase + slot] = rowbase + i; }
            } }
        __syncthreads();
    }
}
__device__ __forceinline__ void pj_combine(Frame& F, int l, int probe = 0) {
    int tid_ = threadIdx.x; asm volatile("" : "+v"(tid_));
    const int lane = tid_ & 63, wave_ = __builtin_amdgcn_readfirstlane(tid_ >> 6);
    const int gw = F.vcu * NWAVES + wave_, NGW = F.G * NWAVES; const bool last = l == DEPTH - 1;
    const int nrows = last ? NLAT : NTOK, rpw = (nrows + NGW - 1) / NGW, r0 = gw * rpw, r1 = r0 + rpw < nrows ? r0 + rpw : nrows;
    bf16* X = WSP(bf16, WS_X); const int* SEL = WSP(int, WS_SEL);
    const float* gnext = last ? inptr(F, IN_FINALG) : inptr(F, IN_NORM1G) + (l + 1) * DM;
    f32x4 va[4], vb[4], g2[4]; int sa = -1, sb = -1; ModVec m; int cset = -1;
    if (r0 < r1) { load_row_bf16(va, X + (size_t)r0 * DM, lane); sa = lane < NE ? SEL[(size_t)r0 * NE + lane] : -1; }
    if (r0 + 1 < r1) { load_row_bf16(vb, X + (size_t)(r0 + 1) * DM, lane); sb = lane < NE ? SEL[(size_t)(r0 + 1) * NE + lane] : -1; }
    for (int r = r0; r < r1; ++r) {
        f32x4 v[4], t[4];
#pragma unroll
        for (int j = 0; j < 4; ++j) { v[j] = va[j]; va[j] = vb[j]; t[j] = (f32x4){0.f, 0.f, 0.f, 0.f}; }
        const int selv = sa; sa = sb;
        if (r + 2 < r1) { load_row_bf16(vb, X + (size_t)(r + 2) * DM, lane); sb = lane < NE ? SEL[(size_t)(r + 2) * NE + lane] : -1; }
        const int mset = row_modset(r);
        if (mset != cset) { const float* mod = WSP(float, WS_MOD) + ((size_t)l * 9 + mset) * 6 * DM; const float* mod1 = WSP(float, WS_MOD) + ((size_t)(last ? l : l + 1) * 9 + mset) * 6 * DM;
#pragma unroll
            for (int j = 0; j < 4; ++j) g2[j] = *(const f32x4*)(mod + 5 * DM + 4 * lane + 256 * j);
            load_modvec(m, gnext, last ? nullptr : mod1, last ? nullptr : mod1 + DM, lane); cset = mset; }
        for (int e = 0; e < NE; ++e) { const int se = __builtin_amdgcn_readlane(selv, e);
            if (se >= 0) { const GAS v2u* y = (const GAS v2u*)(WSP(bf16, WS_G) + ((size_t)e * RPE + se) * DM) + lane;
#pragma unroll
                for (int j = 0; j < 4; ++j) { const v2u w = y[64 * j]; t[j] += (f32x4){bflo(w.x), bfhi(w.x), bflo(w.y), bfhi(w.y)}; } } }
#pragma unroll
        for (int j = 0; j < 4; ++j) v[j] = v[j] + g2[j] * t[j];
        if (probe) { norm_row_m(v, m); asm volatile("" :: "v"(v[0]), "v"(v[1]), "v"(v[2]), "v"(v[3])); continue; }
        if (!last) {
            store_row_bf16(X + (size_t)r * DM, v, lane);
            norm_row_m(v, m);
            store_row_bf16(WSP(bf16, WS_HN) + (size_t)r * DM, v, lane);
        } else {
            norm_row_m(v, m);
#pragma unroll
            for (int j = 0; j < 4; ++j) *(f32x4*)(F.out + (size_t)r * DM + 4 * lane + 256 * j) = v[j];
        }
    }
}

__device__ __forceinline__ void pc_mixers(Frame& F, int l, int rep) {
    int tid_ = threadIdx.x; asm volatile("" : "+v"(tid_));
    const int lane = tid_ & 63, wave_ = __builtin_amdgcn_readfirstlane(tid_ >> 6);
    const bool need_ctx = l < DEPTH - 1;
    {
        Strided<DecDft> S; S.d.Dm = (const char*)(F.ws + WS_DFT); S.d.Dc = (const char*)(F.ws + WS_DFTC); S.d.ABt = (const char*)(F.ws + WS_ABT); S.d.ABtc = (const char*)(F.ws + WS_ABTC);
        S.n = need_ctx ? 72 : 64; S.G = F.G; S.vcu = F.vcu;
        EpiStore E{WSP(bf16, WS_BR), DM};
        pg8::gemm_phase<EpiStore, Strided<DecDft>>(F.lds, (LAS int*)(F.lds + IDXBUF_OFF), S, E);
    }
    typedef attn_body::bf16 abf;
    const abf* Qg = (const abf*)(F.ws + WS_QKV + QKV_QG); const abf* Kg = (const abf*)(F.ws + WS_QKV + QKV_KG); const abf* Vg = (const abf*)(F.ws + WS_QKV + QKV_VG);
    const abf* Qw = (const abf*)(F.ws + WS_QKV + QKV_QW); const abf* Kw = (const abf*)(F.ws + WS_QKV + QKV_KW); const abf* Vw = (const abf*)(F.ws + WS_QKV + QKV_VW);
    abf* BR = (abf*)(F.ws + WS_BR);
    const int nGL = NBATCH * 2 * 32, nWL = NBATCH * 2 * 16, nGC = need_ctx ? NBATCH * 2 * 4 : 0, nWC = need_ctx ? NBATCH * 2 * 2 : 0, nattn = nGL + nWL + nGC + nWC;
    const int nconv = (CONV_IN_ATTN && F.G == 256 && rep == 0) ? CONV_ITEMS_L0 : 0, ntot = nattn + nconv;
    gu32* head = F.ctl + CW_QUEUE + 64 * (l + 2 * rep);
    const int wid = wave_;
    for (;;) {
        if (tid_ == 0) F.MISC[0] = __hip_atomic_fetch_add(head, 1u, RLX_AGENT);
        __syncthreads();
        const int q = (int)F.MISC[0];
        if (q >= ntot) break;
        const int c0 = (int)(((long long)q * nconv) / ntot), c1 = (int)(((long long)(q + 1) * nconv) / ntot);
        if (c1 > c0) { conv_wave_item(F, (l * CONV_ITEMS_L0 + c0) * NWAVES + wave_, lane); __syncthreads(); continue; }
        const int a = q - c0;
        if (a < nGL) {
            const int b = a >> 6, hkv = (a >> 5) & 1, qb = a & 31, head_ = hkv * 4 + (wid >> 1), q0 = qb * 64 + (wid & 1) * 32; const size_t qrow = (size_t)b * SEQ + q0;
            attn_body::attn_unit<0, 8>(Qg + qrow * 512 + head_ * 64, 512, Kg + (size_t)(NLAT + b * CTX) * 128 + hkv * 64, Kg + (size_t)b * SEQ * 128 + hkv * 64,
                                        Vg + (size_t)(NLAT + b * CTX) * 128 + hkv * 64, Vg + (size_t)b * SEQ * 128 + hkv * 64, 128, 4 + SEQ / 64, 0, 0, 0.f, BR + qrow * DM + 256 + head_ * 64, DM, F.ldsg);
        } else if (a < nGL + nWL) {
            const int u = a - nGL, b = u >> 5, hkv = (u >> 4) & 1, qb = u & 15, head_ = hkv * 2 + (wid >> 2), q0 = qb * 128 + (wid & 3) * 32; const size_t qrow = (size_t)b * SEQ + q0;
            const int band0 = qb * 128 - 128 < 0 ? 0 : qb * 128 - 128, band1 = qb * 128 + 256 > SEQ ? SEQ : qb * 128 + 256;
            attn_body::attn_unit<1, 8>(Qw + qrow * 256 + head_ * 64, 256, Kw + (size_t)(NLAT + b * CTX) * 128 + hkv * 64, Kw + ((size_t)b * SEQ + band0) * 128 + hkv * 64,
                                        Vw + (size_t)(NLAT + b * CTX) * 128 + hkv * 64, Vw + ((size_t)b * SEQ + band0) * 128 + hkv * 64, 128, 4 + (band1 - band0) / 64, q0, band0,
                                        inptr(F, IN_SINK)[l * 4 + head_] * LOG2E, BR + qrow * DM + 768 + head_ * 64, DM, F.ldsg);
        } else if (a < nGL + nWL + nGC) {
            const int u = a - nGL - nWL, b = u >> 3, hkv = (u >> 2) & 1, qb = u & 3, head_ = hkv * 4 + (wid >> 1); const size_t qrow = (size_t)NLAT + b * CTX + qb * 64 + (wid & 1) * 32;
            const abf* Kc = Kg + (size_t)(NLAT + b * CTX) * 128 + hkv * 64; const abf* Vc = Vg + (size_t)(NLAT + b * CTX) * 128 + hkv * 64;
            attn_body::attn_unit<0, 8>(Qg + qrow * 512 + head_ * 64, 512, Kc, Kc, Vc, Vc, 128, 4, 0, 0, 0.f, BR + qrow * DM + 256 + head_ * 64, DM, F.ldsg);
        } else {
            const int u = a - nGL - nWL - nGC, b = u >> 2, hkv = (u >> 1) & 1, qb = u & 1, head_ = hkv * 2 + (wid >> 2); const size_t qrow = (size_t)NLAT + b * CTX + qb * 128 + (wid & 3) * 32;
            const abf* Kc = Kw + (size_t)(NLAT + b * CTX) * 128 + hkv * 64; const abf* Vc = Vw + (size_t)(NLAT + b * CTX) * 128 + hkv * 64;
            attn_body::attn_unit<1, 8>(Qw + qrow * 256 + head_ * 64, 256, Kc, Kc, Vc, Vc, 128, 4, 0, 0, inptr(F, IN_SINK)[l * 4 + head_] * LOG2E, BR + qrow * DM + 768 + head_ * 64, DM, F.ldsg);
        }
    }
    __syncthreads();
}
#ifndef MK_N_LAUNCHES
#define MK_N_LAUNCHES 1
#endif
constexpr int N_PHASES = 2 + 9 * DEPTH;
struct Args { const float* in[21]; float* out; unsigned char* ws; int ph_lo, ph_hi, probe, pad_; };

__global__ void __launch_bounds__(NWAVES * 64, 2) hybrid_fwd(Args args) {
    extern __shared__ __attribute__((aligned(16))) unsigned char lds[];
    Frame F;
    F.lds = (LAS unsigned char*)lds; F.ldsg = (char*)lds; F.MISC = (volatile LAS unsigned*)(F.lds + MISC_OFF);
    F.G = gridDim.x; { const int bx = blockIdx.x; F.vcu = (F.G % 8 == 0) ? (bx % 8) * (F.G / 8) + bx / 8 : bx; }
    F.ws = args.ws; F.out = args.out; F.dout = (unsigned char*)args.out; F.ctl = (gu32*)(args.ws + WS_CTL);
#ifdef DBG_LDSPOISON
    for (int u = threadIdx.x; u < LDSCTL_OFF / 4; u += NWAVES * 64) ((LAS unsigned*)F.lds)[u] = 0xFFFFFFFFu;
#endif
    for (int u = threadIdx.x; u < (LDS_BYTES - LDSCTL_OFF) / 4; u += NWAVES * 64) ((LAS unsigned*)(F.lds + LDSCTL_OFF))[u] = 0u;
    __syncthreads();
    if (threadIdx.x < 21) *(LAS unsigned long long*)(F.lds + PTRS_OFF + 8 * threadIdx.x) = (unsigned long long)args.in[threadIdx.x];
    __syncthreads();
    XcdBarrier bar; bar.bar = (unsigned*)(F.ctl + CW_BAR); bar.x = 0; bar.st = nullptr;
    const int lo = args.ph_lo, hi = args.ph_hi;
    if (hi - lo > 1) bar = xcd_barrier_post((unsigned*)(F.ctl + CW_BAR), F.MISC + 8);
#ifndef PHSEL
#define PHSEL 0x7ff
#endif
#define IN(k) (lo <= (k) && (k) < hi)
#define KIND(j) ((PHSEL >> (j)) & 1)
#ifndef DBG_PROBE
#define DBG_PROBE 0
#endif
#ifndef FPROBE_MODE
#define FPROBE_MODE 0
#endif
#ifndef REP_MASK
#define REP_MASK 0
#endif
#define NREP(j, ok) ((((REP_MASK) >> (j)) & 1) && (ok) ? 2 : 1)
#define REPEAT(j, ok) for (int rep_ = 0, nrep_ = NREP(j, ok); rep_ < nrep_; ++rep_, (rep_ < nrep_ ? xcd_barrier(bar) : (void)0))
#define SEAM(k) do { if (IN(k) && IN((k) + 1)) xcd_barrier(bar); } while (0)

#ifdef BAR_PROBE
    if (hi - lo > 1) for (int i_ = 0; i_ < BAR_PROBE; ++i_) xcd_barrier(bar);
#endif
    if (KIND(0) && IN(0)) REPEAT(0, true) { p0_prologue(F, rep_ ? DBG_PROBE : 0); } SEAM(0);
    if (KIND(1) && IN(1)) REPEAT(1, true) { p1_norm1(F); } SEAM(1);
    for (int l = 0; l < DEPTH; ++l) {
        const int pb = 2 + 9 * l; const bool lastl = l == DEPTH - 1;
        const int nrt = lastl ? 64 : 72;
        if (KIND(2) && IN(pb + 0)) REPEAT(2, true) {
            Strided<DecInProj> S; S.d.A = (const char*)(F.ws + WS_HN); S.d.B = (const char*)(F.ws + WS_WIN) + (size_t)l * INW2 * DM * 2; S.d.layer = l; S.n = inproj_units(l); S.G = F.G; S.vcu = F.vcu;
            EpiInProj E; E.ABt = (bf16*)(F.ws + WS_ABT); E.ABtc = (bf16*)(F.ws + WS_ABTC);
            E.Qg = (bf16*)(F.ws + WS_QKV + QKV_QG); E.Kg = (bf16*)(F.ws + WS_QKV + QKV_KG); E.Vg = (bf16*)(F.ws + WS_QKV + QKV_VG);
            E.Qw = (bf16*)(F.ws + WS_QKV + QKV_QW); E.Kw = (bf16*)(F.ws + WS_QKV + QKV_KW); E.Vw = (bf16*)(F.ws + WS_QKV + QKV_VW);
            E.G = WSP(bf16, WS_G); E.rope = WSP(float, WS_ROPE); E.qng = inptr(F, IN_QNG) + l * 64; E.kng = inptr(F, IN_KNG) + l * 64;
            pg8::gemm_phase<EpiInProj, Strided<DecInProj>>(F.lds, (LAS int*)(F.lds + IDXBUF_OFF), S, E);
            if (!CONV_IN_ATTN && l == 0 && F.G == 256 && F.vcu >= 88 && rep_ == 0) tail_convert(F, F.vcu - 88, 0, 4, 672);
        } SEAM(pb + 0);
        if (KIND(3) && IN(pb + 1)) REPEAT(3, true) { pc_mixers(F, l, rep_); } SEAM(pb + 1);
        if (KIND(4) && IN(pb + 2)) REPEAT(4, true) {
            SchedMerge S; S.BR = (const char*)(F.ws + WS_BR); S.W = (const char*)(F.ws + WS_WBR) + (size_t)l * DM * DM * 2; S.ntiles = nrt * 4; S.G = F.G; S.vcu = F.vcu;
            EpiMerge E{WSP(bf16, WS_G), (rep_ + 1 == nrep_ && !args.probe) ? (bf16*)(F.ws + WS_MB) : WSP(bf16, WS_HN), args.probe};
            pg8::gemm_phase<EpiMerge, SchedMerge>(F.lds, (LAS int*)(F.lds + IDXBUF_OFF), S, E);
            if (!CONV_IN_ATTN && l == 0 && F.G == 256 && F.vcu >= 32 && rep_ == 0) tail_convert(F, F.vcu - 32, 672, 2, 1120);
        } SEAM(pb + 2);
        if (KIND(5) && IN(pb + 3)) REPEAT(5, l == 0) {
            Strided<DecWout> S; S.d.Mb = (const char*)(F.ws + WS_MB); S.d.W = (const char*)(F.ws + WS_WOUT) + (size_t)l * DM * DM * 2; S.n = nrt * 4; S.G = F.G; S.vcu = F.vcu;
            EpiWout E; E.baseL = inptr(F, IN_X); E.baseC = inptr(F, IN_CTX) - (size_t)NLAT * DM; E.baseX = WSP(bf16, WS_X); E.X = WSP(bf16, WS_X); E.from_x = l != 0; E.mod = WSP(float, WS_MOD) + (size_t)l * 9 * 6 * DM;
            pg8::gemm_phase<EpiWout, Strided<DecWout>>(F.lds, (LAS int*)(F.lds + IDXBUF_OFF), S, E);
            if (!CONV_IN_ATTN && l == 0 && F.G == 256 && F.vcu >= 32 && rep_ == 0) tail_convert(F, F.vcu - 32, 1120, 5, 2240);
        } SEAM(pb + 3);
        if (KIND(6) && IN(pb + 4)) REPEAT(6, true) { pf_norm2_router(F, l, rep_ ? FPROBE_MODE : 0); } SEAM(pb + 4);
        if (KIND(7) && IN(pb + 5)) REPEAT(7, true) { pg_topk_gather(F, l); } SEAM(pb + 5);
        const int ert = lastl ? 8 : 9;
        if (KIND(8) && IN(pb + 6)) REPEAT(8, true) {
            Strided<DecGU> S; S.d.H2 = (const char*)(F.ws + WS_HN); S.d.IDX = WSP(int, WS_IDX); S.d.W = (const char*)(F.ws + WS_WGU) + (size_t)l * NE * 2 * DM * DM * 2; S.d.nrt = ert; S.n = NE * ert * 8; S.G = F.G; S.vcu = F.vcu;
            EpiGU E{WSP(bf16, WS_HACT)};
            pg8::gemm_phase<EpiGU, Strided<DecGU>>(F.lds, (LAS int*)(F.lds + IDXBUF_OFF), S, E);
            if (!CONV_IN_ATTN && l == 0 && F.G == 256 && F.vcu >= 128 && rep_ == 0) tail_convert(F, F.vcu - 128, 2240, 3, 2624);
        } SEAM(pb + 6);
        if (KIND(9) && IN(pb + 7)) REPEAT(9, true) {
            Strided<DecDown> S; S.d.H = (const char*)(F.ws + WS_HACT); S.d.W = (const char*)(F.ws + WS_WD) + (size_t)l * NE * DM * DM * 2; S.d.nrt = ert; S.n = NE * ert * 4; S.G = F.G; S.vcu = F.vcu;
            EpiDown E{WSP(bf16, WS_G), WSP(float, WS_AFS)};
            pg8::gemm_phase<EpiDown, Strided<DecDown>>(F.lds, (LAS int*)(F.lds + IDXBUF_OFF), S, E);
            if (!CONV_IN_ATTN && l == 0 && F.G == 256 && F.vcu >= 64 && rep_ == 0) tail_convert(F, F.vcu - 64, 2624, 3, CONV_ITEMS);
        } SEAM(pb + 7);
        if (KIND(10) && IN(pb + 8)) REPEAT(10, true) { pj_combine(F, l, rep_); }
        if (!lastl) SEAM(pb + 8);
    }
#undef IN
#undef SEAM
}

#ifdef DBG_STOP
__global__ void k_dump(const unsigned short* __restrict__ src, float* __restrict__ out, size_t n) {
    for (size_t i = (size_t)blockIdx.x * blockDim.x + threadIdx.x; i < n; i += (size_t)gridDim.x * blockDim.x) out[i] = __uint_as_float((unsigned)src[i] << 16);
}
#endif
extern "C" void kernel_launch(void* const* d_in, const int* in_sizes, int n_in, void* d_out, int out_size, void* d_ws, size_t ws_size, hipStream_t stream) {
    static int grid = 0;
    if (grid == 0) {
        if (n_in != 21 || out_size != NLAT * DM || ws_size < WS_END) { fprintf(stderr, "kernel_launch: unexpected problem (n_in %d, out %d, ws %zu < %zu)\n", n_in, out_size, ws_size, (size_t)WS_END); grid = -1; return; }
        int dev = 0, cus = 0, per_cu = 0;
        if (hipGetDevice(&dev) != hipSuccess || hipDeviceGetAttribute(&cus, hipDeviceAttributeMultiprocessorCount, dev) != hipSuccess) { grid = -1; return; }
        if (hipFuncSetAttribute((const void*)hybrid_fwd, hipFuncAttributeMaxDynamicSharedMemorySize, LDS_BYTES) != hipSuccess) { fprintf(stderr, "kernel_launch: hipFuncSetAttribute failed\n"); grid = -1; return; }
        if (hipOccupancyMaxActiveBlocksPerMultiprocessor(&per_cu, (const void*)hybrid_fwd, NWAVES * 64, LDS_BYTES) != hipSuccess || per_cu < 1) { fprintf(stderr, "kernel_launch: occupancy query says %d blocks/CU\n", per_cu); per_cu = 1; }
        (void)hipGetLastError();
        grid = cus * 1;
    }
    if (grid < 0) return;
    hipMemsetAsync((char*)d_ws + WS_CTL, 0, CTL_ZERO_BYTES, stream);
    Args a; memset(&a, 0, sizeof(a));
    for (int i = 0; i < 21; ++i) a.in[i] = (const float*)d_in[i];
    a.out = (float*)d_out; a.ws = (unsigned char*)d_ws;
#if MK_N_LAUNCHES == 1
    a.ph_lo = 0; a.ph_hi = N_PHASES;
    hipLaunchKernelGGL(hybrid_fwd, dim3(grid), dim3(NWAVES * 64), LDS_BYTES, stream, a);
#else
    int nph_ = N_PHASES;
#ifdef DBG_STOP
    nph_ = DBG_STOP;
#endif
    for (int p = 0; p < nph_; ++p) { a.ph_lo = p; a.ph_hi = p + 1; hipLaunchKernelGGL(hybrid_fwd, dim3(grid), dim3(NWAVES * 64), LDS_BYTES, stream, a);
#ifdef DBG_DUP_PHASE
        if (p == DBG_DUP_PHASE) { a.probe = DBG_PROBE; hipLaunchKernelGGL(hybrid_fwd, dim3(grid), dim3(NWAVES * 64), LDS_BYTES, stream, a); a.probe = 0; }
#endif
    }
#ifdef DBG_STOP
    hipLaunchKernelGGL(k_dump, dim3(2048), dim3(256), 0, stream, (const unsigned short*)((const char*)d_ws + ((size_t)DBG_DUMP_MIB << 20)), (float*)d_out, (size_t)NLAT * DM);
#endif
#endif
}
```

```cpp
#define MK_N_LAUNCHES 1
#include <hip/hip_runtime.h>
#include <hip/hip_bf16.h>
#include <cstdio>
#include <cstdint>
#include <cmath>
#include <cstring>

constexpr int DM = 1024, NBATCH = 8, SEQ = 2048, CTX = 256, DEPTH = 2;
constexpr int NLAT = NBATCH * SEQ, NCTX = NBATCH * CTX, NTOK = NLAT + NCTX;
constexpr int INW = 4608, NCOLT = 19, INW2 = NCOLT * 256;
constexpr int NE = 16, CAPL = 256, CAPC = 32, RPE = NBATCH * (CAPL + CAPC);
constexpr float EPS = 1e-6f;
constexpr float QSCALE = 0.125f * 1.4426950408889634f;
constexpr float LOG2E = 1.4426950408889634f;
namespace pg8 {
#define PG8_LAS __attribute__((address_space(3)))
typedef unsigned short bf16_t;
typedef short bf16x8 __attribute__((ext_vector_type(8)));
typedef float f32x4 __attribute__((ext_vector_type(4)));
typedef unsigned u32x4 __attribute__((ext_vector_type(4)));
typedef unsigned u32x2 __attribute__((ext_vector_type(2)));
constexpr int BM = 256, BK = 64, HALF = 128, HTB = HALF * BK * 2  , STAGE_BYTES = 8 * HTB;

__host__ __device__ __forceinline__ int lds_byte(int r, int c) { const int st = (r >> 4) * 2 + (c >> 5), rr = r & 15, cc = c & 31, ob = rr * 64 + cc * 2; return st * 1024 + (ob ^ (((ob >> 9) & 1) << 5)); }
__host__ __device__ __forceinline__ int perm32(int rho) { const int n = rho >> 4, i = rho & 15; return 8 * (i >> 2) + 4 * n + (i & 3); }
__host__ __device__ __forceinline__ void stage_rc(int b, int& R, int& C) { const int st = b / 1024, sb = b % 1024, swz = sb ^ (((sb >> 9) & 1) << 5); R = (st >> 1) * 16 + swz / 64; C = (st & 1) * 32 + (swz % 64) / 2; }

struct Unit { const char* A; const char* B; const int* arows; int ldA, ldB, nt; int pm, pn, tag; };

typedef float f32x2_c __attribute__((ext_vector_type(2)));
typedef __bf16 bf16x2_c __attribute__((ext_vector_type(2)));
__device__ __forceinline__ unsigned cvt_pk_bf16(float lo, float hi) { const f32x2_c v = {lo, hi}; const bf16x2_c b = __builtin_convertvector(v, bf16x2_c); return __builtin_bit_cast(unsigned, b); }

template <class Epi, class Sched>
__device__ __forceinline__ void gemm_phase(PG8_LAS unsigned char* lds, PG8_LAS int* idxbuf  , const Sched& S, const Epi& E) {
    int tid = threadIdx.x; asm volatile("" : "+v"(tid));
    const int wid = __builtin_amdgcn_readfirstlane(tid >> 6), lane = tid & 63, wr = wid >> 2, wc = wid & 3, fr = lane & 15, fq = lane >> 4;
    unsigned Rr[2], RrB[2], Cc2[2];
#pragma unroll
    for (int i = 0; i < 2; ++i) { int R, C; stage_rc(tid * 16 + i * 8192, R, C); Rr[i] = (unsigned)R; RrB[i] = Epi::PERM ? (unsigned)((R & ~31) + perm32(R & 31)) : (unsigned)R; Cc2[i] = (unsigned)C * 2u; }
    const size_t kstep = (size_t)(BK * 2);
    const unsigned ldsw = (unsigned)wid * 1024u;
    const int aoff = lds_byte(wr * 64 + fr, fq * 8), boff = lds_byte(wc * 32 + fr, fq * 8);
#define PG8_SA(b, h) (((b) * 2 + (h)) * HTB)
#define PG8_SB(b, h) ((4 + (b) * 2 + (h)) * HTB)
#define PG8_STAGE(bufoff, gbase, ld) do { _Pragma("unroll") for (int _i = 0; _i < 2; ++_i) \
        __builtin_amdgcn_global_load_lds((const unsigned*)((const char*)(gbase) + (RrB[_i] * (unsigned)(ld) + Cc2[_i])), (PG8_LAS unsigned*)(lds + (bufoff) + ldsw + _i * 8192), 16, 0, 0); } while (0)
#define PG8_STAGE_A(bufoff, gbase, ao) do { _Pragma("unroll") for (int _i = 0; _i < 2; ++_i) \
        __builtin_amdgcn_global_load_lds((const unsigned*)((const char*)(gbase) + (ao)[_i]), (PG8_LAS unsigned*)(lds + (bufoff) + ldsw + _i * 8192), 16, 0, 0); } while (0)
#define PG8_AOFF(u, ao) do { _Pragma("unroll") for (int _h = 0; _h < 2; ++_h) _Pragma("unroll") for (int _i = 0; _i < 2; ++_i) { \
        const unsigned _row = (u).arows ? (unsigned)idxbuf[Rr[_i] + 128 * _h] : Rr[_i] + 128u * _h; (ao)[_h][_i] = _row * (unsigned)(u).ldA + Cc2[_i]; } } while (0)
#define PG8_STAGE_IDX(u) do { if ((u).arows) __builtin_amdgcn_global_load_lds((const unsigned*)((u).arows + (wid & 3) * 64 + lane), (PG8_LAS unsigned*)((PG8_LAS unsigned char*)idxbuf + (wid & 3) * 256), 4, 0, 0); } while (0)
#define PG8_LDA(dst, b, h) do { _Pragma("unroll") for (int m = 0; m < 4; ++m) _Pragma("unroll") for (int k = 0; k < 2; ++k) dst[m][k] = *(const PG8_LAS bf16x8*)(lds + PG8_SA(b, h) + aoff + m * 2048 + k * 1024); } while (0)
#define PG8_LDB(dst, b, h) do { _Pragma("unroll") for (int n = 0; n < 2; ++n) _Pragma("unroll") for (int k = 0; k < 2; ++k) dst[n][k] = *(const PG8_LAS bf16x8*)(lds + PG8_SB(b, h) + boff + n * 2048 + k * 1024); } while (0)
#define PG8_MMA(ai, bj, At, Bt) do { __builtin_amdgcn_s_setprio(1); _Pragma("unroll") for (int m = 0; m < 4; ++m) _Pragma("unroll") for (int n = 0; n < 2; ++n) _Pragma("unroll") for (int k = 0; k < 2; ++k) \
        acc[ai][bj][m][n] = __builtin_amdgcn_mfma_f32_16x16x32_bf16(Bt[n][k], At[m][k], acc[ai][bj][m][n], 0, 0, 0); __builtin_amdgcn_s_setprio(0); } while (0)
#define PG8_WAIT_V(n) asm volatile("s_waitcnt vmcnt(" #n ")" ::: "memory")
#define PG8_WAIT_L(n) asm volatile("s_waitcnt lgkmcnt(" #n ")" ::: "memory")
#define PG8_BAR __builtin_amdgcn_s_barrier()
#define PG8_SCHED __builtin_amdgcn_sched_barrier(0)
    Unit cur, nxt; int ui = 0;
    if (!S.next(0, cur)) return;
    nxt = cur;
    f32x4 acc[2][2][4][2];
#pragma unroll
    for (int a = 0; a < 2; ++a)
#pragma unroll
        for (int b = 0; b < 2; ++b)
#pragma unroll
            for (int m = 0; m < 4; ++m)
#pragma unroll
                for (int n = 0; n < 2; ++n) acc[a][b][m][n] = (f32x4){0.f, 0.f, 0.f, 0.f};
    bf16x8 At[4][2], B0[2][2], B1[2][2];
    const char* cA = cur.A; const char* cB = cur.B; int clb = cur.ldB;
    unsigned ao_c[2][2], ao_n[2][2];
    if (cur.arows) { PG8_STAGE_IDX(cur); PG8_WAIT_V(0); PG8_BAR; }
    PG8_AOFF(cur, ao_c);
#pragma unroll
    for (int _h = 0; _h < 2; ++_h)
#pragma unroll
        for (int _i = 0; _i < 2; ++_i) ao_n[_h][_i] = ao_c[_h][_i];
    if (cur.arows) { PG8_WAIT_L(0); PG8_BAR; }
    {
        const size_t hB = (size_t)HALF * clb;
        PG8_STAGE(PG8_SB(0, 0), cB, clb); PG8_STAGE(PG8_SB(0, 1), cB + hB, clb); PG8_STAGE_A(PG8_SA(0, 0), cA, ao_c[0]); PG8_STAGE_A(PG8_SA(0, 1), cA, ao_c[1]);
        if (wr == 1) PG8_BAR;
        PG8_WAIT_V(2); PG8_BAR;
        PG8_STAGE(PG8_SB(1, 0), cB + kstep, clb); PG8_STAGE_A(PG8_SA(1, 0), cA + kstep, ao_c[0]); PG8_STAGE(PG8_SB(1, 1), cB + hB + kstep, clb);
        PG8_WAIT_V(6); PG8_BAR;
    }
    for (;;) {
        const bool has_next = S.next(ui + 1, nxt);
        const char* nA = has_next ? nxt.A : cA; const char* nB = has_next ? nxt.B : cB; const int nlb = has_next ? nxt.ldB : clb;
        const int nt = cur.nt;
        if (has_next) PG8_STAGE_IDX(nxt);
        for (int t = 0; t < nt; t += 2) {
            const bool last = (t == nt - 2);
            if (last) { if (has_next) { PG8_AOFF(nxt, ao_n); } else {
#pragma unroll
                for (int _h = 0; _h < 2; ++_h)
#pragma unroll
                    for (int _i = 0; _i < 2; ++_i) ao_n[_h][_i] = ao_c[_h][_i]; } }
            unsigned ao2[2][2];
#pragma unroll
            for (int _h = 0; _h < 2; ++_h)
#pragma unroll
                for (int _i = 0; _i < 2; ++_i) ao2[_h][_i] = last ? ao_n[_h][_i] : ao_c[_h][_i];
            const char* a1 = cA + (size_t)(t + 1) * kstep;
            const char* a2 = last ? nA : cA + (size_t)(t + 2) * kstep; const char* b2 = last ? nB : cB + (size_t)(t + 2) * kstep;
            const int lb2 = last ? nlb : clb;
            const size_t hB2 = (size_t)HALF * lb2;
            const char* a3 = a2 + kstep; const char* b3 = b2 + kstep;
            PG8_LDB(B0, 0, 0); PG8_LDB(B1, 0, 1); PG8_SCHED; PG8_LDA(At, 0, 0); PG8_STAGE_A(PG8_SA(1, 1), a1, ao_c[1]);
            PG8_WAIT_V(8); PG8_WAIT_L(0); PG8_BAR; PG8_MMA(0, 0, At, B0); PG8_MMA(0, 1, At, B1); PG8_BAR; PG8_SCHED;
            PG8_LDA(At, 0, 1); PG8_STAGE(PG8_SB(0, 0), b2, lb2); PG8_STAGE(PG8_SB(0, 1), b2 + hB2, lb2); PG8_STAGE_A(PG8_SA(0, 0), a2, ao2[0]);
            PG8_WAIT_V(8); PG8_WAIT_L(0); PG8_BAR; PG8_MMA(1, 0, At, B0); PG8_MMA(1, 1, At, B1); PG8_BAR; PG8_SCHED;
            PG8_LDB(B0, 1, 0); PG8_LDB(B1, 1, 1); PG8_SCHED; PG8_LDA(At, 1, 0); PG8_STAGE_A(PG8_SA(0, 1), a2, ao2[1]);
            PG8_WAIT_V(8); PG8_WAIT_L(0); PG8_BAR; PG8_MMA(0, 0, At, B0); PG8_MMA(0, 1, At, B1); PG8_BAR; PG8_SCHED;
            PG8_LDA(At, 1, 1); PG8_STAGE(PG8_SB(1, 0), b3, lb2); PG8_STAGE(PG8_SB(1, 1), b3 + hB2, lb2); PG8_STAGE_A(PG8_SA(1, 0), a3, ao2[0]);
            PG8_WAIT_V(8); PG8_WAIT_L(0); PG8_BAR; PG8_MMA(1, 0, At, B0); PG8_MMA(1, 1, At, B1); PG8_BAR; PG8_SCHED;
        }
        if (wr == 0) PG8_BAR;
        bool keep_acc;
        { Unit eu = cur; int ewr = wr, ewc = wc, efr = fr, efq = fq; asm volatile("" : "+s"(eu.pm), "+s"(eu.pn), "+s"(eu.tag), "+s"(ewr), "+s"(ewc), "+v"(efr), "+v"(efq));
          keep_acc = E(acc, eu, ewr, ewc, efr, efq); }
        if (!has_next) break;
        if (!keep_acc) {
#pragma unroll
        for (int a = 0; a < 2; ++a)
#pragma unroll
            for (int b = 0; b < 2; ++b)
#pragma unroll
                for (int m = 0; m < 4; ++m)
#pragma unroll
                    for (int n = 0; n < 2; ++n) acc[a][b][m][n] = (f32x4){0.f, 0.f, 0.f, 0.f};
        }
        cur = nxt; cA = nA; cB = nB; clb = nlb; ++ui;
#pragma unroll
        for (int _h = 0; _h < 2; ++_h)
#pragma unroll
            for (int _i = 0; _i < 2; ++_i) ao_c[_h][_i] = ao_n[_h][_i];
        if (wr == 1) PG8_BAR;
    }
    PG8_WAIT_V(0);
    PG8_BAR;
#undef PG8_SA
#undef PG8_SB
#undef PG8_STAGE
#undef PG8_STAGE_A
#undef PG8_AOFF
#undef PG8_STAGE_IDX
#undef PG8_LDA
#undef PG8_LDB
#undef PG8_MMA
#undef PG8_WAIT_V
#undef PG8_WAIT_L
#undef PG8_BAR
#undef PG8_SCHED
}
}
#include <hip/hip_bf16.h>
#include <cmath>
namespace attn_body {
using bf16=__hip_bfloat16;
using bf16x8=__attribute__((ext_vector_type(8)))short;
using s16x4=__attribute__((ext_vector_type(4)))short;
using f32x16=__attribute__((ext_vector_type(16)))float;
using u32x4=__attribute__((ext_vector_type(4)))unsigned;
constexpr int D=64;
constexpr int NW=8,QBLK=32,KVBLK=64,NCT=4;
__device__ __forceinline__ int crow(int r,int hi){return (r&3)+8*(r>>2)+4*hi;}
#define SBAR() __builtin_amdgcn_sched_barrier(0)
__device__ __forceinline__ void wmask(f32x16&p0,f32x16&p1,int kb,int qabs,int hi){
  const float NEG=-INFINITY; const int d0=kb+4*hi-qabs;
  #pragma unroll
  for(int r=0;r<16;++r){int dd=d0+(r&3)+8*(r>>2); if(dd>128||dd<-128)p0[r]=NEG; if(dd+32>128||dd+32<-128)p1[r]=NEG;}
}

constexpr int NSLOT=3, SLOTB=8192;
constexpr int LDS_K=0, LDS_V=NSLOT*SLOTB, LDS_WS=2*NSLOT*SLOTB, LDS_OST=LDS_WS+NW*64*4, LDS_BYTES=LDS_OST+NW*4096;
__device__ __forceinline__ void glds16(const void*gsrc,unsigned lds_dst){unsigned keep;
  asm volatile("s_mov_b32 %0, m0\n\ts_mov_b32 m0, %2\n\ts_nop 0\n\tglobal_load_lds_dwordx4 %1, off\n\ts_mov_b32 m0, %0":"=&s"(keep):"v"(gsrc),"s"(lds_dst):"memory");}
__device__ __forceinline__ float max3f(float a,float b,float c){float r;asm("v_max3_f32 %0, %1, %2, %3":"=v"(r):"v"(a),"v"(b),"v"(c));return r;}
__device__ __forceinline__ float max2f(float a,float b){float r;asm("v_max_f32_e32 %0, %1, %2":"=v"(r):"v"(a),"v"(b));return r;}
__device__ __forceinline__ float fadd_s(float a,float b){float r;asm("v_add_f32_e32 %0, %1, %2":"=v"(r):"v"(a),"v"(b));return r;}
__device__ __forceinline__ float fsub_s(float a,float b){float r;asm("v_sub_f32_e32 %0, %1, %2":"=v"(r):"v"(a),"v"(b));return r;}
typedef float f32x2_t __attribute__((ext_vector_type(2))); typedef __bf16 bf16x2_t __attribute__((ext_vector_type(2)));
__device__ __forceinline__ unsigned cvtpk_s(float lo,float hi){f32x2_t v={lo,hi};bf16x2_t b=__builtin_convertvector(v,bf16x2_t);return __builtin_bit_cast(unsigned,b);}
#define WAIT_BAR(N) asm volatile("s_waitcnt vmcnt(" #N ") lgkmcnt(0)\n\ts_barrier":::"memory")

__device__ __forceinline__ void qkt(f32x16&p0,f32x16&p1,const char*Kslot,const bf16x8*qr,const f32x16&negm,int r32,int hi){
  const char*kb=Kslot+hi*1024+r32*16;
  #pragma unroll
  for(int d0=0;d0<4;++d0){
    const bf16x8 b0=*reinterpret_cast<const bf16x8*>(kb+d0*2048);
    const bf16x8 b1=*reinterpret_cast<const bf16x8*>(kb+d0*2048+512);
    if(d0==0){p0=__builtin_amdgcn_mfma_f32_32x32x16_bf16(b0,qr[0],negm,0,0,0);p1=__builtin_amdgcn_mfma_f32_32x32x16_bf16(b1,qr[0],negm,0,0,0);}
    else{p0=__builtin_amdgcn_mfma_f32_32x32x16_bf16(b0,qr[d0],p0,0,0,0);p1=__builtin_amdgcn_mfma_f32_32x32x16_bf16(b1,qr[d0],p1,0,0,0);}}
}
typedef __attribute__((address_space(3))) const char* lds_cptr;
typedef short v4i16_t __attribute__((ext_vector_type(4)));
__device__ __forceinline__ void kload8(bf16x8*kf,lds_cptr kp){
  kf[0]=*(const __attribute__((address_space(3))) bf16x8*)(kp);      kf[1]=*(const __attribute__((address_space(3))) bf16x8*)(kp+512);
  kf[2]=*(const __attribute__((address_space(3))) bf16x8*)(kp+2048); kf[3]=*(const __attribute__((address_space(3))) bf16x8*)(kp+2560);
  kf[4]=*(const __attribute__((address_space(3))) bf16x8*)(kp+4096); kf[5]=*(const __attribute__((address_space(3))) bf16x8*)(kp+4608);
  kf[6]=*(const __attribute__((address_space(3))) bf16x8*)(kp+6144); kf[7]=*(const __attribute__((address_space(3))) bf16x8*)(kp+6656);
}
__device__ __forceinline__ void kload2(bf16x8*kf,lds_cptr kp,int j){ kf[2*j]=*(const __attribute__((address_space(3))) bf16x8*)(kp+j*2048); kf[2*j+1]=*(const __attribute__((address_space(3))) bf16x8*)(kp+j*2048+512); }
__device__ __forceinline__ s16x4 vtr(lds_cptr p){ return __builtin_bit_cast(s16x4,__builtin_amdgcn_ds_read_tr16_b64_v4i16((__attribute__((address_space(3))) v4i16_t*)p)); }
__device__ __forceinline__ float rowmax(const f32x16&p0,const f32x16&p1){
  float a=max3f(p0[0],p0[1],p1[0]),b=max3f(p0[2],p0[3],p1[1]);a=max3f(a,p1[2],p1[3]);
  #pragma unroll
  for(int r=4;r<16;r+=4){a=max3f(a,p0[r],p0[r+1]);b=max3f(b,p0[r+2],p0[r+3]);a=max3f(a,p1[r],p1[r+1]);b=max3f(b,p1[r+2],p1[r+3]);}
  const float m=max2f(a,b);
  auto rr=__builtin_amdgcn_permlane32_swap(__float_as_uint(m),__float_as_uint(m),false,false);
  return max2f(__uint_as_float(rr[0]),__uint_as_float(rr[1]));
}
__device__ __forceinline__ void pv(f32x16*o,int vb,bf16x8 pa0,bf16x8 pa1,bf16x8 pa2,bf16x8 pa3){
  #pragma unroll
  for(int d0=0;d0<2;++d0){s16x4 lo[4],hi[4];
    #pragma unroll
    for(int ks=0;ks<4;++ks){
      asm volatile("ds_read_b64_tr_b16 %0,%1 offset:%c2":"=&v"(lo[ks]):"v"(vb),"i"(d0*4096+ks*1024):"memory");
      asm volatile("ds_read_b64_tr_b16 %0,%1 offset:%c2":"=&v"(hi[ks]):"v"(vb),"i"(d0*4096+ks*1024+512):"memory");}
    asm volatile("s_waitcnt lgkmcnt(0)":::"memory");SBAR();
    #define PK(k) (bf16x8){lo[k][0],lo[k][1],lo[k][2],lo[k][3],hi[k][0],hi[k][1],hi[k][2],hi[k][3]}
    o[d0]=__builtin_amdgcn_mfma_f32_32x32x16_bf16(pa0,PK(0),o[d0],0,0,0);
    o[d0]=__builtin_amdgcn_mfma_f32_32x32x16_bf16(pa1,PK(1),o[d0],0,0,0);
    o[d0]=__builtin_amdgcn_mfma_f32_32x32x16_bf16(pa2,PK(2),o[d0],0,0,0);
    o[d0]=__builtin_amdgcn_mfma_f32_32x32x16_bf16(pa3,PK(3),o[d0],0,0,0);
    #undef PK
  }
}

#ifndef ATTN_STORE16
#define ATTN_STORE16(p,v) (*(u32x4*)(p)=(v))
#endif
template<int MODE,int THRL> __device__ __forceinline__ void attn_unit(const bf16*Qw,int qp,const bf16*Kc,const bf16*Kl,const bf16*Vc,const bf16*Vl,int kp,int NT,int qabs,int band0,float sinkl2,bf16*Ow,int op,char*shm){
  int tid=threadIdx.x; asm volatile("":"+v"(tid));
  const int lane=tid&63,r32=lane&31,hi=lane>>5; const int wid=__builtin_amdgcn_readfirstlane(tid>>6);
  qabs+=r32;
  const unsigned lds0=(unsigned)(uintptr_t)shm;
  float*wsf=(float*)(shm+LDS_WS)+wid*64;
  const unsigned koff_=(unsigned)(lane*kp+wid*8)*2u;
  const unsigned voff_=(unsigned)((16*(wid&3)+(lane>>2))*kp+(wid>>2)*32+(lane&3)*8)*2u;
  const unsigned kdst=lds0+LDS_K+wid*1024, vdst=lds0+LDS_V+wid*1024;
  #define DMA_K(t,slot) glds16((const char*)((t)<NCT?Kc+(long)(t)*KVBLK*kp:Kl+(long)((t)-NCT)*KVBLK*kp)+koff_,(unsigned)__builtin_amdgcn_readfirstlane(kdst+(slot)))
  #define DMA_V(t,slot) glds16((const char*)((t)<NCT?Vc+(long)(t)*KVBLK*kp:Vl+(long)((t)-NCT)*KVBLK*kp)+voff_,(unsigned)__builtin_amdgcn_readfirstlane(vdst+(slot)))
  const int vb0=(int)(lds0+LDS_V)+((lane>>4)&1)*32+(lane&3)*8+(4*hi+((lane&15)>>2))*64;
  const char*Kbase=shm+LDS_K; bf16x8 kf[8];
  const lds_cptr shm3=(lds_cptr)shm; const lds_cptr kp0=shm3+LDS_K+hi*1024+r32*16; const lds_cptr vp0=shm3+LDS_V+((lane>>4)&1)*32+(lane&3)*8+(4*hi+((lane&15)>>2))*64;
  DMA_K(0,0);DMA_V(0,0);DMA_K(1,SLOTB);
  bf16x8 qr[4];
  #pragma unroll
  for(int d0=0;d0<4;++d0)qr[d0]=*reinterpret_cast<const bf16x8*>(&Qw[(long)r32*qp+d0*16+hi*8]);
  float mhat=0.f,l_reg=0.f;f32x16 o[2];o[0]=f32x16{};o[1]=f32x16{};f32x16 negm=f32x16{};asm volatile("":"+v"(negm));
  #define CMASK(P0,P1,t) do{ if(MODE==1){ if((t)>=NCT)wmask(P0,P1,band0+KVBLK*((t)-NCT),qabs,hi);} }while(0)
  bool resc=false;
  #define START(P0,P1) do{ const float rm=rowmax(P0,P1); resc=false; \
    { const float dl=rm; mhat=fadd_s(mhat,dl); \
      _Pragma("unroll") for(int r=0;r<16;++r){P0[r]=fsub_s(P0[r],dl);P1[r]=fsub_s(P1[r],dl);} \
      _Pragma("unroll") for(int r=0;r<16;++r)negm[r]=-mhat; asm volatile("":"+v"(negm)); } \
    _Pragma("unroll") for(int r=0;r<16;++r)P0[r]=__builtin_amdgcn_exp2f(P0[r]); }while(0)
  #define RESC() do{ if(resc){ asm volatile("s_waitcnt lgkmcnt(0)":::"memory"); \
      _Pragma("unroll") for(int d_=0;d_<2;++d_) _Pragma("unroll") for(int r=0;r<16;++r)o[d_][r]*=wsf[crow(r,hi)]; } }while(0)
  f32x16 pA0,pA1,pB0,pB1;
  int sl_prev=0,sl_cur=0,sl_next=SLOTB;
  #define ROT() do{sl_prev=sl_cur;sl_cur=sl_next;sl_next=(sl_next==(NSLOT-1)*SLOTB)?0:sl_next+SLOTB;}while(0)
  DMA_K(2,2*SLOTB);
  WAIT_BAR(3);
  qkt(pA0,pA1,Kbase,qr,negm,r32,hi);asm volatile("s_nop 15\n\ts_nop 7":"+v"(pA0),"+v"(pA1));CMASK(pA0,pA1,0);
  START(pA0,pA1);
  _Pragma("unroll") for(int r=0;r<16;++r)pA1[r]=__builtin_amdgcn_exp2f(pA1[r]);
  WAIT_BAR(0);
  DMA_K(3,0);DMA_V(1,SLOTB);
  ROT();
  kload8(kf,kp0+sl_cur);
  WAIT_BAR(2);
  s16x4 vlo[8],vhi[8]; u32x4 pw0,pw1,pw2,pw3;
  #define PKW(P,B) cvtpk_s(P[B],P[B+1])
  #define PAF(k) __builtin_bit_cast(bf16x8,pw##k)
  #define VFR(i) (bf16x8){vlo[i][0],vlo[i][1],vlo[i][2],vlo[i][3],vhi[i][0],vhi[i][1],vhi[i][2],vhi[i][3]}
  #define PIN(x) asm volatile("":"+v"(x))
  #define MX3(a,b,c) __builtin_fmaxf(__builtin_fmaxf((a),(b)),(c))
  #define GAPA(MF,A0,A1,A2,A3,W0,W1,PW) do{ MF; sacc+=A0; sacc+=A1; sacc+=A2; sacc+=A3; PIN(sacc); W0; W1; PIN(PW); SBAR(); }while(0)
  #define EX(v) __builtin_amdgcn_exp2f(v)
  #define GAPB(MF,X,B) do{ MF; X[B]=EX(X[B]); X[B+1]=EX(X[B+1]); X[B+2]=EX(X[B+2]); X[B+3]=EX(X[B+3]); PIN(X); SBAR(); }while(0)
  #define VRD(i) do{ vlo[i]=vtr(vp_+(((i)>>2)*4096+((i)&3)*1024)); vhi[i]=vtr(vp_+(((i)>>2)*4096+((i)&3)*1024+512)); }while(0)
  #define KRD(G,j) do{ if(G){ kload2(kf,kp0+sl_next,j); SBAR(); } }while(0)
  #define STEP(C0,C1,P0,P1,t,GK,GV,GL) do{ SBAR(); \
    const lds_cptr vp_=vp0+sl_prev; \
    VRD(0); SBAR(); float sacc=(P0[0]+P0[1]); \
    GAPA(C0=__builtin_amdgcn_mfma_f32_32x32x16_bf16(kf[0],qr[0],negm,0,0,0), P0[2],P0[3],P0[4],P0[5],     pw0[0]=PKW(P0,0), pw0[1]=PKW(P0,2), pw0); \
    VRD(4); SBAR(); GAPA(C1=__builtin_amdgcn_mfma_f32_32x32x16_bf16(kf[1],qr[0],negm,0,0,0), P0[6],P0[7],P0[8],P0[9],     pw0[2]=PKW(P0,4), pw0[3]=PKW(P0,6), pw0); \
    VRD(1); SBAR(); GAPA(C0=__builtin_amdgcn_mfma_f32_32x32x16_bf16(kf[2],qr[1],C0,0,0,0),   P0[10],P0[11],P0[12],P0[13], pw1[0]=PKW(P0,8), pw1[1]=PKW(P0,10), pw1); \
    VRD(5); SBAR(); GAPA(C1=__builtin_amdgcn_mfma_f32_32x32x16_bf16(kf[3],qr[1],C1,0,0,0),   P0[14],P0[15],P1[0],P1[1],   pw1[2]=PKW(P0,12),pw1[3]=PKW(P0,14), pw1); \
    VRD(2); SBAR(); GAPA(C0=__builtin_amdgcn_mfma_f32_32x32x16_bf16(kf[4],qr[2],C0,0,0,0),   P1[2],P1[3],P1[4],P1[5],     pw2[0]=PKW(P1,0), pw2[1]=PKW(P1,2), pw2); \
    VRD(6); SBAR(); GAPA(C1=__builtin_amdgcn_mfma_f32_32x32x16_bf16(kf[5],qr[2],C1,0,0,0),   P1[6],P1[7],P1[8],P1[9],     pw2[2]=PKW(P1,4), pw2[3]=PKW(P1,6), pw2); \
    VRD(3); SBAR(); GAPA(C0=__builtin_amdgcn_mfma_f32_32x32x16_bf16(kf[6],qr[3],C0,0,0,0),   P1[10],P1[11],P1[12],P1[13], pw3[0]=PKW(P1,8), pw3[1]=PKW(P1,10), pw3); \
    VRD(7); SBAR(); GAPA(C1=__builtin_amdgcn_mfma_f32_32x32x16_bf16(kf[7],qr[3],C1,0,0,0),   P1[14],P1[15],0.f,0.f,       pw3[2]=PKW(P1,12),pw3[3]=PKW(P1,14), pw3); \
    l_reg+=sacc; \
    if(GK){DMA_K((t)+3,sl_cur);} if(GV){DMA_V((t)+1,sl_next);} \
    CMASK(C0,C1,t); \
    { float a=MX3(C0[0],C0[1],C1[0]),b=MX3(C0[2],C0[3],C1[1]); a=MX3(a,C1[2],C1[3]); \
      _Pragma("unroll") for(int r=4;r<16;r+=4){a=MX3(a,C0[r],C0[r+1]);b=MX3(b,C0[r+2],C0[r+3]);a=MX3(a,C1[r],C1[r+1]);b=MX3(b,C1[r+2],C1[r+3]);} \
      float rm=__builtin_fmaxf(a,b); { auto rr=__builtin_amdgcn_permlane32_swap(__float_as_uint(rm),__float_as_uint(rm),false,false); rm=__builtin_fmaxf(__uint_as_float(rr[0]),__uint_as_float(rr[1])); } \
      resc=false; \
      if(__builtin_expect(__any(rm>(float)THRL),0)){ const float dl=__builtin_fmaxf(rm,0.f); mhat+=dl; \
        _Pragma("unroll") for(int r=0;r<16;++r){C0[r]-=dl;C1[r]-=dl;} \
        _Pragma("unroll") for(int r=0;r<16;++r)negm[r]=-mhat; asm volatile("":"+v"(negm)); \
        const float f=__builtin_amdgcn_exp2f(-dl); l_reg*=f; if(hi==0)wsf[r32]=f; resc=true; } } \
    SBAR(); \
    GAPB(o[0]=__builtin_amdgcn_mfma_f32_32x32x16_bf16(PAF(0),VFR(0),o[0],0,0,0), C0,0); \
    GAPB(o[1]=__builtin_amdgcn_mfma_f32_32x32x16_bf16(PAF(0),VFR(4),o[1],0,0,0), C0,4); \
    KRD(GL,0); GAPB(o[0]=__builtin_amdgcn_mfma_f32_32x32x16_bf16(PAF(1),VFR(1),o[0],0,0,0), C0,8); \
    KRD(GL,1); GAPB(o[1]=__builtin_amdgcn_mfma_f32_32x32x16_bf16(PAF(1),VFR(5),o[1],0,0,0), C0,12); \
    KRD(GL,2); GAPB(o[0]=__builtin_amdgcn_mfma_f32_32x32x16_bf16(PAF(2),VFR(2),o[0],0,0,0), C1,0); \
    KRD(GL,3); GAPB(o[1]=__builtin_amdgcn_mfma_f32_32x32x16_bf16(PAF(2),VFR(6),o[1],0,0,0), C1,4); \
    GAPB(o[0]=__builtin_amdgcn_mfma_f32_32x32x16_bf16(PAF(3),VFR(3),o[0],0,0,0), C1,8); \
    GAPB(o[1]=__builtin_amdgcn_mfma_f32_32x32x16_bf16(PAF(3),VFR(7),o[1],0,0,0), C1,12); \
    }while(0)
  int t=1;
  for(;t+5<NT;t+=2){
    STEP(pB0,pB1,pA0,pA1,t,true,true,true);     WAIT_BAR(2); RESC(); ROT();
    STEP(pA0,pA1,pB0,pB1,t+1,true,true,true);   WAIT_BAR(2); RESC(); ROT();
  }
  #define ENDW(tt) do{ if((tt)+3<NT){WAIT_BAR(2);} else if((tt)+2<NT){WAIT_BAR(1);} else {WAIT_BAR(0);} }while(0)
  for(;t+1<NT;t+=2){
    STEP(pB0,pB1,pA0,pA1,t,(t+3<NT),(t+1<NT),(t+1<NT));       ENDW(t);   RESC(); ROT();
    STEP(pA0,pA1,pB0,pB1,t+1,(t+4<NT),(t+2<NT),(t+2<NT));     ENDW(t+1); RESC(); ROT();
  }
  STEP(pB0,pB1,pA0,pA1,NT-1,false,false,false); RESC();
  { float sacc=pB0[0]+pB0[1]; _Pragma("unroll") for(int r=2;r<16;++r)sacc+=pB0[r]; _Pragma("unroll") for(int r=0;r<16;++r)sacc+=pB1[r]; l_reg+=sacc;
    pw0=(u32x4){PKW(pB0,0),PKW(pB0,2),PKW(pB0,4),PKW(pB0,6)};pw1=(u32x4){PKW(pB0,8),PKW(pB0,10),PKW(pB0,12),PKW(pB0,14)};pw2=(u32x4){PKW(pB1,0),PKW(pB1,2),PKW(pB1,4),PKW(pB1,6)};pw3=(u32x4){PKW(pB1,8),PKW(pB1,10),PKW(pB1,12),PKW(pB1,14)};
    SBAR(); pv(o,vb0+sl_cur,PAF(0),PAF(1),PAF(2),PAF(3)); }
  #undef PKW
  #undef PAF
  #undef VFR
  #undef PIN
  #undef MX3
  #undef GAPA
  #undef GAPB
  #undef EX
  #undef VRD
  #undef KRD
  #undef STEP
  #undef ENDW
  {auto rr=__builtin_amdgcn_permlane32_swap(__float_as_uint(l_reg),__float_as_uint(l_reg),false,false);l_reg=__uint_as_float(rr[0])+__uint_as_float(rr[1]);}
  if(MODE==1)l_reg+=__builtin_amdgcn_exp2f(sinkl2-mhat);
  if(hi==0)wsf[32+r32]=l_reg;asm volatile("s_waitcnt lgkmcnt(0)":::"memory");
  float rli[16];
  #pragma unroll
  for(int r=0;r<16;++r)rli[r]=__builtin_amdgcn_rcpf(wsf[32+crow(r,hi)]);
  { bf16*stg=(bf16*)(shm+LDS_OST)+wid*2048;
    #pragma unroll
    for(int r=0;r<16;++r){const int orow=crow(r,hi);
      #pragma unroll
      for(int d0=0;d0<2;++d0)stg[orow*64+d0*32+r32]=__float2bfloat16(o[d0][r]*rli[r]);}
    asm volatile("s_waitcnt lgkmcnt(0)":::"memory");
    #pragma unroll
    for(int i=0;i<4;++i){const int row=i*8+(lane>>3),ch=lane&7; const u32x4 v=*(const u32x4*)(stg+row*64+ch*8); ATTN_STORE16(Ow+(long)row*op+ch*8,v);} }
  asm volatile("s_waitcnt lgkmcnt(0)\n\ts_barrier":::"memory");
  #undef DMA_K
  #undef DMA_V
  #undef CMASK
  #undef START
  #undef RESC
  #undef ROT
}
constexpr int ATTN_LDS_BYTES=LDS_BYTES;
#undef SBAR
#undef WAIT_BAR
}
constexpr int NWAVES = 8;
constexpr size_t MiB = 1u << 20;
constexpr size_t WS_CTL = 0, CTL_ZERO_BYTES = 256 * 1024;
constexpr size_t WS_MOD = 1 * MiB;
constexpr size_t WS_ROPE = WS_MOD + 512 * 1024;
constexpr size_t WS_AFS = WS_ROPE + 64 * 1024;
constexpr size_t WS_IDX = WS_AFS + 192 * 1024;
constexpr size_t WS_SEL = 2 * MiB;
constexpr size_t WS_AFF = 4 * MiB;
constexpr size_t WS_ABTC = WS_AFF;
constexpr size_t WS_WIN = 6 * MiB;
constexpr size_t WS_WBR = 25 * MiB;
constexpr size_t WS_WOUT = 29 * MiB;
constexpr size_t WS_DFT = 33 * MiB;
constexpr size_t WS_DFTC = 49 * MiB;
constexpr size_t WS_WGU = 50 * MiB;
constexpr size_t WS_WD = 178 * MiB;
constexpr size_t WS_X = 242 * MiB;
constexpr size_t WS_HN = 314 * MiB;
constexpr size_t WS_MB = WS_HN;
constexpr size_t WS_QKV = 350 * MiB;
constexpr size_t WS_G = 395 * MiB;
constexpr size_t WS_BR = 503 * MiB;
constexpr size_t WS_HACT = 467 * MiB;
constexpr size_t WS_ABT = 539 * MiB;
constexpr size_t WS_END = 555 * MiB;
constexpr size_t QKV_QG = 0, QKV_KG = (size_t)NTOK * 512 * 2, QKV_VG = QKV_KG + (size_t)NTOK * 128 * 2, QKV_QW = QKV_VG + (size_t)NTOK * 128 * 2,
                 QKV_KW = QKV_QW + (size_t)NTOK * 256 * 2, QKV_VW = QKV_KW + (size_t)NTOK * 128 * 2;
static_assert(WS_WIN + (size_t)DEPTH * INW2 * DM * 2 <= WS_WBR && WS_QKV + QKV_VW + (size_t)NTOK * 128 * 2 <= WS_G && WS_G + (size_t)NTOK * 3 * DM * 2 <= WS_BR && WS_HACT >= WS_G + (size_t)NE * RPE * DM * 2 &&
              WS_HACT + (size_t)NE * RPE * DM * 2 <= WS_ABT && WS_ABT + (size_t)NBATCH * 256 * 2 * SEQ * 2 <= WS_END && (size_t)NBATCH * 256 * 2 * CTX * 2 <= 2 * MiB, "d_ws map");
constexpr int CW_BAR = 1024;
constexpr int CW_QUEUE = 8192;
constexpr int CW_CONVQ = 8192 + 64 * 8;
constexpr int CW_FIN = CW_CONVQ + 64;
constexpr int RING_BYTES = 131072;
constexpr int LDSCTL_OFF = RING_BYTES, MISC_OFF = LDSCTL_OFF + 320;
constexpr int IDXBUF_OFF = LDSCTL_OFF + 1024 + 8192;
constexpr int LDS_BYTES = 147456;

#define GAS __attribute__((address_space(1)))
#define LAS __attribute__((address_space(3)))
typedef unsigned short bf16;
typedef unsigned v4u __attribute__((ext_vector_type(4)));
typedef unsigned v2u __attribute__((ext_vector_type(2)));
typedef float f32x4 __attribute__((ext_vector_type(4)));
typedef GAS unsigned gu32;
#define RLX_AGENT __ATOMIC_RELAXED, __HIP_MEMORY_SCOPE_AGENT
#define LDS_WAIT() asm volatile("s_waitcnt lgkmcnt(0)" ::: "memory")
#define VM_WAIT() asm volatile("s_waitcnt vmcnt(0)" ::: "memory")
__device__ __forceinline__ unsigned f2bf(float f) { unsigned u = __builtin_bit_cast(unsigned, f); return (u + 0x7fffu + ((u >> 16) & 1u)) >> 16; }
__device__ __forceinline__ unsigned pk2(float lo, float hi) { return f2bf(lo) | (f2bf(hi) << 16); }
__device__ __forceinline__ float bf2f(unsigned short h) { return __builtin_bit_cast(float, (unsigned)h << 16); }
__device__ __forceinline__ float bflo(unsigned w) { return __builtin_bit_cast(float, w << 16); }
__device__ __forceinline__ float bfhi(unsigned w) { return __builtin_bit_cast(float, w & 0xffff0000u); }

#define XB_TMO      128
#define XB_XCNT(j)  (256  + 64 * (j))
#define XB_XSUB(j)  (1280 + 64 * (j))
#define XB_XGEN(j)  (2304 + 64 * (j))
#define XB_TOP      3328
#define XB_TOPGEN   3392
#define XCD_BAR_WORDS 3456
#define XB_SPIN_CAP (1u << 20)
__device__ __forceinline__ unsigned xb_ld(unsigned* p)              { return __hip_atomic_load(p, __ATOMIC_RELAXED, __HIP_MEMORY_SCOPE_AGENT); }
__device__ __forceinline__ unsigned xb_add(unsigned* p, unsigned v) { return __hip_atomic_fetch_add(p, v, __ATOMIC_RELAXED, __HIP_MEMORY_SCOPE_AGENT); }
__device__ __forceinline__ unsigned xb_xcc_id() { return (unsigned)__builtin_amdgcn_s_getreg((3 << 11) | 20) & 0xFu; }
#define XB_SPIN(cond, bar) do { unsigned _sp = 0; while (cond) { __builtin_amdgcn_s_sleep(1); \
    if ((++_sp & 255u) == 0u) { if (xb_ld(&(bar)[XB_TMO])) break; if (_sp > XB_SPIN_CAP) { atomicAdd(&(bar)[XB_TMO], 1u); break; } } } } while (0)
struct XcdBarrier { unsigned* bar; unsigned x; volatile LAS unsigned* st; };
__device__ __forceinline__ XcdBarrier xcd_barrier_post(unsigned* bar, volatile LAS unsigned* st) {
    XcdBarrier b; b.bar = bar; b.x = xb_xcc_id(); b.st = st;
    if (threadIdx.x == 0) (void)xb_add(&bar[XB_XCNT(b.x)], 1u);
    return b;
}
__device__ __forceinline__ void xcd_barrier_complete(unsigned* bar, unsigned x, unsigned& nloc, unsigned& nx) {
    const unsigned G = gridDim.x * gridDim.y * gridDim.z;
    unsigned sum, cnt, mine, sp = 0u;
    for (;;) {
        sum = 0u; cnt = 0u; mine = 0u;
#pragma unroll
        for (unsigned j = 0; j < 16; ++j) { const unsigned c = xb_ld(&bar[XB_XCNT(j)]); sum += c; cnt += (c > 0u) ? 1u : 0u; mine = (j == x) ? c : mine; }
        if (sum == G) break;
        __builtin_amdgcn_s_sleep(1);
        if ((++sp & 255u) == 0u) { if (xb_ld(&bar[XB_TMO])) break; if (sp > XB_SPIN_CAP) { atomicAdd(&bar[XB_TMO], 1u); break; } }
    }
    nloc = mine > 0u ? mine : 1u; nx = cnt > 0u ? cnt : 1u;
}
__device__ __forceinline__ void xcd_barrier(const XcdBarrier& b) {
    asm volatile("s_waitcnt vmcnt(0)" ::: "memory");
    __syncthreads();
    if (threadIdx.x == 0) {
        unsigned* bar = b.bar;
        __builtin_amdgcn_s_waitcnt(0);
        unsigned nloc = b.st[0], nx = b.st[1];
        if (nloc == 0u) { xcd_barrier_complete(bar, b.x, nloc, nx); b.st[0] = nloc; b.st[1] = nx; }
        const unsigned old = xb_add(&bar[XB_XSUB(b.x)], 1u);
        const unsigned gen = old / nloc;
        if (old + 1u == (gen + 1u) * nloc) {
            __builtin_amdgcn_fence(__ATOMIC_RELEASE, "agent");
            asm volatile("s_waitcnt vmcnt(0)" ::: "memory");
            const unsigned og = xb_add(&bar[XB_TOP], 1u);
            const unsigned tg = og / nx;
            if (og + 1u == (tg + 1u) * nx) xb_add(&bar[XB_TOPGEN], 1u);
            else XB_SPIN(xb_ld(&bar[XB_TOPGEN]) == tg, bar);
            __builtin_amdgcn_fence(__ATOMIC_ACQUIRE, "agent");
            xb_add(&bar[XB_XGEN(b.x)], 1u);
            asm volatile("s_waitcnt vmcnt(0)" ::: "memory");
        } else {
            XB_SPIN(xb_ld(&bar[XB_XGEN(b.x)]) == gen, bar);
            __builtin_amdgcn_fence(__ATOMIC_ACQUIRE, "agent");
            asm volatile("s_waitcnt vmcnt(0)" ::: "memory");
        }
    }
    __syncthreads();
}
template <int CTRL> __device__ __forceinline__ float dpp_mov(float v) { return __builtin_bit_cast(float, __builtin_amdgcn_update_dpp(0, __builtin_bit_cast(int, v), CTRL, 0xF, 0xF, true)); }
__device__ __forceinline__ float lx1(float v) { return dpp_mov<0xB1>(v); }
__device__ __forceinline__ float lx2(float v) { return dpp_mov<0x4E>(v); }
__device__ __forceinline__ float lx4(float v) { return dpp_mov<0x1B>(dpp_mov<0x141>(v)); }
__device__ __forceinline__ float lx8(float v) { return dpp_mov<0x141>(dpp_mov<0x140>(v)); }
__device__ __forceinline__ float lx16(float v) { return __shfl_xor(v, 16); }
__device__ __forceinline__ float lx32(float v) { const unsigned u = __builtin_bit_cast(unsigned, v); auto r = __builtin_amdgcn_permlane32_swap(u, u, false, false);
    return __builtin_bit_cast(float, (threadIdx.x & 32) ? r[0] : r[1]); }
__device__ __forceinline__ float wave_sum(float v) {
    v += lx1(v); v += lx2(v); v += lx4(v); v += lx8(v); v += lx16(v); v += lx32(v);
    return v;
}
using pg8::Unit;
typedef pg8::f32x4 (&AccRef)[2][2][4][2];

__device__ __forceinline__ v2u pack4(f32x4 v) { v2u w; w.x = pg8::cvt_pk_bf16(v[0], v[1]); w.y = pg8::cvt_pk_bf16(v[2], v[3]); return w; }
__device__ __forceinline__ float rsig_(float t) { return 1.f + __builtin_amdgcn_exp2f(t); }
__device__ __forceinline__ float sigmoidf_(float v) { return __builtin_amdgcn_rcpf(1.f + __builtin_amdgcn_exp2f(-LOG2E * v)); }

template <class Dec> struct Strided {
    Dec d; int n, G, vcu;
    __device__ __forceinline__ bool next(int i, Unit& u) const { const int L = i * G + vcu; if (L >= n) return false; d(L, u); return true; }
};

struct DecInProj { const char* A; const char* B; int layer;
    __device__ __forceinline__ void operator()(int L, Unit& u) const {
        int pm, pn;
        if (L < 1024) { const int cg = L >> 8, rg = (L & 255) >> 5, w = L & 31; pm = rg * 8 + (w & 7); pn = cg * 4 + (w >> 3); }
        else if (L < 1216) { const int q = L - 1024, rg = q / 24, w = q % 24; pm = rg * 8 + (w & 7); pn = 16 + (w >> 3); }
        else { const int q = L - 1216; pm = 64 + (q & 7); pn = q >> 3; if (layer == DEPTH - 1) pn = pn ? 6 : 4; }
        u.A = A + (size_t)pm * 256 * (DM * 2); u.B = B + (size_t)pn * 256 * (DM * 2); u.arows = nullptr; u.ldA = DM * 2; u.ldB = DM * 2; u.nt = DM / 64; u.pm = pm; u.pn = pn; u.tag = 0;
    } };
constexpr int inproj_units(int layer) { return 1216 + (layer == DEPTH - 1 ? 16 : 152); }

struct EpiInProj {
    static constexpr bool PERM = true;
    bf16 *ABt, *ABtc, *Qg, *Kg, *Vg, *Qw, *Kw, *Vw, *G; const float* rope; const float* qng; const float* kng;
    __device__ __forceinline__ bool operator()(AccRef acc, const Unit& u, int wr, int wc, int fr, int fq) const {
        const int pm = u.pm, pn = u.pn; const bool lat = pm < 64;
        const int rowt = wr * 64 + fr;
        if (pn < 2) {
            bf16* dst; int ld;
            if (lat) { dst = ABt + ((size_t)(pm >> 3) * 256) * (2 * SEQ) + pn * SEQ + (pm & 7) * 256; ld = 2 * SEQ; }
            else { dst = ABtc + ((size_t)(pm - 64) * 256) * (2 * CTX) + pn * CTX; ld = 2 * CTX; }
#pragma unroll
            for (int ai = 0; ai < 2; ++ai)
#pragma unroll
                for (int m = 0; m < 4; ++m) { const int tok = rowt + ai * 128 + m * 16;
#pragma unroll
                    for (int bj = 0; bj < 2; ++bj)
#pragma unroll
                        for (int n = 0; n < 2; ++n) { const int c = bj * 128 + wc * 32 + fq * 8 + n * 4; const pg8::f32x4 v = acc[ai][bj][m][n];
#pragma unroll
                            for (int j = 0; j < 4; ++j) dst[(size_t)(c + j) * ld + tok] = (bf16)f2bf(v[j]); } }
        } else if (pn < 7) {
            bf16* dst; int ld; const float* ng = nullptr; bool rope_on = false; float sc = 1.f;
            if (pn <= 3)      { dst = Qg + (pn - 2) * 256 + wc * 64; ld = 512; ng = qng; rope_on = lat; sc = QSCALE; }
            else if (pn == 4) { if (wc < 2) { dst = Kg + wc * 64; ng = kng; rope_on = lat; } else { dst = Vg + (wc - 2) * 64; } ld = 128; }
            else if (pn == 5) { dst = Qw + wc * 64; ld = 256; rope_on = lat; sc = QSCALE; }
            else              { if (wc < 2) { dst = Kw + wc * 64; rope_on = lat; } else { dst = Vw + (wc - 2) * 64; } ld = 128; }
#pragma unroll
            for (int ai = 0; ai < 2; ++ai)
#pragma unroll
                for (int m = 0; m < 4; ++m) {
                    const int row = pm * 256 + rowt + ai * 128 + m * 16;
                    pg8::f32x4 v[2][2];
                    float ss = 0.f;
#pragma unroll
                    for (int bj = 0; bj < 2; ++bj)
#pragma unroll
                        for (int n = 0; n < 2; ++n) { v[bj][n] = acc[ai][bj][m][n]; ss += (v[bj][n][0] * v[bj][n][0] + v[bj][n][1] * v[bj][n][1]) + (v[bj][n][2] * v[bj][n][2] + v[bj][n][3] * v[bj][n][3]); }
                    float r = sc;
                    if (ng) { ss += __shfl_xor(ss, 16); ss += __shfl_xor(ss, 32); r = sc * rsqrtf(ss * (1.f / 64.f) + EPS); }
                    const int t = row & (SEQ - 1);
#pragma unroll
                    for (int bj = 0; bj < 2; ++bj) { v2u o[2];
#pragma unroll
                        for (int n = 0; n < 2; ++n) {
                            pg8::f32x4 x = v[bj][n] * r; if (ng) x = x * *(const pg8::f32x4*)(ng + bj * 32 + fq * 8 + n * 4);
                            if (rope_on) {
                                const int pos = bj ? (t & 63) : (t >> 6);
                                const pg8::f32x4 cs = *(const pg8::f32x4*)(rope + ((size_t)pos * 16 + fq * 4 + n * 2) * 2);
                                x = (pg8::f32x4){x[0] * cs[0] - x[1] * cs[1], x[0] * cs[1] + x[1] * cs[0], x[2] * cs[2] - x[3] * cs[3], x[2] * cs[3] + x[3] * cs[2]};
                            }
                            o[n] = pack4(x);
                        }
                        *(v4u*)(dst + (size_t)row * ld + bj * 32 + fq * 8) = (v4u){o[0].x, o[0].y, o[1].x, o[1].y}; }
                    asm volatile("" ::: "memory");
                }
        } else {
            bf16* dst = G + ((size_t)pm * 12 + (pn - 7)) * 65536 + (size_t)(((wr * 4 + wc) * 64 + fq * 16 + fr) * 8);
#pragma unroll
            for (int ai = 0; ai < 2; ++ai)
#pragma unroll
                for (int bj = 0; bj < 2; ++bj)
#pragma unroll
                    for (int m = 0; m < 4; ++m) { const pg8::f32x4 a = acc[ai][bj][m][0], b = acc[ai][bj][m][1];
                        const v2u lo = pack4((pg8::f32x4){rsig_(a[0]), rsig_(a[1]), rsig_(a[2]), rsig_(a[3])}), hi = pack4((pg8::f32x4){rsig_(b[0]), rsig_(b[1]), rsig_(b[2]), rsig_(b[3])});
                        *(v4u*)(dst + (size_t)(((ai * 2 + bj) * 4 + m) * 4096)) = (v4u){lo.x, lo.y, hi.x, hi.y}; }
        }
        return false;
    }
};

struct EpiStore { static constexpr bool PERM = true; bf16* O; int ld;
    __device__ __forceinline__ bool operator()(AccRef acc, const Unit& u, int wr, int wc, int fr, int fq) const {
        bf16* dst = O + ((size_t)u.pm * 256 + wr * 64 + fr) * ld + u.pn * 256 + wc * 32 + fq * 8;
#pragma unroll
        for (int ai = 0; ai < 2; ++ai)
#pragma unroll
            for (int m = 0; m < 4; ++m)
#pragma unroll
                for (int bj = 0; bj < 2; ++bj) { const v2u o0 = pack4(acc[ai][bj][m][0]), o1 = pack4(acc[ai][bj][m][1]);
                    *(v4u*)(dst + (size_t)(ai * 128 + m * 16) * ld + bj * 128) = (v4u){o0.x, o0.y, o1.x, o1.y}; }
        return false;
    } };
struct DecDft { const char* Dm; const char* Dc; const char* ABt; const char* ABtc;
    __device__ __forceinline__ void operator()(int L, Unit& u) const {
        if (L < 64) { const int b = L >> 3, mt = L & 7; u.A = Dm + (size_t)mt * 256 * (4 * SEQ); u.B = ABt + (size_t)b * 256 * (4 * SEQ); u.ldA = 4 * SEQ; u.ldB = 4 * SEQ; u.nt = 2 * SEQ / 64; u.pm = L; }
        else { const int b = L - 64; u.A = Dc; u.B = ABtc + (size_t)b * 256 * (4 * CTX); u.ldA = 4 * CTX; u.ldB = 4 * CTX; u.nt = 2 * CTX / 64; u.pm = 64 + b; }
        u.pn = 0; u.tag = 0; u.arows = nullptr;
    } };

struct SchedMerge { const char* BR; const char* W; int ntiles, G, vcu;
    __device__ __forceinline__ bool next(int i, Unit& u) const {
        const int round = i / 3, tag = i - round * 3, tile = round * G + vcu; if (tile >= ntiles) return false;
        const int pm = tile >> 2, pn = tile & 3, koff = tag == 0 ? 0 : (tag == 1 ? 256 : 768);
        u.A = BR + (size_t)pm * 256 * (DM * 2) + koff * 2; u.B = W + (size_t)pn * 256 * (DM * 2) + koff * 2; u.arows = nullptr; u.ldA = DM * 2; u.ldB = DM * 2; u.nt = tag == 1 ? 8 : 4; u.pm = pm; u.pn = pn; u.tag = tag;
        return true;
    } };
struct EpiMerge { static constexpr bool PERM = true; const bf16* G; bf16* Mb; int probe;
    __device__ __forceinline__ bool operator()(AccRef acc, const Unit& u, int wr, int wc, int fr, int fq) const {
        const size_t row0 = (size_t)u.pm * 256 + wr * 64 + fr; const int col0 = u.pn * 256 + wc * 32 + fq * 8; const int tag = u.tag;
        const bf16* g0 = G + ((size_t)u.pm * 12 + tag * 4 + u.pn) * 65536 + (size_t)(((wr * 4 + wc) * 64 + fq * 16 + fr) * 8);
#pragma unroll
        for (int ai = 0; ai < 2; ++ai)
#pragma unroll
            for (int bj = 0; bj < 2; ++bj) {
#pragma unroll
                for (int m = 0; m < 4; ++m) { const size_t fo = (size_t)(((ai * 2 + bj) * 4 + m) * 4096);
                    const v4u gw = probe == 2 ? (v4u){0x3f803f80u, 0x3f803f80u, 0x3f803f80u, 0x3f803f80u} : *(const v4u*)(g0 + fo);
                    pg8::f32x4 ga = {bflo(gw.x), bfhi(gw.x), bflo(gw.y), bfhi(gw.y)}, gb = {bflo(gw.z), bfhi(gw.z), bflo(gw.w), bfhi(gw.w)};
                    ga = (pg8::f32x4){__builtin_amdgcn_rcpf(ga[0]), __builtin_amdgcn_rcpf(ga[1]), __builtin_amdgcn_rcpf(ga[2]), __builtin_amdgcn_rcpf(ga[3])};
                    gb = (pg8::f32x4){__builtin_amdgcn_rcpf(gb[0]), __builtin_amdgcn_rcpf(gb[1]), __builtin_amdgcn_rcpf(gb[2]), __builtin_amdgcn_rcpf(gb[3])};
                    if (tag < 2) { const v4u hw = probe == 2 ? (v4u){0x3f803f80u, 0x3f803f80u, 0x3f803f80u, 0x3f803f80u} : *(const v4u*)(g0 + 4 * 65536 + fo);
                        ga = (pg8::f32x4){ga[0] * bflo(hw.x), ga[1] * bfhi(hw.x), ga[2] * bflo(hw.y), ga[3] * bfhi(hw.y)};
                        gb = (pg8::f32x4){gb[0] * bflo(hw.z), gb[1] * bfhi(hw.z), gb[2] * bflo(hw.w), gb[3] * bfhi(hw.w)};
                        acc[ai][bj][m][0] = acc[ai][bj][m][0] * ga; acc[ai][bj][m][1] = acc[ai][bj][m][1] * gb; }
                    else { const size_t row = row0 + ai * 128 + m * 16; const int c = col0 + bj * 128;
                        const v2u o0 = pack4(acc[ai][bj][m][0] * ga), o1 = pack4(acc[ai][bj][m][1] * gb); *(v4u*)(Mb + row * DM + c) = (v4u){o0.x, o0.y, o1.x, o1.y}; } }
                asm volatile("" ::: "memory"); }
        return tag < 2;
    } };

struct DecWout { const char* Mb; const char* W;
    __device__ __forceinline__ void operator()(int L, Unit& u) const { const int pm = L >> 2, pn = L & 3;
        u.A = Mb + (size_t)pm * 256 * (DM * 2); u.B = W + (size_t)pn * 256 * (DM * 2); u.arows = nullptr; u.ldA = DM * 2; u.ldB = DM * 2; u.nt = DM / 64; u.pm = pm; u.pn = pn; u.tag = 0; } };
struct EpiWout { static constexpr bool PERM = true; const float* baseL; const float* baseC; const bf16* baseX; bf16* X; const float* mod; int from_x;
    __device__ __forceinline__ bool operator()(AccRef acc, const Unit& u, int wr, int wc, int fr, int fq) const {
        const int pm = u.pm; const float* base = pm < 64 ? baseL : baseC; const float* g1 = mod + (size_t)(pm < 64 ? (pm >> 3) : 8) * (6 * DM) + 2 * DM;
        const size_t row0 = (size_t)pm * 256 + wr * 64 + fr; const int col0 = u.pn * 256 + wc * 32 + fq * 8;
#pragma unroll
        for (int bj = 0; bj < 2; ++bj) { const int c = col0 + bj * 128; const pg8::f32x4 gv0 = *(const pg8::f32x4*)(g1 + c), gv1 = *(const pg8::f32x4*)(g1 + c + 4);
#pragma unroll
            for (int ai = 0; ai < 2; ++ai)
#pragma unroll
                for (int m = 0; m < 4; ++m) { const size_t off = (row0 + ai * 128 + m * 16) * DM + c; pg8::f32x4 b0, b1;
                    if (from_x) { const v4u w = *(const v4u*)(baseX + off); b0 = (pg8::f32x4){bflo(w.x), bfhi(w.x), bflo(w.y), bfhi(w.y)}; b1 = (pg8::f32x4){bflo(w.z), bfhi(w.z), bflo(w.w), bfhi(w.w)}; }
                    else { b0 = *(const pg8::f32x4*)(base + off); b1 = *(const pg8::f32x4*)(base + off + 4); }
                    const v2u o0 = pack4(b0 + gv0 * acc[ai][bj][m][0]), o1 = pack4(b1 + gv1 * acc[ai][bj][m][1]);
                    *(v4u*)(X + off) = (v4u){o0.x, o0.y, o1.x, o1.y}; } }
        return false;
    } };

struct DecGU { const char* H2; const int* IDX; const char* W; int nrt;
    __device__ __forceinline__ void operator()(int L, Unit& u) const { const int per = nrt * 8, e = L / per, q = L - e * per, ct = q & 7, rt = q >> 3;
        u.A = H2; u.arows = IDX + (size_t)e * RPE + rt * 256; u.B = W + ((size_t)e * 2 * DM + ct * 256) * (DM * 2); u.ldA = DM * 2; u.ldB = DM * 2; u.nt = DM / 64; u.pm = rt; u.pn = ct; u.tag = e; } };
struct EpiGU { static constexpr bool PERM = true; bf16* H;
    __device__ __forceinline__ bool operator()(AccRef acc, const Unit& u, int wr, int wc, int fr, int fq) const {
        bf16* dst = H + ((size_t)u.tag * RPE + u.pm * 256 + wr * 64 + fr) * DM + u.pn * 128 + wc * 32 + fq * 8;
#pragma unroll
        for (int ai = 0; ai < 2; ++ai)
#pragma unroll
            for (int m = 0; m < 4; ++m) { v2u o[2];
#pragma unroll
                for (int n = 0; n < 2; ++n) { const pg8::f32x4 a = acc[ai][0][m][n], up = acc[ai][1][m][n];
                    o[n] = pack4((pg8::f32x4){a[0] * sigmoidf_(a[0]) * up[0], a[1] * sigmoidf_(a[1]) * up[1], a[2] * sigmoidf_(a[2]) * up[2], a[3] * sigmoidf_(a[3]) * up[3]}); }
                *(v4u*)(dst + (size_t)(ai * 128 + m * 16) * DM) = (v4u){o[0].x, o[0].y, o[1].x, o[1].y}; }
        return false;
    } };
struct DecDown { const char* H; const char* W; int nrt;
    __device__ __forceinline__ void operator()(int L, Unit& u) const { const int per = nrt * 4, e = L / per, q = L - e * per, ct = q & 3, rt = q >> 2;
        u.A = H + ((size_t)e * RPE + rt * 256) * (DM * 2); u.arows = nullptr; u.B = W + ((size_t)e * DM + ct * 256) * (DM * 2); u.ldA = DM * 2; u.ldB = DM * 2; u.nt = DM / 64; u.pm = rt; u.pn = ct; u.tag = e; } };
struct EpiDown { static constexpr bool PERM = true; bf16* Y; const float* afs;
    __device__ __forceinline__ bool operator()(AccRef acc, const Unit& u, int wr, int wc, int fr, int fq) const {
        const size_t r0 = (size_t)u.tag * RPE + u.pm * 256 + wr * 64 + fr;
#pragma unroll
        for (int ai = 0; ai < 2; ++ai)
#pragma unroll
            for (int m = 0; m < 4; ++m) { const size_t r = r0 + ai * 128 + m * 16; const float a = afs[r];
#pragma unroll
                for (int bj = 0; bj < 2; ++bj) { const v2u o0 = pack4(acc[ai][bj][m][0] * a), o1 = pack4(acc[ai][bj][m][1] * a);
                    *(v4u*)(Y + r * DM + u.pn * 256 + bj * 128 + wc * 32 + fq * 8) = (v4u){o0.x, o0.y, o1.x, o1.y}; } }
        return false;
    } };
struct Frame {
    LAS unsigned char* lds; char* ldsg; volatile LAS unsigned* MISC; gu32* ctl;
    int vcu, G;
    unsigned char* ws; unsigned char* dout; float* out;
};
constexpr int PTRS_OFF = LDSCTL_OFF + 512;
enum { IN_X = 0, IN_C, IN_CTX, IN_CCTX, IN_WADA, IN_BADA, IN_NORM1G, IN_WIN, IN_QNG, IN_KNG, IN_SINK, IN_WBRF, IN_WBRG, IN_WBRW, IN_WOUT, IN_NORM2G, IN_WROUTER, IN_WGATE, IN_WUP, IN_WDOWN, IN_FINALG };
__device__ __forceinline__ const float* inptr(const Frame& F, int k) {
    const unsigned long long v = *(const LAS unsigned long long*)(F.lds + PTRS_OFF + 8 * k);
    const unsigned lo = __builtin_amdgcn_readfirstlane((unsigned)v), hi = __builtin_amdgcn_readfirstlane((unsigned)(v >> 32));
    return (const float*)(((unsigned long long)hi << 32) | lo);
}
#define WSP(T, off) ((T*)(F.ws + (off)))

constexpr int COSTAB_OFF = LDSCTL_OFF + 1024;
static_assert(COSTAB_OFF + 8192 <= LDS_BYTES, "cos table fits");
__device__ __forceinline__ void transpose_item(const float* W, int ldw, int k0, int n0, bf16* WT, int drow0, int dld, int dk0, int lane, float sc = 1.f) {
    const int g = lane >> 3, n4 = (lane & 7) * 4;
    const float* src = W + (size_t)(k0 + 8 * g) * ldw + n0 + n4;
    f32x4 v[8];
#pragma unroll
    for (int i = 0; i < 8; ++i) v[i] = *(const GAS f32x4*)(src + (size_t)i * ldw);
    bf16* dst = WT + (size_t)(drow0 + n4) * dld + dk0 + k0 + 8 * g;
#pragma unroll
    for (int j = 0; j < 4; ++j) { v4u o; o.x = pk2(v[0][j] * sc, v[1][j] * sc); o.y = pk2(v[2][j] * sc, v[3][j] * sc); o.z = pk2(v[4][j] * sc, v[5][j] * sc); o.w = pk2(v[6][j] * sc, v[7][j] * sc);
        *(GAS v4u*)(dst + (size_t)j * dld) = o; }
}
__device__ __forceinline__ void transpose_item2(const float* W, int ldw, int k0, int n0, bf16* WT, int drow0, int dld, int lane) {
    const int g = lane >> 3, n4 = (lane & 7) * 4;
    const float* src = W + (size_t)(k0 + 8 * g) * ldw + n0 + n4;
    f32x4 v[2][8];
#pragma unroll
    for (int h = 0; h < 2; ++h)
#pragma unroll
        for (int i = 0; i < 8; ++i) v[h][i] = __builtin_nontemporal_load((const GAS f32x4*)(src + (size_t)(h * 64 + i) * ldw));
    bf16* dst = WT + (size_t)(drow0 + n4) * dld + k0 + 8 * g;
#pragma unroll
    for (int h = 0; h < 2; ++h)
#pragma unroll
        for (int j = 0; j < 4; ++j) { v4u o; o.x = pk2(v[h][0][j], v[h][1][j]); o.y = pk2(v[h][2][j], v[h][3][j]); o.z = pk2(v[h][4][j], v[h][5][j]); o.w = pk2(v[h][6][j], v[h][7][j]);
            __builtin_nontemporal_store(o, (GAS v4u*)(dst + (size_t)j * dld + h * 64)); }
}
__device__ __forceinline__ void fold_item(const float* W, int k0, int g, int sinmode, bf16* WT, int drow0, LAS float* scr, const LAS float* ctab, int lane) {
#pragma unroll
    for (int kk = 0; kk < 16; ++kk) scr[lane * 20 + kk] = W[(size_t)(k0 + kk) * INW + g * 64 + lane];
    LDS_WAIT(); asm volatile("" ::: "memory");
    float acc[16];
#pragma unroll
    for (int k = 0; k < 16; ++k) acc[k] = 0.f;
#pragma unroll 4
    for (int c = 0; c < 64; ++c) {
        const int r = (c * lane) & 63;
        const float tv = sinmode ? -ctab[((r - 16) & 63) * 32] : ctab[r * 32];
#pragma unroll
        for (int k4 = 0; k4 < 4; ++k4) { const f32x4 w = *(const LAS f32x4*)(scr + c * 20 + 4 * k4);
            acc[4 * k4] = fmaf(w[0], tv, acc[4 * k4]); acc[4 * k4 + 1] = fmaf(w[1], tv, acc[4 * k4 + 1]); acc[4 * k4 + 2] = fmaf(w[2], tv, acc[4 * k4 + 2]); acc[4 * k4 + 3] = fmaf(w[3], tv, acc[4 * k4 + 3]); }
    }
    GAS v4u* dst = (GAS v4u*)(WT + (size_t)(drow0 + lane) * DM + k0);
#pragma unroll
    for (int q = 0; q < 2; ++q) { v4u o; o.x = pk2(acc[8 * q], acc[8 * q + 1]); o.y = pk2(acc[8 * q + 2], acc[8 * q + 3]); o.z = pk2(acc[8 * q + 4], acc[8 * q + 5]); o.w = pk2(acc[8 * q + 6], acc[8 * q + 7]); dst[q] = o; }
    LDS_WAIT(); asm volatile("" ::: "memory");
}

#ifndef CONV_IN_ATTN
#define CONV_IN_ATTN 0
#endif
constexpr int CONV_WAVE_ITEMS = DEPTH * NE * 768, CONV_ITEMS = CONV_WAVE_ITEMS / NWAVES, CONV_ITEMS_L0 = CONV_ITEMS / DEPTH;
__device__ __forceinline__ void conv_wave_item(Frame& F, int r, int lane) {
    const int le = r / 768, q = r % 768, which = q / 256, qq = q % 256, kb = qq >> 5, nb = qq & 31, f0 = nb * 32;
    if (which < 2) transpose_item2((which ? inptr(F, IN_WUP) : inptr(F, IN_WGATE)) + (size_t)le * DM * DM, DM, kb * 128, f0, WSP(bf16, WS_WGU) + (size_t)le * 2 * DM * DM, (f0 >> 7) * 256 + which * 128 + (f0 & 127), DM, lane);
    else transpose_item2(inptr(F, IN_WDOWN) + (size_t)le * DM * DM, DM, kb * 128, f0, WSP(bf16, WS_WD) + (size_t)le * DM * DM, f0, DM, lane);
}
__device__ __forceinline__ void tail_convert(Frame& F, int idx, int first, int per, int end) {
    int tid_ = threadIdx.x; asm volatile("" : "+v"(tid_));
    const int lane = tid_ & 63, wave_ = __builtin_amdgcn_readfirstlane(tid_ >> 6);
    for (int t = 0; t < per; ++t) { const int it = first + idx * per + t; if (it >= end) break; conv_wave_item(F, it * NWAVES + wave_, lane); }
}

__device__ __forceinline__ void p0_prologue(Frame& F, int mode = 0) {
    int tid_ = threadIdx.x; asm volatile("" : "+v"(tid_));
    const int lane = tid_ & 63, wave_ = __builtin_amdgcn_readfirstlane(tid_ >> 6);
    const int gw = F.vcu * NWAVES + wave_, NGW = F.G * NWAVES;
    LAS float* st = (LAS float*)F.lds;
    LAS float* red = (LAS float*)(F.lds + 40960);
    LAS float* ctab = (LAS float*)(F.lds + COSTAB_OFF);
    { const float* cp = inptr(F, IN_C); const float* ccp = inptr(F, IN_CCTX);
#pragma unroll 6
      for (int i = tid_; i < 9 * DM; i += NWAVES * 64) { const int s = i / DM, k = i - s * DM; const float v = s < 8 ? cp[s * DM + k] : ccp[k]; st[i] = v / (1.f + expf(-v)); } }
    for (int i = tid_; i < 2048; i += NWAVES * 64) ctab[i] = cosf(6.283185307179586f * (float)i * (1.f / 2048.f));
    __syncthreads();
    const float* bada = inptr(F, IN_BADA);
    if (mode != 2) for (int it = F.vcu; it < DEPTH * 96; it += F.G) {
        const int l = it / 96, j = (it % 96) * 64 + lane, kb = wave_ * 128;
        const float* W = inptr(F, IN_WADA) + (size_t)l * DM * 6 * DM + (size_t)kb * 6 * DM + j;
        float acc[9];
#pragma unroll
        for (int s = 0; s < 9; ++s) acc[s] = 0.f;
        for (int k0 = 0; k0 < 128; k0 += 16) {
            float w[16];
#pragma unroll
            for (int i = 0; i < 16; ++i) w[i] = W[(size_t)(k0 + i) * 6 * DM];
#pragma unroll
            for (int i = 0; i < 16; ++i)
#pragma unroll
                for (int s = 0; s < 9; ++s) acc[s] = fmaf(st[s * DM + kb + k0 + i], w[i], acc[s]);
        }
#pragma unroll
        for (int s = 0; s < 9; ++s) red[(wave_ * 9 + s) * 64 + lane] = acc[s];
        __syncthreads();
        for (int o = tid_; o < 9 * 64; o += NWAVES * 64) { float v = 0.f;
#pragma unroll
            for (int w = 0; w < 8; ++w) v += red[w * 576 + o];
            const int s = o >> 6, jj = (it % 96) * 64 + (o & 63);
            WSP(float, WS_MOD)[((size_t)l * 9 + s) * 6 * DM + jj] = v + bada[l * 6 * DM + jj]; }
        __syncthreads();
    }
    __syncthreads();
#ifdef DBG_POISON
    {
        const size_t n16 = (WS_END - WS_X) / 16, m16 = ((size_t)NLAT * DM * 4) / 16; const v4u pz = {0xFFFFFFFFu, 0xFFFFFFFFu, 0xFFFFFFFFu, 0xFFFFFFFFu};
        for (size_t i = (size_t)gw * 64 + lane; i < n16; i += (size_t)NGW * 64) ((GAS v4u*)(F.ws + WS_X))[i] = pz;
        for (size_t i = (size_t)gw * 64 + lane; i < m16; i += (size_t)NGW * 64) ((GAS v4u*)F.dout)[i] = pz;
    }
#endif
    LAS float* scr = (LAS float*)(F.lds + wave_ * 16384);
    constexpr int T_A = DEPTH * 2176, T_B = DEPTH * 512, T_C = DEPTH * 512, T_D = DEPTH * 512, T_E = DEPTH * NE * 768, T_F = SEQ + CTX, T_G = 1;
    constexpr int NITEMS = T_A + T_B + T_C + T_D + T_E + T_F + T_G;
    if (mode != 1 && mode != 5 && mode != 6) for (int it = gw; it < NITEMS; it += NGW) {
        int r = it;
        if (r < T_A) { const int l = r / 2176, q = r % 2176, kb = q / 136, nb = q % 136, s0 = 256 + nb * 32;
            int drow; if (s0 < 1536) { const int tile = 2 + ((s0 - 256) >> 8), hh = ((s0 - 256) & 255) >> 6, dh = (s0 & 63) >> 5; drow = tile * 256 + dh * 128 + hh * 32; } else drow = s0 + 256;
            transpose_item(inptr(F, IN_WIN) + (size_t)l * DM * INW, INW, kb * 64, s0, WSP(bf16, WS_WIN) + (size_t)l * INW2 * DM, drow, DM, 0, lane, s0 < 1536 ? 1.f : -LOG2E); continue; } r -= T_A;
        if (r < T_B) { const int l = r / 512, q = r % 512, kq = q & 3, kb = (q >> 2) >> 3, g = ((q >> 2) >> 1) & 3, sm = (q >> 2) & 1;
            fold_item(inptr(F, IN_WIN) + (size_t)l * DM * INW, kb * 64 + kq * 16, g, sm, WSP(bf16, WS_WIN) + (size_t)l * INW2 * DM, sm * 256 + g * 64, scr, ctab, lane); continue; } r -= T_B;
        if (r < T_C) { const int l = r / 512, q = r % 512; const float* W; int kb, koff;
            if (q < 128) { W = inptr(F, IN_WBRF) + (size_t)l * 256 * DM; kb = q >> 5; koff = 0; } else if (q < 384) { W = inptr(F, IN_WBRG) + (size_t)l * 512 * DM; kb = (q - 128) >> 5; koff = 256; } else { W = inptr(F, IN_WBRW) + (size_t)l * 256 * DM; kb = (q - 384) >> 5; koff = 768; }
            const int nb = q & 31;
            transpose_item(W, DM, kb * 64, nb * 32, WSP(bf16, WS_WBR) + (size_t)l * DM * DM, nb * 32, DM, koff, lane); continue; } r -= T_C;
        if (r < T_D) { const int l = r / 512, q = r % 512, kb = q >> 5, nb = q & 31;
            transpose_item(inptr(F, IN_WOUT) + (size_t)l * DM * DM, DM, kb * 64, nb * 32, WSP(bf16, WS_WOUT) + (size_t)l * DM * DM, nb * 32, DM, 0, lane); continue; } r -= T_D;
        if (r < T_E) { if (F.G != 256) conv_wave_item(F, r, lane); continue; } r -= T_E;
        if (r < T_F) {
            const bool big = r < SEQ; const int N = big ? SEQ : CTX, k = big ? r : r - SEQ, sh = big ? 0 : 3; const float sc = 1.f / sqrtf(64.f * (float)N);
            bf16* row = (big ? WSP(bf16, WS_DFT) : WSP(bf16, WS_DFTC)) + (size_t)k * 2 * N;
            for (int n = 2 * lane; n < N; n += 128) {
                const int r0 = (k * n) & (N - 1), r1 = (k * (n + 1)) & (N - 1);
                *(GAS unsigned*)(row + n) = pk2(ctab[r0 << sh] * sc, ctab[r1 << sh] * sc);
                *(GAS unsigned*)(row + N + n) = pk2(ctab[((r0 - (N >> 2)) & (N - 1)) << sh] * sc, ctab[((r1 - (N >> 2)) & (N - 1)) << sh] * sc); }
            continue; } r -= T_F;
        {
            for (int i = lane; i < 64 * 16; i += 64) { const int pos = i >> 4, f = i & 15; const float inv = powf(10000.f, -(float)(2 * f) / 32.f), ang = (float)pos * inv;
                WSP(float, WS_ROPE)[2 * i] = cosf(ang); WSP(float, WS_ROPE)[2 * i + 1] = sinf(ang); }
        }
    }
}

__device__ __forceinline__ void norm_row(f32x4 (&v)[4], const float* gain, const float* shift, const float* scale, int lane) {
    float ss = 0.f;
#pragma unroll
    for (int j = 0; j < 4; ++j) ss += (v[j][0] * v[j][0] + v[j][1] * v[j][1]) + (v[j][2] * v[j][2] + v[j][3] * v[j][3]);
    const float r = rsqrtf(wave_sum(ss) * (1.f / DM) + EPS);
#pragma unroll
    for (int j = 0; j < 4; ++j) { const f32x4 g = *(const f32x4*)(gain + 4 * lane + 256 * j); f32x4 y = v[j] * r * g;
        if (shift) { const f32x4 sh = *(const f32x4*)(shift + 4 * lane + 256 * j), sc = *(const f32x4*)(scale + 4 * lane + 256 * j); y = y * (sc + 1.f) + sh; }
        v[j] = y; }
}
__device__ __forceinline__ void store_row_bf16(bf16* orow, const f32x4 (&v)[4], int lane) {
    GAS v2u* o8 = (GAS v2u*)orow + lane;
#pragma unroll
    for (int j = 0; j < 4; ++j) { v2u w; w.x = pg8::cvt_pk_bf16(v[j][0], v[j][1]); w.y = pg8::cvt_pk_bf16(v[j][2], v[j][3]); o8[64 * j] = w; }
}
__device__ __forceinline__ int row_modset(int r) { return r < NLAT ? (r >> 11) : 8; }
struct ModVec { f32x4 g[4], sh[4], sc[4]; };
__device__ __forceinline__ void load_modvec(ModVec& m, const float* gain, const float* shift, const float* scale, int lane) {
#pragma unroll
    for (int j = 0; j < 4; ++j) { m.g[j] = *(const f32x4*)(gain + 4 * lane + 256 * j);
        if (shift) { m.sh[j] = *(const f32x4*)(shift + 4 * lane + 256 * j); m.sc[j] = *(const f32x4*)(scale + 4 * lane + 256 * j); } else { m.sh[j] = (f32x4){0.f, 0.f, 0.f, 0.f}; m.sc[j] = (f32x4){0.f, 0.f, 0.f, 0.f}; } }
}
__device__ __forceinline__ void norm_row_m(f32x4 (&v)[4], const ModVec& m) {
    float ss = 0.f;
#pragma unroll
    for (int j = 0; j < 4; ++j) ss += (v[j][0] * v[j][0] + v[j][1] * v[j][1]) + (v[j][2] * v[j][2] + v[j][3] * v[j][3]);
    const float r = rsqrtf(wave_sum(ss) * (1.f / DM) + EPS);
#pragma unroll
    for (int j = 0; j < 4; ++j) v[j] = (v[j] * r * m.g[j]) * (m.sc[j] + 1.f) + m.sh[j];
}
__device__ __forceinline__ void load_row_bf16(f32x4 (&v)[4], const bf16* row, int lane) {
    const GAS v2u* i8 = (const GAS v2u*)row + lane;
#pragma unroll
    for (int j = 0; j < 4; ++j) { const v2u w = i8[64 * j]; v[j] = (f32x4){bflo(w.x), bfhi(w.x), bflo(w.y), bfhi(w.y)}; }
}
__device__ __forceinline__ void load_row_f32(f32x4 (&v)[4], const float* row, int lane) {
#pragma unroll
    for (int j = 0; j < 4; ++j) v[j] = *(const f32x4*)(row + 4 * lane + 256 * j);
}

__device__ __forceinline__ void p1_norm1(Frame& F) {
    int tid_ = threadIdx.x; asm volatile("" : "+v"(tid_));
    const int lane = tid_ & 63, wave_ = __builtin_amdgcn_readfirstlane(tid_ >> 6);
    const int gw = F.vcu * NWAVES + wave_, NGW = F.G * NWAVES, rpw = (NTOK + NGW - 1) / NGW, r0 = gw * rpw, r1 = r0 + rpw < NTOK ? r0 + rpw : NTOK;
    const float* xin = inptr(F, IN_X); const float* cin = inptr(F, IN_CTX) - (size_t)NLAT * DM; const float* g1 = inptr(F, IN_NORM1G);
#define P1_ROW(r) (((r) < NLAT ? xin : cin) + (size_t)(r) * DM)
    f32x4 va[4], vb[4]; ModVec m; int cset = -1;
    if (r0 < r1) load_row_f32(va, P1_ROW(r0), lane);
    if (r0 + 1 < r1) load_row_f32(vb, P1_ROW(r0 + 1), lane);
    for (int r = r0; r < r1; ++r) {
        f32x4 v[4];
#pragma unroll
        for (int j = 0; j < 4; ++j) { v[j] = va[j]; va[j] = vb[j]; }
        if (r + 2 < r1) load_row_f32(vb, P1_ROW(r + 2), lane);
        const int set = row_modset(r);
        if (set != cset) { const float* mod = WSP(float, WS_MOD) + (size_t)set * 6 * DM; load_modvec(m, g1, mod, mod + DM, lane); cset = set; }
        norm_row_m(v, m);
        store_row_bf16(WSP(bf16, WS_HN) + (size_t)r * DM, v, lane);
    }
#undef P1_ROW
}
__device__ __forceinline__ void router_finish(const float (&a16)[NE], int r, int lane, float* AFF) {
    float b8[8], b4[4], b2[2], lg;
    { const bool hi = lane & 32;
#pragma unroll
      for (int i = 0; i < 8; ++i) { const float keep = hi ? a16[i + 8] : a16[i], send = hi ? a16[i] : a16[i + 8]; b8[i] = keep + lx32(send); } }
    { const bool hi = lane & 16;
#pragma unroll
      for (int i = 0; i < 4; ++i) { const float keep = hi ? b8[i + 4] : b8[i], send = hi ? b8[i] : b8[i + 4]; b4[i] = keep + lx16(send); } }
    { const bool hi = lane & 8;
#pragma unroll
      for (int i = 0; i < 2; ++i) { const float keep = hi ? b4[i + 2] : b4[i], send = hi ? b4[i] : b4[i + 2]; b2[i] = keep + lx8(send); } }
    { const bool hi = lane & 4; const float keep = hi ? b2[1] : b2[0], send = hi ? b2[0] : b2[1]; lg = keep + lx4(send); }
    lg += lx2(lg); lg += lx1(lg);
    float mx = lg;
    mx = fmaxf(mx, lx4(mx)); mx = fmaxf(mx, lx8(mx)); mx = fmaxf(mx, lx16(mx)); mx = fmaxf(mx, lx32(mx));
    const float ex = expf(lg - mx); float sum = ex;
    sum += lx4(sum); sum += lx8(sum); sum += lx16(sum); sum += lx32(sum);
    const int set = r < NLAT ? (r >> 11) : 8 + ((r - NLAT) >> 8), n = r < NLAT ? (r & (SEQ - 1)) : ((r - NLAT) & (CTX - 1));
    if ((lane & 3) == 0) AFF[((size_t)set * NE + ((lane >> 2) & 15)) * SEQ + n] = ex / sum;
}
__device__ __forceinline__ void pf_norm2_router(Frame& F, int l, int mode = 0) {
    int tid_ = threadIdx.x; asm volatile("" : "+v"(tid_));
    const int lane = tid_ & 63, wave_ = __builtin_amdgcn_readfirstlane(tid_ >> 6);
    const int gw = F.vcu * NWAVES + wave_, NGW = F.G * NWAVES;
    LAS float* wrT = (LAS float*)F.lds;
    { const float* wr = inptr(F, IN_WROUTER) + (size_t)l * DM * NE;
#pragma unroll 8
      for (int i = tid_; i < DM * NE; i += NWAVES * 64) { const int k = i >> 4, e = i & 15; wrT[e * DM + k] = wr[i]; } }
    __syncthreads();
    const int nrows = (l == DEPTH - 1) ? NLAT : NTOK, rpw = (nrows + NGW - 1) / NGW, r0 = gw * rpw, r1 = r0 + rpw < nrows ? r0 + rpw : nrows;
    const bf16* X = WSP(bf16, WS_X); const float* g2n = inptr(F, IN_NORM2G) + l * DM; float* AFF = WSP(float, WS_AFF);
    f32x4 va[4], vb[4]; ModVec m; int cset = -1;
    if (r0 < r1) load_row_bf16(va, X + (size_t)r0 * DM, lane);
    if (r0 + 1 < r1) load_row_bf16(vb, X + (size_t)(r0 + 1) * DM, lane);
    for (int r = r0; r < r1; ++r) {
        f32x4 v[4];
#pragma unroll
        for (int j = 0; j < 4; ++j) { v[j] = va[j]; va[j] = vb[j]; }
        if (r + 2 < r1) load_row_bf16(vb, X + (size_t)(r + 2) * DM, lane);
        const int mset = row_modset(r);
        if (mset != cset) { const float* mod = WSP(float, WS_MOD) + ((size_t)l * 9 + mset) * 6 * DM; load_modvec(m, g2n, mod + 3 * DM, mod + 4 * DM, lane); cset = mset; }
        norm_row_m(v, m);
        if (mode < 2) store_row_bf16(WSP(bf16, WS_HN) + (size_t)r * DM, v, lane);
        if (mode >= 1) { asm volatile("" :: "v"(v[0]), "v"(v[1]), "v"(v[2]), "v"(v[3])); continue; }
        float a16[NE];
#pragma unroll
        for (int e = 0; e < NE; ++e) { float a = 0.f;
#pragma unroll
            for (int j = 0; j < 4; ++j) { const f32x4 w = *(const LAS f32x4*)(wrT + e * DM + 4 * lane + 256 * j); a = fmaf(v[j][0], w[0], a); a = fmaf(v[j][1], w[1], a); a = fmaf(v[j][2], w[2], a); a = fmaf(v[j][3], w[3], a); }
            a16[e] = a; if ((e & 3) == 3) asm volatile("" ::: "memory"); }
        router_finish(a16, r, lane, AFF);
    }
    __syncthreads();
}
__device__ __forceinline__ void pg_topk_gather(Frame& F, int l) {
    int tid_ = threadIdx.x; asm volatile("" : "+v"(tid_));
    const int lane = tid_ & 63, wave_ = __builtin_amdgcn_readfirstlane(tid_ >> 6);
    LAS unsigned* cnt = (LAS unsigned*)F.lds;
    LAS int* sidx = (LAS int*)(F.lds + 1024);
    const int nitems = (l == DEPTH - 1) ? 8 * NE : 16 * NE;
    const int tid = tid_, wave = wave_;
    const unsigned long long lt = (1ull << lane) - 1ull;
    for (int it = F.vcu; it < nitems; it += F.G) {
        const int set = it >> 4, e = it & 15; const bool latent = set < 8; const int N = latent ? SEQ : CTX, cap = latent ? CAPL : CAPC;
        const int rowbase = latent ? set * SEQ : NLAT + (set - 8) * CTX, xbase = latent ? set * CAPL : 8 * CAPL + (set - 8) * CAPC;
        const float* a = WSP(float, WS_AFF) + ((size_t)set * NE + e) * SEQ;
        unsigned key[4];
#pragma unroll
        for (int q = 0; q < 4; ++q) { const int i = q * 512 + tid; key[q] = i < N ? __builtin_bit_cast(unsigned, a[i]) : 0u; }
        unsigned T = 0u;
        for (int bit = 30; bit >= 0; --bit) {
            const unsigned cand = T | (1u << bit); unsigned c = 0;
#pragma unroll
            for (int q = 0; q < 4; ++q) c += (unsigned)__builtin_popcountll(__ballot(key[q] >= cand));
            LAS unsigned* cb = cnt + (bit & 1) * 8;
            if (lane == 0) cb[wave] = c;
            __syncthreads();
            unsigned tot = 0;
#pragma unroll
            for (int w = 0; w < 8; ++w) tot += cb[w];
            if (tot >= (unsigned)cap) T = cand;
        }
        LAS unsigned* cg = cnt + 64; LAS unsigned* ce = cnt + 96;
        unsigned long long bg[4], be[4];
#pragma unroll
        for (int q = 0; q < 4; ++q) { bg[q] = __ballot(key[q] > T); be[q] = __ballot(key[q] == T && key[q] != 0u);
            if (lane == 0) { cg[q * 8 + wave] = (unsigned)__builtin_popcountll(bg[q]); ce[q * 8 + wave] = (unsigned)__builtin_popcountll(be[q]); } }
        __syncthreads();
        unsigned ngt = 0;
        for (int c2 = 0; c2 < 32; ++c2) ngt += cg[c2];
        const unsigned need = (unsigned)cap - ngt;
        unsigned pre_g[4], pre_e[4];
        { unsigned rg = 0, re = 0;
#pragma unroll
          for (int q = 0; q < 4; ++q) { for (int w = 0; w < 8; ++w) { if (w == wave) { pre_g[q] = rg; pre_e[q] = re; } rg += cg[q * 8 + w]; re += ce[q * 8 + w]; } } }
        int* SEL = WSP(int, WS_SEL);
#pragma unroll
        for (int q = 0; q < 4; ++q) { const int i = q * 512 + tid;
            if (i < N) {
                const unsigned eb = pre_e[q] + (unsigned)__builtin_popcountll(be[q] & lt);
                const unsigned gb = pre_g[q] + (unsigned)__builtin_popcountll(bg[q] & lt);
                const bool isg = key[q] > T, ise = key[q] == T;
                const bool sel = isg || (ise && eb < need);
                const unsigned slot = gb + (eb < need ? eb : need);
                SEL[(size_t)(rowbase + i) * NE + e] = sel ? xbase + (int)slot : -1;
                if (sel) { WSP(float, WS_AFS)[(size_t)e * RPE + xbase + slot] = __builtin_bit_cast(float, key[q]); WSP(int, WS_IDX)[(size_t)e * RPE + xbase + slot] = rowbase + i; }
            } }
        __syncthreads();
    }
}
__device__ __forceinline__ unsigned ye_issue4(const bf16* YE, int selv, unsigned mk, v2u (&w)[4][4], int lane) {
#pragma unroll
    for (int i = 0; i < 4; ++i) {
        if (mk) { const int e = __builtin_ctz(mk); mk &= mk - 1u; const int se = __builtin_amdgcn_readlane(selv, e);
            const GAS v2u* y = (const GAS v2u*)(YE + ((size_t)e * RPE + se) * DM) + lane;
#pragma unroll
            for (int j = 0; j < 4; ++j) w[i][j] = y[64 * j]; }
        else {
#pragma unroll
            for (int j = 0; j < 4; ++j) w[i][j] = (v2u){0u, 0u}; }
    }
    return mk;
}
__device__ __forceinline__ void ye_acc4(f32x4 (&t)[4], const v2u (&w)[4][4]) {
#pragma unroll
    for (int i = 0; i < 4; ++i)
#pragma unroll
        for (int j = 0; j < 4; ++j) t[j] += (f32x4){bflo(w[i][j].x), bfhi(w[i][j].x), bflo(w[i][j].y), bfhi(w[i][j].y)};
}
__device__ __forceinline__ unsigned sel_mask(int selv) { return (unsigned)__builtin_amdgcn_readfirstlane((int)(__ballot(selv >= 0) & 0xFFFFull)); }
__device__ __forceinline__ void pj_combine(Frame& F, int l, int probe = 0) {
    int tid_ = threadIdx.x; asm volatile("" : "+v"(tid_));
    const int lane = tid_ & 63, wave_ = __builtin_amdgcn_readfirstlane(tid_ >> 6);
    const int gw = F.vcu * NWAVES + wave_, NGW = F.G * NWAVES; const bool last = l == DEPTH - 1;
    const int nrows = last ? NLAT : NTOK, rpw = (nrows + NGW - 1) / NGW, r0 = gw * rpw, r1 = r0 + rpw < nrows ? r0 + rpw : nrows;
    bf16* X = WSP(bf16, WS_X); const int* SEL = WSP(int, WS_SEL);
    const float* gnext = last ? inptr(F, IN_FINALG) : inptr(F, IN_NORM1G) + (l + 1) * DM;
    f32x4 va[4], vb[4], g2[4]; int sa = -1, sb = -1; ModVec m; int cset = -1;
    if (r0 < r1) { load_row_bf16(va, X + (size_t)r0 * DM, lane); sa = lane < NE ? SEL[(size_t)r0 * NE + lane] : -1; }
    if (r0 + 1 < r1) { load_row_bf16(vb, X + (size_t)(r0 + 1) * DM, lane); sb = lane < NE ? SEL[(size_t)(r0 + 1) * NE + lane] : -1; }
    const bf16* YE = WSP(bf16, WS_G); v2u wA[4][4], wB[4][4]; unsigned restA = 0u, restB = 0u;
    restA = ye_issue4(YE, sa, r0 < r1 ? sel_mask(sa) : 0u, wA, lane);
#define PJ_ROW(r, WC, WN, RC, RN) do { \
        f32x4 v[4], t[4]; \
        _Pragma("unroll") for (int j = 0; j < 4; ++j) { v[j] = va[j]; va[j] = vb[j]; t[j] = (f32x4){0.f, 0.f, 0.f, 0.f}; } \
        const int selv = sa; sa = sb; \
        if ((r) + 2 < r1) { load_row_bf16(vb, X + (size_t)((r) + 2) * DM, lane); sb = lane < NE ? SEL[(size_t)((r) + 2) * NE + lane] : -1; } \
        const int mset = row_modset(r); \
        if (mset != cset) { const float* mod = WSP(float, WS_MOD) + ((size_t)l * 9 + mset) * 6 * DM; const float* mod1 = WSP(float, WS_MOD) + ((size_t)(last ? l : l + 1) * 9 + mset) * 6 * DM; \
            _Pragma("unroll") for (int j = 0; j < 4; ++j) g2[j] = *(const f32x4*)(mod + 5 * DM + 4 * lane + 256 * j); \
            load_modvec(m, gnext, last ? nullptr : mod1, last ? nullptr : mod1 + DM, lane); cset = mset; } \
        RN = ye_issue4(YE, sa, (r) + 1 < r1 ? sel_mask(sa) : 0u, WN, lane);                \
        ye_acc4(t, WC); \
        while (RC) { RC = ye_issue4(YE, selv, RC, WC, lane); ye_acc4(t, WC); }               \
        _Pragma("unroll") for (int j = 0; j < 4; ++j) v[j] = v[j] + g2[j] * t[j]; \
        if (probe) { norm_row_m(v, m); asm volatile("" :: "v"(v[0]), "v"(v[1]), "v"(v[2]), "v"(v[3])); } \
        else if (!last) { \
            store_row_bf16(X + (size_t)(r) * DM, v, lane); \
            norm_row_m(v, m); \
            store_row_bf16(WSP(bf16, WS_HN) + (size_t)(r) * DM, v, lane); \
        } else { \
            norm_row_m(v, m); \
            _Pragma("unroll") for (int j = 0; j < 4; ++j) *(f32x4*)(F.out + (size_t)(r) * DM + 4 * lane + 256 * j) = v[j]; \
        } } while (0)
    for (int r = r0; r < r1; r += 2) {
        PJ_ROW(r, wA, wB, restA, restB);
        if (r + 1 < r1) PJ_ROW(r + 1, wB, wA, restB, restA);
    }
#undef PJ_ROW
}

__device__ __forceinline__ void pc_mixers(Frame& F, int l, int rep) {
    int tid_ = threadIdx.x; asm volatile("" : "+v"(tid_));
    const int lane = tid_ & 63, wave_ = __builtin_amdgcn_readfirstlane(tid_ >> 6);
    const bool need_ctx = l < DEPTH - 1;
    {
        Strided<DecDft> S; S.d.Dm = (const char*)(F.ws + WS_DFT); S.d.Dc = (const char*)(F.ws + WS_DFTC); S.d.ABt = (const char*)(F.ws + WS_ABT); S.d.ABtc = (const char*)(F.ws + WS_ABTC);
        S.n = need_ctx ? 72 : 64; S.G = F.G; S.vcu = F.vcu;
        EpiStore E{WSP(bf16, WS_BR), DM};
        pg8::gemm_phase<EpiStore, Strided<DecDft>>(F.lds, (LAS int*)(F.lds + IDXBUF_OFF), S, E);
    }
    typedef attn_body::bf16 abf;
    const abf* Qg = (const abf*)(F.ws + WS_QKV + QKV_QG); const abf* Kg = (const abf*)(F.ws + WS_QKV + QKV_KG); const abf* Vg = (const abf*)(F.ws + WS_QKV + QKV_VG);
    const abf* Qw = (const abf*)(F.ws + WS_QKV + QKV_QW); const abf* Kw = (const abf*)(F.ws + WS_QKV + QKV_KW); const abf* Vw = (const abf*)(F.ws + WS_QKV + QKV_VW);
    abf* BR = (abf*)(F.ws + WS_BR);
    const int nGL = NBATCH * 2 * 32, nWL = NBATCH * 2 * 16, nGC = need_ctx ? NBATCH * 2 * 4 : 0, nWC = need_ctx ? NBATCH * 2 * 2 : 0, nattn = nGL + nWL + nGC + nWC;
    const int nconv = (CONV_IN_ATTN && F.G == 256 && rep == 0) ? CONV_ITEMS_L0 : 0, ntot = nattn + nconv;
    gu32* head = F.ctl + CW_QUEUE + 64 * (l + 2 * rep);
    const int wid = wave_;
    for (;;) {
        if (tid_ == 0) F.MISC[0] = __hip_atomic_fetch_add(head, 1u, RLX_AGENT);
        __syncthreads();
        const int q = (int)F.MISC[0];
        if (q >= ntot) break;
        const int c0 = (int)(((long long)q * nconv) / ntot), c1 = (int)(((long long)(q + 1) * nconv) / ntot);
        if (c1 > c0) { conv_wave_item(F, (l * CONV_ITEMS_L0 + c0) * NWAVES + wave_, lane); __syncthreads(); continue; }
        const int a = q - c0;
        if (a < nGL) {
            const int b = a >> 6, hkv = (a >> 5) & 1, qb = a & 31, head_ = hkv * 4 + (wid >> 1), q0 = qb * 64 + (wid & 1) * 32; const size_t qrow = (size_t)b * SEQ + q0;
            attn_body::attn_unit<0, 8>(Qg + qrow * 512 + head_ * 64, 512, Kg + (size_t)(NLAT + b * CTX) * 128 + hkv * 64, Kg + (size_t)b * SEQ * 128 + hkv * 64,
                                        Vg + (size_t)(NLAT + b * CTX) * 128 + hkv * 64, Vg + (size_t)b * SEQ * 128 + hkv * 64, 128, 4 + SEQ / 64, 0, 0, 0.f, BR + qrow * DM + 256 + head_ * 64, DM, F.ldsg);
        } else if (a < nGL + nWL) {
            const int u = a - nGL, b = u >> 5, hkv = (u >> 4) & 1, qb = u & 15, head_ = hkv * 2 + (wid >> 2), q0 = qb * 128 + (wid & 3) * 32; const size_t qrow = (size_t)b * SEQ + q0;
            const int band0 = qb * 128 - 128 < 0 ? 0 : qb * 128 - 128, band1 = qb * 128 + 256 > SEQ ? SEQ : qb * 128 + 256;
            attn_body::attn_unit<1, 8>(Qw + qrow * 256 + head_ * 64, 256, Kw + (size_t)(NLAT + b * CTX) * 128 + hkv * 64, Kw + ((size_t)b * SEQ + band0) * 128 + hkv * 64,
                                        Vw + (size_t)(NLAT + b * CTX) * 128 + hkv * 64, Vw + ((size_t)b * SEQ + band0) * 128 + hkv * 64, 128, 4 + (band1 - band0) / 64, q0, band0,
                                        inptr(F, IN_SINK)[l * 4 + head_] * LOG2E, BR + qrow * DM + 768 + head_ * 64, DM, F.ldsg);
        } else if (a < nGL + nWL + nGC) {
            const int u = a - nGL - nWL, b = u >> 3, hkv = (u >> 2) & 1, qb = u & 3, head_ = hkv * 4 + (wid >> 1); const size_t qrow = (size_t)NLAT + b * CTX + qb * 64 + (wid & 1) * 32;
            const abf* Kc = Kg + (size_t)(NLAT + b * CTX) * 128 + hkv * 64; const abf* Vc = Vg + (size_t)(NLAT + b * CTX) * 128 + hkv * 64;
            attn_body::attn_unit<0, 8>(Qg + qrow * 512 + head_ * 64, 512, Kc, Kc, Vc, Vc, 128, 4, 0, 0, 0.f, BR + qrow * DM + 256 + head_ * 64, DM, F.ldsg);
        } else {
            const int u = a - nGL - nWL - nGC, b = u >> 2, hkv = (u >> 1) & 1, qb = u & 1, head_ = hkv * 2 + (wid >> 2); const size_t qrow = (size_t)NLAT + b * CTX + qb * 128 + (wid & 3) * 32;
            const abf* Kc = Kw + (size_t)(NLAT + b * CTX) * 128 + hkv * 64; const abf* Vc = Vw + (size_t)(NLAT + b * CTX) * 128 + hkv * 64;
            attn_body::attn_unit<1, 8>(Qw + qrow * 256 + head_ * 64, 256, Kc, Kc, Vc, Vc, 128, 4, 0, 0, inptr(F, IN_SINK)[l * 4 + head_] * LOG2E, BR + qrow * DM + 768 + head_ * 64, DM, F.ldsg);
        }
    }
    __syncthreads();
}
#ifndef MK_N_LAUNCHES
#define MK_N_LAUNCHES 1
#endif
constexpr int N_PHASES = 2 + 9 * DEPTH;
struct Args { const float* in[21]; float* out; unsigned char* ws; int ph_lo, ph_hi, probe, pad_; };

__global__ void __launch_bounds__(NWAVES * 64, 2) hybrid_fwd(Args args) {
    extern __shared__ __attribute__((aligned(16))) unsigned char lds[];
    Frame F;
    F.lds = (LAS unsigned char*)lds; F.ldsg = (char*)lds; F.MISC = (volatile LAS unsigned*)(F.lds + MISC_OFF);
    F.G = gridDim.x; { const int bx = blockIdx.x; F.vcu = (F.G % 8 == 0) ? (bx % 8) * (F.G / 8) + bx / 8 : bx; }
    F.ws = args.ws; F.out = args.out; F.dout = (unsigned char*)args.out; F.ctl = (gu32*)(args.ws + WS_CTL);
#ifdef DBG_LDSPOISON
    for (int u = threadIdx.x; u < LDSCTL_OFF / 4; u += NWAVES * 64) ((LAS unsigned*)F.lds)[u] = 0xFFFFFFFFu;
#endif
    for (int u = threadIdx.x; u < (LDS_BYTES - LDSCTL_OFF) / 4; u += NWAVES * 64) ((LAS unsigned*)(F.lds + LDSCTL_OFF))[u] = 0u;
    __syncthreads();
    if (threadIdx.x < 21) *(LAS unsigned long long*)(F.lds + PTRS_OFF + 8 * threadIdx.x) = (unsigned long long)args.in[threadIdx.x];
    __syncthreads();
    XcdBarrier bar; bar.bar = (unsigned*)(F.ctl + CW_BAR); bar.x = 0; bar.st = nullptr;
    const int lo = args.ph_lo, hi = args.ph_hi;
    if (hi - lo > 1) bar = xcd_barrier_post((unsigned*)(F.ctl + CW_BAR), F.MISC + 8);
#ifndef PHSEL
#define PHSEL 0x7ff
#endif
#define IN(k) (lo <= (k) && (k) < hi)
#define KIND(j) ((PHSEL >> (j)) & 1)
#ifndef DBG_PROBE
#define DBG_PROBE 0
#endif
#ifndef FPROBE_MODE
#define FPROBE_MODE 0
#endif
#ifndef REP_MASK
#define REP_MASK 0
#endif
#define NREP(j, ok) ((((REP_MASK) >> (j)) & 1) && (ok) ? 2 : 1)
#define REPEAT(j, ok) for (int rep_ = 0, nrep_ = NREP(j, ok); rep_ < nrep_; ++rep_, (rep_ < nrep_ ? xcd_barrier(bar) : (void)0))
#define SEAM(k) do { if (IN(k) && IN((k) + 1)) xcd_barrier(bar); } while (0)

#ifdef BAR_PROBE
    if (hi - lo > 1) for (int i_ = 0; i_ < BAR_PROBE; ++i_) xcd_barrier(bar);
#endif
    if (KIND(0) && IN(0)) REPEAT(0, true) { p0_prologue(F, rep_ ? DBG_PROBE : 0); } SEAM(0);
    if (KIND(1) && IN(1)) REPEAT(1, true) { p1_norm1(F); } SEAM(1);
    for (int l = 0; l < DEPTH; ++l) {
        const int pb = 2 + 9 * l; const bool lastl = l == DEPTH - 1;
        const int nrt = lastl ? 64 : 72;
        if (KIND(2) && IN(pb + 0)) REPEAT(2, true) {
            Strided<DecInProj> S; S.d.A = (const char*)(F.ws + WS_HN); S.d.B = (const char*)(F.ws + WS_WIN) + (size_t)l * INW2 * DM * 2; S.d.layer = l; S.n = inproj_units(l); S.G = F.G; S.vcu = F.vcu;
            EpiInProj E; E.ABt = (bf16*)(F.ws + WS_ABT); E.ABtc = (bf16*)(F.ws + WS_ABTC);
            E.Qg = (bf16*)(F.ws + WS_QKV + QKV_QG); E.Kg = (bf16*)(F.ws + WS_QKV + QKV_KG); E.Vg = (bf16*)(F.ws + WS_QKV + QKV_VG);
            E.Qw = (bf16*)(F.ws + WS_QKV + QKV_QW); E.Kw = (bf16*)(F.ws + WS_QKV + QKV_KW); E.Vw = (bf16*)(F.ws + WS_QKV + QKV_VW);
            E.G = WSP(bf16, WS_G); E.rope = WSP(float, WS_ROPE); E.qng = inptr(F, IN_QNG) + l * 64; E.kng = inptr(F, IN_KNG) + l * 64;
            pg8::gemm_phase<EpiInProj, Strided<DecInProj>>(F.lds, (LAS int*)(F.lds + IDXBUF_OFF), S, E);
            if (!CONV_IN_ATTN && l == 0 && F.G == 256 && F.vcu >= 88 && rep_ == 0) tail_convert(F, F.vcu - 88, 0, 4, 672);
        } SEAM(pb + 0);
        if (KIND(3) && IN(pb + 1)) REPEAT(3, true) { pc_mixers(F, l, rep_); } SEAM(pb + 1);
        if (KIND(4) && IN(pb + 2)) REPEAT(4, true) {
            SchedMerge S; S.BR = (const char*)(F.ws + WS_BR); S.W = (const char*)(F.ws + WS_WBR) + (size_t)l * DM * DM * 2; S.ntiles = nrt * 4; S.G = F.G; S.vcu = F.vcu;
            EpiMerge E{WSP(bf16, WS_G), (rep_ + 1 == nrep_ && !args.probe) ? (bf16*)(F.ws + WS_MB) : WSP(bf16, WS_HN), args.probe};
            pg8::gemm_phase<EpiMerge, SchedMerge>(F.lds, (LAS int*)(F.lds + IDXBUF_OFF), S, E);
            if (!CONV_IN_ATTN && l == 0 && F.G == 256 && F.vcu >= 32 && rep_ == 0) tail_convert(F, F.vcu - 32, 672, 3, 1344);
        } SEAM(pb + 2);
        if (KIND(5) && IN(pb + 3)) REPEAT(5, l == 0) {
            Strided<DecWout> S; S.d.Mb = (const char*)(F.ws + WS_MB); S.d.W = (const char*)(F.ws + WS_WOUT) + (size_t)l * DM * DM * 2; S.n = nrt * 4; S.G = F.G; S.vcu = F.vcu;
            EpiWout E; E.baseL = inptr(F, IN_X); E.baseC = inptr(F, IN_CTX) - (size_t)NLAT * DM; E.baseX = WSP(bf16, WS_X); E.X = WSP(bf16, WS_X); E.from_x = l != 0; E.mod = WSP(float, WS_MOD) + (size_t)l * 9 * 6 * DM;
            pg8::gemm_phase<EpiWout, Strided<DecWout>>(F.lds, (LAS int*)(F.lds + IDXBUF_OFF), S, E);
            if (!CONV_IN_ATTN && l == 0 && F.G == 256 && F.vcu >= 32 && rep_ == 0) tail_convert(F, F.vcu - 32, 1344, 3, 2016);
        } SEAM(pb + 3);
        if (KIND(6) && IN(pb + 4)) REPEAT(6, true) { pf_norm2_router(F, l, rep_ ? FPROBE_MODE : 0); } SEAM(pb + 4);
        if (KIND(7) && IN(pb + 5)) REPEAT(7, true) { pg_topk_gather(F, l); } SEAM(pb + 5);
        const int ert = lastl ? 8 : 9;
        if (KIND(8) && IN(pb + 6)) REPEAT(8, true) {
            Strided<DecGU> S; S.d.H2 = (const char*)(F.ws + WS_HN); S.d.IDX = WSP(int, WS_IDX); S.d.W = (const char*)(F.ws + WS_WGU) + (size_t)l * NE * 2 * DM * DM * 2; S.d.nrt = ert; S.n = NE * ert * 8; S.G = F.G; S.vcu = F.vcu;
            EpiGU E{WSP(bf16, WS_HACT)};
            pg8::gemm_phase<EpiGU, Strided<DecGU>>(F.lds, (LAS int*)(F.lds + IDXBUF_OFF), S, E);
            if (!CONV_IN_ATTN && l == 0 && F.G == 256 && F.vcu >= 128 && rep_ == 0) tail_convert(F, F.vcu - 128, 2016, 4, 2528);
        } SEAM(pb + 6);
        if (KIND(9) && IN(pb + 7)) REPEAT(9, true) {
            Strided<DecDown> S; S.d.H = (const char*)(F.ws + WS_HACT); S.d.W = (const char*)(F.ws + WS_WD) + (size_t)l * NE * DM * DM * 2; S.d.nrt = ert; S.n = NE * ert * 4; S.G = F.G; S.vcu = F.vcu;
            EpiDown E{WSP(bf16, WS_G), WSP(float, WS_AFS)};
            pg8::gemm_phase<EpiDown, Strided<DecDown>>(F.lds, (LAS int*)(F.lds + IDXBUF_OFF), S, E);
            if (!CONV_IN_ATTN && l == 0 && F.G == 256 && F.vcu >= 64 && rep_ == 0) tail_convert(F, F.vcu - 64, 2528, 3, CONV_ITEMS);
        } SEAM(pb + 7);
        if (KIND(10) && IN(pb + 8)) REPEAT(10, true) { pj_combine(F, l, rep_); }
        if (!lastl) SEAM(pb + 8);
    }
#undef IN
#undef SEAM
}

#ifdef DBG_STOP
__global__ void k_dump(const unsigned short* __restrict__ src, float* __restrict__ out, size_t n) {
    for (size_t i = (size_t)blockIdx.x * blockDim.x + threadIdx.x; i < n; i += (size_t)gridDim.x * blockDim.x) out[i] = __uint_as_float((unsigned)src[i] << 16);
}
#endif
extern "C" void kernel_launch(void* const* d_in, const int* in_sizes, int n_in, void* d_out, int out_size, void* d_ws, size_t ws_size, hipStream_t stream) {
    static int grid = 0;
    if (grid == 0) {
        if (n_in != 21 || out_size != NLAT * DM || ws_size < WS_END) { fprintf(stderr, "kernel_launch: unexpected problem (n_in %d, out %d, ws %zu < %zu)\n", n_in, out_size, ws_size, (size_t)WS_END); grid = -1; return; }
        int dev = 0, cus = 0, per_cu = 0;
        if (hipGetDevice(&dev) != hipSuccess || hipDeviceGetAttribute(&cus, hipDeviceAttributeMultiprocessorCount, dev) != hipSuccess) { grid = -1; return; }
        if (hipFuncSetAttribute((const void*)hybrid_fwd, hipFuncAttributeMaxDynamicSharedMemorySize, LDS_BYTES) != hipSuccess) { fprintf(stderr, "kernel_launch: hipFuncSetAttribute failed\n"); grid = -1; return; }
        if (hipOccupancyMaxActiveBlocksPerMultiprocessor(&per_cu, (const void*)hybrid_fwd, NWAVES * 64, LDS_BYTES) != hipSuccess || per_cu < 1) { fprintf(stderr, "kernel_launch: occupancy query says %d blocks/CU\n", per_cu); per_cu = 1; }
        (void)hipGetLastError();
        grid = cus * 1;
    }
    if (grid < 0) return;
    hipMemsetAsync((char*)d_ws + WS_CTL, 0, CTL_ZERO_BYTES, stream);
    Args a; memset(&a, 0, sizeof(a));
    for (int i = 0; i < 21; ++i) a.in[i] = (const float*)d_in[i];
    a.out = (float*)d_out; a.ws = (unsigned char*)d_ws;
#if MK_N_LAUNCHES == 1
    a.ph_lo = 0; a.ph_hi = N_PHASES;
    hipLaunchKernelGGL(hybrid_fwd, dim3(grid), dim3(NWAVES * 64), LDS_BYTES, stream, a);
#else
    int nph_ = N_PHASES;
#ifdef DBG_STOP
    nph_ = DBG_STOP;
#endif
    for (int p = 0; p < nph_; ++p) { a.ph_lo = p; a.ph_hi = p + 1; hipLaunchKernelGGL(hybrid_fwd, dim3(grid), dim3(NWAVES * 64), LDS_BYTES, stream, a);
#ifdef DBG_DUP_PHASE
        if (p == DBG_DUP_PHASE) { a.probe = DBG_PROBE; hipLaunchKernelGGL(hybrid_fwd, dim3(grid), dim3(NWAVES * 64), LDS_BYTES, stream, a); a.probe = 0; }
#endif
    }
#ifdef DBG_STOP
    hipLaunchKernelGGL(k_dump, dim3(2048), dim3(256), 0, stream, (const unsigned short*)((const char*)d_ws + ((size_t)DBG_DUMP_MIB << 20)), (float*)d_out, (size_t)NLAT * DM);
#endif
#endif
}
```

```cpp
#define MK_N_LAUNCHES 1
#include <hip/hip_runtime.h>
#include <hip/hip_bf16.h>
#include <cstdio>
#include <cstdint>
#include <cmath>
#include <cstring>

constexpr int DM = 1024, NBATCH = 8, SEQ = 2048, CTX = 256, DEPTH = 2;
constexpr int NLAT = NBATCH * SEQ, NCTX = NBATCH * CTX, NTOK = NLAT + NCTX;
constexpr int INW = 4608, NCOLT = 19, INW2 = NCOLT * 256;
constexpr int NE = 16, CAPL = 256, CAPC = 32, RPE = NBATCH * (CAPL + CAPC);
constexpr float EPS = 1e-6f;
constexpr float QSCALE = 0.125f * 1.4426950408889634f;
constexpr float LOG2E = 1.4426950408889634f;
namespace pg8 {
#define PG8_LAS __attribute__((address_space(3)))
typedef unsigned short bf16_t;
typedef short bf16x8 __attribute__((ext_vector_type(8)));
typedef float f32x4 __attribute__((ext_vector_type(4)));
typedef unsigned u32x4 __attribute__((ext_vector_type(4)));
typedef unsigned u32x2 __attribute__((ext_vector_type(2)));
constexpr int BM = 256, BK = 64, HALF = 128, HTB = HALF * BK * 2  , STAGE_BYTES = 8 * HTB;

__host__ __device__ __forceinline__ int lds_byte(int r, int c) { const int st = (r >> 4) * 2 + (c >> 5), rr = r & 15, cc = c & 31, ob = rr * 64 + cc * 2; return st * 1024 + (ob ^ (((ob >> 9) & 1) << 5)); }
__host__ __device__ __forceinline__ int perm32(int rho) { const int n = rho >> 4, i = rho & 15; return 8 * (i >> 2) + 4 * n + (i & 3); }
__host__ __device__ __forceinline__ void stage_rc(int b, int& R, int& C) { const int st = b / 1024, sb = b % 1024, swz = sb ^ (((sb >> 9) & 1) << 5); R = (st >> 1) * 16 + swz / 64; C = (st & 1) * 32 + (swz % 64) / 2; }

struct Unit { const char* A; const char* B; const int* arows; int ldA, ldB, nt; int pm, pn, tag; };

typedef float f32x2_c __attribute__((ext_vector_type(2)));
typedef __bf16 bf16x2_c __attribute__((ext_vector_type(2)));
__device__ __forceinline__ unsigned cvt_pk_bf16(float lo, float hi) { const f32x2_c v = {lo, hi}; const bf16x2_c b = __builtin_convertvector(v, bf16x2_c); return __builtin_bit_cast(unsigned, b); }

template <class Epi, class Sched>
__device__ __forceinline__ void gemm_phase(PG8_LAS unsigned char* lds, PG8_LAS int* idxbuf  , const Sched& S, const Epi& E) {
    int tid = threadIdx.x; asm volatile("" : "+v"(tid));
    const int wid = __builtin_amdgcn_readfirstlane(tid >> 6), lane = tid & 63, wr = wid >> 2, wc = wid & 3, fr = lane & 15, fq = lane >> 4;
    unsigned Rr[2], RrB[2], Cc2[2];
#pragma unroll
    for (int i = 0; i < 2; ++i) { int R, C; stage_rc(tid * 16 + i * 8192, R, C); Rr[i] = (unsigned)R; RrB[i] = Epi::PERM ? (unsigned)((R & ~31) + perm32(R & 31)) : (unsigned)R; Cc2[i] = (unsigned)C * 2u; }
    const size_t kstep = (size_t)(BK * 2);
    const unsigned ldsw = (unsigned)wid * 1024u;
    const int aoff = lds_byte(wr * 64 + fr, fq * 8), boff = lds_byte(wc * 32 + fr, fq * 8);
#define PG8_SA(b, h) (((b) * 2 + (h)) * HTB)
#define PG8_SB(b, h) ((4 + (b) * 2 + (h)) * HTB)
#define PG8_STAGE(bufoff, gbase, ld) do { _Pragma("unroll") for (int _i = 0; _i < 2; ++_i) \
        __builtin_amdgcn_global_load_lds((const unsigned*)((const char*)(gbase) + (RrB[_i] * (unsigned)(ld) + Cc2[_i])), (PG8_LAS unsigned*)(lds + (bufoff) + ldsw + _i * 8192), 16, 0, 0); } while (0)
#define PG8_STAGE_A(bufoff, gbase, ao) do { _Pragma("unroll") for (int _i = 0; _i < 2; ++_i) \
        __builtin_amdgcn_global_load_lds((const unsigned*)((const char*)(gbase) + (ao)[_i]), (PG8_LAS unsigned*)(lds + (bufoff) + ldsw + _i * 8192), 16, 0, 0); } while (0)
#define PG8_AOFF(u, ao) do { _Pragma("unroll") for (int _h = 0; _h < 2; ++_h) _Pragma("unroll") for (int _i = 0; _i < 2; ++_i) { \
        const unsigned _row = (u).arows ? (unsigned)idxbuf[Rr[_i] + 128 * _h] : Rr[_i] + 128u * _h; (ao)[_h][_i] = _row * (unsigned)(u).ldA + Cc2[_i]; } } while (0)
#define PG8_STAGE_IDX(u) do { if ((u).arows) __builtin_amdgcn_global_load_lds((const unsigned*)((u).arows + (wid & 3) * 64 + lane), (PG8_LAS unsigned*)((PG8_LAS unsigned char*)idxbuf + (wid & 3) * 256), 4, 0, 0); } while (0)
#define PG8_LDA(dst, b, h) do { _Pragma("unroll") for (int m = 0; m < 4; ++m) _Pragma("unroll") for (int k = 0; k < 2; ++k) dst[m][k] = *(const PG8_LAS bf16x8*)(lds + PG8_SA(b, h) + aoff + m * 2048 + k * 1024); } while (0)
#define PG8_LDB(dst, b, h) do { _Pragma("unroll") for (int n = 0; n < 2; ++n) _Pragma("unroll") for (int k = 0; k < 2; ++k) dst[n][k] = *(const PG8_LAS bf16x8*)(lds + PG8_SB(b, h) + boff + n * 2048 + k * 1024); } while (0)
#define PG8_MMA(ai, bj, At, Bt) do { __builtin_amdgcn_s_setprio(1); _Pragma("unroll") for (int m = 0; m < 4; ++m) _Pragma("unroll") for (int n = 0; n < 2; ++n) _Pragma("unroll") for (int k = 0; k < 2; ++k) \
        acc[ai][bj][m][n] = __builtin_amdgcn_mfma_f32_16x16x32_bf16(Bt[n][k], At[m][k], acc[ai][bj][m][n], 0, 0, 0); __builtin_amdgcn_s_setprio(0); } while (0)
#define PG8_WAIT_V(n) asm volatile("s_waitcnt vmcnt(" #n ")" ::: "memory")
#define PG8_WAIT_L(n) asm volatile("s_waitcnt lgkmcnt(" #n ")" ::: "memory")
#define PG8_BAR __builtin_amdgcn_s_barrier()
#define PG8_SCHED __builtin_amdgcn_sched_barrier(0)
    Unit cur, nxt; int ui = 0;
    if (!S.next(0, cur)) return;
    nxt = cur;
    f32x4 acc[2][2][4][2];
#pragma unroll
    for (int a = 0; a < 2; ++a)
#pragma unroll
        for (int b = 0; b < 2; ++b)
#pragma unroll
            for (int m = 0; m < 4; ++m)
#pragma unroll
                for (int n = 0; n < 2; ++n) acc[a][b][m][n] = (f32x4){0.f, 0.f, 0.f, 0.f};
    bf16x8 At[4][2], B0[2][2], B1[2][2];
    const char* cA = cur.A; const char* cB = cur.B; int clb = cur.ldB;
    unsigned ao_c[2][2], ao_n[2][2];
    if (cur.arows) { PG8_STAGE_IDX(cur); PG8_WAIT_V(0); PG8_BAR; }
    PG8_AOFF(cur, ao_c);
#pragma unroll
    for (int _h = 0; _h < 2; ++_h)
#pragma unroll
        for (int _i = 0; _i < 2; ++_i) ao_n[_h][_i] = ao_c[_h][_i];
    if (cur.arows) { PG8_WAIT_L(0); PG8_BAR; }
    {
        const size_t hB = (size_t)HALF * clb;
        PG8_STAGE(PG8_SB(0, 0), cB, clb); PG8_STAGE(PG8_SB(0, 1), cB + hB, clb); PG8_STAGE_A(PG8_SA(0, 0), cA, ao_c[0]); PG8_STAGE_A(PG8_SA(0, 1), cA, ao_c[1]);
        if (wr == 1) PG8_BAR;
        PG8_WAIT_V(2); PG8_BAR;
        PG8_STAGE(PG8_SB(1, 0), cB + kstep, clb); PG8_STAGE_A(PG8_SA(1, 0), cA + kstep, ao_c[0]); PG8_STAGE(PG8_SB(1, 1), cB + hB + kstep, clb);
        PG8_WAIT_V(6); PG8_BAR;
    }
    for (;;) {
        const bool has_next = S.next(ui + 1, nxt);
        const char* nA = has_next ? nxt.A : cA; const char* nB = has_next ? nxt.B : cB; const int nlb = has_next ? nxt.ldB : clb;
        const int nt = cur.nt;
        if (has_next) PG8_STAGE_IDX(nxt);
        for (int t = 0; t < nt; t += 2) {
            const bool last = (t == nt - 2);
            if (last) { if (has_next) { PG8_AOFF(nxt, ao_n); } else {
#pragma unroll
                for (int _h = 0; _h < 2; ++_h)
#pragma unroll
                    for (int _i = 0; _i < 2; ++_i) ao_n[_h][_i] = ao_c[_h][_i]; } }
            unsigned ao2[2][2];
#pragma unroll
            for (int _h = 0; _h < 2; ++_h)
#pragma unroll
                for (int _i = 0; _i < 2; ++_i) ao2[_h][_i] = last ? ao_n[_h][_i] : ao_c[_h][_i];
            const char* a1 = cA + (size_t)(t + 1) * kstep;
            const char* a2 = last ? nA : cA + (size_t)(t + 2) * kstep; const char* b2 = last ? nB : cB + (size_t)(t + 2) * kstep;
            const int lb2 = last ? nlb : clb;
            const size_t hB2 = (size_t)HALF * lb2;
            const char* a3 = a2 + kstep; const char* b3 = b2 + kstep;
            PG8_LDB(B0, 0, 0); PG8_LDB(B1, 0, 1); PG8_SCHED; PG8_LDA(At, 0, 0); PG8_STAGE_A(PG8_SA(1, 1), a1, ao_c[1]);
            PG8_WAIT_V(8); PG8_WAIT_L(0); PG8_BAR; PG8_MMA(0, 0, At, B0); PG8_MMA(0, 1, At, B1); PG8_BAR; PG8_SCHED;
            PG8_LDA(At, 0, 1); PG8_STAGE(PG8_SB(0, 0), b2, lb2); PG8_STAGE(PG8_SB(0, 1), b2 + hB2, lb2); PG8_STAGE_A(PG8_SA(0, 0), a2, ao2[0]);
            PG8_WAIT_V(8); PG8_WAIT_L(0); PG8_BAR; PG8_MMA(1, 0, At, B0); PG8_MMA(1, 1, At, B1); PG8_BAR; PG8_SCHED;
            PG8_LDB(B0, 1, 0); PG8_LDB(B1, 1, 1); PG8_SCHED; PG8_LDA(At, 1, 0); PG8_STAGE_A(PG8_SA(0, 1), a2, ao2[1]);
            PG8_WAIT_V(8); PG8_WAIT_L(0); PG8_BAR; PG8_MMA(0, 0, At, B0); PG8_MMA(0, 1, At, B1); PG8_BAR; PG8_SCHED;
            PG8_LDA(At, 1, 1); PG8_STAGE(PG8_SB(1, 0), b3, lb2); PG8_STAGE(PG8_SB(1, 1), b3 + hB2, lb2); PG8_STAGE_A(PG8_SA(1, 0), a3, ao2[0]);
            PG8_WAIT_V(8); PG8_WAIT_L(0); PG8_BAR; PG8_MMA(1, 0, At, B0); PG8_MMA(1, 1, At, B1); PG8_BAR; PG8_SCHED;
        }
        if (wr == 0) PG8_BAR;
        bool keep_acc;
        { Unit eu = cur; int ewr = wr, ewc = wc, efr = fr, efq = fq; asm volatile("" : "+s"(eu.pm), "+s"(eu.pn), "+s"(eu.tag), "+s"(ewr), "+s"(ewc), "+v"(efr), "+v"(efq));
          keep_acc = E(acc, eu, ewr, ewc, efr, efq); }
        if (!has_next) break;
        if (!keep_acc) {
#pragma unroll
        for (int a = 0; a < 2; ++a)
#pragma unroll
            for (int b = 0; b < 2; ++b)
#pragma unroll
                for (int m = 0; m < 4; ++m)
#pragma unroll
                    for (int n = 0; n < 2; ++n) acc[a][b][m][n] = (f32x4){0.f, 0.f, 0.f, 0.f};
        }
        cur = nxt; cA = nA; cB = nB; clb = nlb; ++ui;
#pragma unroll
        for (int _h = 0; _h < 2; ++_h)
#pragma unroll
            for (int _i = 0; _i < 2; ++_i) ao_c[_h][_i] = ao_n[_h][_i];
        if (wr == 1) PG8_BAR;
    }
    PG8_WAIT_V(0);
    PG8_BAR;
#undef PG8_SA
#undef PG8_SB
#undef PG8_STAGE
#undef PG8_STAGE_A
#undef PG8_AOFF
#undef PG8_STAGE_IDX
#undef PG8_LDA
#undef PG8_LDB
#undef PG8_MMA
#undef PG8_WAIT_V
#undef PG8_WAIT_L
#undef PG8_BAR
#undef PG8_SCHED
}
}
#include <hip/hip_bf16.h>
#include <cmath>
namespace attn_body {
using bf16=__hip_bfloat16;
using bf16x8=__attribute__((ext_vector_type(8)))short;
using s16x4=__attribute__((ext_vector_type(4)))short;
using f32x16=__attribute__((ext_vector_type(16)))float;
using u32x4=__attribute__((ext_vector_type(4)))unsigned;
constexpr int D=64;
constexpr int NW=8,QBLK=32,KVBLK=64,NCT=4;
__device__ __forceinline__ int crow(int r,int hi){return (r&3)+8*(r>>2)+4*hi;}
#define SBAR() __builtin_amdgcn_sched_barrier(0)
__device__ __forceinline__ void wmask(f32x16&p0,f32x16&p1,int kb,int qabs,int hi){
  const float NEG=-INFINITY; const int d0=kb+4*hi-qabs;
  #pragma unroll
  for(int r=0;r<16;++r){int dd=d0+(r&3)+8*(r>>2); if(dd>128||dd<-128)p0[r]=NEG; if(dd+32>128||dd+32<-128)p1[r]=NEG;}
}

constexpr int NSLOT=3, SLOTB=8192;
constexpr int LDS_K=0, LDS_V=NSLOT*SLOTB, LDS_WS=2*NSLOT*SLOTB, LDS_OST=LDS_WS+NW*64*4, LDS_BYTES=LDS_OST+NW*4096;
__device__ __forceinline__ void glds16(const void*gsrc,unsigned lds_dst){unsigned keep;
  asm volatile("s_mov_b32 %0, m0\n\ts_mov_b32 m0, %2\n\ts_nop 0\n\tglobal_load_lds_dwordx4 %1, off\n\ts_mov_b32 m0, %0":"=&s"(keep):"v"(gsrc),"s"(lds_dst):"memory");}
__device__ __forceinline__ float max3f(float a,float b,float c){float r;asm("v_max3_f32 %0, %1, %2, %3":"=v"(r):"v"(a),"v"(b),"v"(c));return r;}
__device__ __forceinline__ float max2f(float a,float b){float r;asm("v_max_f32_e32 %0, %1, %2":"=v"(r):"v"(a),"v"(b));return r;}
__device__ __forceinline__ float fadd_s(float a,float b){float r;asm("v_add_f32_e32 %0, %1, %2":"=v"(r):"v"(a),"v"(b));return r;}
__device__ __forceinline__ float fsub_s(float a,float b){float r;asm("v_sub_f32_e32 %0, %1, %2":"=v"(r):"v"(a),"v"(b));return r;}
typedef float f32x2_t __attribute__((ext_vector_type(2))); typedef __bf16 bf16x2_t __attribute__((ext_vector_type(2)));
__device__ __forceinline__ unsigned cvtpk_s(float lo,float hi){f32x2_t v={lo,hi};bf16x2_t b=__builtin_convertvector(v,bf16x2_t);return __builtin_bit_cast(unsigned,b);}
#define WAIT_BAR(N) asm volatile("s_waitcnt vmcnt(" #N ") lgkmcnt(0)\n\ts_barrier":::"memory")

__device__ __forceinline__ void qkt(f32x16&p0,f32x16&p1,const char*Kslot,const bf16x8*qr,const f32x16&negm,int r32,int hi){
  const char*kb=Kslot+hi*1024+r32*16;
  #pragma unroll
  for(int d0=0;d0<4;++d0){
    const bf16x8 b0=*reinterpret_cast<const bf16x8*>(kb+d0*2048);
    const bf16x8 b1=*reinterpret_cast<const bf16x8*>(kb+d0*2048+512);
    if(d0==0){p0=__builtin_amdgcn_mfma_f32_32x32x16_bf16(b0,qr[0],negm,0,0,0);p1=__builtin_amdgcn_mfma_f32_32x32x16_bf16(b1,qr[0],negm,0,0,0);}
    else{p0=__builtin_amdgcn_mfma_f32_32x32x16_bf16(b0,qr[d0],p0,0,0,0);p1=__builtin_amdgcn_mfma_f32_32x32x16_bf16(b1,qr[d0],p1,0,0,0);}}
}
typedef __attribute__((address_space(3))) const char* lds_cptr;
typedef short v4i16_t __attribute__((ext_vector_type(4)));
__device__ __forceinline__ void kload8(bf16x8*kf,lds_cptr kp){
  kf[0]=*(const __attribute__((address_space(3))) bf16x8*)(kp);      kf[1]=*(const __attribute__((address_space(3))) bf16x8*)(kp+512);
  kf[2]=*(const __attribute__((address_space(3))) bf16x8*)(kp+2048); kf[3]=*(const __attribute__((address_space(3))) bf16x8*)(kp+2560);
  kf[4]=*(const __attribute__((address_space(3))) bf16x8*)(kp+4096); kf[5]=*(const __attribute__((address_space(3))) bf16x8*)(kp+4608);
  kf[6]=*(const __attribute__((address_space(3))) bf16x8*)(kp+6144); kf[7]=*(const __attribute__((address_space(3))) bf16x8*)(kp+6656);
}
__device__ __forceinline__ void kload2(bf16x8*kf,lds_cptr kp,int j){ kf[2*j]=*(const __attribute__((address_space(3))) bf16x8*)(kp+j*2048); kf[2*j+1]=*(const __attribute__((address_space(3))) bf16x8*)(kp+j*2048+512); }
__device__ __forceinline__ s16x4 vtr(lds_cptr p){ return __builtin_bit_cast(s16x4,__builtin_amdgcn_ds_read_tr16_b64_v4i16((__attribute__((address_space(3))) v4i16_t*)p)); }
__device__ __forceinline__ float rowmax(const f32x16&p0,const f32x16&p1){
  float a=max3f(p0[0],p0[1],p1[0]),b=max3f(p0[2],p0[3],p1[1]);a=max3f(a,p1[2],p1[3]);
  #pragma unroll
  for(int r=4;r<16;r+=4){a=max3f(a,p0[r],p0[r+1]);b=max3f(b,p0[r+2],p0[r+3]);a=max3f(a,p1[r],p1[r+1]);b=max3f(b,p1[r+2],p1[r+3]);}
  const float m=max2f(a,b);
  auto rr=__builtin_amdgcn_permlane32_swap(__float_as_uint(m),__float_as_uint(m),false,false);
  return max2f(__uint_as_float(rr[0]),__uint_as_float(rr[1]));
}
__device__ __forceinline__ void pv(f32x16*o,int vb,bf16x8 pa0,bf16x8 pa1,bf16x8 pa2,bf16x8 pa3){
  #pragma unroll
  for(int d0=0;d0<2;++d0){s16x4 lo[4],hi[4];
    #pragma unroll
    for(int ks=0;ks<4;++ks){
      asm volatile("ds_read_b64_tr_b16 %0,%1 offset:%c2":"=&v"(lo[ks]):"v"(vb),"i"(d0*4096+ks*1024):"memory");
      asm volatile("ds_read_b64_tr_b16 %0,%1 offset:%c2":"=&v"(hi[ks]):"v"(vb),"i"(d0*4096+ks*1024+512):"memory");}
    asm volatile("s_waitcnt lgkmcnt(0)":::"memory");SBAR();
    #define PK(k) (bf16x8){lo[k][0],lo[k][1],lo[k][2],lo[k][3],hi[k][0],hi[k][1],hi[k][2],hi[k][3]}
    o[d0]=__builtin_amdgcn_mfma_f32_32x32x16_bf16(pa0,PK(0),o[d0],0,0,0);
    o[d0]=__builtin_amdgcn_mfma_f32_32x32x16_bf16(pa1,PK(1),o[d0],0,0,0);
    o[d0]=__builtin_amdgcn_mfma_f32_32x32x16_bf16(pa2,PK(2),o[d0],0,0,0);
    o[d0]=__builtin_amdgcn_mfma_f32_32x32x16_bf16(pa3,PK(3),o[d0],0,0,0);
    #undef PK
  }
}

#ifndef ATTN_STORE16
#define ATTN_STORE16(p,v) (*(u32x4*)(p)=(v))
#endif
template<int MODE,int THRL> __device__ __forceinline__ void attn_unit(const bf16*Qw,int qp,const bf16*Kc,const bf16*Kl,const bf16*Vc,const bf16*Vl,int kp,int NT,int qabs,int band0,float sinkl2,bf16*Ow,int op,char*shm){
  int tid=threadIdx.x; asm volatile("":"+v"(tid));
  const int lane=tid&63,r32=lane&31,hi=lane>>5; const int wid=__builtin_amdgcn_readfirstlane(tid>>6);
  qabs+=r32;
  const unsigned lds0=(unsigned)(uintptr_t)shm;
  float*wsf=(float*)(shm+LDS_WS)+wid*64;
  const unsigned koff_=(unsigned)(lane*kp+wid*8)*2u;
  const unsigned voff_=(unsigned)((16*(wid&3)+(lane>>2))*kp+(wid>>2)*32+(lane&3)*8)*2u;
  const unsigned kdst=lds0+LDS_K+wid*1024, vdst=lds0+LDS_V+wid*1024;
  #define DMA_K(t,slot) glds16((const char*)((t)<NCT?Kc+(long)(t)*KVBLK*kp:Kl+(long)((t)-NCT)*KVBLK*kp)+koff_,(unsigned)__builtin_amdgcn_readfirstlane(kdst+(slot)))
  #define DMA_V(t,slot) glds16((const char*)((t)<NCT?Vc+(long)(t)*KVBLK*kp:Vl+(long)((t)-NCT)*KVBLK*kp)+voff_,(unsigned)__builtin_amdgcn_readfirstlane(vdst+(slot)))
  const int vb0=(int)(lds0+LDS_V)+((lane>>4)&1)*32+(lane&3)*8+(4*hi+((lane&15)>>2))*64;
  const char*Kbase=shm+LDS_K; bf16x8 kf[8];
  const lds_cptr shm3=(lds_cptr)shm; const lds_cptr kp0=shm3+LDS_K+hi*1024+r32*16; const lds_cptr vp0=shm3+LDS_V+((lane>>4)&1)*32+(lane&3)*8+(4*hi+((lane&15)>>2))*64;
  DMA_K(0,0);DMA_V(0,0);DMA_K(1,SLOTB);
  bf16x8 qr[4];
  #pragma unroll
  for(int d0=0;d0<4;++d0)qr[d0]=*reinterpret_cast<const bf16x8*>(&Qw[(long)r32*qp+d0*16+hi*8]);
  float mhat=0.f,l_reg=0.f;f32x16 o[2];o[0]=f32x16{};o[1]=f32x16{};f32x16 negm=f32x16{};asm volatile("":"+v"(negm));
  #define CMASK(P0,P1,t) do{ if(MODE==1){ if((t)>=NCT)wmask(P0,P1,band0+KVBLK*((t)-NCT),qabs,hi);} }while(0)
  bool resc=false;
  #define START(P0,P1) do{ const float rm=rowmax(P0,P1); resc=false; \
    { const float dl=rm; mhat=fadd_s(mhat,dl); \
      _Pragma("unroll") for(int r=0;r<16;++r){P0[r]=fsub_s(P0[r],dl);P1[r]=fsub_s(P1[r],dl);} \
      _Pragma("unroll") for(int r=0;r<16;++r)negm[r]=-mhat; asm volatile("":"+v"(negm)); } \
    _Pragma("unroll") for(int r=0;r<16;++r)P0[r]=__builtin_amdgcn_exp2f(P0[r]); }while(0)
  #define RESC() do{ if(resc){ asm volatile("s_waitcnt lgkmcnt(0)":::"memory"); \
      _Pragma("unroll") for(int d_=0;d_<2;++d_) _Pragma("unroll") for(int r=0;r<16;++r)o[d_][r]*=wsf[crow(r,hi)]; } }while(0)
  f32x16 pA0,pA1,pB0,pB1;
  int sl_prev=0,sl_cur=0,sl_next=SLOTB;
  #define ROT() do{sl_prev=sl_cur;sl_cur=sl_next;sl_next=(sl_next==(NSLOT-1)*SLOTB)?0:sl_next+SLOTB;}while(0)
  DMA_K(2,2*SLOTB);
  WAIT_BAR(3);
  qkt(pA0,pA1,Kbase,qr,negm,r32,hi);asm volatile("s_nop 15\n\ts_nop 7":"+v"(pA0),"+v"(pA1));CMASK(pA0,pA1,0);
  START(pA0,pA1);
  _Pragma("unroll") for(int r=0;r<16;++r)pA1[r]=__builtin_amdgcn_exp2f(pA1[r]);
  WAIT_BAR(0);
  DMA_K(3,0);DMA_V(1,SLOTB);
  ROT();
  kload8(kf,kp0+sl_cur);
  WAIT_BAR(2);
  s16x4 vlo[8],vhi[8]; u32x4 pw0,pw1,pw2,pw3;
  #define PKW(P,B) cvtpk_s(P[B],P[B+1])
  #define PAF(k) __builtin_bit_cast(bf16x8,pw##k)
  #define VFR(i) (bf16x8){vlo[i][0],vlo[i][1],vlo[i][2],vlo[i][3],vhi[i][0],vhi[i][1],vhi[i][2],vhi[i][3]}
  #define PIN(x) asm volatile("":"+v"(x))
  #define MX3(a,b,c) __builtin_fmaxf(__builtin_fmaxf((a),(b)),(c))
  #define GAPA(MF,A0,A1,A2,A3,W0,W1,PW) do{ MF; sacc+=A0; sacc+=A1; sacc+=A2; sacc+=A3; PIN(sacc); W0; W1; PIN(PW); SBAR(); }while(0)
  #define EX(v) __builtin_amdgcn_exp2f(v)
  #define GAPB(MF,X,B) do{ MF; X[B]=EX(X[B]); X[B+1]=EX(X[B+1]); X[B+2]=EX(X[B+2]); X[B+3]=EX(X[B+3]); PIN(X); SBAR(); }while(0)
  #define VRD(i) do{ vlo[i]=vtr(vp_+(((i)>>2)*4096+((i)&3)*1024)); vhi[i]=vtr(vp_+(((i)>>2)*4096+((i)&3)*1024+512)); }while(0)
  #define KRD(G,j) do{ if(G){ kload2(kf,kp0+sl_next,j); SBAR(); } }while(0)
  #define STEP(C0,C1,P0,P1,t,GK,GV,GL) do{ SBAR(); \
    const lds_cptr vp_=vp0+sl_prev; \
    VRD(0); SBAR(); float sacc=(P0[0]+P0[1]); \
    GAPA(C0=__builtin_amdgcn_mfma_f32_32x32x16_bf16(kf[0],qr[0],negm,0,0,0), P0[2],P0[3],P0[4],P0[5],     pw0[0]=PKW(P0,0), pw0[1]=PKW(P0,2), pw0); \
    VRD(4); SBAR(); GAPA(C1=__builtin_amdgcn_mfma_f32_32x32x16_bf16(kf[1],qr[0],negm,0,0,0), P0[6],P0[7],P0[8],P0[9],     pw0[2]=PKW(P0,4), pw0[3]=PKW(P0,6), pw0); \
    VRD(1); SBAR(); GAPA(C0=__builtin_amdgcn_mfma_f32_32x32x16_bf16(kf[2],qr[1],C0,0,0,0),   P0[10],P0[11],P0[12],P0[13], pw1[0]=PKW(P0,8), pw1[1]=PKW(P0,10), pw1); \
    VRD(5); SBAR(); GAPA(C1=__builtin_amdgcn_mfma_f32_32x32x16_bf16(kf[3],qr[1],C1,0,0,0),   P0[14],P0[15],P1[0],P1[1],   pw1[2]=PKW(P0,12),pw1[3]=PKW(P0,14), pw1); \
    VRD(2); SBAR(); GAPA(C0=__builtin_amdgcn_mfma_f32_32x32x16_bf16(kf[4],qr[2],C0,0,0,0),   P1[2],P1[3],P1[4],P1[5],     pw2[0]=PKW(P1,0), pw2[1]=PKW(P1,2), pw2); \
    VRD(6); SBAR(); GAPA(C1=__builtin_amdgcn_mfma_f32_32x32x16_bf16(kf[5],qr[2],C1,0,0,0),   P1[6],P1[7],P1[8],P1[9],     pw2[2]=PKW(P1,4), pw2[3]=PKW(P1,6), pw2); \
    VRD(3); SBAR(); GAPA(C0=__builtin_amdgcn_mfma_f32_32x32x16_bf16(kf[6],qr[3],C0,0,0,0),   P1[10],P1[11],P1[12],P1[13], pw3[0]=PKW(P1,8), pw3[1]=PKW(P1,10), pw3); \
    VRD(7); SBAR(); GAPA(C1=__builtin_amdgcn_mfma_f32_32x32x16_bf16(kf[7],qr[3],C1,0,0,0),   P1[14],P1[15],0.f,0.f,       pw3[2]=PKW(P1,12),pw3[3]=PKW(P1,14), pw3); \
    l_reg+=sacc; \
    if(GK){DMA_K((t)+3,sl_cur);} if(GV){DMA_V((t)+1,sl_next);} \
    CMASK(C0,C1,t); \
    { float a=MX3(C0[0],C0[1],C1[0]),b=MX3(C0[2],C0[3],C1[1]); a=MX3(a,C1[2],C1[3]); \
      _Pragma("unroll") for(int r=4;r<16;r+=4){a=MX3(a,C0[r],C0[r+1]);b=MX3(b,C0[r+2],C0[r+3]);a=MX3(a,C1[r],C1[r+1]);b=MX3(b,C1[r+2],C1[r+3]);} \
      float rm=__builtin_fmaxf(a,b); { auto rr=__builtin_amdgcn_permlane32_swap(__float_as_uint(rm),__float_as_uint(rm),false,false); rm=__builtin_fmaxf(__uint_as_float(rr[0]),__uint_as_float(rr[1])); } \
      resc=false; \
      if(__builtin_expect(__any(rm>(float)THRL),0)){ const float dl=__builtin_fmaxf(rm,0.f); mhat+=dl; \
        _Pragma("unroll") for(int r=0;r<16;++r){C0[r]-=dl;C1[r]-=dl;} \
        _Pragma("unroll") for(int r=0;r<16;++r)negm[r]=-mhat; asm volatile("":"+v"(negm)); \
        const float f=__builtin_amdgcn_exp2f(-dl); l_reg*=f; if(hi==0)wsf[r32]=f; resc=true; } } \
    SBAR(); \
    GAPB(o[0]=__builtin_amdgcn_mfma_f32_32x32x16_bf16(PAF(0),VFR(0),o[0],0,0,0), C0,0); \
    GAPB(o[1]=__builtin_amdgcn_mfma_f32_32x32x16_bf16(PAF(0),VFR(4),o[1],0,0,0), C0,4); \
    KRD(GL,0); GAPB(o[0]=__builtin_amdgcn_mfma_f32_32x32x16_bf16(PAF(1),VFR(1),o[0],0,0,0), C0,8); \
    KRD(GL,1); GAPB(o[1]=__builtin_amdgcn_mfma_f32_32x32x16_bf16(PAF(1),VFR(5),o[1],0,0,0), C0,12); \
    KRD(GL,2); GAPB(o[0]=__builtin_amdgcn_mfma_f32_32x32x16_bf16(PAF(2),VFR(2),o[0],0,0,0), C1,0); \
    KRD(GL,3); GAPB(o[1]=__builtin_amdgcn_mfma_f32_32x32x16_bf16(PAF(2),VFR(6),o[1],0,0,0), C1,4); \
    GAPB(o[0]=__builtin_amdgcn_mfma_f32_32x32x16_bf16(PAF(3),VFR(3),o[0],0,0,0), C1,8); \
    GAPB(o[1]=__builtin_amdgcn_mfma_f32_32x32x16_bf16(PAF(3),VFR(7),o[1],0,0,0), C1,12); \
    }while(0)
  int t=1;
  for(;t+5<NT;t+=2){
    STEP(pB0,pB1,pA0,pA1,t,true,true,true);     WAIT_BAR(2); RESC(); ROT();
    STEP(pA0,pA1,pB0,pB1,t+1,true,true,true);   WAIT_BAR(2); RESC(); ROT();
  }
  #define ENDW(tt) do{ if((tt)+3<NT){WAIT_BAR(2);} else if((tt)+2<NT){WAIT_BAR(1);} else {WAIT_BAR(0);} }while(0)
  for(;t+1<NT;t+=2){
    STEP(pB0,pB1,pA0,pA1,t,(t+3<NT),(t+1<NT),(t+1<NT));       ENDW(t);   RESC(); ROT();
    STEP(pA0,pA1,pB0,pB1,t+1,(t+4<NT),(t+2<NT),(t+2<NT));     ENDW(t+1); RESC(); ROT();
  }
  STEP(pB0,pB1,pA0,pA1,NT-1,false,false,false); RESC();
  { float sacc=pB0[0]+pB0[1]; _Pragma("unroll") for(int r=2;r<16;++r)sacc+=pB0[r]; _Pragma("unroll") for(int r=0;r<16;++r)sacc+=pB1[r]; l_reg+=sacc;
    pw0=(u32x4){PKW(pB0,0),PKW(pB0,2),PKW(pB0,4),PKW(pB0,6)};pw1=(u32x4){PKW(pB0,8),PKW(pB0,10),PKW(pB0,12),PKW(pB0,14)};pw2=(u32x4){PKW(pB1,0),PKW(pB1,2),PKW(pB1,4),PKW(pB1,6)};pw3=(u32x4){PKW(pB1,8),PKW(pB1,10),PKW(pB1,12),PKW(pB1,14)};
    SBAR(); pv(o,vb0+sl_cur,PAF(0),PAF(1),PAF(2),PAF(3)); }
  #undef PKW
  #undef PAF
  #undef VFR
  #undef PIN
  #undef MX3
  #undef GAPA
  #undef GAPB
  #undef EX
  #undef VRD
  #undef KRD
  #undef STEP
  #undef ENDW
  {auto rr=__builtin_amdgcn_permlane32_swap(__float_as_uint(l_reg),__float_as_uint(l_reg),false,false);l_reg=__uint_as_float(rr[0])+__uint_as_float(rr[1]);}
  if(MODE==1)l_reg+=__builtin_amdgcn_exp2f(sinkl2-mhat);
  if(hi==0)wsf[32+r32]=l_reg;asm volatile("s_waitcnt lgkmcnt(0)":::"memory");
  float rli[16];
  #pragma unroll
  for(int r=0;r<16;++r)rli[r]=__builtin_amdgcn_rcpf(wsf[32+crow(r,hi)]);
  { bf16*stg=(bf16*)(shm+LDS_OST)+wid*2048;
    #pragma unroll
    for(int r=0;r<16;++r){const int orow=crow(r,hi);
      #pragma unroll
      for(int d0=0;d0<2;++d0)stg[orow*64+d0*32+r32]=__float2bfloat16(o[d0][r]*rli[r]);}
    asm volatile("s_waitcnt lgkmcnt(0)":::"memory");
    #pragma unroll
    for(int i=0;i<4;++i){const int row=i*8+(lane>>3),ch=lane&7; const u32x4 v=*(const u32x4*)(stg+row*64+ch*8); ATTN_STORE16(Ow+(long)row*op+ch*8,v);} }
  asm volatile("s_waitcnt lgkmcnt(0)\n\ts_barrier":::"memory");
  #undef DMA_K
  #undef DMA_V
  #undef CMASK
  #undef START
  #undef RESC
  #undef ROT
}
constexpr int ATTN_LDS_BYTES=LDS_BYTES;
#undef SBAR
#undef WAIT_BAR
}
constexpr int NWAVES = 8;
constexpr size_t MiB = 1u << 20;
constexpr size_t WS_CTL = 0, CTL_ZERO_BYTES = 256 * 1024;
constexpr size_t WS_MOD = 1 * MiB;
constexpr size_t WS_ROPE = WS_MOD + 512 * 1024;
constexpr size_t WS_AFS = WS_ROPE + 64 * 1024;
constexpr size_t WS_IDX = WS_AFS + 192 * 1024;
constexpr size_t WS_SEL = 2 * MiB;
constexpr size_t WS_AFF = 4 * MiB;
constexpr size_t WS_ABTC = WS_AFF;
constexpr size_t WS_WIN = 6 * MiB;
constexpr size_t WS_WBR = 25 * MiB;
constexpr size_t WS_WOUT = 29 * MiB;
constexpr size_t WS_DFT = 33 * MiB;
constexpr size_t WS_DFTC = 49 * MiB;
constexpr size_t WS_WGU = 50 * MiB;
constexpr size_t WS_WD = 178 * MiB;
constexpr size_t WS_X = 242 * MiB;
constexpr size_t WS_HN = 314 * MiB;
constexpr size_t WS_MB = WS_HN;
constexpr size_t WS_QKV = 350 * MiB;
constexpr size_t WS_G = 395 * MiB;
constexpr size_t WS_BR = 503 * MiB;
constexpr size_t WS_HACT = 467 * MiB;
constexpr size_t WS_ABT = 539 * MiB;
constexpr size_t WS_END = 555 * MiB;
constexpr size_t QKV_QG = 0, QKV_KG = (size_t)NTOK * 512 * 2, QKV_VG = QKV_KG + (size_t)NTOK * 128 * 2, QKV_QW = QKV_VG + (size_t)NTOK * 128 * 2,
                 QKV_KW = QKV_QW + (size_t)NTOK * 256 * 2, QKV_VW = QKV_KW + (size_t)NTOK * 128 * 2;
static_assert(WS_WIN + (size_t)DEPTH * INW2 * DM * 2 <= WS_WBR && WS_QKV + QKV_VW + (size_t)NTOK * 128 * 2 <= WS_G && WS_G + (size_t)NTOK * 3 * DM * 2 <= WS_BR && WS_HACT >= WS_G + (size_t)NE * RPE * DM * 2 &&
              WS_HACT + (size_t)NE * RPE * DM * 2 <= WS_ABT && WS_ABT + (size_t)NBATCH * 256 * 2 * SEQ * 2 <= WS_END && (size_t)NBATCH * 256 * 2 * CTX * 2 <= 2 * MiB, "d_ws map");
constexpr int CW_BAR = 1024;
constexpr int CW_QUEUE = 8192;
constexpr int CW_CONVQ = 8192 + 64 * 8;
constexpr int CW_FIN = CW_CONVQ + 64;
constexpr int RING_BYTES = 131072;
constexpr int LDSCTL_OFF = RING_BYTES, MISC_OFF = LDSCTL_OFF + 320;
constexpr int IDXBUF_OFF = LDSCTL_OFF + 1024 + 8192;
constexpr int LDS_BYTES = 147456;

#define GAS __attribute__((address_space(1)))
#define LAS __attribute__((address_space(3)))
typedef unsigned short bf16;
typedef unsigned v4u __attribute__((ext_vector_type(4)));
typedef unsigned v2u __attribute__((ext_vector_type(2)));
typedef float f32x4 __attribute__((ext_vector_type(4)));
typedef GAS unsigned gu32;
#define RLX_AGENT __ATOMIC_RELAXED, __HIP_MEMORY_SCOPE_AGENT
#define LDS_WAIT() asm volatile("s_waitcnt lgkmcnt(0)" ::: "memory")
#define VM_WAIT() asm volatile("s_waitcnt vmcnt(0)" ::: "memory")
__device__ __forceinline__ unsigned f2bf(float f) { unsigned u = __builtin_bit_cast(unsigned, f); return (u + 0x7fffu + ((u >> 16) & 1u)) >> 16; }
__device__ __forceinline__ unsigned pk2(float lo, float hi) { return f2bf(lo) | (f2bf(hi) << 16); }
__device__ __forceinline__ float bf2f(unsigned short h) { return __builtin_bit_cast(float, (unsigned)h << 16); }
__device__ __forceinline__ float bflo(unsigned w) { return __builtin_bit_cast(float, w << 16); }
__device__ __forceinline__ float bfhi(unsigned w) { return __builtin_bit_cast(float, w & 0xffff0000u); }

#define XB_TMO      128
#define XB_XCNT(j)  (256  + 64 * (j))
#define XB_XSUB(j)  (1280 + 64 * (j))
#define XB_XGEN(j)  (2304 + 64 * (j))
#define XB_TOP      3328
#define XB_TOPGEN   3392
#define XCD_BAR_WORDS 3456
#define XB_SPIN_CAP (1u << 20)
__device__ __forceinline__ unsigned xb_ld(unsigned* p)              { return __hip_atomic_load(p, __ATOMIC_RELAXED, __HIP_MEMORY_SCOPE_AGENT); }
__device__ __forceinline__ unsigned xb_add(unsigned* p, unsigned v) { return __hip_atomic_fetch_add(p, v, __ATOMIC_RELAXED, __HIP_MEMORY_SCOPE_AGENT); }
__device__ __forceinline__ unsigned xb_xcc_id() { return (unsigned)__builtin_amdgcn_s_getreg((3 << 11) | 20) & 0xFu; }
#define XB_SPIN(cond, bar) do { unsigned _sp = 0; while (cond) { __builtin_amdgcn_s_sleep(1); \
    if ((++_sp & 255u) == 0u) { if (xb_ld(&(bar)[XB_TMO])) break; if (_sp > XB_SPIN_CAP) { atomicAdd(&(bar)[XB_TMO], 1u); break; } } } } while (0)
struct XcdBarrier { unsigned* bar; unsigned x; volatile LAS unsigned* st; };
__device__ __forceinline__ XcdBarrier xcd_barrier_post(unsigned* bar, volatile LAS unsigned* st) {
    XcdBarrier b; b.bar = bar; b.x = xb_xcc_id(); b.st = st;
    if (threadIdx.x == 0) (void)xb_add(&bar[XB_XCNT(b.x)], 1u);
    return b;
}
__device__ __forceinline__ void xcd_barrier_complete(unsigned* bar, unsigned x, unsigned& nloc, unsigned& nx) {
    const unsigned G = gridDim.x * gridDim.y * gridDim.z;
    unsigned sum, cnt, mine, sp = 0u;
    for (;;) {
        sum = 0u; cnt = 0u; mine = 0u;
#pragma unroll
        for (unsigned j = 0; j < 16; ++j) { const unsigned c = xb_ld(&bar[XB_XCNT(j)]); sum += c; cnt += (c > 0u) ? 1u : 0u; mine = (j == x) ? c : mine; }
        if (sum == G) break;
        __builtin_amdgcn_s_sleep(1);
        if ((++sp & 255u) == 0u) { if (xb_ld(&bar[XB_TMO])) break; if (sp > XB_SPIN_CAP) { atomicAdd(&bar[XB_TMO], 1u); break; } }
    }
    nloc = mine > 0u ? mine : 1u; nx = cnt > 0u ? cnt : 1u;
}
__device__ __forceinline__ void xcd_barrier(const XcdBarrier& b) {
    asm volatile("s_waitcnt vmcnt(0)" ::: "memory");
    __syncthreads();
    if (threadIdx.x == 0) {
        unsigned* bar = b.bar;
        __builtin_amdgcn_s_waitcnt(0);
        unsigned nloc = b.st[0], nx = b.st[1];
        if (nloc == 0u) { xcd_barrier_complete(bar, b.x, nloc, nx); b.st[0] = nloc; b.st[1] = nx; }
        const unsigned old = xb_add(&bar[XB_XSUB(b.x)], 1u);
        const unsigned gen = old / nloc;
        if (old + 1u == (gen + 1u) * nloc) {
            __builtin_amdgcn_fence(__ATOMIC_RELEASE, "agent");
            asm volatile("s_waitcnt vmcnt(0)" ::: "memory");
            const unsigned og = xb_add(&bar[XB_TOP], 1u);
            const unsigned tg = og / nx;
            if (og + 1u == (tg + 1u) * nx) xb_add(&bar[XB_TOPGEN], 1u);
            else XB_SPIN(xb_ld(&bar[XB_TOPGEN]) == tg, bar);
            __builtin_amdgcn_fence(__ATOMIC_ACQUIRE, "agent");
            xb_add(&bar[XB_XGEN(b.x)], 1u);
            asm volatile("s_waitcnt vmcnt(0)" ::: "memory");
        } else {
            XB_SPIN(xb_ld(&bar[XB_XGEN(b.x)]) == gen, bar);
            __builtin_amdgcn_fence(__ATOMIC_ACQUIRE, "agent");
            asm volatile("s_waitcnt vmcnt(0)" ::: "memory");
        }
    }
    __syncthreads();
}
template <int CTRL> __device__ __forceinline__ float dpp_mov(float v) { return __builtin_bit_cast(float, __builtin_amdgcn_update_dpp(0, __builtin_bit_cast(int, v), CTRL, 0xF, 0xF, true)); }
__device__ __forceinline__ float lx1(float v) { return dpp_mov<0xB1>(v); }
__device__ __forceinline__ float lx2(float v) { return dpp_mov<0x4E>(v); }
__device__ __forceinline__ float lx4(float v) { return dpp_mov<0x1B>(dpp_mov<0x141>(v)); }
__device__ __forceinline__ float lx8(float v) { return dpp_mov<0x141>(dpp_mov<0x140>(v)); }
__device__ __forceinline__ float lx16(float v) { return __shfl_xor(v, 16); }
__device__ __forceinline__ float lx32(float v) { const unsigned u = __builtin_bit_cast(unsigned, v); auto r = __builtin_amdgcn_permlane32_swap(u, u, false, false);
    return __builtin_bit_cast(float, (threadIdx.x & 32) ? r[0] : r[1]); }
__device__ __forceinline__ float wave_sum(float v) {
    v += lx1(v); v += lx2(v); v += lx4(v); v += lx8(v); v += lx16(v); v += lx32(v);
    return v;
}
using pg8::Unit;
typedef pg8::f32x4 (&AccRef)[2][2][4][2];

__device__ __forceinline__ v2u pack4(f32x4 v) { v2u w; w.x = pg8::cvt_pk_bf16(v[0], v[1]); w.y = pg8::cvt_pk_bf16(v[2], v[3]); return w; }
__device__ __forceinline__ float rsig_(float t) { return 1.f + __builtin_amdgcn_exp2f(t); }
__device__ __forceinline__ float sigmoidf_(float v) { return __builtin_amdgcn_rcpf(1.f + __builtin_amdgcn_exp2f(-LOG2E * v)); }

template <class Dec> struct Strided {
    Dec d; int n, G, vcu;
    __device__ __forceinline__ bool next(int i, Unit& u) const { const int L = i * G + vcu; if (L >= n) return false; d(L, u); return true; }
};

struct DecInProj { const char* A; const char* B; int layer;
    __device__ __forceinline__ void operator()(int L, Unit& u) const {
        int pm, pn;
        if (L < 1024) { const int cg = L >> 8, rg = (L & 255) >> 5, w = L & 31; pm = rg * 8 + (w & 7); pn = cg * 4 + (w >> 3); }
        else if (L < 1216) { const int q = L - 1024, rg = q / 24, w = q % 24; pm = rg * 8 + (w & 7); pn = 16 + (w >> 3); }
        else { const int q = L - 1216; pm = 64 + (q & 7); pn = q >> 3; if (layer == DEPTH - 1) pn = pn ? 6 : 4; }
        u.A = A + (size_t)pm * 256 * (DM * 2); u.B = B + (size_t)pn * 256 * (DM * 2); u.arows = nullptr; u.ldA = DM * 2; u.ldB = DM * 2; u.nt = DM / 64; u.pm = pm; u.pn = pn; u.tag = 0;
    } };
constexpr int inproj_units(int layer) { return 1216 + (layer == DEPTH - 1 ? 16 : 152); }

struct EpiInProj {
    static constexpr bool PERM = true;
    bf16 *ABt, *ABtc, *Qg, *Kg, *Vg, *Qw, *Kw, *Vw, *G; const float* rope; const float* qng; const float* kng;
    __device__ __forceinline__ bool operator()(AccRef acc, const Unit& u, int wr, int wc, int fr, int fq) const {
        const int pm = u.pm, pn = u.pn; const bool lat = pm < 64;
        const int rowt = wr * 64 + fr;
        if (pn < 2) {
            bf16* dst; int ld;
            if (lat) { dst = ABt + ((size_t)(pm >> 3) * 256) * (2 * SEQ) + pn * SEQ + (pm & 7) * 256; ld = 2 * SEQ; }
            else { dst = ABtc + ((size_t)(pm - 64) * 256) * (2 * CTX) + pn * CTX; ld = 2 * CTX; }
#pragma unroll
            for (int ai = 0; ai < 2; ++ai)
#pragma unroll
                for (int m = 0; m < 4; ++m) { const int tok = rowt + ai * 128 + m * 16;
#pragma unroll
                    for (int bj = 0; bj < 2; ++bj)
#pragma unroll
                        for (int n = 0; n < 2; ++n) { const int c = bj * 128 + wc * 32 + fq * 8 + n * 4; const pg8::f32x4 v = acc[ai][bj][m][n];
#pragma unroll
                            for (int j = 0; j < 4; ++j) dst[(size_t)(c + j) * ld + tok] = (bf16)f2bf(v[j]); } }
        } else if (pn < 7) {
            bf16* dst; int ld; const float* ng = nullptr; bool rope_on = false; float sc = 1.f;
            if (pn <= 3)      { dst = Qg + (pn - 2) * 256 + wc * 64; ld = 512; ng = qng; rope_on = lat; sc = QSCALE; }
            else if (pn == 4) { if (wc < 2) { dst = Kg + wc * 64; ng = kng; rope_on = lat; } else { dst = Vg + (wc - 2) * 64; } ld = 128; }
            else if (pn == 5) { dst = Qw + wc * 64; ld = 256; rope_on = lat; sc = QSCALE; }
            else              { if (wc < 2) { dst = Kw + wc * 64; rope_on = lat; } else { dst = Vw + (wc - 2) * 64; } ld = 128; }
#pragma unroll
            for (int ai = 0; ai < 2; ++ai)
#pragma unroll
                for (int m = 0; m < 4; ++m) {
                    const int row = pm * 256 + rowt + ai * 128 + m * 16;
                    pg8::f32x4 v[2][2];
                    float ss = 0.f;
#pragma unroll
                    for (int bj = 0; bj < 2; ++bj)
#pragma unroll
                        for (int n = 0; n < 2; ++n) { v[bj][n] = acc[ai][bj][m][n]; ss += (v[bj][n][0] * v[bj][n][0] + v[bj][n][1] * v[bj][n][1]) + (v[bj][n][2] * v[bj][n][2] + v[bj][n][3] * v[bj][n][3]); }
                    float r = sc;
                    if (ng) { ss += __shfl_xor(ss, 16); ss += __shfl_xor(ss, 32); r = sc * rsqrtf(ss * (1.f / 64.f) + EPS); }
                    const int t = row & (SEQ - 1);
#pragma unroll
                    for (int bj = 0; bj < 2; ++bj) { v2u o[2];
#pragma unroll
                        for (int n = 0; n < 2; ++n) {
                            pg8::f32x4 x = v[bj][n] * r; if (ng) x = x * *(const pg8::f32x4*)(ng + bj * 32 + fq * 8 + n * 4);
                            if (rope_on) {
                                const int pos = bj ? (t & 63) : (t >> 6);
                                const pg8::f32x4 cs = *(const pg8::f32x4*)(rope + ((size_t)pos * 16 + fq * 4 + n * 2) * 2);
                                x = (pg8::f32x4){x[0] * cs[0] - x[1] * cs[1], x[0] * cs[1] + x[1] * cs[0], x[2] * cs[2] - x[3] * cs[3], x[2] * cs[3] + x[3] * cs[2]};
                            }
                            o[n] = pack4(x);
                        }
                        *(v4u*)(dst + (size_t)row * ld + bj * 32 + fq * 8) = (v4u){o[0].x, o[0].y, o[1].x, o[1].y}; }
                    asm volatile("" ::: "memory");
                }
        } else {
            bf16* dst = G + ((size_t)pm * 12 + (pn - 7)) * 65536 + (size_t)(((wr * 4 + wc) * 64 + fq * 16 + fr) * 8);
#pragma unroll
            for (int ai = 0; ai < 2; ++ai)
#pragma unroll
                for (int bj = 0; bj < 2; ++bj)
#pragma unroll
                    for (int m = 0; m < 4; ++m) { const pg8::f32x4 a = acc[ai][bj][m][0], b = acc[ai][bj][m][1];
                        const v2u lo = pack4((pg8::f32x4){rsig_(a[0]), rsig_(a[1]), rsig_(a[2]), rsig_(a[3])}), hi = pack4((pg8::f32x4){rsig_(b[0]), rsig_(b[1]), rsig_(b[2]), rsig_(b[3])});
                        *(v4u*)(dst + (size_t)(((ai * 2 + bj) * 4 + m) * 4096)) = (v4u){lo.x, lo.y, hi.x, hi.y}; }
        }
        return false;
    }
};

struct EpiStore { static constexpr bool PERM = true; bf16* O; int ld;
    __device__ __forceinline__ bool operator()(AccRef acc, const Unit& u, int wr, int wc, int fr, int fq) const {
        bf16* dst = O + ((size_t)u.pm * 256 + wr * 64 + fr) * ld + u.pn * 256 + wc * 32 + fq * 8;
#pragma unroll
        for (int ai = 0; ai < 2; ++ai)
#pragma unroll
            for (int m = 0; m < 4; ++m)
#pragma unroll
                for (int bj = 0; bj < 2; ++bj) { const v2u o0 = pack4(acc[ai][bj][m][0]), o1 = pack4(acc[ai][bj][m][1]);
                    *(v4u*)(dst + (size_t)(ai * 128 + m * 16) * ld + bj * 128) = (v4u){o0.x, o0.y, o1.x, o1.y}; }
        return false;
    } };
struct DecDft { const char* Dm; const char* Dc; const char* ABt; const char* ABtc;
    __device__ __forceinline__ void operator()(int L, Unit& u) const {
        if (L < 64) { const int b = L >> 3, mt = L & 7; u.A = Dm + (size_t)mt * 256 * (4 * SEQ); u.B = ABt + (size_t)b * 256 * (4 * SEQ); u.ldA = 4 * SEQ; u.ldB = 4 * SEQ; u.nt = 2 * SEQ / 64; u.pm = L; }
        else { const int b = L - 64; u.A = Dc; u.B = ABtc + (size_t)b * 256 * (4 * CTX); u.ldA = 4 * CTX; u.ldB = 4 * CTX; u.nt = 2 * CTX / 64; u.pm = 64 + b; }
        u.pn = 0; u.tag = 0; u.arows = nullptr;
    } };

struct SchedMerge { const char* BR; const char* W; int ntiles, G, vcu;
    __device__ __forceinline__ bool next(int i, Unit& u) const {
        const int round = i / 3, tag = i - round * 3, tile = round * G + vcu; if (tile >= ntiles) return false;
        const int pm = tile >> 2, pn = tile & 3, koff = tag == 0 ? 0 : (tag == 1 ? 256 : 768);
        u.A = BR + (size_t)pm * 256 * (DM * 2) + koff * 2; u.B = W + (size_t)pn * 256 * (DM * 2) + koff * 2; u.arows = nullptr; u.ldA = DM * 2; u.ldB = DM * 2; u.nt = tag == 1 ? 8 : 4; u.pm = pm; u.pn = pn; u.tag = tag;
        return true;
    } };
struct EpiMerge { static constexpr bool PERM = true; const bf16* G; bf16* Mb; int probe;
    __device__ __forceinline__ bool operator()(AccRef acc, const Unit& u, int wr, int wc, int fr, int fq) const {
        const size_t row0 = (size_t)u.pm * 256 + wr * 64 + fr; const int col0 = u.pn * 256 + wc * 32 + fq * 8; const int tag = u.tag;
        const GAS char* gt = (const GAS char*)(G + ((size_t)u.pm * 12 + tag * 4 + u.pn) * 65536);
        const unsigned lo = (unsigned)(((wr * 4 + wc) * 64 + fq * 16 + fr) * 16);
#pragma unroll
        for (int q = 0; q < 4; ++q) { const int ai = q >> 1, bj = q & 1;
            v4u gwv[4];
#pragma unroll
            for (int m = 0; m < 4; ++m) { const GAS char* gp = gt + (size_t)((q * 4 + m) * 8192); asm volatile("" : "+s"(gp)); gwv[m] = *(const GAS v4u*)(gp + lo); }
            if (tag < 2) {
                v4u hwv[4];
#pragma unroll
                for (int m = 0; m < 4; ++m) { const GAS char* gp = gt + (size_t)(4 * 131072 + (q * 4 + m) * 8192); asm volatile("" : "+s"(gp)); hwv[m] = *(const GAS v4u*)(gp + lo); }
#pragma unroll
                for (int m = 0; m < 4; ++m) { const v4u gw = gwv[m], hw = hwv[m];
                    const pg8::f32x4 ga = {__builtin_amdgcn_rcpf(bflo(gw.x)) * bflo(hw.x), __builtin_amdgcn_rcpf(bfhi(gw.x)) * bfhi(hw.x), __builtin_amdgcn_rcpf(bflo(gw.y)) * bflo(hw.y), __builtin_amdgcn_rcpf(bfhi(gw.y)) * bfhi(hw.y)};
                    const pg8::f32x4 gb = {__builtin_amdgcn_rcpf(bflo(gw.z)) * bflo(hw.z), __builtin_amdgcn_rcpf(bfhi(gw.z)) * bfhi(hw.z), __builtin_amdgcn_rcpf(bflo(gw.w)) * bflo(hw.w), __builtin_amdgcn_rcpf(bfhi(gw.w)) * bfhi(hw.w)};
                    acc[ai][bj][m][0] = acc[ai][bj][m][0] * ga; acc[ai][bj][m][1] = acc[ai][bj][m][1] * gb; }
            } else {
#pragma unroll
                for (int m = 0; m < 4; ++m) { const v4u gw = gwv[m];
                    const pg8::f32x4 ga = {__builtin_amdgcn_rcpf(bflo(gw.x)), __builtin_amdgcn_rcpf(bfhi(gw.x)), __builtin_amdgcn_rcpf(bflo(gw.y)), __builtin_amdgcn_rcpf(bfhi(gw.y))};
                    const pg8::f32x4 gb = {__builtin_amdgcn_rcpf(bflo(gw.z)), __builtin_amdgcn_rcpf(bfhi(gw.z)), __builtin_amdgcn_rcpf(bflo(gw.w)), __builtin_amdgcn_rcpf(bfhi(gw.w))};
                    const size_t row = row0 + ai * 128 + m * 16; const int c = col0 + bj * 128;
                    const v2u o0 = pack4(acc[ai][bj][m][0] * ga), o1 = pack4(acc[ai][bj][m][1] * gb); *(v4u*)(Mb + row * DM + c) = (v4u){o0.x, o0.y, o1.x, o1.y}; }
            }
            asm volatile("" ::: "memory");
        }
        return tag < 2;
    } };

struct DecWout { const char* Mb; const char* W;
    __device__ __forceinline__ void operator()(int L, Unit& u) const { const int pm = L >> 2, pn = L & 3;
        u.A = Mb + (size_t)pm * 256 * (DM * 2); u.B = W + (size_t)pn * 256 * (DM * 2); u.arows = nullptr; u.ldA = DM * 2; u.ldB = DM * 2; u.nt = DM / 64; u.pm = pm; u.pn = pn; u.tag = 0; } };
struct EpiWout { static constexpr bool PERM = true; const float* baseL; const float* baseC; const bf16* baseX; bf16* X; const float* mod; int from_x;
    __device__ __forceinline__ bool operator()(AccRef acc, const Unit& u, int wr, int wc, int fr, int fq) const {
        const int pm = u.pm; const float* base = pm < 64 ? baseL : baseC; const float* g1 = mod + (size_t)(pm < 64 ? (pm >> 3) : 8) * (6 * DM) + 2 * DM;
        const size_t row0 = (size_t)pm * 256 + wr * 64 + fr; const int col0 = u.pn * 256 + wc * 32 + fq * 8;
#pragma unroll
        for (int bj = 0; bj < 2; ++bj) { const int c = col0 + bj * 128; const pg8::f32x4 gv0 = *(const pg8::f32x4*)(g1 + c), gv1 = *(const pg8::f32x4*)(g1 + c + 4);
#pragma unroll
            for (int ai = 0; ai < 2; ++ai)
#pragma unroll
                for (int m = 0; m < 4; ++m) { const size_t off = (row0 + ai * 128 + m * 16) * DM + c; pg8::f32x4 b0, b1;
                    if (from_x) { const v4u w = *(const v4u*)(baseX + off); b0 = (pg8::f32x4){bflo(w.x), bfhi(w.x), bflo(w.y), bfhi(w.y)}; b1 = (pg8::f32x4){bflo(w.z), bfhi(w.z), bflo(w.w), bfhi(w.w)}; }
                    else { b0 = *(const pg8::f32x4*)(base + off); b1 = *(const pg8::f32x4*)(base + off + 4); }
                    const v2u o0 = pack4(b0 + gv0 * acc[ai][bj][m][0]), o1 = pack4(b1 + gv1 * acc[ai][bj][m][1]);
                    *(v4u*)(X + off) = (v4u){o0.x, o0.y, o1.x, o1.y}; } }
        return false;
    } };

struct DecGU { const char* H2; const int* IDX; const char* W; int nrt;
    __device__ __forceinline__ void operator()(int L, Unit& u) const { const int per = nrt * 8, e = L / per, q = L - e * per, ct = q & 7, rt = q >> 3;
        u.A = H2; u.arows = IDX + (size_t)e * RPE + rt * 256; u.B = W + ((size_t)e * 2 * DM + ct * 256) * (DM * 2); u.ldA = DM * 2; u.ldB = DM * 2; u.nt = DM / 64; u.pm = rt; u.pn = ct; u.tag = e; } };
struct EpiGU { static constexpr bool PERM = true; bf16* H;
    __device__ __forceinline__ bool operator()(AccRef acc, const Unit& u, int wr, int wc, int fr, int fq) const {
        bf16* dst = H + ((size_t)u.tag * RPE + u.pm * 256 + wr * 64 + fr) * DM + u.pn * 128 + wc * 32 + fq * 8;
#pragma unroll
        for (int ai = 0; ai < 2; ++ai)
#pragma unroll
            for (int m = 0; m < 4; ++m) { v2u o[2];
#pragma unroll
                for (int n = 0; n < 2; ++n) { const pg8::f32x4 a = acc[ai][0][m][n], up = acc[ai][1][m][n];
                    o[n] = pack4((pg8::f32x4){a[0] * sigmoidf_(a[0]) * up[0], a[1] * sigmoidf_(a[1]) * up[1], a[2] * sigmoidf_(a[2]) * up[2], a[3] * sigmoidf_(a[3]) * up[3]}); }
                *(v4u*)(dst + (size_t)(ai * 128 + m * 16) * DM) = (v4u){o[0].x, o[0].y, o[1].x, o[1].y}; }
        return false;
    } };
struct DecDown { const char* H; const char* W; int nrt;
    __device__ __forceinline__ void operator()(int L, Unit& u) const { const int per = nrt * 4, e = L / per, q = L - e * per, ct = q & 3, rt = q >> 2;
        u.A = H + ((size_t)e * RPE + rt * 256) * (DM * 2); u.arows = nullptr; u.B = W + ((size_t)e * DM + ct * 256) * (DM * 2); u.ldA = DM * 2; u.ldB = DM * 2; u.nt = DM / 64; u.pm = rt; u.pn = ct; u.tag = e; } };
struct EpiDown { static constexpr bool PERM = true; bf16* Y; const float* afs;
    __device__ __forceinline__ bool operator()(AccRef acc, const Unit& u, int wr, int wc, int fr, int fq) const {
        const size_t r0 = (size_t)u.tag * RPE + u.pm * 256 + wr * 64 + fr;
#pragma unroll
        for (int ai = 0; ai < 2; ++ai)
#pragma unroll
            for (int m = 0; m < 4; ++m) { const size_t r = r0 + ai * 128 + m * 16; const float a = afs[r];
#pragma unroll
                for (int bj = 0; bj < 2; ++bj) { const v2u o0 = pack4(acc[ai][bj][m][0] * a), o1 = pack4(acc[ai][bj][m][1] * a);
                    *(v4u*)(Y + r * DM + u.pn * 256 + bj * 128 + wc * 32 + fq * 8) = (v4u){o0.x, o0.y, o1.x, o1.y}; } }
        return false;
    } };
struct Frame {
    LAS unsigned char* lds; char* ldsg; volatile LAS unsigned* MISC; gu32* ctl;
    int vcu, G;
    unsigned char* ws; unsigned char* dout; float* out;
};
constexpr int PTRS_OFF = LDSCTL_OFF + 512;
enum { IN_X = 0, IN_C, IN_CTX, IN_CCTX, IN_WADA, IN_BADA, IN_NORM1G, IN_WIN, IN_QNG, IN_KNG, IN_SINK, IN_WBRF, IN_WBRG, IN_WBRW, IN_WOUT, IN_NORM2G, IN_WROUTER, IN_WGATE, IN_WUP, IN_WDOWN, IN_FINALG };
__device__ __forceinline__ const float* inptr(const Frame& F, int k) {
    const unsigned long long v = *(const LAS unsigned long long*)(F.lds + PTRS_OFF + 8 * k);
    const unsigned lo = __builtin_amdgcn_readfirstlane((unsigned)v), hi = __builtin_amdgcn_readfirstlane((unsigned)(v >> 32));
    return (const float*)(((unsigned long long)hi << 32) | lo);
}
#define WSP(T, off) ((T*)(F.ws + (off)))

constexpr int COSTAB_OFF = LDSCTL_OFF + 1024;
static_assert(COSTAB_OFF + 8192 <= LDS_BYTES, "cos table fits");
__device__ __forceinline__ void transpose_item(const float* W, int ldw, int k0, int n0, bf16* WT, int drow0, int dld, int dk0, int lane, float sc = 1.f) {
    const int g = lane >> 3, n4 = (lane & 7) * 4;
    const float* src = W + (size_t)(k0 + 8 * g) * ldw + n0 + n4;
    f32x4 v[8];
#pragma unroll
    for (int i = 0; i < 8; ++i) v[i] = *(const GAS f32x4*)(src + (size_t)i * ldw);
    bf16* dst = WT + (size_t)(drow0 + n4) * dld + dk0 + k0 + 8 * g;
#pragma unroll
    for (int j = 0; j < 4; ++j) { v4u o; o.x = pk2(v[0][j] * sc, v[1][j] * sc); o.y = pk2(v[2][j] * sc, v[3][j] * sc); o.z = pk2(v[4][j] * sc, v[5][j] * sc); o.w = pk2(v[6][j] * sc, v[7][j] * sc);
        *(GAS v4u*)(dst + (size_t)j * dld) = o; }
}
__device__ __forceinline__ void transpose_item2(const float* W, int ldw, int k0, int n0, bf16* WT, int drow0, int dld, int lane) {
    const int g = lane >> 3, n4 = (lane & 7) * 4;
    const float* src = W + (size_t)(k0 + 8 * g) * ldw + n0 + n4;
    f32x4 v[2][8];
#pragma unroll
    for (int h = 0; h < 2; ++h)
#pragma unroll
        for (int i = 0; i < 8; ++i) v[h][i] = __builtin_nontemporal_load((const GAS f32x4*)(src + (size_t)(h * 64 + i) * ldw));
    bf16* dst = WT + (size_t)(drow0 + n4) * dld + k0 + 8 * g;
#pragma unroll
    for (int h = 0; h < 2; ++h)
#pragma unroll
        for (int j = 0; j < 4; ++j) { v4u o; o.x = pk2(v[h][0][j], v[h][1][j]); o.y = pk2(v[h][2][j], v[h][3][j]); o.z = pk2(v[h][4][j], v[h][5][j]); o.w = pk2(v[h][6][j], v[h][7][j]);
            __builtin_nontemporal_store(o, (GAS v4u*)(dst + (size_t)j * dld + h * 64)); }
}
__device__ __forceinline__ void fold_item(const float* W, int k0, int g, int sinmode, bf16* WT, int drow0, LAS float* scr, const LAS float* ctab, int lane) {
#pragma unroll
    for (int kk = 0; kk < 16; ++kk) scr[lane * 20 + kk] = W[(size_t)(k0 + kk) * INW + g * 64 + lane];
    LDS_WAIT(); asm volatile("" ::: "memory");
    float acc[16];
#pragma unroll
    for (int k = 0; k < 16; ++k) acc[k] = 0.f;
#pragma unroll 4
    for (int c = 0; c < 64; ++c) {
        const int r = (c * lane) & 63;
        const float tv = sinmode ? -ctab[((r - 16) & 63) * 32] : ctab[r * 32];
#pragma unroll
        for (int k4 = 0; k4 < 4; ++k4) { const f32x4 w = *(const LAS f32x4*)(scr + c * 20 + 4 * k4);
            acc[4 * k4] = fmaf(w[0], tv, acc[4 * k4]); acc[4 * k4 + 1] = fmaf(w[1], tv, acc[4 * k4 + 1]); acc[4 * k4 + 2] = fmaf(w[2], tv, acc[4 * k4 + 2]); acc[4 * k4 + 3] = fmaf(w[3], tv, acc[4 * k4 + 3]); }
    }
    GAS v4u* dst = (GAS v4u*)(WT + (size_t)(drow0 + lane) * DM + k0);
#pragma unroll
    for (int q = 0; q < 2; ++q) { v4u o; o.x = pk2(acc[8 * q], acc[8 * q + 1]); o.y = pk2(acc[8 * q + 2], acc[8 * q + 3]); o.z = pk2(acc[8 * q + 4], acc[8 * q + 5]); o.w = pk2(acc[8 * q + 6], acc[8 * q + 7]); dst[q] = o; }
    LDS_WAIT(); asm volatile("" ::: "memory");
}

#ifndef CONV_IN_ATTN
#define CONV_IN_ATTN 0
#endif
constexpr int CONV_WAVE_ITEMS = DEPTH * NE * 768, CONV_ITEMS = CONV_WAVE_ITEMS / NWAVES, CONV_ITEMS_L0 = CONV_ITEMS / DEPTH;
__device__ __forceinline__ void conv_wave_item(Frame& F, int r, int lane) {
    const int le = r / 768, q = r % 768, which = q / 256, qq = q % 256, kb = qq >> 5, nb = qq & 31, f0 = nb * 32;
    if (which < 2) transpose_item2((which ? inptr(F, IN_WUP) : inptr(F, IN_WGATE)) + (size_t)le * DM * DM, DM, kb * 128, f0, WSP(bf16, WS_WGU) + (size_t)le * 2 * DM * DM, (f0 >> 7) * 256 + which * 128 + (f0 & 127), DM, lane);
    else transpose_item2(inptr(F, IN_WDOWN) + (size_t)le * DM * DM, DM, kb * 128, f0, WSP(bf16, WS_WD) + (size_t)le * DM * DM, f0, DM, lane);
}
__device__ __forceinline__ void tail_convert(Frame& F, int idx, int first, int per, int end) {
    int tid_ = threadIdx.x; asm volatile("" : "+v"(tid_));
    const int lane = tid_ & 63, wave_ = __builtin_amdgcn_readfirstlane(tid_ >> 6);
    for (int t = 0; t < per; ++t) { const int it = first + idx * per + t; if (it >= end) break; conv_wave_item(F, it * NWAVES + wave_, lane); }
}

__device__ __forceinline__ void p0_prologue(Frame& F, int mode = 0) {
    int tid_ = threadIdx.x; asm volatile("" : "+v"(tid_));
    const int lane = tid_ & 63, wave_ = __builtin_amdgcn_readfirstlane(tid_ >> 6);
    const int gw = F.vcu * NWAVES + wave_, NGW = F.G * NWAVES;
    LAS float* st = (LAS float*)F.lds;
    LAS float* red = (LAS float*)(F.lds + 40960);
    LAS float* ctab = (LAS float*)(F.lds + COSTAB_OFF);
    { const float* cp = inptr(F, IN_C); const float* ccp = inptr(F, IN_CCTX);
#pragma unroll 6
      for (int i = tid_; i < 9 * DM; i += NWAVES * 64) { const int s = i / DM, k = i - s * DM; const float v = s < 8 ? cp[s * DM + k] : ccp[k]; st[i] = v / (1.f + expf(-v)); } }
    for (int i = tid_; i < 2048; i += NWAVES * 64) ctab[i] = cosf(6.283185307179586f * (float)i * (1.f / 2048.f));
    __syncthreads();
    const float* bada = inptr(F, IN_BADA);
    if (mode != 2) for (int it = F.vcu; it < DEPTH * 96; it += F.G) {
        const int l = it / 96, j = (it % 96) * 64 + lane, kb = wave_ * 128;
        const float* W = inptr(F, IN_WADA) + (size_t)l * DM * 6 * DM + (size_t)kb * 6 * DM + j;
        float acc[9];
#pragma unroll
        for (int s = 0; s < 9; ++s) acc[s] = 0.f;
        for (int k0 = 0; k0 < 128; k0 += 16) {
            float w[16];
#pragma unroll
            for (int i = 0; i < 16; ++i) w[i] = W[(size_t)(k0 + i) * 6 * DM];
#pragma unroll
            for (int i = 0; i < 16; ++i)
#pragma unroll
                for (int s = 0; s < 9; ++s) acc[s] = fmaf(st[s * DM + kb + k0 + i], w[i], acc[s]);
        }
#pragma unroll
        for (int s = 0; s < 9; ++s) red[(wave_ * 9 + s) * 64 + lane] = acc[s];
        __syncthreads();
        for (int o = tid_; o < 9 * 64; o += NWAVES * 64) { float v = 0.f;
#pragma unroll
            for (int w = 0; w < 8; ++w) v += red[w * 576 + o];
            const int s = o >> 6, jj = (it % 96) * 64 + (o & 63);
            WSP(float, WS_MOD)[((size_t)l * 9 + s) * 6 * DM + jj] = v + bada[l * 6 * DM + jj]; }
        __syncthreads();
    }
    __syncthreads();
#ifdef DBG_POISON
    {
        const size_t n16 = (WS_END - WS_X) / 16, m16 = ((size_t)NLAT * DM * 4) / 16; const v4u pz = {0xFFFFFFFFu, 0xFFFFFFFFu, 0xFFFFFFFFu, 0xFFFFFFFFu};
        for (size_t i = (size_t)gw * 64 + lane; i < n16; i += (size_t)NGW * 64) ((GAS v4u*)(F.ws + WS_X))[i] = pz;
        for (size_t i = (size_t)gw * 64 + lane; i < m16; i += (size_t)NGW * 64) ((GAS v4u*)F.dout)[i] = pz;
    }
#endif
    LAS float* scr = (LAS float*)(F.lds + wave_ * 16384);
    constexpr int T_A = DEPTH * 2176, T_B = DEPTH * 512, T_C = DEPTH * 512, T_D = DEPTH * 512, T_E = DEPTH * NE * 768, T_F = SEQ + CTX, T_G = 1;
    constexpr int NITEMS = T_A + T_B + T_C + T_D + T_E + T_F + T_G;
    if (mode != 1 && mode != 5 && mode != 6) for (int it = gw; it < NITEMS; it += NGW) {
        int r = it;
        if (r < T_A) { const int l = r / 2176, q = r % 2176, kb = q / 136, nb = q % 136, s0 = 256 + nb * 32;
            int drow; if (s0 < 1536) { const int tile = 2 + ((s0 - 256) >> 8), hh = ((s0 - 256) & 255) >> 6, dh = (s0 & 63) >> 5; drow = tile * 256 + dh * 128 + hh * 32; } else drow = s0 + 256;
            transpose_item(inptr(F, IN_WIN) + (size_t)l * DM * INW, INW, kb * 64, s0, WSP(bf16, WS_WIN) + (size_t)l * INW2 * DM, drow, DM, 0, lane, s0 < 1536 ? 1.f : -LOG2E); continue; } r -= T_A;
        if (r < T_B) { const int l = r / 512, q = r % 512, kq = q & 3, kb = (q >> 2) >> 3, g = ((q >> 2) >> 1) & 3, sm = (q >> 2) & 1;
            fold_item(inptr(F, IN_WIN) + (size_t)l * DM * INW, kb * 64 + kq * 16, g, sm, WSP(bf16, WS_WIN) + (size_t)l * INW2 * DM, sm * 256 + g * 64, scr, ctab, lane); continue; } r -= T_B;
        if (r < T_C) { const int l = r / 512, q = r % 512; const float* W; int kb, koff;
            if (q < 128) { W = inptr(F, IN_WBRF) + (size_t)l * 256 * DM; kb = q >> 5; koff = 0; } else if (q < 384) { W = inptr(F, IN_WBRG) + (size_t)l * 512 * DM; kb = (q - 128) >> 5; koff = 256; } else { W = inptr(F, IN_WBRW) + (size_t)l * 256 * DM; kb = (q - 384) >> 5; koff = 768; }
            const int nb = q & 31;
            transpose_item(W, DM, kb * 64, nb * 32, WSP(bf16, WS_WBR) + (size_t)l * DM * DM, nb * 32, DM, koff, lane); continue; } r -= T_C;
        if (r < T_D) { const int l = r / 512, q = r % 512, kb = q >> 5, nb = q & 31;
            transpose_item(inptr(F, IN_WOUT) + (size_t)l * DM * DM, DM, kb * 64, nb * 32, WSP(bf16, WS_WOUT) + (size_t)l * DM * DM, nb * 32, DM, 0, lane); continue; } r -= T_D;
        if (r < T_E) { if (F.G != 256) conv_wave_item(F, r, lane); continue; } r -= T_E;
        if (r < T_F) {
            const bool big = r < SEQ; const int N = big ? SEQ : CTX, k = big ? r : r - SEQ, sh = big ? 0 : 3; const float sc = 1.f / sqrtf(64.f * (float)N);
            bf16* row = (big ? WSP(bf16, WS_DFT) : WSP(bf16, WS_DFTC)) + (size_t)k * 2 * N;
            for (int n = 2 * lane; n < N; n += 128) {
                const int r0 = (k * n) & (N - 1), r1 = (k * (n + 1)) & (N - 1);
                *(GAS unsigned*)(row + n) = pk2(ctab[r0 << sh] * sc, ctab[r1 << sh] * sc);
                *(GAS unsigned*)(row + N + n) = pk2(ctab[((r0 - (N >> 2)) & (N - 1)) << sh] * sc, ctab[((r1 - (N >> 2)) & (N - 1)) << sh] * sc); }
            continue; } r -= T_F;
        {
            for (int i = lane; i < 64 * 16; i += 64) { const int pos = i >> 4, f = i & 15; const float inv = powf(10000.f, -(float)(2 * f) / 32.f), ang = (float)pos * inv;
                WSP(float, WS_ROPE)[2 * i] = cosf(ang); WSP(float, WS_ROPE)[2 * i + 1] = sinf(ang); }
        }
    }
}

__device__ __forceinline__ void norm_row(f32x4 (&v)[4], const float* gain, const float* shift, const float* scale, int lane) {
    float ss = 0.f;
#pragma unroll
    for (int j = 0; j < 4; ++j) ss += (v[j][0] * v[j][0] + v[j][1] * v[j][1]) + (v[j][2] * v[j][2] + v[j][3] * v[j][3]);
    const float r = rsqrtf(wave_sum(ss) * (1.f / DM) + EPS);
#pragma unroll
    for (int j = 0; j < 4; ++j) { const f32x4 g = *(const f32x4*)(gain + 4 * lane + 256 * j); f32x4 y = v[j] * r * g;
        if (shift) { const f32x4 sh = *(const f32x4*)(shift + 4 * lane + 256 * j), sc = *(const f32x4*)(scale + 4 * lane + 256 * j); y = y * (sc + 1.f) + sh; }
        v[j] = y; }
}
__device__ __forceinline__ void store_row_bf16(bf16* orow, const f32x4 (&v)[4], int lane) {
    GAS v2u* o8 = (GAS v2u*)orow + lane;
#pragma unroll
    for (int j = 0; j < 4; ++j) { v2u w; w.x = pg8::cvt_pk_bf16(v[j][0], v[j][1]); w.y = pg8::cvt_pk_bf16(v[j][2], v[j][3]); o8[64 * j] = w; }
}
__device__ __forceinline__ int row_modset(int r) { return r < NLAT ? (r >> 11) : 8; }
struct ModVec { f32x4 g[4], sh[4], sc[4]; };
__device__ __forceinline__ void load_modvec(ModVec& m, const float* gain, const float* shift, const float* scale, int lane) {
#pragma unroll
    for (int j = 0; j < 4; ++j) { m.g[j] = *(const f32x4*)(gain + 4 * lane + 256 * j);
        if (shift) { m.sh[j] = *(const f32x4*)(shift + 4 * lane + 256 * j); m.sc[j] = *(const f32x4*)(scale + 4 * lane + 256 * j); } else { m.sh[j] = (f32x4){0.f, 0.f, 0.f, 0.f}; m.sc[j] = (f32x4){0.f, 0.f, 0.f, 0.f}; } }
}
__device__ __forceinline__ void norm_row_m(f32x4 (&v)[4], const ModVec& m) {
    float ss = 0.f;
#pragma unroll
    for (int j = 0; j < 4; ++j) ss += (v[j][0] * v[j][0] + v[j][1] * v[j][1]) + (v[j][2] * v[j][2] + v[j][3] * v[j][3]);
    const float r = rsqrtf(wave_sum(ss) * (1.f / DM) + EPS);
#pragma unroll
    for (int j = 0; j < 4; ++j) v[j] = (v[j] * r * m.g[j]) * (m.sc[j] + 1.f) + m.sh[j];
}
__device__ __forceinline__ void load_row_bf16(f32x4 (&v)[4], const bf16* row, int lane) {
    const GAS v2u* i8 = (const GAS v2u*)row + lane;
#pragma unroll
    for (int j = 0; j < 4; ++j) { const v2u w = i8[64 * j]; v[j] = (f32x4){bflo(w.x), bfhi(w.x), bflo(w.y), bfhi(w.y)}; }
}
__device__ __forceinline__ void load_row_f32(f32x4 (&v)[4], const float* row, int lane) {
#pragma unroll
    for (int j = 0; j < 4; ++j) v[j] = *(const f32x4*)(row + 4 * lane + 256 * j);
}

__device__ __forceinline__ void p1_norm1(Frame& F) {
    int tid_ = threadIdx.x; asm volatile("" : "+v"(tid_));
    const int lane = tid_ & 63, wave_ = __builtin_amdgcn_readfirstlane(tid_ >> 6);
    const int gw = F.vcu * NWAVES + wave_, NGW = F.G * NWAVES, rpw = (NTOK + NGW - 1) / NGW, r0 = gw * rpw, r1 = r0 + rpw < NTOK ? r0 + rpw : NTOK;
    const float* xin = inptr(F, IN_X); const float* cin = inptr(F, IN_CTX) - (size_t)NLAT * DM; const float* g1 = inptr(F, IN_NORM1G);
#define P1_ROW(r) (((r) < NLAT ? xin : cin) + (size_t)(r) * DM)
    f32x4 va[4], vb[4]; ModVec m; int cset = -1;
    if (r0 < r1) load_row_f32(va, P1_ROW(r0), lane);
    if (r0 + 1 < r1) load_row_f32(vb, P1_ROW(r0 + 1), lane);
    for (int r = r0; r < r1; ++r) {
        f32x4 v[4];
#pragma unroll
        for (int j = 0; j < 4; ++j) { v[j] = va[j]; va[j] = vb[j]; }
        if (r + 2 < r1) load_row_f32(vb, P1_ROW(r + 2), lane);
        const int set = row_modset(r);
        if (set != cset) { const float* mod = WSP(float, WS_MOD) + (size_t)set * 6 * DM; load_modvec(m, g1, mod, mod + DM, lane); cset = set; }
        norm_row_m(v, m);
        store_row_bf16(WSP(bf16, WS_HN) + (size_t)r * DM, v, lane);
    }
#undef P1_ROW
}
__device__ __forceinline__ void router_finish(const float (&a16)[NE], int r, int lane, float* AFF) {
    float b8[8], b4[4], b2[2], lg;
    { const bool hi = lane & 32;
#pragma unroll
      for (int i = 0; i < 8; ++i) { const float keep = hi ? a16[i + 8] : a16[i], send = hi ? a16[i] : a16[i + 8]; b8[i] = keep + lx32(send); } }
    { const bool hi = lane & 16;
#pragma unroll
      for (int i = 0; i < 4; ++i) { const float keep = hi ? b8[i + 4] : b8[i], send = hi ? b8[i] : b8[i + 4]; b4[i] = keep + lx16(send); } }
    { const bool hi = lane & 8;
#pragma unroll
      for (int i = 0; i < 2; ++i) { const float keep = hi ? b4[i + 2] : b4[i], send = hi ? b4[i] : b4[i + 2]; b2[i] = keep + lx8(send); } }
    { const bool hi = lane & 4; const float keep = hi ? b2[1] : b2[0], send = hi ? b2[0] : b2[1]; lg = keep + lx4(send); }
    lg += lx2(lg); lg += lx1(lg);
    float mx = lg;
    mx = fmaxf(mx, lx4(mx)); mx = fmaxf(mx, lx8(mx)); mx = fmaxf(mx, lx16(mx)); mx = fmaxf(mx, lx32(mx));
    const float ex = expf(lg - mx); float sum = ex;
    sum += lx4(sum); sum += lx8(sum); sum += lx16(sum); sum += lx32(sum);
    const int set = r < NLAT ? (r >> 11) : 8 + ((r - NLAT) >> 8), n = r < NLAT ? (r & (SEQ - 1)) : ((r - NLAT) & (CTX - 1));
    if ((lane & 3) == 0) AFF[((size_t)set * NE + ((lane >> 2) & 15)) * SEQ + n] = ex / sum;
}
__device__ __forceinline__ void pf_norm2_router(Frame& F, int l, int mode = 0) {
    int tid_ = threadIdx.x; asm volatile("" : "+v"(tid_));
    const int lane = tid_ & 63, wave_ = __builtin_amdgcn_readfirstlane(tid_ >> 6);
    const int gw = F.vcu * NWAVES + wave_, NGW = F.G * NWAVES;
    LAS float* wrT = (LAS float*)F.lds;
    { const float* wr = inptr(F, IN_WROUTER) + (size_t)l * DM * NE;
#pragma unroll 8
      for (int i = tid_; i < DM * NE; i += NWAVES * 64) { const int k = i >> 4, e = i & 15; wrT[e * DM + k] = wr[i]; } }
    __syncthreads();
    const int nrows = (l == DEPTH - 1) ? NLAT : NTOK, rpw = (nrows + NGW - 1) / NGW, r0 = gw * rpw, r1 = r0 + rpw < nrows ? r0 + rpw : nrows;
    const bf16* X = WSP(bf16, WS_X); const float* g2n = inptr(F, IN_NORM2G) + l * DM; float* AFF = WSP(float, WS_AFF);
    f32x4 va[4], vb[4]; ModVec m; int cset = -1;
    if (r0 < r1) load_row_bf16(va, X + (size_t)r0 * DM, lane);
    if (r0 + 1 < r1) load_row_bf16(vb, X + (size_t)(r0 + 1) * DM, lane);
    for (int r = r0; r < r1; ++r) {
        f32x4 v[4];
#pragma unroll
        for (int j = 0; j < 4; ++j) { v[j] = va[j]; va[j] = vb[j]; }
        if (r + 2 < r1) load_row_bf16(vb, X + (size_t)(r + 2) * DM, lane);
        const int mset = row_modset(r);
        if (mset != cset) { const float* mod = WSP(float, WS_MOD) + ((size_t)l * 9 + mset) * 6 * DM; load_modvec(m, g2n, mod + 3 * DM, mod + 4 * DM, lane); cset = mset; }
        norm_row_m(v, m);
        if (mode < 2) store_row_bf16(WSP(bf16, WS_HN) + (size_t)r * DM, v, lane);
        if (mode >= 1) { asm volatile("" :: "v"(v[0]), "v"(v[1]), "v"(v[2]), "v"(v[3])); continue; }
        float a16[NE];
#pragma unroll
        for (int e = 0; e < NE; ++e) { float a = 0.f;
#pragma unroll
            for (int j = 0; j < 4; ++j) { const f32x4 w = *(const LAS f32x4*)(wrT + e * DM + 4 * lane + 256 * j); a = fmaf(v[j][0], w[0], a); a = fmaf(v[j][1], w[1], a); a = fmaf(v[j][2], w[2], a); a = fmaf(v[j][3], w[3], a); }
            a16[e] = a; if ((e & 3) == 3) asm volatile("" ::: "memory"); }
        router_finish(a16, r, lane, AFF);
    }
    __syncthreads();
}
__device__ __forceinline__ void pg_topk_gather(Frame& F, int l) {
    int tid_ = threadIdx.x; asm volatile("" : "+v"(tid_));
    const int lane = tid_ & 63, wave_ = __builtin_amdgcn_readfirstlane(tid_ >> 6);
    LAS unsigned* cnt = (LAS unsigned*)F.lds;
    LAS int* sidx = (LAS int*)(F.lds + 1024);
    const int nitems = (l == DEPTH - 1) ? 8 * NE : 16 * NE;
    const int tid = tid_, wave = wave_;
    const unsigned long long lt = (1ull << lane) - 1ull;
    for (int it = F.vcu; it < nitems; it += F.G) {
        const int set = it >> 4, e = it & 15; const bool latent = set < 8; const int N = latent ? SEQ : CTX, cap = latent ? CAPL : CAPC;
        const int rowbase = latent ? set * SEQ : NLAT + (set - 8) * CTX, xbase = latent ? set * CAPL : 8 * CAPL + (set - 8) * CAPC;
        const float* a = WSP(float, WS_AFF) + ((size_t)set * NE + e) * SEQ;
        unsigned key[4];
#pragma unroll
        for (int q = 0; q < 4; ++q) { const int i = q * 512 + tid; key[q] = i < N ? __builtin_bit_cast(unsigned, a[i]) : 0u; }
        unsigned T = 0u;
        for (int bit = 30; bit >= 0; --bit) {
            const unsigned cand = T | (1u << bit); unsigned c = 0;
#pragma unroll
            for (int q = 0; q < 4; ++q) c += (unsigned)__builtin_popcountll(__ballot(key[q] >= cand));
            LAS unsigned* cb = cnt + (bit & 1) * 8;
            if (lane == 0) cb[wave] = c;
            __syncthreads();
            unsigned tot = 0;
#pragma unroll
            for (int w = 0; w < 8; ++w) tot += cb[w];
            if (tot >= (unsigned)cap) T = cand;
        }
        LAS unsigned* cg = cnt + 64; LAS unsigned* ce = cnt + 96;
        unsigned long long bg[4], be[4];
#pragma unroll
        for (int q = 0; q < 4; ++q) { bg[q] = __ballot(key[q] > T); be[q] = __ballot(key[q] == T && key[q] != 0u);
            if (lane == 0) { cg[q * 8 + wave] = (unsigned)__builtin_popcountll(bg[q]); ce[q * 8 + wave] = (unsigned)__builtin_popcountll(be[q]); } }
        __syncthreads();
        unsigned ngt = 0;
        for (int c2 = 0; c2 < 32; ++c2) ngt += cg[c2];
        const unsigned need = (unsigned)cap - ngt;
        unsigned pre_g[4], pre_e[4];
        { unsigned rg = 0, re = 0;
#pragma unroll
          for (int q = 0; q < 4; ++q) { for (int w = 0; w < 8; ++w) { if (w == wave) { pre_g[q] = rg; pre_e[q] = re; } rg += cg[q * 8 + w]; re += ce[q * 8 + w]; } } }
        int* SEL = WSP(int, WS_SEL);
#pragma unroll
        for (int q = 0; q < 4; ++q) { const int i = q * 512 + tid;
            if (i < N) {
                const unsigned eb = pre_e[q] + (unsigned)__builtin_popcountll(be[q] & lt);
                const unsigned gb = pre_g[q] + (unsigned)__builtin_popcountll(bg[q] & lt);
                const bool isg = key[q] > T, ise = key[q] == T;
                const bool sel = isg || (ise && eb < need);
                const unsigned slot = gb + (eb < need ? eb : need);
                SEL[(size_t)(rowbase + i) * NE + e] = sel ? xbase + (int)slot : -1;
                if (sel) { WSP(float, WS_AFS)[(size_t)e * RPE + xbase + slot] = __builtin_bit_cast(float, key[q]); WSP(int, WS_IDX)[(size_t)e * RPE + xbase + slot] = rowbase + i; }
            } }
        __syncthreads();
    }
}
__device__ __forceinline__ unsigned ye_issue4(const bf16* YE, int selv, unsigned mk, v2u (&w)[4][4], int lane) {
#pragma unroll
    for (int i = 0; i < 4; ++i) {
        if (mk) { const int e = __builtin_ctz(mk); mk &= mk - 1u; const int se = __builtin_amdgcn_readlane(selv, e);
            const GAS v2u* y = (const GAS v2u*)(YE + ((size_t)e * RPE + se) * DM) + lane;
#pragma unroll
            for (int j = 0; j < 4; ++j) w[i][j] = y[64 * j]; }
        else {
#pragma unroll
            for (int j = 0; j < 4; ++j) w[i][j] = (v2u){0u, 0u}; }
    }
    return mk;
}
__device__ __forceinline__ void ye_acc4(f32x4 (&t)[4], const v2u (&w)[4][4]) {
#pragma unroll
    for (int i = 0; i < 4; ++i)
#pragma unroll
        for (int j = 0; j < 4; ++j) t[j] += (f32x4){bflo(w[i][j].x), bfhi(w[i][j].x), bflo(w[i][j].y), bfhi(w[i][j].y)};
}
__device__ __forceinline__ unsigned sel_mask(int selv) { return (unsigned)__builtin_amdgcn_readfirstlane((int)(__ballot(selv >= 0) & 0xFFFFull)); }
__device__ __forceinline__ void pj_combine(Frame& F, int l, int probe = 0) {
    int tid_ = threadIdx.x; asm volatile("" : "+v"(tid_));
    const int lane = tid_ & 63, wave_ = __builtin_amdgcn_readfirstlane(tid_ >> 6);
    const int gw = F.vcu * NWAVES + wave_, NGW = F.G * NWAVES; const bool last = l == DEPTH - 1;
    const int nrows = last ? NLAT : NTOK, rpw = (nrows + NGW - 1) / NGW, r0 = gw * rpw, r1 = r0 + rpw < nrows ? r0 + rpw : nrows;
    bf16* X = WSP(bf16, WS_X); const int* SEL = WSP(int, WS_SEL);
    const float* gnext = last ? inptr(F, IN_FINALG) : inptr(F, IN_NORM1G) + (l + 1) * DM;
    f32x4 va[4], vb[4], g2[4]; int sa = -1, sb = -1; ModVec m; int cset = -1;
    if (r0 < r1) { load_row_bf16(va, X + (size_t)r0 * DM, lane); sa = lane < NE ? SEL[(size_t)r0 * NE + lane] : -1; }
    if (r0 + 1 < r1) { load_row_bf16(vb, X + (size_t)(r0 + 1) * DM, lane); sb = lane < NE ? SEL[(size_t)(r0 + 1) * NE + lane] : -1; }
    const bf16* YE = WSP(bf16, WS_G); v2u wA[4][4], wB[4][4]; unsigned restA = 0u, restB = 0u;
    restA = ye_issue4(YE, sa, r0 < r1 ? sel_mask(sa) : 0u, wA, lane);
#define PJ_ROW(r, WC, WN, RC, RN) do { \
        f32x4 v[4], t[4]; \
        _Pragma("unroll") for (int j = 0; j < 4; ++j) { v[j] = va[j]; va[j] = vb[j]; t[j] = (f32x4){0.f, 0.f, 0.f, 0.f}; } \
        const int selv = sa; sa = sb; \
        if ((r) + 2 < r1) { load_row_bf16(vb, X + (size_t)((r) + 2) * DM, lane); sb = lane < NE ? SEL[(size_t)((r) + 2) * NE + lane] : -1; } \
        const int mset = row_modset(r); \
        if (mset != cset) { const float* mod = WSP(float, WS_MOD) + ((size_t)l * 9 + mset) * 6 * DM; const float* mod1 = WSP(float, WS_MOD) + ((size_t)(last ? l : l + 1) * 9 + mset) * 6 * DM; \
            _Pragma("unroll") for (int j = 0; j < 4; ++j) g2[j] = *(const f32x4*)(mod + 5 * DM + 4 * lane + 256 * j); \
            load_modvec(m, gnext, last ? nullptr : mod1, last ? nullptr : mod1 + DM, lane); cset = mset; } \
        RN = ye_issue4(YE, sa, (r) + 1 < r1 ? sel_mask(sa) : 0u, WN, lane);                \
        ye_acc4(t, WC); \
        while (RC) { RC = ye_issue4(YE, selv, RC, WC, lane); ye_acc4(t, WC); }               \
        _Pragma("unroll") for (int j = 0; j < 4; ++j) v[j] = v[j] + g2[j] * t[j]; \
        if (probe) { norm_row_m(v, m); asm volatile("" :: "v"(v[0]), "v"(v[1]), "v"(v[2]), "v"(v[3])); } \
        else if (!last) { \
            store_row_bf16(X + (size_t)(r) * DM, v, lane); \
            norm_row_m(v, m); \
            store_row_bf16(WSP(bf16, WS_HN) + (size_t)(r) * DM, v, lane); \
        } else { \
            norm_row_m(v, m); \
            _Pragma("unroll") for (int j = 0; j < 4; ++j) *(f32x4*)(F.out + (size_t)(r) * DM + 4 * lane + 256 * j) = v[j]; \
        } } while (0)
    for (int r = r0; r < r1; r += 2) {
        PJ_ROW(r, wA, wB, restA, restB);
        if (r + 1 < r1) PJ_ROW(r + 1, wB, wA, restB, restA);
    }
#undef PJ_ROW
}

__device__ __forceinline__ void pc_mixers(Frame& F, int l, int rep) {
    int tid_ = threadIdx.x; asm volatile("" : "+v"(tid_));
    const int lane = tid_ & 63, wave_ = __builtin_amdgcn_readfirstlane(tid_ >> 6);
    const bool need_ctx = l < DEPTH - 1;
    {
        Strided<DecDft> S; S.d.Dm = (const char*)(F.ws + WS_DFT); S.d.Dc = (const char*)(F.ws + WS_DFTC); S.d.ABt = (const char*)(F.ws + WS_ABT); S.d.ABtc = (const char*)(F.ws + WS_ABTC);
        S.n = need_ctx ? 72 : 64; S.G = F.G; S.vcu = F.vcu;
        EpiStore E{WSP(bf16, WS_BR), DM};
        pg8::gemm_phase<EpiStore, Strided<DecDft>>(F.lds, (LAS int*)(F.lds + IDXBUF_OFF), S, E);
    }
    typedef attn_body::bf16 abf;
    const abf* Qg = (const abf*)(F.ws + WS_QKV + QKV_QG); const abf* Kg = (const abf*)(F.ws + WS_QKV + QKV_KG); const abf* Vg = (const abf*)(F.ws + WS_QKV + QKV_VG);
    const abf* Qw = (const abf*)(F.ws + WS_QKV + QKV_QW); const abf* Kw = (const abf*)(F.ws + WS_QKV + QKV_KW); const abf* Vw = (const abf*)(F.ws + WS_QKV + QKV_VW);
    abf* BR = (abf*)(F.ws + WS_BR);
    const int nGL = NBATCH * 2 * 32, nWL = NBATCH * 2 * 16, nGC = need_ctx ? NBATCH * 2 * 4 : 0, nWC = need_ctx ? NBATCH * 2 * 2 : 0, nattn = nGL + nWL + nGC + nWC;
    const int nconv = (CONV_IN_ATTN && F.G == 256 && rep == 0) ? CONV_ITEMS_L0 : 0, ntot = nattn + nconv;
    gu32* head = F.ctl + CW_QUEUE + 64 * (l + 2 * rep);
    const int wid = wave_;
    for (;;) {
        if (tid_ == 0) F.MISC[0] = __hip_atomic_fetch_add(head, 1u, RLX_AGENT);
        __syncthreads();
        const int q = (int)F.MISC[0];
        if (q >= ntot) break;
        const int c0 = (int)(((long long)q * nconv) / ntot), c1 = (int)(((long long)(q + 1) * nconv) / ntot);
        if (c1 > c0) { conv_wave_item(F, (l * CONV_ITEMS_L0 + c0) * NWAVES + wave_, lane); __syncthreads(); continue; }
        const int a = q - c0;
        if (a < nGL) {
            const int b = a >> 6, hkv = (a >> 5) & 1, qb = a & 31, head_ = hkv * 4 + (wid >> 1), q0 = qb * 64 + (wid & 1) * 32; const size_t qrow = (size_t)b * SEQ + q0;
            attn_body::attn_unit<0, 8>(Qg + qrow * 512 + head_ * 64, 512, Kg + (size_t)(NLAT + b * CTX) * 128 + hkv * 64, Kg + (size_t)b * SEQ * 128 + hkv * 64,
                                        Vg + (size_t)(NLAT + b * CTX) * 128 + hkv * 64, Vg + (size_t)b * SEQ * 128 + hkv * 64, 128, 4 + SEQ / 64, 0, 0, 0.f, BR + qrow * DM + 256 + head_ * 64, DM, F.ldsg);
        } else if (a < nGL + nWL) {
            const int u = a - nGL, b = u >> 5, hkv = (u >> 4) & 1, qb = u & 15, head_ = hkv * 2 + (wid >> 2), q0 = qb * 128 + (wid & 3) * 32; const size_t qrow = (size_t)b * SEQ + q0;
            const int band0 = qb * 128 - 128 < 0 ? 0 : qb * 128 - 128, band1 = qb * 128 + 256 > SEQ ? SEQ : qb * 128 + 256;
            attn_body::attn_unit<1, 8>(Qw + qrow * 256 + head_ * 64, 256, Kw + (size_t)(NLAT + b * CTX) * 128 + hkv * 64, Kw + ((size_t)b * SEQ + band0) * 128 + hkv * 64,
                                        Vw + (size_t)(NLAT + b * CTX) * 128 + hkv * 64, Vw + ((size_t)b * SEQ + band0) * 128 + hkv * 64, 128, 4 + (band1 - band0) / 64, q0, band0,
                                        inptr(F, IN_SINK)[l * 4 + head_] * LOG2E, BR + qrow * DM + 768 + head_ * 64, DM, F.ldsg);
        } else if (a < nGL + nWL + nGC) {
            const int u = a - nGL - nWL, b = u >> 3, hkv = (u >> 2) & 1, qb = u & 3, head_ = hkv * 4 + (wid >> 1); const size_t qrow = (size_t)NLAT + b * CTX + qb * 64 + (wid & 1) * 32;
            const abf* Kc = Kg + (size_t)(NLAT + b * CTX) * 128 + hkv * 64; const abf* Vc = Vg + (size_t)(NLAT + b * CTX) * 128 + hkv * 64;
            attn_body::attn_unit<0, 8>(Qg + qrow * 512 + head_ * 64, 512, Kc, Kc, Vc, Vc, 128, 4, 0, 0, 0.f, BR + qrow * DM + 256 + head_ * 64, DM, F.ldsg);
        } else {
            const int u = a - nGL - nWL - nGC, b = u >> 2, hkv = (u >> 1) & 1, qb = u & 1, head_ = hkv * 2 + (wid >> 2); const size_t qrow = (size_t)NLAT + b * CTX + qb * 128 + (wid & 3) * 32;
            const abf* Kc = Kw + (size_t)(NLAT + b * CTX) * 128 + hkv * 64; const abf* Vc = Vw + (size_t)(NLAT + b * CTX) * 128 + hkv * 64;
            attn_body::attn_unit<1, 8>(Qw + qrow * 256 + head_ * 64, 256, Kc, Kc, Vc, Vc, 128, 4, 0, 0, inptr(F, IN_SINK)[l * 4 + head_] * LOG2E, BR + qrow * DM + 768 + head_ * 64, DM, F.ldsg);
        }
    }
    __syncthreads();
}
#ifndef MK_N_LAUNCHES
#define MK_N_LAUNCHES 1
#endif
constexpr int N_PHASES = 2 + 9 * DEPTH;
struct Args { const float* in[21]; float* out; unsigned char* ws; int ph_lo, ph_hi, probe, pad_; };

__global__ void __launch_bounds__(NWAVES * 64, 2) hybrid_fwd(Args args) {
    extern __shared__ __attribute__((aligned(16))) unsigned char lds[];
    Frame F;
    F.lds = (LAS unsigned char*)lds; F.ldsg = (char*)lds; F.MISC = (volatile LAS unsigned*)(F.lds + MISC_OFF);
    F.G = gridDim.x; { const int bx = blockIdx.x; F.vcu = (F.G % 8 == 0) ? (bx % 8) * (F.G / 8) + bx / 8 : bx; }
    F.ws = args.ws; F.out = args.out; F.dout = (unsigned char*)args.out; F.ctl = (gu32*)(args.ws + WS_CTL);
#ifdef DBG_LDSPOISON
    for (int u = threadIdx.x; u < LDSCTL_OFF / 4; u += NWAVES * 64) ((LAS unsigned*)F.lds)[u] = 0xFFFFFFFFu;
#endif
    for (int u = threadIdx.x; u < (LDS_BYTES - LDSCTL_OFF) / 4; u += NWAVES * 64) ((LAS unsigned*)(F.lds + LDSCTL_OFF))[u] = 0u;
    __syncthreads();
    if (threadIdx.x < 21) *(LAS unsigned long long*)(F.lds + PTRS_OFF + 8 * threadIdx.x) = (unsigned long long)args.in[threadIdx.x];
    __syncthreads();
    XcdBarrier bar; bar.bar = (unsigned*)(F.ctl + CW_BAR); bar.x = 0; bar.st = nullptr;
    const int lo = args.ph_lo, hi = args.ph_hi;
    if (hi - lo > 1) bar = xcd_barrier_post((unsigned*)(F.ctl + CW_BAR), F.MISC + 8);
#ifndef PHSEL
#define PHSEL 0x7ff
#endif
#define IN(k) (lo <= (k) && (k) < hi)
#define KIND(j) ((PHSEL >> (j)) & 1)
#ifndef DBG_PROBE
#define DBG_PROBE 0
#endif
#ifndef FPROBE_MODE
#define FPROBE_MODE 0
#endif
#ifndef REP_MASK
#define REP_MASK 0
#endif
#define NREP(j, ok) ((((REP_MASK) >> (j)) & 1) && (ok) ? 2 : 1)
#define REPEAT(j, ok) for (int rep_ = 0, nrep_ = NREP(j, ok); rep_ < nrep_; ++rep_, (rep_ < nrep_ ? xcd_barrier(bar) : (void)0))
#define SEAM(k) do { if (IN(k) && IN((k) + 1)) xcd_barrier(bar); } while (0)

#ifdef BAR_PROBE
    if (hi - lo > 1) for (int i_ = 0; i_ < BAR_PROBE; ++i_) xcd_barrier(bar);
#endif
    if (KIND(0) && IN(0)) REPEAT(0, true) { p0_prologue(F, rep_ ? DBG_PROBE : 0); } SEAM(0);
    if (KIND(1) && IN(1)) REPEAT(1, true) { p1_norm1(F); } SEAM(1);
    for (int l = 0; l < DEPTH; ++l) {
        const int pb = 2 + 9 * l; const bool lastl = l == DEPTH - 1;
        const int nrt = lastl ? 64 : 72;
        if (KIND(2) && IN(pb + 0)) REPEAT(2, true) {
            Strided<DecInProj> S; S.d.A = (const char*)(F.ws + WS_HN); S.d.B = (const char*)(F.ws + WS_WIN) + (size_t)l * INW2 * DM * 2; S.d.layer = l; S.n = inproj_units(l); S.G = F.G; S.vcu = F.vcu;
            EpiInProj E; E.ABt = (bf16*)(F.ws + WS_ABT); E.ABtc = (bf16*)(F.ws + WS_ABTC);
            E.Qg = (bf16*)(F.ws + WS_QKV + QKV_QG); E.Kg = (bf16*)(F.ws + WS_QKV + QKV_KG); E.Vg = (bf16*)(F.ws + WS_QKV + QKV_VG);
            E.Qw = (bf16*)(F.ws + WS_QKV + QKV_QW); E.Kw = (bf16*)(F.ws + WS_QKV + QKV_KW); E.Vw = (bf16*)(F.ws + WS_QKV + QKV_VW);
            E.G = WSP(bf16, WS_G); E.rope = WSP(float, WS_ROPE); E.qng = inptr(F, IN_QNG) + l * 64; E.kng = inptr(F, IN_KNG) + l * 64;
            pg8::gemm_phase<EpiInProj, Strided<DecInProj>>(F.lds, (LAS int*)(F.lds + IDXBUF_OFF), S, E);
            if (!CONV_IN_ATTN && l == 0 && F.G == 256 && F.vcu >= 88 && rep_ == 0) tail_convert(F, F.vcu - 88, 0, 4, 672);
        } SEAM(pb + 0);
        if (KIND(3) && IN(pb + 1)) REPEAT(3, true) { pc_mixers(F, l, rep_); } SEAM(pb + 1);
        if (KIND(4) && IN(pb + 2)) REPEAT(4, true) {
            SchedMerge S; S.BR = (const char*)(F.ws + WS_BR); S.W = (const char*)(F.ws + WS_WBR) + (size_t)l * DM * DM * 2; S.ntiles = nrt * 4; S.G = F.G; S.vcu = F.vcu;
            EpiMerge E{WSP(bf16, WS_G), (rep_ + 1 == nrep_ && !args.probe) ? (bf16*)(F.ws + WS_MB) : WSP(bf16, WS_HN), args.probe};
            pg8::gemm_phase<EpiMerge, SchedMerge>(F.lds, (LAS int*)(F.lds + IDXBUF_OFF), S, E);
            if (!CONV_IN_ATTN && l == 0 && F.G == 256 && F.vcu >= 32 && rep_ == 0) tail_convert(F, F.vcu - 32, 672, 3, 1344);
        } SEAM(pb + 2);
        if (KIND(5) && IN(pb + 3)) REPEAT(5, l == 0) {
            Strided<DecWout> S; S.d.Mb = (const char*)(F.ws + WS_MB); S.d.W = (const char*)(F.ws + WS_WOUT) + (size_t)l * DM * DM * 2; S.n = nrt * 4; S.G = F.G; S.vcu = F.vcu;
            EpiWout E; E.baseL = inptr(F, IN_X); E.baseC = inptr(F, IN_CTX) - (size_t)NLAT * DM; E.baseX = WSP(bf16, WS_X); E.X = WSP(bf16, WS_X); E.from_x = l != 0; E.mod = WSP(float, WS_MOD) + (size_t)l * 9 * 6 * DM;
            pg8::gemm_phase<EpiWout, Strided<DecWout>>(F.lds, (LAS int*)(F.lds + IDXBUF_OFF), S, E);
            if (!CONV_IN_ATTN && l == 0 && F.G == 256 && F.vcu >= 32 && rep_ == 0) tail_convert(F, F.vcu - 32, 1344, 3, 2016);
        } SEAM(pb + 3);
        if (KIND(6) && IN(pb + 4)) REPEAT(6, true) { pf_norm2_router(F, l, rep_ ? FPROBE_MODE : 0); } SEAM(pb + 4);
        if (KIND(7) && IN(pb + 5)) REPEAT(7, true) { pg_topk_gather(F, l); } SEAM(pb + 5);
        const int ert = lastl ? 8 : 9;
        if (KIND(8) && IN(pb + 6)) REPEAT(8, true) {
            Strided<DecGU> S; S.d.H2 = (const char*)(F.ws + WS_HN); S.d.IDX = WSP(int, WS_IDX); S.d.W = (const char*)(F.ws + WS_WGU) + (size_t)l * NE * 2 * DM * DM * 2; S.d.nrt = ert; S.n = NE * ert * 8; S.G = F.G; S.vcu = F.vcu;
            EpiGU E{WSP(bf16, WS_HACT)};
            pg8::gemm_phase<EpiGU, Strided<DecGU>>(F.lds, (LAS int*)(F.lds + IDXBUF_OFF), S, E);
            if (!CONV_IN_ATTN && l == 0 && F.G == 256 && F.vcu >= 128 && rep_ == 0) tail_convert(F, F.vcu - 128, 2016, 4, 2528);
        } SEAM(pb + 6);
        if (KIND(9) && IN(pb + 7)) REPEAT(9, true) {
            Strided<DecDown> S; S.d.H = (const char*)(F.ws + WS_HACT); S.d.W = (const char*)(F.ws + WS_WD) + (size_t)l * NE * DM * DM * 2; S.d.nrt = ert; S.n = NE * ert * 4; S.G = F.G; S.vcu = F.vcu;
            EpiDown E{WSP(bf16, WS_G), WSP(float, WS_AFS)};
            pg8::gemm_phase<EpiDown, Strided<DecDown>>(F.lds, (LAS int*)(F.lds + IDXBUF_OFF), S, E);
            if (!CONV_IN_ATTN && l == 0 && F.G == 256 && F.vcu >= 64 && rep_ == 0) tail_convert(F, F.vcu - 64, 2528, 3, CONV_ITEMS);
        } SEAM(pb + 7);
        if (KIND(10) && IN(pb + 8)) REPEAT(10, true) { pj_combine(F, l, rep_); }
        if (!lastl) SEAM(pb + 8);
    }
#undef IN
#undef SEAM
}

#ifdef DBG_STOP
__global__ void k_dump(const unsigned short* __restrict__ src, float* __restrict__ out, size_t n) {
    for (size_t i = (size_t)blockIdx.x * blockDim.x + threadIdx.x; i < n; i += (size_t)gridDim.x * blockDim.x) out[i] = __uint_as_float((unsigned)src[i] << 16);
}
#endif
extern "C" void kernel_launch(void* const* d_in, const int* in_sizes, int n_in, void* d_out, int out_size, void* d_ws, size_t ws_size, hipStream_t stream) {
    static int grid = 0;
    if (grid == 0) {
        if (n_in != 21 || out_size != NLAT * DM || ws_size < WS_END) { fprintf(stderr, "kernel_launch: unexpected problem (n_in %d, out %d, ws %zu < %zu)\n", n_in, out_size, ws_size, (size_t)WS_END); grid = -1; return; }
        int dev = 0, cus = 0, per_cu = 0;
        if (hipGetDevice(&dev) != hipSuccess || hipDeviceGetAttribute(&cus, hipDeviceAttributeMultiprocessorCount, dev) != hipSuccess) { grid = -1; return; }
        if (hipFuncSetAttribute((const void*)hybrid_fwd, hipFuncAttributeMaxDynamicSharedMemorySize, LDS_BYTES) != hipSuccess) { fprintf(stderr, "kernel_launch: hipFuncSetAttribute failed\n"); grid = -1; return; }
        if (hipOccupancyMaxActiveBlocksPerMultiprocessor(&per_cu, (const void*)hybrid_fwd, NWAVES * 64, LDS_BYTES) != hipSuccess || per_cu < 1) { fprintf(stderr, "kernel_launch: occupancy query says %d blocks/CU\n", per_cu); per_cu = 1; }
        (void)hipGetLastError();
        grid = cus * 1;
    }
    if (grid < 0) return;
    hipMemsetAsync((char*)d_ws + WS_CTL, 0, CTL_ZERO_BYTES, stream);
    Args a; memset(&a, 0, sizeof(a));
    for (int i = 0; i < 21; ++i) a.in[i] = (const float*)d_in[i];
    a.out = (float*)d_out; a.ws = (unsigned char*)d_ws;
#if MK_N_LAUNCHES == 1
    a.ph_lo = 0; a.ph_hi = N_PHASES;
    hipLaunchKernelGGL(hybrid_fwd, dim3(grid), dim3(NWAVES * 64), LDS_BYTES, stream, a);
#else
    int nph_ = N_PHASES;
#ifdef DBG_STOP
    nph_ = DBG_STOP;
#endif
    for (int p = 0; p < nph_; ++p) { a.ph_lo = p; a.ph_hi = p + 1; hipLaunchKernelGGL(hybrid_fwd, dim3(grid), dim3(NWAVES * 64), LDS_BYTES, stream, a);
#ifdef DBG_DUP_PHASE
        if (p == DBG_DUP_PHASE) { a.probe = DBG_PROBE; hipLaunchKernelGGL(hybrid_fwd, dim3(grid), dim3(NWAVES * 64), LDS_BYTES, stream, a); a.probe = 0; }
#endif
    }
#ifdef DBG_STOP
    hipLaunchKernelGGL(k_dump, dim3(2048), dim3(256), 0, stream, (const unsigned short*)((const char*)d_ws + ((size_t)DBG_DUMP_MIB << 20)), (float*)d_out, (size_t)NLAT * DM);
#endif
#endif
}
```

```cpp
#define MK_N_LAUNCHES 1
#include <hip/hip_runtime.h>
#include <hip/hip_bf16.h>
#include <cstdio>
#include <cstdint>
#include <cmath>
#include <cstring>

constexpr int DM = 1024, NBATCH = 8, SEQ = 2048, CTX = 256, DEPTH = 2;
constexpr int NLAT = NBATCH * SEQ, NCTX = NBATCH * CTX, NTOK = NLAT + NCTX;
constexpr int INW = 4608, NCOLT = 19, INW2 = NCOLT * 256;
constexpr int NE = 16, CAPL = 256, CAPC = 32, RPE = NBATCH * (CAPL + CAPC);
constexpr float EPS = 1e-6f;
constexpr float QSCALE = 0.125f * 1.4426950408889634f;
constexpr float LOG2E = 1.4426950408889634f;
namespace pg8 {
#define PG8_LAS __attribute__((address_space(3)))
typedef unsigned short bf16_t;
typedef short bf16x8 __attribute__((ext_vector_type(8)));
typedef float f32x4 __attribute__((ext_vector_type(4)));
typedef unsigned u32x4 __attribute__((ext_vector_type(4)));
typedef unsigned u32x2 __attribute__((ext_vector_type(2)));
constexpr int BM = 256, BK = 64, HALF = 128, HTB = HALF * BK * 2  , STAGE_BYTES = 8 * HTB;

__host__ __device__ __forceinline__ int lds_byte(int r, int c) { const int st = (r >> 4) * 2 + (c >> 5), rr = r & 15, cc = c & 31, ob = rr * 64 + cc * 2; return st * 1024 + (ob ^ (((ob >> 9) & 1) << 5)); }
__host__ __device__ __forceinline__ int perm32(int rho) { const int n = rho >> 4, i = rho & 15; return 8 * (i >> 2) + 4 * n + (i & 3); }
__host__ __device__ __forceinline__ void stage_rc(int b, int& R, int& C) { const int st = b / 1024, sb = b % 1024, swz = sb ^ (((sb >> 9) & 1) << 5); R = (st >> 1) * 16 + swz / 64; C = (st & 1) * 32 + (swz % 64) / 2; }

struct Unit { const char* A; const char* B; const int* arows; int ldA, ldB, nt; int pm, pn, tag; };

typedef float f32x2_c __attribute__((ext_vector_type(2)));
typedef __bf16 bf16x2_c __attribute__((ext_vector_type(2)));
__device__ __forceinline__ unsigned cvt_pk_bf16(float lo, float hi) { const f32x2_c v = {lo, hi}; const bf16x2_c b = __builtin_convertvector(v, bf16x2_c); return __builtin_bit_cast(unsigned, b); }

template <class Epi, class Sched>
__device__ __forceinline__ void gemm_phase(PG8_LAS unsigned char* lds, PG8_LAS int* idxbuf  , const Sched& S, const Epi& E) {
    int tid = threadIdx.x; asm volatile("" : "+v"(tid));
    const int wid = __builtin_amdgcn_readfirstlane(tid >> 6), lane = tid & 63, wr = wid >> 2, wc = wid & 3, fr = lane & 15, fq = lane >> 4;
    unsigned Rr[2], RrB[2], Cc2[2];
#pragma unroll
    for (int i = 0; i < 2; ++i) { int R, C; stage_rc(tid * 16 + i * 8192, R, C); Rr[i] = (unsigned)R; RrB[i] = Epi::PERM ? (unsigned)((R & ~31) + perm32(R & 31)) : (unsigned)R; Cc2[i] = (unsigned)C * 2u; }
    const size_t kstep = (size_t)(BK * 2);
    const unsigned ldsw = (unsigned)wid * 1024u;
    const int aoff = lds_byte(wr * 64 + fr, fq * 8), boff = lds_byte(wc * 32 + fr, fq * 8);
#define PG8_SA(b, h) (((b) * 2 + (h)) * HTB)
#define PG8_SB(b, h) ((4 + (b) * 2 + (h)) * HTB)
#define PG8_STAGE(bufoff, gbase, ld) do { _Pragma("unroll") for (int _i = 0; _i < 2; ++_i) \
        __builtin_amdgcn_global_load_lds((const unsigned*)((const char*)(gbase) + (RrB[_i] * (unsigned)(ld) + Cc2[_i])), (PG8_LAS unsigned*)(lds + (bufoff) + ldsw + _i * 8192), 16, 0, 0); } while (0)
#define PG8_STAGE_A(bufoff, gbase, ao) do { _Pragma("unroll") for (int _i = 0; _i < 2; ++_i) \
        __builtin_amdgcn_global_load_lds((const unsigned*)((const char*)(gbase) + (ao)[_i]), (PG8_LAS unsigned*)(lds + (bufoff) + ldsw + _i * 8192), 16, 0, 0); } while (0)
#define PG8_AOFF(u, ao) do { _Pragma("unroll") for (int _h = 0; _h < 2; ++_h) _Pragma("unroll") for (int _i = 0; _i < 2; ++_i) { \
        const unsigned _row = (u).arows ? (unsigned)idxbuf[Rr[_i] + 128 * _h] : Rr[_i] + 128u * _h; (ao)[_h][_i] = _row * (unsigned)(u).ldA + Cc2[_i]; } } while (0)
#define PG8_STAGE_IDX(u) do { if ((u).arows) __builtin_amdgcn_global_load_lds((const unsigned*)((u).arows + (wid & 3) * 64 + lane), (PG8_LAS unsigned*)((PG8_LAS unsigned char*)idxbuf + (wid & 3) * 256), 4, 0, 0); } while (0)
#define PG8_LDA(dst, b, h) do { _Pragma("unroll") for (int m = 0; m < 4; ++m) _Pragma("unroll") for (int k = 0; k < 2; ++k) dst[m][k] = *(const PG8_LAS bf16x8*)(lds + PG8_SA(b, h) + aoff + m * 2048 + k * 1024); } while (0)
#define PG8_LDB(dst, b, h) do { _Pragma("unroll") for (int n = 0; n < 2; ++n) _Pragma("unroll") for (int k = 0; k < 2; ++k) dst[n][k] = *(const PG8_LAS bf16x8*)(lds + PG8_SB(b, h) + boff + n * 2048 + k * 1024); } while (0)
#define PG8_MMA(ai, bj, At, Bt) do { __builtin_amdgcn_s_setprio(1); _Pragma("unroll") for (int m = 0; m < 4; ++m) _Pragma("unroll") for (int n = 0; n < 2; ++n) _Pragma("unroll") for (int k = 0; k < 2; ++k) \
        acc[ai][bj][m][n] = __builtin_amdgcn_mfma_f32_16x16x32_bf16(Bt[n][k], At[m][k], acc[ai][bj][m][n], 0, 0, 0); __builtin_amdgcn_s_setprio(0); } while (0)
#define PG8_WAIT_V(n) asm volatile("s_waitcnt vmcnt(" #n ")" ::: "memory")
#define PG8_WAIT_L(n) asm volatile("s_waitcnt lgkmcnt(" #n ")" ::: "memory")
#define PG8_BAR __builtin_amdgcn_s_barrier()
#define PG8_SCHED __builtin_amdgcn_sched_barrier(0)
    Unit cur, nxt; int ui = 0;
    if (!S.next(0, cur)) return;
    nxt = cur;
    f32x4 acc[2][2][4][2];
#pragma unroll
    for (int a = 0; a < 2; ++a)
#pragma unroll
        for (int b = 0; b < 2; ++b)
#pragma unroll
            for (int m = 0; m < 4; ++m)
#pragma unroll
                for (int n = 0; n < 2; ++n) acc[a][b][m][n] = (f32x4){0.f, 0.f, 0.f, 0.f};
    bf16x8 At[4][2], B0[2][2], B1[2][2];
    const char* cA = cur.A; const char* cB = cur.B; int clb = cur.ldB;
    unsigned ao_c[2][2], ao_n[2][2];
    if (cur.arows) { PG8_STAGE_IDX(cur); PG8_WAIT_V(0); PG8_BAR; }
    PG8_AOFF(cur, ao_c);
#pragma unroll
    for (int _h = 0; _h < 2; ++_h)
#pragma unroll
        for (int _i = 0; _i < 2; ++_i) ao_n[_h][_i] = ao_c[_h][_i];
    if (cur.arows) { PG8_WAIT_L(0); PG8_BAR; }
    {
        const size_t hB = (size_t)HALF * clb;
        PG8_STAGE(PG8_SB(0, 0), cB, clb); PG8_STAGE(PG8_SB(0, 1), cB + hB, clb); PG8_STAGE_A(PG8_SA(0, 0), cA, ao_c[0]); PG8_STAGE_A(PG8_SA(0, 1), cA, ao_c[1]);
        if (wr == 1) PG8_BAR;
        PG8_WAIT_V(2); PG8_BAR;
        PG8_STAGE(PG8_SB(1, 0), cB + kstep, clb); PG8_STAGE_A(PG8_SA(1, 0), cA + kstep, ao_c[0]); PG8_STAGE(PG8_SB(1, 1), cB + hB + kstep, clb);
        PG8_WAIT_V(6); PG8_BAR;
    }
    for (;;) {
        const bool has_next = S.next(ui + 1, nxt);
        const char* nA = has_next ? nxt.A : cA; const char* nB = has_next ? nxt.B : cB; const int nlb = has_next ? nxt.ldB : clb;
        const int nt = cur.nt;
        if (has_next) PG8_STAGE_IDX(nxt);
        for (int t = 0; t < nt; t += 2) {
            const bool last = (t == nt - 2);
            if (last) { if (has_next) { PG8_AOFF(nxt, ao_n); } else {
#pragma unroll
                for (int _h = 0; _h < 2; ++_h)
#pragma unroll
                    for (int _i = 0; _i < 2; ++_i) ao_n[_h][_i] = ao_c[_h][_i]; } }
            unsigned ao2[2][2];
#pragma unroll
            for (int _h = 0; _h < 2; ++_h)
#pragma unroll
                for (int _i = 0; _i < 2; ++_i) ao2[_h][_i] = last ? ao_n[_h][_i] : ao_c[_h][_i];
            const char* a1 = cA + (size_t)(t + 1) * kstep;
            const char* a2 = last ? nA : cA + (size_t)(t + 2) * kstep; const char* b2 = last ? nB : cB + (size_t)(t + 2) * kstep;
            const int lb2 = last ? nlb : clb;
            const size_t hB2 = (size_t)HALF * lb2;
            const char* a3 = a2 + kstep; const char* b3 = b2 + kstep;
            PG8_LDB(B0, 0, 0); PG8_LDB(B1, 0, 1); PG8_SCHED; PG8_LDA(At, 0, 0); PG8_STAGE_A(PG8_SA(1, 1), a1, ao_c[1]);
            PG8_WAIT_V(8); PG8_WAIT_L(0); PG8_BAR; PG8_MMA(0, 0, At, B0); PG8_MMA(0, 1, At, B1); PG8_BAR; PG8_SCHED;
            PG8_LDA(At, 0, 1); PG8_STAGE(PG8_SB(0, 0), b2, lb2); PG8_STAGE(PG8_SB(0, 1), b2 + hB2, lb2); PG8_STAGE_A(PG8_SA(0, 0), a2, ao2[0]);
            PG8_WAIT_V(8); PG8_WAIT_L(0); PG8_BAR; PG8_MMA(1, 0, At, B0); PG8_MMA(1, 1, At, B1); PG8_BAR; PG8_SCHED;
            PG8_LDB(B0, 1, 0); PG8_LDB(B1, 1, 1); PG8_SCHED; PG8_LDA(At, 1, 0); PG8_STAGE_A(PG8_SA(0, 1), a2, ao2[1]);
            PG8_WAIT_V(8); PG8_WAIT_L(0); PG8_BAR; PG8_MMA(0, 0, At, B0); PG8_MMA(0, 1, At, B1); PG8_BAR; PG8_SCHED;
            PG8_LDA(At, 1, 1); PG8_STAGE(PG8_SB(1, 0), b3, lb2); PG8_STAGE(PG8_SB(1, 1), b3 + hB2, lb2); PG8_STAGE_A(PG8_SA(1, 0), a3, ao2[0]);
            PG8_WAIT_V(8); PG8_WAIT_L(0); PG8_BAR; PG8_MMA(1, 0, At, B0); PG8_MMA(1, 1, At, B1); PG8_BAR; PG8_SCHED;
        }
        if (wr == 0) PG8_BAR;
        bool keep_acc;
        { Unit eu = cur; int ewr = wr, ewc = wc, efr = fr, efq = fq; asm volatile("" : "+s"(eu.pm), "+s"(eu.pn), "+s"(eu.tag), "+s"(ewr), "+s"(ewc), "+v"(efr), "+v"(efq));
          keep_acc = E(acc, eu, ewr, ewc, efr, efq); }
        if (!has_next) break;
        if (!keep_acc) {
#pragma unroll
        for (int a = 0; a < 2; ++a)
#pragma unroll
            for (int b = 0; b < 2; ++b)
#pragma unroll
                for (int m = 0; m < 4; ++m)
#pragma unroll
                    for (int n = 0; n < 2; ++n) acc[a][b][m][n] = (f32x4){0.f, 0.f, 0.f, 0.f};
        }
        cur = nxt; cA = nA; cB = nB; clb = nlb; ++ui;
#pragma unroll
        for (int _h = 0; _h < 2; ++_h)
#pragma unroll
            for (int _i = 0; _i < 2; ++_i) ao_c[_h][_i] = ao_n[_h][_i];
        if (wr == 1) PG8_BAR;
    }
    PG8_WAIT_V(0);
    PG8_BAR;
#undef PG8_SA
#undef PG8_SB
#undef PG8_STAGE
#undef PG8_STAGE_A
#undef PG8_AOFF
#undef PG8_STAGE_IDX
#undef PG8_LDA
#undef PG8_LDB
#undef PG8_MMA
#undef PG8_WAIT_V
#undef PG8_WAIT_L
#undef PG8_BAR
#undef PG8_SCHED
}
}
#include <hip/hip_bf16.h>
#include <cmath>
namespace attn_body {
using bf16=__hip_bfloat16;
using bf16x8=__attribute__((ext_vector_type(8)))short;
using s16x4=__attribute__((ext_vector_type(4)))short;
using f32x16=__attribute__((ext_vector_type(16)))float;
using u32x4=__attribute__((ext_vector_type(4)))unsigned;
constexpr int D=64;
constexpr int NW=8,QBLK=32,KVBLK=64,NCT=4;
__device__ __forceinline__ int crow(int r,int hi){return (r&3)+8*(r>>2)+4*hi;}
#define SBAR() __builtin_amdgcn_sched_barrier(0)
__device__ __forceinline__ void wmask(f32x16&p0,f32x16&p1,int kb,int qabs,int hi){
  const float NEG=-INFINITY; const int d0=kb+4*hi-qabs;
  #pragma unroll
  for(int r=0;r<16;++r){int dd=d0+(r&3)+8*(r>>2); if(dd>128||dd<-128)p0[r]=NEG; if(dd+32>128||dd+32<-128)p1[r]=NEG;}
}

constexpr int NSLOT=3, SLOTB=8192;
constexpr int LDS_K=0, LDS_V=NSLOT*SLOTB, LDS_WS=2*NSLOT*SLOTB, LDS_OST=LDS_WS+NW*64*4, LDS_BYTES=LDS_OST+NW*4096;
__device__ __forceinline__ void glds16(const void*gsrc,unsigned lds_dst){unsigned keep;
  asm volatile("s_mov_b32 %0, m0\n\ts_mov_b32 m0, %2\n\ts_nop 0\n\tglobal_load_lds_dwordx4 %1, off\n\ts_mov_b32 m0, %0":"=&s"(keep):"v"(gsrc),"s"(lds_dst):"memory");}
__device__ __forceinline__ float max3f(float a,float b,float c){float r;asm("v_max3_f32 %0, %1, %2, %3":"=v"(r):"v"(a),"v"(b),"v"(c));return r;}
__device__ __forceinline__ float max2f(float a,float b){float r;asm("v_max_f32_e32 %0, %1, %2":"=v"(r):"v"(a),"v"(b));return r;}
__device__ __forceinline__ float fadd_s(float a,float b){float r;asm("v_add_f32_e32 %0, %1, %2":"=v"(r):"v"(a),"v"(b));return r;}
__device__ __forceinline__ float fsub_s(float a,float b){float r;asm("v_sub_f32_e32 %0, %1, %2":"=v"(r):"v"(a),"v"(b));return r;}
typedef float f32x2_t __attribute__((ext_vector_type(2))); typedef __bf16 bf16x2_t __attribute__((ext_vector_type(2)));
__device__ __forceinline__ unsigned cvtpk_s(float lo,float hi){f32x2_t v={lo,hi};bf16x2_t b=__builtin_convertvector(v,bf16x2_t);return __builtin_bit_cast(unsigned,b);}
#define WAIT_BAR(N) asm volatile("s_waitcnt vmcnt(" #N ") lgkmcnt(0)\n\ts_barrier":::"memory")

__device__ __forceinline__ void qkt(f32x16&p0,f32x16&p1,const char*Kslot,const bf16x8*qr,const f32x16&negm,int r32,int hi){
  const char*kb=Kslot+hi*1024+r32*16;
  #pragma unroll
  for(int d0=0;d0<4;++d0){
    const bf16x8 b0=*reinterpret_cast<const bf16x8*>(kb+d0*2048);
    const bf16x8 b1=*reinterpret_cast<const bf16x8*>(kb+d0*2048+512);
    if(d0==0){p0=__builtin_amdgcn_mfma_f32_32x32x16_bf16(b0,qr[0],negm,0,0,0);p1=__builtin_amdgcn_mfma_f32_32x32x16_bf16(b1,qr[0],negm,0,0,0);}
    else{p0=__builtin_amdgcn_mfma_f32_32x32x16_bf16(b0,qr[d0],p0,0,0,0);p1=__builtin_amdgcn_mfma_f32_32x32x16_bf16(b1,qr[d0],p1,0,0,0);}}
}
typedef __attribute__((address_space(3))) const char* lds_cptr;
typedef short v4i16_t __attribute__((ext_vector_type(4)));
__device__ __forceinline__ void kload8(bf16x8*kf,lds_cptr kp){
  kf[0]=*(const __attribute__((address_space(3))) bf16x8*)(kp);      kf[1]=*(const __attribute__((address_space(3))) bf16x8*)(kp+512);
  kf[2]=*(const __attribute__((address_space(3))) bf16x8*)(kp+2048); kf[3]=*(const __attribute__((address_space(3))) bf16x8*)(kp+2560);
  kf[4]=*(const __attribute__((address_space(3))) bf16x8*)(kp+4096); kf[5]=*(const __attribute__((address_space(3))) bf16x8*)(kp+4608);
  kf[6]=*(const __attribute__((address_space(3))) bf16x8*)(kp+6144); kf[7]=*(const __attribute__((address_space(3))) bf16x8*)(kp+6656);
}
__device__ __forceinline__ void kload2(bf16x8*kf,lds_cptr kp,int j){ kf[2*j]=*(const __attribute__((address_space(3))) bf16x8*)(kp+j*2048); kf[2*j+1]=*(const __attribute__((address_space(3))) bf16x8*)(kp+j*2048+512); }
__device__ __forceinline__ s16x4 vtr(lds_cptr p){ return __builtin_bit_cast(s16x4,__builtin_amdgcn_ds_read_tr16_b64_v4i16((__attribute__((address_space(3))) v4i16_t*)p)); }
__device__ __forceinline__ float rowmax(const f32x16&p0,const f32x16&p1){
  float a=max3f(p0[0],p0[1],p1[0]),b=max3f(p0[2],p0[3],p1[1]);a=max3f(a,p1[2],p1[3]);
  #pragma unroll
  for(int r=4;r<16;r+=4){a=max3f(a,p0[r],p0[r+1]);b=max3f(b,p0[r+2],p0[r+3]);a=max3f(a,p1[r],p1[r+1]);b=max3f(b,p1[r+2],p1[r+3]);}
  const float m=max2f(a,b);
  auto rr=__builtin_amdgcn_permlane32_swap(__float_as_uint(m),__float_as_uint(m),false,false);
  return max2f(__uint_as_float(rr[0]),__uint_as_float(rr[1]));
}
__device__ __forceinline__ void pv(f32x16*o,int vb,bf16x8 pa0,bf16x8 pa1,bf16x8 pa2,bf16x8 pa3){
  #pragma unroll
  for(int d0=0;d0<2;++d0){s16x4 lo[4],hi[4];
    #pragma unroll
    for(int ks=0;ks<4;++ks){
      asm volatile("ds_read_b64_tr_b16 %0,%1 offset:%c2":"=&v"(lo[ks]):"v"(vb),"i"(d0*4096+ks*1024):"memory");
      asm volatile("ds_read_b64_tr_b16 %0,%1 offset:%c2":"=&v"(hi[ks]):"v"(vb),"i"(d0*4096+ks*1024+512):"memory");}
    asm volatile("s_waitcnt lgkmcnt(0)":::"memory");SBAR();
    #define PK(k) (bf16x8){lo[k][0],lo[k][1],lo[k][2],lo[k][3],hi[k][0],hi[k][1],hi[k][2],hi[k][3]}
    o[d0]=__builtin_amdgcn_mfma_f32_32x32x16_bf16(pa0,PK(0),o[d0],0,0,0);
    o[d0]=__builtin_amdgcn_mfma_f32_32x32x16_bf16(pa1,PK(1),o[d0],0,0,0);
    o[d0]=__builtin_amdgcn_mfma_f32_32x32x16_bf16(pa2,PK(2),o[d0],0,0,0);
    o[d0]=__builtin_amdgcn_mfma_f32_32x32x16_bf16(pa3,PK(3),o[d0],0,0,0);
    #undef PK
  }
}

#ifndef ATTN_STORE16
#define ATTN_STORE16(p,v) (*(u32x4*)(p)=(v))
#endif
template<int MODE,int THRL> __device__ __forceinline__ void attn_unit(const bf16*Qw,int qp,const bf16*Kc,const bf16*Kl,const bf16*Vc,const bf16*Vl,int kp,int NT,int qabs,int band0,float sinkl2,bf16*Ow,int op,char*shm){
  int tid=threadIdx.x; asm volatile("":"+v"(tid));
  const int lane=tid&63,r32=lane&31,hi=lane>>5; const int wid=__builtin_amdgcn_readfirstlane(tid>>6);
  qabs+=r32;
  const unsigned lds0=(unsigned)(uintptr_t)shm;
  float*wsf=(float*)(shm+LDS_WS)+wid*64;
  const unsigned koff_=(unsigned)(lane*kp+wid*8)*2u;
  const unsigned voff_=(unsigned)((16*(wid&3)+(lane>>2))*kp+(wid>>2)*32+(lane&3)*8)*2u;
  const unsigned kdst=lds0+LDS_K+wid*1024, vdst=lds0+LDS_V+wid*1024;
  #define DMA_K(t,slot) glds16((const char*)((t)<NCT?Kc+(long)(t)*KVBLK*kp:Kl+(long)((t)-NCT)*KVBLK*kp)+koff_,(unsigned)__builtin_amdgcn_readfirstlane(kdst+(slot)))
  #define DMA_V(t,slot) glds16((const char*)((t)<NCT?Vc+(long)(t)*KVBLK*kp:Vl+(long)((t)-NCT)*KVBLK*kp)+voff_,(unsigned)__builtin_amdgcn_readfirstlane(vdst+(slot)))
  const int vb0=(int)(lds0+LDS_V)+((lane>>4)&1)*32+(lane&3)*8+(4*hi+((lane&15)>>2))*64;
  const char*Kbase=shm+LDS_K; bf16x8 kf[8];
  const lds_cptr shm3=(lds_cptr)shm; const lds_cptr kp0=shm3+LDS_K+hi*1024+r32*16; const lds_cptr vp0=shm3+LDS_V+((lane>>4)&1)*32+(lane&3)*8+(4*hi+((lane&15)>>2))*64;
  DMA_K(0,0);DMA_V(0,0);DMA_K(1,SLOTB);
  bf16x8 qr[4];
  #pragma unroll
  for(int d0=0;d0<4;++d0)qr[d0]=*reinterpret_cast<const bf16x8*>(&Qw[(long)r32*qp+d0*16+hi*8]);
  float mhat=0.f,l_reg=0.f;f32x16 o[2];o[0]=f32x16{};o[1]=f32x16{};f32x16 negm=f32x16{};asm volatile("":"+v"(negm));
  #define CMASK(P0,P1,t) do{ if(MODE==1){ if((t)>=NCT)wmask(P0,P1,band0+KVBLK*((t)-NCT),qabs,hi);} }while(0)
  bool resc=false;
  #define START(P0,P1) do{ const float rm=rowmax(P0,P1); resc=false; \
    { const float dl=rm; mhat=fadd_s(mhat,dl); \
      _Pragma("unroll") for(int r=0;r<16;++r){P0[r]=fsub_s(P0[r],dl);P1[r]=fsub_s(P1[r],dl);} \
      _Pragma("unroll") for(int r=0;r<16;++r)negm[r]=-mhat; asm volatile("":"+v"(negm)); } \
    _Pragma("unroll") for(int r=0;r<16;++r)P0[r]=__builtin_amdgcn_exp2f(P0[r]); }while(0)
  #define RESC() do{ if(resc){ asm volatile("s_waitcnt lgkmcnt(0)":::"memory"); \
      _Pragma("unroll") for(int d_=0;d_<2;++d_) _Pragma("unroll") for(int r=0;r<16;++r)o[d_][r]*=wsf[crow(r,hi)]; } }while(0)
  f32x16 pA0,pA1,pB0,pB1;
  int sl_prev=0,sl_cur=0,sl_next=SLOTB;
  #define ROT() do{sl_prev=sl_cur;sl_cur=sl_next;sl_next=(sl_next==(NSLOT-1)*SLOTB)?0:sl_next+SLOTB;}while(0)
  DMA_K(2,2*SLOTB);
  WAIT_BAR(3);
  qkt(pA0,pA1,Kbase,qr,negm,r32,hi);asm volatile("s_nop 15\n\ts_nop 7":"+v"(pA0),"+v"(pA1));CMASK(pA0,pA1,0);
  START(pA0,pA1);
  _Pragma("unroll") for(int r=0;r<16;++r)pA1[r]=__builtin_amdgcn_exp2f(pA1[r]);
  WAIT_BAR(0);
  DMA_K(3,0);DMA_V(1,SLOTB);
  ROT();
  kload8(kf,kp0+sl_cur);
  WAIT_BAR(2);
  s16x4 vlo[8],vhi[8]; u32x4 pw0,pw1,pw2,pw3;
  #define PKW(P,B) cvtpk_s(P[B],P[B+1])
  #define PAF(k) __builtin_bit_cast(bf16x8,pw##k)
  #define VFR(i) (bf16x8){vlo[i][0],vlo[i][1],vlo[i][2],vlo[i][3],vhi[i][0],vhi[i][1],vhi[i][2],vhi[i][3]}
  #define PIN(x) asm volatile("":"+v"(x))
  #define MX3(a,b,c) __builtin_fmaxf(__builtin_fmaxf((a),(b)),(c))
  #define GAPA(MF,A0,A1,A2,A3,W0,W1,PW) do{ MF; sacc+=A0; sacc+=A1; sacc+=A2; sacc+=A3; PIN(sacc); W0; W1; PIN(PW); SBAR(); }while(0)
  #define EX(v) __builtin_amdgcn_exp2f(v)
  #define GAPB(MF,X,B) do{ MF; X[B]=EX(X[B]); X[B+1]=EX(X[B+1]); X[B+2]=EX(X[B+2]); X[B+3]=EX(X[B+3]); PIN(X); SBAR(); }while(0)
  #define VRD(i) do{ vlo[i]=vtr(vp_+(((i)>>2)*4096+((i)&3)*1024)); vhi[i]=vtr(vp_+(((i)>>2)*4096+((i)&3)*1024+512)); }while(0)
  #define KRD(G,j) do{ if(G){ kload2(kf,kp0+sl_next,j); SBAR(); } }while(0)
  #define STEP(C0,C1,P0,P1,t,GK,GV,GL) do{ SBAR(); \
    const lds_cptr vp_=vp0+sl_prev; \
    VRD(0); SBAR(); float sacc=(P0[0]+P0[1]); \
    GAPA(C0=__builtin_amdgcn_mfma_f32_32x32x16_bf16(kf[0],qr[0],negm,0,0,0), P0[2],P0[3],P0[4],P0[5],     pw0[0]=PKW(P0,0), pw0[1]=PKW(P0,2), pw0); \
    VRD(4); SBAR(); GAPA(C1=__builtin_amdgcn_mfma_f32_32x32x16_bf16(kf[1],qr[0],negm,0,0,0), P0[6],P0[7],P0[8],P0[9],     pw0[2]=PKW(P0,4), pw0[3]=PKW(P0,6), pw0); \
    VRD(1); SBAR(); GAPA(C0=__builtin_amdgcn_mfma_f32_32x32x16_bf16(kf[2],qr[1],C0,0,0,0),   P0[10],P0[11],P0[12],P0[13], pw1[0]=PKW(P0,8), pw1[1]=PKW(P0,10), pw1); \
    VRD(5); SBAR(); GAPA(C1=__builtin_amdgcn_mfma_f32_32x32x16_bf16(kf[3],qr[1],C1,0,0,0),   P0[14],P0[15],P1[0],P1[1],   pw1[2]=PKW(P0,12),pw1[3]=PKW(P0,14), pw1); \
    VRD(2); SBAR(); GAPA(C0=__builtin_amdgcn_mfma_f32_32x32x16_bf16(kf[4],qr[2],C0,0,0,0),   P1[2],P1[3],P1[4],P1[5],     pw2[0]=PKW(P1,0), pw2[1]=PKW(P1,2), pw2); \
    VRD(6); SBAR(); GAPA(C1=__builtin_amdgcn_mfma_f32_32x32x16_bf16(kf[5],qr[2],C1,0,0,0),   P1[6],P1[7],P1[8],P1[9],     pw2[2]=PKW(P1,4), pw2[3]=PKW(P1,6), pw2); \
    VRD(3); SBAR(); GAPA(C0=__builtin_amdgcn_mfma_f32_32x32x16_bf16(kf[6],qr[3],C0,0,0,0),   P1[10],P1[11],P1[12],P1[13], pw3[0]=PKW(P1,8), pw3[1]=PKW(P1,10), pw3); \
    VRD(7); SBAR(); GAPA(C1=__builtin_amdgcn_mfma_f32_32x32x16_bf16(kf[7],qr[3],C1,0,0,0),   P1[14],P1[15],0.f,0.f,       pw3[2]=PKW(P1,12),pw3[3]=PKW(P1,14), pw3); \
    l_reg+=sacc; \
    if(GK){DMA_K((t)+3,sl_cur);} if(GV){DMA_V((t)+1,sl_next);} \
    CMASK(C0,C1,t); \
    { float a=MX3(C0[0],C0[1],C1[0]),b=MX3(C0[2],C0[3],C1[1]); a=MX3(a,C1[2],C1[3]); \
      _Pragma("unroll") for(int r=4;r<16;r+=4){a=MX3(a,C0[r],C0[r+1]);b=MX3(b,C0[r+2],C0[r+3]);a=MX3(a,C1[r],C1[r+1]);b=MX3(b,C1[r+2],C1[r+3]);} \
      float rm=__builtin_fmaxf(a,b); { auto rr=__builtin_amdgcn_permlane32_swap(__float_as_uint(rm),__float_as_uint(rm),false,false); rm=__builtin_fmaxf(__uint_as_float(rr[0]),__uint_as_float(rr[1])); } \
      resc=false; \
      if(__builtin_expect(__any(rm>(float)THRL),0)){ const float dl=__builtin_fmaxf(rm,0.f); mhat+=dl; \
        _Pragma("unroll") for(int r=0;r<16;++r){C0[r]-=dl;C1[r]-=dl;} \
        _Pragma("unroll") for(int r=0;r<16;++r)negm[r]=-mhat; asm volatile("":"+v"(negm)); \
        const float f=__builtin_amdgcn_exp2f(-dl); l_reg*=f; if(hi==0)wsf[r32]=f; resc=true; } } \
    SBAR(); \
    GAPB(o[0]=__builtin_amdgcn_mfma_f32_32x32x16_bf16(PAF(0),VFR(0),o[0],0,0,0), C0,0); \
    GAPB(o[1]=__builtin_amdgcn_mfma_f32_32x32x16_bf16(PAF(0),VFR(4),o[1],0,0,0), C0,4); \
    KRD(GL,0); GAPB(o[0]=__builtin_amdgcn_mfma_f32_32x32x16_bf16(PAF(1),VFR(1),o[0],0,0,0), C0,8); \
    KRD(GL,1); GAPB(o[1]=__builtin_amdgcn_mfma_f32_32x32x16_bf16(PAF(1),VFR(5),o[1],0,0,0), C0,12); \
    KRD(GL,2); GAPB(o[0]=__builtin_amdgcn_mfma_f32_32x32x16_bf16(PAF(2),VFR(2),o[0],0,0,0), C1,0); \
    KRD(GL,3); GAPB(o[1]=__builtin_amdgcn_mfma_f32_32x32x16_bf16(PAF(2),VFR(6),o[1],0,0,0), C1,4); \
    GAPB(o[0]=__builtin_amdgcn_mfma_f32_32x32x16_bf16(PAF(3),VFR(3),o[0],0,0,0), C1,8); \
    GAPB(o[1]=__builtin_amdgcn_mfma_f32_32x32x16_bf16(PAF(3),VFR(7),o[1],0,0,0), C1,12); \
    }while(0)
  int t=1;
  for(;t+5<NT;t+=2){
    STEP(pB0,pB1,pA0,pA1,t,true,true,true);     WAIT_BAR(2); RESC(); ROT();
    STEP(pA0,pA1,pB0,pB1,t+1,true,true,true);   WAIT_BAR(2); RESC(); ROT();
  }
  #define ENDW(tt) do{ if((tt)+3<NT){WAIT_BAR(2);} else if((tt)+2<NT){WAIT_BAR(1);} else {WAIT_BAR(0);} }while(0)
  for(;t+1<NT;t+=2){
    STEP(pB0,pB1,pA0,pA1,t,(t+3<NT),(t+1<NT),(t+1<NT));       ENDW(t);   RESC(); ROT();
    STEP(pA0,pA1,pB0,pB1,t+1,(t+4<NT),(t+2<NT),(t+2<NT));     ENDW(t+1); RESC(); ROT();
  }
  STEP(pB0,pB1,pA0,pA1,NT-1,false,false,false); RESC();
  { float sacc=pB0[0]+pB0[1]; _Pragma("unroll") for(int r=2;r<16;++r)sacc+=pB0[r]; _Pragma("unroll") for(int r=0;r<16;++r)sacc+=pB1[r]; l_reg+=sacc;
    pw0=(u32x4){PKW(pB0,0),PKW(pB0,2),PKW(pB0,4),PKW(pB0,6)};pw1=(u32x4){PKW(pB0,8),PKW(pB0,10),PKW(pB0,12),PKW(pB0,14)};pw2=(u32x4){PKW(pB1,0),PKW(pB1,2),PKW(pB1,4),PKW(pB1,6)};pw3=(u32x4){PKW(pB1,8),PKW(pB1,10),PKW(pB1,12),PKW(pB1,14)};
    SBAR(); pv(o,vb0+sl_cur,PAF(0),PAF(1),PAF(2),PAF(3)); }
  #undef PKW
  #undef PAF
  #undef VFR
  #undef PIN
  #undef MX3
  #undef GAPA
  #undef GAPB
  #undef EX
  #undef VRD
  #undef KRD
  #undef STEP
  #undef ENDW
  {auto rr=__builtin_amdgcn_permlane32_swap(__float_as_uint(l_reg),__float_as_uint(l_reg),false,false);l_reg=__uint_as_float(rr[0])+__uint_as_float(rr[1]);}
  if(MODE==1)l_reg+=__builtin_amdgcn_exp2f(sinkl2-mhat);
  if(hi==0)wsf[32+r32]=l_reg;asm volatile("s_waitcnt lgkmcnt(0)":::"memory");
  float rli[16];
  #pragma unroll
  for(int r=0;r<16;++r)rli[r]=__builtin_amdgcn_rcpf(wsf[32+crow(r,hi)]);
  { bf16*stg=(bf16*)(shm+LDS_OST)+wid*2048;
    #pragma unroll
    for(int r=0;r<16;++r){const int orow=crow(r,hi);
      #pragma unroll
      for(int d0=0;d0<2;++d0)stg[orow*64+d0*32+r32]=__float2bfloat16(o[d0][r]*rli[r]);}
    asm volatile("s_waitcnt lgkmcnt(0)":::"memory");
    #pragma unroll
    for(int i=0;i<4;++i){const int row=i*8+(lane>>3),ch=lane&7; const u32x4 v=*(const u32x4*)(stg+row*64+ch*8); ATTN_STORE16(Ow+(long)row*op+ch*8,v);} }
  asm volatile("s_waitcnt lgkmcnt(0)\n\ts_barrier":::"memory");
  #undef DMA_K
  #undef DMA_V
  #undef CMASK
  #undef START
  #undef RESC
  #undef ROT
}
constexpr int ATTN_LDS_BYTES=LDS_BYTES;
#undef SBAR
#undef WAIT_BAR
}
constexpr int NWAVES = 8;
constexpr size_t MiB = 1u << 20;
constexpr size_t WS_CTL = 0, CTL_ZERO_BYTES = 256 * 1024;
constexpr size_t WS_MOD = 1 * MiB;
constexpr size_t WS_ROPE = WS_MOD + 512 * 1024;
constexpr size_t WS_AFS = WS_ROPE + 64 * 1024;
constexpr size_t WS_IDX = WS_AFS + 192 * 1024;
constexpr size_t WS_SEL = 2 * MiB;
constexpr size_t WS_AFF = 4 * MiB;
constexpr size_t WS_ABTC = WS_AFF;
constexpr size_t WS_WIN = 6 * MiB;
constexpr size_t WS_WBR = 25 * MiB;
constexpr size_t WS_WOUT = 29 * MiB;
constexpr size_t WS_DFT = 33 * MiB;
constexpr size_t WS_DFTC = 49 * MiB;
constexpr size_t WS_WGU = 50 * MiB;
constexpr size_t WS_WD = 178 * MiB;
constexpr size_t WS_X = 242 * MiB;
constexpr size_t WS_HN = 314 * MiB;
constexpr size_t WS_MB = WS_HN;
constexpr size_t WS_QKV = 350 * MiB;
constexpr size_t WS_G = 395 * MiB;
constexpr size_t WS_BR = 503 * MiB;
constexpr size_t WS_HACT = 467 * MiB;
constexpr size_t WS_ABT = 539 * MiB;
constexpr size_t WS_END = 555 * MiB;
constexpr size_t QKV_QG = 0, QKV_KG = (size_t)NTOK * 512 * 2, QKV_VG = QKV_KG + (size_t)NTOK * 128 * 2, QKV_QW = QKV_VG + (size_t)NTOK * 128 * 2,
                 QKV_KW = QKV_QW + (size_t)NTOK * 256 * 2, QKV_VW = QKV_KW + (size_t)NTOK * 128 * 2;
static_assert(WS_WIN + (size_t)DEPTH * INW2 * DM * 2 <= WS_WBR && WS_QKV + QKV_VW + (size_t)NTOK * 128 * 2 <= WS_G && WS_G + (size_t)NTOK * 3 * DM * 2 <= WS_BR && WS_HACT >= WS_G + (size_t)NE * RPE * DM * 2 &&
              WS_HACT + (size_t)NE * RPE * DM * 2 <= WS_ABT && WS_ABT + (size_t)NBATCH * 256 * 2 * SEQ * 2 <= WS_END && (size_t)NBATCH * 256 * 2 * CTX * 2 <= 2 * MiB, "d_ws map");
constexpr int CW_BAR = 1024;
constexpr int CW_QUEUE = 8192;
constexpr int CW_CONVQ = 8192 + 64 * 8;
constexpr int CW_FIN = CW_CONVQ + 64;
constexpr int RING_BYTES = 131072;
constexpr int LDSCTL_OFF = RING_BYTES, MISC_OFF = LDSCTL_OFF + 320;
constexpr int IDXBUF_OFF = LDSCTL_OFF + 1024 + 8192;
constexpr int LDS_BYTES = 147456;

#define GAS __attribute__((address_space(1)))
#define LAS __attribute__((address_space(3)))
typedef unsigned short bf16;
typedef unsigned v4u __attribute__((ext_vector_type(4)));
typedef unsigned v2u __attribute__((ext_vector_type(2)));
typedef float f32x4 __attribute__((ext_vector_type(4)));
typedef GAS unsigned gu32;
#define RLX_AGENT __ATOMIC_RELAXED, __HIP_MEMORY_SCOPE_AGENT
#define LDS_WAIT() asm volatile("s_waitcnt lgkmcnt(0)" ::: "memory")
#define VM_WAIT() asm volatile("s_waitcnt vmcnt(0)" ::: "memory")
__device__ __forceinline__ unsigned f2bf(float f) { unsigned u = __builtin_bit_cast(unsigned, f); return (u + 0x7fffu + ((u >> 16) & 1u)) >> 16; }
__device__ __forceinline__ unsigned pk2(float lo, float hi) { return f2bf(lo) | (f2bf(hi) << 16); }
__device__ __forceinline__ float bf2f(unsigned short h) { return __builtin_bit_cast(float, (unsigned)h << 16); }
__device__ __forceinline__ float bflo(unsigned w) { return __builtin_bit_cast(float, w << 16); }
__device__ __forceinline__ float bfhi(unsigned w) { return __builtin_bit_cast(float, w & 0xffff0000u); }

#define XB_TMO      128
#define XB_XCNT(j)  (256  + 64 * (j))
#define XB_XSUB(j)  (1280 + 64 * (j))
#define XB_XGEN(j)  (2304 + 64 * (j))
#define XB_TOP      3328
#define XB_TOPGEN   3392
#define XCD_BAR_WORDS 3456
#define XB_SPIN_CAP (1u << 20)
__device__ __forceinline__ unsigned xb_ld(unsigned* p)              { return __hip_atomic_load(p, __ATOMIC_RELAXED, __HIP_MEMORY_SCOPE_AGENT); }
__device__ __forceinline__ unsigned xb_add(unsigned* p, unsigned v) { return __hip_atomic_fetch_add(p, v, __ATOMIC_RELAXED, __HIP_MEMORY_SCOPE_AGENT); }
__device__ __forceinline__ unsigned xb_xcc_id() { return (unsigned)__builtin_amdgcn_s_getreg((3 << 11) | 20) & 0xFu; }
#define XB_SPIN(cond, bar) do { unsigned _sp = 0; while (cond) { __builtin_amdgcn_s_sleep(1); \
    if ((++_sp & 255u) == 0u) { if (xb_ld(&(bar)[XB_TMO])) break; if (_sp > XB_SPIN_CAP) { atomicAdd(&(bar)[XB_TMO], 1u); break; } } } } while (0)
struct XcdBarrier { unsigned* bar; unsigned x; volatile LAS unsigned* st; };
__device__ __forceinline__ XcdBarrier xcd_barrier_post(unsigned* bar, volatile LAS unsigned* st) {
    XcdBarrier b; b.bar = bar; b.x = xb_xcc_id(); b.st = st;
    if (threadIdx.x == 0) (void)xb_add(&bar[XB_XCNT(b.x)], 1u);
    return b;
}
__device__ __forceinline__ void xcd_barrier_complete(unsigned* bar, unsigned x, unsigned& nloc, unsigned& nx) {
    const unsigned G = gridDim.x * gridDim.y * gridDim.z;
    unsigned sum, cnt, mine, sp = 0u;
    for (;;) {
        sum = 0u; cnt = 0u; mine = 0u;
#pragma unroll
        for (unsigned j = 0; j < 16; ++j) { const unsigned c = xb_ld(&bar[XB_XCNT(j)]); sum += c; cnt += (c > 0u) ? 1u : 0u; mine = (j == x) ? c : mine; }
        if (sum == G) break;
        __builtin_amdgcn_s_sleep(1);
        if ((++sp & 255u) == 0u) { if (xb_ld(&bar[XB_TMO])) break; if (sp > XB_SPIN_CAP) { atomicAdd(&bar[XB_TMO], 1u); break; } }
    }
    nloc = mine > 0u ? mine : 1u; nx = cnt > 0u ? cnt : 1u;
}
__device__ __forceinline__ void xcd_barrier(const XcdBarrier& b) {
    asm volatile("s_waitcnt vmcnt(0)" ::: "memory");
    __syncthreads();
    if (threadIdx.x == 0) {
        unsigned* bar = b.bar;
        __builtin_amdgcn_s_waitcnt(0);
        unsigned nloc = b.st[0], nx = b.st[1];
        if (nloc == 0u) { xcd_barrier_complete(bar, b.x, nloc, nx); b.st[0] = nloc; b.st[1] = nx; }
        const unsigned old = xb_add(&bar[XB_XSUB(b.x)], 1u);
        const unsigned gen = old / nloc;
        if (old + 1u == (gen + 1u) * nloc) {
            __builtin_amdgcn_fence(__ATOMIC_RELEASE, "agent");
            asm volatile("s_waitcnt vmcnt(0)" ::: "memory");
            const unsigned og = xb_add(&bar[XB_TOP], 1u);
            const unsigned tg = og / nx;
            if (og + 1u == (tg + 1u) * nx) xb_add(&bar[XB_TOPGEN], 1u);
            else XB_SPIN(xb_ld(&bar[XB_TOPGEN]) == tg, bar);
            __builtin_amdgcn_fence(__ATOMIC_ACQUIRE, "agent");
            xb_add(&bar[XB_XGEN(b.x)], 1u);
            asm volatile("s_waitcnt vmcnt(0)" ::: "memory");
        } else {
            XB_SPIN(xb_ld(&bar[XB_XGEN(b.x)]) == gen, bar);
            __builtin_amdgcn_fence(__ATOMIC_ACQUIRE, "agent");
            asm volatile("s_waitcnt vmcnt(0)" ::: "memory");
        }
    }
    __syncthreads();
}
template <int CTRL> __device__ __forceinline__ float dpp_mov(float v) { return __builtin_bit_cast(float, __builtin_amdgcn_update_dpp(0, __builtin_bit_cast(int, v), CTRL, 0xF, 0xF, true)); }
__device__ __forceinline__ float lx1(float v) { return dpp_mov<0xB1>(v); }
__device__ __forceinline__ float lx2(float v) { return dpp_mov<0x4E>(v); }
__device__ __forceinline__ float lx4(float v) { return dpp_mov<0x1B>(dpp_mov<0x141>(v)); }
__device__ __forceinline__ float lx8(float v) { return dpp_mov<0x141>(dpp_mov<0x140>(v)); }
__device__ __forceinline__ float lx16(float v) { return __shfl_xor(v, 16); }
__device__ __forceinline__ float lx32(float v) { const unsigned u = __builtin_bit_cast(unsigned, v); auto r = __builtin_amdgcn_permlane32_swap(u, u, false, false);
    return __builtin_bit_cast(float, (threadIdx.x & 32) ? r[0] : r[1]); }
__device__ __forceinline__ float wave_sum(float v) {
    v += lx1(v); v += lx2(v); v += lx4(v); v += lx8(v); v += lx16(v); v += lx32(v);
    return v;
}
using pg8::Unit;
typedef pg8::f32x4 (&AccRef)[2][2][4][2];

__device__ __forceinline__ v2u pack4(f32x4 v) { v2u w; w.x = pg8::cvt_pk_bf16(v[0], v[1]); w.y = pg8::cvt_pk_bf16(v[2], v[3]); return w; }
__device__ __forceinline__ float rsig_(float t) { return 1.f + __builtin_amdgcn_exp2f(t); }
__device__ __forceinline__ float sigmoidf_(float v) { return __builtin_amdgcn_rcpf(1.f + __builtin_amdgcn_exp2f(-LOG2E * v)); }

template <class Dec> struct Strided {
    Dec d; int n, G, vcu;
    __device__ __forceinline__ bool next(int i, Unit& u) const { const int L = i * G + vcu; if (L >= n) return false; d(L, u); return true; }
};

struct DecInProj { const char* A; const char* B; int layer;
    __device__ __forceinline__ void operator()(int L, Unit& u) const {
        int pm, pn;
        if (L < 1024) { const int cg = L >> 8, rg = (L & 255) >> 5, w = L & 31; pm = rg * 8 + (w & 7); pn = cg * 4 + (w >> 3); }
        else if (L < 1216) { const int q = L - 1024, rg = q / 24, w = q % 24; pm = rg * 8 + (w & 7); pn = 16 + (w >> 3); }
        else { const int q = L - 1216; pm = 64 + (q & 7); pn = q >> 3; if (layer == DEPTH - 1) pn = pn ? 6 : 4; }
        u.A = A + (size_t)pm * 256 * (DM * 2); u.B = B + (size_t)pn * 256 * (DM * 2); u.arows = nullptr; u.ldA = DM * 2; u.ldB = DM * 2; u.nt = DM / 64; u.pm = pm; u.pn = pn; u.tag = 0;
    } };
constexpr int inproj_units(int layer) { return 1216 + (layer == DEPTH - 1 ? 16 : 152); }

struct EpiInProj {
    static constexpr bool PERM = true;
    bf16 *ABt, *ABtc, *Qg, *Kg, *Vg, *Qw, *Kw, *Vw, *G; const float* rope; const float* qng; const float* kng;
    __device__ __forceinline__ bool operator()(AccRef acc, const Unit& u, int wr, int wc, int fr, int fq) const {
        const int pm = u.pm, pn = u.pn; const bool lat = pm < 64;
        const int rowt = wr * 64 + fr;
        if (pn < 2) {
            bf16* dst; int ld;
            if (lat) { dst = ABt + ((size_t)(pm >> 3) * 256) * (2 * SEQ) + pn * SEQ + (pm & 7) * 256; ld = 2 * SEQ; }
            else { dst = ABtc + ((size_t)(pm - 64) * 256) * (2 * CTX) + pn * CTX; ld = 2 * CTX; }
#pragma unroll
            for (int ai = 0; ai < 2; ++ai)
#pragma unroll
                for (int m = 0; m < 4; ++m) { const int tok = rowt + ai * 128 + m * 16;
#pragma unroll
                    for (int bj = 0; bj < 2; ++bj)
#pragma unroll
                        for (int n = 0; n < 2; ++n) { const int c = bj * 128 + wc * 32 + fq * 8 + n * 4; const pg8::f32x4 v = acc[ai][bj][m][n];
#pragma unroll
                            for (int j = 0; j < 4; ++j) dst[(size_t)(c + j) * ld + tok] = (bf16)f2bf(v[j]); } }
        } else if (pn < 7) {
            bf16* dst; int ld; const float* ng = nullptr; bool rope_on = false; float sc = 1.f;
            if (pn <= 3)      { dst = Qg + (pn - 2) * 256 + wc * 64; ld = 512; ng = qng; rope_on = lat; sc = QSCALE; }
            else if (pn == 4) { if (wc < 2) { dst = Kg + wc * 64; ng = kng; rope_on = lat; } else { dst = Vg + (wc - 2) * 64; } ld = 128; }
            else if (pn == 5) { dst = Qw + wc * 64; ld = 256; rope_on = lat; sc = QSCALE; }
            else              { if (wc < 2) { dst = Kw + wc * 64; rope_on = lat; } else { dst = Vw + (wc - 2) * 64; } ld = 128; }
#pragma unroll
            for (int ai = 0; ai < 2; ++ai)
#pragma unroll
                for (int m = 0; m < 4; ++m) {
                    const int row = pm * 256 + rowt + ai * 128 + m * 16;
                    pg8::f32x4 v[2][2];
                    float ss = 0.f;
#pragma unroll
                    for (int bj = 0; bj < 2; ++bj)
#pragma unroll
                        for (int n = 0; n < 2; ++n) { v[bj][n] = acc[ai][bj][m][n]; ss += (v[bj][n][0] * v[bj][n][0] + v[bj][n][1] * v[bj][n][1]) + (v[bj][n][2] * v[bj][n][2] + v[bj][n][3] * v[bj][n][3]); }
                    float r = sc;
                    if (ng) { ss += __shfl_xor(ss, 16); ss += __shfl_xor(ss, 32); r = sc * rsqrtf(ss * (1.f / 64.f) + EPS); }
                    const int t = row & (SEQ - 1);
#pragma unroll
                    for (int bj = 0; bj < 2; ++bj) { v2u o[2];
#pragma unroll
                        for (int n = 0; n < 2; ++n) {
                            pg8::f32x4 x = v[bj][n] * r; if (ng) x = x * *(const pg8::f32x4*)(ng + bj * 32 + fq * 8 + n * 4);
                            if (rope_on) {
                                const int pos = bj ? (t & 63) : (t >> 6);
                                const pg8::f32x4 cs = *(const pg8::f32x4*)(rope + ((size_t)pos * 16 + fq * 4 + n * 2) * 2);
                                x = (pg8::f32x4){x[0] * cs[0] - x[1] * cs[1], x[0] * cs[1] + x[1] * cs[0], x[2] * cs[2] - x[3] * cs[3], x[2] * cs[3] + x[3] * cs[2]};
                            }
                            o[n] = pack4(x);
                        }
                        *(v4u*)(dst + (size_t)row * ld + bj * 32 + fq * 8) = (v4u){o[0].x, o[0].y, o[1].x, o[1].y}; }
                    asm volatile("" ::: "memory");
                }
        } else {
            bf16* dst = G + ((size_t)pm * 12 + (pn - 7)) * 65536 + (size_t)(((wr * 4 + wc) * 64 + fq * 16 + fr) * 8);
#pragma unroll
            for (int ai = 0; ai < 2; ++ai)
#pragma unroll
                for (int bj = 0; bj < 2; ++bj)
#pragma unroll
                    for (int m = 0; m < 4; ++m) { const pg8::f32x4 a = acc[ai][bj][m][0], b = acc[ai][bj][m][1];
                        const v2u lo = pack4((pg8::f32x4){rsig_(a[0]), rsig_(a[1]), rsig_(a[2]), rsig_(a[3])}), hi = pack4((pg8::f32x4){rsig_(b[0]), rsig_(b[1]), rsig_(b[2]), rsig_(b[3])});
                        *(v4u*)(dst + (size_t)(((ai * 2 + bj) * 4 + m) * 4096)) = (v4u){lo.x, lo.y, hi.x, hi.y}; }
        }
        return false;
    }
};

struct EpiStore { static constexpr bool PERM = true; bf16* O; int ld;
    __device__ __forceinline__ bool operator()(AccRef acc, const Unit& u, int wr, int wc, int fr, int fq) const {
        bf16* dst = O + ((size_t)u.pm * 256 + wr * 64 + fr) * ld + u.pn * 256 + wc * 32 + fq * 8;
#pragma unroll
        for (int ai = 0; ai < 2; ++ai)
#pragma unroll
            for (int m = 0; m < 4; ++m)
#pragma unroll
                for (int bj = 0; bj < 2; ++bj) { const v2u o0 = pack4(acc[ai][bj][m][0]), o1 = pack4(acc[ai][bj][m][1]);
                    *(v4u*)(dst + (size_t)(ai * 128 + m * 16) * ld + bj * 128) = (v4u){o0.x, o0.y, o1.x, o1.y}; }
        return false;
    } };
struct DecDft { const char* Dm; const char* Dc; const char* ABt; const char* ABtc;
    __device__ __forceinline__ void operator()(int L, Unit& u) const {
        if (L < 64) { const int b = L >> 3, mt = L & 7; u.A = Dm + (size_t)mt * 256 * (4 * SEQ); u.B = ABt + (size_t)b * 256 * (4 * SEQ); u.ldA = 4 * SEQ; u.ldB = 4 * SEQ; u.nt = 2 * SEQ / 64; u.pm = L; }
        else { const int b = L - 64; u.A = Dc; u.B = ABtc + (size_t)b * 256 * (4 * CTX); u.ldA = 4 * CTX; u.ldB = 4 * CTX; u.nt = 2 * CTX / 64; u.pm = 64 + b; }
        u.pn = 0; u.tag = 0; u.arows = nullptr;
    } };

struct SchedMerge { const char* BR; const char* W; int ntiles, G, vcu;
    __device__ __forceinline__ bool next(int i, Unit& u) const {
        const int round = i / 3, tag = i - round * 3, tile = round * G + vcu; if (tile >= ntiles) return false;
        const int pm = tile >> 2, pn = tile & 3, koff = tag == 0 ? 0 : (tag == 1 ? 256 : 768);
        u.A = BR + (size_t)pm * 256 * (DM * 2) + koff * 2; u.B = W + (size_t)pn * 256 * (DM * 2) + koff * 2; u.arows = nullptr; u.ldA = DM * 2; u.ldB = DM * 2; u.nt = tag == 1 ? 8 : 4; u.pm = pm; u.pn = pn; u.tag = tag;
        return true;
    } };
struct EpiMerge { static constexpr bool PERM = true; const bf16* G; bf16* Mb; int probe;
    __device__ __forceinline__ bool operator()(AccRef acc, const Unit& u, int wr, int wc, int fr, int fq) const {
        const size_t row0 = (size_t)u.pm * 256 + wr * 64 + fr; const int col0 = u.pn * 256 + wc * 32 + fq * 8; const int tag = u.tag;
        const GAS char* gt = (const GAS char*)(G + ((size_t)u.pm * 12 + tag * 4 + u.pn) * 65536);
        const unsigned lo = (unsigned)(((wr * 4 + wc) * 64 + fq * 16 + fr) * 16);
        if (tag < 2) {
#pragma unroll
            for (int q = 0; q < 4; ++q) { const int ai = q >> 1, bj = q & 1;
                v4u gwv[4], hwv[4];
#pragma unroll
                for (int m = 0; m < 4; ++m) { const GAS char* gp = gt + (size_t)((q * 4 + m) * 8192); asm volatile("" : "+s"(gp)); gwv[m] = *(const GAS v4u*)(gp + lo); }
#pragma unroll
                for (int m = 0; m < 4; ++m) { const GAS char* gp = gt + (size_t)(4 * 131072 + (q * 4 + m) * 8192); asm volatile("" : "+s"(gp)); hwv[m] = *(const GAS v4u*)(gp + lo); }
#pragma unroll
                for (int m = 0; m < 4; ++m) { const v4u gw = gwv[m], hw = hwv[m];
                    const pg8::f32x4 ga = {__builtin_amdgcn_rcpf(bflo(gw.x)) * bflo(hw.x), __builtin_amdgcn_rcpf(bfhi(gw.x)) * bfhi(hw.x), __builtin_amdgcn_rcpf(bflo(gw.y)) * bflo(hw.y), __builtin_amdgcn_rcpf(bfhi(gw.y)) * bfhi(hw.y)};
                    const pg8::f32x4 gb = {__builtin_amdgcn_rcpf(bflo(gw.z)) * bflo(hw.z), __builtin_amdgcn_rcpf(bfhi(gw.z)) * bfhi(hw.z), __builtin_amdgcn_rcpf(bflo(gw.w)) * bflo(hw.w), __builtin_amdgcn_rcpf(bfhi(gw.w)) * bfhi(hw.w)};
                    acc[ai][bj][m][0] = acc[ai][bj][m][0] * ga; acc[ai][bj][m][1] = acc[ai][bj][m][1] * gb; }
                asm volatile("" ::: "memory");
            }
        } else {
#pragma unroll
            for (int ai = 0; ai < 2; ++ai) {
                v4u gwv[8];
#pragma unroll
                for (int i = 0; i < 8; ++i) { const GAS char* gp = gt + (size_t)((ai * 8 + i) * 8192); asm volatile("" : "+s"(gp)); gwv[i] = *(const GAS v4u*)(gp + lo); }
#pragma unroll
                for (int i = 0; i < 8; ++i) { const int bj = i >> 2, m = i & 3; const v4u gw = gwv[i];
                    const pg8::f32x4 ga = {__builtin_amdgcn_rcpf(bflo(gw.x)), __builtin_amdgcn_rcpf(bfhi(gw.x)), __builtin_amdgcn_rcpf(bflo(gw.y)), __builtin_amdgcn_rcpf(bfhi(gw.y))};
                    const pg8::f32x4 gb = {__builtin_amdgcn_rcpf(bflo(gw.z)), __builtin_amdgcn_rcpf(bfhi(gw.z)), __builtin_amdgcn_rcpf(bflo(gw.w)), __builtin_amdgcn_rcpf(bfhi(gw.w))};
                    const size_t row = row0 + ai * 128 + m * 16; const int c = col0 + bj * 128;
                    const v2u o0 = pack4(acc[ai][bj][m][0] * ga), o1 = pack4(acc[ai][bj][m][1] * gb); *(v4u*)(Mb + row * DM + c) = (v4u){o0.x, o0.y, o1.x, o1.y}; }
                asm volatile("" ::: "memory");
            }
        }
        return tag < 2;
    } };

struct DecWout { const char* Mb; const char* W;
    __device__ __forceinline__ void operator()(int L, Unit& u) const { const int pm = L >> 2, pn = L & 3;
        u.A = Mb + (size_t)pm * 256 * (DM * 2); u.B = W + (size_t)pn * 256 * (DM * 2); u.arows = nullptr; u.ldA = DM * 2; u.ldB = DM * 2; u.nt = DM / 64; u.pm = pm; u.pn = pn; u.tag = 0; } };
struct EpiWout { static constexpr bool PERM = true; const float* baseL; const float* baseC; const bf16* baseX; bf16* X; const float* mod; int from_x;
    __device__ __forceinline__ bool operator()(AccRef acc, const Unit& u, int wr, int wc, int fr, int fq) const {
        const int pm = u.pm; const float* base = pm < 64 ? baseL : baseC; const float* g1 = mod + (size_t)(pm < 64 ? (pm >> 3) : 8) * (6 * DM) + 2 * DM;
        const size_t row0 = (size_t)pm * 256 + wr * 64 + fr; const int col0 = u.pn * 256 + wc * 32 + fq * 8;
#pragma unroll
        for (int bj = 0; bj < 2; ++bj) { const int c = col0 + bj * 128; const pg8::f32x4 gv0 = *(const pg8::f32x4*)(g1 + c), gv1 = *(const pg8::f32x4*)(g1 + c + 4);
            if (from_x) {
                v4u w[8];
#pragma unroll
                for (int i = 0; i < 8; ++i) w[i] = *(const v4u*)(baseX + (row0 + (i >> 2) * 128 + (i & 3) * 16) * DM + c);
#pragma unroll
                for (int i = 0; i < 8; ++i) { const int ai = i >> 2, m = i & 3; const size_t off = (row0 + ai * 128 + m * 16) * DM + c;
                    const pg8::f32x4 b0 = {bflo(w[i].x), bfhi(w[i].x), bflo(w[i].y), bfhi(w[i].y)}, b1 = {bflo(w[i].z), bfhi(w[i].z), bflo(w[i].w), bfhi(w[i].w)};
                    const v2u o0 = pack4(b0 + gv0 * acc[ai][bj][m][0]), o1 = pack4(b1 + gv1 * acc[ai][bj][m][1]);
                    *(v4u*)(X + off) = (v4u){o0.x, o0.y, o1.x, o1.y}; }
            } else {
#pragma unroll
                for (int ai = 0; ai < 2; ++ai) {
                    pg8::f32x4 b0[4], b1[4];
#pragma unroll
                    for (int m = 0; m < 4; ++m) { const size_t off = (row0 + ai * 128 + m * 16) * DM + c; b0[m] = *(const pg8::f32x4*)(base + off); b1[m] = *(const pg8::f32x4*)(base + off + 4); }
#pragma unroll
                    for (int m = 0; m < 4; ++m) { const size_t off = (row0 + ai * 128 + m * 16) * DM + c;
                        const v2u o0 = pack4(b0[m] + gv0 * acc[ai][bj][m][0]), o1 = pack4(b1[m] + gv1 * acc[ai][bj][m][1]);
                        *(v4u*)(X + off) = (v4u){o0.x, o0.y, o1.x, o1.y}; }
                    asm volatile("" ::: "memory");
                }
            }
            asm volatile("" ::: "memory");
        }
        return false;
    } };

struct DecGU { const char* H2; const int* IDX; const char* W; int nrt;
    __device__ __forceinline__ void operator()(int L, Unit& u) const { const int per = nrt * 8, e = L / per, q = L - e * per, ct = q & 7, rt = q >> 3;
        u.A = H2; u.arows = IDX + (size_t)e * RPE + rt * 256; u.B = W + ((size_t)e * 2 * DM + ct * 256) * (DM * 2); u.ldA = DM * 2; u.ldB = DM * 2; u.nt = DM / 64; u.pm = rt; u.pn = ct; u.tag = e; } };
struct EpiGU { static constexpr bool PERM = true; bf16* H;
    __device__ __forceinline__ bool operator()(AccRef acc, const Unit& u, int wr, int wc, int fr, int fq) const {
        bf16* dst = H + ((size_t)u.tag * RPE + u.pm * 256 + wr * 64 + fr) * DM + u.pn * 128 + wc * 32 + fq * 8;
#pragma unroll
        for (int ai = 0; ai < 2; ++ai)
#pragma unroll
            for (int m = 0; m < 4; ++m) { v2u o[2];
#pragma unroll
                for (int n = 0; n < 2; ++n) { const pg8::f32x4 a = acc[ai][0][m][n], up = acc[ai][1][m][n];
                    o[n] = pack4((pg8::f32x4){a[0] * sigmoidf_(a[0]) * up[0], a[1] * sigmoidf_(a[1]) * up[1], a[2] * sigmoidf_(a[2]) * up[2], a[3] * sigmoidf_(a[3]) * up[3]}); }
                *(v4u*)(dst + (size_t)(ai * 128 + m * 16) * DM) = (v4u){o[0].x, o[0].y, o[1].x, o[1].y}; }
        return false;
    } };
struct DecDown { const char* H; const char* W; int nrt;
    __device__ __forceinline__ void operator()(int L, Unit& u) const { const int per = nrt * 4, e = L / per, q = L - e * per, ct = q & 3, rt = q >> 2;
        u.A = H + ((size_t)e * RPE + rt * 256) * (DM * 2); u.arows = nullptr; u.B = W + ((size_t)e * DM + ct * 256) * (DM * 2); u.ldA = DM * 2; u.ldB = DM * 2; u.nt = DM / 64; u.pm = rt; u.pn = ct; u.tag = e; } };
struct EpiDown { static constexpr bool PERM = true; bf16* Y; const float* afs;
    __device__ __forceinline__ bool operator()(AccRef acc, const Unit& u, int wr, int wc, int fr, int fq) const {
        const size_t r0 = (size_t)u.tag * RPE + u.pm * 256 + wr * 64 + fr;
        float av[2][4];
#pragma unroll
        for (int ai = 0; ai < 2; ++ai)
#pragma unroll
            for (int m = 0; m < 4; ++m) av[ai][m] = afs[r0 + ai * 128 + m * 16];
#pragma unroll
        for (int ai = 0; ai < 2; ++ai)
#pragma unroll
            for (int m = 0; m < 4; ++m) { const size_t r = r0 + ai * 128 + m * 16; const float a = av[ai][m];
#pragma unroll
                for (int bj = 0; bj < 2; ++bj) { const v2u o0 = pack4(acc[ai][bj][m][0] * a), o1 = pack4(acc[ai][bj][m][1] * a);
                    *(v4u*)(Y + r * DM + u.pn * 256 + bj * 128 + wc * 32 + fq * 8) = (v4u){o0.x, o0.y, o1.x, o1.y}; } }
        return false;
    } };
struct Frame {
    LAS unsigned char* lds; char* ldsg; volatile LAS unsigned* MISC; gu32* ctl;
    int vcu, G;
    unsigned char* ws; unsigned char* dout; float* out;
};
constexpr int PTRS_OFF = LDSCTL_OFF + 512;
enum { IN_X = 0, IN_C, IN_CTX, IN_CCTX, IN_WADA, IN_BADA, IN_NORM1G, IN_WIN, IN_QNG, IN_KNG, IN_SINK, IN_WBRF, IN_WBRG, IN_WBRW, IN_WOUT, IN_NORM2G, IN_WROUTER, IN_WGATE, IN_WUP, IN_WDOWN, IN_FINALG };
__device__ __forceinline__ const float* inptr(const Frame& F, int k) {
    const unsigned long long v = *(const LAS unsigned long long*)(F.lds + PTRS_OFF + 8 * k);
    const unsigned lo = __builtin_amdgcn_readfirstlane((unsigned)v), hi = __builtin_amdgcn_readfirstlane((unsigned)(v >> 32));
    return (const float*)(((unsigned long long)hi << 32) | lo);
}
#define WSP(T, off) ((T*)(F.ws + (off)))

constexpr int COSTAB_OFF = LDSCTL_OFF + 1024;
static_assert(COSTAB_OFF + 8192 <= LDS_BYTES, "cos table fits");
__device__ __forceinline__ void transpose_item(const float* W, int ldw, int k0, int n0, bf16* WT, int drow0, int dld, int dk0, int lane, float sc = 1.f) {
    const int g = lane >> 3, n4 = (lane & 7) * 4;
    const float* src = W + (size_t)(k0 + 8 * g) * ldw + n0 + n4;
    f32x4 v[8];
#pragma unroll
    for (int i = 0; i < 8; ++i) v[i] = *(const GAS f32x4*)(src + (size_t)i * ldw);
    bf16* dst = WT + (size_t)(drow0 + n4) * dld + dk0 + k0 + 8 * g;
#pragma unroll
    for (int j = 0; j < 4; ++j) { v4u o; o.x = pk2(v[0][j] * sc, v[1][j] * sc); o.y = pk2(v[2][j] * sc, v[3][j] * sc); o.z = pk2(v[4][j] * sc, v[5][j] * sc); o.w = pk2(v[6][j] * sc, v[7][j] * sc);
        *(GAS v4u*)(dst + (size_t)j * dld) = o; }
}
__device__ __forceinline__ void transpose_item2(const float* W, int ldw, int k0, int n0, bf16* WT, int drow0, int dld, int lane) {
    const int g = lane >> 3, n4 = (lane & 7) * 4;
    const float* src = W + (size_t)(k0 + 8 * g) * ldw + n0 + n4;
    f32x4 v[2][8];
#pragma unroll
    for (int h = 0; h < 2; ++h)
#pragma unroll
        for (int i = 0; i < 8; ++i) v[h][i] = __builtin_nontemporal_load((const GAS f32x4*)(src + (size_t)(h * 64 + i) * ldw));
    bf16* dst = WT + (size_t)(drow0 + n4) * dld + k0 + 8 * g;
#pragma unroll
    for (int h = 0; h < 2; ++h)
#pragma unroll
        for (int j = 0; j < 4; ++j) { v4u o; o.x = pk2(v[h][0][j], v[h][1][j]); o.y = pk2(v[h][2][j], v[h][3][j]); o.z = pk2(v[h][4][j], v[h][5][j]); o.w = pk2(v[h][6][j], v[h][7][j]);
            __builtin_nontemporal_store(o, (GAS v4u*)(dst + (size_t)j * dld + h * 64)); }
}
__device__ __forceinline__ void fold_item(const float* W, int k0, int g, int sinmode, bf16* WT, int drow0, LAS float* scr, const LAS float* ctab, int lane) {
#pragma unroll
    for (int kk = 0; kk < 16; ++kk) scr[lane * 20 + kk] = W[(size_t)(k0 + kk) * INW + g * 64 + lane];
    LDS_WAIT(); asm volatile("" ::: "memory");
    float acc[16];
#pragma unroll
    for (int k = 0; k < 16; ++k) acc[k] = 0.f;
#pragma unroll 4
    for (int c = 0; c < 64; ++c) {
        const int r = (c * lane) & 63;
        const float tv = sinmode ? -ctab[((r - 16) & 63) * 32] : ctab[r * 32];
#pragma unroll
        for (int k4 = 0; k4 < 4; ++k4) { const f32x4 w = *(const LAS f32x4*)(scr + c * 20 + 4 * k4);
            acc[4 * k4] = fmaf(w[0], tv, acc[4 * k4]); acc[4 * k4 + 1] = fmaf(w[1], tv, acc[4 * k4 + 1]); acc[4 * k4 + 2] = fmaf(w[2], tv, acc[4 * k4 + 2]); acc[4 * k4 + 3] = fmaf(w[3], tv, acc[4 * k4 + 3]); }
    }
    GAS v4u* dst = (GAS v4u*)(WT + (size_t)(drow0 + lane) * DM + k0);
#pragma unroll
    for (int q = 0; q < 2; ++q) { v4u o; o.x = pk2(acc[8 * q], acc[8 * q + 1]); o.y = pk2(acc[8 * q + 2], acc[8 * q + 3]); o.z = pk2(acc[8 * q + 4], acc[8 * q + 5]); o.w = pk2(acc[8 * q + 6], acc[8 * q + 7]); dst[q] = o; }
    LDS_WAIT(); asm volatile("" ::: "memory");
}

#ifndef CONV_IN_ATTN
#define CONV_IN_ATTN 0
#endif
constexpr int CONV_WAVE_ITEMS = DEPTH * NE * 768, CONV_ITEMS = CONV_WAVE_ITEMS / NWAVES, CONV_ITEMS_L0 = CONV_ITEMS / DEPTH;
__device__ __forceinline__ void conv_wave_item(Frame& F, int r, int lane) {
    const int le = r / 768, q = r % 768, which = q / 256, qq = q % 256, kb = qq >> 5, nb = qq & 31, f0 = nb * 32;
    if (which < 2) transpose_item2((which ? inptr(F, IN_WUP) : inptr(F, IN_WGATE)) + (size_t)le * DM * DM, DM, kb * 128, f0, WSP(bf16, WS_WGU) + (size_t)le * 2 * DM * DM, (f0 >> 7) * 256 + which * 128 + (f0 & 127), DM, lane);
    else transpose_item2(inptr(F, IN_WDOWN) + (size_t)le * DM * DM, DM, kb * 128, f0, WSP(bf16, WS_WD) + (size_t)le * DM * DM, f0, DM, lane);
}
__device__ __forceinline__ void tail_convert(Frame& F, int idx, int first, int per, int end) {
    int tid_ = threadIdx.x; asm volatile("" : "+v"(tid_));
    const int lane = tid_ & 63, wave_ = __builtin_amdgcn_readfirstlane(tid_ >> 6);
    for (int t = 0; t < per; ++t) { const int it = first + idx * per + t; if (it >= end) break; conv_wave_item(F, it * NWAVES + wave_, lane); }
}

__device__ __forceinline__ void p0_prologue(Frame& F, int mode = 0) {
    int tid_ = threadIdx.x; asm volatile("" : "+v"(tid_));
    const int lane = tid_ & 63, wave_ = __builtin_amdgcn_readfirstlane(tid_ >> 6);
    const int gw = F.vcu * NWAVES + wave_, NGW = F.G * NWAVES;
    LAS float* st = (LAS float*)F.lds;
    LAS float* red = (LAS float*)(F.lds + 40960);
    LAS float* ctab = (LAS float*)(F.lds + COSTAB_OFF);
    { const float* cp = inptr(F, IN_C); const float* ccp = inptr(F, IN_CCTX);
#pragma unroll 6
      for (int i = tid_; i < 9 * DM; i += NWAVES * 64) { const int s = i / DM, k = i - s * DM; const float v = s < 8 ? cp[s * DM + k] : ccp[k]; st[i] = v / (1.f + expf(-v)); } }
    for (int i = tid_; i < 2048; i += NWAVES * 64) ctab[i] = cosf(6.283185307179586f * (float)i * (1.f / 2048.f));
    __syncthreads();
    const float* bada = inptr(F, IN_BADA);
    if (mode != 2) for (int it = F.vcu; it < DEPTH * 96; it += F.G) {
        const int l = it / 96, j = (it % 96) * 64 + lane, kb = wave_ * 128;
        const float* W = inptr(F, IN_WADA) + (size_t)l * DM * 6 * DM + (size_t)kb * 6 * DM + j;
        float acc[9];
#pragma unroll
        for (int s = 0; s < 9; ++s) acc[s] = 0.f;
        for (int k0 = 0; k0 < 128; k0 += 16) {
            float w[16];
#pragma unroll
            for (int i = 0; i < 16; ++i) w[i] = W[(size_t)(k0 + i) * 6 * DM];
#pragma unroll
            for (int i = 0; i < 16; ++i)
#pragma unroll
                for (int s = 0; s < 9; ++s) acc[s] = fmaf(st[s * DM + kb + k0 + i], w[i], acc[s]);
        }
#pragma unroll
        for (int s = 0; s < 9; ++s) red[(wave_ * 9 + s) * 64 + lane] = acc[s];
        __syncthreads();
        for (int o = tid_; o < 9 * 64; o += NWAVES * 64) { float v = 0.f;
#pragma unroll
            for (int w = 0; w < 8; ++w) v += red[w * 576 + o];
            const int s = o >> 6, jj = (it % 96) * 64 + (o & 63);
            WSP(float, WS_MOD)[((size_t)l * 9 + s) * 6 * DM + jj] = v + bada[l * 6 * DM + jj]; }
        __syncthreads();
    }
    __syncthreads();
#ifdef DBG_POISON
    {
        const size_t n16 = (WS_END - WS_X) / 16, m16 = ((size_t)NLAT * DM * 4) / 16; const v4u pz = {0xFFFFFFFFu, 0xFFFFFFFFu, 0xFFFFFFFFu, 0xFFFFFFFFu};
        for (size_t i = (size_t)gw * 64 + lane; i < n16; i += (size_t)NGW * 64) ((GAS v4u*)(F.ws + WS_X))[i] = pz;
        for (size_t i = (size_t)gw * 64 + lane; i < m16; i += (size_t)NGW * 64) ((GAS v4u*)F.dout)[i] = pz;
    }
#endif
    LAS float* scr = (LAS float*)(F.lds + wave_ * 16384);
    constexpr int T_A = DEPTH * 2176, T_B = DEPTH * 512, T_C = DEPTH * 512, T_D = DEPTH * 512, T_E = DEPTH * NE * 768, T_F = SEQ + CTX, T_G = 1;
    constexpr int NITEMS = T_A + T_B + T_C + T_D + T_E + T_F + T_G;
    if (mode != 1 && mode != 5 && mode != 6) for (int it = gw; it < NITEMS; it += NGW) {
        int r = it;
        if (r < T_A) { const int l = r / 2176, q = r % 2176, kb = q / 136, nb = q % 136, s0 = 256 + nb * 32;
            int drow; if (s0 < 1536) { const int tile = 2 + ((s0 - 256) >> 8), hh = ((s0 - 256) & 255) >> 6, dh = (s0 & 63) >> 5; drow = tile * 256 + dh * 128 + hh * 32; } else drow = s0 + 256;
            transpose_item(inptr(F, IN_WIN) + (size_t)l * DM * INW, INW, kb * 64, s0, WSP(bf16, WS_WIN) + (size_t)l * INW2 * DM, drow, DM, 0, lane, s0 < 1536 ? 1.f : -LOG2E); continue; } r -= T_A;
        if (r < T_B) { const int l = r / 512, q = r % 512, kq = q & 3, kb = (q >> 2) >> 3, g = ((q >> 2) >> 1) & 3, sm = (q >> 2) & 1;
            fold_item(inptr(F, IN_WIN) + (size_t)l * DM * INW, kb * 64 + kq * 16, g, sm, WSP(bf16, WS_WIN) + (size_t)l * INW2 * DM, sm * 256 + g * 64, scr, ctab, lane); continue; } r -= T_B;
        if (r < T_C) { const int l = r / 512, q = r % 512; const float* W; int kb, koff;
            if (q < 128) { W = inptr(F, IN_WBRF) + (size_t)l * 256 * DM; kb = q >> 5; koff = 0; } else if (q < 384) { W = inptr(F, IN_WBRG) + (size_t)l * 512 * DM; kb = (q - 128) >> 5; koff = 256; } else { W = inptr(F, IN_WBRW) + (size_t)l * 256 * DM; kb = (q - 384) >> 5; koff = 768; }
            const int nb = q & 31;
            transpose_item(W, DM, kb * 64, nb * 32, WSP(bf16, WS_WBR) + (size_t)l * DM * DM, nb * 32, DM, koff, lane); continue; } r -= T_C;
        if (r < T_D) { const int l = r / 512, q = r % 512, kb = q >> 5, nb = q & 31;
            transpose_item(inptr(F, IN_WOUT) + (size_t)l * DM * DM, DM, kb * 64, nb * 32, WSP(bf16, WS_WOUT) + (size_t)l * DM * DM, nb * 32, DM, 0, lane); continue; } r -= T_D;
        if (r < T_E) { if (F.G != 256) conv_wave_item(F, r, lane); continue; } r -= T_E;
        if (r < T_F) {
            const bool big = r < SEQ; const int N = big ? SEQ : CTX, k = big ? r : r - SEQ, sh = big ? 0 : 3; const float sc = 1.f / sqrtf(64.f * (float)N);
            bf16* row = (big ? WSP(bf16, WS_DFT) : WSP(bf16, WS_DFTC)) + (size_t)k * 2 * N;
            for (int n = 2 * lane; n < N; n += 128) {
                const int r0 = (k * n) & (N - 1), r1 = (k * (n + 1)) & (N - 1);
                *(GAS unsigned*)(row + n) = pk2(ctab[r0 << sh] * sc, ctab[r1 << sh] * sc);
                *(GAS unsigned*)(row + N + n) = pk2(ctab[((r0 - (N >> 2)) & (N - 1)) << sh] * sc, ctab[((r1 - (N >> 2)) & (N - 1)) << sh] * sc); }
            continue; } r -= T_F;
        {
            for (int i = lane; i < 64 * 16; i += 64) { const int pos = i >> 4, f = i & 15; const float inv = powf(10000.f, -(float)(2 * f) / 32.f), ang = (float)pos * inv;
                WSP(float, WS_ROPE)[2 * i] = cosf(ang); WSP(float, WS_ROPE)[2 * i + 1] = sinf(ang); }
        }
    }
}

__device__ __forceinline__ void norm_row(f32x4 (&v)[4], const float* gain, const float* shift, const float* scale, int lane) {
    float ss = 0.f;
#pragma unroll
    for (int j = 0; j < 4; ++j) ss += (v[j][0] * v[j][0] + v[j][1] * v[j][1]) + (v[j][2] * v[j][2] + v[j][3] * v[j][3]);
    const float r = rsqrtf(wave_sum(ss) * (1.f / DM) + EPS);
#pragma unroll
    for (int j = 0; j < 4; ++j) { const f32x4 g = *(const f32x4*)(gain + 4 * lane + 256 * j); f32x4 y = v[j] * r * g;
        if (shift) { const f32x4 sh = *(const f32x4*)(shift + 4 * lane + 256 * j), sc = *(const f32x4*)(scale + 4 * lane + 256 * j); y = y * (sc + 1.f) + sh; }
        v[j] = y; }
}
__device__ __forceinline__ void store_row_bf16(bf16* orow, const f32x4 (&v)[4], int lane) {
    GAS v2u* o8 = (GAS v2u*)orow + lane;
#pragma unroll
    for (int j = 0; j < 4; ++j) { v2u w; w.x = pg8::cvt_pk_bf16(v[j][0], v[j][1]); w.y = pg8::cvt_pk_bf16(v[j][2], v[j][3]); o8[64 * j] = w; }
}
__device__ __forceinline__ int row_modset(int r) { return r < NLAT ? (r >> 11) : 8; }
struct ModVec { f32x4 g[4], sh[4], sc[4]; };
__device__ __forceinline__ void load_modvec(ModVec& m, const float* gain, const float* shift, const float* scale, int lane) {
#pragma unroll
    for (int j = 0; j < 4; ++j) { m.g[j] = *(const f32x4*)(gain + 4 * lane + 256 * j);
        if (shift) { m.sh[j] = *(const f32x4*)(shift + 4 * lane + 256 * j); m.sc[j] = *(const f32x4*)(scale + 4 * lane + 256 * j); } else { m.sh[j] = (f32x4){0.f, 0.f, 0.f, 0.f}; m.sc[j] = (f32x4){0.f, 0.f, 0.f, 0.f}; } }
}
__device__ __forceinline__ void norm_row_m(f32x4 (&v)[4], const ModVec& m) {
    float ss = 0.f;
#pragma unroll
    for (int j = 0; j < 4; ++j) ss += (v[j][0] * v[j][0] + v[j][1] * v[j][1]) + (v[j][2] * v[j][2] + v[j][3] * v[j][3]);
    const float r = rsqrtf(wave_sum(ss) * (1.f / DM) + EPS);
#pragma unroll
    for (int j = 0; j < 4; ++j) v[j] = (v[j] * r * m.g[j]) * (m.sc[j] + 1.f) + m.sh[j];
}
__device__ __forceinline__ void load_row_bf16(f32x4 (&v)[4], const bf16* row, int lane) {
    const GAS v2u* i8 = (const GAS v2u*)row + lane;
#pragma unroll
    for (int j = 0; j < 4; ++j) { const v2u w = i8[64 * j]; v[j] = (f32x4){bflo(w.x), bfhi(w.x), bflo(w.y), bfhi(w.y)}; }
}
__device__ __forceinline__ void load_row_f32(f32x4 (&v)[4], const float* row, int lane) {
#pragma unroll
    for (int j = 0; j < 4; ++j) v[j] = *(const f32x4*)(row + 4 * lane + 256 * j);
}

__device__ __forceinline__ void p1_norm1(Frame& F) {
    int tid_ = threadIdx.x; asm volatile("" : "+v"(tid_));
    const int lane = tid_ & 63, wave_ = __builtin_amdgcn_readfirstlane(tid_ >> 6);
    const int gw = F.vcu * NWAVES + wave_, NGW = F.G * NWAVES, rpw = (NTOK + NGW - 1) / NGW, r0 = gw * rpw, r1 = r0 + rpw < NTOK ? r0 + rpw : NTOK;
    const float* xin = inptr(F, IN_X); const float* cin = inptr(F, IN_CTX) - (size_t)NLAT * DM; const float* g1 = inptr(F, IN_NORM1G);
#define P1_ROW(r) (((r) < NLAT ? xin : cin) + (size_t)(r) * DM)
    f32x4 va[4], vb[4]; ModVec m; int cset = -1;
    if (r0 < r1) load_row_f32(va, P1_ROW(r0), lane);
    if (r0 + 1 < r1) load_row_f32(vb, P1_ROW(r0 + 1), lane);
    for (int r = r0; r < r1; ++r) {
        f32x4 v[4];
#pragma unroll
        for (int j = 0; j < 4; ++j) { v[j] = va[j]; va[j] = vb[j]; }
        if (r + 2 < r1) load_row_f32(vb, P1_ROW(r + 2), lane);
        const int set = row_modset(r);
        if (set != cset) { const float* mod = WSP(float, WS_MOD) + (size_t)set * 6 * DM; load_modvec(m, g1, mod, mod + DM, lane); cset = set; }
        norm_row_m(v, m);
        store_row_bf16(WSP(bf16, WS_HN) + (size_t)r * DM, v, lane);
    }
#undef P1_ROW
}
__device__ __forceinline__ void router_finish(const float (&a16)[NE], int r, int lane, float* AFF) {
    float b8[8], b4[4], b2[2], lg;
    { const bool hi = lane & 32;
#pragma unroll
      for (int i = 0; i < 8; ++i) { const float keep = hi ? a16[i + 8] : a16[i], send = hi ? a16[i] : a16[i + 8]; b8[i] = keep + lx32(send); } }
    { const bool hi = lane & 16;
#pragma unroll
      for (int i = 0; i < 4; ++i) { const float keep = hi ? b8[i + 4] : b8[i], send = hi ? b8[i] : b8[i + 4]; b4[i] = keep + lx16(send); } }
    { const bool hi = lane & 8;
#pragma unroll
      for (int i = 0; i < 2; ++i) { const float keep = hi ? b4[i + 2] : b4[i], send = hi ? b4[i] : b4[i + 2]; b2[i] = keep + lx8(send); } }
    { const bool hi = lane & 4; const float keep = hi ? b2[1] : b2[0], send = hi ? b2[0] : b2[1]; lg = keep + lx4(send); }
    lg += lx2(lg); lg += lx1(lg);
    float mx = lg;
    mx = fmaxf(mx, lx4(mx)); mx = fmaxf(mx, lx8(mx)); mx = fmaxf(mx, lx16(mx)); mx = fmaxf(mx, lx32(mx));
    const float ex = expf(lg - mx); float sum = ex;
    sum += lx4(sum); sum += lx8(sum); sum += lx16(sum); sum += lx32(sum);
    const int set = r < NLAT ? (r >> 11) : 8 + ((r - NLAT) >> 8), n = r < NLAT ? (r & (SEQ - 1)) : ((r - NLAT) & (CTX - 1));
    if ((lane & 3) == 0) AFF[((size_t)set * NE + ((lane >> 2) & 15)) * SEQ + n] = ex / sum;
}
__device__ __forceinline__ void pf_norm2_router(Frame& F, int l, int mode = 0) {
    int tid_ = threadIdx.x; asm volatile("" : "+v"(tid_));
    const int lane = tid_ & 63, wave_ = __builtin_amdgcn_readfirstlane(tid_ >> 6);
    const int gw = F.vcu * NWAVES + wave_, NGW = F.G * NWAVES;
    LAS float* wrT = (LAS float*)F.lds;
    { const float* wr = inptr(F, IN_WROUTER) + (size_t)l * DM * NE;
#pragma unroll 8
      for (int i = tid_; i < DM * NE; i += NWAVES * 64) { const int k = i >> 4, e = i & 15; wrT[e * DM + k] = wr[i]; } }
    __syncthreads();
    const int nrows = (l == DEPTH - 1) ? NLAT : NTOK, rpw = (nrows + NGW - 1) / NGW, r0 = gw * rpw, r1 = r0 + rpw < nrows ? r0 + rpw : nrows;
    const bf16* X = WSP(bf16, WS_X); const float* g2n = inptr(F, IN_NORM2G) + l * DM; float* AFF = WSP(float, WS_AFF);
    f32x4 va[4], vb[4]; ModVec m; int cset = -1;
    if (r0 < r1) load_row_bf16(va, X + (size_t)r0 * DM, lane);
    if (r0 + 1 < r1) load_row_bf16(vb, X + (size_t)(r0 + 1) * DM, lane);
    for (int r = r0; r < r1; ++r) {
        f32x4 v[4];
#pragma unroll
        for (int j = 0; j < 4; ++j) { v[j] = va[j]; va[j] = vb[j]; }
        if (r + 2 < r1) load_row_bf16(vb, X + (size_t)(r + 2) * DM, lane);
        const int mset = row_modset(r);
        if (mset != cset) { const float* mod = WSP(float, WS_MOD) + ((size_t)l * 9 + mset) * 6 * DM; load_modvec(m, g2n, mod + 3 * DM, mod + 4 * DM, lane); cset = mset; }
        norm_row_m(v, m);
        if (mode < 2) store_row_bf16(WSP(bf16, WS_HN) + (size_t)r * DM, v, lane);
        if (mode >= 1) { asm volatile("" :: "v"(v[0]), "v"(v[1]), "v"(v[2]), "v"(v[3])); continue; }
        float a16[NE];
#pragma unroll
        for (int e = 0; e < NE; ++e) { float a = 0.f;
#pragma unroll
            for (int j = 0; j < 4; ++j) { const f32x4 w = *(const LAS f32x4*)(wrT + e * DM + 4 * lane + 256 * j); a = fmaf(v[j][0], w[0], a); a = fmaf(v[j][1], w[1], a); a = fmaf(v[j][2], w[2], a); a = fmaf(v[j][3], w[3], a); }
            a16[e] = a; if ((e & 3) == 3) asm volatile("" ::: "memory"); }
        router_finish(a16, r, lane, AFF);
    }
    __syncthreads();
}
__device__ __forceinline__ void pg_topk_gather(Frame& F, int l) {
    int tid_ = threadIdx.x; asm volatile("" : "+v"(tid_));
    const int lane = tid_ & 63, wave_ = __builtin_amdgcn_readfirstlane(tid_ >> 6);
    LAS unsigned* cnt = (LAS unsigned*)F.lds;
    LAS int* sidx = (LAS int*)(F.lds + 1024);
    const int nitems = (l == DEPTH - 1) ? 8 * NE : 16 * NE;
    const int tid = tid_, wave = wave_;
    const unsigned long long lt = (1ull << lane) - 1ull;
    for (int it = F.vcu; it < nitems; it += F.G) {
        const int set = it >> 4, e = it & 15; const bool latent = set < 8; const int N = latent ? SEQ : CTX, cap = latent ? CAPL : CAPC;
        const int rowbase = latent ? set * SEQ : NLAT + (set - 8) * CTX, xbase = latent ? set * CAPL : 8 * CAPL + (set - 8) * CAPC;
        const float* a = WSP(float, WS_AFF) + ((size_t)set * NE + e) * SEQ;
        unsigned key[4];
#pragma unroll
        for (int q = 0; q < 4; ++q) { const int i = q * 512 + tid; key[q] = i < N ? __builtin_bit_cast(unsigned, a[i]) : 0u; }
        unsigned T = 0u;
        for (int bit = 30; bit >= 0; --bit) {
            const unsigned cand = T | (1u << bit); unsigned c = 0;
#pragma unroll
            for (int q = 0; q < 4; ++q) c += (unsigned)__builtin_popcountll(__ballot(key[q] >= cand));
            LAS unsigned* cb = cnt + (bit & 1) * 8;
            if (lane == 0) cb[wave] = c;
            __syncthreads();
            unsigned tot = 0;
#pragma unroll
            for (int w = 0; w < 8; ++w) tot += cb[w];
            if (tot >= (unsigned)cap) T = cand;
        }
        LAS unsigned* cg = cnt + 64; LAS unsigned* ce = cnt + 96;
        unsigned long long bg[4], be[4];
#pragma unroll
        for (int q = 0; q < 4; ++q) { bg[q] = __ballot(key[q] > T); be[q] = __ballot(key[q] == T && key[q] != 0u);
            if (lane == 0) { cg[q * 8 + wave] = (unsigned)__builtin_popcountll(bg[q]); ce[q * 8 + wave] = (unsigned)__builtin_popcountll(be[q]); } }
        __syncthreads();
        unsigned ngt = 0;
        for (int c2 = 0; c2 < 32; ++c2) ngt += cg[c2];
        const unsigned need = (unsigned)cap - ngt;
        unsigned pre_g[4], pre_e[4];
        { unsigned rg = 0, re = 0;
#pragma unroll
          for (int q = 0; q < 4; ++q) { for (int w = 0; w < 8; ++w) { if (w == wave) { pre_g[q] = rg; pre_e[q] = re; } rg += cg[q * 8 + w]; re += ce[q * 8 + w]; } } }
        int* SEL = WSP(int, WS_SEL);
#pragma unroll
        for (int q = 0; q < 4; ++q) { const int i = q * 512 + tid;
            if (i < N) {
                const unsigned eb = pre_e[q] + (unsigned)__builtin_popcountll(be[q] & lt);
                const unsigned gb = pre_g[q] + (unsigned)__builtin_popcountll(bg[q] & lt);
                const bool isg = key[q] > T, ise = key[q] == T;
                const bool sel = isg || (ise && eb < need);
                const unsigned slot = gb + (eb < need ? eb : need);
                SEL[(size_t)(rowbase + i) * NE + e] = sel ? xbase + (int)slot : -1;
                if (sel) { WSP(float, WS_AFS)[(size_t)e * RPE + xbase + slot] = __builtin_bit_cast(float, key[q]); WSP(int, WS_IDX)[(size_t)e * RPE + xbase + slot] = rowbase + i; }
            } }
        __syncthreads();
    }
}
__device__ __forceinline__ unsigned ye_issue4(const bf16* YE, int selv, unsigned mk, v2u (&w)[4][4], int lane) {
#pragma unroll
    for (int i = 0; i < 4; ++i) {
        if (mk) { const int e = __builtin_ctz(mk); mk &= mk - 1u; const int se = __builtin_amdgcn_readlane(selv, e);
            const GAS v2u* y = (const GAS v2u*)(YE + ((size_t)e * RPE + se) * DM) + lane;
#pragma unroll
            for (int j = 0; j < 4; ++j) w[i][j] = y[64 * j]; }
        else {
#pragma unroll
            for (int j = 0; j < 4; ++j) w[i][j] = (v2u){0u, 0u}; }
    }
    return mk;
}
__device__ __forceinline__ void ye_acc4(f32x4 (&t)[4], const v2u (&w)[4][4]) {
#pragma unroll
    for (int i = 0; i < 4; ++i)
#pragma unroll
        for (int j = 0; j < 4; ++j) t[j] += (f32x4){bflo(w[i][j].x), bfhi(w[i][j].x), bflo(w[i][j].y), bfhi(w[i][j].y)};
}
__device__ __forceinline__ unsigned sel_mask(int selv) { return (unsigned)__builtin_amdgcn_readfirstlane((int)(__ballot(selv >= 0) & 0xFFFFull)); }
__device__ __forceinline__ void pj_combine(Frame& F, int l, int probe = 0) {
    int tid_ = threadIdx.x; asm volatile("" : "+v"(tid_));
    const int lane = tid_ & 63, wave_ = __builtin_amdgcn_readfirstlane(tid_ >> 6);
    const int gw = F.vcu * NWAVES + wave_, NGW = F.G * NWAVES; const bool last = l == DEPTH - 1;
    const int nrows = last ? NLAT : NTOK, rpw = (nrows + NGW - 1) / NGW, r0 = gw * rpw, r1 = r0 + rpw < nrows ? r0 + rpw : nrows;
    bf16* X = WSP(bf16, WS_X); const int* SEL = WSP(int, WS_SEL);
    const float* gnext = last ? inptr(F, IN_FINALG) : inptr(F, IN_NORM1G) + (l + 1) * DM;
    f32x4 va[4], vb[4], g2[4]; int sa = -1, sb = -1; ModVec m; int cset = -1;
    if (r0 < r1) { load_row_bf16(va, X + (size_t)r0 * DM, lane); sa = lane < NE ? SEL[(size_t)r0 * NE + lane] : -1; }
    if (r0 + 1 < r1) { load_row_bf16(vb, X + (size_t)(r0 + 1) * DM, lane); sb = lane < NE ? SEL[(size_t)(r0 + 1) * NE + lane] : -1; }
    const bf16* YE = WSP(bf16, WS_G); v2u wA[4][4], wB[4][4]; unsigned restA = 0u, restB = 0u;
    restA = ye_issue4(YE, sa, r0 < r1 ? sel_mask(sa) : 0u, wA, lane);
#define PJ_ROW(r, WC, WN, RC, RN) do { \
        f32x4 v[4], t[4]; \
        _Pragma("unroll") for (int j = 0; j < 4; ++j) { v[j] = va[j]; va[j] = vb[j]; t[j] = (f32x4){0.f, 0.f, 0.f, 0.f}; } \
        const int selv = sa; sa = sb; \
        if ((r) + 2 < r1) { load_row_bf16(vb, X + (size_t)((r) + 2) * DM, lane); sb = lane < NE ? SEL[(size_t)((r) + 2) * NE + lane] : -1; } \
        const int mset = row_modset(r); \
        if (mset != cset) { const float* mod = WSP(float, WS_MOD) + ((size_t)l * 9 + mset) * 6 * DM; const float* mod1 = WSP(float, WS_MOD) + ((size_t)(last ? l : l + 1) * 9 + mset) * 6 * DM; \
            _Pragma("unroll") for (int j = 0; j < 4; ++j) g2[j] = *(const f32x4*)(mod + 5 * DM + 4 * lane + 256 * j); \
            load_modvec(m, gnext, last ? nullptr : mod1, last ? nullptr : mod1 + DM, lane); cset = mset; } \
        RN = ye_issue4(YE, sa, (r) + 1 < r1 ? sel_mask(sa) : 0u, WN, lane);                \
        ye_acc4(t, WC); \
        while (RC) { RC = ye_issue4(YE, selv, RC, WC, lane); ye_acc4(t, WC); }               \
        _Pragma("unroll") for (int j = 0; j < 4; ++j) v[j] = v[j] + g2[j] * t[j]; \
        if (probe) { norm_row_m(v, m); asm volatile("" :: "v"(v[0]), "v"(v[1]), "v"(v[2]), "v"(v[3])); } \
        else if (!last) { \
            store_row_bf16(X + (size_t)(r) * DM, v, lane); \
            norm_row_m(v, m); \
            store_row_bf16(WSP(bf16, WS_HN) + (size_t)(r) * DM, v, lane); \
        } else { \
            norm_row_m(v, m); \
            _Pragma("unroll") for (int j = 0; j < 4; ++j) *(f32x4*)(F.out + (size_t)(r) * DM + 4 * lane + 256 * j) = v[j]; \
        } } while (0)
    for (int r = r0; r < r1; r += 2) {
        PJ_ROW(r, wA, wB, restA, restB);
        if (r + 1 < r1) PJ_ROW(r + 1, wB, wA, restB, restA);
    }
#undef PJ_ROW
}

__device__ __forceinline__ void pc_mixers(Frame& F, int l, int rep) {
    int tid_ = threadIdx.x; asm volatile("" : "+v"(tid_));
    const int lane = tid_ & 63, wave_ = __builtin_amdgcn_readfirstlane(tid_ >> 6);
    const bool need_ctx = l < DEPTH - 1;
    {
        Strided<DecDft> S; S.d.Dm = (const char*)(F.ws + WS_DFT); S.d.Dc = (const char*)(F.ws + WS_DFTC); S.d.ABt = (const char*)(F.ws + WS_ABT); S.d.ABtc = (const char*)(F.ws + WS_ABTC);
        S.n = need_ctx ? 72 : 64; S.G = F.G; S.vcu = F.vcu;
        EpiStore E{WSP(bf16, WS_BR), DM};
        pg8::gemm_phase<EpiStore, Strided<DecDft>>(F.lds, (LAS int*)(F.lds + IDXBUF_OFF), S, E);
    }
    typedef attn_body::bf16 abf;
    const abf* Qg = (const abf*)(F.ws + WS_QKV + QKV_QG); const abf* Kg = (const abf*)(F.ws + WS_QKV + QKV_KG); const abf* Vg = (const abf*)(F.ws + WS_QKV + QKV_VG);
    const abf* Qw = (const abf*)(F.ws + WS_QKV + QKV_QW); const abf* Kw = (const abf*)(F.ws + WS_QKV + QKV_KW); const abf* Vw = (const abf*)(F.ws + WS_QKV + QKV_VW);
    abf* BR = (abf*)(F.ws + WS_BR);
    const int nGL = NBATCH * 2 * 32, nWL = NBATCH * 2 * 16, nGC = need_ctx ? NBATCH * 2 * 4 : 0, nWC = need_ctx ? NBATCH * 2 * 2 : 0, nattn = nGL + nWL + nGC + nWC;
    const int nconv = (CONV_IN_ATTN && F.G == 256 && rep == 0) ? CONV_ITEMS_L0 : 0, ntot = nattn + nconv;
    gu32* head = F.ctl + CW_QUEUE + 64 * (l + 2 * rep);
    const int wid = wave_;
    for (;;) {
        if (tid_ == 0) F.MISC[0] = __hip_atomic_fetch_add(head, 1u, RLX_AGENT);
        __syncthreads();
        const int q = (int)F.MISC[0];
        if (q >= ntot) break;
        const int c0 = (int)(((long long)q * nconv) / ntot), c1 = (int)(((long long)(q + 1) * nconv) / ntot);
        if (c1 > c0) { conv_wave_item(F, (l * CONV_ITEMS_L0 + c0) * NWAVES + wave_, lane); __syncthreads(); continue; }
        const int a = q - c0;
        if (a < nGL) {
            const int b = a >> 6, hkv = (a >> 5) & 1, qb = a & 31, head_ = hkv * 4 + (wid >> 1), q0 = qb * 64 + (wid & 1) * 32; const size_t qrow = (size_t)b * SEQ + q0;
            attn_body::attn_unit<0, 8>(Qg + qrow * 512 + head_ * 64, 512, Kg + (size_t)(NLAT + b * CTX) * 128 + hkv * 64, Kg + (size_t)b * SEQ * 128 + hkv * 64,
                                        Vg + (size_t)(NLAT + b * CTX) * 128 + hkv * 64, Vg + (size_t)b * SEQ * 128 + hkv * 64, 128, 4 + SEQ / 64, 0, 0, 0.f, BR + qrow * DM + 256 + head_ * 64, DM, F.ldsg);
        } else if (a < nGL + nWL) {
            const int u = a - nGL, b = u >> 5, hkv = (u >> 4) & 1, qb = u & 15, head_ = hkv * 2 + (wid >> 2), q0 = qb * 128 + (wid & 3) * 32; const size_t qrow = (size_t)b * SEQ + q0;
            const int band0 = qb * 128 - 128 < 0 ? 0 : qb * 128 - 128, band1 = qb * 128 + 256 > SEQ ? SEQ : qb * 128 + 256;
            attn_body::attn_unit<1, 8>(Qw + qrow * 256 + head_ * 64, 256, Kw + (size_t)(NLAT + b * CTX) * 128 + hkv * 64, Kw + ((size_t)b * SEQ + band0) * 128 + hkv * 64,
                                        Vw + (size_t)(NLAT + b * CTX) * 128 + hkv * 64, Vw + ((size_t)b * SEQ + band0) * 128 + hkv * 64, 128, 4 + (band1 - band0) / 64, q0, band0,
                                        inptr(F, IN_SINK)[l * 4 + head_] * LOG2E, BR + qrow * DM + 768 + head_ * 64, DM, F.ldsg);
        } else if (a < nGL + nWL + nGC) {
            const int u = a - nGL - nWL, b = u >> 3, hkv = (u >> 2) & 1, qb = u & 3, head_ = hkv * 4 + (wid >> 1); const size_t qrow = (size_t)NLAT + b * CTX + qb * 64 + (wid & 1) * 32;
            const abf* Kc = Kg + (size_t)(NLAT + b * CTX) * 128 + hkv * 64; const abf* Vc = Vg + (size_t)(NLAT + b * CTX) * 128 + hkv * 64;
            attn_body::attn_unit<0, 8>(Qg + qrow * 512 + head_ * 64, 512, Kc, Kc, Vc, Vc, 128, 4, 0, 0, 0.f, BR + qrow * DM + 256 + head_ * 64, DM, F.ldsg);
        } else {
            const int u = a - nGL - nWL - nGC, b = u >> 2, hkv = (u >> 1) & 1, qb = u & 1, head_ = hkv * 2 + (wid >> 2); const size_t qrow = (size_t)NLAT + b * CTX + qb * 128 + (wid & 3) * 32;
            const abf* Kc = Kw + (size_t)(NLAT + b * CTX) * 128 + hkv * 64; const abf* Vc = Vw + (size_t)(NLAT + b * CTX) * 128 + hkv * 64;
            attn_body::attn_unit<1, 8>(Qw + qrow * 256 + head_ * 64, 256, Kc, Kc, Vc, Vc, 128, 4, 0, 0, inptr(F, IN_SINK)[l * 4 + head_] * LOG2E, BR + qrow * DM + 768 + head_ * 64, DM, F.ldsg);
        }
    }
    __syncthreads();
}
#ifndef MK_N_LAUNCHES
#define MK_N_LAUNCHES 1
#endif
constexpr int N_PHASES = 2 + 9 * DEPTH;
struct Args { const float* in[21]; float* out; unsigned char* ws; int ph_lo, ph_hi, probe, pad_; };

__global__ void __launch_bounds__(NWAVES * 64, 2) hybrid_fwd(Args args) {
    extern __shared__ __attribute__((aligned(16))) unsigned char lds[];
    Frame F;
    F.lds = (LAS unsigned char*)lds; F.ldsg = (char*)lds; F.MISC = (volatile LAS unsigned*)(F.lds + MISC_OFF);
    F.G = gridDim.x; { const int bx = blockIdx.x; F.vcu = (F.G % 8 == 0) ? (bx % 8) * (F.G / 8) + bx / 8 : bx; }
    F.ws = args.ws; F.out = args.out; F.dout = (unsigned char*)args.out; F.ctl = (gu32*)(args.ws + WS_CTL);
#ifdef DBG_LDSPOISON
    for (int u = threadIdx.x; u < LDSCTL_OFF / 4; u += NWAVES * 64) ((LAS unsigned*)F.lds)[u] = 0xFFFFFFFFu;
#endif
    for (int u = threadIdx.x; u < (LDS_BYTES - LDSCTL_OFF) / 4; u += NWAVES * 64) ((LAS unsigned*)(F.lds + LDSCTL_OFF))[u] = 0u;
    __syncthreads();
    if (threadIdx.x < 21) *(LAS unsigned long long*)(F.lds + PTRS_OFF + 8 * threadIdx.x) = (unsigned long long)args.in[threadIdx.x];
    __syncthreads();
    XcdBarrier bar; bar.bar = (unsigned*)(F.ctl + CW_BAR); bar.x = 0; bar.st = nullptr;
    const int lo = args.ph_lo, hi = args.ph_hi;
    if (hi - lo > 1) bar = xcd_barrier_post((unsigned*)(F.ctl + CW_BAR), F.MISC + 8);
#ifndef PHSEL
#define PHSEL 0x7ff
#endif
#define IN(k) (lo <= (k) && (k) < hi)
#define KIND(j) ((PHSEL >> (j)) & 1)
#ifndef DBG_PROBE
#define DBG_PROBE 0
#endif
#ifndef FPROBE_MODE
#define FPROBE_MODE 0
#endif
#ifndef REP_MASK
#define REP_MASK 0
#endif
#define NREP(j, ok) ((((REP_MASK) >> (j)) & 1) && (ok) ? 2 : 1)
#define REPEAT(j, ok) for (int rep_ = 0, nrep_ = NREP(j, ok); rep_ < nrep_; ++rep_, (rep_ < nrep_ ? xcd_barrier(bar) : (void)0))
#define SEAM(k) do { if (IN(k) && IN((k) + 1)) xcd_barrier(bar); } while (0)

#ifdef BAR_PROBE
    if (hi - lo > 1) for (int i_ = 0; i_ < BAR_PROBE; ++i_) xcd_barrier(bar);
#endif
    if (KIND(0) && IN(0)) REPEAT(0, true) { p0_prologue(F, rep_ ? DBG_PROBE : 0); } SEAM(0);
    if (KIND(1) && IN(1)) REPEAT(1, true) { p1_norm1(F); } SEAM(1);
    for (int l = 0; l < DEPTH; ++l) {
        const int pb = 2 + 9 * l; const bool lastl = l == DEPTH - 1;
        const int nrt = lastl ? 64 : 72;
        if (KIND(2) && IN(pb + 0)) REPEAT(2, true) {
            Strided<DecInProj> S; S.d.A = (const char*)(F.ws + WS_HN); S.d.B = (const char*)(F.ws + WS_WIN) + (size_t)l * INW2 * DM * 2; S.d.layer = l; S.n = inproj_units(l); S.G = F.G; S.vcu = F.vcu;
            EpiInProj E; E.ABt = (bf16*)(F.ws + WS_ABT); E.ABtc = (bf16*)(F.ws + WS_ABTC);
            E.Qg = (bf16*)(F.ws + WS_QKV + QKV_QG); E.Kg = (bf16*)(F.ws + WS_QKV + QKV_KG); E.Vg = (bf16*)(F.ws + WS_QKV + QKV_VG);
            E.Qw = (bf16*)(F.ws + WS_QKV + QKV_QW); E.Kw = (bf16*)(F.ws + WS_QKV + QKV_KW); E.Vw = (bf16*)(F.ws + WS_QKV + QKV_VW);
            E.G = WSP(bf16, WS_G); E.rope = WSP(float, WS_ROPE); E.qng = inptr(F, IN_QNG) + l * 64; E.kng = inptr(F, IN_KNG) + l * 64;
            pg8::gemm_phase<EpiInProj, Strided<DecInProj>>(F.lds, (LAS int*)(F.lds + IDXBUF_OFF), S, E);
            if (!CONV_IN_ATTN && l == 0 && F.G == 256 && F.vcu >= 88 && rep_ == 0) tail_convert(F, F.vcu - 88, 0, 4, 672);
        } SEAM(pb + 0);
        if (KIND(3) && IN(pb + 1)) REPEAT(3, true) { pc_mixers(F, l, rep_); } SEAM(pb + 1);
        if (KIND(4) && IN(pb + 2)) REPEAT(4, true) {
            SchedMerge S; S.BR = (const char*)(F.ws + WS_BR); S.W = (const char*)(F.ws + WS_WBR) + (size_t)l * DM * DM * 2; S.ntiles = nrt * 4; S.G = F.G; S.vcu = F.vcu;
            EpiMerge E{WSP(bf16, WS_G), (rep_ + 1 == nrep_ && !args.probe) ? (bf16*)(F.ws + WS_MB) : WSP(bf16, WS_HN), args.probe};
            pg8::gemm_phase<EpiMerge, SchedMerge>(F.lds, (LAS int*)(F.lds + IDXBUF_OFF), S, E);
            if (!CONV_IN_ATTN && l == 0 && F.G == 256 && F.vcu >= 32 && rep_ == 0) tail_convert(F, F.vcu - 32, 672, 3, 1344);
        } SEAM(pb + 2);
        if (KIND(5) && IN(pb + 3)) REPEAT(5, l == 0) {
            Strided<DecWout> S; S.d.Mb = (const char*)(F.ws + WS_MB); S.d.W = (const char*)(F.ws + WS_WOUT) + (size_t)l * DM * DM * 2; S.n = nrt * 4; S.G = F.G; S.vcu = F.vcu;
            EpiWout E; E.baseL = inptr(F, IN_X); E.baseC = inptr(F, IN_CTX) - (size_t)NLAT * DM; E.baseX = WSP(bf16, WS_X); E.X = WSP(bf16, WS_X); E.from_x = l != 0; E.mod = WSP(float, WS_MOD) + (size_t)l * 9 * 6 * DM;
            pg8::gemm_phase<EpiWout, Strided<DecWout>>(F.lds, (LAS int*)(F.lds + IDXBUF_OFF), S, E);
            if (!CONV_IN_ATTN && l == 0 && F.G == 256 && F.vcu >= 32 && rep_ == 0) tail_convert(F, F.vcu - 32, 1344, 3, 2016);
        } SEAM(pb + 3);
        if (KIND(6) && IN(pb + 4)) REPEAT(6, true) { pf_norm2_router(F, l, rep_ ? FPROBE_MODE : 0); } SEAM(pb + 4);
        if (KIND(7) && IN(pb + 5)) REPEAT(7, true) { pg_topk_gather(F, l); } SEAM(pb + 5);
        const int ert = lastl ? 8 : 9;
        if (KIND(8) && IN(pb + 6)) REPEAT(8, true) {
            Strided<DecGU> S; S.d.H2 = (const char*)(F.ws + WS_HN); S.d.IDX = WSP(int, WS_IDX); S.d.W = (const char*)(F.ws + WS_WGU) + (size_t)l * NE * 2 * DM * DM * 2; S.d.nrt = ert; S.n = NE * ert * 8; S.G = F.G; S.vcu = F.vcu;
            EpiGU E{WSP(bf16, WS_HACT)};
            pg8::gemm_phase<EpiGU, Strided<DecGU>>(F.lds, (LAS int*)(F.lds + IDXBUF_OFF), S, E);
            if (!CONV_IN_ATTN && l == 0 && F.G == 256 && F.vcu >= 128 && rep_ == 0) tail_convert(F, F.vcu - 128, 2016, 4, 2528);
        } SEAM(pb + 6);
        if (KIND(9) && IN(pb + 7)) REPEAT(9, true) {
            Strided<DecDown> S; S.d.H = (const char*)(F.ws + WS_HACT); S.d.W = (const char*)(F.ws + WS_WD) + (size_t)l * NE * DM * DM * 2; S.d.nrt = ert; S.n = NE * ert * 4; S.G = F.G; S.vcu = F.vcu;
            EpiDown E{WSP(bf16, WS_G), WSP(float, WS_AFS)};
            pg8::gemm_phase<EpiDown, Strided<DecDown>>(F.lds, (LAS int*)(F.lds + IDXBUF_OFF), S, E);
            if (!CONV_IN_ATTN && l == 0 && F.G == 256 && F.vcu >= 64 && rep_ == 0) tail_convert(F, F.vcu - 64, 2528, 3, CONV_ITEMS);
        } SEAM(pb + 7);
        if (KIND(10) && IN(pb + 8)) REPEAT(10, true) { pj_combine(F, l, rep_); }
        if (!lastl) SEAM(pb + 8);
    }
#undef IN
#undef SEAM
}

#ifdef DBG_STOP
__global__ void k_dump(const unsigned short* __restrict__ src, float* __restrict__ out, size_t n) {
    for (size_t i = (size_t)blockIdx.x * blockDim.x + threadIdx.x; i < n; i += (size_t)gridDim.x * blockDim.x) out[i] = __uint_as_float((unsigned)src[i] << 16);
}
#endif
extern "C" void kernel_launch(void* const* d_in, const int* in_sizes, int n_in, void* d_out, int out_size, void* d_ws, size_t ws_size, hipStream_t stream) {
    static int grid = 0;
    if (grid == 0) {
        if (n_in != 21 || out_size != NLAT * DM || ws_size < WS_END) { fprintf(stderr, "kernel_launch: unexpected problem (n_in %d, out %d, ws %zu < %zu)\n", n_in, out_size, ws_size, (size_t)WS_END); grid = -1; return; }
        int dev = 0, cus = 0, per_cu = 0;
        if (hipGetDevice(&dev) != hipSuccess || hipDeviceGetAttribute(&cus, hipDeviceAttributeMultiprocessorCount, dev) != hipSuccess) { grid = -1; return; }
        if (hipFuncSetAttribute((const void*)hybrid_fwd, hipFuncAttributeMaxDynamicSharedMemorySize, LDS_BYTES) != hipSuccess) { fprintf(stderr, "kernel_launch: hipFuncSetAttribute failed\n"); grid = -1; return; }
        if (hipOccupancyMaxActiveBlocksPerMultiprocessor(&per_cu, (const void*)hybrid_fwd, NWAVES * 64, LDS_BYTES) != hipSuccess || per_cu < 1) { fprintf(stderr, "kernel_launch: occupancy query says %d blocks/CU\n", per_cu); per_cu = 1; }
        (void)hipGetLastError();
        grid = cus * 1;
    }
    if (grid < 0) return;
    hipMemsetAsync((char*)d_ws + WS_CTL, 0, CTL_ZERO_BYTES, stream);
    Args a; memset(&a, 0, sizeof(a));
    for (int i = 0; i < 21; ++i) a.in[i] = (const float*)d_in[i];
    a.out = (float*)d_out; a.ws = (unsigned char*)d_ws;
#if MK_N_LAUNCHES == 1
    a.ph_lo = 0; a.ph_hi = N_PHASES;
    hipLaunchKernelGGL(hybrid_fwd, dim3(grid), dim3(NWAVES * 64), LDS_BYTES, stream, a);
#else
    int nph_ = N_PHASES;
#ifdef DBG_STOP
    nph_ = DBG_STOP;
#endif
    for (int p = 0; p < nph_; ++p) { a.ph_lo = p; a.ph_hi = p + 1; hipLaunchKernelGGL(hybrid_fwd, dim3(grid), dim3(NWAVES * 64), LDS_BYTES, stream, a);
#ifdef DBG_DUP_PHASE
        if (p == DBG_DUP_PHASE) { a.probe = DBG_PROBE; hipLaunchKernelGGL(hybrid_fwd, dim3(grid), dim3(NWAVES * 64), LDS_BYTES, stream, a); a.probe = 0; }
#endif
    }
#ifdef DBG_STOP
    hipLaunchKernelGGL(k_dump, dim3(2048), dim3(256), 0, stream, (const unsigned short*)((const char*)d_ws + ((size_t)DBG_DUMP_MIB << 20)), (float*)d_out, (size_t)NLAT * DM);
#endif
#endif
}
```

```cpp
#define MK_N_LAUNCHES 1
#include <hip/hip_runtime.h>
#include <hip/hip_bf16.h>
#include <cstdio>
#include <cstdint>
#include <cmath>
#include <cstring>

constexpr int DM = 1024, NBATCH = 8, SEQ = 2048, CTX = 256, DEPTH = 2;
constexpr int NLAT = NBATCH * SEQ, NCTX = NBATCH * CTX, NTOK = NLAT + NCTX;
constexpr int INW = 4608, NCOLT = 19, INW2 = NCOLT * 256;
constexpr int NE = 16, CAPL = 256, CAPC = 32, RPE = NBATCH * (CAPL + CAPC);
constexpr float EPS = 1e-6f;
constexpr float QSCALE = 0.125f * 1.4426950408889634f;
constexpr float LOG2E = 1.4426950408889634f;
namespace pg8 {
#define PG8_LAS __attribute__((address_space(3)))
typedef unsigned short bf16_t;
typedef short bf16x8 __attribute__((ext_vector_type(8)));
typedef float f32x4 __attribute__((ext_vector_type(4)));
typedef unsigned u32x4 __attribute__((ext_vector_type(4)));
typedef unsigned u32x2 __attribute__((ext_vector_type(2)));
constexpr int BM = 256, BK = 64, HALF = 128, HTB = HALF * BK * 2  , STAGE_BYTES = 8 * HTB;

__host__ __device__ __forceinline__ int lds_byte(int r, int c) { const int st = (r >> 4) * 2 + (c >> 5), rr = r & 15, cc = c & 31, ob = rr * 64 + cc * 2; return st * 1024 + (ob ^ (((ob >> 9) & 1) << 5)); }
__host__ __device__ __forceinline__ int perm32(int rho) { const int n = rho >> 4, i = rho & 15; return 8 * (i >> 2) + 4 * n + (i & 3); }
__host__ __device__ __forceinline__ void stage_rc(int b, int& R, int& C) { const int st = b / 1024, sb = b % 1024, swz = sb ^ (((sb >> 9) & 1) << 5); R = (st >> 1) * 16 + swz / 64; C = (st & 1) * 32 + (swz % 64) / 2; }

struct Unit { const char* A; const char* B; const int* arows; int ldA, ldB, nt; int pm, pn, tag; };

typedef float f32x2_c __attribute__((ext_vector_type(2)));
typedef __bf16 bf16x2_c __attribute__((ext_vector_type(2)));
__device__ __forceinline__ unsigned cvt_pk_bf16(float lo, float hi) { const f32x2_c v = {lo, hi}; const bf16x2_c b = __builtin_convertvector(v, bf16x2_c); return __builtin_bit_cast(unsigned, b); }

template <class Epi, class Sched>
__device__ __forceinline__ void gemm_phase(PG8_LAS unsigned char* lds, PG8_LAS int* idxbuf  , const Sched& S, const Epi& E) {
    int tid = threadIdx.x; asm volatile("" : "+v"(tid));
    const int wid = __builtin_amdgcn_readfirstlane(tid >> 6), lane = tid & 63, wr = wid >> 2, wc = wid & 3, fr = lane & 15, fq = lane >> 4;
    unsigned Rr[2], RrB[2], Cc2[2];
#pragma unroll
    for (int i = 0; i < 2; ++i) { int R, C; stage_rc(tid * 16 + i * 8192, R, C); Rr[i] = (unsigned)R; RrB[i] = Epi::PERM ? (unsigned)((R & ~31) + perm32(R & 31)) : (unsigned)R; Cc2[i] = (unsigned)C * 2u; }
    const size_t kstep = (size_t)(BK * 2);
    const unsigned ldsw = (unsigned)wid * 1024u;
    const int aoff = lds_byte(wr * 64 + fr, fq * 8), boff = lds_byte(wc * 32 + fr, fq * 8);
#define PG8_SA(b, h) (((b) * 2 + (h)) * HTB)
#define PG8_SB(b, h) ((4 + (b) * 2 + (h)) * HTB)
#define PG8_STAGE(bufoff, gbase, ld) do { _Pragma("unroll") for (int _i = 0; _i < 2; ++_i) \
        __builtin_amdgcn_global_load_lds((const unsigned*)((const char*)(gbase) + (RrB[_i] * (unsigned)(ld) + Cc2[_i])), (PG8_LAS unsigned*)(lds + (bufoff) + ldsw + _i * 8192), 16, 0, 0); } while (0)
#define PG8_STAGE_A(bufoff, gbase, ao) do { _Pragma("unroll") for (int _i = 0; _i < 2; ++_i) \
        __builtin_amdgcn_global_load_lds((const unsigned*)((const char*)(gbase) + (ao)[_i]), (PG8_LAS unsigned*)(lds + (bufoff) + ldsw + _i * 8192), 16, 0, 0); } while (0)
#define PG8_AOFF(u, ao) do { _Pragma("unroll") for (int _h = 0; _h < 2; ++_h) _Pragma("unroll") for (int _i = 0; _i < 2; ++_i) { \
        const unsigned _row = (u).arows ? (unsigned)idxbuf[Rr[_i] + 128 * _h] : Rr[_i] + 128u * _h; (ao)[_h][_i] = _row * (unsigned)(u).ldA + Cc2[_i]; } } while (0)
#define PG8_STAGE_IDX(u) do { if ((u).arows) __builtin_amdgcn_global_load_lds((const unsigned*)((u).arows + (wid & 3) * 64 + lane), (PG8_LAS unsigned*)((PG8_LAS unsigned char*)idxbuf + (wid & 3) * 256), 4, 0, 0); } while (0)
#define PG8_LDA(dst, b, h) do { _Pragma("unroll") for (int m = 0; m < 4; ++m) _Pragma("unroll") for (int k = 0; k < 2; ++k) dst[m][k] = *(const PG8_LAS bf16x8*)(lds + PG8_SA(b, h) + aoff + m * 2048 + k * 1024); } while (0)
#define PG8_LDB(dst, b, h) do { _Pragma("unroll") for (int n = 0; n < 2; ++n) _Pragma("unroll") for (int k = 0; k < 2; ++k) dst[n][k] = *(const PG8_LAS bf16x8*)(lds + PG8_SB(b, h) + boff + n * 2048 + k * 1024); } while (0)
#define PG8_MMA(ai, bj, At, Bt) do { __builtin_amdgcn_s_setprio(1); _Pragma("unroll") for (int m = 0; m < 4; ++m) _Pragma("unroll") for (int n = 0; n < 2; ++n) _Pragma("unroll") for (int k = 0; k < 2; ++k) \
        acc[ai][bj][m][n] = __builtin_amdgcn_mfma_f32_16x16x32_bf16(Bt[n][k], At[m][k], acc[ai][bj][m][n], 0, 0, 0); __builtin_amdgcn_s_setprio(0); } while (0)
#define PG8_WAIT_V(n) asm volatile("s_waitcnt vmcnt(" #n ")" ::: "memory")
#define PG8_WAIT_L(n) asm volatile("s_waitcnt lgkmcnt(" #n ")" ::: "memory")
#define PG8_BAR __builtin_amdgcn_s_barrier()
#define PG8_SCHED __builtin_amdgcn_sched_barrier(0)
    Unit cur, nxt; int ui = 0;
    if (!S.next(0, cur)) return;
    nxt = cur;
    f32x4 acc[2][2][4][2];
#pragma unroll
    for (int a = 0; a < 2; ++a)
#pragma unroll
        for (int b = 0; b < 2; ++b)
#pragma unroll
            for (int m = 0; m < 4; ++m)
#pragma unroll
                for (int n = 0; n < 2; ++n) acc[a][b][m][n] = (f32x4){0.f, 0.f, 0.f, 0.f};
    bf16x8 At[4][2], B0[2][2], B1[2][2];
    const char* cA = cur.A; const char* cB = cur.B; int clb = cur.ldB;
    unsigned ao_c[2][2], ao_n[2][2];
    if (cur.arows) { PG8_STAGE_IDX(cur); PG8_WAIT_V(0); PG8_BAR; }
    PG8_AOFF(cur, ao_c);
#pragma unroll
    for (int _h = 0; _h < 2; ++_h)
#pragma unroll
        for (int _i = 0; _i < 2; ++_i) ao_n[_h][_i] = ao_c[_h][_i];
    if (cur.arows) { PG8_WAIT_L(0); PG8_BAR; }
    {
        const size_t hB = (size_t)HALF * clb;
        PG8_STAGE(PG8_SB(0, 0), cB, clb); PG8_STAGE(PG8_SB(0, 1), cB + hB, clb); PG8_STAGE_A(PG8_SA(0, 0), cA, ao_c[0]); PG8_STAGE_A(PG8_SA(0, 1), cA, ao_c[1]);
        if (wr == 1) PG8_BAR;
        PG8_WAIT_V(2); PG8_BAR;
        PG8_STAGE(PG8_SB(1, 0), cB + kstep, clb); PG8_STAGE_A(PG8_SA(1, 0), cA + kstep, ao_c[0]); PG8_STAGE(PG8_SB(1, 1), cB + hB + kstep, clb);
        PG8_WAIT_V(6); PG8_BAR;
    }
    for (;;) {
        const bool has_next = S.next(ui + 1, nxt);
        const char* nA = has_next ? nxt.A : cA; const char* nB = has_next ? nxt.B : cB; const int nlb = has_next ? nxt.ldB : clb;
        const int nt = cur.nt;
        if (has_next) PG8_STAGE_IDX(nxt);
        for (int t = 0; t < nt; t += 2) {
            const bool last = (t == nt - 2);
            if (last) { if (has_next) { PG8_AOFF(nxt, ao_n); } else {
#pragma unroll
                for (int _h = 0; _h < 2; ++_h)
#pragma unroll
                    for (int _i = 0; _i < 2; ++_i) ao_n[_h][_i] = ao_c[_h][_i]; } }
            unsigned ao2[2][2];
#pragma unroll
            for (int _h = 0; _h < 2; ++_h)
#pragma unroll
                for (int _i = 0; _i < 2; ++_i) ao2[_h][_i] = last ? ao_n[_h][_i] : ao_c[_h][_i];
            const char* a1 = cA + (size_t)(t + 1) * kstep;
            const char* a2 = last ? nA : cA + (size_t)(t + 2) * kstep; const char* b2 = last ? nB : cB + (size_t)(t + 2) * kstep;
            const int lb2 = last ? nlb : clb;
            const size_t hB2 = (size_t)HALF * lb2;
            const char* a3 = a2 + kstep; const char* b3 = b2 + kstep;
            PG8_LDB(B0, 0, 0); PG8_LDB(B1, 0, 1); PG8_SCHED; PG8_LDA(At, 0, 0); PG8_STAGE_A(PG8_SA(1, 1), a1, ao_c[1]);
            PG8_WAIT_V(8); PG8_WAIT_L(0); PG8_BAR; PG8_MMA(0, 0, At, B0); PG8_MMA(0, 1, At, B1); PG8_BAR; PG8_SCHED;
            PG8_LDA(At, 0, 1); PG8_STAGE(PG8_SB(0, 0), b2, lb2); PG8_STAGE(PG8_SB(0, 1), b2 + hB2, lb2); PG8_STAGE_A(PG8_SA(0, 0), a2, ao2[0]);
            PG8_WAIT_V(8); PG8_WAIT_L(0); PG8_BAR; PG8_MMA(1, 0, At, B0); PG8_MMA(1, 1, At, B1); PG8_BAR; PG8_SCHED;
            PG8_LDB(B0, 1, 0); PG8_LDB(B1, 1, 1); PG8_SCHED; PG8_LDA(At, 1, 0); PG8_STAGE_A(PG8_SA(0, 1), a2, ao2[1]);
            PG8_WAIT_V(8); PG8_WAIT_L(0); PG8_BAR; PG8_MMA(0, 0, At, B0); PG8_MMA(0, 1, At, B1); PG8_BAR; PG8_SCHED;
            PG8_LDA(At, 1, 1); PG8_STAGE(PG8_SB(1, 0), b3, lb2); PG8_STAGE(PG8_SB(1, 1), b3 + hB2, lb2); PG8_STAGE_A(PG8_SA(1, 0), a3, ao2[0]);
            PG8_WAIT_V(8); PG8_WAIT_L(0); PG8_BAR; PG8_MMA(1, 0, At, B0); PG8_MMA(1, 1, At, B1); PG8_BAR; PG8_SCHED;
        }
        if (wr == 0) PG8_BAR;
        bool keep_acc;
        { Unit eu = cur; int ewr = wr, ewc = wc, efr = fr, efq = fq; asm volatile("" : "+s"(eu.pm), "+s"(eu.pn), "+s"(eu.tag), "+s"(ewr), "+s"(ewc), "+v"(efr), "+v"(efq));
          keep_acc = E(acc, eu, ewr, ewc, efr, efq); }
        if (!has_next) break;
        if (!keep_acc) {
#pragma unroll
        for (int a = 0; a < 2; ++a)
#pragma unroll
            for (int b = 0; b < 2; ++b)
#pragma unroll
                for (int m = 0; m < 4; ++m)
#pragma unroll
                    for (int n = 0; n < 2; ++n) acc[a][b][m][n] = (f32x4){0.f, 0.f, 0.f, 0.f};
        }
        cur = nxt; cA = nA; cB = nB; clb = nlb; ++ui;
#pragma unroll
        for (int _h = 0; _h < 2; ++_h)
#pragma unroll
            for (int _i = 0; _i < 2; ++_i) ao_c[_h][_i] = ao_n[_h][_i];
        if (wr == 1) PG8_BAR;
    }
    PG8_WAIT_V(0);
    PG8_BAR;
#undef PG8_SA
#undef PG8_SB
#undef PG8_STAGE
#undef PG8_STAGE_A
#undef PG8_AOFF
#undef PG8_STAGE_IDX
#undef PG8_LDA
#undef PG8_LDB
#undef PG8_MMA
#undef PG8_WAIT_V
#undef PG8_WAIT_L
#undef PG8_BAR
#undef PG8_SCHED
}
}
#include <hip/hip_bf16.h>
#include <cmath>
namespace attn_body {
using bf16=__hip_bfloat16;
using bf16x8=__attribute__((ext_vector_type(8)))short;
using s16x4=__attribute__((ext_vector_type(4)))short;
using f32x16=__attribute__((ext_vector_type(16)))float;
using u32x4=__attribute__((ext_vector_type(4)))unsigned;
constexpr int D=64;
constexpr int NW=8,QBLK=32,KVBLK=64,NCT=4;
__device__ __forceinline__ int crow(int r,int hi){return (r&3)+8*(r>>2)+4*hi;}
#define SBAR() __builtin_amdgcn_sched_barrier(0)
__device__ __forceinline__ void wmask(f32x16&p0,f32x16&p1,int kb,int qabs,int hi){
  const float NEG=-INFINITY; const int d0=kb+4*hi-qabs;
  #pragma unroll
  for(int r=0;r<16;++r){int dd=d0+(r&3)+8*(r>>2); if(dd>128||dd<-128)p0[r]=NEG; if(dd+32>128||dd+32<-128)p1[r]=NEG;}
}

constexpr int NSLOT=3, SLOTB=8192;
constexpr int LDS_K=0, LDS_V=NSLOT*SLOTB, LDS_WS=2*NSLOT*SLOTB, LDS_OST=LDS_WS+NW*64*4, LDS_BYTES=LDS_OST+NW*4096;
__device__ __forceinline__ void glds16(const void*gsrc,unsigned lds_dst){unsigned keep;
  asm volatile("s_mov_b32 %0, m0\n\ts_mov_b32 m0, %2\n\ts_nop 0\n\tglobal_load_lds_dwordx4 %1, off\n\ts_mov_b32 m0, %0":"=&s"(keep):"v"(gsrc),"s"(lds_dst):"memory");}
__device__ __forceinline__ float max3f(float a,float b,float c){float r;asm("v_max3_f32 %0, %1, %2, %3":"=v"(r):"v"(a),"v"(b),"v"(c));return r;}
__device__ __forceinline__ float max2f(float a,float b){float r;asm("v_max_f32_e32 %0, %1, %2":"=v"(r):"v"(a),"v"(b));return r;}
__device__ __forceinline__ float fadd_s(float a,float b){float r;asm("v_add_f32_e32 %0, %1, %2":"=v"(r):"v"(a),"v"(b));return r;}
__device__ __forceinline__ float fsub_s(float a,float b){float r;asm("v_sub_f32_e32 %0, %1, %2":"=v"(r):"v"(a),"v"(b));return r;}
typedef float f32x2_t __attribute__((ext_vector_type(2))); typedef __bf16 bf16x2_t __attribute__((ext_vector_type(2)));
__device__ __forceinline__ unsigned cvtpk_s(float lo,float hi){f32x2_t v={lo,hi};bf16x2_t b=__builtin_convertvector(v,bf16x2_t);return __builtin_bit_cast(unsigned,b);}
#define WAIT_BAR(N) asm volatile("s_waitcnt vmcnt(" #N ") lgkmcnt(0)\n\ts_barrier":::"memory")

__device__ __forceinline__ void qkt(f32x16&p0,f32x16&p1,const char*Kslot,const bf16x8*qr,const f32x16&negm,int r32,int hi){
  const char*kb=Kslot+hi*1024+r32*16;
  #pragma unroll
  for(int d0=0;d0<4;++d0){
    const bf16x8 b0=*reinterpret_cast<const bf16x8*>(kb+d0*2048);
    const bf16x8 b1=*reinterpret_cast<const bf16x8*>(kb+d0*2048+512);
    if(d0==0){p0=__builtin_amdgcn_mfma_f32_32x32x16_bf16(b0,qr[0],negm,0,0,0);p1=__builtin_amdgcn_mfma_f32_32x32x16_bf16(b1,qr[0],negm,0,0,0);}
    else{p0=__builtin_amdgcn_mfma_f32_32x32x16_bf16(b0,qr[d0],p0,0,0,0);p1=__builtin_amdgcn_mfma_f32_32x32x16_bf16(b1,qr[d0],p1,0,0,0);}}
}
typedef __attribute__((address_space(3))) const char* lds_cptr;
typedef short v4i16_t __attribute__((ext_vector_type(4)));
__device__ __forceinline__ void kload8(bf16x8*kf,lds_cptr kp){
  kf[0]=*(const __attribute__((address_space(3))) bf16x8*)(kp);      kf[1]=*(const __attribute__((address_space(3))) bf16x8*)(kp+512);
  kf[2]=*(const __attribute__((address_space(3))) bf16x8*)(kp+2048); kf[3]=*(const __attribute__((address_space(3))) bf16x8*)(kp+2560);
  kf[4]=*(const __attribute__((address_space(3))) bf16x8*)(kp+4096); kf[5]=*(const __attribute__((address_space(3))) bf16x8*)(kp+4608);
  kf[6]=*(const __attribute__((address_space(3))) bf16x8*)(kp+6144); kf[7]=*(const __attribute__((address_space(3))) bf16x8*)(kp+6656);
}
__device__ __forceinline__ void kload2(bf16x8*kf,lds_cptr kp,int j){ kf[2*j]=*(const __attribute__((address_space(3))) bf16x8*)(kp+j*2048); kf[2*j+1]=*(const __attribute__((address_space(3))) bf16x8*)(kp+j*2048+512); }
__device__ __forceinline__ s16x4 vtr(lds_cptr p){ return __builtin_bit_cast(s16x4,__builtin_amdgcn_ds_read_tr16_b64_v4i16((__attribute__((address_space(3))) v4i16_t*)p)); }
__device__ __forceinline__ float rowmax(const f32x16&p0,const f32x16&p1){
  float a=max3f(p0[0],p0[1],p1[0]),b=max3f(p0[2],p0[3],p1[1]);a=max3f(a,p1[2],p1[3]);
  #pragma unroll
  for(int r=4;r<16;r+=4){a=max3f(a,p0[r],p0[r+1]);b=max3f(b,p0[r+2],p0[r+3]);a=max3f(a,p1[r],p1[r+1]);b=max3f(b,p1[r+2],p1[r+3]);}
  const float m=max2f(a,b);
  auto rr=__builtin_amdgcn_permlane32_swap(__float_as_uint(m),__float_as_uint(m),false,false);
  return max2f(__uint_as_float(rr[0]),__uint_as_float(rr[1]));
}
__device__ __forceinline__ void pv(f32x16*o,int vb,bf16x8 pa0,bf16x8 pa1,bf16x8 pa2,bf16x8 pa3){
  #pragma unroll
  for(int d0=0;d0<2;++d0){s16x4 lo[4],hi[4];
    #pragma unroll
    for(int ks=0;ks<4;++ks){
      asm volatile("ds_read_b64_tr_b16 %0,%1 offset:%c2":"=&v"(lo[ks]):"v"(vb),"i"(d0*4096+ks*1024):"memory");
      asm volatile("ds_read_b64_tr_b16 %0,%1 offset:%c2":"=&v"(hi[ks]):"v"(vb),"i"(d0*4096+ks*1024+512):"memory");}
    asm volatile("s_waitcnt lgkmcnt(0)":::"memory");SBAR();
    #define PK(k) (bf16x8){lo[k][0],lo[k][1],lo[k][2],lo[k][3],hi[k][0],hi[k][1],hi[k][2],hi[k][3]}
    o[d0]=__builtin_amdgcn_mfma_f32_32x32x16_bf16(pa0,PK(0),o[d0],0,0,0);
    o[d0]=__builtin_amdgcn_mfma_f32_32x32x16_bf16(pa1,PK(1),o[d0],0,0,0);
    o[d0]=__builtin_amdgcn_mfma_f32_32x32x16_bf16(pa2,PK(2),o[d0],0,0,0);
    o[d0]=__builtin_amdgcn_mfma_f32_32x32x16_bf16(pa3,PK(3),o[d0],0,0,0);
    #undef PK
  }
}

#ifndef ATTN_STORE16
#define ATTN_STORE16(p,v) (*(u32x4*)(p)=(v))
#endif
template<int MODE,int THRL> __device__ __forceinline__ void attn_unit(const bf16*Qw,int qp,const bf16*Kc,const bf16*Kl,const bf16*Vc,const bf16*Vl,int kp,int NT,int qabs,int band0,float sinkl2,bf16*Ow,int op,char*shm){
  int tid=threadIdx.x; asm volatile("":"+v"(tid));
  const int lane=tid&63,r32=lane&31,hi=lane>>5; const int wid=__builtin_amdgcn_readfirstlane(tid>>6);
  qabs+=r32;
  const unsigned lds0=(unsigned)(uintptr_t)shm;
  float*wsf=(float*)(shm+LDS_WS)+wid*64;
  const unsigned koff_=(unsigned)(lane*kp+wid*8)*2u;
  const unsigned voff_=(unsigned)((16*(wid&3)+(lane>>2))*kp+(wid>>2)*32+(lane&3)*8)*2u;
  const unsigned kdst=lds0+LDS_K+wid*1024, vdst=lds0+LDS_V+wid*1024;
  #define DMA_K(t,slot) glds16((const char*)((t)<NCT?Kc+(long)(t)*KVBLK*kp:Kl+(long)((t)-NCT)*KVBLK*kp)+koff_,(unsigned)__builtin_amdgcn_readfirstlane(kdst+(slot)))
  #define DMA_V(t,slot) glds16((const char*)((t)<NCT?Vc+(long)(t)*KVBLK*kp:Vl+(long)((t)-NCT)*KVBLK*kp)+voff_,(unsigned)__builtin_amdgcn_readfirstlane(vdst+(slot)))
  const int vb0=(int)(lds0+LDS_V)+((lane>>4)&1)*32+(lane&3)*8+(4*hi+((lane&15)>>2))*64;
  const char*Kbase=shm+LDS_K; bf16x8 kf[8];
  const lds_cptr shm3=(lds_cptr)shm; const lds_cptr kp0=shm3+LDS_K+hi*1024+r32*16; const lds_cptr vp0=shm3+LDS_V+((lane>>4)&1)*32+(lane&3)*8+(4*hi+((lane&15)>>2))*64;
  DMA_K(0,0);DMA_V(0,0);DMA_K(1,SLOTB);
  bf16x8 qr[4];
  #pragma unroll
  for(int d0=0;d0<4;++d0)qr[d0]=*reinterpret_cast<const bf16x8*>(&Qw[(long)r32*qp+d0*16+hi*8]);
  float mhat=0.f,l_reg=0.f;f32x16 o[2];o[0]=f32x16{};o[1]=f32x16{};f32x16 negm=f32x16{};asm volatile("":"+v"(negm));
  #define CMASK(P0,P1,t) do{ if(MODE==1){ if((t)>=NCT)wmask(P0,P1,band0+KVBLK*((t)-NCT),qabs,hi);} }while(0)
  bool resc=false;
  #define START(P0,P1) do{ const float rm=rowmax(P0,P1); resc=false; \
    { const float dl=rm; mhat=fadd_s(mhat,dl); \
      _Pragma("unroll") for(int r=0;r<16;++r){P0[r]=fsub_s(P0[r],dl);P1[r]=fsub_s(P1[r],dl);} \
      _Pragma("unroll") for(int r=0;r<16;++r)negm[r]=-mhat; asm volatile("":"+v"(negm)); } \
    _Pragma("unroll") for(int r=0;r<16;++r)P0[r]=__builtin_amdgcn_exp2f(P0[r]); }while(0)
  #define RESC() do{ if(resc){ asm volatile("s_waitcnt lgkmcnt(0)":::"memory"); \
      _Pragma("unroll") for(int d_=0;d_<2;++d_) _Pragma("unroll") for(int r=0;r<16;++r)o[d_][r]*=wsf[crow(r,hi)]; } }while(0)
  f32x16 pA0,pA1,pB0,pB1;
  int sl_prev=0,sl_cur=0,sl_next=SLOTB;
  #define ROT() do{sl_prev=sl_cur;sl_cur=sl_next;sl_next=(sl_next==(NSLOT-1)*SLOTB)?0:sl_next+SLOTB;}while(0)
  DMA_K(2,2*SLOTB);
  WAIT_BAR(3);
  qkt(pA0,pA1,Kbase,qr,negm,r32,hi);asm volatile("s_nop 15\n\ts_nop 7":"+v"(pA0),"+v"(pA1));CMASK(pA0,pA1,0);
  START(pA0,pA1);
  _Pragma("unroll") for(int r=0;r<16;++r)pA1[r]=__builtin_amdgcn_exp2f(pA1[r]);
  WAIT_BAR(0);
  DMA_K(3,0);DMA_V(1,SLOTB);
  ROT();
  kload8(kf,kp0+sl_cur);
  WAIT_BAR(2);
  s16x4 vlo[8],vhi[8]; u32x4 pw0,pw1,pw2,pw3;
  #define PKW(P,B) cvtpk_s(P[B],P[B+1])
  #define PAF(k) __builtin_bit_cast(bf16x8,pw##k)
  #define VFR(i) (bf16x8){vlo[i][0],vlo[i][1],vlo[i][2],vlo[i][3],vhi[i][0],vhi[i][1],vhi[i][2],vhi[i][3]}
  #define PIN(x) asm volatile("":"+v"(x))
  #define MX3(a,b,c) __builtin_fmaxf(__builtin_fmaxf((a),(b)),(c))
  #define GAPA(MF,A0,A1,A2,A3,W0,W1,PW) do{ MF; sacc+=A0; sacc+=A1; sacc+=A2; sacc+=A3; PIN(sacc); W0; W1; PIN(PW); SBAR(); }while(0)
  #define EX(v) __builtin_amdgcn_exp2f(v)
  #define GAPB(MF,X,B) do{ MF; X[B]=EX(X[B]); X[B+1]=EX(X[B+1]); X[B+2]=EX(X[B+2]); X[B+3]=EX(X[B+3]); PIN(X); SBAR(); }while(0)
  #define VRD(i) do{ vlo[i]=vtr(vp_+(((i)>>2)*4096+((i)&3)*1024)); vhi[i]=vtr(vp_+(((i)>>2)*4096+((i)&3)*1024+512)); }while(0)
  #define KRD(G,j) do{ if(G){ kload2(kf,kp0+sl_next,j); SBAR(); } }while(0)
  #define STEP(C0,C1,P0,P1,t,GK,GV,GL) do{ SBAR(); \
    const lds_cptr vp_=vp0+sl_prev; \
    VRD(0); SBAR(); float sacc=(P0[0]+P0[1]); \
    GAPA(C0=__builtin_amdgcn_mfma_f32_32x32x16_bf16(kf[0],qr[0],negm,0,0,0), P0[2],P0[3],P0[4],P0[5],     pw0[0]=PKW(P0,0), pw0[1]=PKW(P0,2), pw0); \
    VRD(4); SBAR(); GAPA(C1=__builtin_amdgcn_mfma_f32_32x32x16_bf16(kf[1],qr[0],negm,0,0,0), P0[6],P0[7],P0[8],P0[9],     pw0[2]=PKW(P0,4), pw0[3]=PKW(P0,6), pw0); \
    VRD(1); SBAR(); GAPA(C0=__builtin_amdgcn_mfma_f32_32x32x16_bf16(kf[2],qr[1],C0,0,0,0),   P0[10],P0[11],P0[12],P0[13], pw1[0]=PKW(P0,8), pw1[1]=PKW(P0,10), pw1); \
    VRD(5); SBAR(); GAPA(C1=__builtin_amdgcn_mfma_f32_32x32x16_bf16(kf[3],qr[1],C1,0,0,0),   P0[14],P0[15],P1[0],P1[1],   pw1[2]=PKW(P0,12),pw1[3]=PKW(P0,14), pw1); \
    VRD(2); SBAR(); GAPA(C0=__builtin_amdgcn_mfma_f32_32x32x16_bf16(kf[4],qr[2],C0,0,0,0),   P1[2],P1[3],P1[4],P1[5],     pw2[0]=PKW(P1,0), pw2[1]=PKW(P1,2), pw2); \
    VRD(6); SBAR(); GAPA(C1=__builtin_amdgcn_mfma_f32_32x32x16_bf16(kf[5],qr[2],C1,0,0,0),   P1[6],P1[7],P1[8],P1[9],     pw2[2]=PKW(P1,4), pw2[3]=PKW(P1,6), pw2); \
    VRD(3); SBAR(); GAPA(C0=__builtin_amdgcn_mfma_f32_32x32x16_bf16(kf[6],qr[3],C0,0,0,0),   P1[10],P1[11],P1[12],P1[13], pw3[0]=PKW(P1,8), pw3[1]=PKW(P1,10), pw3); \
    VRD(7); SBAR(); GAPA(C1=__builtin_amdgcn_mfma_f32_32x32x16_bf16(kf[7],qr[3],C1,0,0,0),   P1[14],P1[15],0.f,0.f,       pw3[2]=PKW(P1,12),pw3[3]=PKW(P1,14), pw3); \
    l_reg+=sacc; \
    if(GK){DMA_K((t)+3,sl_cur);} if(GV){DMA_V((t)+1,sl_next);} \
    CMASK(C0,C1,t); \
    { float a=MX3(C0[0],C0[1],C1[0]),b=MX3(C0[2],C0[3],C1[1]); a=MX3(a,C1[2],C1[3]); \
      _Pragma("unroll") for(int r=4;r<16;r+=4){a=MX3(a,C0[r],C0[r+1]);b=MX3(b,C0[r+2],C0[r+3]);a=MX3(a,C1[r],C1[r+1]);b=MX3(b,C1[r+2],C1[r+3]);} \
      float rm=__builtin_fmaxf(a,b); { auto rr=__builtin_amdgcn_permlane32_swap(__float_as_uint(rm),__float_as_uint(rm),false,false); rm=__builtin_fmaxf(__uint_as_float(rr[0]),__uint_as_float(rr[1])); } \
      resc=false; \
      if(__builtin_expect(__any(rm>(float)THRL),0)){ const float dl=__builtin_fmaxf(rm,0.f); mhat+=dl; \
        _Pragma("unroll") for(int r=0;r<16;++r){C0[r]-=dl;C1[r]-=dl;} \
        _Pragma("unroll") for(int r=0;r<16;++r)negm[r]=-mhat; asm volatile("":"+v"(negm)); \
        const float f=__builtin_amdgcn_exp2f(-dl); l_reg*=f; if(hi==0)wsf[r32]=f; resc=true; } } \
    SBAR(); \
    GAPB(o[0]=__builtin_amdgcn_mfma_f32_32x32x16_bf16(PAF(0),VFR(0),o[0],0,0,0), C0,0); \
    GAPB(o[1]=__builtin_amdgcn_mfma_f32_32x32x16_bf16(PAF(0),VFR(4),o[1],0,0,0), C0,4); \
    KRD(GL,0); GAPB(o[0]=__builtin_amdgcn_mfma_f32_32x32x16_bf16(PAF(1),VFR(1),o[0],0,0,0), C0,8); \
    KRD(GL,1); GAPB(o[1]=__builtin_amdgcn_mfma_f32_32x32x16_bf16(PAF(1),VFR(5),o[1],0,0,0), C0,12); \
    KRD(GL,2); GAPB(o[0]=__builtin_amdgcn_mfma_f32_32x32x16_bf16(PAF(2),VFR(2),o[0],0,0,0), C1,0); \
    KRD(GL,3); GAPB(o[1]=__builtin_amdgcn_mfma_f32_32x32x16_bf16(PAF(2),VFR(6),o[1],0,0,0), C1,4); \
    GAPB(o[0]=__builtin_amdgcn_mfma_f32_32x32x16_bf16(PAF(3),VFR(3),o[0],0,0,0), C1,8); \
    GAPB(o[1]=__builtin_amdgcn_mfma_f32_32x32x16_bf16(PAF(3),VFR(7),o[1],0,0,0), C1,12); \
    }while(0)
  int t=1;
  for(;t+5<NT;t+=2){
    STEP(pB0,pB1,pA0,pA1,t,true,true,true);     WAIT_BAR(2); RESC(); ROT();
    STEP(pA0,pA1,pB0,pB1,t+1,true,true,true);   WAIT_BAR(2); RESC(); ROT();
  }
  #define ENDW(tt) do{ if((tt)+3<NT){WAIT_BAR(2);} else if((tt)+2<NT){WAIT_BAR(1);} else {WAIT_BAR(0);} }while(0)
  for(;t+1<NT;t+=2){
    STEP(pB0,pB1,pA0,pA1,t,(t+3<NT),(t+1<NT),(t+1<NT));       ENDW(t);   RESC(); ROT();
    STEP(pA0,pA1,pB0,pB1,t+1,(t+4<NT),(t+2<NT),(t+2<NT));     ENDW(t+1); RESC(); ROT();
  }
  STEP(pB0,pB1,pA0,pA1,NT-1,false,false,false); RESC();
  { float sacc=pB0[0]+pB0[1]; _Pragma("unroll") for(int r=2;r<16;++r)sacc+=pB0[r]; _Pragma("unroll") for(int r=0;r<16;++r)sacc+=pB1[r]; l_reg+=sacc;
    pw0=(u32x4){PKW(pB0,0),PKW(pB0,2),PKW(pB0,4),PKW(pB0,6)};pw1=(u32x4){PKW(pB0,8),PKW(pB0,10),PKW(pB0,12),PKW(pB0,14)};pw2=(u32x4){PKW(pB1,0),PKW(pB1,2),PKW(pB1,4),PKW(pB1,6)};pw3=(u32x4){PKW(pB1,8),PKW(pB1,10),PKW(pB1,12),PKW(pB1,14)};
    SBAR(); pv(o,vb0+sl_cur,PAF(0),PAF(1),PAF(2),PAF(3)); }
  #undef PKW
  #undef PAF
  #undef VFR
  #undef PIN
  #undef MX3
  #undef GAPA
  #undef GAPB
  #undef EX
  #undef VRD
  #undef KRD
  #undef STEP
  #undef ENDW
  {auto rr=__builtin_amdgcn_permlane32_swap(__float_as_uint(l_reg),__float_as_uint(l_reg),false,false);l_reg=__uint_as_float(rr[0])+__uint_as_float(rr[1]);}
  if(MODE==1)l_reg+=__builtin_amdgcn_exp2f(sinkl2-mhat);
  if(hi==0)wsf[32+r32]=l_reg;asm volatile("s_waitcnt lgkmcnt(0)":::"memory");
  float rli[16];
  #pragma unroll
  for(int r=0;r<16;++r)rli[r]=__builtin_amdgcn_rcpf(wsf[32+crow(r,hi)]);
  { bf16*stg=(bf16*)(shm+LDS_OST)+wid*2048;
    #pragma unroll
    for(int r=0;r<16;++r){const int orow=crow(r,hi);
      #pragma unroll
      for(int d0=0;d0<2;++d0)stg[orow*64+d0*32+r32]=__float2bfloat16(o[d0][r]*rli[r]);}
    asm volatile("s_waitcnt lgkmcnt(0)":::"memory");
    #pragma unroll
    for(int i=0;i<4;++i){const int row=i*8+(lane>>3),ch=lane&7; const u32x4 v=*(const u32x4*)(stg+row*64+ch*8); ATTN_STORE16(Ow+(long)row*op+ch*8,v);} }
  asm volatile("s_waitcnt lgkmcnt(0)\n\ts_barrier":::"memory");
  #undef DMA_K
  #undef DMA_V
  #undef CMASK
  #undef START
  #undef RESC
  #undef ROT
}
constexpr int ATTN_LDS_BYTES=LDS_BYTES;
#undef SBAR
#undef WAIT_BAR
}
constexpr int NWAVES = 8;
constexpr size_t MiB = 1u << 20;
constexpr size_t WS_CTL = 0, CTL_ZERO_BYTES = 256 * 1024;
constexpr size_t WS_MOD = 1 * MiB;
constexpr size_t WS_ROPE = WS_MOD + 512 * 1024;
constexpr size_t WS_AFS = WS_ROPE + 64 * 1024;
constexpr size_t WS_IDX = WS_AFS + 192 * 1024;
constexpr size_t WS_SEL = 2 * MiB;
constexpr size_t WS_AFF = 4 * MiB;
constexpr size_t WS_ABTC = WS_AFF;
constexpr size_t WS_WIN = 6 * MiB;
constexpr size_t WS_WBR = 25 * MiB;
constexpr size_t WS_WOUT = 29 * MiB;
constexpr size_t WS_DFT = 33 * MiB;
constexpr size_t WS_DFTC = 49 * MiB;
constexpr size_t WS_WGU = 50 * MiB;
constexpr size_t WS_WD = 178 * MiB;
constexpr size_t WS_X = 242 * MiB;
constexpr size_t WS_HN = 314 * MiB;
constexpr size_t WS_MB = WS_HN;
constexpr size_t WS_QKV = 350 * MiB;
constexpr size_t WS_G = 395 * MiB;
constexpr size_t WS_BR = 503 * MiB;
constexpr size_t WS_HACT = 467 * MiB;
constexpr size_t WS_ABT = 539 * MiB;
constexpr size_t WS_END = 555 * MiB;
constexpr size_t QKV_QG = 0, QKV_KG = (size_t)NTOK * 512 * 2, QKV_VG = QKV_KG + (size_t)NTOK * 128 * 2, QKV_QW = QKV_VG + (size_t)NTOK * 128 * 2,
                 QKV_KW = QKV_QW + (size_t)NTOK * 256 * 2, QKV_VW = QKV_KW + (size_t)NTOK * 128 * 2;
static_assert(WS_WIN + (size_t)DEPTH * INW2 * DM * 2 <= WS_WBR && WS_QKV + QKV_VW + (size_t)NTOK * 128 * 2 <= WS_G && WS_G + (size_t)NTOK * 3 * DM * 2 <= WS_BR && WS_HACT >= WS_G + (size_t)NE * RPE * DM * 2 &&
              WS_HACT + (size_t)NE * RPE * DM * 2 <= WS_ABT && WS_ABT + (size_t)NBATCH * 256 * 2 * SEQ * 2 <= WS_END && (size_t)NBATCH * 256 * 2 * CTX * 2 <= 2 * MiB, "d_ws map");
constexpr int CW_BAR = 1024;
constexpr int CW_QUEUE = 8192;
constexpr int CW_CONVQ = 8192 + 64 * 8;
constexpr int CW_FIN = CW_CONVQ + 64;
constexpr int RING_BYTES = 131072;
constexpr int LDSCTL_OFF = RING_BYTES, MISC_OFF = LDSCTL_OFF + 320;
constexpr int IDXBUF_OFF = LDSCTL_OFF + 1024 + 8192;
constexpr int LDS_BYTES = 147456;

#define GAS __attribute__((address_space(1)))
#define LAS __attribute__((address_space(3)))
typedef unsigned short bf16;
typedef unsigned v4u __attribute__((ext_vector_type(4)));
typedef unsigned v2u __attribute__((ext_vector_type(2)));
typedef float f32x4 __attribute__((ext_vector_type(4)));
typedef GAS unsigned gu32;
#define RLX_AGENT __ATOMIC_RELAXED, __HIP_MEMORY_SCOPE_AGENT
#define LDS_WAIT() asm volatile("s_waitcnt lgkmcnt(0)" ::: "memory")
#define VM_WAIT() asm volatile("s_waitcnt vmcnt(0)" ::: "memory")
__device__ __forceinline__ unsigned f2bf(float f) { unsigned u = __builtin_bit_cast(unsigned, f); return (u + 0x7fffu + ((u >> 16) & 1u)) >> 16; }
__device__ __forceinline__ unsigned pk2(float lo, float hi) { return f2bf(lo) | (f2bf(hi) << 16); }
__device__ __forceinline__ float bf2f(unsigned short h) { return __builtin_bit_cast(float, (unsigned)h << 16); }
__device__ __forceinline__ float bflo(unsigned w) { return __builtin_bit_cast(float, w << 16); }
__device__ __forceinline__ float bfhi(unsigned w) { return __builtin_bit_cast(float, w & 0xffff0000u); }

#define XB_TMO      128
#define XB_XCNT(j)  (256  + 64 * (j))
#define XB_XSUB(j)  (1280 + 64 * (j))
#define XB_XGEN(j)  (2304 + 64 * (j))
#define XB_TOP      3328
#define XB_TOPGEN   3392
#define XCD_BAR_WORDS 3456
#define XB_SPIN_CAP (1u << 20)
__device__ __forceinline__ unsigned xb_ld(unsigned* p)              { return __hip_atomic_load(p, __ATOMIC_RELAXED, __HIP_MEMORY_SCOPE_AGENT); }
__device__ __forceinline__ unsigned xb_add(unsigned* p, unsigned v) { return __hip_atomic_fetch_add(p, v, __ATOMIC_RELAXED, __HIP_MEMORY_SCOPE_AGENT); }
__device__ __forceinline__ unsigned xb_xcc_id() { return (unsigned)__builtin_amdgcn_s_getreg((3 << 11) | 20) & 0xFu; }
#define XB_SPIN(cond, bar) do { unsigned _sp = 0; while (cond) { __builtin_amdgcn_s_sleep(1); \
    if ((++_sp & 255u) == 0u) { if (xb_ld(&(bar)[XB_TMO])) break; if (_sp > XB_SPIN_CAP) { atomicAdd(&(bar)[XB_TMO], 1u); break; } } } } while (0)
struct XcdBarrier { unsigned* bar; unsigned x; volatile LAS unsigned* st; };
__device__ __forceinline__ XcdBarrier xcd_barrier_post(unsigned* bar, volatile LAS unsigned* st) {
    XcdBarrier b; b.bar = bar; b.x = xb_xcc_id(); b.st = st;
    if (threadIdx.x == 0) (void)xb_add(&bar[XB_XCNT(b.x)], 1u);
    return b;
}
__device__ __forceinline__ void xcd_barrier_complete(unsigned* bar, unsigned x, unsigned& nloc, unsigned& nx) {
    const unsigned G = gridDim.x * gridDim.y * gridDim.z;
    unsigned sum, cnt, mine, sp = 0u;
    for (;;) {
        sum = 0u; cnt = 0u; mine = 0u;
#pragma unroll
        for (unsigned j = 0; j < 16; ++j) { const unsigned c = xb_ld(&bar[XB_XCNT(j)]); sum += c; cnt += (c > 0u) ? 1u : 0u; mine = (j == x) ? c : mine; }
        if (sum == G) break;
        __builtin_amdgcn_s_sleep(1);
        if ((++sp & 255u) == 0u) { if (xb_ld(&bar[XB_TMO])) break; if (sp > XB_SPIN_CAP) { atomicAdd(&bar[XB_TMO], 1u); break; } }
    }
    nloc = mine > 0u ? mine : 1u; nx = cnt > 0u ? cnt : 1u;
}
__device__ __forceinline__ void xcd_barrier(const XcdBarrier& b) {
    asm volatile("s_waitcnt vmcnt(0)" ::: "memory");
    __syncthreads();
    if (threadIdx.x == 0) {
        unsigned* bar = b.bar;
        __builtin_amdgcn_s_waitcnt(0);
        unsigned nloc = b.st[0], nx = b.st[1];
        if (nloc == 0u) { xcd_barrier_complete(bar, b.x, nloc, nx); b.st[0] = nloc; b.st[1] = nx; }
        const unsigned old = xb_add(&bar[XB_XSUB(b.x)], 1u);
        const unsigned gen = old / nloc;
        if (old + 1u == (gen + 1u) * nloc) {
            __builtin_amdgcn_fence(__ATOMIC_RELEASE, "agent");
            asm volatile("s_waitcnt vmcnt(0)" ::: "memory");
            const unsigned og = xb_add(&bar[XB_TOP], 1u);
            const unsigned tg = og / nx;
            if (og + 1u == (tg + 1u) * nx) xb_add(&bar[XB_TOPGEN], 1u);
            else XB_SPIN(xb_ld(&bar[XB_TOPGEN]) == tg, bar);
            __builtin_amdgcn_fence(__ATOMIC_ACQUIRE, "agent");
            xb_add(&bar[XB_XGEN(b.x)], 1u);
            asm volatile("s_waitcnt vmcnt(0)" ::: "memory");
        } else {
            XB_SPIN(xb_ld(&bar[XB_XGEN(b.x)]) == gen, bar);
            __builtin_amdgcn_fence(__ATOMIC_ACQUIRE, "agent");
            asm volatile("s_waitcnt vmcnt(0)" ::: "memory");
        }
    }
    __syncthreads();
}
template <int CTRL> __device__ __forceinline__ float dpp_mov(float v) { return __builtin_bit_cast(float, __builtin_amdgcn_update_dpp(0, __builtin_bit_cast(int, v), CTRL, 0xF, 0xF, true)); }
__device__ __forceinline__ float lx1(float v) { return dpp_mov<0xB1>(v); }
__device__ __forceinline__ float lx2(float v) { return dpp_mov<0x4E>(v); }
__device__ __forceinline__ float lx4(float v) { return dpp_mov<0x1B>(dpp_mov<0x141>(v)); }
__device__ __forceinline__ float lx8(float v) { return dpp_mov<0x141>(dpp_mov<0x140>(v)); }
__device__ __forceinline__ float lx16(float v) { return __shfl_xor(v, 16); }
__device__ __forceinline__ float lx32(float v) { const unsigned u = __builtin_bit_cast(unsigned, v); auto r = __builtin_amdgcn_permlane32_swap(u, u, false, false);
    return __builtin_bit_cast(float, (threadIdx.x & 32) ? r[0] : r[1]); }
__device__ __forceinline__ float wave_sum(float v) {
    v += lx1(v); v += lx2(v); v += lx4(v); v += lx8(v); v += lx16(v); v += lx32(v);
    return v;
}
using pg8::Unit;
typedef pg8::f32x4 (&AccRef)[2][2][4][2];

__device__ __forceinline__ v2u pack4(f32x4 v) { v2u w; w.x = pg8::cvt_pk_bf16(v[0], v[1]); w.y = pg8::cvt_pk_bf16(v[2], v[3]); return w; }
__device__ __forceinline__ float rsig_(float t) { return 1.f + __builtin_amdgcn_exp2f(t); }
__device__ __forceinline__ float sigmoidf_(float v) { return __builtin_amdgcn_rcpf(1.f + __builtin_amdgcn_exp2f(-LOG2E * v)); }

template <class Dec> struct Strided {
    Dec d; int n, G, vcu;
    __device__ __forceinline__ bool next(int i, Unit& u) const { const int L = i * G + vcu; if (L >= n) return false; d(L, u); return true; }
};

struct DecInProj { const char* A; const char* B; int layer;
    __device__ __forceinline__ void operator()(int L, Unit& u) const {
        int pm, pn;
        if (L < 1024) { const int cg = L >> 8, rg = (L & 255) >> 5, w = L & 31; pm = rg * 8 + (w & 7); pn = cg * 4 + (w >> 3); }
        else if (L < 1216) { const int q = L - 1024, rg = q / 24, w = q % 24; pm = rg * 8 + (w & 7); pn = 16 + (w >> 3); }
        else { const int q = L - 1216; pm = 64 + (q & 7); pn = q >> 3; if (layer == DEPTH - 1) pn = pn ? 6 : 4; }
        u.A = A + (size_t)pm * 256 * (DM * 2); u.B = B + (size_t)pn * 256 * (DM * 2); u.arows = nullptr; u.ldA = DM * 2; u.ldB = DM * 2; u.nt = DM / 64; u.pm = pm; u.pn = pn; u.tag = 0;
        if (pn < 2) { const char* t = u.A; u.A = u.B; u.B = t; }
    } };
constexpr int inproj_units(int layer) { return 1216 + (layer == DEPTH - 1 ? 16 : 152); }

struct EpiInProj {
    static constexpr bool PERM = true;
    bf16 *ABt, *ABtc, *Qg, *Kg, *Vg, *Qw, *Kw, *Vw, *G; const float* rope; const float* qng; const float* kng;
    __device__ __forceinline__ bool operator()(AccRef acc, const Unit& u, int wr, int wc, int fr, int fq) const {
        const int pm = u.pm, pn = u.pn; const bool lat = pm < 64;
        const int rowt = wr * 64 + fr;
        if (pn < 2) {
            bf16* dst; int ld;
            if (lat) { dst = ABt + ((size_t)(pm >> 3) * 256) * (2 * SEQ) + pn * SEQ + (pm & 7) * 256; ld = 2 * SEQ; }
            else { dst = ABtc + ((size_t)(pm - 64) * 256) * (2 * CTX) + pn * CTX; ld = 2 * CTX; }
            dst += (size_t)rowt * ld + wc * 32 + fq * 8;
#pragma unroll
            for (int ai = 0; ai < 2; ++ai)
#pragma unroll
                for (int m = 0; m < 4; ++m)
#pragma unroll
                    for (int bj = 0; bj < 2; ++bj) { const v2u o0 = pack4(acc[ai][bj][m][0]), o1 = pack4(acc[ai][bj][m][1]);
                        *(v4u*)(dst + (size_t)(ai * 128 + m * 16) * ld + bj * 128) = (v4u){o0.x, o0.y, o1.x, o1.y}; }
        } else if (pn < 7) {
            bf16* dst; int ld; const float* ng = nullptr; bool rope_on = false; float sc = 1.f;
            if (pn <= 3)      { dst = Qg + (pn - 2) * 256 + wc * 64; ld = 512; ng = qng; rope_on = lat; sc = QSCALE; }
            else if (pn == 4) { if (wc < 2) { dst = Kg + wc * 64; ng = kng; rope_on = lat; } else { dst = Vg + (wc - 2) * 64; } ld = 128; }
            else if (pn == 5) { dst = Qw + wc * 64; ld = 256; rope_on = lat; sc = QSCALE; }
            else              { if (wc < 2) { dst = Kw + wc * 64; rope_on = lat; } else { dst = Vw + (wc - 2) * 64; } ld = 128; }
#pragma unroll
            for (int ai = 0; ai < 2; ++ai)
#pragma unroll
                for (int m = 0; m < 4; ++m) {
                    const int row = pm * 256 + rowt + ai * 128 + m * 16;
                    pg8::f32x4 v[2][2];
                    float ss = 0.f;
#pragma unroll
                    for (int bj = 0; bj < 2; ++bj)
#pragma unroll
                        for (int n = 0; n < 2; ++n) { v[bj][n] = acc[ai][bj][m][n]; ss += (v[bj][n][0] * v[bj][n][0] + v[bj][n][1] * v[bj][n][1]) + (v[bj][n][2] * v[bj][n][2] + v[bj][n][3] * v[bj][n][3]); }
                    float r = sc;
                    if (ng) { ss += __shfl_xor(ss, 16); ss += __shfl_xor(ss, 32); r = sc * rsqrtf(ss * (1.f / 64.f) + EPS); }
                    const int t = row & (SEQ - 1);
#pragma unroll
                    for (int bj = 0; bj < 2; ++bj) { v2u o[2];
#pragma unroll
                        for (int n = 0; n < 2; ++n) {
                            pg8::f32x4 x = v[bj][n] * r; if (ng) x = x * *(const pg8::f32x4*)(ng + bj * 32 + fq * 8 + n * 4);
                            if (rope_on) {
                                const int pos = bj ? (t & 63) : (t >> 6);
                                const pg8::f32x4 cs = *(const pg8::f32x4*)(rope + ((size_t)pos * 16 + fq * 4 + n * 2) * 2);
                                x = (pg8::f32x4){x[0] * cs[0] - x[1] * cs[1], x[0] * cs[1] + x[1] * cs[0], x[2] * cs[2] - x[3] * cs[3], x[2] * cs[3] + x[3] * cs[2]};
                            }
                            o[n] = pack4(x);
                        }
                        *(v4u*)(dst + (size_t)row * ld + bj * 32 + fq * 8) = (v4u){o[0].x, o[0].y, o[1].x, o[1].y}; }
                    asm volatile("" ::: "memory");
                }
        } else {
            bf16* dst = G + ((size_t)pm * 12 + (pn - 7)) * 65536 + (size_t)(((wr * 4 + wc) * 64 + fq * 16 + fr) * 8);
#pragma unroll
            for (int ai = 0; ai < 2; ++ai)
#pragma unroll
                for (int bj = 0; bj < 2; ++bj)
#pragma unroll
                    for (int m = 0; m < 4; ++m) { const pg8::f32x4 a = acc[ai][bj][m][0], b = acc[ai][bj][m][1];
                        const v2u lo = pack4((pg8::f32x4){rsig_(a[0]), rsig_(a[1]), rsig_(a[2]), rsig_(a[3])}), hi = pack4((pg8::f32x4){rsig_(b[0]), rsig_(b[1]), rsig_(b[2]), rsig_(b[3])});
                        *(v4u*)(dst + (size_t)(((ai * 2 + bj) * 4 + m) * 4096)) = (v4u){lo.x, lo.y, hi.x, hi.y}; }
        }
        return false;
    }
};

struct EpiStore { static constexpr bool PERM = true; bf16* O; int ld;
    __device__ __forceinline__ bool operator()(AccRef acc, const Unit& u, int wr, int wc, int fr, int fq) const {
        bf16* dst = O + ((size_t)u.pm * 256 + wr * 64 + fr) * ld + u.pn * 256 + wc * 32 + fq * 8;
#pragma unroll
        for (int ai = 0; ai < 2; ++ai)
#pragma unroll
            for (int m = 0; m < 4; ++m)
#pragma unroll
                for (int bj = 0; bj < 2; ++bj) { const v2u o0 = pack4(acc[ai][bj][m][0]), o1 = pack4(acc[ai][bj][m][1]);
                    *(v4u*)(dst + (size_t)(ai * 128 + m * 16) * ld + bj * 128) = (v4u){o0.x, o0.y, o1.x, o1.y}; }
        return false;
    } };
struct DecDft { const char* Dm; const char* Dc; const char* ABt; const char* ABtc;
    __device__ __forceinline__ void operator()(int L, Unit& u) const {
        if (L < 64) { const int b = L >> 3, mt = L & 7; u.A = Dm + (size_t)mt * 256 * (4 * SEQ); u.B = ABt + (size_t)b * 256 * (4 * SEQ); u.ldA = 4 * SEQ; u.ldB = 4 * SEQ; u.nt = 2 * SEQ / 64; u.pm = L; }
        else { const int b = L - 64; u.A = Dc; u.B = ABtc + (size_t)b * 256 * (4 * CTX); u.ldA = 4 * CTX; u.ldB = 4 * CTX; u.nt = 2 * CTX / 64; u.pm = 64 + b; }
        u.pn = 0; u.tag = 0; u.arows = nullptr;
    } };

struct SchedMerge { const char* BR; const char* W; int ntiles, G, vcu;
    __device__ __forceinline__ bool next(int i, Unit& u) const {
        const int round = i / 3, tag = i - round * 3, tile = round * G + vcu; if (tile >= ntiles) return false;
        const int pm = tile >> 2, pn = tile & 3, koff = tag == 0 ? 0 : (tag == 1 ? 256 : 768);
        u.A = BR + (size_t)pm * 256 * (DM * 2) + koff * 2; u.B = W + (size_t)pn * 256 * (DM * 2) + koff * 2; u.arows = nullptr; u.ldA = DM * 2; u.ldB = DM * 2; u.nt = tag == 1 ? 8 : 4; u.pm = pm; u.pn = pn; u.tag = tag;
        return true;
    } };
struct EpiMerge { static constexpr bool PERM = true; const bf16* G; bf16* Mb; int probe;
    __device__ __forceinline__ bool operator()(AccRef acc, const Unit& u, int wr, int wc, int fr, int fq) const {
        const size_t row0 = (size_t)u.pm * 256 + wr * 64 + fr; const int col0 = u.pn * 256 + wc * 32 + fq * 8; const int tag = u.tag;
        const GAS char* gt = (const GAS char*)(G + ((size_t)u.pm * 12 + tag * 4 + u.pn) * 65536);
        const unsigned lo = (unsigned)(((wr * 4 + wc) * 64 + fq * 16 + fr) * 16);
        if (tag < 2) {
#pragma unroll
            for (int q = 0; q < 4; ++q) { const int ai = q >> 1, bj = q & 1;
                v4u gwv[4], hwv[4];
#pragma unroll
                for (int m = 0; m < 4; ++m) { const GAS char* gp = gt + (size_t)((q * 4 + m) * 8192); asm volatile("" : "+s"(gp)); gwv[m] = *(const GAS v4u*)(gp + lo); }
#pragma unroll
                for (int m = 0; m < 4; ++m) { const GAS char* gp = gt + (size_t)(4 * 131072 + (q * 4 + m) * 8192); asm volatile("" : "+s"(gp)); hwv[m] = *(const GAS v4u*)(gp + lo); }
#pragma unroll
                for (int m = 0; m < 4; ++m) { const v4u gw = gwv[m], hw = hwv[m];
                    const pg8::f32x4 ga = {__builtin_amdgcn_rcpf(bflo(gw.x)) * bflo(hw.x), __builtin_amdgcn_rcpf(bfhi(gw.x)) * bfhi(hw.x), __builtin_amdgcn_rcpf(bflo(gw.y)) * bflo(hw.y), __builtin_amdgcn_rcpf(bfhi(gw.y)) * bfhi(hw.y)};
                    const pg8::f32x4 gb = {__builtin_amdgcn_rcpf(bflo(gw.z)) * bflo(hw.z), __builtin_amdgcn_rcpf(bfhi(gw.z)) * bfhi(hw.z), __builtin_amdgcn_rcpf(bflo(gw.w)) * bflo(hw.w), __builtin_amdgcn_rcpf(bfhi(gw.w)) * bfhi(hw.w)};
                    acc[ai][bj][m][0] = acc[ai][bj][m][0] * ga; acc[ai][bj][m][1] = acc[ai][bj][m][1] * gb; }
                asm volatile("" ::: "memory");
            }
        } else {
#pragma unroll
            for (int ai = 0; ai < 2; ++ai) {
                v4u gwv[8];
#pragma unroll
                for (int i = 0; i < 8; ++i) { const GAS char* gp = gt + (size_t)((ai * 8 + i) * 8192); asm volatile("" : "+s"(gp)); gwv[i] = *(const GAS v4u*)(gp + lo); }
#pragma unroll
                for (int i = 0; i < 8; ++i) { const int bj = i >> 2, m = i & 3; const v4u gw = gwv[i];
                    const pg8::f32x4 ga = {__builtin_amdgcn_rcpf(bflo(gw.x)), __builtin_amdgcn_rcpf(bfhi(gw.x)), __builtin_amdgcn_rcpf(bflo(gw.y)), __builtin_amdgcn_rcpf(bfhi(gw.y))};
                    const pg8::f32x4 gb = {__builtin_amdgcn_rcpf(bflo(gw.z)), __builtin_amdgcn_rcpf(bfhi(gw.z)), __builtin_amdgcn_rcpf(bflo(gw.w)), __builtin_amdgcn_rcpf(bfhi(gw.w))};
                    const size_t row = row0 + ai * 128 + m * 16; const int c = col0 + bj * 128;
                    const v2u o0 = pack4(acc[ai][bj][m][0] * ga), o1 = pack4(acc[ai][bj][m][1] * gb); *(v4u*)(Mb + row * DM + c) = (v4u){o0.x, o0.y, o1.x, o1.y}; }
                asm volatile("" ::: "memory");
            }
        }
        return tag < 2;
    } };

struct DecWout { const char* Mb; const char* W;
    __device__ __forceinline__ void operator()(int L, Unit& u) const { const int pm = L >> 2, pn = L & 3;
        u.A = Mb + (size_t)pm * 256 * (DM * 2); u.B = W + (size_t)pn * 256 * (DM * 2); u.arows = nullptr; u.ldA = DM * 2; u.ldB = DM * 2; u.nt = DM / 64; u.pm = pm; u.pn = pn; u.tag = 0; } };
struct EpiWout { static constexpr bool PERM = true; const float* baseL; const float* baseC; const bf16* baseX; bf16* X; const float* mod; int from_x;
    __device__ __forceinline__ bool operator()(AccRef acc, const Unit& u, int wr, int wc, int fr, int fq) const {
        const int pm = u.pm; const float* base = pm < 64 ? baseL : baseC; const float* g1 = mod + (size_t)(pm < 64 ? (pm >> 3) : 8) * (6 * DM) + 2 * DM;
        const size_t row0 = (size_t)pm * 256 + wr * 64 + fr; const int col0 = u.pn * 256 + wc * 32 + fq * 8;
#pragma unroll
        for (int bj = 0; bj < 2; ++bj) { const int c = col0 + bj * 128; const pg8::f32x4 gv0 = *(const pg8::f32x4*)(g1 + c), gv1 = *(const pg8::f32x4*)(g1 + c + 4);
            if (from_x) {
                v4u w[8];
#pragma unroll
                for (int i = 0; i < 8; ++i) w[i] = *(const v4u*)(baseX + (row0 + (i >> 2) * 128 + (i & 3) * 16) * DM + c);
#pragma unroll
                for (int i = 0; i < 8; ++i) { const int ai = i >> 2, m = i & 3; const size_t off = (row0 + ai * 128 + m * 16) * DM + c;
                    const pg8::f32x4 b0 = {bflo(w[i].x), bfhi(w[i].x), bflo(w[i].y), bfhi(w[i].y)}, b1 = {bflo(w[i].z), bfhi(w[i].z), bflo(w[i].w), bfhi(w[i].w)};
                    const v2u o0 = pack4(b0 + gv0 * acc[ai][bj][m][0]), o1 = pack4(b1 + gv1 * acc[ai][bj][m][1]);
                    *(v4u*)(X + off) = (v4u){o0.x, o0.y, o1.x, o1.y}; }
            } else {
#pragma unroll
                for (int ai = 0; ai < 2; ++ai) {
                    pg8::f32x4 b0[4], b1[4];
#pragma unroll
                    for (int m = 0; m < 4; ++m) { const size_t off = (row0 + ai * 128 + m * 16) * DM + c; b0[m] = *(const pg8::f32x4*)(base + off); b1[m] = *(const pg8::f32x4*)(base + off + 4); }
#pragma unroll
                    for (int m = 0; m < 4; ++m) { const size_t off = (row0 + ai * 128 + m * 16) * DM + c;
                        const v2u o0 = pack4(b0[m] + gv0 * acc[ai][bj][m][0]), o1 = pack4(b1[m] + gv1 * acc[ai][bj][m][1]);
                        *(v4u*)(X + off) = (v4u){o0.x, o0.y, o1.x, o1.y}; }
                    asm volatile("" ::: "memory");
                }
            }
            asm volatile("" ::: "memory");
        }
        return false;
    } };

struct DecGU { const char* H2; const int* IDX; const char* W; int nrt;
    __device__ __forceinline__ void operator()(int L, Unit& u) const { const int per = nrt * 8, e = L / per, q = L - e * per, ct = q & 7, rt = q >> 3;
        u.A = H2; u.arows = IDX + (size_t)e * RPE + rt * 256; u.B = W + ((size_t)e * 2 * DM + ct * 256) * (DM * 2); u.ldA = DM * 2; u.ldB = DM * 2; u.nt = DM / 64; u.pm = rt; u.pn = ct; u.tag = e; } };
struct EpiGU { static constexpr bool PERM = true; bf16* H;
    __device__ __forceinline__ bool operator()(AccRef acc, const Unit& u, int wr, int wc, int fr, int fq) const {
        bf16* dst = H + ((size_t)u.tag * RPE + u.pm * 256 + wr * 64 + fr) * DM + u.pn * 128 + wc * 32 + fq * 8;
#pragma unroll
        for (int ai = 0; ai < 2; ++ai)
#pragma unroll
            for (int m = 0; m < 4; ++m) { v2u o[2];
#pragma unroll
                for (int n = 0; n < 2; ++n) { const pg8::f32x4 a = acc[ai][0][m][n], up = acc[ai][1][m][n];
                    o[n] = pack4((pg8::f32x4){a[0] * sigmoidf_(a[0]) * up[0], a[1] * sigmoidf_(a[1]) * up[1], a[2] * sigmoidf_(a[2]) * up[2], a[3] * sigmoidf_(a[3]) * up[3]}); }
                *(v4u*)(dst + (size_t)(ai * 128 + m * 16) * DM) = (v4u){o[0].x, o[0].y, o[1].x, o[1].y}; }
        return false;
    } };
struct DecDown { const char* H; const char* W; int nrt;
    __device__ __forceinline__ void operator()(int L, Unit& u) const { const int per = nrt * 4, e = L / per, q = L - e * per, ct = q & 3, rt = q >> 2;
        u.A = H + ((size_t)e * RPE + rt * 256) * (DM * 2); u.arows = nullptr; u.B = W + ((size_t)e * DM + ct * 256) * (DM * 2); u.ldA = DM * 2; u.ldB = DM * 2; u.nt = DM / 64; u.pm = rt; u.pn = ct; u.tag = e; } };
struct EpiDown { static constexpr bool PERM = true; bf16* Y; const float* afs;
    __device__ __forceinline__ bool operator()(AccRef acc, const Unit& u, int wr, int wc, int fr, int fq) const {
        const size_t r0 = (size_t)u.tag * RPE + u.pm * 256 + wr * 64 + fr;
        float av[2][4];
#pragma unroll
        for (int ai = 0; ai < 2; ++ai)
#pragma unroll
            for (int m = 0; m < 4; ++m) av[ai][m] = afs[r0 + ai * 128 + m * 16];
#pragma unroll
        for (int ai = 0; ai < 2; ++ai)
#pragma unroll
            for (int m = 0; m < 4; ++m) { const size_t r = r0 + ai * 128 + m * 16; const float a = av[ai][m];
#pragma unroll
                for (int bj = 0; bj < 2; ++bj) { const v2u o0 = pack4(acc[ai][bj][m][0] * a), o1 = pack4(acc[ai][bj][m][1] * a);
                    *(v4u*)(Y + r * DM + u.pn * 256 + bj * 128 + wc * 32 + fq * 8) = (v4u){o0.x, o0.y, o1.x, o1.y}; } }
        return false;
    } };
struct Frame {
    LAS unsigned char* lds; char* ldsg; volatile LAS unsigned* MISC; gu32* ctl;
    int vcu, G;
    unsigned char* ws; unsigned char* dout; float* out;
};
constexpr int PTRS_OFF = LDSCTL_OFF + 512;
enum { IN_X = 0, IN_C, IN_CTX, IN_CCTX, IN_WADA, IN_BADA, IN_NORM1G, IN_WIN, IN_QNG, IN_KNG, IN_SINK, IN_WBRF, IN_WBRG, IN_WBRW, IN_WOUT, IN_NORM2G, IN_WROUTER, IN_WGATE, IN_WUP, IN_WDOWN, IN_FINALG };
__device__ __forceinline__ const float* inptr(const Frame& F, int k) {
    const unsigned long long v = *(const LAS unsigned long long*)(F.lds + PTRS_OFF + 8 * k);
    const unsigned lo = __builtin_amdgcn_readfirstlane((unsigned)v), hi = __builtin_amdgcn_readfirstlane((unsigned)(v >> 32));
    return (const float*)(((unsigned long long)hi << 32) | lo);
}
#define WSP(T, off) ((T*)(F.ws + (off)))

constexpr int COSTAB_OFF = LDSCTL_OFF + 1024;
static_assert(COSTAB_OFF + 8192 <= LDS_BYTES, "cos table fits");
__device__ __forceinline__ void transpose_item(const float* W, int ldw, int k0, int n0, bf16* WT, int drow0, int dld, int dk0, int lane, float sc = 1.f) {
    const int g = lane >> 3, n4 = (lane & 7) * 4;
    const float* src = W + (size_t)(k0 + 8 * g) * ldw + n0 + n4;
    f32x4 v[8];
#pragma unroll
    for (int i = 0; i < 8; ++i) v[i] = *(const GAS f32x4*)(src + (size_t)i * ldw);
    bf16* dst = WT + (size_t)(drow0 + n4) * dld + dk0 + k0 + 8 * g;
#pragma unroll
    for (int j = 0; j < 4; ++j) { v4u o; o.x = pk2(v[0][j] * sc, v[1][j] * sc); o.y = pk2(v[2][j] * sc, v[3][j] * sc); o.z = pk2(v[4][j] * sc, v[5][j] * sc); o.w = pk2(v[6][j] * sc, v[7][j] * sc);
        *(GAS v4u*)(dst + (size_t)j * dld) = o; }
}
__device__ __forceinline__ void transpose_item2(const float* W, int ldw, int k0, int n0, bf16* WT, int drow0, int dld, int lane) {
    const int g = lane >> 3, n4 = (lane & 7) * 4;
    const float* src = W + (size_t)(k0 + 8 * g) * ldw + n0 + n4;
    f32x4 v[2][8];
#pragma unroll
    for (int h = 0; h < 2; ++h)
#pragma unroll
        for (int i = 0; i < 8; ++i) v[h][i] = __builtin_nontemporal_load((const GAS f32x4*)(src + (size_t)(h * 64 + i) * ldw));
    bf16* dst = WT + (size_t)(drow0 + n4) * dld + k0 + 8 * g;
#pragma unroll
    for (int h = 0; h < 2; ++h)
#pragma unroll
        for (int j = 0; j < 4; ++j) { v4u o; o.x = pk2(v[h][0][j], v[h][1][j]); o.y = pk2(v[h][2][j], v[h][3][j]); o.z = pk2(v[h][4][j], v[h][5][j]); o.w = pk2(v[h][6][j], v[h][7][j]);
            __builtin_nontemporal_store(o, (GAS v4u*)(dst + (size_t)j * dld + h * 64)); }
}
__device__ __forceinline__ void fold_item(const float* W, int k0, int g, int sinmode, bf16* WT, int drow0, LAS float* scr, const LAS float* ctab, int lane) {
#pragma unroll
    for (int kk = 0; kk < 16; ++kk) scr[lane * 20 + kk] = W[(size_t)(k0 + kk) * INW + g * 64 + lane];
    LDS_WAIT(); asm volatile("" ::: "memory");
    float acc[16];
#pragma unroll
    for (int k = 0; k < 16; ++k) acc[k] = 0.f;
#pragma unroll 4
    for (int c = 0; c < 64; ++c) {
        const int r = (c * lane) & 63;
        const float tv = sinmode ? -ctab[((r - 16) & 63) * 32] : ctab[r * 32];
#pragma unroll
        for (int k4 = 0; k4 < 4; ++k4) { const f32x4 w = *(const LAS f32x4*)(scr + c * 20 + 4 * k4);
            acc[4 * k4] = fmaf(w[0], tv, acc[4 * k4]); acc[4 * k4 + 1] = fmaf(w[1], tv, acc[4 * k4 + 1]); acc[4 * k4 + 2] = fmaf(w[2], tv, acc[4 * k4 + 2]); acc[4 * k4 + 3] = fmaf(w[3], tv, acc[4 * k4 + 3]); }
    }
    GAS v4u* dst = (GAS v4u*)(WT + (size_t)(drow0 + lane) * DM + k0);
#pragma unroll
    for (int q = 0; q < 2; ++q) { v4u o; o.x = pk2(acc[8 * q], acc[8 * q + 1]); o.y = pk2(acc[8 * q + 2], acc[8 * q + 3]); o.z = pk2(acc[8 * q + 4], acc[8 * q + 5]); o.w = pk2(acc[8 * q + 6], acc[8 * q + 7]); dst[q] = o; }
    LDS_WAIT(); asm volatile("" ::: "memory");
}

#ifndef CONV_IN_ATTN
#define CONV_IN_ATTN 0
#endif
constexpr int CONV_WAVE_ITEMS = DEPTH * NE * 768, CONV_ITEMS = CONV_WAVE_ITEMS / NWAVES, CONV_ITEMS_L0 = CONV_ITEMS / DEPTH;
__device__ __forceinline__ void conv_wave_item(Frame& F, int r, int lane) {
    const int le = r / 768, q = r % 768, which = q / 256, qq = q % 256, kb = qq >> 5, nb = qq & 31, f0 = nb * 32;
    if (which < 2) transpose_item2((which ? inptr(F, IN_WUP) : inptr(F, IN_WGATE)) + (size_t)le * DM * DM, DM, kb * 128, f0, WSP(bf16, WS_WGU) + (size_t)le * 2 * DM * DM, (f0 >> 7) * 256 + which * 128 + (f0 & 127), DM, lane);
    else transpose_item2(inptr(F, IN_WDOWN) + (size_t)le * DM * DM, DM, kb * 128, f0, WSP(bf16, WS_WD) + (size_t)le * DM * DM, f0, DM, lane);
}
__device__ __forceinline__ void tail_convert(Frame& F, int idx, int first, int per, int end) {
    int tid_ = threadIdx.x; asm volatile("" : "+v"(tid_));
    const int lane = tid_ & 63, wave_ = __builtin_amdgcn_readfirstlane(tid_ >> 6);
    for (int t = 0; t < per; ++t) { const int it = first + idx * per + t; if (it >= end) break; conv_wave_item(F, it * NWAVES + wave_, lane); }
}

__device__ __forceinline__ void p0_prologue(Frame& F, int mode = 0) {
    int tid_ = threadIdx.x; asm volatile("" : "+v"(tid_));
    const int lane = tid_ & 63, wave_ = __builtin_amdgcn_readfirstlane(tid_ >> 6);
    const int gw = F.vcu * NWAVES + wave_, NGW = F.G * NWAVES;
    LAS float* st = (LAS float*)F.lds;
    LAS float* red = (LAS float*)(F.lds + 40960);
    LAS float* ctab = (LAS float*)(F.lds + COSTAB_OFF);
    { const float* cp = inptr(F, IN_C); const float* ccp = inptr(F, IN_CCTX);
#pragma unroll 6
      for (int i = tid_; i < 9 * DM; i += NWAVES * 64) { const int s = i / DM, k = i - s * DM; const float v = s < 8 ? cp[s * DM + k] : ccp[k]; st[i] = v / (1.f + expf(-v)); } }
    for (int i = tid_; i < 2048; i += NWAVES * 64) ctab[i] = cosf(6.283185307179586f * (float)i * (1.f / 2048.f));
    __syncthreads();
    const float* bada = inptr(F, IN_BADA);
    if (mode != 2) for (int it = F.vcu; it < DEPTH * 96; it += F.G) {
        const int l = it / 96, j = (it % 96) * 64 + lane, kb = wave_ * 128;
        const float* W = inptr(F, IN_WADA) + (size_t)l * DM * 6 * DM + (size_t)kb * 6 * DM + j;
        float acc[9];
#pragma unroll
        for (int s = 0; s < 9; ++s) acc[s] = 0.f;
        for (int k0 = 0; k0 < 128; k0 += 16) {
            float w[16];
#pragma unroll
            for (int i = 0; i < 16; ++i) w[i] = W[(size_t)(k0 + i) * 6 * DM];
#pragma unroll
            for (int i = 0; i < 16; ++i)
#pragma unroll
                for (int s = 0; s < 9; ++s) acc[s] = fmaf(st[s * DM + kb + k0 + i], w[i], acc[s]);
        }
#pragma unroll
        for (int s = 0; s < 9; ++s) red[(wave_ * 9 + s) * 64 + lane] = acc[s];
        __syncthreads();
        for (int o = tid_; o < 9 * 64; o += NWAVES * 64) { float v = 0.f;
#pragma unroll
            for (int w = 0; w < 8; ++w) v += red[w * 576 + o];
            const int s = o >> 6, jj = (it % 96) * 64 + (o & 63);
            WSP(float, WS_MOD)[((size_t)l * 9 + s) * 6 * DM + jj] = v + bada[l * 6 * DM + jj]; }
        __syncthreads();
    }
    __syncthreads();
#ifdef DBG_POISON
    {
        const size_t n16 = (WS_END - WS_X) / 16, m16 = ((size_t)NLAT * DM * 4) / 16; const v4u pz = {0xFFFFFFFFu, 0xFFFFFFFFu, 0xFFFFFFFFu, 0xFFFFFFFFu};
        for (size_t i = (size_t)gw * 64 + lane; i < n16; i += (size_t)NGW * 64) ((GAS v4u*)(F.ws + WS_X))[i] = pz;
        for (size_t i = (size_t)gw * 64 + lane; i < m16; i += (size_t)NGW * 64) ((GAS v4u*)F.dout)[i] = pz;
    }
#endif
    LAS float* scr = (LAS float*)(F.lds + wave_ * 16384);
    constexpr int T_A = DEPTH * 2176, T_B = DEPTH * 512, T_C = DEPTH * 512, T_D = DEPTH * 512, T_E = DEPTH * NE * 768, T_F = SEQ + CTX, T_G = 1;
    constexpr int NITEMS = T_A + T_B + T_C + T_D + T_E + T_F + T_G;
    if (mode != 1 && mode != 5 && mode != 6) for (int it = gw; it < NITEMS; it += NGW) {
        int r = it;
        if (r < T_A) { const int l = r / 2176, q = r % 2176, kb = q / 136, nb = q % 136, s0 = 256 + nb * 32;
            int drow; if (s0 < 1536) { const int tile = 2 + ((s0 - 256) >> 8), hh = ((s0 - 256) & 255) >> 6, dh = (s0 & 63) >> 5; drow = tile * 256 + dh * 128 + hh * 32; } else drow = s0 + 256;
            transpose_item(inptr(F, IN_WIN) + (size_t)l * DM * INW, INW, kb * 64, s0, WSP(bf16, WS_WIN) + (size_t)l * INW2 * DM, drow, DM, 0, lane, s0 < 1536 ? 1.f : -LOG2E); continue; } r -= T_A;
        if (r < T_B) { const int l = r / 512, q = r % 512, kq = q & 3, kb = (q >> 2) >> 3, g = ((q >> 2) >> 1) & 3, sm = (q >> 2) & 1;
            fold_item(inptr(F, IN_WIN) + (size_t)l * DM * INW, kb * 64 + kq * 16, g, sm, WSP(bf16, WS_WIN) + (size_t)l * INW2 * DM, sm * 256 + g * 64, scr, ctab, lane); continue; } r -= T_B;
        if (r < T_C) { const int l = r / 512, q = r % 512; const float* W; int kb, koff;
            if (q < 128) { W = inptr(F, IN_WBRF) + (size_t)l * 256 * DM; kb = q >> 5; koff = 0; } else if (q < 384) { W = inptr(F, IN_WBRG) + (size_t)l * 512 * DM; kb = (q - 128) >> 5; koff = 256; } else { W = inptr(F, IN_WBRW) + (size_t)l * 256 * DM; kb = (q - 384) >> 5; koff = 768; }
            const int nb = q & 31;
            transpose_item(W, DM, kb * 64, nb * 32, WSP(bf16, WS_WBR) + (size_t)l * DM * DM, nb * 32, DM, koff, lane); continue; } r -= T_C;
        if (r < T_D) { const int l = r / 512, q = r % 512, kb = q >> 5, nb = q & 31;
            transpose_item(inptr(F, IN_WOUT) + (size_t)l * DM * DM, DM, kb * 64, nb * 32, WSP(bf16, WS_WOUT) + (size_t)l * DM * DM, nb * 32, DM, 0, lane); continue; } r -= T_D;
        if (r < T_E) { if (F.G != 256) conv_wave_item(F, r, lane); continue; } r -= T_E;
        if (r < T_F) {
            const bool big = r < SEQ; const int N = big ? SEQ : CTX, k = big ? r : r - SEQ, sh = big ? 0 : 3; const float sc = 1.f / sqrtf(64.f * (float)N);
            bf16* row = (big ? WSP(bf16, WS_DFT) : WSP(bf16, WS_DFTC)) + (size_t)k * 2 * N;
            for (int n = 2 * lane; n < N; n += 128) {
                const int r0 = (k * n) & (N - 1), r1 = (k * (n + 1)) & (N - 1);
                *(GAS unsigned*)(row + n) = pk2(ctab[r0 << sh] * sc, ctab[r1 << sh] * sc);
                *(GAS unsigned*)(row + N + n) = pk2(ctab[((r0 - (N >> 2)) & (N - 1)) << sh] * sc, ctab[((r1 - (N >> 2)) & (N - 1)) << sh] * sc); }
            continue; } r -= T_F;
        {
            for (int i = lane; i < 64 * 16; i += 64) { const int pos = i >> 4, f = i & 15; const float inv = powf(10000.f, -(float)(2 * f) / 32.f), ang = (float)pos * inv;
                WSP(float, WS_ROPE)[2 * i] = cosf(ang); WSP(float, WS_ROPE)[2 * i + 1] = sinf(ang); }
        }
    }
}

__device__ __forceinline__ void norm_row(f32x4 (&v)[4], const float* gain, const float* shift, const float* scale, int lane) {
    float ss = 0.f;
#pragma unroll
    for (int j = 0; j < 4; ++j) ss += (v[j][0] * v[j][0] + v[j][1] * v[j][1]) + (v[j][2] * v[j][2] + v[j][3] * v[j][3]);
    const float r = rsqrtf(wave_sum(ss) * (1.f / DM) + EPS);
#pragma unroll
    for (int j = 0; j < 4; ++j) { const f32x4 g = *(const f32x4*)(gain + 4 * lane + 256 * j); f32x4 y = v[j] * r * g;
        if (shift) { const f32x4 sh = *(const f32x4*)(shift + 4 * lane + 256 * j), sc = *(const f32x4*)(scale + 4 * lane + 256 * j); y = y * (sc + 1.f) + sh; }
        v[j] = y; }
}
__device__ __forceinline__ void store_row_bf16(bf16* orow, const f32x4 (&v)[4], int lane) {
    GAS v2u* o8 = (GAS v2u*)orow + lane;
#pragma unroll
    for (int j = 0; j < 4; ++j) { v2u w; w.x = pg8::cvt_pk_bf16(v[j][0], v[j][1]); w.y = pg8::cvt_pk_bf16(v[j][2], v[j][3]); o8[64 * j] = w; }
}
__device__ __forceinline__ int row_modset(int r) { return r < NLAT ? (r >> 11) : 8; }
struct ModVec { f32x4 g[4], sh[4], sc[4]; };
__device__ __forceinline__ void load_modvec(ModVec& m, const float* gain, const float* shift, const float* scale, int lane) {
#pragma unroll
    for (int j = 0; j < 4; ++j) { m.g[j] = *(const f32x4*)(gain + 4 * lane + 256 * j);
        if (shift) { m.sh[j] = *(const f32x4*)(shift + 4 * lane + 256 * j); m.sc[j] = *(const f32x4*)(scale + 4 * lane + 256 * j); } else { m.sh[j] = (f32x4){0.f, 0.f, 0.f, 0.f}; m.sc[j] = (f32x4){0.f, 0.f, 0.f, 0.f}; } }
}
__device__ __forceinline__ void norm_row_m(f32x4 (&v)[4], const ModVec& m) {
    float ss = 0.f;
#pragma unroll
    for (int j = 0; j < 4; ++j) ss += (v[j][0] * v[j][0] + v[j][1] * v[j][1]) + (v[j][2] * v[j][2] + v[j][3] * v[j][3]);
    const float r = rsqrtf(wave_sum(ss) * (1.f / DM) + EPS);
#pragma unroll
    for (int j = 0; j < 4; ++j) v[j] = (v[j] * r * m.g[j]) * (m.sc[j] + 1.f) + m.sh[j];
}
__device__ __forceinline__ void load_row_bf16(f32x4 (&v)[4], const bf16* row, int lane) {
    const GAS v2u* i8 = (const GAS v2u*)row + lane;
#pragma unroll
    for (int j = 0; j < 4; ++j) { const v2u w = i8[64 * j]; v[j] = (f32x4){bflo(w.x), bfhi(w.x), bflo(w.y), bfhi(w.y)}; }
}
__device__ __forceinline__ void load_row_f32(f32x4 (&v)[4], const float* row, int lane) {
#pragma unroll
    for (int j = 0; j < 4; ++j) v[j] = *(const f32x4*)(row + 4 * lane + 256 * j);
}

__device__ __forceinline__ void p1_norm1(Frame& F) {
    int tid_ = threadIdx.x; asm volatile("" : "+v"(tid_));
    const int lane = tid_ & 63, wave_ = __builtin_amdgcn_readfirstlane(tid_ >> 6);
    const int gw = F.vcu * NWAVES + wave_, NGW = F.G * NWAVES, rpw = (NTOK + NGW - 1) / NGW, r0 = gw * rpw, r1 = r0 + rpw < NTOK ? r0 + rpw : NTOK;
    const float* xin = inptr(F, IN_X); const float* cin = inptr(F, IN_CTX) - (size_t)NLAT * DM; const float* g1 = inptr(F, IN_NORM1G);
#define P1_ROW(r) (((r) < NLAT ? xin : cin) + (size_t)(r) * DM)
    f32x4 va[4], vb[4]; ModVec m; int cset = -1;
    if (r0 < r1) load_row_f32(va, P1_ROW(r0), lane);
    if (r0 + 1 < r1) load_row_f32(vb, P1_ROW(r0 + 1), lane);
    for (int r = r0; r < r1; ++r) {
        f32x4 v[4];
#pragma unroll
        for (int j = 0; j < 4; ++j) { v[j] = va[j]; va[j] = vb[j]; }
        if (r + 2 < r1) load_row_f32(vb, P1_ROW(r + 2), lane);
        const int set = row_modset(r);
        if (set != cset) { const float* mod = WSP(float, WS_MOD) + (size_t)set * 6 * DM; load_modvec(m, g1, mod, mod + DM, lane); cset = set; }
        norm_row_m(v, m);
        store_row_bf16(WSP(bf16, WS_HN) + (size_t)r * DM, v, lane);
    }
#undef P1_ROW
}
__device__ __forceinline__ void router_finish(const float (&a16)[NE], int r, int lane, float* AFF) {
    float b8[8], b4[4], b2[2], lg;
    { const bool hi = lane & 32;
#pragma unroll
      for (int i = 0; i < 8; ++i) { const float keep = hi ? a16[i + 8] : a16[i], send = hi ? a16[i] : a16[i + 8]; b8[i] = keep + lx32(send); } }
    { const bool hi = lane & 16;
#pragma unroll
      for (int i = 0; i < 4; ++i) { const float keep = hi ? b8[i + 4] : b8[i], send = hi ? b8[i] : b8[i + 4]; b4[i] = keep + lx16(send); } }
    { const bool hi = lane & 8;
#pragma unroll
      for (int i = 0; i < 2; ++i) { const float keep = hi ? b4[i + 2] : b4[i], send = hi ? b4[i] : b4[i + 2]; b2[i] = keep + lx8(send); } }
    { const bool hi = lane & 4; const float keep = hi ? b2[1] : b2[0], send = hi ? b2[0] : b2[1]; lg = keep + lx4(send); }
    lg += lx2(lg); lg += lx1(lg);
    float mx = lg;
    mx = fmaxf(mx, lx4(mx)); mx = fmaxf(mx, lx8(mx)); mx = fmaxf(mx, lx16(mx)); mx = fmaxf(mx, lx32(mx));
    const float ex = expf(lg - mx); float sum = ex;
    sum += lx4(sum); sum += lx8(sum); sum += lx16(sum); sum += lx32(sum);
    const int set = r < NLAT ? (r >> 11) : 8 + ((r - NLAT) >> 8), n = r < NLAT ? (r & (SEQ - 1)) : ((r - NLAT) & (CTX - 1));
    if ((lane & 3) == 0) AFF[((size_t)set * NE + ((lane >> 2) & 15)) * SEQ + n] = ex / sum;
}
__device__ __forceinline__ void pf_norm2_router(Frame& F, int l, int mode = 0) {
    int tid_ = threadIdx.x; asm volatile("" : "+v"(tid_));
    const int lane = tid_ & 63, wave_ = __builtin_amdgcn_readfirstlane(tid_ >> 6);
    const int gw = F.vcu * NWAVES + wave_, NGW = F.G * NWAVES;
    LAS float* wrT = (LAS float*)F.lds;
    { const float* wr = inptr(F, IN_WROUTER) + (size_t)l * DM * NE;
#pragma unroll 8
      for (int i = tid_; i < DM * NE; i += NWAVES * 64) { const int k = i >> 4, e = i & 15; wrT[e * DM + k] = wr[i]; } }
    __syncthreads();
    const int nrows = (l == DEPTH - 1) ? NLAT : NTOK, rpw = (nrows + NGW - 1) / NGW, r0 = gw * rpw, r1 = r0 + rpw < nrows ? r0 + rpw : nrows;
    const bf16* X = WSP(bf16, WS_X); const float* g2n = inptr(F, IN_NORM2G) + l * DM; float* AFF = WSP(float, WS_AFF);
    f32x4 va[4], vb[4]; ModVec m; int cset = -1;
    if (r0 < r1) load_row_bf16(va, X + (size_t)r0 * DM, lane);
    if (r0 + 1 < r1) load_row_bf16(vb, X + (size_t)(r0 + 1) * DM, lane);
    for (int r = r0; r < r1; ++r) {
        f32x4 v[4];
#pragma unroll
        for (int j = 0; j < 4; ++j) { v[j] = va[j]; va[j] = vb[j]; }
        if (r + 2 < r1) load_row_bf16(vb, X + (size_t)(r + 2) * DM, lane);
        const int mset = row_modset(r);
        if (mset != cset) { const float* mod = WSP(float, WS_MOD) + ((size_t)l * 9 + mset) * 6 * DM; load_modvec(m, g2n, mod + 3 * DM, mod + 4 * DM, lane); cset = mset; }
        norm_row_m(v, m);
        if (mode < 2) store_row_bf16(WSP(bf16, WS_HN) + (size_t)r * DM, v, lane);
        if (mode >= 1) { asm volatile("" :: "v"(v[0]), "v"(v[1]), "v"(v[2]), "v"(v[3])); continue; }
        float a16[NE];
#pragma unroll
        for (int e = 0; e < NE; ++e) { float a = 0.f;
#pragma unroll
            for (int j = 0; j < 4; ++j) { const f32x4 w = *(const LAS f32x4*)(wrT + e * DM + 4 * lane + 256 * j); a = fmaf(v[j][0], w[0], a); a = fmaf(v[j][1], w[1], a); a = fmaf(v[j][2], w[2], a); a = fmaf(v[j][3], w[3], a); }
            a16[e] = a; if ((e & 3) == 3) asm volatile("" ::: "memory"); }
        router_finish(a16, r, lane, AFF);
    }
    __syncthreads();
}
__device__ __forceinline__ void pg_topk_gather(Frame& F, int l) {
    int tid_ = threadIdx.x; asm volatile("" : "+v"(tid_));
    const int lane = tid_ & 63, wave_ = __builtin_amdgcn_readfirstlane(tid_ >> 6);
    LAS unsigned* cnt = (LAS unsigned*)F.lds;
    LAS int* sidx = (LAS int*)(F.lds + 1024);
    const int nitems = (l == DEPTH - 1) ? 8 * NE : 16 * NE;
    const int tid = tid_, wave = wave_;
    const unsigned long long lt = (1ull << lane) - 1ull;
    for (int it = F.vcu; it < nitems; it += F.G) {
        const int set = it >> 4, e = it & 15; const bool latent = set < 8; const int N = latent ? SEQ : CTX, cap = latent ? CAPL : CAPC;
        const int rowbase = latent ? set * SEQ : NLAT + (set - 8) * CTX, xbase = latent ? set * CAPL : 8 * CAPL + (set - 8) * CAPC;
        const float* a = WSP(float, WS_AFF) + ((size_t)set * NE + e) * SEQ;
        unsigned key[4];
#pragma unroll
        for (int q = 0; q < 4; ++q) { const int i = q * 512 + tid; key[q] = i < N ? __builtin_bit_cast(unsigned, a[i]) : 0u; }
        unsigned T = 0u;
        for (int bit = 30; bit >= 0; --bit) {
            const unsigned cand = T | (1u << bit); unsigned c = 0;
#pragma unroll
            for (int q = 0; q < 4; ++q) c += (unsigned)__builtin_popcountll(__ballot(key[q] >= cand));
            LAS unsigned* cb = cnt + (bit & 1) * 8;
            if (lane == 0) cb[wave] = c;
            __syncthreads();
            unsigned tot = 0;
#pragma unroll
            for (int w = 0; w < 8; ++w) tot += cb[w];
            if (tot >= (unsigned)cap) T = cand;
        }
        LAS unsigned* cg = cnt + 64; LAS unsigned* ce = cnt + 96;
        unsigned long long bg[4], be[4];
#pragma unroll
        for (int q = 0; q < 4; ++q) { bg[q] = __ballot(key[q] > T); be[q] = __ballot(key[q] == T && key[q] != 0u);
            if (lane == 0) { cg[q * 8 + wave] = (unsigned)__builtin_popcountll(bg[q]); ce[q * 8 + wave] = (unsigned)__builtin_popcountll(be[q]); } }
        __syncthreads();
        unsigned ngt = 0;
        for (int c2 = 0; c2 < 32; ++c2) ngt += cg[c2];
        const unsigned need = (unsigned)cap - ngt;
        unsigned pre_g[4], pre_e[4];
        { unsigned rg = 0, re = 0;
#pragma unroll
          for (int q = 0; q < 4; ++q) { for (int w = 0; w < 8; ++w) { if (w == wave) { pre_g[q] = rg; pre_e[q] = re; } rg += cg[q * 8 + w]; re += ce[q * 8 + w]; } } }
        int* SEL = WSP(int, WS_SEL);
#pragma unroll
        for (int q = 0; q < 4; ++q) { const int i = q * 512 + tid;
            if (i < N) {
                const unsigned eb = pre_e[q] + (unsigned)__builtin_popcountll(be[q] & lt);
                const unsigned gb = pre_g[q] + (unsigned)__builtin_popcountll(bg[q] & lt);
                const bool isg = key[q] > T, ise = key[q] == T;
                const bool sel = isg || (ise && eb < need);
                const unsigned slot = gb + (eb < need ? eb : need);
                SEL[(size_t)(rowbase + i) * NE + e] = sel ? xbase + (int)slot : -1;
                if (sel) { WSP(float, WS_AFS)[(size_t)e * RPE + xbase + slot] = __builtin_bit_cast(float, key[q]); WSP(int, WS_IDX)[(size_t)e * RPE + xbase + slot] = rowbase + i; }
            } }
        __syncthreads();
    }
}
__device__ __forceinline__ unsigned ye_issue4(const bf16* YE, int selv, unsigned mk, v2u (&w)[4][4], int lane) {
#pragma unroll
    for (int i = 0; i < 4; ++i) {
        if (mk) { const int e = __builtin_ctz(mk); mk &= mk - 1u; const int se = __builtin_amdgcn_readlane(selv, e);
            const GAS v2u* y = (const GAS v2u*)(YE + ((size_t)e * RPE + se) * DM) + lane;
#pragma unroll
            for (int j = 0; j < 4; ++j) w[i][j] = y[64 * j]; }
        else {
#pragma unroll
            for (int j = 0; j < 4; ++j) w[i][j] = (v2u){0u, 0u}; }
    }
    return mk;
}
__device__ __forceinline__ void ye_acc4(f32x4 (&t)[4], const v2u (&w)[4][4]) {
#pragma unroll
    for (int i = 0; i < 4; ++i)
#pragma unroll
        for (int j = 0; j < 4; ++j) t[j] += (f32x4){bflo(w[i][j].x), bfhi(w[i][j].x), bflo(w[i][j].y), bfhi(w[i][j].y)};
}
__device__ __forceinline__ unsigned sel_mask(int selv) { return (unsigned)__builtin_amdgcn_readfirstlane((int)(__ballot(selv >= 0) & 0xFFFFull)); }
__device__ __forceinline__ void pj_combine(Frame& F, int l, int probe = 0) {
    int tid_ = threadIdx.x; asm volatile("" : "+v"(tid_));
    const int lane = tid_ & 63, wave_ = __builtin_amdgcn_readfirstlane(tid_ >> 6);
    const int gw = F.vcu * NWAVES + wave_, NGW = F.G * NWAVES; const bool last = l == DEPTH - 1;
    const int nrows = last ? NLAT : NTOK, rpw = (nrows + NGW - 1) / NGW, r0 = gw * rpw, r1 = r0 + rpw < nrows ? r0 + rpw : nrows;
    bf16* X = WSP(bf16, WS_X); const int* SEL = WSP(int, WS_SEL);
    const float* gnext = last ? inptr(F, IN_FINALG) : inptr(F, IN_NORM1G) + (l + 1) * DM;
    f32x4 va[4], vb[4], g2[4]; int sa = -1, sb = -1; ModVec m; int cset = -1;
    if (r0 < r1) { load_row_bf16(va, X + (size_t)r0 * DM, lane); sa = lane < NE ? SEL[(size_t)r0 * NE + lane] : -1; }
    if (r0 + 1 < r1) { load_row_bf16(vb, X + (size_t)(r0 + 1) * DM, lane); sb = lane < NE ? SEL[(size_t)(r0 + 1) * NE + lane] : -1; }
    const bf16* YE = WSP(bf16, WS_G); v2u wA[4][4], wB[4][4]; unsigned restA = 0u, restB = 0u;
    restA = ye_issue4(YE, sa, r0 < r1 ? sel_mask(sa) : 0u, wA, lane);
#define PJ_ROW(r, WC, WN, RC, RN) do { \
        f32x4 v[4], t[4]; \
        _Pragma("unroll") for (int j = 0; j < 4; ++j) { v[j] = va[j]; va[j] = vb[j]; t[j] = (f32x4){0.f, 0.f, 0.f, 0.f}; } \
        const int selv = sa; sa = sb; \
        if ((r) + 2 < r1) { load_row_bf16(vb, X + (size_t)((r) + 2) * DM, lane); sb = lane < NE ? SEL[(size_t)((r) + 2) * NE + lane] : -1; } \
        const int mset = row_modset(r); \
        if (mset != cset) { const float* mod = WSP(float, WS_MOD) + ((size_t)l * 9 + mset) * 6 * DM; const float* mod1 = WSP(float, WS_MOD) + ((size_t)(last ? l : l + 1) * 9 + mset) * 6 * DM; \
            _Pragma("unroll") for (int j = 0; j < 4; ++j) g2[j] = *(const f32x4*)(mod + 5 * DM + 4 * lane + 256 * j); \
            load_modvec(m, gnext, last ? nullptr : mod1, last ? nullptr : mod1 + DM, lane); cset = mset; } \
        RN = ye_issue4(YE, sa, (r) + 1 < r1 ? sel_mask(sa) : 0u, WN, lane);                \
        ye_acc4(t, WC); \
        while (RC) { RC = ye_issue4(YE, selv, RC, WC, lane); ye_acc4(t, WC); }               \
        _Pragma("unroll") for (int j = 0; j < 4; ++j) v[j] = v[j] + g2[j] * t[j]; \
        if (probe) { norm_row_m(v, m); asm volatile("" :: "v"(v[0]), "v"(v[1]), "v"(v[2]), "v"(v[3])); } \
        else if (!last) { \
            store_row_bf16(X + (size_t)(r) * DM, v, lane); \
            norm_row_m(v, m); \
            store_row_bf16(WSP(bf16, WS_HN) + (size_t)(r) * DM, v, lane); \
        } else { \
            norm_row_m(v, m); \
            _Pragma("unroll") for (int j = 0; j < 4; ++j) *(f32x4*)(F.out + (size_t)(r) * DM + 4 * lane + 256 * j) = v[j]; \
        } } while (0)
    for (int r = r0; r < r1; r += 2) {
        PJ_ROW(r, wA, wB, restA, restB);
        if (r + 1 < r1) PJ_ROW(r + 1, wB, wA, restB, restA);
    }
#undef PJ_ROW
}

__device__ __forceinline__ void pc_mixers(Frame& F, int l, int rep) {
    int tid_ = threadIdx.x; asm volatile("" : "+v"(tid_));
    const int lane = tid_ & 63, wave_ = __builtin_amdgcn_readfirstlane(tid_ >> 6);
    const bool need_ctx = l < DEPTH - 1;
    {
        Strided<DecDft> S; S.d.Dm = (const char*)(F.ws + WS_DFT); S.d.Dc = (const char*)(F.ws + WS_DFTC); S.d.ABt = (const char*)(F.ws + WS_ABT); S.d.ABtc = (const char*)(F.ws + WS_ABTC);
        S.n = need_ctx ? 72 : 64; S.G = F.G; S.vcu = F.vcu;
        EpiStore E{WSP(bf16, WS_BR), DM};
        pg8::gemm_phase<EpiStore, Strided<DecDft>>(F.lds, (LAS int*)(F.lds + IDXBUF_OFF), S, E);
    }
    typedef attn_body::bf16 abf;
    const abf* Qg = (const abf*)(F.ws + WS_QKV + QKV_QG); const abf* Kg = (const abf*)(F.ws + WS_QKV + QKV_KG); const abf* Vg = (const abf*)(F.ws + WS_QKV + QKV_VG);
    const abf* Qw = (const abf*)(F.ws + WS_QKV + QKV_QW); const abf* Kw = (const abf*)(F.ws + WS_QKV + QKV_KW); const abf* Vw = (const abf*)(F.ws + WS_QKV + QKV_VW);
    abf* BR = (abf*)(F.ws + WS_BR);
    const int nGL = NBATCH * 2 * 32, nWL = NBATCH * 2 * 16, nGC = need_ctx ? NBATCH * 2 * 4 : 0, nWC = need_ctx ? NBATCH * 2 * 2 : 0, nattn = nGL + nWL + nGC + nWC;
    const int nconv = (CONV_IN_ATTN && F.G == 256 && rep == 0) ? CONV_ITEMS_L0 : 0, ntot = nattn + nconv;
    gu32* head = F.ctl + CW_QUEUE + 64 * (l + 2 * rep);
    const int wid = wave_;
    for (;;) {
        if (tid_ == 0) F.MISC[0] = __hip_atomic_fetch_add(head, 1u, RLX_AGENT);
        __syncthreads();
        const int q = (int)F.MISC[0];
        if (q >= ntot) break;
        const int c0 = (int)(((long long)q * nconv) / ntot), c1 = (int)(((long long)(q + 1) * nconv) / ntot);
        if (c1 > c0) { conv_wave_item(F, (l * CONV_ITEMS_L0 + c0) * NWAVES + wave_, lane); __syncthreads(); continue; }
        const int a = q - c0;
        if (a < nGL) {
            const int b = a >> 6, hkv = (a >> 5) & 1, qb = a & 31, head_ = hkv * 4 + (wid >> 1), q0 = qb * 64 + (wid & 1) * 32; const size_t qrow = (size_t)b * SEQ + q0;
            attn_body::attn_unit<0, 8>(Qg + qrow * 512 + head_ * 64, 512, Kg + (size_t)(NLAT + b * CTX) * 128 + hkv * 64, Kg + (size_t)b * SEQ * 128 + hkv * 64,
                                        Vg + (size_t)(NLAT + b * CTX) * 128 + hkv * 64, Vg + (size_t)b * SEQ * 128 + hkv * 64, 128, 4 + SEQ / 64, 0, 0, 0.f, BR + qrow * DM + 256 + head_ * 64, DM, F.ldsg);
        } else if (a < nGL + nWL) {
            const int u = a - nGL, b = u >> 5, hkv = (u >> 4) & 1, qb = u & 15, head_ = hkv * 2 + (wid >> 2), q0 = qb * 128 + (wid & 3) * 32; const size_t qrow = (size_t)b * SEQ + q0;
            const int band0 = qb * 128 - 128 < 0 ? 0 : qb * 128 - 128, band1 = qb * 128 + 256 > SEQ ? SEQ : qb * 128 + 256;
            attn_body::attn_unit<1, 8>(Qw + qrow * 256 + head_ * 64, 256, Kw + (size_t)(NLAT + b * CTX) * 128 + hkv * 64, Kw + ((size_t)b * SEQ + band0) * 128 + hkv * 64,
                                        Vw + (size_t)(NLAT + b * CTX) * 128 + hkv * 64, Vw + ((size_t)b * SEQ + band0) * 128 + hkv * 64, 128, 4 + (band1 - band0) / 64, q0, band0,
                                        inptr(F, IN_SINK)[l * 4 + head_] * LOG2E, BR + qrow * DM + 768 + head_ * 64, DM, F.ldsg);
        } else if (a < nGL + nWL + nGC) {
            const int u = a - nGL - nWL, b = u >> 3, hkv = (u >> 2) & 1, qb = u & 3, head_ = hkv * 4 + (wid >> 1); const size_t qrow = (size_t)NLAT + b * CTX + qb * 64 + (wid & 1) * 32;
            const abf* Kc = Kg + (size_t)(NLAT + b * CTX) * 128 + hkv * 64; const abf* Vc = Vg + (size_t)(NLAT + b * CTX) * 128 + hkv * 64;
            attn_body::attn_unit<0, 8>(Qg + qrow * 512 + head_ * 64, 512, Kc, Kc, Vc, Vc, 128, 4, 0, 0, 0.f, BR + qrow * DM + 256 + head_ * 64, DM, F.ldsg);
        } else {
            const int u = a - nGL - nWL - nGC, b = u >> 2, hkv = (u >> 1) & 1, qb = u & 1, head_ = hkv * 2 + (wid >> 2); const size_t qrow = (size_t)NLAT + b * CTX + qb * 128 + (wid & 3) * 32;
            const abf* Kc = Kw + (size_t)(NLAT + b * CTX) * 128 + hkv * 64; const abf* Vc = Vw + (size_t)(NLAT + b * CTX) * 128 + hkv * 64;
            attn_body::attn_unit<1, 8>(Qw + qrow * 256 + head_ * 64, 256, Kc, Kc, Vc, Vc, 128, 4, 0, 0, inptr(F, IN_SINK)[l * 4 + head_] * LOG2E, BR + qrow * DM + 768 + head_ * 64, DM, F.ldsg);
        }
    }
    __syncthreads();
}
#ifndef MK_N_LAUNCHES
#define MK_N_LAUNCHES 1
#endif
constexpr int N_PHASES = 2 + 9 * DEPTH;
struct Args { const float* in[21]; float* out; unsigned char* ws; int ph_lo, ph_hi, probe, pad_; };

__global__ void __launch_bounds__(NWAVES * 64, 2) hybrid_fwd(Args args) {
    extern __shared__ __attribute__((aligned(16))) unsigned char lds[];
    Frame F;
    F.lds = (LAS unsigned char*)lds; F.ldsg = (char*)lds; F.MISC = (volatile LAS unsigned*)(F.lds + MISC_OFF);
    F.G = gridDim.x; { const int bx = blockIdx.x; F.vcu = (F.G % 8 == 0) ? (bx % 8) * (F.G / 8) + bx / 8 : bx; }
    F.ws = args.ws; F.out = args.out; F.dout = (unsigned char*)args.out; F.ctl = (gu32*)(args.ws + WS_CTL);
#ifdef DBG_LDSPOISON
    for (int u = threadIdx.x; u < LDSCTL_OFF / 4; u += NWAVES * 64) ((LAS unsigned*)F.lds)[u] = 0xFFFFFFFFu;
#endif
    for (int u = threadIdx.x; u < (LDS_BYTES - LDSCTL_OFF) / 4; u += NWAVES * 64) ((LAS unsigned*)(F.lds + LDSCTL_OFF))[u] = 0u;
    __syncthreads();
    if (threadIdx.x < 21) *(LAS unsigned long long*)(F.lds + PTRS_OFF + 8 * threadIdx.x) = (unsigned long long)args.in[threadIdx.x];
    __syncthreads();
    XcdBarrier bar; bar.bar = (unsigned*)(F.ctl + CW_BAR); bar.x = 0; bar.st = nullptr;
    const int lo = args.ph_lo, hi = args.ph_hi;
    if (hi - lo > 1) bar = xcd_barrier_post((unsigned*)(F.ctl + CW_BAR), F.MISC + 8);
#ifndef PHSEL
#define PHSEL 0x7ff
#endif
#define IN(k) (lo <= (k) && (k) < hi)
#define KIND(j) ((PHSEL >> (j)) & 1)
#ifndef DBG_PROBE
#define DBG_PROBE 0
#endif
#ifndef FPROBE_MODE
#define FPROBE_MODE 0
#endif
#ifndef REP_MASK
#define REP_MASK 0
#endif
#define NREP(j, ok) ((((REP_MASK) >> (j)) & 1) && (ok) ? 2 : 1)
#define REPEAT(j, ok) for (int rep_ = 0, nrep_ = NREP(j, ok); rep_ < nrep_; ++rep_, (rep_ < nrep_ ? xcd_barrier(bar) : (void)0))
#define SEAM(k) do { if (IN(k) && IN((k) + 1)) xcd_barrier(bar); } while (0)

#ifdef BAR_PROBE
    if (hi - lo > 1) for (int i_ = 0; i_ < BAR_PROBE; ++i_) xcd_barrier(bar);
#endif
    if (KIND(0) && IN(0)) REPEAT(0, true) { p0_prologue(F, rep_ ? DBG_PROBE : 0); } SEAM(0);
    if (KIND(1) && IN(1)) REPEAT(1, true) { p1_norm1(F); } SEAM(1);
    for (int l = 0; l < DEPTH; ++l) {
        const int pb = 2 + 9 * l; const bool lastl = l == DEPTH - 1;
        const int nrt = lastl ? 64 : 72;
        if (KIND(2) && IN(pb + 0)) REPEAT(2, true) {
            Strided<DecInProj> S; S.d.A = (const char*)(F.ws + WS_HN); S.d.B = (const char*)(F.ws + WS_WIN) + (size_t)l * INW2 * DM * 2; S.d.layer = l; S.n = inproj_units(l); S.G = F.G; S.vcu = F.vcu;
            EpiInProj E; E.ABt = (bf16*)(F.ws + WS_ABT); E.ABtc = (bf16*)(F.ws + WS_ABTC);
            E.Qg = (bf16*)(F.ws + WS_QKV + QKV_QG); E.Kg = (bf16*)(F.ws + WS_QKV + QKV_KG); E.Vg = (bf16*)(F.ws + WS_QKV + QKV_VG);
            E.Qw = (bf16*)(F.ws + WS_QKV + QKV_QW); E.Kw = (bf16*)(F.ws + WS_QKV + QKV_KW); E.Vw = (bf16*)(F.ws + WS_QKV + QKV_VW);
            E.G = WSP(bf16, WS_G); E.rope = WSP(float, WS_ROPE); E.qng = inptr(F, IN_QNG) + l * 64; E.kng = inptr(F, IN_KNG) + l * 64;
            pg8::gemm_phase<EpiInProj, Strided<DecInProj>>(F.lds, (LAS int*)(F.lds + IDXBUF_OFF), S, E);
            if (!CONV_IN_ATTN && l == 0 && F.G == 256 && F.vcu >= 88 && rep_ == 0) tail_convert(F, F.vcu - 88, 0, 4, 672);
        } SEAM(pb + 0);
        if (KIND(3) && IN(pb + 1)) REPEAT(3, true) { pc_mixers(F, l, rep_); } SEAM(pb + 1);
        if (KIND(4) && IN(pb + 2)) REPEAT(4, true) {
            SchedMerge S; S.BR = (const char*)(F.ws + WS_BR); S.W = (const char*)(F.ws + WS_WBR) + (size_t)l * DM * DM * 2; S.ntiles = nrt * 4; S.G = F.G; S.vcu = F.vcu;
            EpiMerge E{WSP(bf16, WS_G), (rep_ + 1 == nrep_ && !args.probe) ? (bf16*)(F.ws + WS_MB) : WSP(bf16, WS_HN), args.probe};
            pg8::gemm_phase<EpiMerge, SchedMerge>(F.lds, (LAS int*)(F.lds + IDXBUF_OFF), S, E);
            if (!CONV_IN_ATTN && l == 0 && F.G == 256 && F.vcu >= 32 && rep_ == 0) tail_convert(F, F.vcu - 32, 672, 3, 1344);
        } SEAM(pb + 2);
        if (KIND(5) && IN(pb + 3)) REPEAT(5, l == 0) {
            Strided<DecWout> S; S.d.Mb = (const char*)(F.ws + WS_MB); S.d.W = (const char*)(F.ws + WS_WOUT) + (size_t)l * DM * DM * 2; S.n = nrt * 4; S.G = F.G; S.vcu = F.vcu;
            EpiWout E; E.baseL = inptr(F, IN_X); E.baseC = inptr(F, IN_CTX) - (size_t)NLAT * DM; E.baseX = WSP(bf16, WS_X); E.X = WSP(bf16, WS_X); E.from_x = l != 0; E.mod = WSP(float, WS_MOD) + (size_t)l * 9 * 6 * DM;
            pg8::gemm_phase<EpiWout, Strided<DecWout>>(F.lds, (LAS int*)(F.lds + IDXBUF_OFF), S, E);
            if (!CONV_IN_ATTN && l == 0 && F.G == 256 && F.vcu >= 32 && rep_ == 0) tail_convert(F, F.vcu - 32, 1344, 3, 2016);
        } SEAM(pb + 3);
        if (KIND(6) && IN(pb + 4)) REPEAT(6, true) { pf_norm2_router(F, l, rep_ ? FPROBE_MODE : 0); } SEAM(pb + 4);
        if (KIND(7) && IN(pb + 5)) REPEAT(7, true) { pg_topk_gather(F, l); } SEAM(pb + 5);
        const int ert = lastl ? 8 : 9;
        if (KIND(8) && IN(pb + 6)) REPEAT(8, true) {
            Strided<DecGU> S; S.d.H2 = (const char*)(F.ws + WS_HN); S.d.IDX = WSP(int, WS_IDX); S.d.W = (const char*)(F.ws + WS_WGU) + (size_t)l * NE * 2 * DM * DM * 2; S.d.nrt = ert; S.n = NE * ert * 8; S.G = F.G; S.vcu = F.vcu;
            EpiGU E{WSP(bf16, WS_HACT)};
            pg8::gemm_phase<EpiGU, Strided<DecGU>>(F.lds, (LAS int*)(F.lds + IDXBUF_OFF), S, E);
            if (!CONV_IN_ATTN && l == 0 && F.G == 256 && F.vcu >= 128 && rep_ == 0) tail_convert(F, F.vcu - 128, 2016, 4, 2528);
        } SEAM(pb + 6);
        if (KIND(9) && IN(pb + 7)) REPEAT(9, true) {
            Strided<DecDown> S; S.d.H = (const char*)(F.ws + WS_HACT); S.d.W = (const char*)(F.ws + WS_WD) + (size_t)l * NE * DM * DM * 2; S.d.nrt = ert; S.n = NE * ert * 4; S.G = F.G; S.vcu = F.vcu;
            EpiDown E{WSP(bf16, WS_G), WSP(float, WS_AFS)};
            pg8::gemm_phase<EpiDown, Strided<DecDown>>(F.lds, (LAS int*)(F.lds + IDXBUF_OFF), S, E);
            if (!CONV_IN_ATTN && l == 0 && F.G == 256 && F.vcu >= 64 && rep_ == 0) tail_convert(F, F.vcu - 64, 2528, 3, CONV_ITEMS);
        } SEAM(pb + 7);
        if (KIND(10) && IN(pb + 8)) REPEAT(10, true) { pj_combine(F, l, rep_); }
        if (!lastl) SEAM(pb + 8);
    }
#undef IN
#undef SEAM
}

#ifdef DBG_STOP
__global__ void k_dump(const unsigned short* __restrict__ src, float* __restrict__ out, size_t n) {
    for (size_t i = (size_t)blockIdx.x * blockDim.x + threadIdx.x; i < n; i += (size_t)gridDim.x * blockDim.x) out[i] = __uint_as_float((unsigned)src[i] << 16);
}
#endif
extern "C" void kernel_launch(void* const* d_in, const int* in_sizes, int n_in, void* d_out, int out_size, void* d_ws, size_t ws_size, hipStream_t stream) {
    static int grid = 0;
    if (grid == 0) {
        if (n_in != 21 || out_size != NLAT * DM || ws_size < WS_END) { fprintf(stderr, "kernel_launch: unexpected problem (n_in %d, out %d, ws %zu < %zu)\n", n_in, out_size, ws_size, (size_t)WS_END); grid = -1; return; }
        int dev = 0, cus = 0, per_cu = 0;
        if (hipGetDevice(&dev) != hipSuccess || hipDeviceGetAttribute(&cus, hipDeviceAttributeMultiprocessorCount, dev) != hipSuccess) { grid = -1; return; }
        if (hipFuncSetAttribute((const void*)hybrid_fwd, hipFuncAttributeMaxDynamicSharedMemorySize, LDS_BYTES) != hipSuccess) { fprintf(stderr, "kernel_launch: hipFuncSetAttribute failed\n"); grid = -1; return; }
        if (hipOccupancyMaxActiveBlocksPerMultiprocessor(&per_cu, (const void*)hybrid_fwd, NWAVES * 64, LDS_BYTES) != hipSuccess || per_cu < 1) { fprintf(stderr, "kernel_launch: occupancy query says %d blocks/CU\n", per_cu); per_cu = 1; }
        (void)hipGetLastError();
        grid = cus * 1;
    }
    if (grid < 0) return;
    hipMemsetAsync((char*)d_ws + WS_CTL, 0, CTL_ZERO_BYTES, stream);
    Args a; memset(&a, 0, sizeof(a));
    for (int i = 0; i < 21; ++i) a.in[i] = (const float*)d_in[i];
    a.out = (float*)d_out; a.ws = (unsigned char*)d_ws;
#if MK_N_LAUNCHES == 1
    a.ph_lo = 0; a.ph_hi = N_PHASES;
    hipLaunchKernelGGL(hybrid_fwd, dim3(grid), dim3(NWAVES * 64), LDS_BYTES, stream, a);
#else
    int nph_ = N_PHASES;
#ifdef DBG_STOP
    nph_ = DBG_STOP;
#endif
    for (int p = 0; p < nph_; ++p) { a.ph_lo = p; a.ph_hi = p + 1; hipLaunchKernelGGL(hybrid_fwd, dim3(grid), dim3(NWAVES * 64), LDS_BYTES, stream, a);
#ifdef DBG_DUP_PHASE
        if (p == DBG_DUP_PHASE) { a.probe = DBG_PROBE; hipLaunchKernelGGL(hybrid_fwd, dim3(grid), dim3(NWAVES * 64), LDS_BYTES, stream, a); a.probe = 0; }
#endif
    }
#ifdef DBG_STOP
    hipLaunchKernelGGL(k_dump, dim3(2048), dim3(256), 0, stream, (const unsigned short*)((const char*)d_ws + ((size_t)DBG_DUMP_MIB << 20)), (float*)d_out, (size_t)NLAT * DM);
#endif
#endif
}
```

```cpp
#define MK_N_LAUNCHES 1
#include <hip/hip_runtime.h>
#include <hip/hip_bf16.h>
#include <cstdio>
#include <cstdint>
#include <cmath>
#include <cstring>

constexpr int DM = 1024, NBATCH = 8, SEQ = 2048, CTX = 256, DEPTH = 2;
constexpr int NLAT = NBATCH * SEQ, NCTX = NBATCH * CTX, NTOK = NLAT + NCTX;
constexpr int INW = 4608, NCOLT = 19, INW2 = NCOLT * 256;
constexpr int NE = 16, CAPL = 256, CAPC = 32, RPE = NBATCH * (CAPL + CAPC);
constexpr float EPS = 1e-6f;
constexpr float QSCALE = 0.125f * 1.4426950408889634f;
constexpr float LOG2E = 1.4426950408889634f;
namespace pg8 {
#define PG8_LAS __attribute__((address_space(3)))
typedef unsigned short bf16_t;
typedef short bf16x8 __attribute__((ext_vector_type(8)));
typedef float f32x4 __attribute__((ext_vector_type(4)));
typedef unsigned u32x4 __attribute__((ext_vector_type(4)));
typedef unsigned u32x2 __attribute__((ext_vector_type(2)));
constexpr int BM = 256, BK = 64, HALF = 128, HTB = HALF * BK * 2  , STAGE_BYTES = 8 * HTB;

__host__ __device__ __forceinline__ int lds_byte(int r, int c) { const int st = (r >> 4) * 2 + (c >> 5), rr = r & 15, cc = c & 31, ob = rr * 64 + cc * 2; return st * 1024 + (ob ^ (((ob >> 9) & 1) << 5)); }
__host__ __device__ __forceinline__ int perm32(int rho) { const int n = rho >> 4, i = rho & 15; return 8 * (i >> 2) + 4 * n + (i & 3); }
__host__ __device__ __forceinline__ void stage_rc(int b, int& R, int& C) { const int st = b / 1024, sb = b % 1024, swz = sb ^ (((sb >> 9) & 1) << 5); R = (st >> 1) * 16 + swz / 64; C = (st & 1) * 32 + (swz % 64) / 2; }

struct Unit { const char* A; const char* B; const int* arows; int ldA, ldB, nt; int pm, pn, tag; };

typedef float f32x2_c __attribute__((ext_vector_type(2)));
typedef __bf16 bf16x2_c __attribute__((ext_vector_type(2)));
__device__ __forceinline__ unsigned cvt_pk_bf16(float lo, float hi) { const f32x2_c v = {lo, hi}; const bf16x2_c b = __builtin_convertvector(v, bf16x2_c); return __builtin_bit_cast(unsigned, b); }

template <class Epi, class Sched>
__device__ __forceinline__ void gemm_phase(PG8_LAS unsigned char* lds, PG8_LAS int* idxbuf  , const Sched& S, const Epi& E) {
    int tid = threadIdx.x; asm volatile("" : "+v"(tid));
    const int wid = __builtin_amdgcn_readfirstlane(tid >> 6), lane = tid & 63, wr = wid >> 2, wc = wid & 3, fr = lane & 15, fq = lane >> 4;
    unsigned Rr[2], RrB[2], Cc2[2];
#pragma unroll
    for (int i = 0; i < 2; ++i) { int R, C; stage_rc(tid * 16 + i * 8192, R, C); Rr[i] = (unsigned)R; RrB[i] = Epi::PERM ? (unsigned)((R & ~31) + perm32(R & 31)) : (unsigned)R; Cc2[i] = (unsigned)C * 2u; }
    const size_t kstep = (size_t)(BK * 2);
    const unsigned ldsw = (unsigned)wid * 1024u;
    const int aoff = lds_byte(wr * 64 + fr, fq * 8), boff = lds_byte(wc * 32 + fr, fq * 8);
#define PG8_SA(b, h) (((b) * 2 + (h)) * HTB)
#define PG8_SB(b, h) ((4 + (b) * 2 + (h)) * HTB)
#define PG8_STAGE(bufoff, gbase, ld) do { _Pragma("unroll") for (int _i = 0; _i < 2; ++_i) \
        __builtin_amdgcn_global_load_lds((const unsigned*)((const char*)(gbase) + (RrB[_i] * (unsigned)(ld) + Cc2[_i])), (PG8_LAS unsigned*)(lds + (bufoff) + ldsw + _i * 8192), 16, 0, 0); } while (0)
#define PG8_STAGE_A(bufoff, gbase, ao) do { _Pragma("unroll") for (int _i = 0; _i < 2; ++_i) \
        __builtin_amdgcn_global_load_lds((const unsigned*)((const char*)(gbase) + (ao)[_i]), (PG8_LAS unsigned*)(lds + (bufoff) + ldsw + _i * 8192), 16, 0, 0); } while (0)
#define PG8_AOFF(u, ao) do { _Pragma("unroll") for (int _h = 0; _h < 2; ++_h) _Pragma("unroll") for (int _i = 0; _i < 2; ++_i) { \
        const unsigned _row = (u).arows ? (unsigned)idxbuf[Rr[_i] + 128 * _h] : Rr[_i] + 128u * _h; (ao)[_h][_i] = _row * (unsigned)(u).ldA + Cc2[_i]; } } while (0)
#define PG8_STAGE_IDX(u) do { if ((u).arows) __builtin_amdgcn_global_load_lds((const unsigned*)((u).arows + (wid & 3) * 64 + lane), (PG8_LAS unsigned*)((PG8_LAS unsigned char*)idxbuf + (wid & 3) * 256), 4, 0, 0); } while (0)
#define PG8_LDA(dst, b, h) do { _Pragma("unroll") for (int m = 0; m < 4; ++m) _Pragma("unroll") for (int k = 0; k < 2; ++k) dst[m][k] = *(const PG8_LAS bf16x8*)(lds + PG8_SA(b, h) + aoff + m * 2048 + k * 1024); } while (0)
#define PG8_LDB(dst, b, h) do { _Pragma("unroll") for (int n = 0; n < 2; ++n) _Pragma("unroll") for (int k = 0; k < 2; ++k) dst[n][k] = *(const PG8_LAS bf16x8*)(lds + PG8_SB(b, h) + boff + n * 2048 + k * 1024); } while (0)
#define PG8_MMA(ai, bj, At, Bt) do { __builtin_amdgcn_s_setprio(1); _Pragma("unroll") for (int m = 0; m < 4; ++m) _Pragma("unroll") for (int n = 0; n < 2; ++n) _Pragma("unroll") for (int k = 0; k < 2; ++k) \
        acc[ai][bj][m][n] = __builtin_amdgcn_mfma_f32_16x16x32_bf16(Bt[n][k], At[m][k], acc[ai][bj][m][n], 0, 0, 0); __builtin_amdgcn_s_setprio(0); } while (0)
#define PG8_WAIT_V(n) asm volatile("s_waitcnt vmcnt(" #n ")" ::: "memory")
#define PG8_WAIT_L(n) asm volatile("s_waitcnt lgkmcnt(" #n ")" ::: "memory")
#define PG8_BAR __builtin_amdgcn_s_barrier()
#define PG8_SCHED __builtin_amdgcn_sched_barrier(0)
    Unit cur, nxt; int ui = 0;
    if (!S.next(0, cur)) return;
    nxt = cur;
    f32x4 acc[2][2][4][2];
#pragma unroll
    for (int a = 0; a < 2; ++a)
#pragma unroll
        for (int b = 0; b < 2; ++b)
#pragma unroll
            for (int m = 0; m < 4; ++m)
#pragma unroll
                for (int n = 0; n < 2; ++n) acc[a][b][m][n] = (f32x4){0.f, 0.f, 0.f, 0.f};
    bf16x8 At[4][2], B0[2][2], B1[2][2];
    const char* cA = cur.A; const char* cB = cur.B; int clb = cur.ldB;
    unsigned ao_c[2][2], ao_n[2][2];
    if (cur.arows) { PG8_STAGE_IDX(cur); PG8_WAIT_V(0); PG8_BAR; }
    PG8_AOFF(cur, ao_c);
#pragma unroll
    for (int _h = 0; _h < 2; ++_h)
#pragma unroll
        for (int _i = 0; _i < 2; ++_i) ao_n[_h][_i] = ao_c[_h][_i];
    if (cur.arows) { PG8_WAIT_L(0); PG8_BAR; }
    {
        const size_t hB = (size_t)HALF * clb;
        PG8_STAGE(PG8_SB(0, 0), cB, clb); PG8_STAGE(PG8_SB(0, 1), cB + hB, clb); PG8_STAGE_A(PG8_SA(0, 0), cA, ao_c[0]); PG8_STAGE_A(PG8_SA(0, 1), cA, ao_c[1]);
        if (wr == 1) PG8_BAR;
        PG8_WAIT_V(2); PG8_BAR;
        PG8_STAGE(PG8_SB(1, 0), cB + kstep, clb); PG8_STAGE_A(PG8_SA(1, 0), cA + kstep, ao_c[0]); PG8_STAGE(PG8_SB(1, 1), cB + hB + kstep, clb);
        PG8_WAIT_V(6); PG8_BAR;
    }
    for (;;) {
        const bool has_next = S.next(ui + 1, nxt);
        const char* nA = has_next ? nxt.A : cA; const char* nB = has_next ? nxt.B : cB; const int nlb = has_next ? nxt.ldB : clb;
        const int nt = cur.nt;
        if (has_next) PG8_STAGE_IDX(nxt);
        for (int t = 0; t < nt; t += 2) {
            const bool last = (t == nt - 2);
            if (last) { if (has_next) { PG8_AOFF(nxt, ao_n); } else {
#pragma unroll
                for (int _h = 0; _h < 2; ++_h)
#pragma unroll
                    for (int _i = 0; _i < 2; ++_i) ao_n[_h][_i] = ao_c[_h][_i]; } }
            unsigned ao2[2][2];
#pragma unroll
            for (int _h = 0; _h < 2; ++_h)
#pragma unroll
                for (int _i = 0; _i < 2; ++_i) ao2[_h][_i] = last ? ao_n[_h][_i] : ao_c[_h][_i];
            const char* a1 = cA + (size_t)(t + 1) * kstep;
            const char* a2 = last ? nA : cA + (size_t)(t + 2) * kstep; const char* b2 = last ? nB : cB + (size_t)(t + 2) * kstep;
            const int lb2 = last ? nlb : clb;
            const size_t hB2 = (size_t)HALF * lb2;
            const char* a3 = a2 + kstep; const char* b3 = b2 + kstep;
            PG8_LDB(B0, 0, 0); PG8_LDB(B1, 0, 1); PG8_SCHED; PG8_LDA(At, 0, 0); PG8_STAGE_A(PG8_SA(1, 1), a1, ao_c[1]);
            PG8_WAIT_V(8); PG8_WAIT_L(0); PG8_BAR; PG8_MMA(0, 0, At, B0); PG8_MMA(0, 1, At, B1); PG8_BAR; PG8_SCHED;
            PG8_LDA(At, 0, 1); PG8_STAGE(PG8_SB(0, 0), b2, lb2); PG8_STAGE(PG8_SB(0, 1), b2 + hB2, lb2); PG8_STAGE_A(PG8_SA(0, 0), a2, ao2[0]);
            PG8_WAIT_V(8); PG8_WAIT_L(0); PG8_BAR; PG8_MMA(1, 0, At, B0); PG8_MMA(1, 1, At, B1); PG8_BAR; PG8_SCHED;
            PG8_LDB(B0, 1, 0); PG8_LDB(B1, 1, 1); PG8_SCHED; PG8_LDA(At, 1, 0); PG8_STAGE_A(PG8_SA(0, 1), a2, ao2[1]);
            PG8_WAIT_V(8); PG8_WAIT_L(0); PG8_BAR; PG8_MMA(0, 0, At, B0); PG8_MMA(0, 1, At, B1); PG8_BAR; PG8_SCHED;
            PG8_LDA(At, 1, 1); PG8_STAGE(PG8_SB(1, 0), b3, lb2); PG8_STAGE(PG8_SB(1, 1), b3 + hB2, lb2); PG8_STAGE_A(PG8_SA(1, 0), a3, ao2[0]);
            PG8_WAIT_V(8); PG8_WAIT_L(0); PG8_BAR; PG8_MMA(1, 0, At, B0); PG8_MMA(1, 1, At, B1); PG8_BAR; PG8_SCHED;
        }
        if (wr == 0) PG8_BAR;
        bool keep_acc;
        { Unit eu = cur; int ewr = wr, ewc = wc, efr = fr, efq = fq; asm volatile("" : "+s"(eu.pm), "+s"(eu.pn), "+s"(eu.tag), "+s"(ewr), "+s"(ewc), "+v"(efr), "+v"(efq));
          keep_acc = E(acc, eu, ewr, ewc, efr, efq); }
        if (!has_next) break;
        if (!keep_acc) {
#pragma unroll
        for (int a = 0; a < 2; ++a)
#pragma unroll
            for (int b = 0; b < 2; ++b)
#pragma unroll
                for (int m = 0; m < 4; ++m)
#pragma unroll
                    for (int n = 0; n < 2; ++n) acc[a][b][m][n] = (f32x4){0.f, 0.f, 0.f, 0.f};
        }
        cur = nxt; cA = nA; cB = nB; clb = nlb; ++ui;
#pragma unroll
        for (int _h = 0; _h < 2; ++_h)
#pragma unroll
            for (int _i = 0; _i < 2; ++_i) ao_c[_h][_i] = ao_n[_h][_i];
        if (wr == 1) PG8_BAR;
    }
    PG8_WAIT_V(0);
    PG8_BAR;
#undef PG8_SA
#undef PG8_SB
#undef PG8_STAGE
#undef PG8_STAGE_A
#undef PG8_AOFF
#undef PG8_STAGE_IDX
#undef PG8_LDA
#undef PG8_LDB
#undef PG8_MMA
#undef PG8_WAIT_V
#undef PG8_WAIT_L
#undef PG8_BAR
#undef PG8_SCHED
}
}
#include <hip/hip_bf16.h>
#include <cmath>
namespace attn_body {
using bf16=__hip_bfloat16;
using bf16x8=__attribute__((ext_vector_type(8)))short;
using s16x4=__attribute__((ext_vector_type(4)))short;
using f32x16=__attribute__((ext_vector_type(16)))float;
using u32x4=__attribute__((ext_vector_type(4)))unsigned;
constexpr int D=64;
constexpr int NW=8,QBLK=32,KVBLK=64,NCT=4;
__device__ __forceinline__ int crow(int r,int hi){return (r&3)+8*(r>>2)+4*hi;}
#define SBAR() __builtin_amdgcn_sched_barrier(0)
__device__ __forceinline__ void wmask(f32x16&p0,f32x16&p1,int kb,int qabs,int hi){
  const float NEG=-INFINITY; const int d0=kb+4*hi-qabs;
  #pragma unroll
  for(int r=0;r<16;++r){int dd=d0+(r&3)+8*(r>>2); if(dd>128||dd<-128)p0[r]=NEG; if(dd+32>128||dd+32<-128)p1[r]=NEG;}
}

constexpr int NSLOT=3, SLOTB=8192;
constexpr int LDS_K=0, LDS_V=NSLOT*SLOTB, LDS_WS=2*NSLOT*SLOTB, LDS_OST=LDS_WS+NW*64*4, LDS_BYTES=LDS_OST+NW*4096;
__device__ __forceinline__ void glds16(const void*gsrc,unsigned lds_dst){unsigned keep;
  asm volatile("s_mov_b32 %0, m0\n\ts_mov_b32 m0, %2\n\ts_nop 0\n\tglobal_load_lds_dwordx4 %1, off\n\ts_mov_b32 m0, %0":"=&s"(keep):"v"(gsrc),"s"(lds_dst):"memory");}
__device__ __forceinline__ float max3f(float a,float b,float c){float r;asm("v_max3_f32 %0, %1, %2, %3":"=v"(r):"v"(a),"v"(b),"v"(c));return r;}
__device__ __forceinline__ float max2f(float a,float b){float r;asm("v_max_f32_e32 %0, %1, %2":"=v"(r):"v"(a),"v"(b));return r;}
__device__ __forceinline__ float fadd_s(float a,float b){float r;asm("v_add_f32_e32 %0, %1, %2":"=v"(r):"v"(a),"v"(b));return r;}
__device__ __forceinline__ float fsub_s(float a,float b){float r;asm("v_sub_f32_e32 %0, %1, %2":"=v"(r):"v"(a),"v"(b));return r;}
typedef float f32x2_t __attribute__((ext_vector_type(2))); typedef __bf16 bf16x2_t __attribute__((ext_vector_type(2)));
__device__ __forceinline__ unsigned cvtpk_s(float lo,float hi){f32x2_t v={lo,hi};bf16x2_t b=__builtin_convertvector(v,bf16x2_t);return __builtin_bit_cast(unsigned,b);}
#define WAIT_BAR(N) asm volatile("s_waitcnt vmcnt(" #N ") lgkmcnt(0)\n\ts_barrier":::"memory")

__device__ __forceinline__ void qkt(f32x16&p0,f32x16&p1,const char*Kslot,const bf16x8*qr,const f32x16&negm,int r32,int hi){
  const char*kb=Kslot+hi*1024+r32*16;
  #pragma unroll
  for(int d0=0;d0<4;++d0){
    const bf16x8 b0=*reinterpret_cast<const bf16x8*>(kb+d0*2048);
    const bf16x8 b1=*reinterpret_cast<const bf16x8*>(kb+d0*2048+512);
    if(d0==0){p0=__builtin_amdgcn_mfma_f32_32x32x16_bf16(b0,qr[0],negm,0,0,0);p1=__builtin_amdgcn_mfma_f32_32x32x16_bf16(b1,qr[0],negm,0,0,0);}
    else{p0=__builtin_amdgcn_mfma_f32_32x32x16_bf16(b0,qr[d0],p0,0,0,0);p1=__builtin_amdgcn_mfma_f32_32x32x16_bf16(b1,qr[d0],p1,0,0,0);}}
}
typedef __attribute__((address_space(3))) const char* lds_cptr;
typedef short v4i16_t __attribute__((ext_vector_type(4)));
__device__ __forceinline__ void kload8(bf16x8*kf,lds_cptr kp){
  kf[0]=*(const __attribute__((address_space(3))) bf16x8*)(kp);      kf[1]=*(const __attribute__((address_space(3))) bf16x8*)(kp+512);
  kf[2]=*(const __attribute__((address_space(3))) bf16x8*)(kp+2048); kf[3]=*(const __attribute__((address_space(3))) bf16x8*)(kp+2560);
  kf[4]=*(const __attribute__((address_space(3))) bf16x8*)(kp+4096); kf[5]=*(const __attribute__((address_space(3))) bf16x8*)(kp+4608);
  kf[6]=*(const __attribute__((address_space(3))) bf16x8*)(kp+6144); kf[7]=*(const __attribute__((address_space(3))) bf16x8*)(kp+6656);
}
__device__ __forceinline__ void kload2(bf16x8*kf,lds_cptr kp,int j){ kf[2*j]=*(const __attribute__((address_space(3))) bf16x8*)(kp+j*2048); kf[2*j+1]=*(const __attribute__((address_space(3))) bf16x8*)(kp+j*2048+512); }
__device__ __forceinline__ s16x4 vtr(lds_cptr p){ return __builtin_bit_cast(s16x4,__builtin_amdgcn_ds_read_tr16_b64_v4i16((__attribute__((address_space(3))) v4i16_t*)p)); }
__device__ __forceinline__ float rowmax(const f32x16&p0,const f32x16&p1){
  float a=max3f(p0[0],p0[1],p1[0]),b=max3f(p0[2],p0[3],p1[1]);a=max3f(a,p1[2],p1[3]);
  #pragma unroll
  for(int r=4;r<16;r+=4){a=max3f(a,p0[r],p0[r+1]);b=max3f(b,p0[r+2],p0[r+3]);a=max3f(a,p1[r],p1[r+1]);b=max3f(b,p1[r+2],p1[r+3]);}
  const float m=max2f(a,b);
  auto rr=__builtin_amdgcn_permlane32_swap(__float_as_uint(m),__float_as_uint(m),false,false);
  return max2f(__uint_as_float(rr[0]),__uint_as_float(rr[1]));
}
__device__ __forceinline__ void pv(f32x16*o,int vb,bf16x8 pa0,bf16x8 pa1,bf16x8 pa2,bf16x8 pa3){
  #pragma unroll
  for(int d0=0;d0<2;++d0){s16x4 lo[4],hi[4];
    #pragma unroll
    for(int ks=0;ks<4;++ks){
      asm volatile("ds_read_b64_tr_b16 %0,%1 offset:%c2":"=&v"(lo[ks]):"v"(vb),"i"(d0*4096+ks*1024):"memory");
      asm volatile("ds_read_b64_tr_b16 %0,%1 offset:%c2":"=&v"(hi[ks]):"v"(vb),"i"(d0*4096+ks*1024+512):"memory");}
    asm volatile("s_waitcnt lgkmcnt(0)":::"memory");SBAR();
    #define PK(k) (bf16x8){lo[k][0],lo[k][1],lo[k][2],lo[k][3],hi[k][0],hi[k][1],hi[k][2],hi[k][3]}
    o[d0]=__builtin_amdgcn_mfma_f32_32x32x16_bf16(pa0,PK(0),o[d0],0,0,0);
    o[d0]=__builtin_amdgcn_mfma_f32_32x32x16_bf16(pa1,PK(1),o[d0],0,0,0);
    o[d0]=__builtin_amdgcn_mfma_f32_32x32x16_bf16(pa2,PK(2),o[d0],0,0,0);
    o[d0]=__builtin_amdgcn_mfma_f32_32x32x16_bf16(pa3,PK(3),o[d0],0,0,0);
    #undef PK
  }
}

#ifndef ATTN_STORE16
#define ATTN_STORE16(p,v) (*(u32x4*)(p)=(v))
#endif
template<int MODE,int THRL> __device__ __forceinline__ void attn_unit(const bf16*Qw,int qp,const bf16*Kc,const bf16*Kl,const bf16*Vc,const bf16*Vl,int kp,int NT,int qabs,int band0,float sinkl2,bf16*Ow,int op,char*shm){
  int tid=threadIdx.x; asm volatile("":"+v"(tid));
  const int lane=tid&63,r32=lane&31,hi=lane>>5; const int wid=__builtin_amdgcn_readfirstlane(tid>>6);
  qabs+=r32;
  const unsigned lds0=(unsigned)(uintptr_t)shm;
  float*wsf=(float*)(shm+LDS_WS)+wid*64;
  const unsigned koff_=(unsigned)(lane*kp+wid*8)*2u;
  const unsigned voff_=(unsigned)((16*(wid&3)+(lane>>2))*kp+(wid>>2)*32+(lane&3)*8)*2u;
  const unsigned kdst=lds0+LDS_K+wid*1024, vdst=lds0+LDS_V+wid*1024;
  #define DMA_K(t,slot) glds16((const char*)((t)<NCT?Kc+(long)(t)*KVBLK*kp:Kl+(long)((t)-NCT)*KVBLK*kp)+koff_,(unsigned)__builtin_amdgcn_readfirstlane(kdst+(slot)))
  #define DMA_V(t,slot) glds16((const char*)((t)<NCT?Vc+(long)(t)*KVBLK*kp:Vl+(long)((t)-NCT)*KVBLK*kp)+voff_,(unsigned)__builtin_amdgcn_readfirstlane(vdst+(slot)))
  const int vb0=(int)(lds0+LDS_V)+((lane>>4)&1)*32+(lane&3)*8+(4*hi+((lane&15)>>2))*64;
  const char*Kbase=shm+LDS_K; bf16x8 kf[8];
  const lds_cptr shm3=(lds_cptr)shm; const lds_cptr kp0=shm3+LDS_K+hi*1024+r32*16; const lds_cptr vp0=shm3+LDS_V+((lane>>4)&1)*32+(lane&3)*8+(4*hi+((lane&15)>>2))*64;
  DMA_K(0,0);DMA_V(0,0);DMA_K(1,SLOTB);
  bf16x8 qr[4];
  #pragma unroll
  for(int d0=0;d0<4;++d0)qr[d0]=*reinterpret_cast<const bf16x8*>(&Qw[(long)r32*qp+d0*16+hi*8]);
  float mhat=0.f,l_reg=0.f;f32x16 o[2];o[0]=f32x16{};o[1]=f32x16{};f32x16 negm=f32x16{};asm volatile("":"+v"(negm));
  #define CMASK(P0,P1,t) do{ if(MODE==1){ if((t)>=NCT)wmask(P0,P1,band0+KVBLK*((t)-NCT),qabs,hi);} }while(0)
  bool resc=false;
  #define START(P0,P1) do{ const float rm=rowmax(P0,P1); resc=false; \
    { const float dl=rm; mhat=fadd_s(mhat,dl); \
      _Pragma("unroll") for(int r=0;r<16;++r){P0[r]=fsub_s(P0[r],dl);P1[r]=fsub_s(P1[r],dl);} \
      _Pragma("unroll") for(int r=0;r<16;++r)negm[r]=-mhat; asm volatile("":"+v"(negm)); } \
    _Pragma("unroll") for(int r=0;r<16;++r)P0[r]=__builtin_amdgcn_exp2f(P0[r]); }while(0)
  #define RESC() do{ if(resc){ asm volatile("s_waitcnt lgkmcnt(0)":::"memory"); \
      _Pragma("unroll") for(int d_=0;d_<2;++d_) _Pragma("unroll") for(int r=0;r<16;++r)o[d_][r]*=wsf[crow(r,hi)]; } }while(0)
  f32x16 pA0,pA1,pB0,pB1;
  int sl_prev=0,sl_cur=0,sl_next=SLOTB;
  #define ROT() do{sl_prev=sl_cur;sl_cur=sl_next;sl_next=(sl_next==(NSLOT-1)*SLOTB)?0:sl_next+SLOTB;}while(0)
  DMA_K(2,2*SLOTB);
  WAIT_BAR(3);
  qkt(pA0,pA1,Kbase,qr,negm,r32,hi);asm volatile("s_nop 15\n\ts_nop 7":"+v"(pA0),"+v"(pA1));CMASK(pA0,pA1,0);
  START(pA0,pA1);
  _Pragma("unroll") for(int r=0;r<16;++r)pA1[r]=__builtin_amdgcn_exp2f(pA1[r]);
  WAIT_BAR(0);
  DMA_K(3,0);DMA_V(1,SLOTB);
  ROT();
  kload8(kf,kp0+sl_cur);
  WAIT_BAR(2);
  s16x4 vlo[8],vhi[8]; u32x4 pw0,pw1,pw2,pw3;
  #define PKW(P,B) cvtpk_s(P[B],P[B+1])
  #define PAF(k) __builtin_bit_cast(bf16x8,pw##k)
  #define VFR(i) (bf16x8){vlo[i][0],vlo[i][1],vlo[i][2],vlo[i][3],vhi[i][0],vhi[i][1],vhi[i][2],vhi[i][3]}
  #define PIN(x) asm volatile("":"+v"(x))
  #define MX3(a,b,c) __builtin_fmaxf(__builtin_fmaxf((a),(b)),(c))
  #define GAPA(MF,A0,A1,A2,A3,W0,W1,PW) do{ MF; sacc+=A0; sacc+=A1; sacc+=A2; sacc+=A3; PIN(sacc); W0; W1; PIN(PW); SBAR(); }while(0)
  #define EX(v) __builtin_amdgcn_exp2f(v)
  #define GAPB(MF,X,B) do{ MF; X[B]=EX(X[B]); X[B+1]=EX(X[B+1]); X[B+2]=EX(X[B+2]); X[B+3]=EX(X[B+3]); PIN(X); SBAR(); }while(0)
  #define VRD(i) do{ vlo[i]=vtr(vp_+(((i)>>2)*4096+((i)&3)*1024)); vhi[i]=vtr(vp_+(((i)>>2)*4096+((i)&3)*1024+512)); }while(0)
  #define KRD(G,j) do{ if(G){ kload2(kf,kp0+sl_next,j); SBAR(); } }while(0)
  #define STEP(C0,C1,P0,P1,t,GK,GV,GL) do{ SBAR(); \
    const lds_cptr vp_=vp0+sl_prev; \
    VRD(0); SBAR(); float sacc=(P0[0]+P0[1]); \
    GAPA(C0=__builtin_amdgcn_mfma_f32_32x32x16_bf16(kf[0],qr[0],negm,0,0,0), P0[2],P0[3],P0[4],P0[5],     pw0[0]=PKW(P0,0), pw0[1]=PKW(P0,2), pw0); \
    VRD(4); SBAR(); GAPA(C1=__builtin_amdgcn_mfma_f32_32x32x16_bf16(kf[1],qr[0],negm,0,0,0), P0[6],P0[7],P0[8],P0[9],     pw0[2]=PKW(P0,4), pw0[3]=PKW(P0,6), pw0); \
    VRD(1); SBAR(); GAPA(C0=__builtin_amdgcn_mfma_f32_32x32x16_bf16(kf[2],qr[1],C0,0,0,0),   P0[10],P0[11],P0[12],P0[13], pw1[0]=PKW(P0,8), pw1[1]=PKW(P0,10), pw1); \
    VRD(5); SBAR(); GAPA(C1=__builtin_amdgcn_mfma_f32_32x32x16_bf16(kf[3],qr[1],C1,0,0,0),   P0[14],P0[15],P1[0],P1[1],   pw1[2]=PKW(P0,12),pw1[3]=PKW(P0,14), pw1); \
    VRD(2); SBAR(); GAPA(C0=__builtin_amdgcn_mfma_f32_32x32x16_bf16(kf[4],qr[2],C0,0,0,0),   P1[2],P1[3],P1[4],P1[5],     pw2[0]=PKW(P1,0), pw2[1]=PKW(P1,2), pw2); \
    VRD(6); SBAR(); GAPA(C1=__builtin_amdgcn_mfma_f32_32x32x16_bf16(kf[5],qr[2],C1,0,0,0),   P1[6],P1[7],P1[8],P1[9],     pw2[2]=PKW(P1,4), pw2[3]=PKW(P1,6), pw2); \
    VRD(3); SBAR(); GAPA(C0=__builtin_amdgcn_mfma_f32_32x32x16_bf16(kf[6],qr[3],C0,0,0,0),   P1[10],P1[11],P1[12],P1[13], pw3[0]=PKW(P1,8), pw3[1]=PKW(P1,10), pw3); \
    VRD(7); SBAR(); GAPA(C1=__builtin_amdgcn_mfma_f32_32x32x16_bf16(kf[7],qr[3],C1,0,0,0),   P1[14],P1[15],0.f,0.f,       pw3[2]=PKW(P1,12),pw3[3]=PKW(P1,14), pw3); \
    l_reg+=sacc; \
    if(GK){DMA_K((t)+3,sl_cur);} if(GV){DMA_V((t)+1,sl_next);} \
    CMASK(C0,C1,t); \
    { float a=MX3(C0[0],C0[1],C1[0]),b=MX3(C0[2],C0[3],C1[1]); a=MX3(a,C1[2],C1[3]); \
      _Pragma("unroll") for(int r=4;r<16;r+=4){a=MX3(a,C0[r],C0[r+1]);b=MX3(b,C0[r+2],C0[r+3]);a=MX3(a,C1[r],C1[r+1]);b=MX3(b,C1[r+2],C1[r+3]);} \
      float rm=__builtin_fmaxf(a,b); { auto rr=__builtin_amdgcn_permlane32_swap(__float_as_uint(rm),__float_as_uint(rm),false,false); rm=__builtin_fmaxf(__uint_as_float(rr[0]),__uint_as_float(rr[1])); } \
      resc=false; \
      if(__builtin_expect(__any(rm>(float)THRL),0)){ const float dl=__builtin_fmaxf(rm,0.f); mhat+=dl; \
        _Pragma("unroll") for(int r=0;r<16;++r){C0[r]-=dl;C1[r]-=dl;} \
        _Pragma("unroll") for(int r=0;r<16;++r)negm[r]=-mhat; asm volatile("":"+v"(negm)); \
        const float f=__builtin_amdgcn_exp2f(-dl); l_reg*=f; if(hi==0)wsf[r32]=f; resc=true; } } \
    SBAR(); \
    GAPB(o[0]=__builtin_amdgcn_mfma_f32_32x32x16_bf16(PAF(0),VFR(0),o[0],0,0,0), C0,0); \
    GAPB(o[1]=__builtin_amdgcn_mfma_f32_32x32x16_bf16(PAF(0),VFR(4),o[1],0,0,0), C0,4); \
    KRD(GL,0); GAPB(o[0]=__builtin_amdgcn_mfma_f32_32x32x16_bf16(PAF(1),VFR(1),o[0],0,0,0), C0,8); \
    KRD(GL,1); GAPB(o[1]=__builtin_amdgcn_mfma_f32_32x32x16_bf16(PAF(1),VFR(5),o[1],0,0,0), C0,12); \
    KRD(GL,2); GAPB(o[0]=__builtin_amdgcn_mfma_f32_32x32x16_bf16(PAF(2),VFR(2),o[0],0,0,0), C1,0); \
    KRD(GL,3); GAPB(o[1]=__builtin_amdgcn_mfma_f32_32x32x16_bf16(PAF(2),VFR(6),o[1],0,0,0), C1,4); \
    GAPB(o[0]=__builtin_amdgcn_mfma_f32_32x32x16_bf16(PAF(3),VFR(3),o[0],0,0,0), C1,8); \
    GAPB(o[1]=__builtin_amdgcn_mfma_f32_32x32x16_bf16(PAF(3),VFR(7),o[1],0,0,0), C1,12); \
    }while(0)
  int t=1;
  for(;t+5<NT;t+=2){
    STEP(pB0,pB1,pA0,pA1,t,true,true,true);     WAIT_BAR(2); RESC(); ROT();
    STEP(pA0,pA1,pB0,pB1,t+1,true,true,true);   WAIT_BAR(2); RESC(); ROT();
  }
  #define ENDW(tt) do{ if((tt)+3<NT){WAIT_BAR(2);} else if((tt)+2<NT){WAIT_BAR(1);} else {WAIT_BAR(0);} }while(0)
  for(;t+1<NT;t+=2){
    STEP(pB0,pB1,pA0,pA1,t,(t+3<NT),(t+1<NT),(t+1<NT));       ENDW(t);   RESC(); ROT();
    STEP(pA0,pA1,pB0,pB1,t+1,(t+4<NT),(t+2<NT),(t+2<NT));     ENDW(t+1); RESC(); ROT();
  }
  STEP(pB0,pB1,pA0,pA1,NT-1,false,false,false); RESC();
  { float sacc=pB0[0]+pB0[1]; _Pragma("unroll") for(int r=2;r<16;++r)sacc+=pB0[r]; _Pragma("unroll") for(int r=0;r<16;++r)sacc+=pB1[r]; l_reg+=sacc;
    pw0=(u32x4){PKW(pB0,0),PKW(pB0,2),PKW(pB0,4),PKW(pB0,6)};pw1=(u32x4){PKW(pB0,8),PKW(pB0,10),PKW(pB0,12),PKW(pB0,14)};pw2=(u32x4){PKW(pB1,0),PKW(pB1,2),PKW(pB1,4),PKW(pB1,6)};pw3=(u32x4){PKW(pB1,8),PKW(pB1,10),PKW(pB1,12),PKW(pB1,14)};
    SBAR(); pv(o,vb0+sl_cur,PAF(0),PAF(1),PAF(2),PAF(3)); }
  #undef PKW
  #undef PAF
  #undef VFR
  #undef PIN
  #undef MX3
  #undef GAPA
  #undef GAPB
  #undef EX
  #undef VRD
  #undef KRD
  #undef STEP
  #undef ENDW
  {auto rr=__builtin_amdgcn_permlane32_swap(__float_as_uint(l_reg),__float_as_uint(l_reg),false,false);l_reg=__uint_as_float(rr[0])+__uint_as_float(rr[1]);}
  if(MODE==1)l_reg+=__builtin_amdgcn_exp2f(sinkl2-mhat);
  if(hi==0)wsf[32+r32]=l_reg;asm volatile("s_waitcnt lgkmcnt(0)":::"memory");
  float rli[16];
  #pragma unroll
  for(int r=0;r<16;++r)rli[r]=__builtin_amdgcn_rcpf(wsf[32+crow(r,hi)]);
  { bf16*stg=(bf16*)(shm+LDS_OST)+wid*2048;
    #pragma unroll
    for(int r=0;r<16;++r){const int orow=crow(r,hi);
      #pragma unroll
      for(int d0=0;d0<2;++d0)stg[orow*64+d0*32+r32]=__float2bfloat16(o[d0][r]*rli[r]);}
    asm volatile("s_waitcnt lgkmcnt(0)":::"memory");
    #pragma unroll
    for(int i=0;i<4;++i){const int row=i*8+(lane>>3),ch=lane&7; const u32x4 v=*(const u32x4*)(stg+row*64+ch*8); ATTN_STORE16(Ow+(long)row*op+ch*8,v);} }
  asm volatile("s_waitcnt lgkmcnt(0)\n\ts_barrier":::"memory");
  #undef DMA_K
  #undef DMA_V
  #undef CMASK
  #undef START
  #undef RESC
  #undef ROT
}
constexpr int ATTN_LDS_BYTES=LDS_BYTES;
#undef SBAR
#undef WAIT_BAR
}
constexpr int NWAVES = 8;
constexpr size_t MiB = 1u << 20;
constexpr size_t WS_CTL = 0, CTL_ZERO_BYTES = 256 * 1024;
constexpr size_t WS_MOD = 1 * MiB;
constexpr size_t WS_ROPE = WS_MOD + 512 * 1024;
constexpr size_t WS_AFS = WS_ROPE + 64 * 1024;
constexpr size_t WS_IDX = WS_AFS + 192 * 1024;
constexpr size_t WS_SEL = 2 * MiB;
constexpr size_t WS_AFF = 4 * MiB;
constexpr size_t WS_ABTC = WS_AFF;
constexpr size_t WS_WIN = 6 * MiB;
constexpr size_t WS_WBR = 25 * MiB;
constexpr size_t WS_WOUT = 29 * MiB;
constexpr size_t WS_DFT = 33 * MiB;
constexpr size_t WS_DFTC = 49 * MiB;
constexpr size_t WS_WGU = 50 * MiB;
constexpr size_t WS_WD = 178 * MiB;
constexpr size_t WS_X = 242 * MiB;
constexpr size_t WS_HN = 314 * MiB;
constexpr size_t WS_MB = WS_HN;
constexpr size_t WS_QKV = 350 * MiB;
constexpr size_t WS_G = 395 * MiB;
constexpr size_t WS_BR = 503 * MiB;
constexpr size_t WS_HACT = 467 * MiB;
constexpr size_t WS_ABT = 539 * MiB;
constexpr size_t WS_END = 555 * MiB;
constexpr size_t QKV_QG = 0, QKV_KG = (size_t)NTOK * 512 * 2, QKV_VG = QKV_KG + (size_t)NTOK * 128 * 2, QKV_QW = QKV_VG + (size_t)NTOK * 128 * 2,
                 QKV_KW = QKV_QW + (size_t)NTOK * 256 * 2, QKV_VW = QKV_KW + (size_t)NTOK * 128 * 2;
static_assert(WS_WIN + (size_t)DEPTH * INW2 * DM * 2 <= WS_WBR && WS_QKV + QKV_VW + (size_t)NTOK * 128 * 2 <= WS_G && WS_G + (size_t)NTOK * 3 * DM * 2 <= WS_BR && WS_HACT >= WS_G + (size_t)NE * RPE * DM * 2 &&
              WS_HACT + (size_t)NE * RPE * DM * 2 <= WS_ABT && WS_ABT + (size_t)NBATCH * 256 * 2 * SEQ * 2 <= WS_END && (size_t)NBATCH * 256 * 2 * CTX * 2 <= 2 * MiB, "d_ws map");
constexpr int CW_BAR = 1024;
constexpr int CW_QUEUE = 8192;
constexpr int CW_CONVQ = 8192 + 64 * 8;
constexpr int CW_FIN = CW_CONVQ + 64;
constexpr int RING_BYTES = 131072;
constexpr int LDSCTL_OFF = RING_BYTES, MISC_OFF = LDSCTL_OFF + 320;
constexpr int IDXBUF_OFF = LDSCTL_OFF + 1024 + 8192;
constexpr int LDS_BYTES = 147456;

#define GAS __attribute__((address_space(1)))
#define LAS __attribute__((address_space(3)))
typedef unsigned short bf16;
typedef unsigned v4u __attribute__((ext_vector_type(4)));
typedef unsigned v2u __attribute__((ext_vector_type(2)));
typedef float f32x4 __attribute__((ext_vector_type(4)));
typedef GAS unsigned gu32;
#define RLX_AGENT __ATOMIC_RELAXED, __HIP_MEMORY_SCOPE_AGENT
#define LDS_WAIT() asm volatile("s_waitcnt lgkmcnt(0)" ::: "memory")
#define VM_WAIT() asm volatile("s_waitcnt vmcnt(0)" ::: "memory")
__device__ __forceinline__ unsigned f2bf(float f) { unsigned u = __builtin_bit_cast(unsigned, f); return (u + 0x7fffu + ((u >> 16) & 1u)) >> 16; }
__device__ __forceinline__ unsigned pk2(float lo, float hi) { return f2bf(lo) | (f2bf(hi) << 16); }
__device__ __forceinline__ float bf2f(unsigned short h) { return __builtin_bit_cast(float, (unsigned)h << 16); }
__device__ __forceinline__ float bflo(unsigned w) { return __builtin_bit_cast(float, w << 16); }
__device__ __forceinline__ float bfhi(unsigned w) { return __builtin_bit_cast(float, w & 0xffff0000u); }

#define XB_TMO      128
#define XB_XCNT(j)  (256  + 64 * (j))
#define XB_XSUB(j)  (1280 + 64 * (j))
#define XB_XGEN(j)  (2304 + 64 * (j))
#define XB_TOP      3328
#define XB_TOPGEN   3392
#define XCD_BAR_WORDS 3456
#define XB_SPIN_CAP (1u << 20)
__device__ __forceinline__ unsigned xb_ld(unsigned* p)              { return __hip_atomic_load(p, __ATOMIC_RELAXED, __HIP_MEMORY_SCOPE_AGENT); }
__device__ __forceinline__ unsigned xb_add(unsigned* p, unsigned v) { return __hip_atomic_fetch_add(p, v, __ATOMIC_RELAXED, __HIP_MEMORY_SCOPE_AGENT); }
__device__ __forceinline__ unsigned xb_xcc_id() { return (unsigned)__builtin_amdgcn_s_getreg((3 << 11) | 20) & 0xFu; }
#define XB_SPIN(cond, bar) do { unsigned _sp = 0; while (cond) { __builtin_amdgcn_s_sleep(1); \
    if ((++_sp & 255u) == 0u) { if (xb_ld(&(bar)[XB_TMO])) break; if (_sp > XB_SPIN_CAP) { atomicAdd(&(bar)[XB_TMO], 1u); break; } } } } while (0)
struct XcdBarrier { unsigned* bar; unsigned x; volatile LAS unsigned* st; };
__device__ __forceinline__ XcdBarrier xcd_barrier_post(unsigned* bar, volatile LAS unsigned* st) {
    XcdBarrier b; b.bar = bar; b.x = xb_xcc_id(); b.st = st;
    if (threadIdx.x == 0) (void)xb_add(&bar[XB_XCNT(b.x)], 1u);
    return b;
}
__device__ __forceinline__ void xcd_barrier_complete(unsigned* bar, unsigned x, unsigned& nloc, unsigned& nx) {
    const unsigned G = gridDim.x * gridDim.y * gridDim.z;
    unsigned sum, cnt, mine, sp = 0u;
    for (;;) {
        sum = 0u; cnt = 0u; mine = 0u;
#pragma unroll
        for (unsigned j = 0; j < 16; ++j) { const unsigned c = xb_ld(&bar[XB_XCNT(j)]); sum += c; cnt += (c > 0u) ? 1u : 0u; mine = (j == x) ? c : mine; }
        if (sum == G) break;
        __builtin_amdgcn_s_sleep(1);
        if ((++sp & 255u) == 0u) { if (xb_ld(&bar[XB_TMO])) break; if (sp > XB_SPIN_CAP) { atomicAdd(&bar[XB_TMO], 1u); break; } }
    }
    nloc = mine > 0u ? mine : 1u; nx = cnt > 0u ? cnt : 1u;
}
__device__ __forceinline__ void xcd_barrier(const XcdBarrier& b) {
    asm volatile("s_waitcnt vmcnt(0)" ::: "memory");
    __syncthreads();
    if (threadIdx.x == 0) {
        unsigned* bar = b.bar;
        __builtin_amdgcn_s_waitcnt(0);
        unsigned nloc = b.st[0], nx = b.st[1];
        if (nloc == 0u) { xcd_barrier_complete(bar, b.x, nloc, nx); b.st[0] = nloc; b.st[1] = nx; }
        const unsigned old = xb_add(&bar[XB_XSUB(b.x)], 1u);
        const unsigned gen = old / nloc;
        if (old + 1u == (gen + 1u) * nloc) {
            __builtin_amdgcn_fence(__ATOMIC_RELEASE, "agent");
            asm volatile("s_waitcnt vmcnt(0)" ::: "memory");
            const unsigned og = xb_add(&bar[XB_TOP], 1u);
            const unsigned tg = og / nx;
            if (og + 1u == (tg + 1u) * nx) xb_add(&bar[XB_TOPGEN], 1u);
            else XB_SPIN(xb_ld(&bar[XB_TOPGEN]) == tg, bar);
            __builtin_amdgcn_fence(__ATOMIC_ACQUIRE, "agent");
            xb_add(&bar[XB_XGEN(b.x)], 1u);
            asm volatile("s_waitcnt vmcnt(0)" ::: "memory");
        } else {
            XB_SPIN(xb_ld(&bar[XB_XGEN(b.x)]) == gen, bar);
            __builtin_amdgcn_fence(__ATOMIC_ACQUIRE, "agent");
            asm volatile("s_waitcnt vmcnt(0)" ::: "memory");
        }
    }
    __syncthreads();
}
template <int CTRL> __device__ __forceinline__ float dpp_mov(float v) { return __builtin_bit_cast(float, __builtin_amdgcn_update_dpp(0, __builtin_bit_cast(int, v), CTRL, 0xF, 0xF, true)); }
__device__ __forceinline__ float lx1(float v) { return dpp_mov<0xB1>(v); }
__device__ __forceinline__ float lx2(float v) { return dpp_mov<0x4E>(v); }
__device__ __forceinline__ float lx4(float v) { return dpp_mov<0x1B>(dpp_mov<0x141>(v)); }
__device__ __forceinline__ float lx8(float v) { return dpp_mov<0x141>(dpp_mov<0x140>(v)); }
__device__ __forceinline__ float lx16(float v) { return __shfl_xor(v, 16); }
__device__ __forceinline__ float lx32(float v) { const unsigned u = __builtin_bit_cast(unsigned, v); auto r = __builtin_amdgcn_permlane32_swap(u, u, false, false);
    return __builtin_bit_cast(float, (threadIdx.x & 32) ? r[0] : r[1]); }
__device__ __forceinline__ float wave_sum(float v) {
    v += lx1(v); v += lx2(v); v += lx4(v); v += lx8(v); v += lx16(v); v += lx32(v);
    return v;
}
using pg8::Unit;
typedef pg8::f32x4 (&AccRef)[2][2][4][2];

__device__ __forceinline__ v2u pack4(f32x4 v) { v2u w; w.x = pg8::cvt_pk_bf16(v[0], v[1]); w.y = pg8::cvt_pk_bf16(v[2], v[3]); return w; }
__device__ __forceinline__ float rsig_(float t) { return 1.f + __builtin_amdgcn_exp2f(t); }
__device__ __forceinline__ float sigmoidf_(float v) { return __builtin_amdgcn_rcpf(1.f + __builtin_amdgcn_exp2f(-LOG2E * v)); }

template <class Dec> struct Strided {
    Dec d; int n, G, vcu;
    __device__ __forceinline__ bool next(int i, Unit& u) const { const int L = i * G + vcu; if (L >= n) return false; d(L, u); return true; }
};

struct DecInProj { const char* A; const char* B; int layer;
    __device__ __forceinline__ void operator()(int L, Unit& u) const {
        int pm, pn;
        if (L < 1024) { const int cg = L >> 8, rg = (L & 255) >> 5, w = L & 31; pm = rg * 8 + (w & 7); pn = cg * 4 + (w >> 3); }
        else if (L < 1216) { const int q = L - 1024, rg = q / 24, w = q % 24; pm = rg * 8 + (w & 7); pn = 16 + (w >> 3); }
        else { const int q = L - 1216; pm = 64 + (q & 7); pn = q >> 3; if (layer == DEPTH - 1) pn = pn ? 6 : 4; }
        u.A = A + (size_t)pm * 256 * (DM * 2); u.B = B + (size_t)pn * 256 * (DM * 2); u.arows = nullptr; u.ldA = DM * 2; u.ldB = DM * 2; u.nt = DM / 64; u.pm = pm; u.pn = pn; u.tag = 0;
        if (pn < 2) { const char* t = u.A; u.A = u.B; u.B = t; }
    } };
constexpr int inproj_units(int layer) { return 1216 + (layer == DEPTH - 1 ? 16 : 152); }

struct EpiInProj {
    static constexpr bool PERM = true;
    bf16 *ABt, *ABtc, *Qg, *Kg, *Vg, *Qw, *Kw, *Vw, *G; const LAS float* rope; const LAS float* qng; const LAS float* kng;
    __device__ __forceinline__ bool operator()(AccRef acc, const Unit& u, int wr, int wc, int fr, int fq) const {
        const int pm = u.pm, pn = u.pn; const bool lat = pm < 64;
        const int rowt = wr * 64 + fr;
        if (pn < 2) {
            bf16* dst; int ld;
            if (lat) { dst = ABt + ((size_t)(pm >> 3) * 256) * (2 * SEQ) + pn * SEQ + (pm & 7) * 256; ld = 2 * SEQ; }
            else { dst = ABtc + ((size_t)(pm - 64) * 256) * (2 * CTX) + pn * CTX; ld = 2 * CTX; }
            dst += (size_t)rowt * ld + wc * 32 + fq * 8;
#pragma unroll
            for (int ai = 0; ai < 2; ++ai)
#pragma unroll
                for (int m = 0; m < 4; ++m)
#pragma unroll
                    for (int bj = 0; bj < 2; ++bj) { const v2u o0 = pack4(acc[ai][bj][m][0]), o1 = pack4(acc[ai][bj][m][1]);
                        *(v4u*)(dst + (size_t)(ai * 128 + m * 16) * ld + bj * 128) = (v4u){o0.x, o0.y, o1.x, o1.y}; }
        } else if (pn < 7) {
            bf16* dst; int ld; const LAS float* ng = nullptr; bool rope_on = false; float sc = 1.f;
            if (pn <= 3)      { dst = Qg + (pn - 2) * 256 + wc * 64; ld = 512; ng = qng; rope_on = lat; sc = QSCALE; }
            else if (pn == 4) { if (wc < 2) { dst = Kg + wc * 64; ng = kng; rope_on = lat; } else { dst = Vg + (wc - 2) * 64; } ld = 128; }
            else if (pn == 5) { dst = Qw + wc * 64; ld = 256; rope_on = lat; sc = QSCALE; }
            else              { if (wc < 2) { dst = Kw + wc * 64; rope_on = lat; } else { dst = Vw + (wc - 2) * 64; } ld = 128; }
#pragma unroll
            for (int ai = 0; ai < 2; ++ai)
#pragma unroll
                for (int m = 0; m < 4; ++m) {
                    const int row = pm * 256 + rowt + ai * 128 + m * 16;
                    pg8::f32x4 v[2][2];
                    float ss = 0.f;
#pragma unroll
                    for (int bj = 0; bj < 2; ++bj)
#pragma unroll
                        for (int n = 0; n < 2; ++n) { v[bj][n] = acc[ai][bj][m][n]; ss += (v[bj][n][0] * v[bj][n][0] + v[bj][n][1] * v[bj][n][1]) + (v[bj][n][2] * v[bj][n][2] + v[bj][n][3] * v[bj][n][3]); }
                    float r = sc;
                    if (ng) { ss += __shfl_xor(ss, 16); ss += __shfl_xor(ss, 32); r = sc * rsqrtf(ss * (1.f / 64.f) + EPS); }
                    const int t = row & (SEQ - 1);
#pragma unroll
                    for (int bj = 0; bj < 2; ++bj) { v2u o[2];
#pragma unroll
                        for (int n = 0; n < 2; ++n) {
                            pg8::f32x4 x = v[bj][n] * r; if (ng) x = x * *(const LAS pg8::f32x4*)(ng + bj * 32 + fq * 8 + n * 4);
                            if (rope_on) {
                                const int pos = bj ? (t & 63) : (t >> 6);
                                const pg8::f32x4 cs = *(const LAS pg8::f32x4*)(rope + (pos * 16 + fq * 4 + n * 2) * 2);
                                x = (pg8::f32x4){x[0] * cs[0] - x[1] * cs[1], x[0] * cs[1] + x[1] * cs[0], x[2] * cs[2] - x[3] * cs[3], x[2] * cs[3] + x[3] * cs[2]};
                            }
                            o[n] = pack4(x);
                        }
                        *(v4u*)(dst + (size_t)row * ld + bj * 32 + fq * 8) = (v4u){o[0].x, o[0].y, o[1].x, o[1].y}; }
                    asm volatile("" ::: "memory");
                }
        } else {
            bf16* dst = G + ((size_t)pm * 12 + (pn - 7)) * 65536 + (size_t)(((wr * 4 + wc) * 64 + fq * 16 + fr) * 8);
#pragma unroll
            for (int ai = 0; ai < 2; ++ai)
#pragma unroll
                for (int bj = 0; bj < 2; ++bj)
#pragma unroll
                    for (int m = 0; m < 4; ++m) { const pg8::f32x4 a = acc[ai][bj][m][0], b = acc[ai][bj][m][1];
                        const v2u lo = pack4((pg8::f32x4){rsig_(a[0]), rsig_(a[1]), rsig_(a[2]), rsig_(a[3])}), hi = pack4((pg8::f32x4){rsig_(b[0]), rsig_(b[1]), rsig_(b[2]), rsig_(b[3])});
                        *(v4u*)(dst + (size_t)(((ai * 2 + bj) * 4 + m) * 4096)) = (v4u){lo.x, lo.y, hi.x, hi.y}; }
        }
        return false;
    }
};

struct EpiStore { static constexpr bool PERM = true; bf16* O; int ld;
    __device__ __forceinline__ bool operator()(AccRef acc, const Unit& u, int wr, int wc, int fr, int fq) const {
        bf16* dst = O + ((size_t)u.pm * 256 + wr * 64 + fr) * ld + u.pn * 256 + wc * 32 + fq * 8;
#pragma unroll
        for (int ai = 0; ai < 2; ++ai)
#pragma unroll
            for (int m = 0; m < 4; ++m)
#pragma unroll
                for (int bj = 0; bj < 2; ++bj) { const v2u o0 = pack4(acc[ai][bj][m][0]), o1 = pack4(acc[ai][bj][m][1]);
                    *(v4u*)(dst + (size_t)(ai * 128 + m * 16) * ld + bj * 128) = (v4u){o0.x, o0.y, o1.x, o1.y}; }
        return false;
    } };
struct DecDft { const char* Dm; const char* Dc; const char* ABt; const char* ABtc;
    __device__ __forceinline__ void operator()(int L, Unit& u) const {
        if (L < 64) { const int b = L >> 3, mt = L & 7; u.A = Dm + (size_t)mt * 256 * (4 * SEQ); u.B = ABt + (size_t)b * 256 * (4 * SEQ); u.ldA = 4 * SEQ; u.ldB = 4 * SEQ; u.nt = 2 * SEQ / 64; u.pm = L; }
        else { const int b = L - 64; u.A = Dc; u.B = ABtc + (size_t)b * 256 * (4 * CTX); u.ldA = 4 * CTX; u.ldB = 4 * CTX; u.nt = 2 * CTX / 64; u.pm = 64 + b; }
        u.pn = 0; u.tag = 0; u.arows = nullptr;
    } };

struct SchedMerge { const char* BR; const char* W; int ntiles, G, vcu;
    __device__ __forceinline__ bool next(int i, Unit& u) const {
        const int round = i / 3, tag = i - round * 3, tile = round * G + vcu; if (tile >= ntiles) return false;
        const int pm = tile >> 2, pn = tile & 3, koff = tag == 0 ? 0 : (tag == 1 ? 256 : 768);
        u.A = BR + (size_t)pm * 256 * (DM * 2) + koff * 2; u.B = W + (size_t)pn * 256 * (DM * 2) + koff * 2; u.arows = nullptr; u.ldA = DM * 2; u.ldB = DM * 2; u.nt = tag == 1 ? 8 : 4; u.pm = pm; u.pn = pn; u.tag = tag;
        return true;
    } };
struct EpiMerge { static constexpr bool PERM = true; const bf16* G; bf16* Mb; int probe;
    __device__ __forceinline__ bool operator()(AccRef acc, const Unit& u, int wr, int wc, int fr, int fq) const {
        const size_t row0 = (size_t)u.pm * 256 + wr * 64 + fr; const int col0 = u.pn * 256 + wc * 32 + fq * 8; const int tag = u.tag;
        const GAS char* gt = (const GAS char*)(G + ((size_t)u.pm * 12 + tag * 4 + u.pn) * 65536);
        const unsigned lo = (unsigned)(((wr * 4 + wc) * 64 + fq * 16 + fr) * 16);
        if (tag < 2) {
#pragma unroll
            for (int q = 0; q < 4; ++q) { const int ai = q >> 1, bj = q & 1;
                v4u gwv[4], hwv[4];
#pragma unroll
                for (int m = 0; m < 4; ++m) { const GAS char* gp = gt + (size_t)((q * 4 + m) * 8192); asm volatile("" : "+s"(gp)); gwv[m] = *(const GAS v4u*)(gp + lo); }
#pragma unroll
                for (int m = 0; m < 4; ++m) { const GAS char* gp = gt + (size_t)(4 * 131072 + (q * 4 + m) * 8192); asm volatile("" : "+s"(gp)); hwv[m] = *(const GAS v4u*)(gp + lo); }
#pragma unroll
                for (int m = 0; m < 4; ++m) { const v4u gw = gwv[m], hw = hwv[m];
                    const pg8::f32x4 ga = {__builtin_amdgcn_rcpf(bflo(gw.x)) * bflo(hw.x), __builtin_amdgcn_rcpf(bfhi(gw.x)) * bfhi(hw.x), __builtin_amdgcn_rcpf(bflo(gw.y)) * bflo(hw.y), __builtin_amdgcn_rcpf(bfhi(gw.y)) * bfhi(hw.y)};
                    const pg8::f32x4 gb = {__builtin_amdgcn_rcpf(bflo(gw.z)) * bflo(hw.z), __builtin_amdgcn_rcpf(bfhi(gw.z)) * bfhi(hw.z), __builtin_amdgcn_rcpf(bflo(gw.w)) * bflo(hw.w), __builtin_amdgcn_rcpf(bfhi(gw.w)) * bfhi(hw.w)};
                    acc[ai][bj][m][0] = acc[ai][bj][m][0] * ga; acc[ai][bj][m][1] = acc[ai][bj][m][1] * gb; }
                asm volatile("" ::: "memory");
            }
        } else {
#pragma unroll
            for (int ai = 0; ai < 2; ++ai) {
                v4u gwv[8];
#pragma unroll
                for (int i = 0; i < 8; ++i) { const GAS char* gp = gt + (size_t)((ai * 8 + i) * 8192); asm volatile("" : "+s"(gp)); gwv[i] = *(const GAS v4u*)(gp + lo); }
#pragma unroll
                for (int i = 0; i < 8; ++i) { const int bj = i >> 2, m = i & 3; const v4u gw = gwv[i];
                    const pg8::f32x4 ga = {__builtin_amdgcn_rcpf(bflo(gw.x)), __builtin_amdgcn_rcpf(bfhi(gw.x)), __builtin_amdgcn_rcpf(bflo(gw.y)), __builtin_amdgcn_rcpf(bfhi(gw.y))};
                    const pg8::f32x4 gb = {__builtin_amdgcn_rcpf(bflo(gw.z)), __builtin_amdgcn_rcpf(bfhi(gw.z)), __builtin_amdgcn_rcpf(bflo(gw.w)), __builtin_amdgcn_rcpf(bfhi(gw.w))};
                    const size_t row = row0 + ai * 128 + m * 16; const int c = col0 + bj * 128;
                    const v2u o0 = pack4(acc[ai][bj][m][0] * ga), o1 = pack4(acc[ai][bj][m][1] * gb); *(v4u*)(Mb + row * DM + c) = (v4u){o0.x, o0.y, o1.x, o1.y}; }
                asm volatile("" ::: "memory");
            }
        }
        return tag < 2;
    } };

struct DecWout { const char* Mb; const char* W;
    __device__ __forceinline__ void operator()(int L, Unit& u) const { const int pm = L >> 2, pn = L & 3;
        u.A = Mb + (size_t)pm * 256 * (DM * 2); u.B = W + (size_t)pn * 256 * (DM * 2); u.arows = nullptr; u.ldA = DM * 2; u.ldB = DM * 2; u.nt = DM / 64; u.pm = pm; u.pn = pn; u.tag = 0; } };
struct EpiWout { static constexpr bool PERM = true; const float* baseL; const float* baseC; const bf16* baseX; bf16* X; const float* mod; int from_x;
    __device__ __forceinline__ bool operator()(AccRef acc, const Unit& u, int wr, int wc, int fr, int fq) const {
        const int pm = u.pm; const float* base = pm < 64 ? baseL : baseC; const float* g1 = mod + (size_t)(pm < 64 ? (pm >> 3) : 8) * (6 * DM) + 2 * DM;
        const size_t row0 = (size_t)pm * 256 + wr * 64 + fr; const int col0 = u.pn * 256 + wc * 32 + fq * 8;
#pragma unroll
        for (int bj = 0; bj < 2; ++bj) { const int c = col0 + bj * 128; const pg8::f32x4 gv0 = *(const pg8::f32x4*)(g1 + c), gv1 = *(const pg8::f32x4*)(g1 + c + 4);
            if (from_x) {
                v4u w[8];
#pragma unroll
                for (int i = 0; i < 8; ++i) w[i] = *(const v4u*)(baseX + (row0 + (i >> 2) * 128 + (i & 3) * 16) * DM + c);
#pragma unroll
                for (int i = 0; i < 8; ++i) { const int ai = i >> 2, m = i & 3; const size_t off = (row0 + ai * 128 + m * 16) * DM + c;
                    const pg8::f32x4 b0 = {bflo(w[i].x), bfhi(w[i].x), bflo(w[i].y), bfhi(w[i].y)}, b1 = {bflo(w[i].z), bfhi(w[i].z), bflo(w[i].w), bfhi(w[i].w)};
                    const v2u o0 = pack4(b0 + gv0 * acc[ai][bj][m][0]), o1 = pack4(b1 + gv1 * acc[ai][bj][m][1]);
                    *(v4u*)(X + off) = (v4u){o0.x, o0.y, o1.x, o1.y}; }
            } else {
#pragma unroll
                for (int ai = 0; ai < 2; ++ai) {
                    pg8::f32x4 b0[4], b1[4];
#pragma unroll
                    for (int m = 0; m < 4; ++m) { const size_t off = (row0 + ai * 128 + m * 16) * DM + c; b0[m] = *(const pg8::f32x4*)(base + off); b1[m] = *(const pg8::f32x4*)(base + off + 4); }
#pragma unroll
                    for (int m = 0; m < 4; ++m) { const size_t off = (row0 + ai * 128 + m * 16) * DM + c;
                        const v2u o0 = pack4(b0[m] + gv0 * acc[ai][bj][m][0]), o1 = pack4(b1[m] + gv1 * acc[ai][bj][m][1]);
                        *(v4u*)(X + off) = (v4u){o0.x, o0.y, o1.x, o1.y}; }
                    asm volatile("" ::: "memory");
                }
            }
            asm volatile("" ::: "memory");
        }
        return false;
    } };

struct DecGU { const char* H2; const int* IDX; const char* W; int nrt;
    __device__ __forceinline__ void operator()(int L, Unit& u) const { const int per = nrt * 8, e = L / per, q = L - e * per, ct = q & 7, rt = q >> 3;
        u.A = H2; u.arows = IDX + (size_t)e * RPE + rt * 256; u.B = W + ((size_t)e * 2 * DM + ct * 256) * (DM * 2); u.ldA = DM * 2; u.ldB = DM * 2; u.nt = DM / 64; u.pm = rt; u.pn = ct; u.tag = e; } };
struct EpiGU { static constexpr bool PERM = true; bf16* H;
    __device__ __forceinline__ bool operator()(AccRef acc, const Unit& u, int wr, int wc, int fr, int fq) const {
        bf16* dst = H + ((size_t)u.tag * RPE + u.pm * 256 + wr * 64 + fr) * DM + u.pn * 128 + wc * 32 + fq * 8;
#pragma unroll
        for (int ai = 0; ai < 2; ++ai)
#pragma unroll
            for (int m = 0; m < 4; ++m) { v2u o[2];
#pragma unroll
                for (int n = 0; n < 2; ++n) { const pg8::f32x4 a = acc[ai][0][m][n], up = acc[ai][1][m][n];
                    o[n] = pack4((pg8::f32x4){a[0] * sigmoidf_(a[0]) * up[0], a[1] * sigmoidf_(a[1]) * up[1], a[2] * sigmoidf_(a[2]) * up[2], a[3] * sigmoidf_(a[3]) * up[3]}); }
                *(v4u*)(dst + (size_t)(ai * 128 + m * 16) * DM) = (v4u){o[0].x, o[0].y, o[1].x, o[1].y}; }
        return false;
    } };
struct DecDown { const char* H; const char* W; int nrt;
    __device__ __forceinline__ void operator()(int L, Unit& u) const { const int per = nrt * 4, e = L / per, q = L - e * per, ct = q & 3, rt = q >> 2;
        u.A = H + ((size_t)e * RPE + rt * 256) * (DM * 2); u.arows = nullptr; u.B = W + ((size_t)e * DM + ct * 256) * (DM * 2); u.ldA = DM * 2; u.ldB = DM * 2; u.nt = DM / 64; u.pm = rt; u.pn = ct; u.tag = e; } };
struct EpiDown { static constexpr bool PERM = true; bf16* Y; const float* afs;
    __device__ __forceinline__ bool operator()(AccRef acc, const Unit& u, int wr, int wc, int fr, int fq) const {
        const size_t r0 = (size_t)u.tag * RPE + u.pm * 256 + wr * 64 + fr;
        float av[2][4];
#pragma unroll
        for (int ai = 0; ai < 2; ++ai)
#pragma unroll
            for (int m = 0; m < 4; ++m) av[ai][m] = afs[r0 + ai * 128 + m * 16];
#pragma unroll
        for (int ai = 0; ai < 2; ++ai)
#pragma unroll
            for (int m = 0; m < 4; ++m) { const size_t r = r0 + ai * 128 + m * 16; const float a = av[ai][m];
#pragma unroll
                for (int bj = 0; bj < 2; ++bj) { const v2u o0 = pack4(acc[ai][bj][m][0] * a), o1 = pack4(acc[ai][bj][m][1] * a);
                    *(v4u*)(Y + r * DM + u.pn * 256 + bj * 128 + wc * 32 + fq * 8) = (v4u){o0.x, o0.y, o1.x, o1.y}; } }
        return false;
    } };
struct Frame {
    LAS unsigned char* lds; char* ldsg; volatile LAS unsigned* MISC; gu32* ctl;
    int vcu, G;
    unsigned char* ws; unsigned char* dout; float* out;
};
constexpr int PTRS_OFF = LDSCTL_OFF + 512;
enum { IN_X = 0, IN_C, IN_CTX, IN_CCTX, IN_WADA, IN_BADA, IN_NORM1G, IN_WIN, IN_QNG, IN_KNG, IN_SINK, IN_WBRF, IN_WBRG, IN_WBRW, IN_WOUT, IN_NORM2G, IN_WROUTER, IN_WGATE, IN_WUP, IN_WDOWN, IN_FINALG };
__device__ __forceinline__ const float* inptr(const Frame& F, int k) {
    const unsigned long long v = *(const LAS unsigned long long*)(F.lds + PTRS_OFF + 8 * k);
    const unsigned lo = __builtin_amdgcn_readfirstlane((unsigned)v), hi = __builtin_amdgcn_readfirstlane((unsigned)(v >> 32));
    return (const float*)(((unsigned long long)hi << 32) | lo);
}
#define WSP(T, off) ((T*)(F.ws + (off)))

constexpr int COSTAB_OFF = LDSCTL_OFF + 1024;
static_assert(COSTAB_OFF + 8192 <= LDS_BYTES, "cos table fits");
__device__ __forceinline__ void transpose_item(const float* W, int ldw, int k0, int n0, bf16* WT, int drow0, int dld, int dk0, int lane, float sc = 1.f) {
    const int g = lane >> 3, n4 = (lane & 7) * 4;
    const float* src = W + (size_t)(k0 + 8 * g) * ldw + n0 + n4;
    f32x4 v[8];
#pragma unroll
    for (int i = 0; i < 8; ++i) v[i] = *(const GAS f32x4*)(src + (size_t)i * ldw);
    bf16* dst = WT + (size_t)(drow0 + n4) * dld + dk0 + k0 + 8 * g;
#pragma unroll
    for (int j = 0; j < 4; ++j) { v4u o; o.x = pk2(v[0][j] * sc, v[1][j] * sc); o.y = pk2(v[2][j] * sc, v[3][j] * sc); o.z = pk2(v[4][j] * sc, v[5][j] * sc); o.w = pk2(v[6][j] * sc, v[7][j] * sc);
        *(GAS v4u*)(dst + (size_t)j * dld) = o; }
}
__device__ __forceinline__ void transpose_item2(const float* W, int ldw, int k0, int n0, bf16* WT, int drow0, int dld, int lane) {
    const int g = lane >> 3, n4 = (lane & 7) * 4;
    const float* src = W + (size_t)(k0 + 8 * g) * ldw + n0 + n4;
    f32x4 v[2][8];
#pragma unroll
    for (int h = 0; h < 2; ++h)
#pragma unroll
        for (int i = 0; i < 8; ++i) v[h][i] = __builtin_nontemporal_load((const GAS f32x4*)(src + (size_t)(h * 64 + i) * ldw));
    bf16* dst = WT + (size_t)(drow0 + n4) * dld + k0 + 8 * g;
#pragma unroll
    for (int h = 0; h < 2; ++h)
#pragma unroll
        for (int j = 0; j < 4; ++j) { v4u o; o.x = pk2(v[h][0][j], v[h][1][j]); o.y = pk2(v[h][2][j], v[h][3][j]); o.z = pk2(v[h][4][j], v[h][5][j]); o.w = pk2(v[h][6][j], v[h][7][j]);
            __builtin_nontemporal_store(o, (GAS v4u*)(dst + (size_t)j * dld + h * 64)); }
}
__device__ __forceinline__ void fold_item(const float* W, int k0, int g, int sinmode, bf16* WT, int drow0, LAS float* scr, const LAS float* ctab, int lane) {
#pragma unroll
    for (int kk = 0; kk < 16; ++kk) scr[lane * 20 + kk] = W[(size_t)(k0 + kk) * INW + g * 64 + lane];
    LDS_WAIT(); asm volatile("" ::: "memory");
    float acc[16];
#pragma unroll
    for (int k = 0; k < 16; ++k) acc[k] = 0.f;
#pragma unroll 4
    for (int c = 0; c < 64; ++c) {
        const int r = (c * lane) & 63;
        const float tv = sinmode ? -ctab[((r - 16) & 63) * 32] : ctab[r * 32];
#pragma unroll
        for (int k4 = 0; k4 < 4; ++k4) { const f32x4 w = *(const LAS f32x4*)(scr + c * 20 + 4 * k4);
            acc[4 * k4] = fmaf(w[0], tv, acc[4 * k4]); acc[4 * k4 + 1] = fmaf(w[1], tv, acc[4 * k4 + 1]); acc[4 * k4 + 2] = fmaf(w[2], tv, acc[4 * k4 + 2]); acc[4 * k4 + 3] = fmaf(w[3], tv, acc[4 * k4 + 3]); }
    }
    GAS v4u* dst = (GAS v4u*)(WT + (size_t)(drow0 + lane) * DM + k0);
#pragma unroll
    for (int q = 0; q < 2; ++q) { v4u o; o.x = pk2(acc[8 * q], acc[8 * q + 1]); o.y = pk2(acc[8 * q + 2], acc[8 * q + 3]); o.z = pk2(acc[8 * q + 4], acc[8 * q + 5]); o.w = pk2(acc[8 * q + 6], acc[8 * q + 7]); dst[q] = o; }
    LDS_WAIT(); asm volatile("" ::: "memory");
}

#ifndef CONV_IN_ATTN
#define CONV_IN_ATTN 0
#endif
constexpr int CONV_WAVE_ITEMS = DEPTH * NE * 768, CONV_ITEMS = CONV_WAVE_ITEMS / NWAVES, CONV_ITEMS_L0 = CONV_ITEMS / DEPTH;
__device__ __forceinline__ void conv_wave_item(Frame& F, int r, int lane) {
    const int le = r / 768, q = r % 768, which = q / 256, qq = q % 256, kb = qq >> 5, nb = qq & 31, f0 = nb * 32;
    if (which < 2) transpose_item2((which ? inptr(F, IN_WUP) : inptr(F, IN_WGATE)) + (size_t)le * DM * DM, DM, kb * 128, f0, WSP(bf16, WS_WGU) + (size_t)le * 2 * DM * DM, (f0 >> 7) * 256 + which * 128 + (f0 & 127), DM, lane);
    else transpose_item2(inptr(F, IN_WDOWN) + (size_t)le * DM * DM, DM, kb * 128, f0, WSP(bf16, WS_WD) + (size_t)le * DM * DM, f0, DM, lane);
}
__device__ __forceinline__ void tail_convert(Frame& F, int idx, int first, int per, int end) {
    int tid_ = threadIdx.x; asm volatile("" : "+v"(tid_));
    const int lane = tid_ & 63, wave_ = __builtin_amdgcn_readfirstlane(tid_ >> 6);
    for (int t = 0; t < per; ++t) { const int it = first + idx * per + t; if (it >= end) break; conv_wave_item(F, it * NWAVES + wave_, lane); }
}

__device__ __forceinline__ void p0_prologue(Frame& F, int mode = 0) {
    int tid_ = threadIdx.x; asm volatile("" : "+v"(tid_));
    const int lane = tid_ & 63, wave_ = __builtin_amdgcn_readfirstlane(tid_ >> 6);
    const int gw = F.vcu * NWAVES + wave_, NGW = F.G * NWAVES;
    LAS float* st = (LAS float*)F.lds;
    LAS float* red = (LAS float*)(F.lds + 40960);
    LAS float* ctab = (LAS float*)(F.lds + COSTAB_OFF);
    { const float* cp = inptr(F, IN_C); const float* ccp = inptr(F, IN_CCTX);
#pragma unroll 6
      for (int i = tid_; i < 9 * DM; i += NWAVES * 64) { const int s = i / DM, k = i - s * DM; const float v = s < 8 ? cp[s * DM + k] : ccp[k]; st[i] = v / (1.f + expf(-v)); } }
    for (int i = tid_; i < 2048; i += NWAVES * 64) ctab[i] = cosf(6.283185307179586f * (float)i * (1.f / 2048.f));
    __syncthreads();
    const float* bada = inptr(F, IN_BADA);
    if (mode != 2) for (int it = F.vcu; it < DEPTH * 96; it += F.G) {
        const int l = it / 96, j = (it % 96) * 64 + lane, kb = wave_ * 128;
        const float* W = inptr(F, IN_WADA) + (size_t)l * DM * 6 * DM + (size_t)kb * 6 * DM + j;
        float acc[9];
#pragma unroll
        for (int s = 0; s < 9; ++s) acc[s] = 0.f;
        for (int k0 = 0; k0 < 128; k0 += 16) {
            float w[16];
#pragma unroll
            for (int i = 0; i < 16; ++i) w[i] = W[(size_t)(k0 + i) * 6 * DM];
#pragma unroll
            for (int i = 0; i < 16; ++i)
#pragma unroll
                for (int s = 0; s < 9; ++s) acc[s] = fmaf(st[s * DM + kb + k0 + i], w[i], acc[s]);
        }
#pragma unroll
        for (int s = 0; s < 9; ++s) red[(wave_ * 9 + s) * 64 + lane] = acc[s];
        __syncthreads();
        for (int o = tid_; o < 9 * 64; o += NWAVES * 64) { float v = 0.f;
#pragma unroll
            for (int w = 0; w < 8; ++w) v += red[w * 576 + o];
            const int s = o >> 6, jj = (it % 96) * 64 + (o & 63);
            WSP(float, WS_MOD)[((size_t)l * 9 + s) * 6 * DM + jj] = v + bada[l * 6 * DM + jj]; }
        __syncthreads();
    }
    __syncthreads();
#ifdef DBG_POISON
    {
        const size_t n16 = (WS_END - WS_X) / 16, m16 = ((size_t)NLAT * DM * 4) / 16; const v4u pz = {0xFFFFFFFFu, 0xFFFFFFFFu, 0xFFFFFFFFu, 0xFFFFFFFFu};
        for (size_t i = (size_t)gw * 64 + lane; i < n16; i += (size_t)NGW * 64) ((GAS v4u*)(F.ws + WS_X))[i] = pz;
        for (size_t i = (size_t)gw * 64 + lane; i < m16; i += (size_t)NGW * 64) ((GAS v4u*)F.dout)[i] = pz;
    }
#endif
    LAS float* scr = (LAS float*)(F.lds + wave_ * 16384);
    constexpr int T_A = DEPTH * 2176, T_B = DEPTH * 512, T_C = DEPTH * 512, T_D = DEPTH * 512, T_E = DEPTH * NE * 768, T_F = SEQ + CTX, T_G = 1;
    constexpr int NITEMS = T_A + T_B + T_C + T_D + T_E + T_F + T_G;
    if (mode != 1 && mode != 5 && mode != 6) for (int it = gw; it < NITEMS; it += NGW) {
        int r = it;
        if (r < T_A) { const int l = r / 2176, q = r % 2176, kb = q / 136, nb = q % 136, s0 = 256 + nb * 32;
            int drow; if (s0 < 1536) { const int tile = 2 + ((s0 - 256) >> 8), hh = ((s0 - 256) & 255) >> 6, dh = (s0 & 63) >> 5; drow = tile * 256 + dh * 128 + hh * 32; } else drow = s0 + 256;
            transpose_item(inptr(F, IN_WIN) + (size_t)l * DM * INW, INW, kb * 64, s0, WSP(bf16, WS_WIN) + (size_t)l * INW2 * DM, drow, DM, 0, lane, s0 < 1536 ? 1.f : -LOG2E); continue; } r -= T_A;
        if (r < T_B) { const int l = r / 512, q = r % 512, kq = q & 3, kb = (q >> 2) >> 3, g = ((q >> 2) >> 1) & 3, sm = (q >> 2) & 1;
            fold_item(inptr(F, IN_WIN) + (size_t)l * DM * INW, kb * 64 + kq * 16, g, sm, WSP(bf16, WS_WIN) + (size_t)l * INW2 * DM, sm * 256 + g * 64, scr, ctab, lane); continue; } r -= T_B;
        if (r < T_C) { const int l = r / 512, q = r % 512; const float* W; int kb, koff;
            if (q < 128) { W = inptr(F, IN_WBRF) + (size_t)l * 256 * DM; kb = q >> 5; koff = 0; } else if (q < 384) { W = inptr(F, IN_WBRG) + (size_t)l * 512 * DM; kb = (q - 128) >> 5; koff = 256; } else { W = inptr(F, IN_WBRW) + (size_t)l * 256 * DM; kb = (q - 384) >> 5; koff = 768; }
            const int nb = q & 31;
            transpose_item(W, DM, kb * 64, nb * 32, WSP(bf16, WS_WBR) + (size_t)l * DM * DM, nb * 32, DM, koff, lane); continue; } r -= T_C;
        if (r < T_D) { const int l = r / 512, q = r % 512, kb = q >> 5, nb = q & 31;
            transpose_item(inptr(F, IN_WOUT) + (size_t)l * DM * DM, DM, kb * 64, nb * 32, WSP(bf16, WS_WOUT) + (size_t)l * DM * DM, nb * 32, DM, 0, lane); continue; } r -= T_D;
        if (r < T_E) { if (F.G != 256) conv_wave_item(F, r, lane); continue; } r -= T_E;
        if (r < T_F) {
            const bool big = r < SEQ; const int N = big ? SEQ : CTX, k = big ? r : r - SEQ, sh = big ? 0 : 3; const float sc = 1.f / sqrtf(64.f * (float)N);
            bf16* row = (big ? WSP(bf16, WS_DFT) : WSP(bf16, WS_DFTC)) + (size_t)k * 2 * N;
            for (int n = 2 * lane; n < N; n += 128) {
                const int r0 = (k * n) & (N - 1), r1 = (k * (n + 1)) & (N - 1);
                *(GAS unsigned*)(row + n) = pk2(ctab[r0 << sh] * sc, ctab[r1 << sh] * sc);
                *(GAS unsigned*)(row + N + n) = pk2(ctab[((r0 - (N >> 2)) & (N - 1)) << sh] * sc, ctab[((r1 - (N >> 2)) & (N - 1)) << sh] * sc); }
            continue; } r -= T_F;
        {
            for (int i = lane; i < 64 * 16; i += 64) { const int pos = i >> 4, f = i & 15; const float inv = powf(10000.f, -(float)(2 * f) / 32.f), ang = (float)pos * inv;
                WSP(float, WS_ROPE)[2 * i] = cosf(ang); WSP(float, WS_ROPE)[2 * i + 1] = sinf(ang); }
        }
    }
}

__device__ __forceinline__ void norm_row(f32x4 (&v)[4], const float* gain, const float* shift, const float* scale, int lane) {
    float ss = 0.f;
#pragma unroll
    for (int j = 0; j < 4; ++j) ss += (v[j][0] * v[j][0] + v[j][1] * v[j][1]) + (v[j][2] * v[j][2] + v[j][3] * v[j][3]);
    const float r = rsqrtf(wave_sum(ss) * (1.f / DM) + EPS);
#pragma unroll
    for (int j = 0; j < 4; ++j) { const f32x4 g = *(const f32x4*)(gain + 4 * lane + 256 * j); f32x4 y = v[j] * r * g;
        if (shift) { const f32x4 sh = *(const f32x4*)(shift + 4 * lane + 256 * j), sc = *(const f32x4*)(scale + 4 * lane + 256 * j); y = y * (sc + 1.f) + sh; }
        v[j] = y; }
}
__device__ __forceinline__ void store_row_bf16(bf16* orow, const f32x4 (&v)[4], int lane) {
    GAS v2u* o8 = (GAS v2u*)orow + lane;
#pragma unroll
    for (int j = 0; j < 4; ++j) { v2u w; w.x = pg8::cvt_pk_bf16(v[j][0], v[j][1]); w.y = pg8::cvt_pk_bf16(v[j][2], v[j][3]); o8[64 * j] = w; }
}
__device__ __forceinline__ int row_modset(int r) { return r < NLAT ? (r >> 11) : 8; }
struct ModVec { f32x4 g[4], sh[4], sc[4]; };
__device__ __forceinline__ void load_modvec(ModVec& m, const float* gain, const float* shift, const float* scale, int lane) {
#pragma unroll
    for (int j = 0; j < 4; ++j) { m.g[j] = *(const f32x4*)(gain + 4 * lane + 256 * j);
        if (shift) { m.sh[j] = *(const f32x4*)(shift + 4 * lane + 256 * j); m.sc[j] = *(const f32x4*)(scale + 4 * lane + 256 * j); } else { m.sh[j] = (f32x4){0.f, 0.f, 0.f, 0.f}; m.sc[j] = (f32x4){0.f, 0.f, 0.f, 0.f}; } }
}
__device__ __forceinline__ void norm_row_m(f32x4 (&v)[4], const ModVec& m) {
    float ss = 0.f;
#pragma unroll
    for (int j = 0; j < 4; ++j) ss += (v[j][0] * v[j][0] + v[j][1] * v[j][1]) + (v[j][2] * v[j][2] + v[j][3] * v[j][3]);
    const float r = rsqrtf(wave_sum(ss) * (1.f / DM) + EPS);
#pragma unroll
    for (int j = 0; j < 4; ++j) v[j] = (v[j] * r * m.g[j]) * (m.sc[j] + 1.f) + m.sh[j];
}
__device__ __forceinline__ void load_row_bf16(f32x4 (&v)[4], const bf16* row, int lane) {
    const GAS v2u* i8 = (const GAS v2u*)row + lane;
#pragma unroll
    for (int j = 0; j < 4; ++j) { const v2u w = i8[64 * j]; v[j] = (f32x4){bflo(w.x), bfhi(w.x), bflo(w.y), bfhi(w.y)}; }
}
__device__ __forceinline__ void load_row_f32(f32x4 (&v)[4], const float* row, int lane) {
#pragma unroll
    for (int j = 0; j < 4; ++j) v[j] = *(const f32x4*)(row + 4 * lane + 256 * j);
}

__device__ __forceinline__ void p1_norm1(Frame& F) {
    int tid_ = threadIdx.x; asm volatile("" : "+v"(tid_));
    const int lane = tid_ & 63, wave_ = __builtin_amdgcn_readfirstlane(tid_ >> 6);
    const int gw = F.vcu * NWAVES + wave_, NGW = F.G * NWAVES, rpw = (NTOK + NGW - 1) / NGW, r0 = gw * rpw, r1 = r0 + rpw < NTOK ? r0 + rpw : NTOK;
    const float* xin = inptr(F, IN_X); const float* cin = inptr(F, IN_CTX) - (size_t)NLAT * DM; const float* g1 = inptr(F, IN_NORM1G);
#define P1_ROW(r) (((r) < NLAT ? xin : cin) + (size_t)(r) * DM)
    f32x4 va[4], vb[4]; ModVec m; int cset = -1;
    if (r0 < r1) load_row_f32(va, P1_ROW(r0), lane);
    if (r0 + 1 < r1) load_row_f32(vb, P1_ROW(r0 + 1), lane);
    for (int r = r0; r < r1; ++r) {
        f32x4 v[4];
#pragma unroll
        for (int j = 0; j < 4; ++j) { v[j] = va[j]; va[j] = vb[j]; }
        if (r + 2 < r1) load_row_f32(vb, P1_ROW(r + 2), lane);
        const int set = row_modset(r);
        if (set != cset) { const float* mod = WSP(float, WS_MOD) + (size_t)set * 6 * DM; load_modvec(m, g1, mod, mod + DM, lane); cset = set; }
        norm_row_m(v, m);
        store_row_bf16(WSP(bf16, WS_HN) + (size_t)r * DM, v, lane);
    }
#undef P1_ROW
}
__device__ __forceinline__ void router_finish(const float (&a16)[NE], int r, int lane, float* AFF) {
    float b8[8], b4[4], b2[2], lg;
    { const bool hi = lane & 32;
#pragma unroll
      for (int i = 0; i < 8; ++i) { const float keep = hi ? a16[i + 8] : a16[i], send = hi ? a16[i] : a16[i + 8]; b8[i] = keep + lx32(send); } }
    { const bool hi = lane & 16;
#pragma unroll
      for (int i = 0; i < 4; ++i) { const float keep = hi ? b8[i + 4] : b8[i], send = hi ? b8[i] : b8[i + 4]; b4[i] = keep + lx16(send); } }
    { const bool hi = lane & 8;
#pragma unroll
      for (int i = 0; i < 2; ++i) { const float keep = hi ? b4[i + 2] : b4[i], send = hi ? b4[i] : b4[i + 2]; b2[i] = keep + lx8(send); } }
    { const bool hi = lane & 4; const float keep = hi ? b2[1] : b2[0], send = hi ? b2[0] : b2[1]; lg = keep + lx4(send); }
    lg += lx2(lg); lg += lx1(lg);
    float mx = lg;
    mx = fmaxf(mx, lx4(mx)); mx = fmaxf(mx, lx8(mx)); mx = fmaxf(mx, lx16(mx)); mx = fmaxf(mx, lx32(mx));
    const float ex = expf(lg - mx); float sum = ex;
    sum += lx4(sum); sum += lx8(sum); sum += lx16(sum); sum += lx32(sum);
    const int set = r < NLAT ? (r >> 11) : 8 + ((r - NLAT) >> 8), n = r < NLAT ? (r & (SEQ - 1)) : ((r - NLAT) & (CTX - 1));
    if ((lane & 3) == 0) AFF[((size_t)set * NE + ((lane >> 2) & 15)) * SEQ + n] = ex / sum;
}
__device__ __forceinline__ void pf_norm2_router(Frame& F, int l, int mode = 0) {
    int tid_ = threadIdx.x; asm volatile("" : "+v"(tid_));
    const int lane = tid_ & 63, wave_ = __builtin_amdgcn_readfirstlane(tid_ >> 6);
    const int gw = F.vcu * NWAVES + wave_, NGW = F.G * NWAVES;
    LAS float* wrT = (LAS float*)F.lds;
    { const float* wr = inptr(F, IN_WROUTER) + (size_t)l * DM * NE;
#pragma unroll 8
      for (int i = tid_; i < DM * NE; i += NWAVES * 64) { const int k = i >> 4, e = i & 15; wrT[e * DM + k] = wr[i]; } }
    __syncthreads();
    const int nrows = (l == DEPTH - 1) ? NLAT : NTOK, rpw = (nrows + NGW - 1) / NGW, r0 = gw * rpw, r1 = r0 + rpw < nrows ? r0 + rpw : nrows;
    const bf16* X = WSP(bf16, WS_X); const float* g2n = inptr(F, IN_NORM2G) + l * DM; float* AFF = WSP(float, WS_AFF);
    f32x4 va[4], vb[4]; ModVec m; int cset = -1;
    if (r0 < r1) load_row_bf16(va, X + (size_t)r0 * DM, lane);
    if (r0 + 1 < r1) load_row_bf16(vb, X + (size_t)(r0 + 1) * DM, lane);
    for (int r = r0; r < r1; ++r) {
        f32x4 v[4];
#pragma unroll
        for (int j = 0; j < 4; ++j) { v[j] = va[j]; va[j] = vb[j]; }
        if (r + 2 < r1) load_row_bf16(vb, X + (size_t)(r + 2) * DM, lane);
        const int mset = row_modset(r);
        if (mset != cset) { const float* mod = WSP(float, WS_MOD) + ((size_t)l * 9 + mset) * 6 * DM; load_modvec(m, g2n, mod + 3 * DM, mod + 4 * DM, lane); cset = mset; }
        norm_row_m(v, m);
        if (mode < 2) store_row_bf16(WSP(bf16, WS_HN) + (size_t)r * DM, v, lane);
        if (mode >= 1) { asm volatile("" :: "v"(v[0]), "v"(v[1]), "v"(v[2]), "v"(v[3])); continue; }
        float a16[NE];
#pragma unroll
        for (int e = 0; e < NE; ++e) { float a = 0.f;
#pragma unroll
            for (int j = 0; j < 4; ++j) { const f32x4 w = *(const LAS f32x4*)(wrT + e * DM + 4 * lane + 256 * j); a = fmaf(v[j][0], w[0], a); a = fmaf(v[j][1], w[1], a); a = fmaf(v[j][2], w[2], a); a = fmaf(v[j][3], w[3], a); }
            a16[e] = a; if ((e & 3) == 3) asm volatile("" ::: "memory"); }
        router_finish(a16, r, lane, AFF);
    }
    __syncthreads();
}
__device__ __forceinline__ void pg_topk_gather(Frame& F, int l) {
    int tid_ = threadIdx.x; asm volatile("" : "+v"(tid_));
    const int lane = tid_ & 63, wave_ = __builtin_amdgcn_readfirstlane(tid_ >> 6);
    LAS unsigned* cnt = (LAS unsigned*)F.lds;
    LAS int* sidx = (LAS int*)(F.lds + 1024);
    const int nitems = (l == DEPTH - 1) ? 8 * NE : 16 * NE;
    const int tid = tid_, wave = wave_;
    const unsigned long long lt = (1ull << lane) - 1ull;
    for (int it = F.vcu; it < nitems; it += F.G) {
        const int set = it >> 4, e = it & 15; const bool latent = set < 8; const int N = latent ? SEQ : CTX, cap = latent ? CAPL : CAPC;
        const int rowbase = latent ? set * SEQ : NLAT + (set - 8) * CTX, xbase = latent ? set * CAPL : 8 * CAPL + (set - 8) * CAPC;
        const float* a = WSP(float, WS_AFF) + ((size_t)set * NE + e) * SEQ;
        unsigned key[4];
#pragma unroll
        for (int q = 0; q < 4; ++q) { const int i = q * 512 + tid; key[q] = i < N ? __builtin_bit_cast(unsigned, a[i]) : 0u; }
        unsigned T = 0u;
        for (int bit = 30; bit >= 0; --bit) {
            const unsigned cand = T | (1u << bit); unsigned c = 0;
#pragma unroll
            for (int q = 0; q < 4; ++q) c += (unsigned)__builtin_popcountll(__ballot(key[q] >= cand));
            LAS unsigned* cb = cnt + (bit & 1) * 8;
            if (lane == 0) cb[wave] = c;
            __syncthreads();
            unsigned tot = 0;
#pragma unroll
            for (int w = 0; w < 8; ++w) tot += cb[w];
            if (tot >= (unsigned)cap) T = cand;
        }
        LAS unsigned* cg = cnt + 64; LAS unsigned* ce = cnt + 96;
        unsigned long long bg[4], be[4];
#pragma unroll
        for (int q = 0; q < 4; ++q) { bg[q] = __ballot(key[q] > T); be[q] = __ballot(key[q] == T && key[q] != 0u);
            if (lane == 0) { cg[q * 8 + wave] = (unsigned)__builtin_popcountll(bg[q]); ce[q * 8 + wave] = (unsigned)__builtin_popcountll(be[q]); } }
        __syncthreads();
        unsigned ngt = 0;
        for (int c2 = 0; c2 < 32; ++c2) ngt += cg[c2];
        const unsigned need = (unsigned)cap - ngt;
        unsigned pre_g[4], pre_e[4];
        { unsigned rg = 0, re = 0;
#pragma unroll
          for (int q = 0; q < 4; ++q) { for (int w = 0; w < 8; ++w) { if (w == wave) { pre_g[q] = rg; pre_e[q] = re; } rg += cg[q * 8 + w]; re += ce[q * 8 + w]; } } }
        int* SEL = WSP(int, WS_SEL);
#pragma unroll
        for (int q = 0; q < 4; ++q) { const int i = q * 512 + tid;
            if (i < N) {
                const unsigned eb = pre_e[q] + (unsigned)__builtin_popcountll(be[q] & lt);
                const unsigned gb = pre_g[q] + (unsigned)__builtin_popcountll(bg[q] & lt);
                const bool isg = key[q] > T, ise = key[q] == T;
                const bool sel = isg || (ise && eb < need);
                const unsigned slot = gb + (eb < need ? eb : need);
                SEL[(size_t)(rowbase + i) * NE + e] = sel ? xbase + (int)slot : -1;
                if (sel) { WSP(float, WS_AFS)[(size_t)e * RPE + xbase + slot] = __builtin_bit_cast(float, key[q]); WSP(int, WS_IDX)[(size_t)e * RPE + xbase + slot] = rowbase + i; }
            } }
        __syncthreads();
    }
}
__device__ __forceinline__ unsigned ye_issue4(const bf16* YE, int selv, unsigned mk, v2u (&w)[4][4], int lane) {
#pragma unroll
    for (int i = 0; i < 4; ++i) {
        if (mk) { const int e = __builtin_ctz(mk); mk &= mk - 1u; const int se = __builtin_amdgcn_readlane(selv, e);
            const GAS v2u* y = (const GAS v2u*)(YE + ((size_t)e * RPE + se) * DM) + lane;
#pragma unroll
            for (int j = 0; j < 4; ++j) w[i][j] = y[64 * j]; }
        else {
#pragma unroll
            for (int j = 0; j < 4; ++j) w[i][j] = (v2u){0u, 0u}; }
    }
    return mk;
}
__device__ __forceinline__ void ye_acc4(f32x4 (&t)[4], const v2u (&w)[4][4]) {
#pragma unroll
    for (int i = 0; i < 4; ++i)
#pragma unroll
        for (int j = 0; j < 4; ++j) t[j] += (f32x4){bflo(w[i][j].x), bfhi(w[i][j].x), bflo(w[i][j].y), bfhi(w[i][j].y)};
}
__device__ __forceinline__ unsigned sel_mask(int selv) { return (unsigned)__builtin_amdgcn_readfirstlane((int)(__ballot(selv >= 0) & 0xFFFFull)); }
__device__ __forceinline__ void pj_combine(Frame& F, int l, int probe = 0) {
    int tid_ = threadIdx.x; asm volatile("" : "+v"(tid_));
    const int lane = tid_ & 63, wave_ = __builtin_amdgcn_readfirstlane(tid_ >> 6);
    const int gw = F.vcu * NWAVES + wave_, NGW = F.G * NWAVES; const bool last = l == DEPTH - 1;
    const int nrows = last ? NLAT : NTOK, rpw = (nrows + NGW - 1) / NGW, r0 = gw * rpw, r1 = r0 + rpw < nrows ? r0 + rpw : nrows;
    bf16* X = WSP(bf16, WS_X); const int* SEL = WSP(int, WS_SEL);
    const float* gnext = last ? inptr(F, IN_FINALG) : inptr(F, IN_NORM1G) + (l + 1) * DM;
    f32x4 va[4], vb[4], g2[4]; int sa = -1, sb = -1; ModVec m; int cset = -1;
    if (r0 < r1) { load_row_bf16(va, X + (size_t)r0 * DM, lane); sa = lane < NE ? SEL[(size_t)r0 * NE + lane] : -1; }
    if (r0 + 1 < r1) { load_row_bf16(vb, X + (size_t)(r0 + 1) * DM, lane); sb = lane < NE ? SEL[(size_t)(r0 + 1) * NE + lane] : -1; }
    const bf16* YE = WSP(bf16, WS_G); v2u wA[4][4], wB[4][4]; unsigned restA = 0u, restB = 0u;
    restA = ye_issue4(YE, sa, r0 < r1 ? sel_mask(sa) : 0u, wA, lane);
#define PJ_ROW(r, WC, WN, RC, RN) do { \
        f32x4 v[4], t[4]; \
        _Pragma("unroll") for (int j = 0; j < 4; ++j) { v[j] = va[j]; va[j] = vb[j]; t[j] = (f32x4){0.f, 0.f, 0.f, 0.f}; } \
        const int selv = sa; sa = sb; \
        if ((r) + 2 < r1) { load_row_bf16(vb, X + (size_t)((r) + 2) * DM, lane); sb = lane < NE ? SEL[(size_t)((r) + 2) * NE + lane] : -1; } \
        const int mset = row_modset(r); \
        if (mset != cset) { const float* mod = WSP(float, WS_MOD) + ((size_t)l * 9 + mset) * 6 * DM; const float* mod1 = WSP(float, WS_MOD) + ((size_t)(last ? l : l + 1) * 9 + mset) * 6 * DM; \
            _Pragma("unroll") for (int j = 0; j < 4; ++j) g2[j] = *(const f32x4*)(mod + 5 * DM + 4 * lane + 256 * j); \
            load_modvec(m, gnext, last ? nullptr : mod1, last ? nullptr : mod1 + DM, lane); cset = mset; } \
        RN = ye_issue4(YE, sa, (r) + 1 < r1 ? sel_mask(sa) : 0u, WN, lane);                \
        ye_acc4(t, WC); \
        while (RC) { RC = ye_issue4(YE, selv, RC, WC, lane); ye_acc4(t, WC); }               \
        _Pragma("unroll") for (int j = 0; j < 4; ++j) v[j] = v[j] + g2[j] * t[j]; \
        if (probe) { norm_row_m(v, m); asm volatile("" :: "v"(v[0]), "v"(v[1]), "v"(v[2]), "v"(v[3])); } \
        else if (!last) { \
            store_row_bf16(X + (size_t)(r) * DM, v, lane); \
            norm_row_m(v, m); \
            store_row_bf16(WSP(bf16, WS_HN) + (size_t)(r) * DM, v, lane); \
        } else { \
            norm_row_m(v, m); \
            _Pragma("unroll") for (int j = 0; j < 4; ++j) *(f32x4*)(F.out + (size_t)(r) * DM + 4 * lane + 256 * j) = v[j]; \
        } } while (0)
    for (int r = r0; r < r1; r += 2) {
        PJ_ROW(r, wA, wB, restA, restB);
        if (r + 1 < r1) PJ_ROW(r + 1, wB, wA, restB, restA);
    }
#undef PJ_ROW
}

__device__ __forceinline__ void pc_mixers(Frame& F, int l, int rep) {
    int tid_ = threadIdx.x; asm volatile("" : "+v"(tid_));
    const int lane = tid_ & 63, wave_ = __builtin_amdgcn_readfirstlane(tid_ >> 6);
    const bool need_ctx = l < DEPTH - 1;
    {
        Strided<DecDft> S; S.d.Dm = (const char*)(F.ws + WS_DFT); S.d.Dc = (const char*)(F.ws + WS_DFTC); S.d.ABt = (const char*)(F.ws + WS_ABT); S.d.ABtc = (const char*)(F.ws + WS_ABTC);
        S.n = need_ctx ? 72 : 64; S.G = F.G; S.vcu = F.vcu;
        EpiStore E{WSP(bf16, WS_BR), DM};
        pg8::gemm_phase<EpiStore, Strided<DecDft>>(F.lds, (LAS int*)(F.lds + IDXBUF_OFF), S, E);
    }
    typedef attn_body::bf16 abf;
    const abf* Qg = (const abf*)(F.ws + WS_QKV + QKV_QG); const abf* Kg = (const abf*)(F.ws + WS_QKV + QKV_KG); const abf* Vg = (const abf*)(F.ws + WS_QKV + QKV_VG);
    const abf* Qw = (const abf*)(F.ws + WS_QKV + QKV_QW); const abf* Kw = (const abf*)(F.ws + WS_QKV + QKV_KW); const abf* Vw = (const abf*)(F.ws + WS_QKV + QKV_VW);
    abf* BR = (abf*)(F.ws + WS_BR);
    const int nGL = NBATCH * 2 * 32, nWL = NBATCH * 2 * 16, nGC = need_ctx ? NBATCH * 2 * 4 : 0, nWC = need_ctx ? NBATCH * 2 * 2 : 0, nattn = nGL + nWL + nGC + nWC;
    const int nconv = (CONV_IN_ATTN && F.G == 256 && rep == 0) ? CONV_ITEMS_L0 : 0, ntot = nattn + nconv;
    gu32* head = F.ctl + CW_QUEUE + 64 * (l + 2 * rep);
    const int wid = wave_;
    for (;;) {
        if (tid_ == 0) F.MISC[0] = __hip_atomic_fetch_add(head, 1u, RLX_AGENT);
        __syncthreads();
        const int q = (int)F.MISC[0];
        if (q >= ntot) break;
        const int c0 = (int)(((long long)q * nconv) / ntot), c1 = (int)(((long long)(q + 1) * nconv) / ntot);
        if (c1 > c0) { conv_wave_item(F, (l * CONV_ITEMS_L0 + c0) * NWAVES + wave_, lane); __syncthreads(); continue; }
        const int a = q - c0;
        if (a < nGL) {
            const int b = a >> 6, hkv = (a >> 5) & 1, qb = a & 31, head_ = hkv * 4 + (wid >> 1), q0 = qb * 64 + (wid & 1) * 32; const size_t qrow = (size_t)b * SEQ + q0;
            attn_body::attn_unit<0, 8>(Qg + qrow * 512 + head_ * 64, 512, Kg + (size_t)(NLAT + b * CTX) * 128 + hkv * 64, Kg + (size_t)b * SEQ * 128 + hkv * 64,
                                        Vg + (size_t)(NLAT + b * CTX) * 128 + hkv * 64, Vg + (size_t)b * SEQ * 128 + hkv * 64, 128, 4 + SEQ / 64, 0, 0, 0.f, BR + qrow * DM + 256 + head_ * 64, DM, F.ldsg);
        } else if (a < nGL + nWL) {
            const int u = a - nGL, b = u >> 5, hkv = (u >> 4) & 1, qb = u & 15, head_ = hkv * 2 + (wid >> 2), q0 = qb * 128 + (wid & 3) * 32; const size_t qrow = (size_t)b * SEQ + q0;
            const int band0 = qb * 128 - 128 < 0 ? 0 : qb * 128 - 128, band1 = qb * 128 + 256 > SEQ ? SEQ : qb * 128 + 256;
            attn_body::attn_unit<1, 8>(Qw + qrow * 256 + head_ * 64, 256, Kw + (size_t)(NLAT + b * CTX) * 128 + hkv * 64, Kw + ((size_t)b * SEQ + band0) * 128 + hkv * 64,
                                        Vw + (size_t)(NLAT + b * CTX) * 128 + hkv * 64, Vw + ((size_t)b * SEQ + band0) * 128 + hkv * 64, 128, 4 + (band1 - band0) / 64, q0, band0,
                                        inptr(F, IN_SINK)[l * 4 + head_] * LOG2E, BR + qrow * DM + 768 + head_ * 64, DM, F.ldsg);
        } else if (a < nGL + nWL + nGC) {
            const int u = a - nGL - nWL, b = u >> 3, hkv = (u >> 2) & 1, qb = u & 3, head_ = hkv * 4 + (wid >> 1); const size_t qrow = (size_t)NLAT + b * CTX + qb * 64 + (wid & 1) * 32;
            const abf* Kc = Kg + (size_t)(NLAT + b * CTX) * 128 + hkv * 64; const abf* Vc = Vg + (size_t)(NLAT + b * CTX) * 128 + hkv * 64;
            attn_body::attn_unit<0, 8>(Qg + qrow * 512 + head_ * 64, 512, Kc, Kc, Vc, Vc, 128, 4, 0, 0, 0.f, BR + qrow * DM + 256 + head_ * 64, DM, F.ldsg);
        } else {
            const int u = a - nGL - nWL - nGC, b = u >> 2, hkv = (u >> 1) & 1, qb = u & 1, head_ = hkv * 2 + (wid >> 2); const size_t qrow = (size_t)NLAT + b * CTX + qb * 128 + (wid & 3) * 32;
            const abf* Kc = Kw + (size_t)(NLAT + b * CTX) * 128 + hkv * 64; const abf* Vc = Vw + (size_t)(NLAT + b * CTX) * 128 + hkv * 64;
            attn_body::attn_unit<1, 8>(Qw + qrow * 256 + head_ * 64, 256, Kc, Kc, Vc, Vc, 128, 4, 0, 0, inptr(F, IN_SINK)[l * 4 + head_] * LOG2E, BR + qrow * DM + 768 + head_ * 64, DM, F.ldsg);
        }
    }
    __syncthreads();
}
#ifndef MK_N_LAUNCHES
#define MK_N_LAUNCHES 1
#endif
constexpr int N_PHASES = 2 + 9 * DEPTH;
struct Args { const float* in[21]; float* out; unsigned char* ws; int ph_lo, ph_hi, probe, pad_; };

__global__ void __launch_bounds__(NWAVES * 64, 2) hybrid_fwd(Args args) {
    extern __shared__ __attribute__((aligned(16))) unsigned char lds[];
    Frame F;
    F.lds = (LAS unsigned char*)lds; F.ldsg = (char*)lds; F.MISC = (volatile LAS unsigned*)(F.lds + MISC_OFF);
    F.G = gridDim.x; { const int bx = blockIdx.x; F.vcu = (F.G % 8 == 0) ? (bx % 8) * (F.G / 8) + bx / 8 : bx; }
    F.ws = args.ws; F.out = args.out; F.dout = (unsigned char*)args.out; F.ctl = (gu32*)(args.ws + WS_CTL);
#ifdef DBG_LDSPOISON
    for (int u = threadIdx.x; u < LDSCTL_OFF / 4; u += NWAVES * 64) ((LAS unsigned*)F.lds)[u] = 0xFFFFFFFFu;
#endif
    for (int u = threadIdx.x; u < (LDS_BYTES - LDSCTL_OFF) / 4; u += NWAVES * 64) ((LAS unsigned*)(F.lds + LDSCTL_OFF))[u] = 0u;
    __syncthreads();
    if (threadIdx.x < 21) *(LAS unsigned long long*)(F.lds + PTRS_OFF + 8 * threadIdx.x) = (unsigned long long)args.in[threadIdx.x];
    __syncthreads();
    XcdBarrier bar; bar.bar = (unsigned*)(F.ctl + CW_BAR); bar.x = 0; bar.st = nullptr;
    const int lo = args.ph_lo, hi = args.ph_hi;
    if (hi - lo > 1) bar = xcd_barrier_post((unsigned*)(F.ctl + CW_BAR), F.MISC + 8);
#ifndef PHSEL
#define PHSEL 0x7ff
#endif
#define IN(k) (lo <= (k) && (k) < hi)
#define KIND(j) ((PHSEL >> (j)) & 1)
#ifndef DBG_PROBE
#define DBG_PROBE 0
#endif
#ifndef FPROBE_MODE
#define FPROBE_MODE 0
#endif
#ifndef REP_MASK
#define REP_MASK 0
#endif
#define NREP(j, ok) ((((REP_MASK) >> (j)) & 1) && (ok) ? 2 : 1)
#define REPEAT(j, ok) for (int rep_ = 0, nrep_ = NREP(j, ok); rep_ < nrep_; ++rep_, (rep_ < nrep_ ? xcd_barrier(bar) : (void)0))
#define SEAM(k) do { if (IN(k) && IN((k) + 1)) xcd_barrier(bar); } while (0)

#ifdef BAR_PROBE
    if (hi - lo > 1) for (int i_ = 0; i_ < BAR_PROBE; ++i_) xcd_barrier(bar);
#endif
    if (KIND(0) && IN(0)) REPEAT(0, true) { p0_prologue(F, rep_ ? DBG_PROBE : 0); } SEAM(0);
    if (KIND(1) && IN(1)) REPEAT(1, true) { p1_norm1(F); } SEAM(1);
    for (int l = 0; l < DEPTH; ++l) {
        const int pb = 2 + 9 * l; const bool lastl = l == DEPTH - 1;
        const int nrt = lastl ? 64 : 72;
        if (KIND(2) && IN(pb + 0)) REPEAT(2, true) {
            Strided<DecInProj> S; S.d.A = (const char*)(F.ws + WS_HN); S.d.B = (const char*)(F.ws + WS_WIN) + (size_t)l * INW2 * DM * 2; S.d.layer = l; S.n = inproj_units(l); S.G = F.G; S.vcu = F.vcu;
            EpiInProj E; E.ABt = (bf16*)(F.ws + WS_ABT); E.ABtc = (bf16*)(F.ws + WS_ABTC);
            E.Qg = (bf16*)(F.ws + WS_QKV + QKV_QG); E.Kg = (bf16*)(F.ws + WS_QKV + QKV_KG); E.Vg = (bf16*)(F.ws + WS_QKV + QKV_VG);
            E.Qw = (bf16*)(F.ws + WS_QKV + QKV_QW); E.Kw = (bf16*)(F.ws + WS_QKV + QKV_KW); E.Vw = (bf16*)(F.ws + WS_QKV + QKV_VW);
            E.G = WSP(bf16, WS_G);
            {
                LAS float* ropeL = (LAS float*)(F.lds + COSTAB_OFF); LAS float* ngL = (LAS float*)(F.lds + IDXBUF_OFF);
                const float* rsrc = WSP(float, WS_ROPE); const float* qsrc = inptr(F, IN_QNG) + l * 64; const float* ksrc = inptr(F, IN_KNG) + l * 64;
                int t_ = threadIdx.x; asm volatile("" : "+v"(t_));
                for (int i = t_; i < 2048; i += NWAVES * 64) ropeL[i] = rsrc[i];
                if (t_ < 64) ngL[t_] = qsrc[t_]; else if (t_ < 128) ngL[t_] = ksrc[t_ - 64];
                __syncthreads();
                E.rope = ropeL; E.qng = ngL; E.kng = ngL + 64; }
            pg8::gemm_phase<EpiInProj, Strided<DecInProj>>(F.lds, (LAS int*)(F.lds + IDXBUF_OFF), S, E);
            if (!CONV_IN_ATTN && l == 0 && F.G == 256 && F.vcu >= 88 && rep_ == 0) tail_convert(F, F.vcu - 88, 0, 4, 672);
        } SEAM(pb + 0);
        if (KIND(3) && IN(pb + 1)) REPEAT(3, true) { pc_mixers(F, l, rep_); } SEAM(pb + 1);
        if (KIND(4) && IN(pb + 2)) REPEAT(4, true) {
            SchedMerge S; S.BR = (const char*)(F.ws + WS_BR); S.W = (const char*)(F.ws + WS_WBR) + (size_t)l * DM * DM * 2; S.ntiles = nrt * 4; S.G = F.G; S.vcu = F.vcu;
            EpiMerge E{WSP(bf16, WS_G), (rep_ + 1 == nrep_ && !args.probe) ? (bf16*)(F.ws + WS_MB) : WSP(bf16, WS_HN), args.probe};
            pg8::gemm_phase<EpiMerge, SchedMerge>(F.lds, (LAS int*)(F.lds + IDXBUF_OFF), S, E);
            if (!CONV_IN_ATTN && l == 0 && F.G == 256 && F.vcu >= 32 && rep_ == 0) tail_convert(F, F.vcu - 32, 672, 3, 1344);
        } SEAM(pb + 2);
        if (KIND(5) && IN(pb + 3)) REPEAT(5, l == 0) {
            Strided<DecWout> S; S.d.Mb = (const char*)(F.ws + WS_MB); S.d.W = (const char*)(F.ws + WS_WOUT) + (size_t)l * DM * DM * 2; S.n = nrt * 4; S.G = F.G; S.vcu = F.vcu;
            EpiWout E; E.baseL = inptr(F, IN_X); E.baseC = inptr(F, IN_CTX) - (size_t)NLAT * DM; E.baseX = WSP(bf16, WS_X); E.X = WSP(bf16, WS_X); E.from_x = l != 0; E.mod = WSP(float, WS_MOD) + (size_t)l * 9 * 6 * DM;
            pg8::gemm_phase<EpiWout, Strided<DecWout>>(F.lds, (LAS int*)(F.lds + IDXBUF_OFF), S, E);
            if (!CONV_IN_ATTN && l == 0 && F.G == 256 && F.vcu >= 32 && rep_ == 0) tail_convert(F, F.vcu - 32, 1344, 3, 2016);
        } SEAM(pb + 3);
        if (KIND(6) && IN(pb + 4)) REPEAT(6, true) { pf_norm2_router(F, l, rep_ ? FPROBE_MODE : 0); } SEAM(pb + 4);
        if (KIND(7) && IN(pb + 5)) REPEAT(7, true) { pg_topk_gather(F, l); } SEAM(pb + 5);
        const int ert = lastl ? 8 : 9;
        if (KIND(8) && IN(pb + 6)) REPEAT(8, true) {
            Strided<DecGU> S; S.d.H2 = (const char*)(F.ws + WS_HN); S.d.IDX = WSP(int, WS_IDX); S.d.W = (const char*)(F.ws + WS_WGU) + (size_t)l * NE * 2 * DM * DM * 2; S.d.nrt = ert; S.n = NE * ert * 8; S.G = F.G; S.vcu = F.vcu;
            EpiGU E{WSP(bf16, WS_HACT)};
            pg8::gemm_phase<EpiGU, Strided<DecGU>>(F.lds, (LAS int*)(F.lds + IDXBUF_OFF), S, E);
            if (!CONV_IN_ATTN && l == 0 && F.G == 256 && F.vcu >= 128 && rep_ == 0) tail_convert(F, F.vcu - 128, 2016, 4, 2528);
        } SEAM(pb + 6);
        if (KIND(9) && IN(pb + 7)) REPEAT(9, true) {
            Strided<DecDown> S; S.d.H = (const char*)(F.ws + WS_HACT); S.d.W = (const char*)(F.ws + WS_WD) + (size_t)l * NE * DM * DM * 2; S.d.nrt = ert; S.n = NE * ert * 4; S.G = F.G; S.vcu = F.vcu;
            EpiDown E{WSP(bf16, WS_G), WSP(float, WS_AFS)};
            pg8::gemm_phase<EpiDown, Strided<DecDown>>(F.lds, (LAS int*)(F.lds + IDXBUF_OFF), S, E);
            if (!CONV_IN_ATTN && l == 0 && F.G == 256 && F.vcu >= 64 && rep_ == 0) tail_convert(F, F.vcu - 64, 2528, 3, CONV_ITEMS);
        } SEAM(pb + 7);
        if (KIND(10) && IN(pb + 8)) REPEAT(10, true) { pj_combine(F, l, rep_); }
        if (!lastl) SEAM(pb + 8);
    }
#undef IN
#undef SEAM
}

#ifdef DBG_STOP
__global__ void k_dump(const unsigned short* __restrict__ src, float* __restrict__ out, size_t n) {
    for (size_t i = (size_t)blockIdx.x * blockDim.x + threadIdx.x; i < n; i += (size_t)gridDim.x * blockDim.x) out[i] = __uint_as_float((unsigned)src[i] << 16);
}
#endif
extern "C" void kernel_launch(void* const* d_in, const int* in_sizes, int n_in, void* d_out, int out_size, void* d_ws, size_t ws_size, hipStream_t stream) {
    static int grid = 0;
    if (grid == 0) {
        if (n_in != 21 || out_size != NLAT * DM || ws_size < WS_END) { fprintf(stderr, "kernel_launch: unexpected problem (n_in %d, out %d, ws %zu < %zu)\n", n_in, out_size, ws_size, (size_t)WS_END); grid = -1; return; }
        int dev = 0, cus = 0, per_cu = 0;
        if (hipGetDevice(&dev) != hipSuccess || hipDeviceGetAttribute(&cus, hipDeviceAttributeMultiprocessorCount, dev) != hipSuccess) { grid = -1; return; }
        if (hipFuncSetAttribute((const void*)hybrid_fwd, hipFuncAttributeMaxDynamicSharedMemorySize, LDS_BYTES) != hipSuccess) { fprintf(stderr, "kernel_launch: hipFuncSetAttribute failed\n"); grid = -1; return; }
        if (hipOccupancyMaxActiveBlocksPerMultiprocessor(&per_cu, (const void*)hybrid_fwd, NWAVES * 64, LDS_BYTES) != hipSuccess || per_cu < 1) { fprintf(stderr, "kernel_launch: occupancy query says %d blocks/CU\n", per_cu); per_cu = 1; }
        (void)hipGetLastError();
        grid = cus * 1;
    }
    if (grid < 0) return;
    hipMemsetAsync((char*)d_ws + WS_CTL, 0, CTL_ZERO_BYTES, stream);
    Args a; memset(&a, 0, sizeof(a));
    for (int i = 0; i < 21; ++i) a.in[i] = (const float*)d_in[i];
    a.out = (float*)d_out; a.ws = (unsigned char*)d_ws;
#if MK_N_LAUNCHES == 1
    a.ph_lo = 0; a.ph_hi = N_PHASES;
    hipLaunchKernelGGL(hybrid_fwd, dim3(grid), dim3(NWAVES * 64), LDS_BYTES, stream, a);
#else
    int nph_ = N_PHASES;
#ifdef DBG_STOP
    nph_ = DBG_STOP;
#endif
    for (int p = 0; p < nph_; ++p) { a.ph_lo = p; a.ph_hi = p + 1; hipLaunchKernelGGL(hybrid_fwd, dim3(grid), dim3(NWAVES * 64), LDS_BYTES, stream, a);
#ifdef DBG_DUP_PHASE
        if (p == DBG_DUP_PHASE) { a.probe = DBG_PROBE; hipLaunchKernelGGL(hybrid_fwd, dim3(grid), dim3(NWAVES * 64), LDS_BYTES, stream, a); a.probe = 0; }
#endif
    }
#ifdef DBG_STOP
    hipLaunchKernelGGL(k_dump, dim3(2048), dim3(256), 0, stream, (const unsigned short*)((const char*)d_ws + ((size_t)DBG_DUMP_MIB << 20)), (float*)d_out, (size_t)NLAT * DM);
#endif
#endif
}
```

```cpp
#define MK_N_LAUNCHES 1
#include <hip/hip_runtime.h>
#include <hip/hip_bf16.h>
#include <cstdio>
#include <cstdint>
#include <cmath>
#include <cstring>

constexpr int DM = 1024, NBATCH = 8, SEQ = 2048, CTX = 256, DEPTH = 2;
constexpr int NLAT = NBATCH * SEQ, NCTX = NBATCH * CTX, NTOK = NLAT + NCTX;
constexpr int INW = 4608, NCOLT = 19, INW2 = NCOLT * 256;
constexpr int NE = 16, CAPL = 256, CAPC = 32, RPE = NBATCH * (CAPL + CAPC);
constexpr float EPS = 1e-6f;
constexpr float QSCALE = 0.125f * 1.4426950408889634f;
constexpr float LOG2E = 1.4426950408889634f;
namespace pg8 {
#define PG8_LAS __attribute__((address_space(3)))
typedef unsigned short bf16_t;
typedef short bf16x8 __attribute__((ext_vector_type(8)));
typedef float f32x4 __attribute__((ext_vector_type(4)));
typedef unsigned u32x4 __attribute__((ext_vector_type(4)));
typedef unsigned u32x2 __attribute__((ext_vector_type(2)));
constexpr int BM = 256, BK = 64, HALF = 128, HTB = HALF * BK * 2  , STAGE_BYTES = 8 * HTB;

__host__ __device__ __forceinline__ int lds_byte(int r, int c) { const int st = (r >> 4) * 2 + (c >> 5), rr = r & 15, cc = c & 31, ob = rr * 64 + cc * 2; return st * 1024 + (ob ^ (((ob >> 9) & 1) << 5)); }
__host__ __device__ __forceinline__ int perm32(int rho) { const int n = rho >> 4, i = rho & 15; return 8 * (i >> 2) + 4 * n + (i & 3); }
__host__ __device__ __forceinline__ void stage_rc(int b, int& R, int& C) { const int st = b / 1024, sb = b % 1024, swz = sb ^ (((sb >> 9) & 1) << 5); R = (st >> 1) * 16 + swz / 64; C = (st & 1) * 32 + (swz % 64) / 2; }

struct Unit { const char* A; const char* B; const int* arows; int ldA, ldB, nt; int pm, pn, tag; };

typedef float f32x2_c __attribute__((ext_vector_type(2)));
typedef __bf16 bf16x2_c __attribute__((ext_vector_type(2)));
__device__ __forceinline__ unsigned cvt_pk_bf16(float lo, float hi) { const f32x2_c v = {lo, hi}; const bf16x2_c b = __builtin_convertvector(v, bf16x2_c); return __builtin_bit_cast(unsigned, b); }

template <class Epi, class Sched>
__device__ __forceinline__ void gemm_phase(PG8_LAS unsigned char* lds, PG8_LAS int* idxbuf  , const Sched& S, const Epi& E) {
    int tid = threadIdx.x; asm volatile("" : "+v"(tid));
    const int wid = __builtin_amdgcn_readfirstlane(tid >> 6), lane = tid & 63, wr = wid >> 2, wc = wid & 3, fr = lane & 15, fq = lane >> 4;
    unsigned Rr[2], RrB[2], Cc2[2];
#pragma unroll
    for (int i = 0; i < 2; ++i) { int R, C; stage_rc(tid * 16 + i * 8192, R, C); Rr[i] = (unsigned)R; RrB[i] = Epi::PERM ? (unsigned)((R & ~31) + perm32(R & 31)) : (unsigned)R; Cc2[i] = (unsigned)C * 2u; }
    const size_t kstep = (size_t)(BK * 2);
    const unsigned ldsw = (unsigned)wid * 1024u;
    const int aoff = lds_byte(wr * 64 + fr, fq * 8), boff = lds_byte(wc * 32 + fr, fq * 8);
#define PG8_SA(b, h) (((b) * 2 + (h)) * HTB)
#define PG8_SB(b, h) ((4 + (b) * 2 + (h)) * HTB)
#define PG8_STAGE(bufoff, gbase, ld) do { _Pragma("unroll") for (int _i = 0; _i < 2; ++_i) \
        __builtin_amdgcn_global_load_lds((const unsigned*)((const char*)(gbase) + (RrB[_i] * (unsigned)(ld) + Cc2[_i])), (PG8_LAS unsigned*)(lds + (bufoff) + ldsw + _i * 8192), 16, 0, 0); } while (0)
#define PG8_STAGE_A(bufoff, gbase, ao) do { _Pragma("unroll") for (int _i = 0; _i < 2; ++_i) \
        __builtin_amdgcn_global_load_lds((const unsigned*)((const char*)(gbase) + (ao)[_i]), (PG8_LAS unsigned*)(lds + (bufoff) + ldsw + _i * 8192), 16, 0, 0); } while (0)
#define PG8_AOFF(u, ao) do { _Pragma("unroll") for (int _h = 0; _h < 2; ++_h) _Pragma("unroll") for (int _i = 0; _i < 2; ++_i) { \
        const unsigned _row = (u).arows ? (unsigned)idxbuf[Rr[_i] + 128 * _h] : Rr[_i] + 128u * _h; (ao)[_h][_i] = _row * (unsigned)(u).ldA + Cc2[_i]; } } while (0)
#define PG8_STAGE_IDX(u) do { if ((u).arows) __builtin_amdgcn_global_load_lds((const unsigned*)((u).arows + (wid & 3) * 64 + lane), (PG8_LAS unsigned*)((PG8_LAS unsigned char*)idxbuf + (wid & 3) * 256), 4, 0, 0); } while (0)
#define PG8_LDA(dst, b, h) do { _Pragma("unroll") for (int m = 0; m < 4; ++m) _Pragma("unroll") for (int k = 0; k < 2; ++k) dst[m][k] = *(const PG8_LAS bf16x8*)(lds + PG8_SA(b, h) + aoff + m * 2048 + k * 1024); } while (0)
#define PG8_LDB(dst, b, h) do { _Pragma("unroll") for (int n = 0; n < 2; ++n) _Pragma("unroll") for (int k = 0; k < 2; ++k) dst[n][k] = *(const PG8_LAS bf16x8*)(lds + PG8_SB(b, h) + boff + n * 2048 + k * 1024); } while (0)
#define PG8_MMA(ai, bj, At, Bt) do { __builtin_amdgcn_s_setprio(1); _Pragma("unroll") for (int m = 0; m < 4; ++m) _Pragma("unroll") for (int n = 0; n < 2; ++n) _Pragma("unroll") for (int k = 0; k < 2; ++k) \
        acc[ai][bj][m][n] = __builtin_amdgcn_mfma_f32_16x16x32_bf16(Bt[n][k], At[m][k], acc[ai][bj][m][n], 0, 0, 0); __builtin_amdgcn_s_setprio(0); } while (0)
#define PG8_WAIT_V(n) asm volatile("s_waitcnt vmcnt(" #n ")" ::: "memory")
#define PG8_WAIT_L(n) asm volatile("s_waitcnt lgkmcnt(" #n ")" ::: "memory")
#define PG8_BAR __builtin_amdgcn_s_barrier()
#define PG8_SCHED __builtin_amdgcn_sched_barrier(0)
    Unit cur, nxt; int ui = 0;
    if (!S.next(0, cur)) return;
    nxt = cur;
    f32x4 acc[2][2][4][2];
#pragma unroll
    for (int a = 0; a < 2; ++a)
#pragma unroll
        for (int b = 0; b < 2; ++b)
#pragma unroll
            for (int m = 0; m < 4; ++m)
#pragma unroll
                for (int n = 0; n < 2; ++n) acc[a][b][m][n] = (f32x4){0.f, 0.f, 0.f, 0.f};
    bf16x8 At[4][2], B0[2][2], B1[2][2];
    const char* cA = cur.A; const char* cB = cur.B; int clb = cur.ldB;
    unsigned ao_c[2][2], ao_n[2][2];
    if (cur.arows) { PG8_STAGE_IDX(cur); PG8_WAIT_V(0); PG8_BAR; }
    PG8_AOFF(cur, ao_c);
#pragma unroll
    for (int _h = 0; _h < 2; ++_h)
#pragma unroll
        for (int _i = 0; _i < 2; ++_i) ao_n[_h][_i] = ao_c[_h][_i];
    if (cur.arows) { PG8_WAIT_L(0); PG8_BAR; }
    {
        const size_t hB = (size_t)HALF * clb;
        PG8_STAGE(PG8_SB(0, 0), cB, clb); PG8_STAGE(PG8_SB(0, 1), cB + hB, clb); PG8_STAGE_A(PG8_SA(0, 0), cA, ao_c[0]); PG8_STAGE_A(PG8_SA(0, 1), cA, ao_c[1]);
        if (wr == 1) PG8_BAR;
        PG8_WAIT_V(2); PG8_BAR;
        PG8_STAGE(PG8_SB(1, 0), cB + kstep, clb); PG8_STAGE_A(PG8_SA(1, 0), cA + kstep, ao_c[0]); PG8_STAGE(PG8_SB(1, 1), cB + hB + kstep, clb);
        PG8_WAIT_V(6); PG8_BAR;
    }
    for (;;) {
        const bool has_next = S.next(ui + 1, nxt);
        const char* nA = has_next ? nxt.A : cA; const char* nB = has_next ? nxt.B : cB; const int nlb = has_next ? nxt.ldB : clb;
        const int nt = cur.nt;
        if (has_next) PG8_STAGE_IDX(nxt);
        for (int t = 0; t < nt; t += 2) {
            const bool last = (t == nt - 2);
            if (last) { if (has_next) { PG8_AOFF(nxt, ao_n); } else {
#pragma unroll
                for (int _h = 0; _h < 2; ++_h)
#pragma unroll
                    for (int _i = 0; _i < 2; ++_i) ao_n[_h][_i] = ao_c[_h][_i]; } }
            unsigned ao2[2][2];
#pragma unroll
            for (int _h = 0; _h < 2; ++_h)
#pragma unroll
                for (int _i = 0; _i < 2; ++_i) ao2[_h][_i] = last ? ao_n[_h][_i] : ao_c[_h][_i];
            const char* a1 = cA + (size_t)(t + 1) * kstep;
            const char* a2 = last ? nA : cA + (size_t)(t + 2) * kstep; const char* b2 = last ? nB : cB + (size_t)(t + 2) * kstep;
            const int lb2 = last ? nlb : clb;
            const size_t hB2 = (size_t)HALF * lb2;
            const char* a3 = a2 + kstep; const char* b3 = b2 + kstep;
            PG8_LDB(B0, 0, 0); PG8_LDB(B1, 0, 1); PG8_SCHED; PG8_LDA(At, 0, 0); PG8_STAGE_A(PG8_SA(1, 1), a1, ao_c[1]);
            PG8_WAIT_V(8); PG8_WAIT_L(0); PG8_BAR; PG8_MMA(0, 0, At, B0); PG8_MMA(0, 1, At, B1); PG8_BAR; PG8_SCHED;
            PG8_LDA(At, 0, 1); PG8_STAGE(PG8_SB(0, 0), b2, lb2); PG8_STAGE(PG8_SB(0, 1), b2 + hB2, lb2); PG8_STAGE_A(PG8_SA(0, 0), a2, ao2[0]);
            PG8_WAIT_V(8); PG8_WAIT_L(0); PG8_BAR; PG8_MMA(1, 0, At, B0); PG8_MMA(1, 1, At, B1); PG8_BAR; PG8_SCHED;
            PG8_LDB(B0, 1, 0); PG8_LDB(B1, 1, 1); PG8_SCHED; PG8_LDA(At, 1, 0); PG8_STAGE_A(PG8_SA(0, 1), a2, ao2[1]);
            PG8_WAIT_V(8); PG8_WAIT_L(0); PG8_BAR; PG8_MMA(0, 0, At, B0); PG8_MMA(0, 1, At, B1); PG8_BAR; PG8_SCHED;
            PG8_LDA(At, 1, 1); PG8_STAGE(PG8_SB(1, 0), b3, lb2); PG8_STAGE(PG8_SB(1, 1), b3 + hB2, lb2); PG8_STAGE_A(PG8_SA(1, 0), a3, ao2[0]);
            PG8_WAIT_V(8); PG8_WAIT_L(0); PG8_BAR; PG8_MMA(1, 0, At, B0); PG8_MMA(1, 1, At, B1); PG8_BAR; PG8_SCHED;
        }
        if (wr == 0) PG8_BAR;
        bool keep_acc;
        { Unit eu = cur; int ewr = wr, ewc = wc, efr = fr, efq = fq; asm volatile("" : "+s"(eu.pm), "+s"(eu.pn), "+s"(eu.tag), "+s"(ewr), "+s"(ewc), "+v"(efr), "+v"(efq));
          keep_acc = E(acc, eu, ewr, ewc, efr, efq); }
        if (!has_next) break;
        if (!keep_acc) {
#pragma unroll
        for (int a = 0; a < 2; ++a)
#pragma unroll
            for (int b = 0; b < 2; ++b)
#pragma unroll
                for (int m = 0; m < 4; ++m)
#pragma unroll
                    for (int n = 0; n < 2; ++n) acc[a][b][m][n] = (f32x4){0.f, 0.f, 0.f, 0.f};
        }
        cur = nxt; cA = nA; cB = nB; clb = nlb; ++ui;
#pragma unroll
        for (int _h = 0; _h < 2; ++_h)
#pragma unroll
            for (int _i = 0; _i < 2; ++_i) ao_c[_h][_i] = ao_n[_h][_i];
        if (wr == 1) PG8_BAR;
    }
    PG8_WAIT_V(0);
    PG8_BAR;
#undef PG8_SA
#undef PG8_SB
#undef PG8_STAGE
#undef PG8_STAGE_A
#undef PG8_AOFF
#undef PG8_STAGE_IDX
#undef PG8_LDA
#undef PG8_LDB
#undef PG8_MMA
#undef PG8_WAIT_V
#undef PG8_WAIT_L
#undef PG8_BAR
#undef PG8_SCHED
}
}
#include <hip/hip_bf16.h>
#include <cmath>
namespace attn_body {
using bf16=__hip_bfloat16;
using bf16x8=__attribute__((ext_vector_type(8)))short;
using s16x4=__attribute__((ext_vector_type(4)))short;
using f32x16=__attribute__((ext_vector_type(16)))float;
using u32x4=__attribute__((ext_vector_type(4)))unsigned;
constexpr int D=64;
constexpr int NW=8,QBLK=32,KVBLK=64,NCT=4;
__device__ __forceinline__ int crow(int r,int hi){return (r&3)+8*(r>>2)+4*hi;}
#define SBAR() __builtin_amdgcn_sched_barrier(0)
__device__ __forceinline__ void wmask(f32x16&p0,f32x16&p1,int kb,int qabs,int hi){
  const float NEG=-INFINITY; const int d0=kb+4*hi-qabs;
  #pragma unroll
  for(int r=0;r<16;++r){int dd=d0+(r&3)+8*(r>>2); if(dd>128||dd<-128)p0[r]=NEG; if(dd+32>128||dd+32<-128)p1[r]=NEG;}
}

constexpr int NSLOT=3, SLOTB=8192;
constexpr int LDS_K=0, LDS_V=NSLOT*SLOTB, LDS_WS=2*NSLOT*SLOTB, LDS_OST=LDS_WS+NW*64*4, LDS_BYTES=LDS_OST+NW*4096;
__device__ __forceinline__ void glds16(const void*gsrc,unsigned lds_dst){unsigned keep;
  asm volatile("s_mov_b32 %0, m0\n\ts_mov_b32 m0, %2\n\ts_nop 0\n\tglobal_load_lds_dwordx4 %1, off\n\ts_mov_b32 m0, %0":"=&s"(keep):"v"(gsrc),"s"(lds_dst):"memory");}
__device__ __forceinline__ float max3f(float a,float b,float c){float r;asm("v_max3_f32 %0, %1, %2, %3":"=v"(r):"v"(a),"v"(b),"v"(c));return r;}
__device__ __forceinline__ float max2f(float a,float b){float r;asm("v_max_f32_e32 %0, %1, %2":"=v"(r):"v"(a),"v"(b));return r;}
__device__ __forceinline__ float fadd_s(float a,float b){float r;asm("v_add_f32_e32 %0, %1, %2":"=v"(r):"v"(a),"v"(b));return r;}
__device__ __forceinline__ float fsub_s(float a,float b){float r;asm("v_sub_f32_e32 %0, %1, %2":"=v"(r):"v"(a),"v"(b));return r;}
typedef float f32x2_t __attribute__((ext_vector_type(2))); typedef __bf16 bf16x2_t __attribute__((ext_vector_type(2)));
__device__ __forceinline__ unsigned cvtpk_s(float lo,float hi){f32x2_t v={lo,hi};bf16x2_t b=__builtin_convertvector(v,bf16x2_t);return __builtin_bit_cast(unsigned,b);}
#define WAIT_BAR(N) asm volatile("s_waitcnt vmcnt(" #N ") lgkmcnt(0)\n\ts_barrier":::"memory")

__device__ __forceinline__ void qkt(f32x16&p0,f32x16&p1,const char*Kslot,const bf16x8*qr,const f32x16&negm,int r32,int hi){
  const char*kb=Kslot+hi*1024+r32*16;
  #pragma unroll
  for(int d0=0;d0<4;++d0){
    const bf16x8 b0=*reinterpret_cast<const bf16x8*>(kb+d0*2048);
    const bf16x8 b1=*reinterpret_cast<const bf16x8*>(kb+d0*2048+512);
    if(d0==0){p0=__builtin_amdgcn_mfma_f32_32x32x16_bf16(b0,qr[0],negm,0,0,0);p1=__builtin_amdgcn_mfma_f32_32x32x16_bf16(b1,qr[0],negm,0,0,0);}
    else{p0=__builtin_amdgcn_mfma_f32_32x32x16_bf16(b0,qr[d0],p0,0,0,0);p1=__builtin_amdgcn_mfma_f32_32x32x16_bf16(b1,qr[d0],p1,0,0,0);}}
}
typedef __attribute__((address_space(3))) const char* lds_cptr;
typedef short v4i16_t __attribute__((ext_vector_type(4)));
__device__ __forceinline__ void kload8(bf16x8*kf,lds_cptr kp){
  kf[0]=*(const __attribute__((address_space(3))) bf16x8*)(kp);      kf[1]=*(const __attribute__((address_space(3))) bf16x8*)(kp+512);
  kf[2]=*(const __attribute__((address_space(3))) bf16x8*)(kp+2048); kf[3]=*(const __attribute__((address_space(3))) bf16x8*)(kp+2560);
  kf[4]=*(const __attribute__((address_space(3))) bf16x8*)(kp+4096); kf[5]=*(const __attribute__((address_space(3))) bf16x8*)(kp+4608);
  kf[6]=*(const __attribute__((address_space(3))) bf16x8*)(kp+6144); kf[7]=*(const __attribute__((address_space(3))) bf16x8*)(kp+6656);
}
__device__ __forceinline__ void kload2(bf16x8*kf,lds_cptr kp,int j){ kf[2*j]=*(const __attribute__((address_space(3))) bf16x8*)(kp+j*2048); kf[2*j+1]=*(const __attribute__((address_space(3))) bf16x8*)(kp+j*2048+512); }
__device__ __forceinline__ s16x4 vtr(lds_cptr p){ return __builtin_bit_cast(s16x4,__builtin_amdgcn_ds_read_tr16_b64_v4i16((__attribute__((address_space(3))) v4i16_t*)p)); }
__device__ __forceinline__ float rowmax(const f32x16&p0,const f32x16&p1){
  float a=max3f(p0[0],p0[1],p1[0]),b=max3f(p0[2],p0[3],p1[1]);a=max3f(a,p1[2],p1[3]);
  #pragma unroll
  for(int r=4;r<16;r+=4){a=max3f(a,p0[r],p0[r+1]);b=max3f(b,p0[r+2],p0[r+3]);a=max3f(a,p1[r],p1[r+1]);b=max3f(b,p1[r+2],p1[r+3]);}
  const float m=max2f(a,b);
  auto rr=__builtin_amdgcn_permlane32_swap(__float_as_uint(m),__float_as_uint(m),false,false);
  return max2f(__uint_as_float(rr[0]),__uint_as_float(rr[1]));
}
__device__ __forceinline__ void pv(f32x16*o,int vb,bf16x8 pa0,bf16x8 pa1,bf16x8 pa2,bf16x8 pa3){
  #pragma unroll
  for(int d0=0;d0<2;++d0){s16x4 lo[4],hi[4];
    #pragma unroll
    for(int ks=0;ks<4;++ks){
      asm volatile("ds_read_b64_tr_b16 %0,%1 offset:%c2":"=&v"(lo[ks]):"v"(vb),"i"(d0*4096+ks*1024):"memory");
      asm volatile("ds_read_b64_tr_b16 %0,%1 offset:%c2":"=&v"(hi[ks]):"v"(vb),"i"(d0*4096+ks*1024+512):"memory");}
    asm volatile("s_waitcnt lgkmcnt(0)":::"memory");SBAR();
    #define PK(k) (bf16x8){lo[k][0],lo[k][1],lo[k][2],lo[k][3],hi[k][0],hi[k][1],hi[k][2],hi[k][3]}
    o[d0]=__builtin_amdgcn_mfma_f32_32x32x16_bf16(pa0,PK(0),o[d0],0,0,0);
    o[d0]=__builtin_amdgcn_mfma_f32_32x32x16_bf16(pa1,PK(1),o[d0],0,0,0);
    o[d0]=__builtin_amdgcn_mfma_f32_32x32x16_bf16(pa2,PK(2),o[d0],0,0,0);
    o[d0]=__builtin_amdgcn_mfma_f32_32x32x16_bf16(pa3,PK(3),o[d0],0,0,0);
    #undef PK
  }
}

#ifndef ATTN_STORE16
#define ATTN_STORE16(p,v) (*(u32x4*)(p)=(v))
#endif
template<int MODE,int THRL,bool NOMX=false> __device__ __forceinline__ void attn_unit(const bf16*Qw,int qp,const bf16*Kc,const bf16*Kl,const bf16*Vc,const bf16*Vl,int kp,int NT,int qabs,int band0,float sinkl2,bf16*Ow,int op,char*shm){
  int tid=threadIdx.x; asm volatile("":"+v"(tid));
  const int lane=tid&63,r32=lane&31,hi=lane>>5; const int wid=__builtin_amdgcn_readfirstlane(tid>>6);
  qabs+=r32;
  if(wid>=4)__builtin_amdgcn_s_setprio(1);
  const unsigned lds0=(unsigned)(uintptr_t)shm;
  float*wsf=(float*)(shm+LDS_WS)+wid*64;
  const unsigned koff_=(unsigned)(lane*kp+wid*8)*2u;
  const unsigned voff_=(unsigned)((16*(wid&3)+(lane>>2))*kp+(wid>>2)*32+(lane&3)*8)*2u;
  const unsigned kdst=lds0+LDS_K+wid*1024, vdst=lds0+LDS_V+wid*1024;
  #define DMA_K(t,slot) glds16((const char*)((t)<NCT?Kc+(long)(t)*KVBLK*kp:Kl+(long)((t)-NCT)*KVBLK*kp)+koff_,(unsigned)__builtin_amdgcn_readfirstlane(kdst+(slot)))
  #define DMA_V(t,slot) glds16((const char*)((t)<NCT?Vc+(long)(t)*KVBLK*kp:Vl+(long)((t)-NCT)*KVBLK*kp)+voff_,(unsigned)__builtin_amdgcn_readfirstlane(vdst+(slot)))
  const int vb0=(int)(lds0+LDS_V)+((lane>>4)&1)*32+(lane&3)*8+(4*hi+((lane&15)>>2))*64;
  const char*Kbase=shm+LDS_K; bf16x8 kf[8];
  const lds_cptr shm3=(lds_cptr)shm; const lds_cptr kp0=shm3+LDS_K+hi*1024+r32*16; const lds_cptr vp0=shm3+LDS_V+((lane>>4)&1)*32+(lane&3)*8+(4*hi+((lane&15)>>2))*64;
  DMA_K(0,0);DMA_V(0,0);DMA_K(1,SLOTB);
  bf16x8 qr[4];
  #pragma unroll
  for(int d0=0;d0<4;++d0)qr[d0]=*reinterpret_cast<const bf16x8*>(&Qw[(long)r32*qp+d0*16+hi*8]);
  float mhat=0.f,l_reg=0.f;f32x16 o[2];o[0]=f32x16{};o[1]=f32x16{};f32x16 negm=f32x16{};asm volatile("":"+v"(negm));
  #define CMASK(P0,P1,t) do{ if(MODE==1){ if((t)>=NCT)wmask(P0,P1,band0+KVBLK*((t)-NCT),qabs,hi);} }while(0)
  bool resc=false;
  #define START(P0,P1) do{ resc=false; \
    if(!NOMX){ const float rm=rowmax(P0,P1); const float dl=rm; mhat=fadd_s(mhat,dl); \
      _Pragma("unroll") for(int r=0;r<16;++r){P0[r]=fsub_s(P0[r],dl);P1[r]=fsub_s(P1[r],dl);} \
      _Pragma("unroll") for(int r=0;r<16;++r)negm[r]=-mhat; asm volatile("":"+v"(negm)); } \
    _Pragma("unroll") for(int r=0;r<16;++r)P0[r]=__builtin_amdgcn_exp2f(P0[r]); }while(0)
  #define RESC() do{ if(!NOMX&&resc){ asm volatile("s_waitcnt lgkmcnt(0)":::"memory"); \
      _Pragma("unroll") for(int d_=0;d_<2;++d_) _Pragma("unroll") for(int r=0;r<16;++r)o[d_][r]*=wsf[crow(r,hi)]; } }while(0)
  f32x16 pA0,pA1,pB0,pB1;
  int sl_prev=0,sl_cur=0,sl_next=SLOTB;
  #define ROT() do{sl_prev=sl_cur;sl_cur=sl_next;sl_next=(sl_next==(NSLOT-1)*SLOTB)?0:sl_next+SLOTB;}while(0)
  DMA_K(2,2*SLOTB);
  WAIT_BAR(3);
  qkt(pA0,pA1,Kbase,qr,negm,r32,hi);asm volatile("s_nop 15\n\ts_nop 7":"+v"(pA0),"+v"(pA1));CMASK(pA0,pA1,0);
  START(pA0,pA1);
  _Pragma("unroll") for(int r=0;r<16;++r)pA1[r]=__builtin_amdgcn_exp2f(pA1[r]);
  WAIT_BAR(0);
  DMA_K(3,0);DMA_V(1,SLOTB);
  ROT();
  kload8(kf,kp0+sl_cur);
  WAIT_BAR(2);
  s16x4 vlo[8],vhi[8]; u32x4 pw0,pw1,pw2,pw3;
  #define PKW(P,B) cvtpk_s(P[B],P[B+1])
  #define PAF(k) __builtin_bit_cast(bf16x8,pw##k)
  #define VFR(i) (bf16x8){vlo[i][0],vlo[i][1],vlo[i][2],vlo[i][3],vhi[i][0],vhi[i][1],vhi[i][2],vhi[i][3]}
  #define PIN(x) asm volatile("":"+v"(x))
  #define MX3(a,b,c) __builtin_fmaxf(__builtin_fmaxf((a),(b)),(c))
  #define GAPA(MF,A0,A1,A2,A3,W0,W1,PW) do{ MF; sacc+=(f32x2_t){A0,A1}; sacc+=(f32x2_t){A2,A3}; PIN(sacc); W0; W1; PIN(PW); SBAR(); }while(0)
  #define EX(v) __builtin_amdgcn_exp2f(v)
  #define GAPB(MF,X,B) do{ MF; X[B]=EX(X[B]); X[B+1]=EX(X[B+1]); X[B+2]=EX(X[B+2]); X[B+3]=EX(X[B+3]); PIN(X); SBAR(); }while(0)
  #define VRD(i) do{ vlo[i]=vtr(vp_+(((i)>>2)*4096+((i)&3)*1024)); vhi[i]=vtr(vp_+(((i)>>2)*4096+((i)&3)*1024+512)); }while(0)
  #define KRD(G,j) do{ if(G){ kload2(kf,kp0+sl_next,j); SBAR(); } }while(0)
  #define STEP(C0,C1,P0,P1,t,GK,GV,GL) do{ SBAR(); \
    const lds_cptr vp_=vp0+sl_prev; \
    VRD(0); SBAR(); f32x2_t sacc={P0[0],P0[1]}; \
    GAPA(C0=__builtin_amdgcn_mfma_f32_32x32x16_bf16(kf[0],qr[0],negm,0,0,0), P0[2],P0[3],P0[4],P0[5],     pw0[0]=PKW(P0,0), pw0[1]=PKW(P0,2), pw0); \
    VRD(4); SBAR(); GAPA(C1=__builtin_amdgcn_mfma_f32_32x32x16_bf16(kf[1],qr[0],negm,0,0,0), P0[6],P0[7],P0[8],P0[9],     pw0[2]=PKW(P0,4), pw0[3]=PKW(P0,6), pw0); \
    VRD(1); SBAR(); GAPA(C0=__builtin_amdgcn_mfma_f32_32x32x16_bf16(kf[2],qr[1],C0,0,0,0),   P0[10],P0[11],P0[12],P0[13], pw1[0]=PKW(P0,8), pw1[1]=PKW(P0,10), pw1); \
    VRD(5); SBAR(); GAPA(C1=__builtin_amdgcn_mfma_f32_32x32x16_bf16(kf[3],qr[1],C1,0,0,0),   P0[14],P0[15],P1[0],P1[1],   pw1[2]=PKW(P0,12),pw1[3]=PKW(P0,14), pw1); \
    VRD(2); SBAR(); GAPA(C0=__builtin_amdgcn_mfma_f32_32x32x16_bf16(kf[4],qr[2],C0,0,0,0),   P1[2],P1[3],P1[4],P1[5],     pw2[0]=PKW(P1,0), pw2[1]=PKW(P1,2), pw2); \
    VRD(6); SBAR(); GAPA(C1=__builtin_amdgcn_mfma_f32_32x32x16_bf16(kf[5],qr[2],C1,0,0,0),   P1[6],P1[7],P1[8],P1[9],     pw2[2]=PKW(P1,4), pw2[3]=PKW(P1,6), pw2); \
    VRD(3); SBAR(); GAPA(C0=__builtin_amdgcn_mfma_f32_32x32x16_bf16(kf[6],qr[3],C0,0,0,0),   P1[10],P1[11],P1[12],P1[13], pw3[0]=PKW(P1,8), pw3[1]=PKW(P1,10), pw3); \
    VRD(7); SBAR(); GAPA(C1=__builtin_amdgcn_mfma_f32_32x32x16_bf16(kf[7],qr[3],C1,0,0,0),   P1[14],P1[15],0.f,0.f,       pw3[2]=PKW(P1,12),pw3[3]=PKW(P1,14), pw3); \
    l_reg+=sacc[0]+sacc[1]; \
    if(GK){DMA_K((t)+3,sl_cur);} if(GV){DMA_V((t)+1,sl_next);} \
    CMASK(C0,C1,t); \
    if(!NOMX){ float a=MX3(C0[0],C0[1],C1[0]),b=MX3(C0[2],C0[3],C1[1]); a=MX3(a,C1[2],C1[3]); \
      _Pragma("unroll") for(int r=4;r<16;r+=4){a=MX3(a,C0[r],C0[r+1]);b=MX3(b,C0[r+2],C0[r+3]);a=MX3(a,C1[r],C1[r+1]);b=MX3(b,C1[r+2],C1[r+3]);} \
      float rm=__builtin_fmaxf(a,b); { auto rr=__builtin_amdgcn_permlane32_swap(__float_as_uint(rm),__float_as_uint(rm),false,false); rm=__builtin_fmaxf(__uint_as_float(rr[0]),__uint_as_float(rr[1])); } \
      resc=false; \
      if(__builtin_expect(__any(rm>(float)THRL),0)){ const float dl=__builtin_fmaxf(rm,0.f); mhat+=dl; \
        _Pragma("unroll") for(int r=0;r<16;++r){C0[r]-=dl;C1[r]-=dl;} \
        _Pragma("unroll") for(int r=0;r<16;++r)negm[r]=-mhat; asm volatile("":"+v"(negm)); \
        const float f=__builtin_amdgcn_exp2f(-dl); l_reg*=f; if(hi==0)wsf[r32]=f; resc=true; } } \
    SBAR(); \
    GAPB(o[0]=__builtin_amdgcn_mfma_f32_32x32x16_bf16(PAF(0),VFR(0),o[0],0,0,0), C0,0); \
    GAPB(o[1]=__builtin_amdgcn_mfma_f32_32x32x16_bf16(PAF(0),VFR(4),o[1],0,0,0), C0,4); \
    KRD(GL,0); GAPB(o[0]=__builtin_amdgcn_mfma_f32_32x32x16_bf16(PAF(1),VFR(1),o[0],0,0,0), C0,8); \
    KRD(GL,1); GAPB(o[1]=__builtin_amdgcn_mfma_f32_32x32x16_bf16(PAF(1),VFR(5),o[1],0,0,0), C0,12); \
    KRD(GL,2); GAPB(o[0]=__builtin_amdgcn_mfma_f32_32x32x16_bf16(PAF(2),VFR(2),o[0],0,0,0), C1,0); \
    KRD(GL,3); GAPB(o[1]=__builtin_amdgcn_mfma_f32_32x32x16_bf16(PAF(2),VFR(6),o[1],0,0,0), C1,4); \
    GAPB(o[0]=__builtin_amdgcn_mfma_f32_32x32x16_bf16(PAF(3),VFR(3),o[0],0,0,0), C1,8); \
    GAPB(o[1]=__builtin_amdgcn_mfma_f32_32x32x16_bf16(PAF(3),VFR(7),o[1],0,0,0), C1,12); \
    }while(0)
  int t=1;
  for(;t+5<NT;t+=2){
    STEP(pB0,pB1,pA0,pA1,t,true,true,true);     WAIT_BAR(2); RESC(); ROT();
    STEP(pA0,pA1,pB0,pB1,t+1,true,true,true);   WAIT_BAR(2); RESC(); ROT();
  }
  #define ENDW(tt) do{ if((tt)+3<NT){WAIT_BAR(2);} else if((tt)+2<NT){WAIT_BAR(1);} else {WAIT_BAR(0);} }while(0)
  for(;t+1<NT;t+=2){
    STEP(pB0,pB1,pA0,pA1,t,(t+3<NT),(t+1<NT),(t+1<NT));       ENDW(t);   RESC(); ROT();
    STEP(pA0,pA1,pB0,pB1,t+1,(t+4<NT),(t+2<NT),(t+2<NT));     ENDW(t+1); RESC(); ROT();
  }
  STEP(pB0,pB1,pA0,pA1,NT-1,false,false,false); RESC();
  { float sacc=pB0[0]+pB0[1]; _Pragma("unroll") for(int r=2;r<16;++r)sacc+=pB0[r]; _Pragma("unroll") for(int r=0;r<16;++r)sacc+=pB1[r]; l_reg+=sacc;
    pw0=(u32x4){PKW(pB0,0),PKW(pB0,2),PKW(pB0,4),PKW(pB0,6)};pw1=(u32x4){PKW(pB0,8),PKW(pB0,10),PKW(pB0,12),PKW(pB0,14)};pw2=(u32x4){PKW(pB1,0),PKW(pB1,2),PKW(pB1,4),PKW(pB1,6)};pw3=(u32x4){PKW(pB1,8),PKW(pB1,10),PKW(pB1,12),PKW(pB1,14)};
    SBAR(); pv(o,vb0+sl_cur,PAF(0),PAF(1),PAF(2),PAF(3)); }
  #undef PKW
  #undef PAF
  #undef VFR
  #undef PIN
  #undef MX3
  #undef GAPA
  #undef GAPB
  #undef EX
  #undef VRD
  #undef KRD
  #undef STEP
  #undef ENDW
  {auto rr=__builtin_amdgcn_permlane32_swap(__float_as_uint(l_reg),__float_as_uint(l_reg),false,false);l_reg=__uint_as_float(rr[0])+__uint_as_float(rr[1]);}
  if(MODE==1)l_reg+=__builtin_amdgcn_exp2f(sinkl2-mhat);
  if(hi==0)wsf[32+r32]=l_reg;asm volatile("s_waitcnt lgkmcnt(0)":::"memory");
  float rli[16];
  #pragma unroll
  for(int r=0;r<16;++r)rli[r]=__builtin_amdgcn_rcpf(wsf[32+crow(r,hi)]);
  { bf16*stg=(bf16*)(shm+LDS_OST)+wid*2048;
    #pragma unroll
    for(int r=0;r<16;++r){const int orow=crow(r,hi);
      #pragma unroll
      for(int d0=0;d0<2;++d0)stg[orow*64+d0*32+r32]=__float2bfloat16(o[d0][r]*rli[r]);}
    asm volatile("s_waitcnt lgkmcnt(0)":::"memory");
    #pragma unroll
    for(int i=0;i<4;++i){const int row=i*8+(lane>>3),ch=lane&7; const u32x4 v=*(const u32x4*)(stg+row*64+ch*8); ATTN_STORE16(Ow+(long)row*op+ch*8,v);} }
  __builtin_amdgcn_s_setprio(0);
  asm volatile("s_waitcnt lgkmcnt(0)\n\ts_barrier":::"memory");
  #undef DMA_K
  #undef DMA_V
  #undef CMASK
  #undef START
  #undef RESC
  #undef ROT
}
constexpr int ATTN_LDS_BYTES=LDS_BYTES;
#undef SBAR
#undef WAIT_BAR
}
constexpr int NWAVES = 8;
constexpr size_t MiB = 1u << 20;
constexpr size_t WS_CTL = 0, CTL_ZERO_BYTES = 256 * 1024;
constexpr size_t WS_MOD = 1 * MiB;
constexpr size_t WS_ROPE = WS_MOD + 512 * 1024;
constexpr size_t WS_AFS = WS_ROPE + 64 * 1024;
constexpr size_t WS_IDX = WS_AFS + 192 * 1024;
constexpr size_t WS_SEL = 2 * MiB;
constexpr size_t WS_AFF = 4 * MiB;
constexpr size_t WS_ABTC = WS_AFF;
constexpr size_t WS_WIN = 6 * MiB;
constexpr size_t WS_WBR = 25 * MiB;
constexpr size_t WS_WOUT = 29 * MiB;
constexpr size_t WS_DFT = 33 * MiB;
constexpr size_t WS_DFTC = 49 * MiB;
constexpr size_t WS_WGU = 50 * MiB;
constexpr size_t WS_WD = 178 * MiB;
constexpr size_t WS_X = 242 * MiB;
constexpr size_t WS_HN = 314 * MiB;
constexpr size_t WS_MB = WS_HN;
constexpr size_t WS_QKV = 350 * MiB;
constexpr size_t WS_G = 395 * MiB;
constexpr size_t WS_BR = 503 * MiB;
constexpr size_t WS_HACT = 467 * MiB;
constexpr size_t WS_ABT = 539 * MiB;
constexpr size_t WS_END = 555 * MiB;
constexpr size_t QKV_QG = 0, QKV_KG = (size_t)NTOK * 512 * 2, QKV_VG = QKV_KG + (size_t)NTOK * 128 * 2, QKV_QW = QKV_VG + (size_t)NTOK * 128 * 2,
                 QKV_KW = QKV_QW + (size_t)NTOK * 256 * 2, QKV_VW = QKV_KW + (size_t)NTOK * 128 * 2;
static_assert(WS_WIN + (size_t)DEPTH * INW2 * DM * 2 <= WS_WBR && WS_QKV + QKV_VW + (size_t)NTOK * 128 * 2 <= WS_G && WS_G + (size_t)NTOK * 3 * DM * 2 <= WS_BR && WS_HACT >= WS_G + (size_t)NE * RPE * DM * 2 &&
              WS_HACT + (size_t)NE * RPE * DM * 2 <= WS_ABT && WS_ABT + (size_t)NBATCH * 256 * 2 * SEQ * 2 <= WS_END && (size_t)NBATCH * 256 * 2 * CTX * 2 <= 2 * MiB, "d_ws map");
constexpr int CW_BAR = 1024;
constexpr int CW_QUEUE = 8192;
constexpr int CW_CONVQ = 8192 + 64 * 8;
constexpr int CW_FIN = CW_CONVQ + 64;
constexpr int RING_BYTES = 131072;
constexpr int LDSCTL_OFF = RING_BYTES, MISC_OFF = LDSCTL_OFF + 320;
constexpr int IDXBUF_OFF = LDSCTL_OFF + 1024 + 8192;
constexpr int LDS_BYTES = 147456;

#define GAS __attribute__((address_space(1)))
#define LAS __attribute__((address_space(3)))
typedef unsigned short bf16;
typedef unsigned v4u __attribute__((ext_vector_type(4)));
typedef unsigned v2u __attribute__((ext_vector_type(2)));
typedef float f32x4 __attribute__((ext_vector_type(4)));
typedef GAS unsigned gu32;
#define RLX_AGENT __ATOMIC_RELAXED, __HIP_MEMORY_SCOPE_AGENT
#define LDS_WAIT() asm volatile("s_waitcnt lgkmcnt(0)" ::: "memory")
#define VM_WAIT() asm volatile("s_waitcnt vmcnt(0)" ::: "memory")
__device__ __forceinline__ unsigned f2bf(float f) { unsigned u = __builtin_bit_cast(unsigned, f); return (u + 0x7fffu + ((u >> 16) & 1u)) >> 16; }
__device__ __forceinline__ unsigned pk2(float lo, float hi) { return f2bf(lo) | (f2bf(hi) << 16); }
__device__ __forceinline__ float bf2f(unsigned short h) { return __builtin_bit_cast(float, (unsigned)h << 16); }
__device__ __forceinline__ float bflo(unsigned w) { return __builtin_bit_cast(float, w << 16); }
__device__ __forceinline__ float bfhi(unsigned w) { return __builtin_bit_cast(float, w & 0xffff0000u); }

#define XB_TMO      128
#define XB_XCNT(j)  (256  + 64 * (j))
#define XB_XSUB(j)  (1280 + 64 * (j))
#define XB_XGEN(j)  (2304 + 64 * (j))
#define XB_TOP      3328
#define XB_TOPGEN   3392
#define XCD_BAR_WORDS 3456
#define XB_SPIN_CAP (1u << 20)
__device__ __forceinline__ unsigned xb_ld(unsigned* p)              { return __hip_atomic_load(p, __ATOMIC_RELAXED, __HIP_MEMORY_SCOPE_AGENT); }
__device__ __forceinline__ unsigned xb_add(unsigned* p, unsigned v) { return __hip_atomic_fetch_add(p, v, __ATOMIC_RELAXED, __HIP_MEMORY_SCOPE_AGENT); }
__device__ __forceinline__ unsigned xb_xcc_id() { return (unsigned)__builtin_amdgcn_s_getreg((3 << 11) | 20) & 0xFu; }
#define XB_SPIN(cond, bar) do { unsigned _sp = 0; while (cond) { __builtin_amdgcn_s_sleep(1); \
    if ((++_sp & 255u) == 0u) { if (xb_ld(&(bar)[XB_TMO])) break; if (_sp > XB_SPIN_CAP) { atomicAdd(&(bar)[XB_TMO], 1u); break; } } } } while (0)
struct XcdBarrier { unsigned* bar; unsigned x; volatile LAS unsigned* st; };
__device__ __forceinline__ XcdBarrier xcd_barrier_post(unsigned* bar, volatile LAS unsigned* st) {
    XcdBarrier b; b.bar = bar; b.x = xb_xcc_id(); b.st = st;
    if (threadIdx.x == 0) (void)xb_add(&bar[XB_XCNT(b.x)], 1u);
    return b;
}
__device__ __forceinline__ void xcd_barrier_complete(unsigned* bar, unsigned x, unsigned& nloc, unsigned& nx) {
    const unsigned G = gridDim.x * gridDim.y * gridDim.z;
    unsigned sum, cnt, mine, sp = 0u;
    for (;;) {
        sum = 0u; cnt = 0u; mine = 0u;
#pragma unroll
        for (unsigned j = 0; j < 16; ++j) { const unsigned c = xb_ld(&bar[XB_XCNT(j)]); sum += c; cnt += (c > 0u) ? 1u : 0u; mine = (j == x) ? c : mine; }
        if (sum == G) break;
        __builtin_amdgcn_s_sleep(1);
        if ((++sp & 255u) == 0u) { if (xb_ld(&bar[XB_TMO])) break; if (sp > XB_SPIN_CAP) { atomicAdd(&bar[XB_TMO], 1u); break; } }
    }
    nloc = mine > 0u ? mine : 1u; nx = cnt > 0u ? cnt : 1u;
}
__device__ __forceinline__ void xcd_barrier(const XcdBarrier& b) {
    asm volatile("s_waitcnt vmcnt(0)" ::: "memory");
    __syncthreads();
    if (threadIdx.x == 0) {
        unsigned* bar = b.bar;
        __builtin_amdgcn_s_waitcnt(0);
        unsigned nloc = b.st[0], nx = b.st[1];
        if (nloc == 0u) { xcd_barrier_complete(bar, b.x, nloc, nx); b.st[0] = nloc; b.st[1] = nx; }
        const unsigned old = xb_add(&bar[XB_XSUB(b.x)], 1u);
        const unsigned gen = old / nloc;
        if (old + 1u == (gen + 1u) * nloc) {
            __builtin_amdgcn_fence(__ATOMIC_RELEASE, "agent");
            asm volatile("s_waitcnt vmcnt(0)" ::: "memory");
            const unsigned og = xb_add(&bar[XB_TOP], 1u);
            const unsigned tg = og / nx;
            if (og + 1u == (tg + 1u) * nx) xb_add(&bar[XB_TOPGEN], 1u);
            else XB_SPIN(xb_ld(&bar[XB_TOPGEN]) == tg, bar);
            __builtin_amdgcn_fence(__ATOMIC_ACQUIRE, "agent");
            xb_add(&bar[XB_XGEN(b.x)], 1u);
            asm volatile("s_waitcnt vmcnt(0)" ::: "memory");
        } else {
            XB_SPIN(xb_ld(&bar[XB_XGEN(b.x)]) == gen, bar);
            __builtin_amdgcn_fence(__ATOMIC_ACQUIRE, "agent");
            asm volatile("s_waitcnt vmcnt(0)" ::: "memory");
        }
    }
    __syncthreads();
}
template <int CTRL> __device__ __forceinline__ float dpp_mov(float v) { return __builtin_bit_cast(float, __builtin_amdgcn_update_dpp(0, __builtin_bit_cast(int, v), CTRL, 0xF, 0xF, true)); }
__device__ __forceinline__ float lx1(float v) { return dpp_mov<0xB1>(v); }
__device__ __forceinline__ float lx2(float v) { return dpp_mov<0x4E>(v); }
__device__ __forceinline__ float lx4(float v) { return dpp_mov<0x1B>(dpp_mov<0x141>(v)); }
__device__ __forceinline__ float lx8(float v) { return dpp_mov<0x141>(dpp_mov<0x140>(v)); }
__device__ __forceinline__ float lx16(float v) { return __shfl_xor(v, 16); }
__device__ __forceinline__ float lx32(float v) { const unsigned u = __builtin_bit_cast(unsigned, v); auto r = __builtin_amdgcn_permlane32_swap(u, u, false, false);
    return __builtin_bit_cast(float, (threadIdx.x & 32) ? r[0] : r[1]); }
__device__ __forceinline__ float wave_sum(float v) {
    v += lx1(v); v += lx2(v); v += lx4(v); v += lx8(v); v += lx16(v); v += lx32(v);
    return v;
}
using pg8::Unit;
typedef pg8::f32x4 (&AccRef)[2][2][4][2];

__device__ __forceinline__ v2u pack4(f32x4 v) { v2u w; w.x = pg8::cvt_pk_bf16(v[0], v[1]); w.y = pg8::cvt_pk_bf16(v[2], v[3]); return w; }
__device__ __forceinline__ float rsig_(float t) { return 1.f + __builtin_amdgcn_exp2f(fminf(t, 100.f)); }
__device__ __forceinline__ float sigmoidf_(float v) { return __builtin_amdgcn_rcpf(1.f + __builtin_amdgcn_exp2f(-LOG2E * v)); }

template <class Dec> struct Strided {
    Dec d; int n, G, vcu;
    __device__ __forceinline__ bool next(int i, Unit& u) const { const int L = i * G + vcu; if (L >= n) return false; d(L, u); return true; }
};

struct DecInProj { const char* A; const char* B; int layer;
    __device__ __forceinline__ void operator()(int L, Unit& u) const {
        int pm, pn;
        if (L < 1024) { const int cg = L >> 8, rg = (L & 255) >> 5, w = L & 31; pm = rg * 8 + (w & 7); pn = cg * 4 + (w >> 3);
            if (layer == DEPTH - 1 && L >= 1008) { const int q = L - 1008; pm = 64 + (q & 7); pn = (q >> 3) ? 6 : 4; } }
        else if (L < 1216) { const int q = L - 1024, rg = q / 24, w = q % 24; pm = rg * 8 + (w & 7); pn = 16 + (w >> 3); }
        else { const int q = L - 1216; pm = 64 + (q & 7); pn = q >> 3; if (layer == DEPTH - 1) pn = pn ? 6 : 4; }
        u.A = A + (size_t)pm * 256 * (DM * 2); u.B = B + (size_t)pn * 256 * (DM * 2); u.arows = nullptr; u.ldA = DM * 2; u.ldB = DM * 2; u.nt = DM / 64; u.pm = pm; u.pn = pn; u.tag = 0;
        if (pn < 2) { const char* t = u.A; u.A = u.B; u.B = t; }
    } };
constexpr int inproj_units(int layer) { return layer == DEPTH - 1 ? 1024 : 1216 + 152; }
constexpr int INPROJ_DEFERRED = 208;
__device__ __forceinline__ void inproj_deferred(int d, const char* A, const char* B, Unit& u) {
    int pm, pn;
    if (d < 192) { const int rg = d / 24, w = d % 24; pm = rg * 8 + (w & 7); pn = 16 + (w >> 3); } else { const int v = d - 192; pm = 56 + (v & 7); pn = 14 + (v >> 3); }
    u.A = A + (size_t)pm * 256 * (DM * 2); u.B = B + (size_t)pn * 256 * (DM * 2); u.arows = nullptr; u.ldA = DM * 2; u.ldB = DM * 2; u.nt = DM / 64; u.pm = pm; u.pn = pn; u.tag = 0;
}
struct OneUnit { Unit u; __device__ __forceinline__ bool next(int i, Unit& o) const { if (i) return false; o = u; return true; } };

struct EpiInProj {
    static constexpr bool PERM = true;
    bf16 *ABt, *ABtc, *Qg, *Kg, *Vg, *Qw, *Kw, *Vw, *G; const LAS float* rope; const LAS float* qng; const LAS float* kng;
    __device__ __forceinline__ bool operator()(AccRef acc, const Unit& u, int wr, int wc, int fr, int fq) const {
        const int pm = u.pm, pn = u.pn; const bool lat = pm < 64;
        const int rowt = wr * 64 + fr;
        if (pn < 2) {
            bf16* dst; int ld;
            if (lat) { dst = ABt + ((size_t)(pm >> 3) * 256) * (2 * SEQ) + pn * SEQ + (pm & 7) * 256; ld = 2 * SEQ; }
            else { dst = ABtc + ((size_t)(pm - 64) * 256) * (2 * CTX) + pn * CTX; ld = 2 * CTX; }
            dst += (size_t)rowt * ld + wc * 32 + fq * 8;
#pragma unroll
            for (int ai = 0; ai < 2; ++ai)
#pragma unroll
                for (int m = 0; m < 4; ++m)
#pragma unroll
                    for (int bj = 0; bj < 2; ++bj) { const v2u o0 = pack4(acc[ai][bj][m][0]), o1 = pack4(acc[ai][bj][m][1]);
                        *(v4u*)(dst + (size_t)(ai * 128 + m * 16) * ld + bj * 128) = (v4u){o0.x, o0.y, o1.x, o1.y}; }
        } else if (pn < 7) {
            bf16* dst; int ld; const LAS float* ng = nullptr; bool rope_on = false; float sc = 1.f;
            if (pn <= 3)      { dst = Qg + (pn - 2) * 256 + wc * 64; ld = 512; ng = qng; rope_on = lat; sc = QSCALE; }
            else if (pn == 4) { if (wc < 2) { dst = Kg + wc * 64; ng = kng; rope_on = lat; } else { dst = Vg + (wc - 2) * 64; } ld = 128; }
            else if (pn == 5) { dst = Qw + wc * 64; ld = 256; rope_on = lat; sc = QSCALE; }
            else              { if (wc < 2) { dst = Kw + wc * 64; rope_on = lat; } else { dst = Vw + (wc - 2) * 64; } ld = 128; }
#pragma unroll
            for (int ai = 0; ai < 2; ++ai)
#pragma unroll
                for (int m = 0; m < 4; ++m) {
                    const int row = pm * 256 + rowt + ai * 128 + m * 16;
                    pg8::f32x4 v[2][2];
                    float ss = 0.f;
#pragma unroll
                    for (int bj = 0; bj < 2; ++bj)
#pragma unroll
                        for (int n = 0; n < 2; ++n) { v[bj][n] = acc[ai][bj][m][n]; ss += (v[bj][n][0] * v[bj][n][0] + v[bj][n][1] * v[bj][n][1]) + (v[bj][n][2] * v[bj][n][2] + v[bj][n][3] * v[bj][n][3]); }
                    float r = sc;
                    if (ng) { ss += __shfl_xor(ss, 16); ss += __shfl_xor(ss, 32); r = sc * rsqrtf(ss * (1.f / 64.f) + EPS); }
                    const int t = row & (SEQ - 1);
#pragma unroll
                    for (int bj = 0; bj < 2; ++bj) { v2u o[2];
#pragma unroll
                        for (int n = 0; n < 2; ++n) {
                            pg8::f32x4 x = v[bj][n] * r; if (ng) x = x * *(const LAS pg8::f32x4*)(ng + bj * 32 + fq * 8 + n * 4);
                            if (rope_on) {
                                const int pos = bj ? (t & 63) : (t >> 6);
                                const pg8::f32x4 cs = *(const LAS pg8::f32x4*)(rope + (pos * 16 + fq * 4 + n * 2) * 2);
                                x = (pg8::f32x4){x[0] * cs[0] - x[1] * cs[1], x[0] * cs[1] + x[1] * cs[0], x[2] * cs[2] - x[3] * cs[3], x[2] * cs[3] + x[3] * cs[2]};
                            }
                            o[n] = pack4(x);
                        }
                        *(v4u*)(dst + (size_t)row * ld + bj * 32 + fq * 8) = (v4u){o[0].x, o[0].y, o[1].x, o[1].y}; }
                    asm volatile("" ::: "memory");
                }
        } else {
            bf16* dst = G + ((size_t)pm * 12 + (pn - 7)) * 65536 + (size_t)(((wr * 4 + wc) * 64 + fq * 16 + fr) * 8);
#pragma unroll
            for (int ai = 0; ai < 2; ++ai)
#pragma unroll
                for (int bj = 0; bj < 2; ++bj)
#pragma unroll
                    for (int m = 0; m < 4; ++m) { const pg8::f32x4 a = acc[ai][bj][m][0], b = acc[ai][bj][m][1];
                        const v2u lo = pack4((pg8::f32x4){rsig_(a[0]), rsig_(a[1]), rsig_(a[2]), rsig_(a[3])}), hi = pack4((pg8::f32x4){rsig_(b[0]), rsig_(b[1]), rsig_(b[2]), rsig_(b[3])});
                        *(v4u*)(dst + (size_t)(((ai * 2 + bj) * 4 + m) * 4096)) = (v4u){lo.x, lo.y, hi.x, hi.y}; }
        }
        return false;
    }
};

struct EpiStore { static constexpr bool PERM = true; bf16* O; int ld;
    __device__ __forceinline__ bool operator()(AccRef acc, const Unit& u, int wr, int wc, int fr, int fq) const {
        bf16* dst = O + ((size_t)u.pm * 256 + wr * 64 + fr) * ld + u.pn * 256 + wc * 32 + fq * 8;
#pragma unroll
        for (int ai = 0; ai < 2; ++ai)
#pragma unroll
            for (int m = 0; m < 4; ++m)
#pragma unroll
                for (int bj = 0; bj < 2; ++bj) { const v2u o0 = pack4(acc[ai][bj][m][0]), o1 = pack4(acc[ai][bj][m][1]);
                    *(v4u*)(dst + (size_t)(ai * 128 + m * 16) * ld + bj * 128) = (v4u){o0.x, o0.y, o1.x, o1.y}; }
        return false;
    } };
struct DecDft { const char* Dm; const char* Dc; const char* ABt; const char* ABtc;
    __device__ __forceinline__ void operator()(int L, Unit& u) const {
        if (L < 64) { const int b = L >> 3, mt = L & 7; u.A = Dm + (size_t)mt * 256 * (4 * SEQ); u.B = ABt + (size_t)b * 256 * (4 * SEQ); u.ldA = 4 * SEQ; u.ldB = 4 * SEQ; u.nt = 2 * SEQ / 64; u.pm = L; }
        else { const int b = L - 64; u.A = Dc; u.B = ABtc + (size_t)b * 256 * (4 * CTX); u.ldA = 4 * CTX; u.ldB = 4 * CTX; u.nt = 2 * CTX / 64; u.pm = 64 + b; }
        u.pn = 0; u.tag = 0; u.arows = nullptr;
    } };

struct SchedDft { const char* Dm; const char* Dc; const char* ABt; const char* ABtc; int nctx, G, vcu;
    __device__ __forceinline__ bool next(int i, Unit& u) const {
        int q = vcu; if (G == 256) { if ((vcu & 31) >= 6) return false; q = (vcu >> 5) * 6 + (vcu & 31); }
        u.pn = 0; u.arows = nullptr;
        if (q < 32) { if (i > 1) return false; const int mt = q >> 3, b = q & 7;
            u.A = Dm + (size_t)mt * 256 * (4 * SEQ) + (size_t)i * (2 * SEQ); u.B = ABt + (size_t)b * 256 * (4 * SEQ) + (size_t)i * (2 * SEQ); u.ldA = 4 * SEQ; u.ldB = 4 * SEQ; u.nt = SEQ / 64; u.pm = b * 8 + mt; u.tag = i; return true; }
        if (i > 0) return false;
        if (q < 40) { const int b = q - 32; u.A = Dm + (size_t)(SEQ / 2) * (4 * SEQ); u.B = ABt + (size_t)b * 256 * (4 * SEQ); u.ldA = 4 * SEQ; u.ldB = 4 * SEQ; u.nt = SEQ / 64; u.pm = b * 8 + 4; u.tag = 2; return true; }
        if (q < 40 + nctx) { const int b = q - 40; u.A = Dc; u.B = ABtc + (size_t)b * 256 * (4 * CTX); u.ldA = 4 * CTX; u.ldB = 4 * CTX; u.nt = 2 * CTX / 64; u.pm = 64 + b; u.tag = 3; return true; }
        return false;
    } };
struct EpiDft { static constexpr bool PERM = true; bf16* O; float* T; int slot;
    __device__ __forceinline__ bool operator()(AccRef acc, const Unit& u, int wr, int wc, int fr, int fq) const {
        const int tag = u.tag, rt = wr * 64 + fr, col = wc * 32 + fq * 8;
        const int tid = (wr * 4 + wc) * 64 + fq * 16 + fr;
        if (tag == 0) {
            GAS pg8::f32x4* t = (GAS pg8::f32x4*)T + tid;
#pragma unroll
            for (int ai = 0; ai < 2; ++ai)
#pragma unroll
                for (int bj = 0; bj < 2; ++bj)
#pragma unroll
                    for (int m = 0; m < 4; ++m)
#pragma unroll
                        for (int n = 0; n < 2; ++n) t[(size_t)((((ai * 2 + bj) * 4 + m) * 2 + n) * 512)] = acc[ai][bj][m][n];
        } else if (tag == 1) {
            const GAS pg8::f32x4* t = (const GAS pg8::f32x4*)T + tid;
            const int b = u.pm >> 3, k0 = (u.pm & 7) * 256 + rt;
#pragma unroll
            for (int ai = 0; ai < 2; ++ai)
#pragma unroll
                for (int bj = 0; bj < 2; ++bj) {
                    pg8::f32x4 p[4][2];
#pragma unroll
                    for (int m = 0; m < 4; ++m)
#pragma unroll
                        for (int n = 0; n < 2; ++n) p[m][n] = t[(size_t)((((ai * 2 + bj) * 4 + m) * 2 + n) * 512)];
#pragma unroll
                    for (int m = 0; m < 4; ++m) { const int k = k0 + ai * 128 + m * 16;
                        const v2u a0 = pack4(p[m][0] + acc[ai][bj][m][0]), a1 = pack4(p[m][1] + acc[ai][bj][m][1]);
                        *(v4u*)(O + ((size_t)b * SEQ + k) * DM + col + bj * 128) = (v4u){a0.x, a0.y, a1.x, a1.y};
                        if (k != 0) { const v2u s0 = pack4(p[m][0] - acc[ai][bj][m][0]), s1 = pack4(p[m][1] - acc[ai][bj][m][1]);
                            *(v4u*)(O + ((size_t)b * SEQ + (SEQ - k)) * DM + col + bj * 128) = (v4u){s0.x, s0.y, s1.x, s1.y}; } }
                    asm volatile("" ::: "memory");
                }
        } else if (tag == 2) {
            if (rt == 0) {
                const int b = u.pm >> 3;
#pragma unroll
                for (int bj = 0; bj < 2; ++bj) { const v2u a0 = pack4(acc[0][bj][0][0]), a1 = pack4(acc[0][bj][0][1]);
                    *(v4u*)(O + ((size_t)b * SEQ + SEQ / 2) * DM + col + bj * 128) = (v4u){a0.x, a0.y, a1.x, a1.y}; }
            }
        } else {
            bf16* dst = O + ((size_t)u.pm * 256 + rt) * DM + col;
#pragma unroll
            for (int ai = 0; ai < 2; ++ai)
#pragma unroll
                for (int m = 0; m < 4; ++m)
#pragma unroll
                    for (int bj = 0; bj < 2; ++bj) { const v2u o0 = pack4(acc[ai][bj][m][0]), o1 = pack4(acc[ai][bj][m][1]);
                        *(v4u*)(dst + (size_t)(ai * 128 + m * 16) * DM + bj * 128) = (v4u){o0.x, o0.y, o1.x, o1.y}; }
        }
        return false;
    } };

struct SchedMerge { const char* BR; const char* W; int ntiles, G, vcu;
    __device__ __forceinline__ bool next(int i, Unit& u) const {
        const int round = i / 3, tag = i - round * 3, tile = round * G + vcu; if (tile >= ntiles) return false;
        const int pm = tile >> 2, pn = tile & 3, koff = tag == 0 ? 0 : (tag == 1 ? 256 : 768);
        u.A = BR + (size_t)pm * 256 * (DM * 2) + koff * 2; u.B = W + (size_t)pn * 256 * (DM * 2) + koff * 2; u.arows = nullptr; u.ldA = DM * 2; u.ldB = DM * 2; u.nt = tag == 1 ? 8 : 4; u.pm = pm; u.pn = pn; u.tag = tag;
        return true;
    } };
struct EpiMerge { static constexpr bool PERM = true; const bf16* G; bf16* Mb; int probe;
    __device__ __forceinline__ bool operator()(AccRef acc, const Unit& u, int wr, int wc, int fr, int fq) const {
        const size_t row0 = (size_t)u.pm * 256 + wr * 64 + fr; const int col0 = u.pn * 256 + wc * 32 + fq * 8; const int tag = u.tag;
        const GAS char* gt = (const GAS char*)(G + ((size_t)u.pm * 12 + tag * 4 + u.pn) * 65536);
        const unsigned lo = (unsigned)(((wr * 4 + wc) * 64 + fq * 16 + fr) * 16);
        if (tag < 2) {
#pragma unroll
            for (int q = 0; q < 4; ++q) { const int ai = q >> 1, bj = q & 1;
                v4u gwv[4], hwv[4];
#pragma unroll
                for (int m = 0; m < 4; ++m) { const GAS char* gp = gt + (size_t)((q * 4 + m) * 8192); asm volatile("" : "+s"(gp)); gwv[m] = *(const GAS v4u*)(gp + lo); }
#pragma unroll
                for (int m = 0; m < 4; ++m) { const GAS char* gp = gt + (size_t)(4 * 131072 + (q * 4 + m) * 8192); asm volatile("" : "+s"(gp)); hwv[m] = *(const GAS v4u*)(gp + lo); }
#pragma unroll
                for (int m = 0; m < 4; ++m) { const v4u gw = gwv[m], hw = hwv[m];
                    const pg8::f32x4 ga = {__builtin_amdgcn_rcpf(bflo(gw.x)) * bflo(hw.x), __builtin_amdgcn_rcpf(bfhi(gw.x)) * bfhi(hw.x), __builtin_amdgcn_rcpf(bflo(gw.y)) * bflo(hw.y), __builtin_amdgcn_rcpf(bfhi(gw.y)) * bfhi(hw.y)};
                    const pg8::f32x4 gb = {__builtin_amdgcn_rcpf(bflo(gw.z)) * bflo(hw.z), __builtin_amdgcn_rcpf(bfhi(gw.z)) * bfhi(hw.z), __builtin_amdgcn_rcpf(bflo(gw.w)) * bflo(hw.w), __builtin_amdgcn_rcpf(bfhi(gw.w)) * bfhi(hw.w)};
                    acc[ai][bj][m][0] = acc[ai][bj][m][0] * ga; acc[ai][bj][m][1] = acc[ai][bj][m][1] * gb; }
                asm volatile("" ::: "memory");
            }
        } else {
#pragma unroll
            for (int ai = 0; ai < 2; ++ai) {
                v4u gwv[8];
#pragma unroll
                for (int i = 0; i < 8; ++i) { const GAS char* gp = gt + (size_t)((ai * 8 + i) * 8192); asm volatile("" : "+s"(gp)); gwv[i] = *(const GAS v4u*)(gp + lo); }
#pragma unroll
                for (int i = 0; i < 8; ++i) { const int bj = i >> 2, m = i & 3; const v4u gw = gwv[i];
                    const pg8::f32x4 ga = {__builtin_amdgcn_rcpf(bflo(gw.x)), __builtin_amdgcn_rcpf(bfhi(gw.x)), __builtin_amdgcn_rcpf(bflo(gw.y)), __builtin_amdgcn_rcpf(bfhi(gw.y))};
                    const pg8::f32x4 gb = {__builtin_amdgcn_rcpf(bflo(gw.z)), __builtin_amdgcn_rcpf(bfhi(gw.z)), __builtin_amdgcn_rcpf(bflo(gw.w)), __builtin_amdgcn_rcpf(bfhi(gw.w))};
                    const size_t row = row0 + ai * 128 + m * 16; const int c = col0 + bj * 128;
                    const v2u o0 = pack4(acc[ai][bj][m][0] * ga), o1 = pack4(acc[ai][bj][m][1] * gb); *(v4u*)(Mb + row * DM + c) = (v4u){o0.x, o0.y, o1.x, o1.y}; }
                asm volatile("" ::: "memory");
            }
        }
        return tag < 2;
    } };

struct DecWout { const char* Mb; const char* W;
    __device__ __forceinline__ void operator()(int L, Unit& u) const { const int pm = L >> 2, pn = L & 3;
        u.A = Mb + (size_t)pm * 256 * (DM * 2); u.B = W + (size_t)pn * 256 * (DM * 2); u.arows = nullptr; u.ldA = DM * 2; u.ldB = DM * 2; u.nt = DM / 64; u.pm = pm; u.pn = pn; u.tag = 0; } };
struct EpiWout { static constexpr bool PERM = true; const float* baseL; const float* baseC; const bf16* baseX; bf16* X; const float* mod; int from_x;
    __device__ __forceinline__ bool operator()(AccRef acc, const Unit& u, int wr, int wc, int fr, int fq) const {
        const int pm = u.pm; const float* g1 = mod + (size_t)(pm < 64 ? (pm >> 3) : 8) * (6 * DM) + 2 * DM;
        const size_t ub = ((size_t)pm * 256 + wr * 64) * DM + u.pn * 256;
        const unsigned lo = (unsigned)(fr * DM + wc * 32 + fq * 8);
        const GAS char* bF = (const GAS char*)((pm < 64 ? baseL : baseC) + ub); const GAS char* bX = (const GAS char*)(baseX + ub);
        const size_t row0 = (size_t)pm * 256 + wr * 64 + fr; const int col0 = u.pn * 256 + wc * 32 + fq * 8;
#pragma unroll
        for (int bj = 0; bj < 2; ++bj) { const int c = col0 + bj * 128; const pg8::f32x4 gv0 = *(const pg8::f32x4*)(g1 + c), gv1 = *(const pg8::f32x4*)(g1 + c + 4);
            if (from_x) {
                v4u w[8];
#pragma unroll
                for (int i = 0; i < 8; ++i) { const GAS char* p = bX + (size_t)((((i >> 2) * 128 + (i & 3) * 16) * DM + bj * 128) * 2); asm volatile("" : "+s"(p)); w[i] = *(const GAS v4u*)(p + lo * 2u); }
#pragma unroll
                for (int i = 0; i < 8; ++i) { const int ai = i >> 2, m = i & 3; const size_t off = (row0 + ai * 128 + m * 16) * DM + c;
                    const pg8::f32x4 b0 = {bflo(w[i].x), bfhi(w[i].x), bflo(w[i].y), bfhi(w[i].y)}, b1 = {bflo(w[i].z), bfhi(w[i].z), bflo(w[i].w), bfhi(w[i].w)};
                    const v2u o0 = pack4(b0 + gv0 * acc[ai][bj][m][0]), o1 = pack4(b1 + gv1 * acc[ai][bj][m][1]);
                    *(v4u*)(X + off) = (v4u){o0.x, o0.y, o1.x, o1.y}; }
            } else {
                pg8::f32x4 b0[8], b1[8];
#pragma unroll
                for (int i = 0; i < 8; ++i) { const GAS char* p = bF + (size_t)((((i >> 2) * 128 + (i & 3) * 16) * DM + bj * 128) * 4); asm volatile("" : "+s"(p)); b0[i] = *(const GAS pg8::f32x4*)(p + lo * 4u); b1[i] = *(const GAS pg8::f32x4*)(p + lo * 4u + 16); }
#pragma unroll
                for (int i = 0; i < 8; ++i) { const int ai = i >> 2, m = i & 3; const size_t off = (row0 + ai * 128 + m * 16) * DM + c;
                    const v2u o0 = pack4(b0[i] + gv0 * acc[ai][bj][m][0]), o1 = pack4(b1[i] + gv1 * acc[ai][bj][m][1]);
                    *(v4u*)(X + off) = (v4u){o0.x, o0.y, o1.x, o1.y}; }
            }
            asm volatile("" ::: "memory");
        }
        return false;
    } };

struct DecGU { const char* H2; const int* IDX; const char* W; int nrt;
    __device__ __forceinline__ void operator()(int L, Unit& u) const { const int per = nrt * 8, e = L / per, q = L - e * per, ct = q & 7, rt = q >> 3;
        u.A = H2; u.arows = IDX + (size_t)e * RPE + rt * 256; u.B = W + ((size_t)e * 2 * DM + ct * 256) * (DM * 2); u.ldA = DM * 2; u.ldB = DM * 2; u.nt = DM / 64; u.pm = rt; u.pn = ct; u.tag = e; } };
struct EpiGU { static constexpr bool PERM = true; bf16* H;
    __device__ __forceinline__ bool operator()(AccRef acc, const Unit& u, int wr, int wc, int fr, int fq) const {
        bf16* dst = H + ((size_t)u.tag * RPE + u.pm * 256 + wr * 64 + fr) * DM + u.pn * 128 + wc * 32 + fq * 8;
#pragma unroll
        for (int ai = 0; ai < 2; ++ai)
#pragma unroll
            for (int m = 0; m < 4; ++m) { v2u o[2];
#pragma unroll
                for (int n = 0; n < 2; ++n) { const pg8::f32x4 a = acc[ai][0][m][n], up = acc[ai][1][m][n];
                    o[n] = pack4((pg8::f32x4){a[0] * sigmoidf_(a[0]) * up[0], a[1] * sigmoidf_(a[1]) * up[1], a[2] * sigmoidf_(a[2]) * up[2], a[3] * sigmoidf_(a[3]) * up[3]}); }
                *(v4u*)(dst + (size_t)(ai * 128 + m * 16) * DM) = (v4u){o[0].x, o[0].y, o[1].x, o[1].y}; }
        return false;
    } };
struct DecDown { const char* H; const char* W; int nrt;
    __device__ __forceinline__ void operator()(int L, Unit& u) const { const int per = nrt * 4, e = L / per, q = L - e * per, ct = q & 3, rt = q >> 2;
        u.A = H + ((size_t)e * RPE + rt * 256) * (DM * 2); u.arows = nullptr; u.B = W + ((size_t)e * DM + ct * 256) * (DM * 2); u.ldA = DM * 2; u.ldB = DM * 2; u.nt = DM / 64; u.pm = rt; u.pn = ct; u.tag = e; } };
struct EpiDown { static constexpr bool PERM = true; bf16* Y; const float* afs;
    __device__ __forceinline__ bool operator()(AccRef acc, const Unit& u, int wr, int wc, int fr, int fq) const {
        const size_t r0 = (size_t)u.tag * RPE + u.pm * 256 + wr * 64 + fr;
        float av[2][4];
#pragma unroll
        for (int ai = 0; ai < 2; ++ai)
#pragma unroll
            for (int m = 0; m < 4; ++m) av[ai][m] = afs[r0 + ai * 128 + m * 16];
#pragma unroll
        for (int ai = 0; ai < 2; ++ai)
#pragma unroll
            for (int m = 0; m < 4; ++m) { const size_t r = r0 + ai * 128 + m * 16; const float a = av[ai][m];
#pragma unroll
                for (int bj = 0; bj < 2; ++bj) { const v2u o0 = pack4(acc[ai][bj][m][0] * a), o1 = pack4(acc[ai][bj][m][1] * a);
                    *(v4u*)(Y + r * DM + u.pn * 256 + bj * 128 + wc * 32 + fq * 8) = (v4u){o0.x, o0.y, o1.x, o1.y}; } }
        return false;
    } };
struct Frame {
    LAS unsigned char* lds; char* ldsg; volatile LAS unsigned* MISC; gu32* ctl;
    int vcu, G;
    unsigned char* ws; unsigned char* dout; float* out;
};
constexpr int PTRS_OFF = LDSCTL_OFF + 512;
enum { IN_X = 0, IN_C, IN_CTX, IN_CCTX, IN_WADA, IN_BADA, IN_NORM1G, IN_WIN, IN_QNG, IN_KNG, IN_SINK, IN_WBRF, IN_WBRG, IN_WBRW, IN_WOUT, IN_NORM2G, IN_WROUTER, IN_WGATE, IN_WUP, IN_WDOWN, IN_FINALG };
__device__ __forceinline__ const float* inptr(const Frame& F, int k) {
    const unsigned long long v = *(const LAS unsigned long long*)(F.lds + PTRS_OFF + 8 * k);
    const unsigned lo = __builtin_amdgcn_readfirstlane((unsigned)v), hi = __builtin_amdgcn_readfirstlane((unsigned)(v >> 32));
    return (const float*)(((unsigned long long)hi << 32) | lo);
}
#define WSP(T, off) ((T*)(F.ws + (off)))

constexpr int COSTAB_OFF = LDSCTL_OFF + 1024;
static_assert(COSTAB_OFF + 8192 <= LDS_BYTES, "cos table fits");
__device__ __forceinline__ void transpose_item(const float* W, int ldw, int k0, int n0, bf16* WT, int drow0, int dld, int dk0, int lane, float sc = 1.f) {
    const int g = lane >> 3, n4 = (lane & 7) * 4;
    const float* src = W + (size_t)(k0 + 8 * g) * ldw + n0 + n4;
    f32x4 v[8];
#pragma unroll
    for (int i = 0; i < 8; ++i) v[i] = *(const GAS f32x4*)(src + (size_t)i * ldw);
    bf16* dst = WT + (size_t)(drow0 + n4) * dld + dk0 + k0 + 8 * g;
#pragma unroll
    for (int j = 0; j < 4; ++j) { v4u o; o.x = pk2(v[0][j] * sc, v[1][j] * sc); o.y = pk2(v[2][j] * sc, v[3][j] * sc); o.z = pk2(v[4][j] * sc, v[5][j] * sc); o.w = pk2(v[6][j] * sc, v[7][j] * sc);
        *(GAS v4u*)(dst + (size_t)j * dld) = o; }
}
__device__ __forceinline__ void transpose_item2(const float* W, int ldw, int k0, int n0, bf16* WT, int drow0, int dld, int lane) {
    const int g = lane >> 3, n4 = (lane & 7) * 4;
    const float* src = W + (size_t)(k0 + 8 * g) * ldw + n0 + n4;
    f32x4 v[2][8];
#pragma unroll
    for (int h = 0; h < 2; ++h)
#pragma unroll
        for (int i = 0; i < 8; ++i) v[h][i] = __builtin_nontemporal_load((const GAS f32x4*)(src + (size_t)(h * 64 + i) * ldw));
    bf16* dst = WT + (size_t)(drow0 + n4) * dld + k0 + 8 * g;
#pragma unroll
    for (int h = 0; h < 2; ++h)
#pragma unroll
        for (int j = 0; j < 4; ++j) { v4u o; o.x = pk2(v[h][0][j], v[h][1][j]); o.y = pk2(v[h][2][j], v[h][3][j]); o.z = pk2(v[h][4][j], v[h][5][j]); o.w = pk2(v[h][6][j], v[h][7][j]);
            __builtin_nontemporal_store(o, (GAS v4u*)(dst + (size_t)j * dld + h * 64)); }
}
__device__ __forceinline__ void fold_item(const float* W, int k0, int g, int sinmode, bf16* WT, int drow0, LAS float* scr, const LAS float* ctab, int lane) {
#pragma unroll
    for (int kk = 0; kk < 16; ++kk) scr[lane * 20 + kk] = W[(size_t)(k0 + kk) * INW + g * 64 + lane];
    LDS_WAIT(); asm volatile("" ::: "memory");
    float acc[16];
#pragma unroll
    for (int k = 0; k < 16; ++k) acc[k] = 0.f;
#pragma unroll 4
    for (int c = 0; c < 64; ++c) {
        const int r = (c * lane) & 63;
        const float tv = sinmode ? -ctab[((r - 16) & 63) * 32] : ctab[r * 32];
#pragma unroll
        for (int k4 = 0; k4 < 4; ++k4) { const f32x4 w = *(const LAS f32x4*)(scr + c * 20 + 4 * k4);
            acc[4 * k4] = fmaf(w[0], tv, acc[4 * k4]); acc[4 * k4 + 1] = fmaf(w[1], tv, acc[4 * k4 + 1]); acc[4 * k4 + 2] = fmaf(w[2], tv, acc[4 * k4 + 2]); acc[4 * k4 + 3] = fmaf(w[3], tv, acc[4 * k4 + 3]); }
    }
    GAS v4u* dst = (GAS v4u*)(WT + (size_t)(drow0 + lane) * DM + k0);
#pragma unroll
    for (int q = 0; q < 2; ++q) { v4u o; o.x = pk2(acc[8 * q], acc[8 * q + 1]); o.y = pk2(acc[8 * q + 2], acc[8 * q + 3]); o.z = pk2(acc[8 * q + 4], acc[8 * q + 5]); o.w = pk2(acc[8 * q + 6], acc[8 * q + 7]); dst[q] = o; }
    LDS_WAIT(); asm volatile("" ::: "memory");
}

#ifndef CONV_IN_ATTN
#define CONV_IN_ATTN 0
#endif
constexpr int CONV_WAVE_ITEMS = DEPTH * NE * 768, CONV_ITEMS = CONV_WAVE_ITEMS / NWAVES, CONV_ITEMS_L0 = CONV_ITEMS / DEPTH;
__device__ __forceinline__ void conv_wave_item(Frame& F, int r, int lane) {
    const int le = r / 768, q = r % 768, which = q / 256, qq = q % 256, kb = qq >> 5, nb = qq & 31, f0 = nb * 32;
    if (which < 2) transpose_item2((which ? inptr(F, IN_WUP) : inptr(F, IN_WGATE)) + (size_t)le * DM * DM, DM, kb * 128, f0, WSP(bf16, WS_WGU) + (size_t)le * 2 * DM * DM, (f0 >> 7) * 256 + which * 128 + (f0 & 127), DM, lane);
    else transpose_item2(inptr(F, IN_WDOWN) + (size_t)le * DM * DM, DM, kb * 128, f0, WSP(bf16, WS_WD) + (size_t)le * DM * DM, f0, DM, lane);
}
__device__ __forceinline__ void tail_convert(Frame& F, int idx, int first, int per, int end) {
    int tid_ = threadIdx.x; asm volatile("" : "+v"(tid_));
    const int lane = tid_ & 63, wave_ = __builtin_amdgcn_readfirstlane(tid_ >> 6);
    for (int t = 0; t < per; ++t) { const int it = first + idx * per + t; if (it >= end) break; conv_wave_item(F, it * NWAVES + wave_, lane); }
}

__device__ __forceinline__ void p0_prologue(Frame& F, int mode = 0) {
    int tid_ = threadIdx.x; asm volatile("" : "+v"(tid_));
    const int lane = tid_ & 63, wave_ = __builtin_amdgcn_readfirstlane(tid_ >> 6);
    const int gw = F.vcu * NWAVES + wave_, NGW = F.G * NWAVES;
    LAS float* st = (LAS float*)F.lds;
    LAS float* red = (LAS float*)(F.lds + 40960);
    LAS float* ctab = (LAS float*)(F.lds + COSTAB_OFF);
    { const float* cp = inptr(F, IN_C); const float* ccp = inptr(F, IN_CCTX);
      f32x4 cv[5];
#pragma unroll
      for (int u = 0; u < 5; ++u) { const int i4 = tid_ + u * (NWAVES * 64), e0 = 4 * i4, s = e0 / DM, k = e0 - s * DM;
          cv[u] = i4 < 9 * DM / 4 ? (s < 8 ? *(const f32x4*)(cp + s * DM + k) : *(const f32x4*)(ccp + k)) : (f32x4){0.f, 0.f, 0.f, 0.f}; }
#pragma unroll
      for (int u = 0; u < 5; ++u) { const int i4 = tid_ + u * (NWAVES * 64);
          if (i4 < 9 * DM / 4) { f32x4 o;
#pragma unroll
              for (int c = 0; c < 4; ++c) o[c] = cv[u][c] / (1.f + expf(-cv[u][c]));
              *(LAS f32x4*)(st + 4 * i4) = o; } } }
    for (int i = tid_; i < 2048; i += NWAVES * 64) ctab[i] = cosf(6.283185307179586f * (float)i * (1.f / 2048.f));
    __syncthreads();
    const float* bada = inptr(F, IN_BADA);
    if (mode != 2) for (int it = F.vcu; it < DEPTH * 96; it += F.G) {
        const int l = it / 96, j = (it % 96) * 64 + lane, kb = wave_ * 128;
        const float* W = inptr(F, IN_WADA) + (size_t)l * DM * 6 * DM + (size_t)kb * 6 * DM + j;
        float acc[9];
#pragma unroll
        for (int s = 0; s < 9; ++s) acc[s] = 0.f;
        for (int k0 = 0; k0 < 128; k0 += 16) {
            float w[16];
#pragma unroll
            for (int i = 0; i < 16; ++i) w[i] = W[(size_t)(k0 + i) * 6 * DM];
#pragma unroll
            for (int i = 0; i < 16; ++i)
#pragma unroll
                for (int s = 0; s < 9; ++s) acc[s] = fmaf(st[s * DM + kb + k0 + i], w[i], acc[s]);
        }
#pragma unroll
        for (int s = 0; s < 9; ++s) red[(wave_ * 9 + s) * 64 + lane] = acc[s];
        __syncthreads();
        for (int o = tid_; o < 9 * 64; o += NWAVES * 64) { float v = 0.f;
#pragma unroll
            for (int w = 0; w < 8; ++w) v += red[w * 576 + o];
            const int s = o >> 6, jj = (it % 96) * 64 + (o & 63);
            WSP(float, WS_MOD)[((size_t)l * 9 + s) * 6 * DM + jj] = v + bada[l * 6 * DM + jj]; }
        __syncthreads();
    }
    __syncthreads();
#ifdef DBG_POISON
    {
        const size_t n16 = (WS_END - WS_X) / 16, m16 = ((size_t)NLAT * DM * 4) / 16; const v4u pz = {0xFFFFFFFFu, 0xFFFFFFFFu, 0xFFFFFFFFu, 0xFFFFFFFFu};
        for (size_t i = (size_t)gw * 64 + lane; i < n16; i += (size_t)NGW * 64) ((GAS v4u*)(F.ws + WS_X))[i] = pz;
        for (size_t i = (size_t)gw * 64 + lane; i < m16; i += (size_t)NGW * 64) ((GAS v4u*)F.dout)[i] = pz;
    }
#endif
    LAS float* scr = (LAS float*)(F.lds + wave_ * 16384);
    constexpr int T_A = DEPTH * 2176, T_B = DEPTH * 512, T_C = DEPTH * 512, T_D = DEPTH * 512, T_E = DEPTH * NE * 768, T_F = (SEQ / 2 + 256) + CTX, T_G = 1;
    constexpr int NITEMS = T_A + T_B + T_C + T_D + T_E + T_F + T_G;
    const bool wdeal = F.G == 256; const int NA_ = wdeal ? NITEMS - 1024 : NITEMS; const bool freewg = wdeal && F.vcu >= 192; bool tailpass = false;
    if (mode != 1 && mode != 5 && mode != 6) for (int it = gw;; it += tailpass ? 512 : NGW) {
        if (!tailpass && it >= NA_) { if (!freewg) break; tailpass = true; it = NA_ + (F.vcu - 192) * NWAVES + wave_; }
        if (it >= NITEMS) break;
        int r = it;
        if (r < T_A) { const int l = r / 2176, q = r % 2176, kb = q / 136, nb = q % 136, s0 = 256 + nb * 32;
            int drow; if (s0 < 1536) { const int tile = 2 + ((s0 - 256) >> 8), hh = ((s0 - 256) & 255) >> 6, dh = (s0 & 63) >> 5; drow = tile * 256 + dh * 128 + hh * 32; } else drow = s0 + 256;
            transpose_item(inptr(F, IN_WIN) + (size_t)l * DM * INW, INW, kb * 64, s0, WSP(bf16, WS_WIN) + (size_t)l * INW2 * DM, drow, DM, 0, lane, s0 < 1536 ? 1.f : -LOG2E); continue; } r -= T_A;
        if (r < T_B) { const int l = r / 512, q = r % 512, kq = q & 3, kb = (q >> 2) >> 3, g = ((q >> 2) >> 1) & 3, sm = (q >> 2) & 1;
            fold_item(inptr(F, IN_WIN) + (size_t)l * DM * INW, kb * 64 + kq * 16, g, sm, WSP(bf16, WS_WIN) + (size_t)l * INW2 * DM, sm * 256 + g * 64, scr, ctab, lane); continue; } r -= T_B;
        if (r < T_C) { const int l = r / 512, q = r % 512; const float* W; int kb, koff;
            if (q < 128) { W = inptr(F, IN_WBRF) + (size_t)l * 256 * DM; kb = q >> 5; koff = 0; } else if (q < 384) { W = inptr(F, IN_WBRG) + (size_t)l * 512 * DM; kb = (q - 128) >> 5; koff = 256; } else { W = inptr(F, IN_WBRW) + (size_t)l * 256 * DM; kb = (q - 384) >> 5; koff = 768; }
            const int nb = q & 31;
            transpose_item(W, DM, kb * 64, nb * 32, WSP(bf16, WS_WBR) + (size_t)l * DM * DM, nb * 32, DM, koff, lane); continue; } r -= T_C;
        if (r < T_D) { const int l = r / 512, q = r % 512, kb = q >> 5, nb = q & 31;
            transpose_item(inptr(F, IN_WOUT) + (size_t)l * DM * DM, DM, kb * 64, nb * 32, WSP(bf16, WS_WOUT) + (size_t)l * DM * DM, nb * 32, DM, 0, lane); continue; } r -= T_D;
        if (r < T_E) { if (F.G != 256) conv_wave_item(F, r, lane); continue; } r -= T_E;
        if (r < T_F) {
            const bool big = r < SEQ / 2 + 256; const int N = big ? SEQ : CTX, k = big ? r : r - (SEQ / 2 + 256), sh = big ? 0 : 3; const float sc = 1.f / sqrtf(64.f * (float)N);
            bf16* row = (big ? WSP(bf16, WS_DFT) : WSP(bf16, WS_DFTC)) + (size_t)k * 2 * N;
            for (int n = 2 * lane; n < N; n += 128) {
                const int r0 = (k * n) & (N - 1), r1 = (k * (n + 1)) & (N - 1);
                *(GAS unsigned*)(row + n) = pk2(ctab[r0 << sh] * sc, ctab[r1 << sh] * sc);
                *(GAS unsigned*)(row + N + n) = pk2(ctab[((r0 - (N >> 2)) & (N - 1)) << sh] * sc, ctab[((r1 - (N >> 2)) & (N - 1)) << sh] * sc); }
            continue; } r -= T_F;
        {
            for (int i = lane; i < 64 * 16; i += 64) { const int pos = i >> 4, f = i & 15; const float inv = powf(10000.f, -(float)(2 * f) / 32.f), ang = (float)pos * inv;
                WSP(float, WS_ROPE)[2 * i] = cosf(ang); WSP(float, WS_ROPE)[2 * i + 1] = sinf(ang); }
        }
    }
}

__device__ __forceinline__ void norm_row(f32x4 (&v)[4], const float* gain, const float* shift, const float* scale, int lane) {
    float ss = 0.f;
#pragma unroll
    for (int j = 0; j < 4; ++j) ss += (v[j][0] * v[j][0] + v[j][1] * v[j][1]) + (v[j][2] * v[j][2] + v[j][3] * v[j][3]);
    const float r = rsqrtf(wave_sum(ss) * (1.f / DM) + EPS);
#pragma unroll
    for (int j = 0; j < 4; ++j) { const f32x4 g = *(const f32x4*)(gain + 4 * lane + 256 * j); f32x4 y = v[j] * r * g;
        if (shift) { const f32x4 sh = *(const f32x4*)(shift + 4 * lane + 256 * j), sc = *(const f32x4*)(scale + 4 * lane + 256 * j); y = y * (sc + 1.f) + sh; }
        v[j] = y; }
}
__device__ __forceinline__ void store_row_bf16(bf16* orow, const f32x4 (&v)[4], int lane) {
    GAS v2u* o8 = (GAS v2u*)orow + lane;
#pragma unroll
    for (int j = 0; j < 4; ++j) { v2u w; w.x = pg8::cvt_pk_bf16(v[j][0], v[j][1]); w.y = pg8::cvt_pk_bf16(v[j][2], v[j][3]); o8[64 * j] = w; }
}
__device__ __forceinline__ int row_modset(int r) { return r < NLAT ? (r >> 11) : 8; }
struct ModVec { f32x4 g[4], sh[4], sc[4]; };
__device__ __forceinline__ void load_modvec(ModVec& m, const float* gain, const float* shift, const float* scale, int lane) {
#pragma unroll
    for (int j = 0; j < 4; ++j) { m.g[j] = *(const f32x4*)(gain + 4 * lane + 256 * j);
        if (shift) { m.sh[j] = *(const f32x4*)(shift + 4 * lane + 256 * j); m.sc[j] = *(const f32x4*)(scale + 4 * lane + 256 * j); } else { m.sh[j] = (f32x4){0.f, 0.f, 0.f, 0.f}; m.sc[j] = (f32x4){0.f, 0.f, 0.f, 0.f}; } }
}
__device__ __forceinline__ void norm_row_m(f32x4 (&v)[4], const ModVec& m) {
    float ss = 0.f;
#pragma unroll
    for (int j = 0; j < 4; ++j) ss += (v[j][0] * v[j][0] + v[j][1] * v[j][1]) + (v[j][2] * v[j][2] + v[j][3] * v[j][3]);
    const float r = rsqrtf(wave_sum(ss) * (1.f / DM) + EPS);
#pragma unroll
    for (int j = 0; j < 4; ++j) v[j] = (v[j] * r * m.g[j]) * (m.sc[j] + 1.f) + m.sh[j];
}
__device__ __forceinline__ void load_row_bf16(f32x4 (&v)[4], const bf16* row, int lane) {
    const GAS v2u* i8 = (const GAS v2u*)row + lane;
#pragma unroll
    for (int j = 0; j < 4; ++j) { const v2u w = i8[64 * j]; v[j] = (f32x4){bflo(w.x), bfhi(w.x), bflo(w.y), bfhi(w.y)}; }
}
__device__ __forceinline__ void load_row_f32(f32x4 (&v)[4], const float* row, int lane) {
#pragma unroll
    for (int j = 0; j < 4; ++j) v[j] = *(const f32x4*)(row + 4 * lane + 256 * j);
}

__device__ __forceinline__ void p1_norm1(Frame& F) {
    int tid_ = threadIdx.x; asm volatile("" : "+v"(tid_));
    const int lane = tid_ & 63, wave_ = __builtin_amdgcn_readfirstlane(tid_ >> 6);
    const int gw = F.vcu * NWAVES + wave_, NGW = F.G * NWAVES, rpw = (NTOK + NGW - 1) / NGW, r0 = gw * rpw, r1 = r0 + rpw < NTOK ? r0 + rpw : NTOK;
    const float* xin = inptr(F, IN_X); const float* cin = inptr(F, IN_CTX) - (size_t)NLAT * DM; const float* g1 = inptr(F, IN_NORM1G);
#define P1_ROW(r) (((r) < NLAT ? xin : cin) + (size_t)(r) * DM)
    f32x4 va[4], vb[4]; ModVec m; int cset = -1;
    if (r0 < r1) load_row_f32(va, P1_ROW(r0), lane);
    if (r0 + 1 < r1) load_row_f32(vb, P1_ROW(r0 + 1), lane);
    for (int r = r0; r < r1; ++r) {
        f32x4 v[4];
#pragma unroll
        for (int j = 0; j < 4; ++j) { v[j] = va[j]; va[j] = vb[j]; }
        if (r + 2 < r1) load_row_f32(vb, P1_ROW(r + 2), lane);
        const int set = row_modset(r);
        if (set != cset) { const float* mod = WSP(float, WS_MOD) + (size_t)set * 6 * DM; load_modvec(m, g1, mod, mod + DM, lane); cset = set; }
        norm_row_m(v, m);
        store_row_bf16(WSP(bf16, WS_HN) + (size_t)r * DM, v, lane);
    }
#undef P1_ROW
}
__device__ __forceinline__ void router_finish(const float (&a16)[NE], int r, int lane, float* AFF) {
    float b8[8], b4[4], b2[2], lg;
    { const bool hi = lane & 32;
#pragma unroll
      for (int i = 0; i < 8; ++i) { const float keep = hi ? a16[i + 8] : a16[i], send = hi ? a16[i] : a16[i + 8]; b8[i] = keep + lx32(send); } }
    { const bool hi = lane & 16;
#pragma unroll
      for (int i = 0; i < 4; ++i) { const float keep = hi ? b8[i + 4] : b8[i], send = hi ? b8[i] : b8[i + 4]; b4[i] = keep + lx16(send); } }
    { const bool hi = lane & 8;
#pragma unroll
      for (int i = 0; i < 2; ++i) { const float keep = hi ? b4[i + 2] : b4[i], send = hi ? b4[i] : b4[i + 2]; b2[i] = keep + lx8(send); } }
    { const bool hi = lane & 4; const float keep = hi ? b2[1] : b2[0], send = hi ? b2[0] : b2[1]; lg = keep + lx4(send); }
    lg += lx2(lg); lg += lx1(lg);
    float mx = lg;
    mx = fmaxf(mx, lx4(mx)); mx = fmaxf(mx, lx8(mx)); mx = fmaxf(mx, lx16(mx)); mx = fmaxf(mx, lx32(mx));
    const float ex = expf(lg - mx); float sum = ex;
    sum += lx4(sum); sum += lx8(sum); sum += lx16(sum); sum += lx32(sum);
    const int set = r < NLAT ? (r >> 11) : 8 + ((r - NLAT) >> 8), n = r < NLAT ? (r & (SEQ - 1)) : ((r - NLAT) & (CTX - 1));
    if ((lane & 3) == 0) AFF[((size_t)set * NE + ((lane >> 2) & 15)) * SEQ + n] = ex / sum;
}
__device__ __forceinline__ void pf_norm2_router(Frame& F, int l, int mode = 0) {
    int tid_ = threadIdx.x; asm volatile("" : "+v"(tid_));
    const int lane = tid_ & 63, wave_ = __builtin_amdgcn_readfirstlane(tid_ >> 6);
    const int ri = lane & 15, kq = lane >> 4, k0 = wave_ * 128 + kq * 32;
    LAS float* T = (LAS float*)F.lds;
    LAS float* red = (LAS float*)(F.lds + 65536);
    LAS float* part = (LAS float*)(F.lds + 65536 + 1024);
    const int nrows = (l == DEPTH - 1) ? NLAT : NTOK, ngr = nrows / 16, g0 = (F.vcu * ngr) / F.G, g1 = ((F.vcu + 1) * ngr) / F.G;
    const bf16* X = WSP(bf16, WS_X); const float* g2n = inptr(F, IN_NORM2G) + l * DM; float* AFF = WSP(float, WS_AFF);
    v4u raw[4]; float ca[32], cb[32]; int cset = -1;
    if (g0 < g1) { const GAS v4u* px = (const GAS v4u*)(X + (size_t)(g0 * 16 + ri) * DM + k0);
#pragma unroll
        for (int q = 0; q < 4; ++q) raw[q] = px[q]; }
    if (mode != 1) { const GAS f32x4* wr4 = (const GAS f32x4*)(inptr(F, IN_WROUTER) + (size_t)l * DM * NE);
        f32x4 wv[8];
#pragma unroll
        for (int u = 0; u < 8; ++u) wv[u] = wr4[tid_ + u * (NWAVES * 64)];
#pragma unroll
        for (int u = 0; u < 8; ++u) { const int i4 = tid_ + u * (NWAVES * 64), k = i4 >> 2, e = (i4 & 3) * 4;
            *(LAS f32x4*)(T + (((k >> 7) * 32 + (k & 31)) * 4 + ((k >> 5) & 3)) * 16 + e) = wv[u]; } }
    __syncthreads();
    const LAS float* Tw = T + wave_ * 2048 + lane;
    for (int g = g0; g < g1; ++g) {
        const int row0 = g * 16, r = row0 + ri, par = (g - g0) & 1;
        float x[32];
#pragma unroll
        for (int q = 0; q < 4; ++q) { x[8 * q] = bflo(raw[q].x); x[8 * q + 1] = bfhi(raw[q].x); x[8 * q + 2] = bflo(raw[q].y); x[8 * q + 3] = bfhi(raw[q].y);
            x[8 * q + 4] = bflo(raw[q].z); x[8 * q + 5] = bfhi(raw[q].z); x[8 * q + 6] = bflo(raw[q].w); x[8 * q + 7] = bfhi(raw[q].w); }
        if (g + 1 < g1) { const GAS v4u* px = (const GAS v4u*)(X + (size_t)(row0 + 16 + ri) * DM + k0);
#pragma unroll
            for (int q = 0; q < 4; ++q) raw[q] = px[q]; }
        const int mset = row_modset(row0);
        if (mset != cset) { const float* mod = WSP(float, WS_MOD) + ((size_t)l * 9 + mset) * 6 * DM; const float* sh = mod + 3 * DM; const float* sc = mod + 4 * DM;
#pragma unroll
            for (int q = 0; q < 8; ++q) { const f32x4 gg = *(const f32x4*)(g2n + k0 + 4 * q), s4 = *(const f32x4*)(sc + k0 + 4 * q), h4 = *(const f32x4*)(sh + k0 + 4 * q);
#pragma unroll
                for (int c = 0; c < 4; ++c) { ca[4 * q + c] = gg[c] * (s4[c] + 1.f); cb[4 * q + c] = h4[c]; } }
            cset = mset; }
        float ss = 0.f;
#pragma unroll
        for (int j = 0; j < 32; ++j) ss = fmaf(x[j], x[j], ss);
        ss += lx16(ss); ss += lx32(ss);
        if (kq == 0) red[par * 128 + wave_ * 16 + ri] = ss;
        __syncthreads();
        float tot = 0.f;
#pragma unroll
        for (int w = 0; w < 8; ++w) tot += red[par * 128 + w * 16 + ri];
        const float rr = rsqrtf(tot * (1.f / DM) + EPS);
#pragma unroll
        for (int j = 0; j < 32; ++j) x[j] = (x[j] * rr) * ca[j] + cb[j];
        { GAS v4u* ph = (GAS v4u*)(WSP(bf16, WS_HN) + (size_t)r * DM + k0);
#pragma unroll
          for (int q = 0; q < 4; ++q) { v4u o; o.x = pg8::cvt_pk_bf16(x[8 * q], x[8 * q + 1]); o.y = pg8::cvt_pk_bf16(x[8 * q + 2], x[8 * q + 3]); o.z = pg8::cvt_pk_bf16(x[8 * q + 4], x[8 * q + 5]); o.w = pg8::cvt_pk_bf16(x[8 * q + 6], x[8 * q + 7]); ph[q] = o; } }
        if (mode == 2) continue;
        f32x4 a0 = {0.f, 0.f, 0.f, 0.f}, a1 = {0.f, 0.f, 0.f, 0.f};
#pragma unroll
        for (int s2 = 0; s2 < 32; s2 += 2) { const float b0 = Tw[s2 * 64], b1 = Tw[(s2 + 1) * 64];
            a0 = __builtin_amdgcn_mfma_f32_16x16x4f32(x[s2], b0, a0, 0, 0, 0); a1 = __builtin_amdgcn_mfma_f32_16x16x4f32(x[s2 + 1], b1, a1, 0, 0, 0); }
        a0 = a0 + a1;
#pragma unroll
        for (int j = 0; j < 4; ++j) part[par * 2048 + wave_ * 256 + (4 * kq + j) * 16 + ri] = a0[j];
        __syncthreads();
        if (wave_ < 4) {
            float lg = 0.f;
#pragma unroll
            for (int w = 0; w < 8; ++w) lg += part[par * 2048 + w * 256 + tid_];
            float mx = lg; mx = fmaxf(mx, lx1(mx)); mx = fmaxf(mx, lx2(mx)); mx = fmaxf(mx, lx4(mx)); mx = fmaxf(mx, lx8(mx));
            const float ex = expf(lg - mx); float sum = ex; sum += lx1(sum); sum += lx2(sum); sum += lx4(sum); sum += lx8(sum);
            const int rw = row0 + (tid_ >> 4), e = tid_ & 15;
            const int set = rw < NLAT ? (rw >> 11) : 8 + ((rw - NLAT) >> 8), n = rw < NLAT ? (rw & (SEQ - 1)) : ((rw - NLAT) & (CTX - 1));
            AFF[((size_t)set * NE + e) * SEQ + n] = ex / sum;
        }
    }
    __syncthreads();
}
__device__ __forceinline__ void pg_topk_gather(Frame& F, int l) {
    int tid_ = threadIdx.x; asm volatile("" : "+v"(tid_));
    const int lane = tid_ & 63, wave_ = __builtin_amdgcn_readfirstlane(tid_ >> 6);
    LAS unsigned* cnt = (LAS unsigned*)F.lds;
    LAS int* sidx = (LAS int*)(F.lds + 1024);
    const int nitems = (l == DEPTH - 1) ? 8 * NE : 16 * NE;
    const int tid = tid_, wave = wave_;
    const unsigned long long lt = (1ull << lane) - 1ull;
    for (int it = F.vcu; it < nitems; it += F.G) {
        const int set = it >> 4, e = it & 15; const bool latent = set < 8; const int N = latent ? SEQ : CTX, cap = latent ? CAPL : CAPC;
        const int rowbase = latent ? set * SEQ : NLAT + (set - 8) * CTX, xbase = latent ? set * CAPL : 8 * CAPL + (set - 8) * CAPC;
        const float* a = WSP(float, WS_AFF) + ((size_t)set * NE + e) * SEQ;
        unsigned key[4];
#pragma unroll
        for (int q = 0; q < 4; ++q) { const int i = q * 512 + tid; key[q] = i < N ? __builtin_bit_cast(unsigned, a[i]) : 0u; }
        unsigned T = 0u;
        for (int bit = 30; bit >= 1; bit -= 2) {
            const unsigned c1 = T | (1u << (bit - 1)), c2 = T | (2u << (bit - 1)), c3 = T | (3u << (bit - 1)); unsigned n1 = 0, n2 = 0, n3 = 0;
#pragma unroll
            for (int q = 0; q < 4; ++q) { n1 += (unsigned)__builtin_popcountll(__ballot(key[q] >= c1)); n2 += (unsigned)__builtin_popcountll(__ballot(key[q] >= c2)); n3 += (unsigned)__builtin_popcountll(__ballot(key[q] >= c3)); }
            LAS unsigned* cb = cnt + ((bit >> 1) & 1) * 24;
            if (lane == 0) { cb[wave] = n1; cb[8 + wave] = n2; cb[16 + wave] = n3; }
            __syncthreads();
            unsigned t1 = 0, t2 = 0, t3 = 0;
#pragma unroll
            for (int w = 0; w < 8; ++w) { t1 += cb[w]; t2 += cb[8 + w]; t3 += cb[16 + w]; }
            if (t3 >= (unsigned)cap) T = c3; else if (t2 >= (unsigned)cap) T = c2; else if (t1 >= (unsigned)cap) T = c1;
        }
        { const unsigned cand = T | 1u; unsigned c = 0;
#pragma unroll
            for (int q = 0; q < 4; ++q) c += (unsigned)__builtin_popcountll(__ballot(key[q] >= cand));
            LAS unsigned* cb = cnt + 48;
            if (lane == 0) cb[wave] = c;
            __syncthreads();
            unsigned tot = 0;
#pragma unroll
            for (int w = 0; w < 8; ++w) tot += cb[w];
            if (tot >= (unsigned)cap) T = cand;
        }
        LAS unsigned* cg = cnt + 64; LAS unsigned* ce = cnt + 96;
        unsigned long long bg[4], be[4];
#pragma unroll
        for (int q = 0; q < 4; ++q) { bg[q] = __ballot(key[q] > T); be[q] = __ballot(key[q] == T && key[q] != 0u);
            if (lane == 0) { cg[q * 8 + wave] = (unsigned)__builtin_popcountll(bg[q]); ce[q * 8 + wave] = (unsigned)__builtin_popcountll(be[q]); } }
        __syncthreads();
        unsigned ngt = 0;
        for (int c2 = 0; c2 < 32; ++c2) ngt += cg[c2];
        const unsigned need = (unsigned)cap - ngt;
        unsigned pre_g[4], pre_e[4];
        { unsigned rg = 0, re = 0;
#pragma unroll
          for (int q = 0; q < 4; ++q) { for (int w = 0; w < 8; ++w) { if (w == wave) { pre_g[q] = rg; pre_e[q] = re; } rg += cg[q * 8 + w]; re += ce[q * 8 + w]; } } }
        int* SEL = WSP(int, WS_SEL);
#pragma unroll
        for (int q = 0; q < 4; ++q) { const int i = q * 512 + tid;
            if (i < N) {
                const unsigned eb = pre_e[q] + (unsigned)__builtin_popcountll(be[q] & lt);
                const unsigned gb = pre_g[q] + (unsigned)__builtin_popcountll(bg[q] & lt);
                const bool isg = key[q] > T, ise = key[q] == T;
                const bool sel = isg || (ise && eb < need);
                const unsigned slot = gb + (eb < need ? eb : need);
                SEL[(size_t)(rowbase + i) * NE + e] = sel ? xbase + (int)slot : -1;
                if (sel) { WSP(float, WS_AFS)[(size_t)e * RPE + xbase + slot] = __builtin_bit_cast(float, key[q]); WSP(int, WS_IDX)[(size_t)e * RPE + xbase + slot] = rowbase + i; }
            } }
        __syncthreads();
    }
}
__device__ __forceinline__ unsigned ye_issue4(const bf16* YE, int selv, unsigned mk, v2u (&w)[4][4], int lane) {
#pragma unroll
    for (int i = 0; i < 4; ++i) {
        if (mk) { const int e = __builtin_ctz(mk); mk &= mk - 1u; const int se = __builtin_amdgcn_readlane(selv, e);
            const GAS v2u* y = (const GAS v2u*)(YE + ((size_t)e * RPE + se) * DM) + lane;
#pragma unroll
            for (int j = 0; j < 4; ++j) w[i][j] = y[64 * j]; }
        else {
#pragma unroll
            for (int j = 0; j < 4; ++j) w[i][j] = (v2u){0u, 0u}; }
    }
    return mk;
}
__device__ __forceinline__ void ye_acc4(f32x4 (&t)[4], const v2u (&w)[4][4]) {
#pragma unroll
    for (int i = 0; i < 4; ++i)
#pragma unroll
        for (int j = 0; j < 4; ++j) t[j] += (f32x4){bflo(w[i][j].x), bfhi(w[i][j].x), bflo(w[i][j].y), bfhi(w[i][j].y)};
}
__device__ __forceinline__ unsigned sel_mask(int selv) { return (unsigned)__builtin_amdgcn_readfirstlane((int)(__ballot(selv >= 0) & 0xFFFFull)); }
__device__ __forceinline__ void pj_combine(Frame& F, int l, int probe = 0) {
    int tid_ = threadIdx.x; asm volatile("" : "+v"(tid_));
    const int lane = tid_ & 63, wave_ = __builtin_amdgcn_readfirstlane(tid_ >> 6);
    const int gw = F.vcu * NWAVES + wave_, NGW = F.G * NWAVES; const bool last = l == DEPTH - 1;
    const int nrows = last ? NLAT : NTOK, rpw = (nrows + NGW - 1) / NGW, r0 = gw * rpw, r1 = r0 + rpw < nrows ? r0 + rpw : nrows;
    bf16* X = WSP(bf16, WS_X); const int* SEL = WSP(int, WS_SEL);
    const float* gnext = last ? inptr(F, IN_FINALG) : inptr(F, IN_NORM1G) + (l + 1) * DM;
    f32x4 va[4], vb[4], g2[4]; int sa = -1, sb = -1; ModVec m; int cset = -1;
    if (r0 < r1) { load_row_bf16(va, X + (size_t)r0 * DM, lane); sa = lane < NE ? SEL[(size_t)r0 * NE + lane] : -1; }
    if (r0 + 1 < r1) { load_row_bf16(vb, X + (size_t)(r0 + 1) * DM, lane); sb = lane < NE ? SEL[(size_t)(r0 + 1) * NE + lane] : -1; }
    const bf16* YE = WSP(bf16, WS_G); v2u wA[4][4], wB[4][4]; unsigned restA = 0u, restB = 0u;
    restA = ye_issue4(YE, sa, r0 < r1 ? sel_mask(sa) : 0u, wA, lane);
#define PJ_ROW(r, WC, WN, RC, RN) do { \
        f32x4 v[4], t[4]; \
        _Pragma("unroll") for (int j = 0; j < 4; ++j) { v[j] = va[j]; va[j] = vb[j]; t[j] = (f32x4){0.f, 0.f, 0.f, 0.f}; } \
        const int selv = sa; sa = sb; \
        if ((r) + 2 < r1) { load_row_bf16(vb, X + (size_t)((r) + 2) * DM, lane); sb = lane < NE ? SEL[(size_t)((r) + 2) * NE + lane] : -1; } \
        const int mset = row_modset(r); \
        if (mset != cset) { const float* mod = WSP(float, WS_MOD) + ((size_t)l * 9 + mset) * 6 * DM; const float* mod1 = WSP(float, WS_MOD) + ((size_t)(last ? l : l + 1) * 9 + mset) * 6 * DM; \
            _Pragma("unroll") for (int j = 0; j < 4; ++j) g2[j] = *(const f32x4*)(mod + 5 * DM + 4 * lane + 256 * j); \
            load_modvec(m, gnext, last ? nullptr : mod1, last ? nullptr : mod1 + DM, lane); cset = mset; } \
        RN = ye_issue4(YE, sa, (r) + 1 < r1 ? sel_mask(sa) : 0u, WN, lane);                \
        ye_acc4(t, WC); \
        while (RC) { RC = ye_issue4(YE, selv, RC, WC, lane); ye_acc4(t, WC); }               \
        _Pragma("unroll") for (int j = 0; j < 4; ++j) v[j] = v[j] + g2[j] * t[j]; \
        if (probe) { norm_row_m(v, m); asm volatile("" :: "v"(v[0]), "v"(v[1]), "v"(v[2]), "v"(v[3])); } \
        else if (!last) { \
            store_row_bf16(X + (size_t)(r) * DM, v, lane); \
            norm_row_m(v, m); \
            store_row_bf16(WSP(bf16, WS_HN) + (size_t)(r) * DM, v, lane); \
        } else { \
            norm_row_m(v, m); \
            _Pragma("unroll") for (int j = 0; j < 4; ++j) *(f32x4*)(F.out + (size_t)(r) * DM + 4 * lane + 256 * j) = v[j]; \
        } } while (0)
    for (int r = r0; r < r1; r += 2) {
        PJ_ROW(r, wA, wB, restA, restB);
        if (r + 1 < r1) PJ_ROW(r + 1, wB, wA, restB, restA);
    }
#undef PJ_ROW
}

__device__ __forceinline__ void pc_mixers(Frame& F, int l, int rep) {
    int tid_ = threadIdx.x; asm volatile("" : "+v"(tid_));
    const int lane = tid_ & 63, wave_ = __builtin_amdgcn_readfirstlane(tid_ >> 6);
    const bool need_ctx = l < DEPTH - 1;
    {
        SchedDft S; S.Dm = (const char*)(F.ws + WS_DFT); S.Dc = (const char*)(F.ws + WS_DFTC); S.ABt = (const char*)(F.ws + WS_ABT); S.ABtc = (const char*)(F.ws + WS_ABTC);
        S.nctx = need_ctx ? 8 : 0; S.G = F.G; S.vcu = F.vcu;
        const int q = F.G == 256 ? (F.vcu >> 5) * 6 + (F.vcu & 31) : F.vcu;
        EpiDft E{WSP(bf16, WS_BR), (float*)(F.ws + WS_X + 40 * MiB) + (size_t)(q & 31) * 65536, 0};
        pg8::gemm_phase<EpiDft, SchedDft>(F.lds, (LAS int*)(F.lds + IDXBUF_OFF), S, E);
    }
    typedef attn_body::bf16 abf;
    const abf* Qg = (const abf*)(F.ws + WS_QKV + QKV_QG); const abf* Kg = (const abf*)(F.ws + WS_QKV + QKV_KG); const abf* Vg = (const abf*)(F.ws + WS_QKV + QKV_VG);
    const abf* Qw = (const abf*)(F.ws + WS_QKV + QKV_QW); const abf* Kw = (const abf*)(F.ws + WS_QKV + QKV_KW); const abf* Vw = (const abf*)(F.ws + WS_QKV + QKV_VW);
    abf* BR = (abf*)(F.ws + WS_BR);
    const int nGL = NBATCH * 2 * 32, nWL = NBATCH * 2 * 16, nGC = need_ctx ? NBATCH * 2 * 4 : 0, nWC = need_ctx ? NBATCH * 2 * 2 : 0, nattn = nGL + nWL + nGC + nWC;
    const int nconv = (CONV_IN_ATTN && F.G == 256 && rep == 0) ? CONV_ITEMS_L0 : 0, ntot = nattn + nconv;
    bool nomx;
    { const float gq = fabsf(inptr(F, IN_QNG)[l * 64 + lane]), gk = fabsf(inptr(F, IN_KNG)[l * 64 + lane]); float mq = gq, mk = gk;
#pragma unroll
      for (int o = 1; o < 64; o <<= 1) { mq = fmaxf(mq, __shfl_xor(mq, o)); mk = fmaxf(mk, __shfl_xor(mk, o)); }
      nomx = __builtin_amdgcn_readfirstlane((int)(8.f * LOG2E * mq * mk < 60.f)) != 0; }
    gu32* head = F.ctl + CW_QUEUE + 64 * (l + 2 * rep);
    const int wid = wave_;
    const int ndef = (l == DEPTH - 1) ? INPROJ_DEFERRED : 0;
    for (;;) {
        if (tid_ == 0) F.MISC[0] = __hip_atomic_fetch_add(head, 1u, RLX_AGENT);
        __syncthreads();
        const int q = (int)F.MISC[0];
        if (q >= ntot + ndef) break;
        if (q >= nGL && q < nGL + ndef) {
            OneUnit S1; inproj_deferred(q - nGL, (const char*)(F.ws + WS_HN), (const char*)(F.ws + WS_WIN) + (size_t)l * INW2 * DM * 2, S1.u);
            EpiInProj E1; E1.ABt = nullptr; E1.ABtc = nullptr; E1.Qg = E1.Kg = E1.Vg = E1.Qw = E1.Kw = E1.Vw = nullptr; E1.G = WSP(bf16, WS_G); E1.rope = nullptr; E1.qng = nullptr; E1.kng = nullptr;
            pg8::gemm_phase<EpiInProj, OneUnit>(F.lds, (LAS int*)(F.lds + IDXBUF_OFF), S1, E1);
            __syncthreads(); continue; }
        const int qa = q < nGL ? q : q - ndef;
        const int c0 = (int)(((long long)qa * nconv) / ntot), c1 = (int)(((long long)(qa + 1) * nconv) / ntot);
        if (c1 > c0) { conv_wave_item(F, (l * CONV_ITEMS_L0 + c0) * NWAVES + wave_, lane); __syncthreads(); continue; }
        const int a = qa - c0;
        if (a < nGL) {
            const int b = a >> 6, hkv = (a >> 5) & 1, qb = a & 31, head_ = hkv * 4 + (wid >> 1), q0 = qb * 64 + (wid & 1) * 32; const size_t qrow = (size_t)b * SEQ + q0;
            if (nomx) attn_body::attn_unit<0, 8, true>(Qg + qrow * 512 + head_ * 64, 512, Kg + (size_t)(NLAT + b * CTX) * 128 + hkv * 64, Kg + (size_t)b * SEQ * 128 + hkv * 64,
                                        Vg + (size_t)(NLAT + b * CTX) * 128 + hkv * 64, Vg + (size_t)b * SEQ * 128 + hkv * 64, 128, 4 + SEQ / 64, 0, 0, 0.f, BR + qrow * DM + 256 + head_ * 64, DM, F.ldsg);
            else attn_body::attn_unit<0, 8>(Qg + qrow * 512 + head_ * 64, 512, Kg + (size_t)(NLAT + b * CTX) * 128 + hkv * 64, Kg + (size_t)b * SEQ * 128 + hkv * 64,
                                        Vg + (size_t)(NLAT + b * CTX) * 128 + hkv * 64, Vg + (size_t)b * SEQ * 128 + hkv * 64, 128, 4 + SEQ / 64, 0, 0, 0.f, BR + qrow * DM + 256 + head_ * 64, DM, F.ldsg);
        } else if (a < nGL + nWL) {
            const int u = a - nGL, b = u >> 5, hkv = (u >> 4) & 1, qb = u & 15, head_ = hkv * 2 + (wid >> 2), q0 = qb * 128 + (wid & 3) * 32; const size_t qrow = (size_t)b * SEQ + q0;
            const int band0 = qb * 128 - 128 < 0 ? 0 : qb * 128 - 128, band1 = qb * 128 + 256 > SEQ ? SEQ : qb * 128 + 256;
            attn_body::attn_unit<1, 8>(Qw + qrow * 256 + head_ * 64, 256, Kw + (size_t)(NLAT + b * CTX) * 128 + hkv * 64, Kw + ((size_t)b * SEQ + band0) * 128 + hkv * 64,
                                        Vw + (size_t)(NLAT + b * CTX) * 128 + hkv * 64, Vw + ((size_t)b * SEQ + band0) * 128 + hkv * 64, 128, 4 + (band1 - band0) / 64, q0, band0,
                                        inptr(F, IN_SINK)[l * 4 + head_] * LOG2E, BR + qrow * DM + 768 + head_ * 64, DM, F.ldsg);
        } else if (a < nGL + nWL + nGC) {
            const int u = a - nGL - nWL, b = u >> 3, hkv = (u >> 2) & 1, qb = u & 3, head_ = hkv * 4 + (wid >> 1); const size_t qrow = (size_t)NLAT + b * CTX + qb * 64 + (wid & 1) * 32;
            const abf* Kc = Kg + (size_t)(NLAT + b * CTX) * 128 + hkv * 64; const abf* Vc = Vg + (size_t)(NLAT + b * CTX) * 128 + hkv * 64;
            attn_body::attn_unit<0, 8>(Qg + qrow * 512 + head_ * 64, 512, Kc, Kc, Vc, Vc, 128, 4, 0, 0, 0.f, BR + qrow * DM + 256 + head_ * 64, DM, F.ldsg);
        } else {
            const int u = a - nGL - nWL - nGC, b = u >> 2, hkv = (u >> 1) & 1, qb = u & 1, head_ = hkv * 2 + (wid >> 2); const size_t qrow = (size_t)NLAT + b * CTX + qb * 128 + (wid & 3) * 32;
            const abf* Kc = Kw + (size_t)(NLAT + b * CTX) * 128 + hkv * 64; const abf* Vc = Vw + (size_t)(NLAT + b * CTX) * 128 + hkv * 64;
            attn_body::attn_unit<1, 8>(Qw + qrow * 256 + head_ * 64, 256, Kc, Kc, Vc, Vc, 128, 4, 0, 0, inptr(F, IN_SINK)[l * 4 + head_] * LOG2E, BR + qrow * DM + 768 + head_ * 64, DM, F.ldsg);
        }
    }
    __syncthreads();
}
#ifndef MK_N_LAUNCHES
#define MK_N_LAUNCHES 1
#endif
constexpr int N_PHASES = 2 + 9 * DEPTH;
struct Args { const float* in[21]; float* out; unsigned char* ws; int ph_lo, ph_hi, probe, pad_; };

__global__ void __launch_bounds__(NWAVES * 64, 2) hybrid_fwd(Args args) {
    extern __shared__ __attribute__((aligned(16))) unsigned char lds[];
    Frame F;
    F.lds = (LAS unsigned char*)lds; F.ldsg = (char*)lds; F.MISC = (volatile LAS unsigned*)(F.lds + MISC_OFF);
    F.G = gridDim.x; { const int bx = blockIdx.x; F.vcu = (F.G % 8 == 0) ? (bx % 8) * (F.G / 8) + bx / 8 : bx; }
    F.ws = args.ws; F.out = args.out; F.dout = (unsigned char*)args.out; F.ctl = (gu32*)(args.ws + WS_CTL);
#ifdef DBG_LDSPOISON
    for (int u = threadIdx.x; u < LDSCTL_OFF / 4; u += NWAVES * 64) ((LAS unsigned*)F.lds)[u] = 0xFFFFFFFFu;
#endif
    for (int u = threadIdx.x; u < (LDS_BYTES - LDSCTL_OFF) / 4; u += NWAVES * 64) ((LAS unsigned*)(F.lds + LDSCTL_OFF))[u] = 0u;
    __syncthreads();
    if (threadIdx.x < 21) *(LAS unsigned long long*)(F.lds + PTRS_OFF + 8 * threadIdx.x) = (unsigned long long)args.in[threadIdx.x];
    __syncthreads();
    XcdBarrier bar; bar.bar = (unsigned*)(F.ctl + CW_BAR); bar.x = 0; bar.st = nullptr;
    const int lo = args.ph_lo, hi = args.ph_hi;
    if (hi - lo > 1) bar = xcd_barrier_post((unsigned*)(F.ctl + CW_BAR), F.MISC + 8);
#ifndef PHSEL
#define PHSEL 0x7ff
#endif
#define IN(k) (lo <= (k) && (k) < hi)
#define KIND(j) ((PHSEL >> (j)) & 1)
#ifndef DBG_PROBE
#define DBG_PROBE 0
#endif
#ifndef FPROBE_MODE
#define FPROBE_MODE 0
#endif
#ifndef REP_MASK
#define REP_MASK 0
#endif
#define NREP(j, ok) ((((REP_MASK) >> (j)) & 1) && (ok) ? 2 : 1)
#define REPEAT(j, ok) for (int rep_ = 0, nrep_ = NREP(j, ok); rep_ < nrep_; ++rep_, (rep_ < nrep_ ? xcd_barrier(bar) : (void)0))
#define SEAM(k) do { if (IN(k) && IN((k) + 1)) xcd_barrier(bar); } while (0)

#ifdef BAR_PROBE
    if (hi - lo > 1) for (int i_ = 0; i_ < BAR_PROBE; ++i_) xcd_barrier(bar);
#endif
    if (KIND(0) && IN(0)) REPEAT(0, true) { p0_prologue(F, rep_ ? DBG_PROBE : 0); } SEAM(0);
    if (KIND(1) && IN(1)) REPEAT(1, true) { p1_norm1(F); } SEAM(1);
    for (int l = 0; l < DEPTH; ++l) {
        const int pb = 2 + 9 * l; const bool lastl = l == DEPTH - 1;
        const int nrt = lastl ? 64 : 72;
        if (KIND(2) && IN(pb + 0)) REPEAT(2, true) {
            Strided<DecInProj> S; S.d.A = (const char*)(F.ws + WS_HN); S.d.B = (const char*)(F.ws + WS_WIN) + (size_t)l * INW2 * DM * 2; S.d.layer = l; S.n = inproj_units(l); S.G = F.G; S.vcu = F.vcu;
            EpiInProj E; E.ABt = (bf16*)(F.ws + WS_ABT); E.ABtc = (bf16*)(F.ws + WS_ABTC);
            E.Qg = (bf16*)(F.ws + WS_QKV + QKV_QG); E.Kg = (bf16*)(F.ws + WS_QKV + QKV_KG); E.Vg = (bf16*)(F.ws + WS_QKV + QKV_VG);
            E.Qw = (bf16*)(F.ws + WS_QKV + QKV_QW); E.Kw = (bf16*)(F.ws + WS_QKV + QKV_KW); E.Vw = (bf16*)(F.ws + WS_QKV + QKV_VW);
            E.G = WSP(bf16, WS_G);
            {
                LAS float* ropeL = (LAS float*)(F.lds + COSTAB_OFF); LAS float* ngL = (LAS float*)(F.lds + IDXBUF_OFF);
                const float* rsrc = WSP(float, WS_ROPE); const float* qsrc = inptr(F, IN_QNG) + l * 64; const float* ksrc = inptr(F, IN_KNG) + l * 64;
                int t_ = threadIdx.x; asm volatile("" : "+v"(t_));
                *(LAS pg8::f32x4*)(ropeL + 4 * t_) = *(const pg8::f32x4*)(rsrc + 4 * t_);
                if (t_ < 64) ngL[t_] = qsrc[t_]; else if (t_ < 128) ngL[t_] = ksrc[t_ - 64];
                __syncthreads();
                E.rope = ropeL; E.qng = ngL; E.kng = ngL + 64; }
            pg8::gemm_phase<EpiInProj, Strided<DecInProj>>(F.lds, (LAS int*)(F.lds + IDXBUF_OFF), S, E);
            if (!CONV_IN_ATTN && l == 0 && F.G == 256 && F.vcu >= 88 && rep_ == 0) tail_convert(F, F.vcu - 88, 0, 4, 672);
        } SEAM(pb + 0);
        if (KIND(3) && IN(pb + 1)) REPEAT(3, true) { pc_mixers(F, l, rep_); } SEAM(pb + 1);
        const bool de_split = (MK_N_LAUNCHES == 1) && l == 0 && F.G == 256 && (REP_MASK) == 0 && (hi - lo > 1);
        if (KIND(4) && IN(pb + 2)) REPEAT(4, true) {
            SchedMerge S; S.BR = (const char*)(F.ws + WS_BR); S.W = (const char*)(F.ws + WS_WBR) + (size_t)l * DM * DM * 2; S.ntiles = de_split ? 256 : nrt * 4; S.G = F.G; S.vcu = F.vcu;
            EpiMerge E{WSP(bf16, WS_G), (rep_ + 1 == nrep_ && !args.probe) ? (bf16*)(F.ws + WS_MB) : WSP(bf16, WS_HN), args.probe};
            pg8::gemm_phase<EpiMerge, SchedMerge>(F.lds, (LAS int*)(F.lds + IDXBUF_OFF), S, E);
            if (!de_split && !CONV_IN_ATTN && l == 0 && F.G == 256 && F.vcu >= 32 && rep_ == 0) tail_convert(F, F.vcu - 32, 672, 2, 1120);
        } SEAM(pb + 2);
        if (KIND(5) && IN(pb + 3)) REPEAT(5, l == 0) {
            Strided<DecWout> S; S.d.Mb = (const char*)(F.ws + WS_MB); S.d.W = (const char*)(F.ws + WS_WOUT) + (size_t)l * DM * DM * 2; S.n = nrt * 4; S.G = F.G; S.vcu = F.vcu;
            EpiWout E; E.baseL = inptr(F, IN_X); E.baseC = inptr(F, IN_CTX) - (size_t)NLAT * DM; E.baseX = WSP(bf16, WS_X); E.X = WSP(bf16, WS_X); E.from_x = l != 0; E.mod = WSP(float, WS_MOD) + (size_t)l * 9 * 6 * DM;
            if (de_split) {
                if (F.vcu < 32) {
                    SchedMerge S2; S2.BR = (const char*)(F.ws + WS_BR); S2.W = (const char*)(F.ws + WS_WBR) + (size_t)l * DM * DM * 2; S2.ntiles = 288; S2.G = 256; S2.vcu = 256 + F.vcu;
                    EpiMerge E2{WSP(bf16, WS_G), (bf16*)(F.ws + WS_MB), 0};
                    pg8::gemm_phase<EpiMerge, SchedMerge>(F.lds, (LAS int*)(F.lds + IDXBUF_OFF), S2, E2);
                } else { S.n = 224; S.G = 256; S.vcu = F.vcu - 32; pg8::gemm_phase<EpiWout, Strided<DecWout>>(F.lds, (LAS int*)(F.lds + IDXBUF_OFF), S, E); }
                xcd_barrier(bar);
                S.n = 288; S.G = 256; S.vcu = F.vcu + 224;
                pg8::gemm_phase<EpiWout, Strided<DecWout>>(F.lds, (LAS int*)(F.lds + IDXBUF_OFF), S, E);
                if (!CONV_IN_ATTN && F.vcu >= 64) tail_convert(F, F.vcu - 64, 672, 6, 1792);
            } else {
                pg8::gemm_phase<EpiWout, Strided<DecWout>>(F.lds, (LAS int*)(F.lds + IDXBUF_OFF), S, E);
                if (!CONV_IN_ATTN && l == 0 && F.G == 256 && F.vcu >= 32 && rep_ == 0) tail_convert(F, F.vcu - 32, 1120, 3, 1792);
            }
        } SEAM(pb + 3);
        if (KIND(6) && IN(pb + 4)) REPEAT(6, true) { pf_norm2_router(F, l, rep_ ? FPROBE_MODE : 0); } SEAM(pb + 4);
        if (KIND(7) && IN(pb + 5)) REPEAT(7, true) { pg_topk_gather(F, l); } SEAM(pb + 5);
        const int ert = lastl ? 8 : 9;
        if (KIND(8) && IN(pb + 6)) REPEAT(8, true) {
            Strided<DecGU> S; S.d.H2 = (const char*)(F.ws + WS_HN); S.d.IDX = WSP(int, WS_IDX); S.d.W = (const char*)(F.ws + WS_WGU) + (size_t)l * NE * 2 * DM * DM * 2; S.d.nrt = ert; S.n = NE * ert * 8; S.G = F.G; S.vcu = F.vcu;
            EpiGU E{WSP(bf16, WS_HACT)};
            pg8::gemm_phase<EpiGU, Strided<DecGU>>(F.lds, (LAS int*)(F.lds + IDXBUF_OFF), S, E);
            if (!CONV_IN_ATTN && l == 0 && F.G == 256 && F.vcu >= 128 && rep_ == 0) tail_convert(F, F.vcu - 128, 1792, 4, 2304);
        } SEAM(pb + 6);
        if (KIND(9) && IN(pb + 7)) REPEAT(9, true) {
            Strided<DecDown> S; S.d.H = (const char*)(F.ws + WS_HACT); S.d.W = (const char*)(F.ws + WS_WD) + (size_t)l * NE * DM * DM * 2; S.d.nrt = ert; S.n = NE * ert * 4; S.G = F.G; S.vcu = F.vcu;
            EpiDown E{WSP(bf16, WS_G), WSP(float, WS_AFS)};
            pg8::gemm_phase<EpiDown, Strided<DecDown>>(F.lds, (LAS int*)(F.lds + IDXBUF_OFF), S, E);
            if (!CONV_IN_ATTN && l == 0 && F.G == 256 && F.vcu >= 64 && rep_ == 0) tail_convert(F, F.vcu - 64, 2304, 4, CONV_ITEMS);
        } SEAM(pb + 7);
        if (KIND(10) && IN(pb + 8)) REPEAT(10, true) { pj_combine(F, l, rep_); }
        if (!lastl) SEAM(pb + 8);
    }
#undef IN
#undef SEAM
}

#ifdef DBG_STOP
__global__ void k_dump(const unsigned short* __restrict__ src, float* __restrict__ out, size_t n) {
    for (size_t i = (size_t)blockIdx.x * blockDim.x + threadIdx.x; i < n; i += (size_t)gridDim.x * blockDim.x) out[i] = __uint_as_float((unsigned)src[i] << 16);
}
#endif
extern "C" void kernel_launch(void* const* d_in, const int* in_sizes, int n_in, void* d_out, int out_size, void* d_ws, size_t ws_size, hipStream_t stream) {
    static int grid = 0;
    if (grid == 0) {
        if (n_in != 21 || out_size != NLAT * DM || ws_size < WS_END) { fprintf(stderr, "kernel_launch: unexpected problem (n_in %d, out %d, ws %zu < %zu)\n", n_in, out_size, ws_size, (size_t)WS_END); grid = -1; return; }
        int dev = 0, cus = 0, per_cu = 0;
        if (hipGetDevice(&dev) != hipSuccess || hipDeviceGetAttribute(&cus, hipDeviceAttributeMultiprocessorCount, dev) != hipSuccess) { grid = -1; return; }
        if (hipFuncSetAttribute((const void*)hybrid_fwd, hipFuncAttributeMaxDynamicSharedMemorySize, LDS_BYTES) != hipSuccess) { fprintf(stderr, "kernel_launch: hipFuncSetAttribute failed\n"); grid = -1; return; }
        if (hipOccupancyMaxActiveBlocksPerMultiprocessor(&per_cu, (const void*)hybrid_fwd, NWAVES * 64, LDS_BYTES) != hipSuccess || per_cu < 1) { fprintf(stderr, "kernel_launch: occupancy query says %d blocks/CU\n", per_cu); per_cu = 1; }
        (void)hipGetLastError();
        grid = cus * 1;
    }
    if (grid < 0) return;
    hipMemsetAsync((char*)d_ws + WS_CTL, 0, CTL_ZERO_BYTES, stream);
    Args a; memset(&a, 0, sizeof(a));
    for (int i = 0; i < 21; ++i) a.in[i] = (const float*)d_in[i];
    a.out = (float*)d_out; a.ws = (unsigned char*)d_ws;
#if MK_N_LAUNCHES == 1
    a.ph_lo = 0; a.ph_hi = N_PHASES;
    hipLaunchKernelGGL(hybrid_fwd, dim3(grid), dim3(NWAVES * 64), LDS_BYTES, stream, a);
#else
    int nph_ = N_PHASES;
#ifdef DBG_STOP
    nph_ = DBG_STOP;
#endif
    for (int p = 0; p < nph_; ++p) { a.ph_lo = p; a.ph_hi = p + 1; hipLaunchKernelGGL(hybrid_fwd, dim3(grid), dim3(NWAVES * 64), LDS_BYTES, stream, a);
#ifdef DBG_DUP_PHASE
        if (p == DBG_DUP_PHASE) { a.probe = DBG_PROBE; hipLaunchKernelGGL(hybrid_fwd, dim3(grid), dim3(NWAVES * 64), LDS_BYTES, stream, a); a.probe = 0; }
#endif
    }
#ifdef DBG_STOP
    hipLaunchKernelGGL(k_dump, dim3(2048), dim3(256), 0, stream, (const unsigned short*)((const char*)d_ws + ((size_t)DBG_DUMP_MIB << 20)), (float*)d_out, (size_t)NLAT * DM);
#endif
#endif
}
```
